# Optimizing an MI355X kernel written in HIP

```python
import jax, jax.numpy as jnp
from jax import lax
import numpy as np

D_MODEL = 1024
BATCH = 2
SEQ = 8192
DEPTH = 4
DEC_BATCH = 32
DEC_SEQ = 16
PAST_LEN = 1024

CHUNK = 64
Q_BLOCK = 128
N_MIXERS = 3
N_LAYERS_A = (DEPTH + 2) // 3
N_LAYERS_B = (DEPTH + 1) // 3
N_LAYERS_C = DEPTH // 3
EPS = 1e-6
MLA_HEADS = 16
MLA_Q_LORA = 512
MLA_KV_LORA = 256
MLA_NOPE = 64
MLA_ROPE = 32
MLA_V = 64
ROPE_BASE = 10000.0
MLA_SCALE = (MLA_NOPE + MLA_ROPE) ** -0.5
CMLP_CHUNK = 128
CMLP_WIDTH = 2048
CMLP_GROUPS = 8
DSA_HEADS = 16
DSA_HEAD_DIM = 64
DSA_SCALE = DSA_HEAD_DIM ** -0.5
IDX_HEADS = 8
IDX_DIM = 64
IDX_SCALE = IDX_DIM ** -0.5
TOPK_MAX = 256
D_FF = -(-8 * D_MODEL // (3 * 256)) * 256

kernel_name = 'hybrid_mla_cmlp_dsa_stream_step'


def rmsnorm(x, g):
    xf = x.astype(jnp.float32)
    y = xf * lax.rsqrt(jnp.mean(xf * xf, axis=-1, keepdims=True) + EPS)
    return (y * g.astype(jnp.float32)).astype(x.dtype)


def layernorm(x, g, b):
    xf = x.astype(jnp.float32)
    mu = jnp.mean(xf, axis=-1, keepdims=True)
    xc = xf - mu
    y = xc * lax.rsqrt(jnp.mean(xc * xc, axis=-1, keepdims=True) + EPS)
    return (y * g.astype(jnp.float32) + b.astype(jnp.float32)).astype(x.dtype)


def rope(x, pos):
    half = x.shape[-1] // 2
    inv = ROPE_BASE ** (-jnp.arange(half, dtype=jnp.float32) / half)
    ang = pos.astype(jnp.float32)[:, None] * inv[None, :]
    ang = ang.reshape(ang.shape[:1] + (1,) * (x.ndim - 3) + (half,))
    cos, sin = jnp.cos(ang), jnp.sin(ang)
    x1, x2 = x[..., :half].astype(jnp.float32), x[..., half:].astype(jnp.float32)
    return jnp.concatenate([x1 * cos - x2 * sin, x1 * sin + x2 * cos], axis=-1).astype(x.dtype)


def chunk_mask(q_pos, k_pos):
    return (k_pos[None, :] // CHUNK) <= (q_pos[:, None] // CHUNK)


def to_blocks(a):
    b, s = a.shape[:2]
    return jnp.moveaxis(a.reshape((b, s // Q_BLOCK, Q_BLOCK) + a.shape[2:]), 1, 0)


def from_blocks(a):
    a = jnp.moveaxis(a, 0, 1)
    return a.reshape((a.shape[0], a.shape[1] * a.shape[2]) + a.shape[3:])


def swiglu(h, w_in, w_out):
    gu = h @ w_in
    return (jax.nn.silu(gu[..., :D_FF]) * gu[..., D_FF:]) @ w_out


def mla_project(h, pos, w_dq, g_q, w_uq, w_dkv, g_kv, w_ukv):
    c_q = rmsnorm(h @ w_dq, g_q)
    q = jnp.einsum('bsc,chd->bshd', c_q, w_uq)
    q_rope = rope(q[..., MLA_NOPE:], pos)
    q_lat = jnp.einsum('bshn,chn->bshc', q[..., :MLA_NOPE], w_ukv[..., :MLA_NOPE])
    kv = h @ w_dkv
    c_kv = rmsnorm(kv[..., :MLA_KV_LORA], g_kv)
    k_rope = rope(kv[..., MLA_KV_LORA:], pos)
    return q_lat, q_rope, c_kv, k_rope


def mla_attend(q_lat, q_rope, c_kv, k_rope, mask):
    s = (jnp.einsum('bqhc,bkc->bhqk', q_lat, c_kv)
         + jnp.einsum('bqhr,bkr->bhqk', q_rope, k_rope)).astype(jnp.float32) * MLA_SCALE
    p = jax.nn.softmax(jnp.where(mask, s, -jnp.inf), axis=-1).astype(c_kv.dtype)
    return jnp.einsum('bhqk,bkc->bqhc', p, c_kv)


def mla_output(out_lat, w_ukv, w_o):
    v = jnp.einsum('bqhc,chv->bqhv', out_lat, w_ukv[..., MLA_NOPE:])
    return v.reshape(v.shape[:2] + (MLA_HEADS * MLA_V,)) @ w_o


def mla_prompt(h, pos, w_dq, g_q, w_uq, w_dkv, g_kv, w_ukv, w_o):
    q_lat, q_rope, c_kv, k_rope = mla_project(h, pos, w_dq, g_q, w_uq, w_dkv, g_kv, w_ukv)
    nb = h.shape[1] // Q_BLOCK

    def blk(args):
        ql, qr, b0 = args
        q_pos = b0 * Q_BLOCK + jnp.arange(Q_BLOCK)
        return mla_attend(ql, qr, c_kv, k_rope, chunk_mask(q_pos, pos))

    out_lat = from_blocks(lax.map(blk, (to_blocks(q_lat), to_blocks(q_rope), jnp.arange(nb))))
    return mla_output(out_lat, w_ukv, w_o), c_kv, k_rope


def mla_sample(h, pos, c_cache, kr_cache, w_dq, g_q, w_uq, w_dkv, g_kv, w_ukv, w_o):
    q_lat, q_rope, c_new, kr_new = mla_project(h, pos, w_dq, g_q, w_uq, w_dkv, g_kv, w_ukv)
    c_all = jnp.concatenate([c_cache, c_new], axis=1)
    kr_all = jnp.concatenate([kr_cache, kr_new], axis=1)
    mask = jnp.ones((h.shape[1], c_all.shape[1]), dtype=bool)
    out_lat = mla_attend(q_lat, q_rope, c_all, kr_all, mask)
    return mla_output(out_lat, w_ukv, w_o), c_new, kr_new


def chunk_mlp_mix(h, w_in, ln_g, ln_b, w_s, b_s, w_out):
    b, s, _ = h.shape
    n = min(s, CMLP_CHUNK)
    uv = jax.nn.gelu(h @ w_in, approximate=False)
    u = uv[..., :CMLP_WIDTH]
    v = layernorm(uv[..., CMLP_WIDTH:], ln_g, ln_b)
    vg = v.reshape(b, s // n, n, CMLP_GROUPS, CMLP_WIDTH // CMLP_GROUPS)
    w = jnp.tril(w_s[:, :n, :n])
    mixed = jnp.einsum('gts,bcsgd->bctgd', w, vg) + b_s[:, :n].T[:, :, None]
    return (u * mixed.reshape(b, s, CMLP_WIDTH)) @ w_out, v


def dsa_project(h, w_qkv, w_qidx, w_kidx, g_kidx, w_widx):
    b, s, _ = h.shape
    qkv = (h @ w_qkv).reshape(b, s, 3, DSA_HEADS, DSA_HEAD_DIM)
    q_idx = (h @ w_qidx).reshape(b, s, IDX_HEADS, IDX_DIM)
    k_idx = rmsnorm(h @ w_kidx, g_kidx)
    w_idx = (h @ w_widx) * (IDX_HEADS ** -0.5)
    return qkv[:, :, 0], qkv[:, :, 1], qkv[:, :, 2], q_idx, k_idx, w_idx


def dsa_attend(q, q_idx, w_idx, k, v, k_idx, mask, topk):
    logits = jnp.einsum('bqhd,bld->bqhl', q_idx, k_idx).astype(jnp.float32) * IDX_SCALE
    score = jnp.einsum('bqh,bqhl->bql', w_idx.astype(jnp.float32), jax.nn.relu(logits))
    score = jnp.where(mask, score, -jnp.inf)
    sel_score, idx = lax.top_k(score, topk)
    valid = jnp.isfinite(sel_score)
    gather = jax.vmap(lambda kb, ib: kb[ib])
    k_sel, v_sel = gather(k, idx), gather(v, idx)
    s = jnp.einsum('bqhd,bqkhd->bhqk', q, k_sel).astype(jnp.float32) * DSA_SCALE
    p = jax.nn.softmax(jnp.where(valid[:, None], s, -jnp.inf), axis=-1).astype(v.dtype)
    return jnp.einsum('bhqk,bqkhd->bqhd', p, v_sel)


def dsa_output(out, w_o):
    return out.reshape(out.shape[:2] + (DSA_HEADS * DSA_HEAD_DIM,)) @ w_o


def dsa_prompt(h, pos, w_qkv, w_o, w_qidx, w_kidx, g_kidx, w_widx):
    q, k, v, q_idx, k_idx, w_idx = dsa_project(h, w_qkv, w_qidx, w_kidx, g_kidx, w_widx)
    seq = h.shape[1]
    topk = min(TOPK_MAX, seq // 4)

    def blk(args):
        qb, qib, wib, b0 = args
        q_pos = b0 * Q_BLOCK + jnp.arange(Q_BLOCK)
        return dsa_attend(qb, qib, wib, k, v, k_idx, chunk_mask(q_pos, pos), topk)

    out = from_blocks(lax.map(blk, (to_blocks(q), to_blocks(q_idx), to_blocks(w_idx),
                                    jnp.arange(seq // Q_BLOCK))))
    return dsa_output(out, w_o), k, v, k_idx


def dsa_sample(h, k_cache, v_cache, kidx_cache, w_qkv, w_o, w_qidx, w_kidx, g_kidx, w_widx):
    q, k_new, v_new, q_idx, kidx_new, w_idx = dsa_project(h, w_qkv, w_qidx, w_kidx, g_kidx, w_widx)
    k_all = jnp.concatenate([k_cache, k_new], axis=1)
    v_all = jnp.concatenate([v_cache, v_new], axis=1)
    kidx_all = jnp.concatenate([kidx_cache, kidx_new], axis=1)
    n_keys = k_all.shape[1]
    mask = jnp.ones((h.shape[1], n_keys), dtype=bool)
    out = dsa_attend(q, q_idx, w_idx, k_all, v_all, kidx_all, mask, min(TOPK_MAX, n_keys // 4))
    return dsa_output(out, w_o), k_new, v_new, kidx_new


def setup_inputs(seed: int = 0) -> dict:
    key = jax.random.key(seed)
    ks = iter(jax.random.split(key, 64))

    def nrm(shape, scale=1.0):
        return jax.random.normal(next(ks), shape, jnp.float32) * scale

    def gain(shape):
        return 1.0 + 0.05 * nrm(shape)

    NA, NB, NC, D = N_LAYERS_A, N_LAYERS_B, N_LAYERS_C, D_MODEL
    return {
        'x_prompt': nrm((BATCH, SEQ, D)),
        'x_sample': nrm((DEC_BATCH, DEC_SEQ, D)),
        'cache_mla_ckv': nrm((NA, DEC_BATCH, PAST_LEN, MLA_KV_LORA)),
        'cache_mla_krope': nrm((NA, DEC_BATCH, PAST_LEN, MLA_ROPE)),
        'cache_dsa_k': nrm((NC, DEC_BATCH, PAST_LEN, DSA_HEADS, DSA_HEAD_DIM)),
        'cache_dsa_v': nrm((NC, DEC_BATCH, PAST_LEN, DSA_HEADS, DSA_HEAD_DIM)),
        'cache_dsa_kidx': nrm((NC, DEC_BATCH, PAST_LEN, IDX_DIM)),
        'norm_mix': gain((DEPTH, D)),
        'norm_ffn': gain((DEPTH, D)),
        'norm_final': gain((D,)),
        'mla_w_dq': nrm((NA, D, MLA_Q_LORA), D ** -0.5),
        'mla_g_q': gain((NA, MLA_Q_LORA)),
        'mla_w_uq': nrm((NA, MLA_Q_LORA, MLA_HEADS, MLA_NOPE + MLA_ROPE), MLA_Q_LORA ** -0.5),
        'mla_w_dkv': nrm((NA, D, MLA_KV_LORA + MLA_ROPE), D ** -0.5),
        'mla_g_kv': gain((NA, MLA_KV_LORA)),
        'mla_w_ukv': nrm((NA, MLA_KV_LORA, MLA_HEADS, MLA_NOPE + MLA_V), MLA_KV_LORA ** -0.5),
        'mla_w_o': nrm((NA, MLA_HEADS * MLA_V, D), (MLA_HEADS * MLA_V) ** -0.5),
        'cmlp_w_in': nrm((NB, D, 2 * CMLP_WIDTH), D ** -0.5),
        'cmlp_ln_g': gain((NB, CMLP_WIDTH)),
        'cmlp_ln_b': nrm((NB, CMLP_WIDTH), 0.02),
        'cmlp_w_s': nrm((NB, CMLP_GROUPS, CMLP_CHUNK, CMLP_CHUNK), CMLP_CHUNK ** -0.5),
        'cmlp_b_s': gain((NB, CMLP_GROUPS, CMLP_CHUNK)),
        'cmlp_w_out': nrm((NB, CMLP_WIDTH, D), CMLP_WIDTH ** -0.5),
        'dsa_w_qkv': nrm((NC, D, 3 * DSA_HEADS * DSA_HEAD_DIM), D ** -0.5),
        'dsa_w_o': nrm((NC, DSA_HEADS * DSA_HEAD_DIM, D), (DSA_HEADS * DSA_HEAD_DIM) ** -0.5),
        'dsa_w_qidx': nrm((NC, D, IDX_HEADS * IDX_DIM), D ** -0.5),
        'dsa_w_kidx': nrm((NC, D, IDX_DIM), D ** -0.5),
        'dsa_g_kidx': gain((NC, IDX_DIM)),
        'dsa_w_widx': nrm((NC, D, IDX_HEADS), D ** -0.5),
        'ffn_w_in': nrm((DEPTH, D, 2 * D_FF), D ** -0.5),
        'ffn_w_out': nrm((DEPTH, D_FF, D), D_FF ** -0.5),
    }


def reference(x_prompt, x_sample, cache_mla_ckv, cache_mla_krope, cache_dsa_k, cache_dsa_v, cache_dsa_kidx,
              norm_mix, norm_ffn, norm_final,
              mla_w_dq, mla_g_q, mla_w_uq, mla_w_dkv, mla_g_kv, mla_w_ukv, mla_w_o,
              cmlp_w_in, cmlp_ln_g, cmlp_ln_b, cmlp_w_s, cmlp_b_s, cmlp_w_out,
              dsa_w_qkv, dsa_w_o, dsa_w_qidx, dsa_w_kidx, dsa_g_kidx, dsa_w_widx,
              ffn_w_in, ffn_w_out):
    xp, xs = x_prompt, x_sample
    pos_p = jnp.arange(xp.shape[1])
    pos_s = PAST_LEN + jnp.arange(xs.shape[1])
    ckv_p, kr_p, ckv_s, kr_s, cv_s = [], [], [], [], []
    dk_p, dv_p, di_p, dk_s, dv_s, di_s = [], [], [], [], [], []
    for i in range(DEPTH):
        kind, j = i % N_MIXERS, i // N_MIXERS
        hp, hs = rmsnorm(xp, norm_mix[i]), rmsnorm(xs, norm_mix[i])
        if kind == 0:
            yp, c1, r1 = mla_prompt(hp, pos_p, mla_w_dq[j], mla_g_q[j], mla_w_uq[j], mla_w_dkv[j],
                                    mla_g_kv[j], mla_w_ukv[j], mla_w_o[j])
            ys, c2, r2 = mla_sample(hs, pos_s, cache_mla_ckv[j], cache_mla_krope[j], mla_w_dq[j], mla_g_q[j],
                                    mla_w_uq[j], mla_w_dkv[j], mla_g_kv[j], mla_w_ukv[j], mla_w_o[j])
            ckv_p.append(c1); kr_p.append(r1); ckv_s.append(c2); kr_s.append(r2)
        elif kind == 1:
            yp, _ = chunk_mlp_mix(hp, cmlp_w_in[j], cmlp_ln_g[j], cmlp_ln_b[j], cmlp_w_s[j], cmlp_b_s[j], cmlp_w_out[j])
            ys, v2 = chunk_mlp_mix(hs, cmlp_w_in[j], cmlp_ln_g[j], cmlp_ln_b[j], cmlp_w_s[j], cmlp_b_s[j], cmlp_w_out[j])
            cv_s.append(v2)
        else:
            yp, k1, v1, i1 = dsa_prompt(hp, pos_p, dsa_w_qkv[j], dsa_w_o[j], dsa_w_qidx[j], dsa_w_kidx[j],
                                        dsa_g_kidx[j], dsa_w_widx[j])
            ys, k2, v2, i2 = dsa_sample(hs, cache_dsa_k[j], cache_dsa_v[j], cache_dsa_kidx[j], dsa_w_qkv[j], dsa_w_o[j],
                                        dsa_w_qidx[j], dsa_w_kidx[j], dsa_g_kidx[j], dsa_w_widx[j])
            dk_p.append(k1); dv_p.append(v1); di_p.append(i1); dk_s.append(k2); dv_s.append(v2); di_s.append(i2)
        xp, xs = xp + yp, xs + ys
        xp = xp + swiglu(rmsnorm(xp, norm_ffn[i]), ffn_w_in[i], ffn_w_out[i])
        xs = xs + swiglu(rmsnorm(xs, norm_ffn[i]), ffn_w_in[i], ffn_w_out[i])
    y_prompt = rmsnorm(xp, norm_final)
    y_sample = rmsnorm(xs, norm_final)
    return (y_prompt, y_sample,
            jnp.stack(ckv_p), jnp.stack(kr_p), jnp.stack(ckv_s), jnp.stack(kr_s),
            jnp.stack(cv_s),
            jnp.stack(dk_p), jnp.stack(dv_p), jnp.stack(di_p),
            jnp.stack(dk_s), jnp.stack(dv_s), jnp.stack(di_s))
```

```cpp
#include <hip/hip_runtime.h>
#include <hip/hip_cooperative_groups.h>
#include <cstdio>
#include <cstring>
#include <cmath>
namespace cg = cooperative_groups;

typedef unsigned short bf16_t;
using bf16x8 = __attribute__((ext_vector_type(8))) short;
using f32x16 = __attribute__((ext_vector_type(16))) float;
using f32x2v = __attribute__((ext_vector_type(2))) float;
using bf2v = __attribute__((ext_vector_type(2))) __bf16;
#define DI __device__ __forceinline__
#define MFMA32(a, b, c) __builtin_amdgcn_mfma_f32_32x32x16_bf16((a), (b), (c), 0, 0, 0)

constexpr int TP = 16384, TS = 512, T = TP + TS;
constexpr int SPAD = 1088, NKS = 1040;
constexpr int KROWS = TP + 32 * SPAD;
constexpr int DFF = 2816;
constexpr float LOG2E = 1.4426950408889634f;
constexpr float EPS = 1e-6f;

constexpr size_t OFF_X = 0;
constexpr size_t OFF_H = OFF_X + (size_t)T * 1024 * 4;
constexpr size_t OFF_W = OFF_H + (size_t)T * 1024 * 2;
constexpr size_t W_ELEMS = 52428800;
constexpr size_t OFF_ROPE = OFF_W + W_ELEMS * 2;
constexpr size_t OFF_R = OFF_ROPE + (size_t)8192 * 16 * 2 * 4;
constexpr size_t R_RAW = 0;
constexpr size_t R_CQ = R_RAW + (size_t)T * 896 * 4;
constexpr size_t R_CKV = R_CQ + (size_t)T * 512 * 2;
constexpr size_t R_KR = R_CKV + (size_t)KROWS * 256 * 2;
constexpr size_t R_Q = R_KR + (size_t)KROWS * 32 * 2;
constexpr size_t R_KN = R_Q + (size_t)T * 1536 * 2;
constexpr size_t R_VT = R_KN + (size_t)KROWS * 1024 * 2;
constexpr size_t R_END = R_VT + (size_t)KROWS * 1024 * 2;
constexpr size_t D_Q = 0;
constexpr size_t D_K = D_Q + (size_t)T * 1024 * 2;
constexpr size_t D_VT = D_K + (size_t)KROWS * 1024 * 2;
constexpr size_t D_QI = D_VT + (size_t)KROWS * 1024 * 2;
constexpr size_t D_KIR = D_QI + (size_t)T * 512 * 2;
constexpr size_t D_KI = D_KIR + (size_t)T * 64 * 4;
constexpr size_t D_WI = D_KI + (size_t)KROWS * 64 * 2;
constexpr size_t D_BM = D_WI + (size_t)T * 8 * 4;
constexpr size_t D_AO = D_BM + (size_t)T * 256 * 4;
constexpr size_t D_END = D_AO + (size_t)T * 1024 * 2;
constexpr size_t C_U = 0;
constexpr size_t C_VR = C_U + (size_t)T * 2048 * 2;
constexpr size_t C_VLN = C_VR + (size_t)T * 2048 * 2;
constexpr size_t C_G = C_VLN + (size_t)T * 2048 * 2;
constexpr size_t C_END = C_G + (size_t)T * 2048 * 2;
constexpr size_t WS_NEED = OFF_R + R_END;
static_assert(D_END <= R_END && C_END <= R_END && (size_t)T * DFF * 2 <= R_END, "region");

constexpr size_t W_MLA = 0;
constexpr size_t WM_D = 0, WM_UQ = 917504, WM_UKV = WM_UQ + 786432, WM_O = WM_UKV + 524288, WM_SZ = 3276800;
constexpr size_t W_CM = 2 * WM_SZ;
constexpr size_t WC_IN = 0, WC_OUT = 4194304, WC_SZ = 6291456;
constexpr size_t W_DS = W_CM + WC_SZ;
constexpr size_t WD_P = 0, WD_O = 3801088, WD_SZ = 4849664;
constexpr size_t W_FF = W_DS + WD_SZ;
constexpr size_t WF_IN = 0, WF_OUT = 5767168, WF_SZ = 8650752;
constexpr size_t W_TRIL = W_FF + 4 * WF_SZ;
static_assert(W_TRIL + 131072 == W_ELEMS, "w");

constexpr size_t O_YP = 0;
constexpr size_t O_YS = O_YP + (size_t)TP * 1024;
constexpr size_t O_CKVP = O_YS + (size_t)TS * 1024;
constexpr size_t O_KRP = O_CKVP + (size_t)2 * TP * 256;
constexpr size_t O_CKVS = O_KRP + (size_t)2 * TP * 32;
constexpr size_t O_KRS = O_CKVS + (size_t)2 * TS * 256;
constexpr size_t O_CVS = O_KRS + (size_t)2 * TS * 32;
constexpr size_t O_DKP = O_CVS + (size_t)TS * 2048;
constexpr size_t O_DVP = O_DKP + (size_t)TP * 1024;
constexpr size_t O_DIP = O_DVP + (size_t)TP * 1024;
constexpr size_t O_DKS = O_DIP + (size_t)TP * 64;
constexpr size_t O_DVS = O_DKS + (size_t)TS * 1024;
constexpr size_t O_DIS = O_DVS + (size_t)TS * 1024;
constexpr size_t O_END = O_DIS + (size_t)TS * 64;

constexpr int NJOBS = 25;
struct Job { const float* src; bf16_t* dst; int nsrc, k, ndst, mode, tile0, pad; };
struct Params {
  const float* in[31];
  float* out;
  unsigned char* ws;
  Job jobs[NJOBS];
  int total_tiles, ph_lo, ph_hi, pad;
  double inv_freq[16];
};

DI unsigned pack2(float a, float b) { f32x2v v = {a, b}; bf2v r = __builtin_convertvector(v, bf2v); return __builtin_bit_cast(unsigned, r); }
DI bf16_t tobf(float a) { return (bf16_t)(pack2(a, 0.f) & 0xffffu); }
DI float frombf(bf16_t v) { return __uint_as_float(((unsigned)v) << 16); }
DI float bflo(unsigned u) { return __uint_as_float(u << 16); }
DI float bfhi(unsigned u) { return __uint_as_float(u & 0xffff0000u); }
DI float wave_sum(float v) {
#pragma unroll
  for (int o = 32; o >= 1; o >>= 1) v += __shfl_xor(v, o, 64);
  return v;
}
DI int ltid() { int t = threadIdx.x; asm volatile("" : "+v"(t)); return t; }
DI int crow(int i, int h) { return (i & 3) + 8 * (i >> 2) + 4 * h; }
DI int rowmap(int t) { if (t < TP) return t; int u = t - TP; return TP + (u >> 4) * SPAD + 1024 + (u & 15); }
DI int tokpos(int t) { return t < TP ? (t & 8191) : 1024 + ((t - TP) & 15); }

DI void transpose_tile(const float* __restrict__ src, int src_ld, int ncols, bf16_t* __restrict__ dst, int dst_ld,
                       int n0, int k0, int mode, float* sm) {
  const int tid = ltid();
  const int nl = tid & 63, kq = tid >> 6;
  const int n = n0 + nl;
  int c;
  if (mode == 0) c = n < ncols ? n : -1;
  else { int tt = n >> 6, r = n & 63; int f = tt * 32 + (r & 31); c = (r < 32) ? f : DFF + f; }
#pragma unroll 4
  for (int i = 0; i < 16; ++i) {
    int kk = kq + 4 * i;
    float v = (c >= 0) ? src[(size_t)(k0 + kk) * src_ld + c] : 0.f;
    sm[kk * 65 + nl] = v;
  }
  __syncthreads();
  const int kp = (tid & 31) * 2, nr = tid >> 5;
#pragma unroll 4
  for (int i = 0; i < 8; ++i) {
    int nn = nr + 8 * i;
    float a = sm[kp * 65 + nn], b = sm[(kp + 1) * 65 + nn];
    *(unsigned*)(dst + (size_t)(n0 + nn) * dst_ld + k0 + kp) = pack2(a, b);
  }
  __syncthreads();
}

enum { E_F32 = 0, E_RESID, E_SWIGLU, E_GELU, E_MLAQ, E_MLAKV, E_DSA };
struct EArgs {
  float* f0; float* f1; float* f2; float* f3; float* f4; float* f5; float* f6;
  bf16_t* b0; bf16_t* b1; bf16_t* b2; bf16_t* b3;
  const float* rope;
};

template <int EPI>
DI void gemm_tile(const bf16_t* __restrict__ A, int lda, const bf16_t* __restrict__ Bt, int ldb, int K, int m0, int n0,
                  const EArgs& ea, unsigned char* smem) {
  const int tid = ltid(), lane = tid & 63, w = tid >> 6, wm = w >> 1, wn = w & 1, lr = lane & 31, lh = lane >> 5;
  bf16_t* As = (bf16_t*)smem;
  bf16_t* Bs = As + 2 * 128 * 72;
  f32x16 acc[2][2];
#pragma unroll
  for (int a = 0; a < 2; ++a)
#pragma unroll
    for (int b = 0; b < 2; ++b)
#pragma unroll
      for (int i = 0; i < 16; ++i) acc[a][b][i] = 0.f;
  const int lrow = tid >> 3, lkc = (tid & 7) * 8;
  const bf16_t* Ag = A + (size_t)(m0 + lrow) * lda + lkc;
  const bf16_t* Bg = Bt + (size_t)(n0 + lrow) * ldb + lkc;
  const size_t astep = (size_t)32 * lda, bstep = (size_t)32 * ldb;
  uint4 ra[4], rb[4];
#pragma unroll
  for (int i = 0; i < 4; ++i) { ra[i] = *(const uint4*)(Ag + i * astep); rb[i] = *(const uint4*)(Bg + i * bstep); }
#pragma unroll
  for (int i = 0; i < 4; ++i) {
    *(uint4*)(As + (lrow + 32 * i) * 72 + lkc) = ra[i];
    *(uint4*)(Bs + (lrow + 32 * i) * 72 + lkc) = rb[i];
  }
  __syncthreads();
  const int nk = K >> 6;
  for (int kt = 0; kt < nk; ++kt) {
    const int buf = kt & 1;
    if (kt + 1 < nk) {
      const int k1 = (kt + 1) << 6;
#pragma unroll
      for (int i = 0; i < 4; ++i) { ra[i] = *(const uint4*)(Ag + i * astep + k1); rb[i] = *(const uint4*)(Bg + i * bstep + k1); }
    }
    const bf16_t* Asb = As + buf * 128 * 72 + (wm * 64 + lr) * 72 + lh * 8;
    const bf16_t* Bsb = Bs + buf * 128 * 72 + (wn * 64 + lr) * 72 + lh * 8;
#pragma unroll
    for (int s = 0; s < 4; ++s) {
      bf16x8 a0 = *(const bf16x8*)(Asb + s * 16);
      bf16x8 a1 = *(const bf16x8*)(Asb + 32 * 72 + s * 16);
      bf16x8 b0 = *(const bf16x8*)(Bsb + s * 16);
      bf16x8 b1 = *(const bf16x8*)(Bsb + 32 * 72 + s * 16);
      acc[0][0] = MFMA32(a0, b0, acc[0][0]);
      acc[0][1] = MFMA32(a0, b1, acc[0][1]);
      acc[1][0] = MFMA32(a1, b0, acc[1][0]);
      acc[1][1] = MFMA32(a1, b1, acc[1][1]);
    }
    if (kt + 1 < nk) {
      const int nb = buf ^ 1;
#pragma unroll
      for (int i = 0; i < 4; ++i) {
        *(uint4*)(As + nb * 128 * 72 + (lrow + 32 * i) * 72 + lkc) = ra[i];
        *(uint4*)(Bs + nb * 128 * 72 + (lrow + 32 * i) * 72 + lkc) = rb[i];
      }
    }
    __syncthreads();
  }
  const int rbase = m0 + wm * 64 + 4 * lh;
  const int cbase = n0 + wn * 64 + lr;
  if constexpr (EPI == E_F32) {
    const int ldc = 896;
#pragma unroll
    for (int mi = 0; mi < 2; ++mi)
#pragma unroll
      for (int ni = 0; ni < 2; ++ni)
#pragma unroll
        for (int i = 0; i < 16; ++i) {
          int row = rbase + mi * 32 + 8 * (i >> 2) + (i & 3), col = cbase + ni * 32;
          ea.f0[(size_t)row * ldc + col] = acc[mi][ni][i];
        }
  } else if constexpr (EPI == E_RESID) {
#pragma unroll
    for (int mi = 0; mi < 2; ++mi)
#pragma unroll
      for (int ni = 0; ni < 2; ++ni)
#pragma unroll
        for (int i = 0; i < 16; ++i) {
          int row = rbase + mi * 32 + 8 * (i >> 2) + (i & 3), col = cbase + ni * 32;
          float* px = ea.f0 + (size_t)row * 1024 + col;
          *px = *px + acc[mi][ni][i];
        }
  } else if constexpr (EPI == E_SWIGLU) {
    const int f = ((n0 + wn * 64) >> 1) + lr;
#pragma unroll
    for (int mi = 0; mi < 2; ++mi)
#pragma unroll
      for (int i = 0; i < 16; ++i) {
        int row = rbase + mi * 32 + 8 * (i >> 2) + (i & 3);
        float g = acc[mi][0][i], u = acc[mi][1][i];
        float a = g / (1.f + __expf(-g)) * u;
        ea.b0[(size_t)row * DFF + f] = tobf(a);
      }
  } else if constexpr (EPI == E_GELU) {
#pragma unroll
    for (int mi = 0; mi < 2; ++mi)
#pragma unroll
      for (int ni = 0; ni < 2; ++ni) {
        int col = cbase + ni * 32;
        bf16_t* dstp = (col < 2048) ? (ea.b0 + col) : (ea.b1 + (col - 2048));
#pragma unroll
        for (int i = 0; i < 16; ++i) {
          int row = rbase + mi * 32 + 8 * (i >> 2) + (i & 3);
          float x = acc[mi][ni][i];
          float y = 0.5f * x * (1.f + erff(x * 0.70710678118654752f));
          dstp[(size_t)row * 2048] = tobf(y);
        }
      }
  } else if constexpr (EPI == E_MLAQ) {
    const float qs = 0.10206207261596577f * LOG2E;
#pragma unroll
    for (int ni = 0; ni < 2; ++ni) {
      const int cb = n0 + wn * 64 + ni * 32;
      const bool is_rope = (cb % 96) == 64;
      const int col = cb + lr;
#pragma unroll
      for (int mi = 0; mi < 2; ++mi)
#pragma unroll
        for (int i = 0; i < 16; ++i) {
          int row = rbase + mi * 32 + 8 * (i >> 2) + (i & 3);
          float v = acc[mi][ni][i];
          float o = v;
          if (is_rope) {
            float pv = __shfl_xor(v, 16, 64);
            int pos = tokpos(row);
            float2 cs = *(const float2*)(ea.rope + ((size_t)pos * 16 + (lr & 15)) * 2);
            o = (lr < 16) ? (v * cs.x - pv * cs.y) : (pv * cs.y + v * cs.x);
          }
          ea.b0[(size_t)row * 1536 + col] = tobf(o * qs);
        }
    }
  } else if constexpr (EPI == E_MLAKV) {
#pragma unroll
    for (int ni = 0; ni < 2; ++ni) {
      const int cb = n0 + wn * 64 + ni * 32;
      const int head = cb >> 7, c = (cb & 127) + lr;
      if (c < 64) {
#pragma unroll
        for (int mi = 0; mi < 2; ++mi)
#pragma unroll
          for (int i = 0; i < 16; ++i) {
            int row = rbase + mi * 32 + 8 * (i >> 2) + (i & 3);
            ea.b0[(size_t)row * 1024 + head * 64 + c] = tobf(acc[mi][ni][i]);
          }
      } else {
        const int d = c - 64;
#pragma unroll
        for (int mi = 0; mi < 2; ++mi)
#pragma unroll
          for (int g = 0; g < 4; ++g) {
            int row = rbase + mi * 32 + 8 * g;
            size_t off;
            if (row < TP) { int b = row >> 13, s = row & 8191; off = ((size_t)((b * 16 + head) * 64 + d)) * 8192 + s; }
            else { int u = row - TP; int b = u / SPAD, s = u - b * SPAD; off = (size_t)TP * 1024 + ((size_t)((b * 16 + head) * 64 + d)) * SPAD + s; }
            uint2 pk; pk.x = pack2(acc[mi][ni][4 * g], acc[mi][ni][4 * g + 1]); pk.y = pack2(acc[mi][ni][4 * g + 2], acc[mi][ni][4 * g + 3]);
            *(uint2*)(ea.b1 + off) = pk;
          }
      }
    }
  } else if constexpr (EPI == E_DSA) {
#pragma unroll
    for (int ni = 0; ni < 2; ++ni) {
      const int cb = n0 + wn * 64 + ni * 32;
      const int col = cb + lr;
      if (cb < 1024) {
        const float qs = 0.125f * LOG2E;
#pragma unroll
        for (int mi = 0; mi < 2; ++mi)
#pragma unroll
          for (int i = 0; i < 16; ++i) {
            int row = rbase + mi * 32 + 8 * (i >> 2) + (i & 3);
            ea.b0[(size_t)row * 1024 + col] = tobf(acc[mi][ni][i] * qs);
          }
      } else if (cb < 2048) {
        const int c = col - 1024;
#pragma unroll
        for (int mi = 0; mi < 2; ++mi)
#pragma unroll
          for (int i = 0; i < 16; ++i) {
            int row = rbase + mi * 32 + 8 * (i >> 2) + (i & 3);
            float v = acc[mi][ni][i];
            if (row < TP) ea.f0[(size_t)row * 1024 + c] = v; else ea.f1[(size_t)(row - TP) * 1024 + c] = v;
            ea.b1[(size_t)rowmap(row) * 1024 + c] = tobf(v);
          }
      } else if (cb < 3072) {
        const int c = col - 2048, head = c >> 6, d = c & 63;
#pragma unroll
        for (int mi = 0; mi < 2; ++mi)
#pragma unroll
          for (int g = 0; g < 4; ++g) {
            int row = rbase + mi * 32 + 8 * g;
#pragma unroll
            for (int j = 0; j < 4; ++j) {
              float v = acc[mi][ni][4 * g + j];
              if (row < TP) ea.f2[(size_t)(row + j) * 1024 + c] = v; else ea.f3[(size_t)(row + j - TP) * 1024 + c] = v;
            }
            size_t off;
            if (row < TP) { int b = row >> 13, s = row & 8191; off = ((size_t)((b * 16 + head) * 64 + d)) * 8192 + s; }
            else { int u = row - TP; int b = u >> 4, s = 1024 + (u & 15); off = (size_t)TP * 1024 + ((size_t)((b * 16 + head) * 64 + d)) * SPAD + s; }
            uint2 pk; pk.x = pack2(acc[mi][ni][4 * g], acc[mi][ni][4 * g + 1]); pk.y = pack2(acc[mi][ni][4 * g + 2], acc[mi][ni][4 * g + 3]);
            *(uint2*)(ea.b2 + off) = pk;
          }
      } else if (cb < 3584) {
        const int c = col - 3072;
#pragma unroll
        for (int mi = 0; mi < 2; ++mi)
#pragma unroll
          for (int i = 0; i < 16; ++i) {
            int row = rbase + mi * 32 + 8 * (i >> 2) + (i & 3);
            ea.b3[(size_t)row * 512 + c] = tobf(acc[mi][ni][i] * 0.125f);
          }
      } else if (cb < 3648) {
        const int c = col - 3584;
#pragma unroll
        for (int mi = 0; mi < 2; ++mi)
#pragma unroll
          for (int i = 0; i < 16; ++i) {
            int row = rbase + mi * 32 + 8 * (i >> 2) + (i & 3);
            ea.f4[(size_t)row * 64 + c] = acc[mi][ni][i];
          }
      } else if (cb == 3648) {
        if (lr < 8) {
#pragma unroll
          for (int mi = 0; mi < 2; ++mi)
#pragma unroll
            for (int i = 0; i < 16; ++i) {
              int row = rbase + mi * 32 + 8 * (i >> 2) + (i & 3);
              ea.f5[(size_t)row * 8 + lr] = acc[mi][ni][i] * 0.35355339059327379f;
            }
        }
      }
    }
  }
}

template <int EPI>
DI void gemm_phase(const bf16_t* A, int lda, const bf16_t* Bt, int ldb, int M, int N, int K, const EArgs& ea,
                   unsigned char* smem, int tstart, int bid, int nblk) {
  const int nt = N >> 7, total = (M >> 7) * nt;
  int t0 = bid - (tstart % nblk); if (t0 < 0) t0 += nblk;
  for (int t = t0; t < total; t += nblk) {
    int tm = t / nt, tn = t - tm * nt;
    gemm_tile<EPI>(A, lda, Bt, ldb, K, tm * 128, tn * 128, ea, smem);
  }
}

DI void rmsnorm_rows(const float* __restrict__ X, const float* __restrict__ g, bf16_t* __restrict__ H, float* outp, float* outs,
                     int bid, int nblk) {
  const int lane = ltid() & 63, w = ltid() >> 6;
  for (int row = bid * 4 + w; row < T; row += nblk * 4) {
    const float* xr = X + (size_t)row * 1024;
    float4 v[4];
    float ss = 0.f;
#pragma unroll
    for (int c = 0; c < 4; ++c) { v[c] = *(const float4*)(xr + c * 256 + lane * 4); ss += v[c].x * v[c].x + v[c].y * v[c].y + v[c].z * v[c].z + v[c].w * v[c].w; }
    ss = wave_sum(ss);
    float r = rsqrtf(ss * (1.f / 1024.f) + EPS);
#pragma unroll
    for (int c = 0; c < 4; ++c) {
      int col = c * 256 + lane * 4;
      float4 gg = *(const float4*)(g + col);
      float a = v[c].x * r * gg.x, b = v[c].y * r * gg.y, cc = v[c].z * r * gg.z, d = v[c].w * r * gg.w;
      if (H) { uint2 pk; pk.x = pack2(a, b); pk.y = pack2(cc, d); *(uint2*)(H + (size_t)row * 1024 + col) = pk; }
      else {
        float* o = (row < TP) ? outp + (size_t)row * 1024 + col : outs + (size_t)(row - TP) * 1024 + col;
        *(float4*)o = make_float4(a, b, cc, d);
      }
    }
  }
}

DI void mla_rowops(const Params& p, int j, int bid, int nblk) {
  const int lane = ltid() & 63, w = ltid() >> 6;
  unsigned char* R = p.ws + OFF_R;
  const float* RAW = (const float*)(R + R_RAW);
  bf16_t* CQ = (bf16_t*)(R + R_CQ); bf16_t* CKV = (bf16_t*)(R + R_CKV); bf16_t* KR = (bf16_t*)(R + R_KR);
  const float* gq = p.in[11] + j * 512; const float* gkv = p.in[14] + j * 256;
  const float* rope = (const float*)(p.ws + OFF_ROPE);
  for (int row = bid * 4 + w; row < T; row += nblk * 4) {
    const float* rr = RAW + (size_t)row * 896;
    float4 a0 = *(const float4*)(rr + lane * 4), a1 = *(const float4*)(rr + 256 + lane * 4);
    float4 c0 = *(const float4*)(rr + 512 + lane * 4);
    float ss = a0.x * a0.x + a0.y * a0.y + a0.z * a0.z + a0.w * a0.w + a1.x * a1.x + a1.y * a1.y + a1.z * a1.z + a1.w * a1.w;
    float s2 = c0.x * c0.x + c0.y * c0.y + c0.z * c0.z + c0.w * c0.w;
    ss = wave_sum(ss); s2 = wave_sum(s2);
    float r1 = rsqrtf(ss * (1.f / 512.f) + EPS), r2 = rsqrtf(s2 * (1.f / 256.f) + EPS);
    {
      float4 g0 = *(const float4*)(gq + lane * 4), g1 = *(const float4*)(gq + 256 + lane * 4);
      uint2 pk; pk.x = pack2(a0.x * r1 * g0.x, a0.y * r1 * g0.y); pk.y = pack2(a0.z * r1 * g0.z, a0.w * r1 * g0.w);
      *(uint2*)(CQ + (size_t)row * 512 + lane * 4) = pk;
      pk.x = pack2(a1.x * r1 * g1.x, a1.y * r1 * g1.y); pk.y = pack2(a1.z * r1 * g1.z, a1.w * r1 * g1.w);
      *(uint2*)(CQ + (size_t)row * 512 + 256 + lane * 4) = pk;
    }
    const int rm = rowmap(row);
    {
      float4 g = *(const float4*)(gkv + lane * 4);
      float4 o = make_float4(c0.x * r2 * g.x, c0.y * r2 * g.y, c0.z * r2 * g.z, c0.w * r2 * g.w);
      float* op = (row < TP) ? p.out + O_CKVP + ((size_t)j * TP + row) * 256 : p.out + O_CKVS + ((size_t)j * TS + (row - TP)) * 256;
      *(float4*)(op + lane * 4) = o;
      uint2 pk; pk.x = pack2(o.x, o.y); pk.y = pack2(o.z, o.w);
      *(uint2*)(CKV + (size_t)rm * 256 + lane * 4) = pk;
    }
    if (lane < 16) {
      float x1 = rr[768 + lane], x2 = rr[784 + lane];
      int pos = tokpos(row);
      float2 cs = *(const float2*)(rope + ((size_t)pos * 16 + lane) * 2);
      float o1 = x1 * cs.x - x2 * cs.y, o2 = x1 * cs.y + x2 * cs.x;
      float* op = (row < TP) ? p.out + O_KRP + ((size_t)j * TP + row) * 32 : p.out + O_KRS + ((size_t)j * TS + (row - TP)) * 32;
      op[lane] = o1; op[16 + lane] = o2;
      KR[(size_t)rm * 32 + lane] = tobf(o1); KR[(size_t)rm * 32 + 16 + lane] = tobf(o2);
    }
  }
}

DI void dsa_rowops(const Params& p, int bid, int nblk) {
  const int lane = ltid() & 63, w = ltid() >> 6;
  unsigned char* R = p.ws + OFF_R;
  const float* KIR = (const float*)(R + D_KIR);
  bf16_t* KI = (bf16_t*)(R + D_KI);
  const float* g = p.in[27];
  for (int row = bid * 4 + w; row < T; row += nblk * 4) {
    float v = KIR[(size_t)row * 64 + lane];
    float ss = wave_sum(v * v);
    float r = rsqrtf(ss * (1.f / 64.f) + EPS);
    float o = v * r * g[lane];
    if (row < TP) p.out[O_DIP + (size_t)row * 64 + lane] = o; else p.out[O_DIS + (size_t)(row - TP) * 64 + lane] = o;
    KI[(size_t)rowmap(row) * 64 + lane] = tobf(o);
  }
}

DI void cmlp_ln_rows(const Params& p, int bid, int nblk) {
  const int lane = ltid() & 63, w = ltid() >> 6;
  unsigned char* R = p.ws + OFF_R;
  const bf16_t* VR = (const bf16_t*)(R + C_VR);
  bf16_t* VLN = (bf16_t*)(R + C_VLN);
  const float* g = p.in[18]; const float* bb = p.in[19];
  for (int row = bid * 4 + w; row < T; row += nblk * 4) {
    float x[32];
    float sum = 0.f;
#pragma unroll
    for (int c = 0; c < 4; ++c) {
      uint4 u = *(const uint4*)(VR + (size_t)row * 2048 + c * 512 + lane * 8);
      x[c * 8 + 0] = bflo(u.x); x[c * 8 + 1] = bfhi(u.x); x[c * 8 + 2] = bflo(u.y); x[c * 8 + 3] = bfhi(u.y);
      x[c * 8 + 4] = bflo(u.z); x[c * 8 + 5] = bfhi(u.z); x[c * 8 + 6] = bflo(u.w); x[c * 8 + 7] = bfhi(u.w);
    }
#pragma unroll
    for (int i = 0; i < 32; ++i) sum += x[i];
    sum = wave_sum(sum);
    float mu = sum * (1.f / 2048.f);
    float vs = 0.f;
#pragma unroll
    for (int i = 0; i < 32; ++i) { x[i] -= mu; vs += x[i] * x[i]; }
    vs = wave_sum(vs);
    float r = rsqrtf(vs * (1.f / 2048.f) + EPS);
#pragma unroll
    for (int c = 0; c < 4; ++c) {
      int col = c * 512 + lane * 8;
      float y[8];
#pragma unroll
      for (int q = 0; q < 2; ++q) {
        float4 gg = *(const float4*)(g + col + q * 4), b4 = *(const float4*)(bb + col + q * 4);
        y[q * 4 + 0] = x[c * 8 + q * 4 + 0] * r * gg.x + b4.x; y[q * 4 + 1] = x[c * 8 + q * 4 + 1] * r * gg.y + b4.y;
        y[q * 4 + 2] = x[c * 8 + q * 4 + 2] * r * gg.z + b4.z; y[q * 4 + 3] = x[c * 8 + q * 4 + 3] * r * gg.w + b4.w;
      }
      uint4 pk; pk.x = pack2(y[0], y[1]); pk.y = pack2(y[2], y[3]); pk.z = pack2(y[4], y[5]); pk.w = pack2(y[6], y[7]);
      *(uint4*)(VLN + (size_t)row * 2048 + col) = pk;
      if (row >= TP) {
        float* o = p.out + O_CVS + (size_t)(row - TP) * 2048 + col;
        *(float4*)o = make_float4(y[0], y[1], y[2], y[3]); *(float4*)(o + 4) = make_float4(y[4], y[5], y[6], y[7]);
      }
    }
  }
}

DI void cmlp_mix_phase(const Params& p, unsigned char* smem, int bid, int nblk) {
  const int tid = ltid(), lane = tid & 63, w = tid >> 6, wm = w >> 1, wn = w & 1, lr = lane & 31, lh = lane >> 5;
  unsigned char* R = p.ws + OFF_R;
  const bf16_t* U = (const bf16_t*)(R + C_U);
  const bf16_t* VLN = (const bf16_t*)(R + C_VLN);
  bf16_t* G = (bf16_t*)(R + C_G);
  const bf16_t* WT = (const bf16_t*)(p.ws + OFF_W) + W_TRIL;
  const float* bs = p.in[21];
  bf16_t* As = (bf16_t*)smem;
  bf16_t* Bs = As + 128 * 136;
  for (int u = bid; u < 2048; u += nblk) {
    const int half = u & 1, g = (u >> 1) & 7, ch = u >> 4;
    const int col0 = g * 256 + half * 128;
#pragma unroll 2
    for (int i = 0; i < 8; ++i) {
      int v = tid + i * 256; int r = v >> 4, c = (v & 15) * 8;
      *(uint4*)(As + r * 136 + c) = *(const uint4*)(WT + ((size_t)g * 128 + r) * 128 + c);
    }
#pragma unroll 2
    for (int i = 0; i < 8; ++i) {
      int v = tid + i * 256; int s = v >> 4, c = (v & 15) * 8;
      uint4 x = *(const uint4*)(VLN + ((size_t)ch * 128 + s) * 2048 + col0 + c);
      Bs[(c + 0) * 136 + s] = (bf16_t)(x.x & 0xffff); Bs[(c + 1) * 136 + s] = (bf16_t)(x.x >> 16);
      Bs[(c + 2) * 136 + s] = (bf16_t)(x.y & 0xffff); Bs[(c + 3) * 136 + s] = (bf16_t)(x.y >> 16);
      Bs[(c + 4) * 136 + s] = (bf16_t)(x.z & 0xffff); Bs[(c + 5) * 136 + s] = (bf16_t)(x.z >> 16);
      Bs[(c + 6) * 136 + s] = (bf16_t)(x.w & 0xffff); Bs[(c + 7) * 136 + s] = (bf16_t)(x.w >> 16);
    }
    __syncthreads();
    f32x16 acc[2][2];
#pragma unroll
    for (int a = 0; a < 2; ++a)
#pragma unroll
      for (int b = 0; b < 2; ++b)
#pragma unroll
        for (int i = 0; i < 16; ++i) acc[a][b][i] = 0.f;
    const bf16_t* Asb = As + (wm * 64 + lr) * 136 + lh * 8;
    const bf16_t* Bsb = Bs + (wn * 64 + lr) * 136 + lh * 8;
    const int ns = (wm + 1) * 4;
    for (int s = 0; s < ns; ++s) {
      bf16x8 a0 = *(const bf16x8*)(Asb + s * 16);
      bf16x8 a1 = *(const bf16x8*)(Asb + 32 * 136 + s * 16);
      bf16x8 b0 = *(const bf16x8*)(Bsb + s * 16);
      bf16x8 b1 = *(const bf16x8*)(Bsb + 32 * 136 + s * 16);
      acc[0][0] = MFMA32(a0, b0, acc[0][0]);
      acc[0][1] = MFMA32(a0, b1, acc[0][1]);
      acc[1][0] = MFMA32(a1, b0, acc[1][0]);
      acc[1][1] = MFMA32(a1, b1, acc[1][1]);
    }
#pragma unroll
    for (int mi = 0; mi < 2; ++mi)
#pragma unroll
      for (int ni = 0; ni < 2; ++ni)
#pragma unroll
        for (int i = 0; i < 16; ++i) {
          int t = wm * 64 + mi * 32 + crow(i, lh);
          int col = col0 + wn * 64 + ni * 32 + lr;
          size_t off = ((size_t)ch * 128 + t) * 2048 + col;
          float mixed = acc[mi][ni][i] + bs[g * 128 + t];
          G[off] = tobf(frombf(U[off]) * mixed);
        }
    __syncthreads();
  }
  const float* wsf = p.in[20];
  for (int e = bid * 256 + tid; e < TS * 2048; e += nblk * 256) {
    int row = e >> 11, col = e & 2047, b = row >> 4, t = row & 15, g = col >> 8;
    float a = bs[g * 128 + t];
    for (int s = 0; s <= t; ++s) a += wsf[((size_t)g * 128 + t) * 128 + s] * frombf(VLN[((size_t)TP + b * 16 + s) * 2048 + col]);
    size_t off = ((size_t)TP + row) * 2048 + col;
    G[off] = tobf(frombf(U[off]) * a);
  }
}

template <int DQK, bool IS_MLA>
DI void attn_unit(const bf16_t* __restrict__ Qp, int ldq, int nq,
                  const bf16_t* __restrict__ Kp, int ldk, const bf16_t* __restrict__ KRp,
                  const bf16_t* __restrict__ Vtp, int ldv,
                  int nkt, int nkt_w, int nkeys, const unsigned* __restrict__ BMp,
                  bf16_t* __restrict__ AOp, unsigned char* smem) {
  constexpr int KS = DQK + 8;
  constexpr int VS = 68;
  constexpr int NQS = DQK / 16;
  const int tid = ltid(), lane = tid & 63, w = tid >> 6, lr = lane & 31, lh = lane >> 5;
  bf16_t* Ks = (bf16_t*)smem;
  bf16_t* Vs = Ks + 2 * 64 * KS;
  const bool q_ok = (w * 32 + lr) < nq;
  const int qrow = q_ok ? (w * 32 + lr) : 0;
  bf16x8 qf[NQS];
#pragma unroll
  for (int s = 0; s < NQS; ++s) qf[s] = *(const bf16x8*)(Qp + (size_t)qrow * ldq + s * 16 + lh * 8);
  f32x16 oacc[2];
#pragma unroll
  for (int d = 0; d < 2; ++d)
#pragma unroll
    for (int i = 0; i < 16; ++i) oacc[d][i] = 0.f;
  float m_run = -INFINITY, l_run = 0.f;
  const int kkey = tid >> 3, kc = (tid & 7) * 8;
  const int rkey = tid >> 2, rc = (tid & 3) * 8;
  const int vd = tid >> 3, vk = (tid & 7) * 8;
  uint4 rk[2], rr, rv[2];
  rr = make_uint4(0, 0, 0, 0);
  auto gload = [&](int kt) {
    const int key0 = kt * 64;
#pragma unroll
    for (int i = 0; i < 2; ++i) rk[i] = *(const uint4*)(Kp + (size_t)(key0 + kkey + 32 * i) * ldk + kc);
    if constexpr (IS_MLA) rr = *(const uint4*)(KRp + (size_t)(key0 + rkey) * 32 + rc);
#pragma unroll
    for (int i = 0; i < 2; ++i) rv[i] = *(const uint4*)(Vtp + (size_t)(vd + 32 * i) * ldv + key0 + vk);
  };
  auto sstore = [&](int buf) {
    bf16_t* Kb = Ks + buf * 64 * KS; bf16_t* Vb = Vs + buf * 64 * VS;
#pragma unroll
    for (int i = 0; i < 2; ++i) *(uint4*)(Kb + (kkey + 32 * i) * KS + kc) = rk[i];
    if constexpr (IS_MLA) *(uint4*)(Kb + rkey * KS + 64 + rc) = rr;
#pragma unroll
    for (int i = 0; i < 2; ++i) {
      uint2 lo = make_uint2(rv[i].x, rv[i].y), hi = make_uint2(rv[i].z, rv[i].w);
      *(uint2*)(Vb + (vd + 32 * i) * VS + vk) = lo;
      *(uint2*)(Vb + (vd + 32 * i) * VS + vk + 4) = hi;
    }
  };
  __syncthreads();
  gload(0); sstore(0);
  __syncthreads();
  for (int kt = 0; kt < nkt; ++kt) {
    const int buf = kt & 1;
    if (kt + 1 < nkt) gload(kt + 1);
    if (kt < nkt_w) {
      const bf16_t* Kb = Ks + buf * 64 * KS; const bf16_t* Vb = Vs + buf * 64 * VS;
      uint2 bmw = make_uint2(0xffffffffu, 0xffffffffu);
      if (BMp) bmw = *(const uint2*)(BMp + (size_t)qrow * 256 + kt * 2);
      f32x16 sacc[2];
#pragma unroll
      for (int mt = 0; mt < 2; ++mt) {
#pragma unroll
        for (int i = 0; i < 16; ++i) sacc[mt][i] = 0.f;
#pragma unroll
        for (int s = 0; s < NQS; ++s) {
          bf16x8 kf = *(const bf16x8*)(Kb + (mt * 32 + lr) * KS + s * 16 + lh * 8);
          sacc[mt] = MFMA32(kf, qf[s], sacc[mt]);
        }
      }
      float mx = -INFINITY;
#pragma unroll
      for (int mt = 0; mt < 2; ++mt) {
        const unsigned wbits = mt ? bmw.y : bmw.x;
#pragma unroll
        for (int i = 0; i < 16; ++i) {
          const int kin = crow(i, lh);
          const int key = kt * 64 + mt * 32 + kin;
          bool ok = (key < nkeys) && ((wbits >> kin) & 1u);
          float sv = ok ? sacc[mt][i] : -INFINITY;
          sacc[mt][i] = sv;
          mx = fmaxf(mx, sv);
        }
      }
      mx = fmaxf(mx, __shfl_xor(mx, 32, 64));
      const float m_new = fmaxf(m_run, mx);
      const float m_safe = (m_new == -INFINITY) ? 0.f : m_new;
      const float alpha = exp2f(m_run - m_safe);
      m_run = m_new;
      float ls = 0.f;
#pragma unroll
      for (int mt = 0; mt < 2; ++mt)
#pragma unroll
        for (int i = 0; i < 16; ++i) { float pv = exp2f(sacc[mt][i] - m_safe); sacc[mt][i] = pv; ls += pv; }
      l_run = l_run * alpha + ls;
#pragma unroll
      for (int d = 0; d < 2; ++d)
#pragma unroll
        for (int i = 0; i < 16; ++i) oacc[d][i] *= alpha;
#pragma unroll
      for (int mt = 0; mt < 2; ++mt)
#pragma unroll
        for (int s = 0; s < 2; ++s) {
          uint4 pp;
          pp.x = pack2(sacc[mt][8 * s + 0], sacc[mt][8 * s + 1]);
          pp.y = pack2(sacc[mt][8 * s + 2], sacc[mt][8 * s + 3]);
          pp.z = pack2(sacc[mt][8 * s + 4], sacc[mt][8 * s + 5]);
          pp.w = pack2(sacc[mt][8 * s + 6], sacc[mt][8 * s + 7]);
          bf16x8 pf = __builtin_bit_cast(bf16x8, pp);
#pragma unroll
          for (int dt = 0; dt < 2; ++dt) {
            const bf16_t* vrow = Vb + (dt * 32 + lr) * VS + mt * 32 + 16 * s + 4 * lh;
            uint2 lo = *(const uint2*)(vrow), hi = *(const uint2*)(vrow + 8);
            uint4 vv = make_uint4(lo.x, lo.y, hi.x, hi.y);
            bf16x8 vf = __builtin_bit_cast(bf16x8, vv);
            oacc[dt] = MFMA32(vf, pf, oacc[dt]);
          }
        }
    }
    if (kt + 1 < nkt) sstore(buf ^ 1);
    __syncthreads();
  }
  if (nkt_w > 0) {
    float lt = l_run + __shfl_xor(l_run, 32, 64);
    float inv = lt > 0.f ? 1.f / lt : 0.f;
    if (q_ok) {
      bf16_t* orow = AOp + (size_t)(w * 32 + lr) * 1024;
#pragma unroll
      for (int dt = 0; dt < 2; ++dt)
#pragma unroll
        for (int g = 0; g < 4; ++g) {
          uint2 pk;
          pk.x = pack2(oacc[dt][4 * g] * inv, oacc[dt][4 * g + 1] * inv);
          pk.y = pack2(oacc[dt][4 * g + 2] * inv, oacc[dt][4 * g + 3] * inv);
          *(uint2*)(orow + dt * 32 + 8 * g + 4 * lh) = pk;
        }
    }
  }
}

DI int snake_idx(int i, int bid, int nblk) { return i * nblk + ((i & 1) ? (nblk - 1 - bid) : bid); }

template <bool IS_MLA>
DI void attn_phase(const Params& p, unsigned char* smem, int bid, int nblk) {
  unsigned char* R = p.ws + OFF_R;
  const int w = ltid() >> 6;
  const int total = 2048 + 512;
  for (int i = 0; i * nblk < total; ++i) {
    int idx = snake_idx(i, bid, nblk);
    if (idx >= total) continue;
    if constexpr (IS_MLA) {
      const bf16_t* Q = (const bf16_t*)(R + R_Q); const bf16_t* KN = (const bf16_t*)(R + R_KN);
      const bf16_t* KR = (const bf16_t*)(R + R_KR); const bf16_t* VT = (const bf16_t*)(R + R_VT);
      bf16_t* AO = (bf16_t*)(R + R_RAW);
      if (idx < 2048) {
        int qt = 63 - (idx >> 5), bh = idx & 31, b = bh >> 4, h = bh & 15;
        int q0 = b * 8192 + qt * 128;
        attn_unit<96, true>(Q + (size_t)q0 * 1536 + h * 96, 1536, 128,
                            KN + (size_t)(b * 8192) * 1024 + h * 64, 1024, KR + (size_t)(b * 8192) * 32,
                            VT + (size_t)((b * 16 + h) * 64) * 8192, 8192,
                            2 * qt + 2, 2 * qt + 1 + (w >> 1), 1 << 30, nullptr,
                            AO + (size_t)q0 * 1024 + h * 64, smem);
      } else {
        int u = idx - 2048, b = u >> 4, h = u & 15;
        int q0 = TP + b * 16;
        attn_unit<96, true>(Q + (size_t)q0 * 1536 + h * 96, 1536, 16,
                            KN + (size_t)(TP + b * SPAD) * 1024 + h * 64, 1024, KR + (size_t)(TP + b * SPAD) * 32,
                            VT + (size_t)TP * 1024 + (size_t)((b * 16 + h) * 64) * SPAD, SPAD,
                            17, (w == 0) ? 17 : 0, NKS, nullptr,
                            AO + (size_t)q0 * 1024 + h * 64, smem);
      }
    } else {
      const bf16_t* Q = (const bf16_t*)(R + D_Q); const bf16_t* KK = (const bf16_t*)(R + D_K);
      const bf16_t* VT = (const bf16_t*)(R + D_VT); const unsigned* BM = (const unsigned*)(R + D_BM);
      bf16_t* AO = (bf16_t*)(R + D_AO);
      if (idx < 2048) {
        int qt = 63 - (idx >> 5), bh = idx & 31, b = bh >> 4, h = bh & 15;
        int q0 = b * 8192 + qt * 128;
        attn_unit<64, false>(Q + (size_t)q0 * 1024 + h * 64, 1024, 128,
                             KK + (size_t)(b * 8192) * 1024 + h * 64, 1024, nullptr,
                             VT + (size_t)((b * 16 + h) * 64) * 8192, 8192,
                             2 * qt + 2, 2 * qt + 1 + (w >> 1), 1 << 30, BM + (size_t)q0 * 256,
                             AO + (size_t)q0 * 1024 + h * 64, smem);
      } else {
        int u = idx - 2048, b = u >> 4, h = u & 15;
        int q0 = TP + b * 16;
        attn_unit<64, false>(Q + (size_t)q0 * 1024 + h * 64, 1024, 16,
                             KK + (size_t)(TP + b * SPAD) * 1024 + h * 64, 1024, nullptr,
                             VT + (size_t)TP * 1024 + (size_t)((b * 16 + h) * 64) * SPAD, SPAD,
                             17, (w == 0) ? 17 : 0, NKS, BM + (size_t)q0 * 256,
                             AO + (size_t)q0 * 1024 + h * 64, smem);
      }
    }
  }
}

constexpr int CAP = 128;
DI int score_bin(float s) {
  unsigned u = __float_as_uint(s);
  int e = (int)((u & 0x7fffffffu) >> 19);
  int m = min(max(e, 1840), 2095) - 1840;
  return (u >> 31) ? (255 - m) : (256 + m);
}

DI void idx_unit(const bf16_t* __restrict__ QI, const float* __restrict__ WI, int q_row0, int nq,
                 const bf16_t* __restrict__ KI, int L, unsigned* __restrict__ BM, unsigned char* smem) {
  const int tid = ltid(), lane = tid & 63, w = tid >> 6, lr = lane & 31, lh = lane >> 5;
  bf16_t* Qs = (bf16_t*)smem;
  float* Ws = (float*)(smem + 36864);
  unsigned* hist = (unsigned*)(smem + 36864 + 1024);
  float* cand_s = (float*)hist;
  int* cand_i = (int*)(smem + 36864 + 1024 + 16384);
  int* bstar = (int*)(smem + 36864 + 1024 + 32768);
  int* need = bstar + 32;
  int* ncand = need + 32;
  __syncthreads();
#pragma unroll
  for (int i = 0; i < 8; ++i) {
    int v = tid + i * 256;
    int hd = v >> 8, q = (v >> 3) & 31, c = (v & 7) * 8;
    int qq = q < nq ? q : 0;
    *(uint4*)(Qs + (hd * 32 + q) * 72 + c) = *(const uint4*)(QI + (size_t)(q_row0 + qq) * 512 + hd * 64 + c);
  }
  { int hd = tid >> 5, q = tid & 31; int qq = q < nq ? q : 0; Ws[hd * 32 + q] = WI[(size_t)(q_row0 + qq) * 8 + hd]; }
  for (int i = tid; i < 32 * 256; i += 256) hist[i] = 0u;
  if (tid < 32) { bstar[tid] = -1; need[tid] = 0; ncand[tid] = 0; }
  __syncthreads();
  const int ntile = (L + 127) >> 7;
  const bool do_select = L > 256;
  for (int pass = do_select ? 0 : 1; pass < 2; ++pass) {
    for (int kt = 0; kt < ntile; ++kt) {
      const int key0 = kt * 128 + w * 32;
      if (key0 < L) {
        const int key = key0 + lr;
        bf16x8 kf[4];
#pragma unroll
        for (int s = 0; s < 4; ++s) kf[s] = *(const bf16x8*)(KI + (size_t)key * 64 + s * 16 + lh * 8);
        float sc[16];
#pragma unroll
        for (int i = 0; i < 16; ++i) sc[i] = 0.f;
#pragma unroll 1
        for (int hd = 0; hd < 8; ++hd) {
          f32x16 acc;
#pragma unroll
          for (int i = 0; i < 16; ++i) acc[i] = 0.f;
#pragma unroll
          for (int s = 0; s < 4; ++s) {
            bf16x8 qf = *(const bf16x8*)(Qs + (hd * 32 + lr) * 72 + s * 16 + lh * 8);
            acc = MFMA32(qf, kf[s], acc);
          }
#pragma unroll
          for (int g = 0; g < 4; ++g) {
            float4 wv = *(const float4*)(Ws + hd * 32 + 8 * g + 4 * lh);
            sc[4 * g + 0] += wv.x * fmaxf(acc[4 * g + 0], 0.f);
            sc[4 * g + 1] += wv.y * fmaxf(acc[4 * g + 1], 0.f);
            sc[4 * g + 2] += wv.z * fmaxf(acc[4 * g + 2], 0.f);
            sc[4 * g + 3] += wv.w * fmaxf(acc[4 * g + 3], 0.f);
          }
        }
        const bool kvalid = key < L;
        if (pass == 0) {
#pragma unroll
          for (int i = 0; i < 16; ++i) {
            int q = crow(i, lh);
            if (kvalid) { int b = score_bin(sc[i]); atomicAdd(&hist[q * 256 + (b >> 1)], (b & 1) ? 65536u : 1u); }
          }
        } else {
#pragma unroll
          for (int i = 0; i < 16; ++i) {
            int q = crow(i, lh);
            int b = score_bin(sc[i]);
            int bs = bstar[q];
            bool sel = kvalid && (b > bs);
            bool cnd = kvalid && (b == bs);
            unsigned long long bal = __ballot(sel);
            if (lr == 0 && q < nq) BM[(size_t)(q_row0 + q) * 256 + (key0 >> 5)] = (unsigned)(bal >> (32 * lh));
            if (cnd) {
              int pos = atomicAdd(&ncand[q], 1);
              if (pos < CAP) { cand_s[q * CAP + pos] = sc[i]; cand_i[q * CAP + pos] = key; }
            }
          }
        }
      }
    }
    __syncthreads();
    if (pass == 0) {
      for (int qi = 0; qi < 8; ++qi) {
        const int q = w * 8 + qi;
        unsigned hw[4];
#pragma unroll
        for (int k = 0; k < 4; ++k) hw[k] = hist[q * 256 + 255 - 4 * lane - k];
        int cnt = 0;
#pragma unroll
        for (int k = 0; k < 4; ++k) cnt += (int)(hw[k] >> 16) + (int)(hw[k] & 0xffffu);
        int pre = cnt;
#pragma unroll
        for (int o = 1; o < 64; o <<= 1) { int t = __shfl_up(pre, o, 64); if (lane >= o) pre += t; }
        unsigned long long bal = __ballot(pre >= 256);
        if (bal != 0ull) {
          int fl = __ffsll((long long)bal) - 1;
          if (lane == fl) {
            int running = pre - cnt;
            int bsel = -1, above = 0;
#pragma unroll
            for (int k = 0; k < 4; ++k) {
              int chi = (int)(hw[k] >> 16), clo = (int)(hw[k] & 0xffffu);
              if (bsel < 0) { if (running + chi >= 256) { bsel = 511 - 8 * lane - 2 * k; above = running; } else running += chi; }
              if (bsel < 0) { if (running + clo >= 256) { bsel = 510 - 8 * lane - 2 * k; above = running; } else running += clo; }
            }
            bstar[q] = bsel; need[q] = 256 - above;
          }
        }
      }
      __syncthreads();
    }
  }
  __threadfence();
  __syncthreads();
  if (do_select) {
    for (int pi = tid; pi < 32 * CAP; pi += 256) {
      int q = pi / CAP, c = pi - q * CAP;
      int n = min(ncand[q], CAP);
      if (c < n && q < nq) {
        float sv = cand_s[q * CAP + c]; int iv = cand_i[q * CAP + c];
        int rank = 0;
        for (int j = 0; j < n; ++j) {
          float sj = cand_s[q * CAP + j]; int ij = cand_i[q * CAP + j];
          rank += (sj > sv || (sj == sv && ij < iv)) ? 1 : 0;
        }
        if (rank < need[q]) atomicOr(&BM[(size_t)(q_row0 + q) * 256 + (iv >> 5)], 1u << (iv & 31));
      }
    }
  }
  __syncthreads();
}

DI void idx_phase(const Params& p, unsigned char* smem, int bid, int nblk) {
  unsigned char* R = p.ws + OFF_R;
  const bf16_t* QI = (const bf16_t*)(R + D_QI); const float* WI = (const float*)(R + D_WI);
  const bf16_t* KI = (const bf16_t*)(R + D_KI); unsigned* BM = (unsigned*)(R + D_BM);
  const int total = 512 + 32;
  const int half = nblk >> 1;
  for (int i = 0; i * nblk < total; ++i) {
    int j = (i == 0) ? ((bid < half) ? bid : (nblk + half - 1 - bid)) : bid;
    int idx = i * nblk + j;
    if (idx >= total) continue;
    if (idx < 512) {
      int qt = 255 - (idx >> 1), b = idx & 1;
      int L = (((qt * 32) >> 6) + 1) * 64;
      idx_unit(QI, WI, b * 8192 + qt * 32, 32, KI + (size_t)(b * 8192) * 64, L, BM, smem);
    } else {
      int b = idx - 512;
      idx_unit(QI, WI, TP + b * 16, 16, KI + (size_t)(TP + b * SPAD) * 64, NKS, BM, smem);
    }
  }
}

DI void cvt8(const float* s, bf16_t* d) {
  float4 a = *(const float4*)s, b = *(const float4*)(s + 4);
  uint4 pk; pk.x = pack2(a.x, a.y); pk.y = pack2(a.z, a.w); pk.z = pack2(b.x, b.y); pk.w = pack2(b.z, b.w);
  *(uint4*)d = pk;
}
DI void cache_rows(const float* __restrict__ src, bf16_t* __restrict__ dst, int Wd, int bid, int nblk) {
  const int vpr = Wd >> 3;
  const size_t total = (size_t)32 * SPAD * vpr;
  for (size_t e = (size_t)bid * 256 + ltid(); e < total; e += (size_t)nblk * 256) {
    int c = (int)(e % vpr) * 8; size_t rw = e / vpr; int b = (int)(rw / SPAD), s = (int)(rw % SPAD);
    bf16_t* d = dst + ((size_t)TP + (size_t)b * SPAD + s) * Wd + c;
    if (s < 1024) cvt8(src + ((size_t)b * 1024 + s) * Wd + c, d);
    else if (s >= NKS) *(uint4*)d = make_uint4(0, 0, 0, 0);
  }
}

extern "C" __global__ void __launch_bounds__(256, 2) mega(Params p) {
  extern __shared__ __attribute__((aligned(16))) unsigned char smem[];
  cg::grid_group grid = cg::this_grid();
  const int bid = blockIdx.x, nblk = gridDim.x, tid = ltid();
  unsigned char* ws = p.ws;
  float* X = (float*)(ws + OFF_X);
  bf16_t* H = (bf16_t*)(ws + OFF_H);
  bf16_t* Wb = (bf16_t*)(ws + OFF_W);
  float* ROPE = (float*)(ws + OFF_ROPE);
  unsigned char* R = ws + OFF_R;
  int ph = 0;
#ifndef PMASK
#define PMASK 0xffffffffu
#endif
#define PHASE_BEGIN(k) if (ph >= p.ph_lo && ph < p.ph_hi) { if constexpr ((PMASK >> (k)) & 1u) {
#define PHASE_END   } if (ph + 1 < p.ph_hi) grid.sync(); } ++ph;

  PHASE_BEGIN(0)
    for (int t = bid; t < p.total_tiles; t += nblk) {
      int ji = 0;
#pragma unroll 1
      for (int q = 1; q < NJOBS; ++q) if (t >= p.jobs[q].tile0) ji = q;
      const Job& jb = p.jobs[ji];
      int lt = t - jb.tile0; int nkt = jb.k >> 6; int nt_ = lt / nkt, kt_ = lt - nt_ * nkt;
      transpose_tile(jb.src, jb.nsrc, jb.nsrc, jb.dst, jb.k, nt_ * 64, kt_ * 64, jb.mode, (float*)smem);
    }
    {
      const size_t n4p = (size_t)TP * 256, n4 = (size_t)T * 256;
      const float4* xp = (const float4*)p.in[0]; const float4* xs = (const float4*)p.in[1];
      for (size_t e = (size_t)bid * 256 + tid; e < n4; e += (size_t)nblk * 256) ((float4*)X)[e] = (e < n4p) ? xp[e] : xs[e - n4p];
      for (int e = bid * 256 + tid; e < 8192 * 16; e += nblk * 256) {
        int pos = e >> 4, i = e & 15;
        double rev = (double)pos * p.inv_freq[i] * 0.15915494309189535;
        rev -= floor(rev);
        float fr = (float)rev;
        ROPE[2 * e] = __builtin_amdgcn_cosf(fr); ROPE[2 * e + 1] = __builtin_amdgcn_sinf(fr);
      }
      const float* wsrc = p.in[20];
      for (int e = bid * 256 + tid; e < 8 * 128 * 128; e += nblk * 256) {
        int s = e & 127, t = (e >> 7) & 127;
        Wb[W_TRIL + e] = tobf(s <= t ? wsrc[e] : 0.f);
      }
    }
  PHASE_END

#pragma unroll 1
  for (int L = 0; L < 4; ++L) {
    const int kind = L % 3, j = L / 3;
    if (kind == 0) {
      bf16_t* Wm = Wb + W_MLA + (size_t)j * WM_SZ;
      PHASE_BEGIN(1)
        rmsnorm_rows(X, p.in[7] + L * 1024, H, nullptr, nullptr, bid, nblk);
        cache_rows(p.in[2] + (size_t)j * 32 * 1024 * 256, (bf16_t*)(R + R_CKV), 256, bid, nblk);
        cache_rows(p.in[3] + (size_t)j * 32 * 1024 * 32, (bf16_t*)(R + R_KR), 32, bid, nblk);
      PHASE_END
      PHASE_BEGIN(2)
        EArgs ea{}; ea.f0 = (float*)(R + R_RAW);
        gemm_phase<E_F32>(H, 1024, Wm + WM_D, 1024, T, 896, 1024, ea, smem, 0, bid, nblk);
      PHASE_END
      PHASE_BEGIN(3)
        mla_rowops(p, j, bid, nblk);
      PHASE_END
      PHASE_BEGIN(4)
        EArgs ea{}; ea.b0 = (bf16_t*)(R + R_Q); ea.rope = ROPE;
        gemm_phase<E_MLAQ>((const bf16_t*)(R + R_CQ), 512, Wm + WM_UQ, 512, T, 1536, 512, ea, smem, 0, bid, nblk);
        EArgs eb{}; eb.b0 = (bf16_t*)(R + R_KN); eb.b1 = (bf16_t*)(R + R_VT);
        gemm_phase<E_MLAKV>((const bf16_t*)(R + R_CKV), 256, Wm + WM_UKV, 256, KROWS, 2048, 256, eb, smem, (T / 128) * 12, bid, nblk);
      PHASE_END
      PHASE_BEGIN(5)
        attn_phase<true>(p, smem, bid, nblk);
      PHASE_END
      PHASE_BEGIN(6)
        EArgs ea{}; ea.f0 = X;
        gemm_phase<E_RESID>((const bf16_t*)(R + R_RAW), 1024, Wm + WM_O, 1024, T, 1024, 1024, ea, smem, 0, bid, nblk);
      PHASE_END
    } else if (kind == 1) {
      bf16_t* Wc = Wb + W_CM;
      PHASE_BEGIN(1)
        rmsnorm_rows(X, p.in[7] + L * 1024, H, nullptr, nullptr, bid, nblk);
      PHASE_END
      PHASE_BEGIN(7)
        EArgs ea{}; ea.b0 = (bf16_t*)(R + C_U); ea.b1 = (bf16_t*)(R + C_VR);
        gemm_phase<E_GELU>(H, 1024, Wc + WC_IN, 1024, T, 4096, 1024, ea, smem, 0, bid, nblk);
      PHASE_END
      PHASE_BEGIN(8)
        cmlp_ln_rows(p, bid, nblk);
      PHASE_END
      PHASE_BEGIN(9)
        cmlp_mix_phase(p, smem, bid, nblk);
      PHASE_END
      PHASE_BEGIN(6)
        EArgs ea{}; ea.f0 = X;
        gemm_phase<E_RESID>((const bf16_t*)(R + C_G), 2048, Wc + WC_OUT, 2048, T, 1024, 2048, ea, smem, 0, bid, nblk);
      PHASE_END
    } else {
      bf16_t* Wd = Wb + W_DS;
      PHASE_BEGIN(10)
        rmsnorm_rows(X, p.in[7] + L * 1024, H, nullptr, nullptr, bid, nblk);
        cache_rows(p.in[4], (bf16_t*)(R + D_K), 1024, bid, nblk);
        cache_rows(p.in[6], (bf16_t*)(R + D_KI), 64, bid, nblk);
        {
          bf16_t* VTs = (bf16_t*)(R + D_VT) + (size_t)TP * 1024;
          for (int u = bid; u < 512 * 16; u += nblk) {
            int st = u & 15, bh = u >> 4, b = bh >> 4, h = bh & 15;
            transpose_tile(p.in[5] + (size_t)b * 1024 * 1024 + h * 64, 1024, 64, VTs + (size_t)(bh * 64) * SPAD, SPAD, 0, st * 64, 0, (float*)smem);
          }
          for (int e = bid * 256 + tid; e < 512 * 64 * 12; e += nblk * 256) {
            int c = e % 12, rw = e / 12;
            *(uint2*)(VTs + (size_t)rw * SPAD + NKS + c * 4) = make_uint2(0, 0);
          }
        }
      PHASE_END
      PHASE_BEGIN(11)
        EArgs ea{};
        ea.f0 = p.out + O_DKP; ea.f1 = p.out + O_DKS; ea.f2 = p.out + O_DVP; ea.f3 = p.out + O_DVS;
        ea.f4 = (float*)(R + D_KIR); ea.f5 = (float*)(R + D_WI);
        ea.b0 = (bf16_t*)(R + D_Q); ea.b1 = (bf16_t*)(R + D_K); ea.b2 = (bf16_t*)(R + D_VT); ea.b3 = (bf16_t*)(R + D_QI);
        gemm_phase<E_DSA>(H, 1024, Wd + WD_P, 1024, T, 3712, 1024, ea, smem, 0, bid, nblk);
      PHASE_END
      PHASE_BEGIN(12)
        dsa_rowops(p, bid, nblk);
      PHASE_END
      PHASE_BEGIN(13)
        idx_phase(p, smem, bid, nblk);
      PHASE_END
      PHASE_BEGIN(14)
        attn_phase<false>(p, smem, bid, nblk);
      PHASE_END
      PHASE_BEGIN(6)
        EArgs ea{}; ea.f0 = X;
        gemm_phase<E_RESID>((const bf16_t*)(R + D_AO), 1024, Wd + WD_O, 1024, T, 1024, 1024, ea, smem, 0, bid, nblk);
      PHASE_END
    }
    bf16_t* Wf = Wb + W_FF + (size_t)L * WF_SZ;
    PHASE_BEGIN(1)
      rmsnorm_rows(X, p.in[8] + L * 1024, H, nullptr, nullptr, bid, nblk);
    PHASE_END
    PHASE_BEGIN(15)
      EArgs ea{}; ea.b0 = (bf16_t*)(R + 0);
      gemm_phase<E_SWIGLU>(H, 1024, Wf + WF_IN, 1024, T, 2 * DFF, 1024, ea, smem, 0, bid, nblk);
    PHASE_END
    PHASE_BEGIN(6)
      EArgs ea{}; ea.f0 = X;
      gemm_phase<E_RESID>((const bf16_t*)(R + 0), DFF, Wf + WF_OUT, DFF, T, 1024, DFF, ea, smem, 0, bid, nblk);
    PHASE_END
  }
  PHASE_BEGIN(1)
    rmsnorm_rows(X, p.in[9], nullptr, p.out + O_YP, p.out + O_YS, bid, nblk);
  PHASE_END
}

extern "C" void kernel_launch(void* const* d_in, const int* in_sizes, int n_in,
                              void* d_out, int out_size, void* d_ws, size_t ws_size,
                              hipStream_t stream) {
  constexpr int kLds = 80 * 1024;
  static int grid_blocks = 0;
  if (!grid_blocks) {
    int dev = 0, cus = 0, per_cu = 0;
    (void)hipGetDevice(&dev);
    (void)hipDeviceGetAttribute(&cus, hipDeviceAttributeMultiprocessorCount, dev);
    (void)hipFuncSetAttribute((const void*)mega, hipFuncAttributeMaxDynamicSharedMemorySize, kLds);
    (void)hipOccupancyMaxActiveBlocksPerMultiprocessor(&per_cu, (const void*)mega, 256, kLds);
    if (per_cu < 1) per_cu = 1;
    if (per_cu > 2) per_cu = 2;
    grid_blocks = cus * per_cu;
    fprintf(stderr, "grid %d (cus %d per_cu %d) ws %zu need %zu out %d need %zu\n", grid_blocks, cus, per_cu, ws_size, (size_t)WS_NEED, out_size, (size_t)O_END);
  }
  if (ws_size < WS_NEED || n_in != 31 || (size_t)out_size != O_END) { fprintf(stderr, "kernel_launch: bad sizes\n"); return; }
  Params p;
  memset(&p, 0, sizeof(p));
  for (int i = 0; i < 31; ++i) p.in[i] = (const float*)d_in[i];
  p.out = (float*)d_out; p.ws = (unsigned char*)d_ws;
  bf16_t* Wb = (bf16_t*)((unsigned char*)d_ws + OFF_W);
  int nj = 0, tiles = 0;
  auto add = [&](const float* src, int nsrc, int k, bf16_t* dst, int ndst, int mode) {
    Job& jb = p.jobs[nj++]; jb.src = src; jb.dst = dst; jb.nsrc = nsrc; jb.k = k; jb.ndst = ndst; jb.mode = mode; jb.tile0 = tiles; jb.pad = 0;
    tiles += (ndst / 64) * (k / 64);
  };
  for (int j = 0; j < 2; ++j) {
    bf16_t* Wm = Wb + W_MLA + (size_t)j * WM_SZ;
    add(p.in[10] + (size_t)j * 1024 * 512, 512, 1024, Wm + WM_D, 512, 0);
    add(p.in[13] + (size_t)j * 1024 * 288, 288, 1024, Wm + WM_D + (size_t)512 * 1024, 384, 0);
    add(p.in[12] + (size_t)j * 512 * 1536, 1536, 512, Wm + WM_UQ, 1536, 0);
    add(p.in[15] + (size_t)j * 256 * 2048, 2048, 256, Wm + WM_UKV, 2048, 0);
    add(p.in[16] + (size_t)j * 1024 * 1024, 1024, 1024, Wm + WM_O, 1024, 0);
  }
  add(p.in[17], 4096, 1024, Wb + W_CM + WC_IN, 4096, 0);
  add(p.in[22], 1024, 2048, Wb + W_CM + WC_OUT, 1024, 0);
  add(p.in[23], 3072, 1024, Wb + W_DS + WD_P, 3072, 0);
  add(p.in[25], 512, 1024, Wb + W_DS + WD_P + (size_t)3072 * 1024, 512, 0);
  add(p.in[26], 64, 1024, Wb + W_DS + WD_P + (size_t)3584 * 1024, 64, 0);
  add(p.in[28], 8, 1024, Wb + W_DS + WD_P + (size_t)3648 * 1024, 64, 0);
  add(p.in[24], 1024, 1024, Wb + W_DS + WD_O, 1024, 0);
  for (int i = 0; i < 4; ++i) {
    add(p.in[29] + (size_t)i * 1024 * 5632, 5632, 1024, Wb + W_FF + (size_t)i * WF_SZ + WF_IN, 5632, 1);
    add(p.in[30] + (size_t)i * 2816 * 1024, 1024, 2816, Wb + W_FF + (size_t)i * WF_SZ + WF_OUT, 1024, 0);
  }
  p.total_tiles = tiles;
  for (int i = 0; i < 16; ++i) p.inv_freq[i] = pow(10000.0, -(double)i / 16.0);
  p.ph_lo = 0; p.ph_hi = 1000;
  void* args[] = {&p};
  hipError_t e = hipLaunchCooperativeKernel((const void*)mega, dim3(grid_blocks), dim3(256), args, kLds, stream);
  if (e != hipSuccess) fprintf(stderr, "coop launch failed: %s\n", hipGetErrorString(e));
}
```

```cpp
#include <hip/hip_runtime.h>
#include <hip/hip_cooperative_groups.h>
#include <cstdio>
#include <cstring>
#include <cmath>
namespace cg = cooperative_groups;

typedef unsigned short bf16_t;
using bf16x8 = __attribute__((ext_vector_type(8))) short;
using f32x16 = __attribute__((ext_vector_type(16))) float;
using f32x2v = __attribute__((ext_vector_type(2))) float;
using bf2v = __attribute__((ext_vector_type(2))) __bf16;
#define DI __device__ __forceinline__
#define MFMA32(a, b, c) __builtin_amdgcn_mfma_f32_32x32x16_bf16((a), (b), (c), 0, 0, 0)

constexpr int TP = 16384, TS = 512, T = TP + TS;
constexpr int NT = 512;
constexpr int SPAD = 1088, NKS = 1040;
constexpr int KROWS = TP + 32 * SPAD;
constexpr int DFF = 2816;
constexpr float LOG2E = 1.4426950408889634f;
constexpr float EPS = 1e-6f;

constexpr size_t OFF_X = 0;
constexpr size_t OFF_H = OFF_X + (size_t)T * 1024 * 4;
constexpr size_t OFF_W = OFF_H + (size_t)T * 1024 * 2;
constexpr size_t W_ELEMS = 52822016;
constexpr size_t OFF_ROPE = OFF_W + W_ELEMS * 2;
constexpr size_t OFF_R = OFF_ROPE + (size_t)8192 * 16 * 2 * 4;
constexpr size_t R_RAW = 0;
constexpr size_t R_CQ = R_RAW + (size_t)T * 1024 * 4;
constexpr size_t R_CKV = R_CQ + (size_t)T * 512 * 2;
constexpr size_t R_KR = R_CKV + (size_t)KROWS * 256 * 2;
constexpr size_t R_Q = R_KR + (size_t)KROWS * 32 * 2;
constexpr size_t R_KN = R_Q + (size_t)T * 1536 * 2;
constexpr size_t R_VT = R_KN + (size_t)KROWS * 1024 * 2;
constexpr size_t R_END = R_VT + (size_t)KROWS * 1024 * 2;
constexpr size_t D_Q = 0;
constexpr size_t D_K = D_Q + (size_t)T * 1024 * 2;
constexpr size_t D_VT = D_K + (size_t)KROWS * 1024 * 2;
constexpr size_t D_QI = D_VT + (size_t)KROWS * 1024 * 2;
constexpr size_t D_KIR = D_QI + (size_t)T * 512 * 2;
constexpr size_t D_KI = D_KIR + (size_t)T * 64 * 4;
constexpr size_t D_WI = D_KI + (size_t)KROWS * 64 * 2;
constexpr size_t D_BM = D_WI + (size_t)T * 8 * 4;
constexpr size_t D_AO = D_BM + (size_t)T * 256 * 4;
constexpr size_t D_END = D_AO + (size_t)T * 1024 * 2;
constexpr size_t C_U = 0;
constexpr size_t C_VR = C_U + (size_t)T * 2048 * 2;
constexpr size_t C_VLN = C_VR + (size_t)T * 2048 * 2;
constexpr size_t C_G = C_VLN + (size_t)T * 2048 * 2;
constexpr size_t C_END = C_G + (size_t)T * 2048 * 2;
constexpr size_t WS_NEED = OFF_R + R_END;
static_assert(D_END <= R_END && C_END <= R_END && (size_t)T * DFF * 2 <= R_END, "region");

constexpr size_t W_MLA = 0;
constexpr size_t WM_D = 0, WM_UQ = 1048576, WM_UKV = WM_UQ + 786432, WM_O = WM_UKV + 524288, WM_SZ = 3407872;
constexpr size_t W_CM = 2 * WM_SZ;
constexpr size_t WC_IN = 0, WC_OUT = 4194304, WC_SZ = 6291456;
constexpr size_t W_DS = W_CM + WC_SZ;
constexpr size_t WD_P = 0, WD_O = 3932160, WD_SZ = 4980736;
constexpr size_t W_FF = W_DS + WD_SZ;
constexpr size_t WF_IN = 0, WF_OUT = 5767168, WF_SZ = 8650752;
constexpr size_t W_TRIL = W_FF + 4 * WF_SZ;
static_assert(W_TRIL + 131072 == W_ELEMS, "w");

constexpr size_t O_YP = 0;
constexpr size_t O_YS = O_YP + (size_t)TP * 1024;
constexpr size_t O_CKVP = O_YS + (size_t)TS * 1024;
constexpr size_t O_KRP = O_CKVP + (size_t)2 * TP * 256;
constexpr size_t O_CKVS = O_KRP + (size_t)2 * TP * 32;
constexpr size_t O_KRS = O_CKVS + (size_t)2 * TS * 256;
constexpr size_t O_CVS = O_KRS + (size_t)2 * TS * 32;
constexpr size_t O_DKP = O_CVS + (size_t)TS * 2048;
constexpr size_t O_DVP = O_DKP + (size_t)TP * 1024;
constexpr size_t O_DIP = O_DVP + (size_t)TP * 1024;
constexpr size_t O_DKS = O_DIP + (size_t)TP * 64;
constexpr size_t O_DVS = O_DKS + (size_t)TS * 1024;
constexpr size_t O_DIS = O_DVS + (size_t)TS * 1024;
constexpr size_t O_END = O_DIS + (size_t)TS * 64;

constexpr int NJOBS = 25;
struct Job { const float* src; bf16_t* dst; int nsrc, k, ndst, mode, tile0, pad; };
struct Params {
  const float* in[31];
  float* out;
  unsigned char* ws;
  Job jobs[NJOBS];
  int total_tiles, ph_lo, ph_hi, pad;
  double inv_freq[16];
};

#define CAS __attribute__((address_space(4)))
typedef const CAS Params CParams;
#define PREF const CAS Params&
DI unsigned pack2(float a, float b) { f32x2v v = {a, b}; bf2v r = __builtin_convertvector(v, bf2v); return __builtin_bit_cast(unsigned, r); }
DI bf16_t tobf(float a) { return (bf16_t)(pack2(a, 0.f) & 0xffffu); }
DI float frombf(bf16_t v) { return __uint_as_float(((unsigned)v) << 16); }
DI float bflo(unsigned u) { return __uint_as_float(u << 16); }
DI float bfhi(unsigned u) { return __uint_as_float(u & 0xffff0000u); }
DI float shflx(float v, int m, int lane) { return __int_as_float(__builtin_amdgcn_ds_bpermute((lane ^ m) << 2, __float_as_int(v))); }
DI float wave_sum(float v, int lane) {
#pragma unroll
  for (int o = 32; o >= 1; o >>= 1) v += shflx(v, o, lane);
  return v;
}
DI int ltid(int wv) { unsigned m1 = ~0u; asm volatile("" : "+s"(m1)); int t = (wv << 6) | (int)__builtin_amdgcn_mbcnt_hi(m1, __builtin_amdgcn_mbcnt_lo(m1, 0u)); asm volatile("" : "+v"(t)); return t; }
DI int crow(int i, int h) { return (i & 3) + 8 * (i >> 2) + 4 * h; }
DI int rowmap(int t) { if (t < TP) return t; int u = t - TP; return TP + (u >> 4) * SPAD + 1024 + (u & 15); }
DI int tokpos(int t) { return t < TP ? (t & 8191) : 1024 + ((t - TP) & 15); }

DI void transpose_tile(const float* __restrict__ src, int src_ld, int ncols, bf16_t* __restrict__ dst, int dst_ld,
                       int n0, int k0, int mode, float* sm, int tid, bool active) {
  const int nl = tid & 63, kq = tid >> 6;
  const int n = n0 + nl;
  int c;
  if (mode == 0) c = n < ncols ? n : -1;
  else { int tt = n >> 5, r = n & 31; int f = tt * 16 + (r & 15); c = (r < 16) ? f : DFF + f; }
  if (active) {
#pragma unroll 4
    for (int i = 0; i < 16; ++i) {
      int kk = kq + 4 * i;
      float v = (c >= 0) ? src[(size_t)(k0 + kk) * src_ld + c] : 0.f;
      sm[kk * 65 + nl] = v;
    }
  }
  __syncthreads();
  if (active) {
    const int kp = (tid & 31) * 2, nr = tid >> 5;
#pragma unroll 4
    for (int i = 0; i < 8; ++i) {
      int nn = nr + 8 * i;
      float a = sm[kp * 65 + nn], b = sm[(kp + 1) * 65 + nn];
      *(unsigned*)(dst + (size_t)(n0 + nn) * dst_ld + k0 + kp) = pack2(a, b);
    }
  }
  __syncthreads();
}

enum { E_F32 = 0, E_RESID, E_SWIGLU, E_GELU, E_MLAQ, E_MLAKV, E_DSA };
struct EArgs {
  float* f0; float* f1; float* f2; float* f3; float* f4; float* f5; float* f6;
  bf16_t* b0; bf16_t* b1; bf16_t* b2; bf16_t* b3;
  const float* rope;
};
using f32x4v = __attribute__((ext_vector_type(4))) float;
#define LAS __attribute__((address_space(3)))
constexpr int G_HT = 128 * 64;
DI int lds_byte(int r, int c) {
  int st = (r >> 4) * 2 + (c >> 5), rr = r & 15, cc = c & 31, ob = rr * 64 + cc * 2;
  return st * 1024 + (ob ^ (((ob >> 9) & 1) << 5));
}
DI void stage_rc(int b, int& R, int& C) {
  int st = b >> 10, sb = b & 1023, swz = sb ^ (((sb >> 9) & 1) << 5);
  R = (st >> 1) * 16 + (swz >> 6); C = (st & 1) * 32 + ((swz & 63) >> 1);
}

template <int EPI>
DI void epi16(const EArgs& ea, int row0, int gb, int fr, const f32x4v& v0, const f32x4v& v1) {
  if constexpr (EPI == E_F32) {
#pragma unroll
    for (int j = 0; j < 4; ++j) { float* o = ea.f0 + (size_t)(row0 + j) * 1024 + gb + fr; o[0] = v0[j]; o[16] = v1[j]; }
  } else if constexpr (EPI == E_RESID) {
#pragma unroll
    for (int j = 0; j < 4; ++j) { float* o = ea.f0 + (size_t)(row0 + j) * 1024 + gb + fr; o[0] += v0[j]; o[16] += v1[j]; }
  } else if constexpr (EPI == E_SWIGLU) {
    const int f = (gb >> 1) + fr;
#pragma unroll
    for (int j = 0; j < 4; ++j) { float g = v0[j], u = v1[j]; ea.b0[(size_t)(row0 + j) * DFF + f] = tobf(g / (1.f + __expf(-g)) * u); }
  } else if constexpr (EPI == E_GELU) {
    bf16_t* dstp = (gb < 2048) ? (ea.b0 + gb + fr) : (ea.b1 + (gb - 2048) + fr);
#pragma unroll
    for (int j = 0; j < 4; ++j) {
      float x = v0[j], y = v1[j];
      dstp[(size_t)(row0 + j) * 2048] = tobf(0.5f * x * (1.f + erff(x * 0.70710678118654752f)));
      dstp[(size_t)(row0 + j) * 2048 + 16] = tobf(0.5f * y * (1.f + erff(y * 0.70710678118654752f)));
    }
  } else if constexpr (EPI == E_MLAQ) {
    const float qs = 0.10206207261596577f * LOG2E;
    const bool is_rope = (gb % 96) == 64;
#pragma unroll
    for (int j = 0; j < 4; ++j) {
      const int row = row0 + j;
      float o0 = v0[j], o1 = v1[j];
      if (is_rope) {
        float2 cs = *(const float2*)(ea.rope + ((size_t)tokpos(row) * 16 + fr) * 2);
        o0 = v0[j] * cs.x - v1[j] * cs.y; o1 = v0[j] * cs.y + v1[j] * cs.x;
      }
      bf16_t* o = ea.b0 + (size_t)row * 1536 + gb + fr;
      o[0] = tobf(o0 * qs); o[16] = tobf(o1 * qs);
    }
  } else if constexpr (EPI == E_MLAKV) {
    const int head = gb >> 7, c0 = gb & 127;
    if (c0 < 64) {
#pragma unroll
      for (int j = 0; j < 4; ++j) { bf16_t* o = ea.b0 + (size_t)(row0 + j) * 1024 + head * 64 + c0 + fr; o[0] = tobf(v0[j]); o[16] = tobf(v1[j]); }
    } else {
      const int d = c0 - 64 + fr;
      size_t off;
      if (row0 < TP) { int b = row0 >> 13, s = row0 & 8191; off = ((size_t)((b * 16 + head) * 64 + d)) * 8192 + s;
        uint2 pk; pk.x = pack2(v0[0], v0[1]); pk.y = pack2(v0[2], v0[3]); *(uint2*)(ea.b1 + off) = pk;
        pk.x = pack2(v1[0], v1[1]); pk.y = pack2(v1[2], v1[3]); *(uint2*)(ea.b1 + off + (size_t)16 * 8192) = pk;
      } else { int u = row0 - TP; int b = u / SPAD, s = u - b * SPAD; off = (size_t)TP * 1024 + ((size_t)((b * 16 + head) * 64 + d)) * SPAD + s;
        uint2 pk; pk.x = pack2(v0[0], v0[1]); pk.y = pack2(v0[2], v0[3]); *(uint2*)(ea.b1 + off) = pk;
        pk.x = pack2(v1[0], v1[1]); pk.y = pack2(v1[2], v1[3]); *(uint2*)(ea.b1 + off + (size_t)16 * SPAD) = pk;
      }
    }
  } else if constexpr (EPI == E_DSA) {
    if (gb < 1024) {
      const float qs = 0.125f * LOG2E;
#pragma unroll
      for (int j = 0; j < 4; ++j) { bf16_t* o = ea.b0 + (size_t)(row0 + j) * 1024 + gb + fr; o[0] = tobf(v0[j] * qs); o[16] = tobf(v1[j] * qs); }
    } else if (gb < 2048) {
      const int c = gb - 1024 + fr;
#pragma unroll
      for (int j = 0; j < 4; ++j) {
        const int row = row0 + j;
        float* o = (row < TP) ? ea.f0 + (size_t)row * 1024 + c : ea.f1 + (size_t)(row - TP) * 1024 + c;
        o[0] = v0[j]; o[16] = v1[j];
        bf16_t* ob = ea.b1 + (size_t)rowmap(row) * 1024 + c;
        ob[0] = tobf(v0[j]); ob[16] = tobf(v1[j]);
      }
    } else if (gb < 3072) {
      const int c = gb - 2048 + fr, head = c >> 6, d = c & 63;
#pragma unroll
      for (int j = 0; j < 4; ++j) {
        const int row = row0 + j;
        float* o = (row < TP) ? ea.f2 + (size_t)row * 1024 + c : ea.f3 + (size_t)(row - TP) * 1024 + c;
        o[0] = v0[j]; o[16] = v1[j];
      }
      size_t off, dstr;
      if (row0 < TP) { int b = row0 >> 13, s = row0 & 8191; off = ((size_t)((b * 16 + head) * 64 + d)) * 8192 + s; dstr = 8192; }
      else { int u = row0 - TP; int b = u >> 4, s = 1024 + (u & 15); off = (size_t)TP * 1024 + ((size_t)((b * 16 + head) * 64 + d)) * SPAD + s; dstr = SPAD; }
      uint2 pk; pk.x = pack2(v0[0], v0[1]); pk.y = pack2(v0[2], v0[3]); *(uint2*)(ea.b2 + off) = pk;
      pk.x = pack2(v1[0], v1[1]); pk.y = pack2(v1[2], v1[3]); *(uint2*)(ea.b2 + off + 16 * dstr) = pk;
    } else if (gb < 3584) {
      const int c = gb - 3072 + fr;
#pragma unroll
      for (int j = 0; j < 4; ++j) { bf16_t* o = ea.b3 + (size_t)(row0 + j) * 512 + c; o[0] = tobf(v0[j] * 0.125f); o[16] = tobf(v1[j] * 0.125f); }
    } else if (gb < 3648) {
      const int c = gb - 3584 + fr;
#pragma unroll
      for (int j = 0; j < 4; ++j) { float* o = ea.f4 + (size_t)(row0 + j) * 64 + c; o[0] = v0[j]; o[16] = v1[j]; }
    } else if (gb == 3648) {
      if (fr < 8) {
#pragma unroll
        for (int j = 0; j < 4; ++j) ea.f5[(size_t)(row0 + j) * 8 + fr] = v0[j] * 0.35355339059327379f;
      }
    }
  }
}

template <int EPI>
DI void gemm256_tile(const bf16_t* __restrict__ A, const bf16_t* __restrict__ Bt, const int K, const int brow, const int bcol,
                     const EArgs& ea, unsigned char* smem, int wv) {
  bf16_t* shm = (bf16_t*)smem;
  const int tid = ltid(wv);
#define SA(b, h) (shm + ((b) * 2 + (h)) * G_HT)
#define SB(b, h) (shm + (4 + (b) * 2 + (h)) * G_HT)
#define STAGE(P, BASE, br, kt) do { const char* _gb = (const char*)((BASE) + (long)(br) * K + (long)(kt) * 64); \
    __builtin_amdgcn_global_load_lds((const unsigned*)(_gb + voff0), (LAS unsigned*)((char*)(P) + tid * 16), 16, 0, 0); \
    __builtin_amdgcn_global_load_lds((const unsigned*)(_gb + voff1), (LAS unsigned*)((char*)(P) + tid * 16 + 8192), 16, 0, 0); } while (0)
#define LDA(dst, b, h) _Pragma("unroll") for (int m = 0; m < 4; ++m) _Pragma("unroll") for (int k = 0; k < 2; ++k) \
    dst[m][k] = *reinterpret_cast<const bf16x8*>((char*)SA(b, h) + lds_byte(wr * 64 + m * 16 + fr, k * 32 + fq * 8))
#define LDB(dst, b, h) _Pragma("unroll") for (int n = 0; n < 2; ++n) _Pragma("unroll") for (int k = 0; k < 2; ++k) \
    dst[n][k] = *reinterpret_cast<const bf16x8*>((char*)SB(b, h) + lds_byte(wc * 32 + n * 16 + fr, k * 32 + fq * 8))
#define MMA(ai, bj, At_, Bt_) do { __builtin_amdgcn_s_setprio(1); \
    _Pragma("unroll") for (int m = 0; m < 4; ++m) _Pragma("unroll") for (int n = 0; n < 2; ++n) _Pragma("unroll") for (int k = 0; k < 2; ++k) \
      acc[ai][bj][m][n] = __builtin_amdgcn_mfma_f32_16x16x32_bf16(At_[m][k], Bt_[n][k], acc[ai][bj][m][n], 0, 0, 0); \
    __builtin_amdgcn_s_setprio(0); } while (0)
#define WAIT_V(n) asm volatile("s_waitcnt vmcnt(" #n ")" ::: "memory")
#define WAIT_L(n) asm volatile("s_waitcnt lgkmcnt(" #n ")" ::: "memory")
#define BAR __builtin_amdgcn_s_barrier()
#define SCHED __builtin_amdgcn_sched_barrier(0)
  const int wid = tid >> 6, lane = tid & 63, wr = wid >> 2, wc = wid & 3, fr = lane & 15, fq = lane >> 4;
  unsigned voff0, voff1;
  { int r_, c_; stage_rc(tid * 16, r_, c_); voff0 = (unsigned)(r_ * K + c_) * 2u; stage_rc(tid * 16 + 8192, r_, c_); voff1 = (unsigned)(r_ * K + c_) * 2u; }
  f32x4v acc[2][2][4][2];
#pragma unroll
  for (int a = 0; a < 2; ++a)
#pragma unroll
    for (int b = 0; b < 2; ++b)
#pragma unroll
      for (int m = 0; m < 4; ++m)
#pragma unroll
        for (int n = 0; n < 2; ++n) acc[a][b][m][n] = (f32x4v){0.f, 0.f, 0.f, 0.f};
  bf16x8 At[4][2], B0[2][2], B1[2][2];
  const int nt = K >> 6;
  const int HALF = 128;
  WAIT_V(0); WAIT_L(0); BAR;
  STAGE(SB(0, 0), Bt, bcol, 0); STAGE(SA(0, 0), A, brow, 0);
  STAGE(SB(0, 1), Bt, bcol + HALF, 0); STAGE(SA(0, 1), A, brow + HALF, 0);
  if (wr == 1) BAR;
  WAIT_V(4); BAR;
  STAGE(SB(1, 0), Bt, bcol, 1); STAGE(SA(1, 0), A, brow, 1); STAGE(SB(1, 1), Bt, bcol + HALF, 1);
  WAIT_V(6); BAR;
  for (int t = 0; t < nt - 2; t += 2) {
    LDB(B0, 0, 0); SCHED; LDA(At, 0, 0); STAGE(SA(1, 1), A, brow + HALF, t + 1);
    WAIT_L(8); BAR; WAIT_L(0); MMA(0, 0, At, B0); BAR; SCHED;
    LDB(B1, 0, 1); STAGE(SB(0, 0), Bt, bcol, t + 2);
    BAR; WAIT_L(0); MMA(0, 1, At, B1); BAR;
    LDA(At, 0, 1); STAGE(SA(0, 0), A, brow, t + 2);
    BAR; WAIT_L(0); MMA(1, 0, At, B0); BAR; SCHED;
    STAGE(SB(0, 1), Bt, bcol + HALF, t + 2);
    WAIT_V(6); BAR; MMA(1, 1, At, B1); BAR;
    LDB(B0, 1, 0); SCHED; LDA(At, 1, 0); STAGE(SA(0, 1), A, brow + HALF, t + 2);
    WAIT_L(8); BAR; WAIT_L(0); MMA(0, 0, At, B0); BAR; SCHED;
    LDB(B1, 1, 1); STAGE(SB(1, 0), Bt, bcol, t + 3);
    BAR; WAIT_L(0); MMA(0, 1, At, B1); BAR;
    LDA(At, 1, 1); STAGE(SA(1, 0), A, brow, t + 3);
    BAR; WAIT_L(0); MMA(1, 0, At, B0); BAR; SCHED;
    STAGE(SB(1, 1), Bt, bcol + HALF, t + 3);
    WAIT_V(6); BAR; MMA(1, 1, At, B1); BAR;
  }
  { LDB(B0, 0, 0); LDA(At, 0, 0); STAGE(SA(1, 1), A, brow + HALF, nt - 1);
    BAR; WAIT_L(0); MMA(0, 0, At, B0); BAR;
    LDB(B1, 0, 1); BAR; WAIT_L(0); MMA(0, 1, At, B1); BAR;
    LDA(At, 0, 1); WAIT_V(4); BAR; WAIT_L(0); MMA(1, 0, At, B0); MMA(1, 1, At, B1); BAR; }
  { LDB(B0, 1, 0); LDA(At, 1, 0); WAIT_V(2); BAR; WAIT_L(0); MMA(0, 0, At, B0); BAR;
    LDB(B1, 1, 1); WAIT_V(0); BAR; WAIT_L(0); MMA(0, 1, At, B1); BAR;
    LDA(At, 1, 1); BAR; WAIT_L(0); MMA(1, 0, At, B0); MMA(1, 1, At, B1); BAR; }
  if (wr == 0) BAR;
#pragma unroll
  for (int ai = 0; ai < 2; ++ai)
#pragma unroll
    for (int bj = 0; bj < 2; ++bj)
#pragma unroll
      for (int m = 0; m < 4; ++m)
      { epi16<EPI>(ea, brow + ai * 128 + wr * 64 + m * 16 + fq * 4, bcol + bj * 128 + wc * 32, fr, acc[ai][bj][m][0], acc[ai][bj][m][1]); __builtin_amdgcn_sched_barrier(0); }
#undef SA
#undef SB
#undef STAGE
#undef LDA
#undef LDB
#undef MMA
#undef WAIT_V
#undef WAIT_L
#undef BAR
#undef SCHED
}

template <int EPI>
DI void gemm_phase(const bf16_t* A, const bf16_t* Bt, int M, int N, int K, const EArgs& ea,
                   unsigned char* smem, int tstart, int bid, int nblk, int wv) {
  const int nM = M >> 8, nN = N >> 8, nwg = nM * nN;
  int t0 = bid - (tstart % nblk); if (t0 < 0) t0 += nblk;
  for (int t = t0; t < nwg; t += nblk) {
    int wgid = t;
    { int q = nwg >> 3, r = nwg & 7, xcd = wgid & 7, off = wgid >> 3; wgid = (xcd < r ? xcd * (q + 1) : r * (q + 1) + (xcd - r) * q) + off; }
    const int nig = 8 * nN, gid = wgid / nig, fm = gid * 8, gsz = min(nM - fm, 8);
    const int pm = fm + ((wgid % nig) % gsz), pn = (wgid % nig) / gsz;
    gemm256_tile<EPI>(A, Bt, K, pm * 256, pn * 256, ea, smem, wv);
  }
}

DI void rmsnorm_rows(const float* __restrict__ X, const float* __restrict__ g, bf16_t* __restrict__ H, float* outp, float* outs,
                     int bid, int nblk, int wv) {
  const int lane = ltid(wv) & 63, w = ltid(wv) >> 6;
  for (int row = bid * 8 + w; row < T; row += nblk * 8) {
    const float* xr = X + (size_t)row * 1024;
    float4 v[4];
    float ss = 0.f;
#pragma unroll
    for (int c = 0; c < 4; ++c) { v[c] = *(const float4*)(xr + c * 256 + lane * 4); ss += v[c].x * v[c].x + v[c].y * v[c].y + v[c].z * v[c].z + v[c].w * v[c].w; }
    ss = wave_sum(ss, lane);
    float r = rsqrtf(ss * (1.f / 1024.f) + EPS);
#pragma unroll
    for (int c = 0; c < 4; ++c) {
      int col = c * 256 + lane * 4;
      float4 gg = *(const float4*)(g + col);
      float a = v[c].x * r * gg.x, b = v[c].y * r * gg.y, cc = v[c].z * r * gg.z, d = v[c].w * r * gg.w;
      if (H) { uint2 pk; pk.x = pack2(a, b); pk.y = pack2(cc, d); *(uint2*)(H + (size_t)row * 1024 + col) = pk; }
      else {
        float* o = (row < TP) ? outp + (size_t)row * 1024 + col : outs + (size_t)(row - TP) * 1024 + col;
        *(float4*)o = make_float4(a, b, cc, d);
      }
    }
  }
}

DI void mla_rowops(PREF p, int j, int bid, int nblk, int wv) {
  const int lane = ltid(wv) & 63, w = ltid(wv) >> 6;
  unsigned char* R = p.ws + OFF_R;
  const float* RAW = (const float*)(R + R_RAW);
  bf16_t* CQ = (bf16_t*)(R + R_CQ); bf16_t* CKV = (bf16_t*)(R + R_CKV); bf16_t* KR = (bf16_t*)(R + R_KR);
  const float* gq = p.in[11] + j * 512; const float* gkv = p.in[14] + j * 256;
  const float* rope = (const float*)(p.ws + OFF_ROPE);
  for (int row = bid * 8 + w; row < T; row += nblk * 8) {
    const float* rr = RAW + (size_t)row * 1024;
    float4 a0 = *(const float4*)(rr + lane * 4), a1 = *(const float4*)(rr + 256 + lane * 4);
    float4 c0 = *(const float4*)(rr + 512 + lane * 4);
    float ss = a0.x * a0.x + a0.y * a0.y + a0.z * a0.z + a0.w * a0.w + a1.x * a1.x + a1.y * a1.y + a1.z * a1.z + a1.w * a1.w;
    float s2 = c0.x * c0.x + c0.y * c0.y + c0.z * c0.z + c0.w * c0.w;
    ss = wave_sum(ss, lane); s2 = wave_sum(s2, lane);
    float r1 = rsqrtf(ss * (1.f / 512.f) + EPS), r2 = rsqrtf(s2 * (1.f / 256.f) + EPS);
    {
      float4 g0 = *(const float4*)(gq + lane * 4), g1 = *(const float4*)(gq + 256 + lane * 4);
      uint2 pk; pk.x = pack2(a0.x * r1 * g0.x, a0.y * r1 * g0.y); pk.y = pack2(a0.z * r1 * g0.z, a0.w * r1 * g0.w);
      *(uint2*)(CQ + (size_t)row * 512 + lane * 4) = pk;
      pk.x = pack2(a1.x * r1 * g1.x, a1.y * r1 * g1.y); pk.y = pack2(a1.z * r1 * g1.z, a1.w * r1 * g1.w);
      *(uint2*)(CQ + (size_t)row * 512 + 256 + lane * 4) = pk;
    }
    const int rm = rowmap(row);
    {
      float4 g = *(const float4*)(gkv + lane * 4);
      float4 o = make_float4(c0.x * r2 * g.x, c0.y * r2 * g.y, c0.z * r2 * g.z, c0.w * r2 * g.w);
      float* op = (row < TP) ? p.out + O_CKVP + ((size_t)j * TP + row) * 256 : p.out + O_CKVS + ((size_t)j * TS + (row - TP)) * 256;
      *(float4*)(op + lane * 4) = o;
      uint2 pk; pk.x = pack2(o.x, o.y); pk.y = pack2(o.z, o.w);
      *(uint2*)(CKV + (size_t)rm * 256 + lane * 4) = pk;
    }
    if (lane < 16) {
      float x1 = rr[768 + lane], x2 = rr[784 + lane];
      int pos = tokpos(row);
      float2 cs = *(const float2*)(rope + ((size_t)pos * 16 + lane) * 2);
      float o1 = x1 * cs.x - x2 * cs.y, o2 = x1 * cs.y + x2 * cs.x;
      float* op = (row < TP) ? p.out + O_KRP + ((size_t)j * TP + row) * 32 : p.out + O_KRS + ((size_t)j * TS + (row - TP)) * 32;
      op[lane] = o1; op[16 + lane] = o2;
      KR[(size_t)rm * 32 + lane] = tobf(o1); KR[(size_t)rm * 32 + 16 + lane] = tobf(o2);
    }
  }
}

DI void dsa_rowops(PREF p, int bid, int nblk, int wv) {
  const int lane = ltid(wv) & 63, w = ltid(wv) >> 6;
  unsigned char* R = p.ws + OFF_R;
  const float* KIR = (const float*)(R + D_KIR);
  bf16_t* KI = (bf16_t*)(R + D_KI);
  const float* g = p.in[27];
  for (int row = bid * 8 + w; row < T; row += nblk * 8) {
    float v = KIR[(size_t)row * 64 + lane];
    float ss = wave_sum(v * v, lane);
    float r = rsqrtf(ss * (1.f / 64.f) + EPS);
    float o = v * r * g[lane];
    if (row < TP) p.out[O_DIP + (size_t)row * 64 + lane] = o; else p.out[O_DIS + (size_t)(row - TP) * 64 + lane] = o;
    KI[(size_t)rowmap(row) * 64 + lane] = tobf(o);
  }
}

DI void cmlp_ln_rows(PREF p, int bid, int nblk, int wv) {
  const int lane = ltid(wv) & 63, w = ltid(wv) >> 6;
  unsigned char* R = p.ws + OFF_R;
  const bf16_t* VR = (const bf16_t*)(R + C_VR);
  bf16_t* VLN = (bf16_t*)(R + C_VLN);
  const float* g = p.in[18]; const float* bb = p.in[19];
  for (int row = bid * 8 + w; row < T; row += nblk * 8) {
    float x[32];
    float sum = 0.f;
#pragma unroll
    for (int c = 0; c < 4; ++c) {
      uint4 u = *(const uint4*)(VR + (size_t)row * 2048 + c * 512 + lane * 8);
      x[c * 8 + 0] = bflo(u.x); x[c * 8 + 1] = bfhi(u.x); x[c * 8 + 2] = bflo(u.y); x[c * 8 + 3] = bfhi(u.y);
      x[c * 8 + 4] = bflo(u.z); x[c * 8 + 5] = bfhi(u.z); x[c * 8 + 6] = bflo(u.w); x[c * 8 + 7] = bfhi(u.w);
    }
#pragma unroll
    for (int i = 0; i < 32; ++i) sum += x[i];
    sum = wave_sum(sum, lane);
    float mu = sum * (1.f / 2048.f);
    float vs = 0.f;
#pragma unroll
    for (int i = 0; i < 32; ++i) { x[i] -= mu; vs += x[i] * x[i]; }
    vs = wave_sum(vs, lane);
    float r = rsqrtf(vs * (1.f / 2048.f) + EPS);
#pragma unroll
    for (int c = 0; c < 4; ++c) {
      int col = c * 512 + lane * 8;
      float y[8];
#pragma unroll
      for (int q = 0; q < 2; ++q) {
        float4 gg = *(const float4*)(g + col + q * 4), b4 = *(const float4*)(bb + col + q * 4);
        y[q * 4 + 0] = x[c * 8 + q * 4 + 0] * r * gg.x + b4.x; y[q * 4 + 1] = x[c * 8 + q * 4 + 1] * r * gg.y + b4.y;
        y[q * 4 + 2] = x[c * 8 + q * 4 + 2] * r * gg.z + b4.z; y[q * 4 + 3] = x[c * 8 + q * 4 + 3] * r * gg.w + b4.w;
      }
      uint4 pk; pk.x = pack2(y[0], y[1]); pk.y = pack2(y[2], y[3]); pk.z = pack2(y[4], y[5]); pk.w = pack2(y[6], y[7]);
      *(uint4*)(VLN + (size_t)row * 2048 + col) = pk;
      if (row >= TP) {
        float* o = p.out + O_CVS + (size_t)(row - TP) * 2048 + col;
        *(float4*)o = make_float4(y[0], y[1], y[2], y[3]); *(float4*)(o + 4) = make_float4(y[4], y[5], y[6], y[7]);
      }
    }
  }
}

DI void cmlp_mix_phase(PREF p, unsigned char* smem, int bid, int nblk, int wv) {
  const int tid = ltid(wv), lane = tid & 63, w = tid >> 6, wm = w >> 2, wn = w & 3, lr = lane & 31, lh = lane >> 5;
  unsigned char* R = p.ws + OFF_R;
  const bf16_t* U = (const bf16_t*)(R + C_U);
  const bf16_t* VLN = (const bf16_t*)(R + C_VLN);
  bf16_t* G = (bf16_t*)(R + C_G);
  const bf16_t* WT = (const bf16_t*)(p.ws + OFF_W) + W_TRIL;
  const float* bs = p.in[21];
  bf16_t* As = (bf16_t*)smem;
  bf16_t* Bs = As + 128 * 136;
  for (int u = bid; u < 1024; u += nblk) {
    const int g = u & 7, ch = u >> 3;
    const int col0 = g * 256;
#pragma unroll 2
    for (int i = 0; i < 4; ++i) {
      int v = tid + i * NT; int r = v >> 4, c = (v & 15) * 8;
      *(uint4*)(As + r * 136 + c) = *(const uint4*)(WT + ((size_t)g * 128 + r) * 128 + c);
    }
#pragma unroll 2
    for (int i = 0; i < 8; ++i) {
      int v = tid + i * NT; int s = v >> 5, c = (v & 31) * 8;
      uint4 x = *(const uint4*)(VLN + ((size_t)ch * 128 + s) * 2048 + col0 + c);
      Bs[(c + 0) * 136 + s] = (bf16_t)(x.x & 0xffff); Bs[(c + 1) * 136 + s] = (bf16_t)(x.x >> 16);
      Bs[(c + 2) * 136 + s] = (bf16_t)(x.y & 0xffff); Bs[(c + 3) * 136 + s] = (bf16_t)(x.y >> 16);
      Bs[(c + 4) * 136 + s] = (bf16_t)(x.z & 0xffff); Bs[(c + 5) * 136 + s] = (bf16_t)(x.z >> 16);
      Bs[(c + 6) * 136 + s] = (bf16_t)(x.w & 0xffff); Bs[(c + 7) * 136 + s] = (bf16_t)(x.w >> 16);
    }
    __syncthreads();
    f32x16 acc[2][2];
#pragma unroll
    for (int a = 0; a < 2; ++a)
#pragma unroll
      for (int b = 0; b < 2; ++b)
#pragma unroll
        for (int i = 0; i < 16; ++i) acc[a][b][i] = 0.f;
    const bf16_t* Asb = As + (wm * 64 + lr) * 136 + lh * 8;
    const bf16_t* Bsb = Bs + (wn * 64 + lr) * 136 + lh * 8;
    const int ns = (wm + 1) * 4;
    for (int s = 0; s < ns; ++s) {
      bf16x8 a0 = *(const bf16x8*)(Asb + s * 16);
      bf16x8 a1 = *(const bf16x8*)(Asb + 32 * 136 + s * 16);
      bf16x8 b0 = *(const bf16x8*)(Bsb + s * 16);
      bf16x8 b1 = *(const bf16x8*)(Bsb + 32 * 136 + s * 16);
      acc[0][0] = MFMA32(a0, b0, acc[0][0]);
      acc[0][1] = MFMA32(a0, b1, acc[0][1]);
      acc[1][0] = MFMA32(a1, b0, acc[1][0]);
      acc[1][1] = MFMA32(a1, b1, acc[1][1]);
    }
#pragma unroll
    for (int mi = 0; mi < 2; ++mi)
#pragma unroll
      for (int ni = 0; ni < 2; ++ni)
#pragma unroll
        for (int i = 0; i < 16; ++i) {
          int t = wm * 64 + mi * 32 + crow(i, lh);
          int col = col0 + wn * 64 + ni * 32 + lr;
          size_t off = ((size_t)ch * 128 + t) * 2048 + col;
          float mixed = acc[mi][ni][i] + bs[g * 128 + t];
          G[off] = tobf(frombf(U[off]) * mixed);
        }
    __syncthreads();
  }
  const float* wsf = p.in[20];
  for (int e = bid * NT + tid; e < TS * 2048; e += nblk * NT) {
    int row = e >> 11, col = e & 2047, b = row >> 4, t = row & 15, g = col >> 8;
    float a = bs[g * 128 + t];
    for (int s = 0; s <= t; ++s) a += wsf[((size_t)g * 128 + t) * 128 + s] * frombf(VLN[((size_t)TP + b * 16 + s) * 2048 + col]);
    size_t off = ((size_t)TP + row) * 2048 + col;
    G[off] = tobf(frombf(U[off]) * a);
  }
}

template <int DQK, bool IS_MLA>
DI void attn_unit(const bf16_t* __restrict__ Qp, int ldq, int nq,
                  const bf16_t* __restrict__ Kp, int ldk, const bf16_t* __restrict__ KRp,
                  const bf16_t* __restrict__ Vtp, int ldv,
                  int nkt, int nkt_w, int nkeys, const unsigned* __restrict__ BMp,
                  bf16_t* __restrict__ AOp, unsigned char* smem_half, int wv) {
  constexpr int KS = DQK + 8;
  constexpr int VS = 68;
  constexpr int NQS = DQK / 16;
  const int tid = ltid(wv) & 255, lane = tid & 63, w = tid >> 6, lr = lane & 31, lh = lane >> 5;
  bf16_t* Ks = (bf16_t*)smem_half;
  bf16_t* Vs = Ks + 2 * 64 * KS;
  const bool q_ok = (w * 32 + lr) < nq;
  const int qrow = q_ok ? (w * 32 + lr) : 0;
  bf16x8 qf[NQS];
#pragma unroll
  for (int s = 0; s < NQS; ++s) qf[s] = *(const bf16x8*)(Qp + (size_t)qrow * ldq + s * 16 + lh * 8);
  f32x16 oacc[2];
#pragma unroll
  for (int d = 0; d < 2; ++d)
#pragma unroll
    for (int i = 0; i < 16; ++i) oacc[d][i] = 0.f;
  float m_run = -INFINITY, l_run = 0.f;
  const int kkey = tid >> 3, kc = (tid & 7) * 8;
  const int rkey = tid >> 2, rc = (tid & 3) * 8;
  const int vd = tid >> 3, vk = (tid & 7) * 8;
  uint4 rk[2], rr, rv[2];
  rr = make_uint4(0, 0, 0, 0);
  auto gload = [&](int kt) {
    const int key0 = kt * 64;
#pragma unroll
    for (int i = 0; i < 2; ++i) rk[i] = *(const uint4*)(Kp + (size_t)(key0 + kkey + 32 * i) * ldk + kc);
    if constexpr (IS_MLA) rr = *(const uint4*)(KRp + (size_t)(key0 + rkey) * 32 + rc);
#pragma unroll
    for (int i = 0; i < 2; ++i) rv[i] = *(const uint4*)(Vtp + (size_t)(vd + 32 * i) * ldv + key0 + vk);
  };
  auto sstore = [&](int buf) {
    bf16_t* Kb = Ks + buf * 64 * KS; bf16_t* Vb = Vs + buf * 64 * VS;
#pragma unroll
    for (int i = 0; i < 2; ++i) *(uint4*)(Kb + (kkey + 32 * i) * KS + kc) = rk[i];
    if constexpr (IS_MLA) *(uint4*)(Kb + rkey * KS + 64 + rc) = rr;
#pragma unroll
    for (int i = 0; i < 2; ++i) {
      uint2 lo = make_uint2(rv[i].x, rv[i].y), hi = make_uint2(rv[i].z, rv[i].w);
      *(uint2*)(Vb + (vd + 32 * i) * VS + vk) = lo;
      *(uint2*)(Vb + (vd + 32 * i) * VS + vk + 4) = hi;
    }
  };
  __syncthreads();
  gload(0); sstore(0);
  __syncthreads();
  for (int kt = 0; kt < nkt; ++kt) {
    const int buf = kt & 1;
    if (kt + 1 < nkt) gload(kt + 1);
    if (kt < nkt_w) {
      const bf16_t* Kb = Ks + buf * 64 * KS; const bf16_t* Vb = Vs + buf * 64 * VS;
      uint2 bmw = make_uint2(0xffffffffu, 0xffffffffu);
      if (BMp) bmw = *(const uint2*)(BMp + (size_t)qrow * 256 + kt * 2);
      f32x16 sacc[2];
#pragma unroll
      for (int mt = 0; mt < 2; ++mt) {
#pragma unroll
        for (int i = 0; i < 16; ++i) sacc[mt][i] = 0.f;
#pragma unroll
        for (int s = 0; s < NQS; ++s) {
          bf16x8 kf = *(const bf16x8*)(Kb + (mt * 32 + lr) * KS + s * 16 + lh * 8);
          sacc[mt] = MFMA32(kf, qf[s], sacc[mt]);
        }
      }
      float mx = -INFINITY;
#pragma unroll
      for (int mt = 0; mt < 2; ++mt) {
        const unsigned wbits = mt ? bmw.y : bmw.x;
#pragma unroll
        for (int i = 0; i < 16; ++i) {
          const int kin = crow(i, lh);
          const int key = kt * 64 + mt * 32 + kin;
          bool ok = (key < nkeys) && ((wbits >> kin) & 1u);
          float sv = ok ? sacc[mt][i] : -INFINITY;
          sacc[mt][i] = sv;
          mx = fmaxf(mx, sv);
        }
      }
      mx = fmaxf(mx, shflx(mx, 32, lane));
      const float m_new = fmaxf(m_run, mx);
      const float m_safe = (m_new == -INFINITY) ? 0.f : m_new;
      const float alpha = exp2f(m_run - m_safe);
      m_run = m_new;
      float ls = 0.f;
#pragma unroll
      for (int mt = 0; mt < 2; ++mt)
#pragma unroll
        for (int i = 0; i < 16; ++i) { float pv = exp2f(sacc[mt][i] - m_safe); sacc[mt][i] = pv; ls += pv; }
      l_run = l_run * alpha + ls;
#pragma unroll
      for (int d = 0; d < 2; ++d)
#pragma unroll
        for (int i = 0; i < 16; ++i) oacc[d][i] *= alpha;
#pragma unroll
      for (int mt = 0; mt < 2; ++mt)
#pragma unroll
        for (int s = 0; s < 2; ++s) {
          uint4 pp;
          pp.x = pack2(sacc[mt][8 * s + 0], sacc[mt][8 * s + 1]);
          pp.y = pack2(sacc[mt][8 * s + 2], sacc[mt][8 * s + 3]);
          pp.z = pack2(sacc[mt][8 * s + 4], sacc[mt][8 * s + 5]);
          pp.w = pack2(sacc[mt][8 * s + 6], sacc[mt][8 * s + 7]);
          bf16x8 pf = __builtin_bit_cast(bf16x8, pp);
#pragma unroll
          for (int dt = 0; dt < 2; ++dt) {
            const bf16_t* vrow = Vb + (dt * 32 + lr) * VS + mt * 32 + 16 * s + 4 * lh;
            uint2 lo = *(const uint2*)(vrow), hi = *(const uint2*)(vrow + 8);
            uint4 vv = make_uint4(lo.x, lo.y, hi.x, hi.y);
            bf16x8 vf = __builtin_bit_cast(bf16x8, vv);
            oacc[dt] = MFMA32(vf, pf, oacc[dt]);
          }
        }
    }
    if (kt + 1 < nkt) sstore(buf ^ 1);
    __syncthreads();
  }
  if (nkt_w > 0) {
    float lt = l_run + shflx(l_run, 32, lane);
    float inv = lt > 0.f ? 1.f / lt : 0.f;
    if (q_ok) {
      bf16_t* orow = AOp + (size_t)(w * 32 + lr) * 1024;
#pragma unroll
      for (int dt = 0; dt < 2; ++dt)
#pragma unroll
        for (int g = 0; g < 4; ++g) {
          uint2 pk;
          pk.x = pack2(oacc[dt][4 * g] * inv, oacc[dt][4 * g + 1] * inv);
          pk.y = pack2(oacc[dt][4 * g + 2] * inv, oacc[dt][4 * g + 3] * inv);
          *(uint2*)(orow + dt * 32 + 8 * g + 4 * lh) = pk;
        }
    }
  }
}


DI int snake_idx(int i, int bid, int nblk) { return i * nblk + ((i & 1) ? (nblk - 1 - bid) : bid); }

template <bool IS_MLA>
DI void attn_phase(PREF p, unsigned char* smem, int bid, int nblk, int wv) {
  unsigned char* R = p.ws + OFF_R;
  const int tl = ltid(wv);
  const int hf = tl >> 8, w = (tl >> 6) & 3;
  unsigned char* smh = smem + hf * 45056;
  const int total = 1024 + 256;
  for (int i = 0; i * nblk < total; ++i) {
    int pu = snake_idx(i, bid, nblk);
    if (pu >= total) continue;
    if constexpr (IS_MLA) {
      const bf16_t* Q = (const bf16_t*)(R + R_Q); const bf16_t* KN = (const bf16_t*)(R + R_KN);
      const bf16_t* KR = (const bf16_t*)(R + R_KR); const bf16_t* VT = (const bf16_t*)(R + R_VT);
      bf16_t* AO = (bf16_t*)(R + R_RAW);
      if (pu < 1024) {
        int qt = 63 - (pu >> 4), bh = (pu & 15) * 2 + hf, b = bh >> 4, h = bh & 15;
        int q0 = b * 8192 + qt * 128;
        attn_unit<96, true>(Q + (size_t)q0 * 1536 + h * 96, 1536, 128,
                            KN + (size_t)(b * 8192) * 1024 + h * 64, 1024, KR + (size_t)(b * 8192) * 32,
                            VT + (size_t)((b * 16 + h) * 64) * 8192, 8192,
                            2 * qt + 2, 2 * qt + 1 + (w >> 1), 1 << 30, nullptr,
                            AO + (size_t)q0 * 1024 + h * 64, smh, wv);
      } else {
        int u = (pu - 1024) * 2 + hf, b = u >> 4, h = u & 15;
        int q0 = TP + b * 16;
        attn_unit<96, true>(Q + (size_t)q0 * 1536 + h * 96, 1536, 16,
                            KN + (size_t)(TP + b * SPAD) * 1024 + h * 64, 1024, KR + (size_t)(TP + b * SPAD) * 32,
                            VT + (size_t)TP * 1024 + (size_t)((b * 16 + h) * 64) * SPAD, SPAD,
                            17, (w == 0) ? 17 : 0, NKS, nullptr,
                            AO + (size_t)q0 * 1024 + h * 64, smh, wv);
      }
    } else {
      const bf16_t* Q = (const bf16_t*)(R + D_Q); const bf16_t* KK = (const bf16_t*)(R + D_K);
      const bf16_t* VT = (const bf16_t*)(R + D_VT); const unsigned* BM = (const unsigned*)(R + D_BM);
      bf16_t* AO = (bf16_t*)(R + D_AO);
      if (pu < 1024) {
        int qt = 63 - (pu >> 4), bh = (pu & 15) * 2 + hf, b = bh >> 4, h = bh & 15;
        int q0 = b * 8192 + qt * 128;
        attn_unit<64, false>(Q + (size_t)q0 * 1024 + h * 64, 1024, 128,
                             KK + (size_t)(b * 8192) * 1024 + h * 64, 1024, nullptr,
                             VT + (size_t)((b * 16 + h) * 64) * 8192, 8192,
                             2 * qt + 2, 2 * qt + 1 + (w >> 1), 1 << 30, BM + (size_t)q0 * 256,
                             AO + (size_t)q0 * 1024 + h * 64, smh, wv);
      } else {
        int u = (pu - 1024) * 2 + hf, b = u >> 4, h = u & 15;
        int q0 = TP + b * 16;
        attn_unit<64, false>(Q + (size_t)q0 * 1024 + h * 64, 1024, 16,
                             KK + (size_t)(TP + b * SPAD) * 1024 + h * 64, 1024, nullptr,
                             VT + (size_t)TP * 1024 + (size_t)((b * 16 + h) * 64) * SPAD, SPAD,
                             17, (w == 0) ? 17 : 0, NKS, BM + (size_t)q0 * 256,
                             AO + (size_t)q0 * 1024 + h * 64, smh, wv);
      }
    }
  }
}

constexpr int CAP = 128;
DI int score_bin(float s) {
  unsigned u = __float_as_uint(s);
  int e = (int)((u & 0x7fffffffu) >> 19);
  int m = min(max(e, 1840), 2095) - 1840;
  return (u >> 31) ? (255 - m) : (256 + m);
}

DI void idx_unit(const bf16_t* __restrict__ QI, const float* __restrict__ WI, int q_row0, int nq,
                 const bf16_t* __restrict__ KI, int L, unsigned* __restrict__ BM, unsigned char* smem, int wv) {
  const int tid = ltid(wv), lane = tid & 63, w = tid >> 6, lr = lane & 31, lh = lane >> 5;
  bf16_t* Qs = (bf16_t*)smem;
  float* Ws = (float*)(smem + 36864);
  unsigned* hist = (unsigned*)(smem + 36864 + 1024);
  float* cand_s = (float*)hist;
  int* cand_i = (int*)(smem + 36864 + 1024 + 16384);
  int* bstar = (int*)(smem + 36864 + 1024 + 32768);
  int* need = bstar + 32;
  int* ncand = need + 32;
  __syncthreads();
#pragma unroll
  for (int i = 0; i < 4; ++i) {
    int v = tid + i * NT;
    int hd = v >> 8, q = (v >> 3) & 31, c = (v & 7) * 8;
    int qq = q < nq ? q : 0;
    *(uint4*)(Qs + (hd * 32 + q) * 72 + c) = *(const uint4*)(QI + (size_t)(q_row0 + qq) * 512 + hd * 64 + c);
  }
  if (tid < 256) { int hd = tid >> 5, q = tid & 31; int qq = q < nq ? q : 0; Ws[hd * 32 + q] = WI[(size_t)(q_row0 + qq) * 8 + hd]; }
  for (int i = tid; i < 32 * 256; i += NT) hist[i] = 0u;
  if (tid < 32) { bstar[tid] = -1; need[tid] = 0; ncand[tid] = 0; }
  __syncthreads();
  const int ntile = (L + 255) >> 8;
  const bool do_select = L > 256;
  for (int pass = do_select ? 0 : 1; pass < 2; ++pass) {
    for (int kt = 0; kt < ntile; ++kt) {
      const int key0 = kt * 256 + w * 32;
      if (key0 < L) {
        const int key = key0 + lr;
        bf16x8 kf[4];
#pragma unroll
        for (int s = 0; s < 4; ++s) kf[s] = *(const bf16x8*)(KI + (size_t)key * 64 + s * 16 + lh * 8);
        float sc[16];
#pragma unroll
        for (int i = 0; i < 16; ++i) sc[i] = 0.f;
#pragma unroll 1
        for (int hd = 0; hd < 8; ++hd) {
          f32x16 acc;
#pragma unroll
          for (int i = 0; i < 16; ++i) acc[i] = 0.f;
#pragma unroll
          for (int s = 0; s < 4; ++s) {
            bf16x8 qf = *(const bf16x8*)(Qs + (hd * 32 + lr) * 72 + s * 16 + lh * 8);
            acc = MFMA32(qf, kf[s], acc);
          }
#pragma unroll
          for (int g = 0; g < 4; ++g) {
            float4 wv = *(const float4*)(Ws + hd * 32 + 8 * g + 4 * lh);
            sc[4 * g + 0] += wv.x * fmaxf(acc[4 * g + 0], 0.f);
            sc[4 * g + 1] += wv.y * fmaxf(acc[4 * g + 1], 0.f);
            sc[4 * g + 2] += wv.z * fmaxf(acc[4 * g + 2], 0.f);
            sc[4 * g + 3] += wv.w * fmaxf(acc[4 * g + 3], 0.f);
          }
        }
        const bool kvalid = key < L;
        if (pass == 0) {
#pragma unroll
          for (int i = 0; i < 16; ++i) {
            int q = crow(i, lh);
            if (kvalid) { int b = score_bin(sc[i]); atomicAdd(&hist[q * 256 + (b >> 1)], (b & 1) ? 65536u : 1u); }
          }
        } else {
#pragma unroll
          for (int i = 0; i < 16; ++i) {
            int q = crow(i, lh);
            int b = score_bin(sc[i]);
            int bs = bstar[q];
            bool sel = kvalid && (b > bs);
            bool cnd = kvalid && (b == bs);
            unsigned long long bal = __ballot(sel);
            if (lr == 0 && q < nq) BM[(size_t)(q_row0 + q) * 256 + (key0 >> 5)] = (unsigned)(bal >> (32 * lh));
            if (cnd) {
              int pos = atomicAdd(&ncand[q], 1);
              if (pos < CAP) { cand_s[q * CAP + pos] = sc[i]; cand_i[q * CAP + pos] = key; }
            }
          }
        }
      }
    }
    __syncthreads();
    if (pass == 0) {
      for (int qi = 0; qi < 4; ++qi) {
        const int q = w * 4 + qi;
        unsigned hw[4];
#pragma unroll
        for (int k = 0; k < 4; ++k) hw[k] = hist[q * 256 + 255 - 4 * lane - k];
        int cnt = 0;
#pragma unroll
        for (int k = 0; k < 4; ++k) cnt += (int)(hw[k] >> 16) + (int)(hw[k] & 0xffffu);
        int pre = cnt;
#pragma unroll
        for (int o = 1; o < 64; o <<= 1) { int t = __builtin_amdgcn_ds_bpermute(((lane - o) & 63) << 2, pre); if (lane >= o) pre += t; }
        unsigned long long bal = __ballot(pre >= 256);
        if (bal != 0ull) {
          int fl = __ffsll((long long)bal) - 1;
          if (lane == fl) {
            int running = pre - cnt;
            int bsel = -1, above = 0;
#pragma unroll
            for (int k = 0; k < 4; ++k) {
              int chi = (int)(hw[k] >> 16), clo = (int)(hw[k] & 0xffffu);
              if (bsel < 0) { if (running + chi >= 256) { bsel = 511 - 8 * lane - 2 * k; above = running; } else running += chi; }
              if (bsel < 0) { if (running + clo >= 256) { bsel = 510 - 8 * lane - 2 * k; above = running; } else running += clo; }
            }
            bstar[q] = bsel; need[q] = 256 - above;
          }
        }
      }
      __syncthreads();
    }
  }
  __threadfence();
  __syncthreads();
  if (do_select) {
    for (int pi = tid; pi < 32 * CAP; pi += NT) {
      int q = pi / CAP, c = pi - q * CAP;
      int n = min(ncand[q], CAP);
      if (c < n && q < nq) {
        float sv = cand_s[q * CAP + c]; int iv = cand_i[q * CAP + c];
        int rank = 0;
        for (int j = 0; j < n; ++j) {
          float sj = cand_s[q * CAP + j]; int ij = cand_i[q * CAP + j];
          rank += (sj > sv || (sj == sv && ij < iv)) ? 1 : 0;
        }
        if (rank < need[q]) atomicOr(&BM[(size_t)(q_row0 + q) * 256 + (iv >> 5)], 1u << (iv & 31));
      }
    }
  }
  __syncthreads();
}

DI void idx_phase(PREF p, unsigned char* smem, int bid, int nblk, int wv) {
  unsigned char* R = p.ws + OFF_R;
  const bf16_t* QI = (const bf16_t*)(R + D_QI); const float* WI = (const float*)(R + D_WI);
  const bf16_t* KI = (const bf16_t*)(R + D_KI); unsigned* BM = (unsigned*)(R + D_BM);
  const int total = 512 + 32;
  for (int i = 0; i * nblk < total; ++i) {
    int idx = snake_idx(i, bid, nblk);
    if (idx >= total) continue;
    if (idx < 512) {
      int qt = 255 - (idx >> 1), b = idx & 1;
      int L = (((qt * 32) >> 6) + 1) * 64;
      idx_unit(QI, WI, b * 8192 + qt * 32, 32, KI + (size_t)(b * 8192) * 64, L, BM, smem, wv);
    } else {
      int b = idx - 512;
      idx_unit(QI, WI, TP + b * 16, 16, KI + (size_t)(TP + b * SPAD) * 64, NKS, BM, smem, wv);
    }
  }
}

DI void cvt8(const float* s, bf16_t* d) {
  float4 a = *(const float4*)s, b = *(const float4*)(s + 4);
  uint4 pk; pk.x = pack2(a.x, a.y); pk.y = pack2(a.z, a.w); pk.z = pack2(b.x, b.y); pk.w = pack2(b.z, b.w);
  *(uint4*)d = pk;
}
DI void cache_rows(const float* __restrict__ src, bf16_t* __restrict__ dst, int Wd, int bid, int nblk, int wv) {
  const int vpr = Wd >> 3;
  const size_t total = (size_t)32 * SPAD * vpr;
  for (size_t e = (size_t)bid * NT + ltid(wv); e < total; e += (size_t)nblk * NT) {
    int c = (int)(e % vpr) * 8; size_t rw = e / vpr; int b = (int)(rw / SPAD), s = (int)(rw % SPAD);
    bf16_t* d = dst + ((size_t)TP + (size_t)b * SPAD + s) * Wd + c;
    if (s < 1024) cvt8(src + ((size_t)b * 1024 + s) * Wd + c, d);
    else if (s >= NKS) { unsigned z = 0; asm volatile("" : "+v"(z)); *(uint4*)d = make_uint4(z, z, z, z); }
  }
}

extern "C" __global__ void __launch_bounds__(512, 2) mega(Params p_unused) {
  extern __shared__ __attribute__((aligned(16))) unsigned char smem[];
  cg::grid_group grid = cg::this_grid();
  const int bid = blockIdx.x, nblk = gridDim.x;
  const int wv = __builtin_amdgcn_readfirstlane((int)(threadIdx.x >> 6));
  CParams* pk = (CParams*)__builtin_amdgcn_kernarg_segment_ptr();
  const int ph_lo = pk->ph_lo, ph_hi = pk->ph_hi;
  int ph = 0;
#ifndef REPMASK
#define REPMASK 0u
#endif
#ifndef PMASK
#define PMASK 0xffffffffu
#endif
#define PHASE_BEGIN(k) if (ph >= ph_lo && ph < ph_hi) { if constexpr ((PMASK >> (k)) & 1u) for (int rep_ = 0; rep_ < 1 + (int)((REPMASK >> (k)) & 1u); ++rep_) { \
    CParams* pp_ = pk; asm volatile("" : "+s"(pp_)); PREF p = *pp_; const int tid = ltid(wv); \
    unsigned char* ws = p.ws; float* X = (float*)(ws + OFF_X); bf16_t* H = (bf16_t*)(ws + OFF_H); bf16_t* Wb = (bf16_t*)(ws + OFF_W); \
    float* ROPE = (float*)(ws + OFF_ROPE); unsigned char* R = ws + OFF_R; (void)tid; (void)X; (void)H; (void)Wb; (void)ROPE; (void)R;
#define PHASE_END   } if (ph + 1 < ph_hi) grid.sync(); } ++ph;

  PHASE_BEGIN(0)
    {
      const int hf = tid >> 8, tl = tid & 255;
      float* smh = (float*)smem + hf * 4224;
      for (int t0 = bid * 2; t0 < p.total_tiles; t0 += nblk * 2) {
        const int t = t0 + hf;
        const bool active = t < p.total_tiles;
        const int tt = active ? t : 0;
        int ji = 0;
#pragma unroll 1
        for (int q = 1; q < NJOBS; ++q) if (tt >= p.jobs[q].tile0) ji = q;
        const CAS Job& jb = p.jobs[ji];
        int lt = tt - jb.tile0; int nkt = jb.k >> 6; int nt_ = lt / nkt, kt_ = lt - nt_ * nkt;
        transpose_tile(jb.src, jb.nsrc, jb.nsrc, jb.dst, jb.k, nt_ * 64, kt_ * 64, jb.mode, smh, tl, active);
      }
    }
    {
      const size_t n4p = (size_t)TP * 256, n4 = (size_t)T * 256;
      const float4* xp = (const float4*)p.in[0]; const float4* xs = (const float4*)p.in[1];
      for (size_t e = (size_t)bid * NT + tid; e < n4; e += (size_t)nblk * NT) ((float4*)X)[e] = (e < n4p) ? xp[e] : xs[e - n4p];
      for (int e = bid * NT + tid; e < 8192 * 16; e += nblk * NT) {
        int pos = e >> 4, i = e & 15;
        double rev = (double)pos * p.inv_freq[i] * 0.15915494309189535;
        rev -= floor(rev);
        float fr = (float)rev;
        ROPE[2 * e] = __builtin_amdgcn_cosf(fr); ROPE[2 * e + 1] = __builtin_amdgcn_sinf(fr);
      }
      const float* wsrc = p.in[20];
      for (int e = bid * NT + tid; e < 8 * 128 * 128; e += nblk * NT) {
        int s = e & 127, t = (e >> 7) & 127;
        Wb[W_TRIL + e] = tobf(s <= t ? wsrc[e] : 0.f);
      }
    }
  PHASE_END

#pragma unroll 1
  for (int L = 0; L < 4; ++L) {
    const int kind = L % 3, j = L / 3;
    if (kind == 0) {
      PHASE_BEGIN(1)
        rmsnorm_rows(X, p.in[7] + L * 1024, H, nullptr, nullptr, bid, nblk, wv);
        cache_rows(p.in[2] + (size_t)j * 32 * 1024 * 256, (bf16_t*)(R + R_CKV), 256, bid, nblk, wv);
        cache_rows(p.in[3] + (size_t)j * 32 * 1024 * 32, (bf16_t*)(R + R_KR), 32, bid, nblk, wv);
      PHASE_END
      PHASE_BEGIN(2)
        EArgs ea{}; ea.f0 = (float*)(R + R_RAW);
        gemm_phase<E_F32>(H, Wb + W_MLA + (size_t)j * WM_SZ + WM_D, T, 1024, 1024, ea, smem, 0, bid, nblk, wv);
      PHASE_END
      PHASE_BEGIN(3)
        mla_rowops(p, j, bid, nblk, wv);
      PHASE_END
      PHASE_BEGIN(4)
        EArgs ea{}; ea.b0 = (bf16_t*)(R + R_Q); ea.rope = ROPE;
        gemm_phase<E_MLAQ>((const bf16_t*)(R + R_CQ), Wb + W_MLA + (size_t)j * WM_SZ + WM_UQ, T, 1536, 512, ea, smem, 0, bid, nblk, wv);
        EArgs eb{}; eb.b0 = (bf16_t*)(R + R_KN); eb.b1 = (bf16_t*)(R + R_VT);
        gemm_phase<E_MLAKV>((const bf16_t*)(R + R_CKV), Wb + W_MLA + (size_t)j * WM_SZ + WM_UKV, KROWS, 2048, 256, eb, smem, (T / 256) * 6, bid, nblk, wv);
      PHASE_END
      PHASE_BEGIN(5)
        attn_phase<true>(p, smem, bid, nblk, wv);
      PHASE_END
      PHASE_BEGIN(6)
        EArgs ea{}; ea.f0 = X;
        gemm_phase<E_RESID>((const bf16_t*)(R + R_RAW), Wb + W_MLA + (size_t)j * WM_SZ + WM_O, T, 1024, 1024, ea, smem, 0, bid, nblk, wv);
      PHASE_END
    } else if (kind == 1) {
      PHASE_BEGIN(1)
        rmsnorm_rows(X, p.in[7] + L * 1024, H, nullptr, nullptr, bid, nblk, wv);
      PHASE_END
      PHASE_BEGIN(7)
        EArgs ea{}; ea.b0 = (bf16_t*)(R + C_U); ea.b1 = (bf16_t*)(R + C_VR);
        gemm_phase<E_GELU>(H, Wb + W_CM + WC_IN, T, 4096, 1024, ea, smem, 0, bid, nblk, wv);
      PHASE_END
      PHASE_BEGIN(8)
        cmlp_ln_rows(p, bid, nblk, wv);
      PHASE_END
      PHASE_BEGIN(9)
        cmlp_mix_phase(p, smem, bid, nblk, wv);
      PHASE_END
      PHASE_BEGIN(6)
        EArgs ea{}; ea.f0 = X;
        gemm_phase<E_RESID>((const bf16_t*)(R + C_G), Wb + W_CM + WC_OUT, T, 1024, 2048, ea, smem, 0, bid, nblk, wv);
      PHASE_END
    } else {
      PHASE_BEGIN(10)
        rmsnorm_rows(X, p.in[7] + L * 1024, H, nullptr, nullptr, bid, nblk, wv);
        cache_rows(p.in[4], (bf16_t*)(R + D_K), 1024, bid, nblk, wv);
        cache_rows(p.in[6], (bf16_t*)(R + D_KI), 64, bid, nblk, wv);
        {
          bf16_t* VTs = (bf16_t*)(R + D_VT) + (size_t)TP * 1024;
          {
            const int hf = tid >> 8, tl = tid & 255;
            float* smh = (float*)smem + hf * 4224;
            for (int u0 = bid * 2; u0 < 512 * 16; u0 += nblk * 2) {
              const int u = u0 + hf;
              int st = u & 15, bh = u >> 4, b = bh >> 4, h = bh & 15;
              transpose_tile(p.in[5] + (size_t)b * 1024 * 1024 + h * 64, 1024, 64, VTs + (size_t)(bh * 64) * SPAD, SPAD, 0, st * 64, 0, smh, tl, true);
            }
          }
          for (int e = bid * NT + tid; e < 512 * 64 * 12; e += nblk * NT) {
            int c = e % 12, rw = e / 12;
            { unsigned z = 0; asm volatile("" : "+v"(z)); *(uint2*)(VTs + (size_t)rw * SPAD + NKS + c * 4) = make_uint2(z, z); }
          }
        }
      PHASE_END
      PHASE_BEGIN(11)
        EArgs ea{};
        ea.f0 = p.out + O_DKP; ea.f1 = p.out + O_DKS; ea.f2 = p.out + O_DVP; ea.f3 = p.out + O_DVS;
        ea.f4 = (float*)(R + D_KIR); ea.f5 = (float*)(R + D_WI);
        ea.b0 = (bf16_t*)(R + D_Q); ea.b1 = (bf16_t*)(R + D_K); ea.b2 = (bf16_t*)(R + D_VT); ea.b3 = (bf16_t*)(R + D_QI);
        gemm_phase<E_DSA>(H, Wb + W_DS + WD_P, T, 3840, 1024, ea, smem, 0, bid, nblk, wv);
      PHASE_END
      PHASE_BEGIN(12)
        dsa_rowops(p, bid, nblk, wv);
      PHASE_END
      PHASE_BEGIN(13)
        idx_phase(p, smem, bid, nblk, wv);
      PHASE_END
      PHASE_BEGIN(14)
        attn_phase<false>(p, smem, bid, nblk, wv);
      PHASE_END
      PHASE_BEGIN(6)
        EArgs ea{}; ea.f0 = X;
        gemm_phase<E_RESID>((const bf16_t*)(R + D_AO), Wb + W_DS + WD_O, T, 1024, 1024, ea, smem, 0, bid, nblk, wv);
      PHASE_END
    }
    PHASE_BEGIN(1)
      rmsnorm_rows(X, p.in[8] + L * 1024, H, nullptr, nullptr, bid, nblk, wv);
    PHASE_END
    PHASE_BEGIN(15)
      EArgs ea{}; ea.b0 = (bf16_t*)(R + 0);
      gemm_phase<E_SWIGLU>(H, Wb + W_FF + (size_t)L * WF_SZ + WF_IN, T, 2 * DFF, 1024, ea, smem, 0, bid, nblk, wv);
    PHASE_END
    PHASE_BEGIN(6)
      EArgs ea{}; ea.f0 = X;
      gemm_phase<E_RESID>((const bf16_t*)(R + 0), Wb + W_FF + (size_t)L * WF_SZ + WF_OUT, T, 1024, DFF, ea, smem, 0, bid, nblk, wv);
    PHASE_END
  }
  PHASE_BEGIN(1)
    rmsnorm_rows(X, p.in[9], nullptr, p.out + O_YP, p.out + O_YS, bid, nblk, wv);
  PHASE_END
}

extern "C" void kernel_launch(void* const* d_in, const int* in_sizes, int n_in,
                              void* d_out, int out_size, void* d_ws, size_t ws_size,
                              hipStream_t stream) {
  constexpr int kLds = 128 * 1024;
  static int grid_blocks = 0;
  if (!grid_blocks) {
    int dev = 0, cus = 0, per_cu = 0;
    (void)hipGetDevice(&dev);
    (void)hipDeviceGetAttribute(&cus, hipDeviceAttributeMultiprocessorCount, dev);
    (void)hipFuncSetAttribute((const void*)mega, hipFuncAttributeMaxDynamicSharedMemorySize, kLds);
    (void)hipOccupancyMaxActiveBlocksPerMultiprocessor(&per_cu, (const void*)mega, NT, kLds);
    if (per_cu < 1) per_cu = 1;
    if (per_cu > 1) per_cu = 1;
    grid_blocks = cus * per_cu;
    fprintf(stderr, "grid %d (cus %d per_cu %d) ws %zu need %zu out %d need %zu\n", grid_blocks, cus, per_cu, ws_size, (size_t)WS_NEED, out_size, (size_t)O_END);
  }
  if (ws_size < WS_NEED || n_in != 31 || (size_t)out_size != O_END) { fprintf(stderr, "kernel_launch: bad sizes\n"); return; }
  Params p;
  memset(&p, 0, sizeof(p));
  for (int i = 0; i < 31; ++i) p.in[i] = (const float*)d_in[i];
  p.out = (float*)d_out; p.ws = (unsigned char*)d_ws;
  bf16_t* Wb = (bf16_t*)((unsigned char*)d_ws + OFF_W);
  int nj = 0, tiles = 0;
  auto add = [&](const float* src, int nsrc, int k, bf16_t* dst, int ndst, int mode) {
    Job& jb = p.jobs[nj++]; jb.src = src; jb.dst = dst; jb.nsrc = nsrc; jb.k = k; jb.ndst = ndst; jb.mode = mode; jb.tile0 = tiles; jb.pad = 0;
    tiles += (ndst / 64) * (k / 64);
  };
  for (int j = 0; j < 2; ++j) {
    bf16_t* Wm = Wb + W_MLA + (size_t)j * WM_SZ;
    add(p.in[10] + (size_t)j * 1024 * 512, 512, 1024, Wm + WM_D, 512, 0);
    add(p.in[13] + (size_t)j * 1024 * 288, 288, 1024, Wb + W_MLA + (size_t)j * WM_SZ + WM_D + (size_t)512 * 1024, 512, 0);
    add(p.in[12] + (size_t)j * 512 * 1536, 1536, 512, Wb + W_MLA + (size_t)j * WM_SZ + WM_UQ, 1536, 0);
    add(p.in[15] + (size_t)j * 256 * 2048, 2048, 256, Wb + W_MLA + (size_t)j * WM_SZ + WM_UKV, 2048, 0);
    add(p.in[16] + (size_t)j * 1024 * 1024, 1024, 1024, Wb + W_MLA + (size_t)j * WM_SZ + WM_O, 1024, 0);
  }
  add(p.in[17], 4096, 1024, Wb + W_CM + WC_IN, 4096, 0);
  add(p.in[22], 1024, 2048, Wb + W_CM + WC_OUT, 1024, 0);
  add(p.in[23], 3072, 1024, Wb + W_DS + WD_P, 3072, 0);
  add(p.in[25], 512, 1024, Wb + W_DS + WD_P + (size_t)3072 * 1024, 512, 0);
  add(p.in[26], 64, 1024, Wb + W_DS + WD_P + (size_t)3584 * 1024, 64, 0);
  add(p.in[28], 8, 1024, Wb + W_DS + WD_P + (size_t)3648 * 1024, 192, 0);
  add(p.in[24], 1024, 1024, Wb + W_DS + WD_O, 1024, 0);
  for (int i = 0; i < 4; ++i) {
    add(p.in[29] + (size_t)i * 1024 * 5632, 5632, 1024, Wb + W_FF + (size_t)i * WF_SZ + WF_IN, 5632, 1);
    add(p.in[30] + (size_t)i * 2816 * 1024, 1024, 2816, Wb + W_FF + (size_t)i * WF_SZ + WF_OUT, 1024, 0);
  }
  p.total_tiles = tiles;
  for (int i = 0; i < 16; ++i) p.inv_freq[i] = pow(10000.0, -(double)i / 16.0);
  p.ph_lo = 0; p.ph_hi = 1000;
  void* args[] = {&p};
  hipError_t e = hipLaunchCooperativeKernel((const void*)mega, dim3(grid_blocks), dim3(NT), args, kLds, stream);
  if (e != hipSuccess) fprintf(stderr, "coop launch failed: %s\n", hipGetErrorString(e));
}
```

```cpp
#include <hip/hip_runtime.h>
#include <hip/hip_cooperative_groups.h>
#include <cstdio>
#include <cstring>
#include <cmath>
namespace cg = cooperative_groups;

typedef unsigned short bf16_t;
using bf16x8 = __attribute__((ext_vector_type(8))) short;
using f32x16 = __attribute__((ext_vector_type(16))) float;
using f32x2v = __attribute__((ext_vector_type(2))) float;
using bf2v = __attribute__((ext_vector_type(2))) __bf16;
#define DI __device__ __forceinline__
#define MFMA32(a, b, c) __builtin_amdgcn_mfma_f32_32x32x16_bf16((a), (b), (c), 0, 0, 0)

constexpr int TP = 16384, TS = 512, T = TP + TS;
constexpr int NT = 512;
constexpr int SPAD = 1088, NKS = 1040;
constexpr int KROWS = TP + 32 * SPAD;
constexpr int DFF = 2816;
constexpr float LOG2E = 1.4426950408889634f;
constexpr float EPS = 1e-6f;

constexpr size_t OFF_X = 0;
constexpr size_t OFF_H = OFF_X + (size_t)T * 1024 * 4;
constexpr size_t OFF_W = OFF_H + (size_t)T * 1024 * 2;
constexpr size_t W_ELEMS = 52822016;
constexpr size_t OFF_ROPE = OFF_W + W_ELEMS * 2;
constexpr size_t OFF_R = OFF_ROPE + (size_t)8192 * 16 * 2 * 4;
constexpr size_t R_RAW = 0;
constexpr size_t R_CQ = R_RAW + (size_t)T * 1024 * 4;
constexpr size_t R_CKV = R_CQ + (size_t)T * 512 * 2;
constexpr size_t R_KR = R_CKV + (size_t)KROWS * 256 * 2;
constexpr size_t R_Q = R_KR + (size_t)KROWS * 32 * 2;
constexpr size_t R_KN = R_Q + (size_t)T * 1536 * 2;
constexpr size_t R_VT = R_KN + (size_t)KROWS * 1024 * 2;
constexpr size_t R_END = R_VT + (size_t)KROWS * 1024 * 2;
constexpr size_t D_Q = 0;
constexpr size_t D_K = D_Q + (size_t)T * 1024 * 2;
constexpr size_t D_VT = D_K + (size_t)KROWS * 1024 * 2;
constexpr size_t D_QI = D_VT + (size_t)KROWS * 1024 * 2;
constexpr size_t D_KIR = D_QI + (size_t)T * 512 * 2;
constexpr size_t D_KI = D_KIR + (size_t)T * 64 * 4;
constexpr size_t D_WI = D_KI + (size_t)KROWS * 64 * 2;
constexpr size_t D_BM = D_WI + (size_t)T * 8 * 4;
constexpr size_t D_AO = D_BM + (size_t)T * 256 * 4;
constexpr size_t D_END = D_AO + (size_t)T * 1024 * 2;
constexpr size_t C_U = 0;
constexpr size_t C_VR = C_U + (size_t)T * 2048 * 2;
constexpr size_t C_VLN = C_VR + (size_t)T * 2048 * 2;
constexpr size_t C_G = C_VLN + (size_t)T * 2048 * 2;
constexpr size_t C_END = C_G + (size_t)T * 2048 * 2;
constexpr size_t OFF_BAR = OFF_R + R_END;
constexpr size_t WS_NEED = OFF_BAR + 16384;
static_assert(D_END <= R_END && C_END <= R_END && (size_t)T * DFF * 2 <= R_END, "region");

constexpr size_t W_MLA = 0;
constexpr size_t WM_D = 0, WM_UQ = 1048576, WM_UKV = WM_UQ + 786432, WM_O = WM_UKV + 524288, WM_SZ = 3407872;
constexpr size_t W_CM = 2 * WM_SZ;
constexpr size_t WC_IN = 0, WC_OUT = 4194304, WC_SZ = 6291456;
constexpr size_t W_DS = W_CM + WC_SZ;
constexpr size_t WD_P = 0, WD_O = 3932160, WD_SZ = 4980736;
constexpr size_t W_FF = W_DS + WD_SZ;
constexpr size_t WF_IN = 0, WF_OUT = 5767168, WF_SZ = 8650752;
constexpr size_t W_TRIL = W_FF + 4 * WF_SZ;
static_assert(W_TRIL + 131072 == W_ELEMS, "w");

constexpr size_t O_YP = 0;
constexpr size_t O_YS = O_YP + (size_t)TP * 1024;
constexpr size_t O_CKVP = O_YS + (size_t)TS * 1024;
constexpr size_t O_KRP = O_CKVP + (size_t)2 * TP * 256;
constexpr size_t O_CKVS = O_KRP + (size_t)2 * TP * 32;
constexpr size_t O_KRS = O_CKVS + (size_t)2 * TS * 256;
constexpr size_t O_CVS = O_KRS + (size_t)2 * TS * 32;
constexpr size_t O_DKP = O_CVS + (size_t)TS * 2048;
constexpr size_t O_DVP = O_DKP + (size_t)TP * 1024;
constexpr size_t O_DIP = O_DVP + (size_t)TP * 1024;
constexpr size_t O_DKS = O_DIP + (size_t)TP * 64;
constexpr size_t O_DVS = O_DKS + (size_t)TS * 1024;
constexpr size_t O_DIS = O_DVS + (size_t)TS * 1024;
constexpr size_t O_END = O_DIS + (size_t)TS * 64;

constexpr int NJOBS = 25;
struct Job { const float* src; bf16_t* dst; int nsrc, k, ndst, mode, tile0, pad; };
struct Params {
  const float* in[31];
  float* out;
  unsigned char* ws;
  Job jobs[NJOBS];
  int total_tiles, ph_lo, ph_hi, pad;
  double inv_freq[16];
};

#define CAS __attribute__((address_space(4)))
typedef const CAS Params CParams;
#define PREF const CAS Params&
DI unsigned pack2(float a, float b) { f32x2v v = {a, b}; bf2v r = __builtin_convertvector(v, bf2v); return __builtin_bit_cast(unsigned, r); }
DI bf16_t tobf(float a) { return (bf16_t)(pack2(a, 0.f) & 0xffffu); }
DI float frombf(bf16_t v) { return __uint_as_float(((unsigned)v) << 16); }
DI float bflo(unsigned u) { return __uint_as_float(u << 16); }
DI float bfhi(unsigned u) { return __uint_as_float(u & 0xffff0000u); }
DI float shflx(float v, int m, int lane) { return __int_as_float(__builtin_amdgcn_ds_bpermute((lane ^ m) << 2, __float_as_int(v))); }
DI float wave_sum(float v, int lane) {
#pragma unroll
  for (int o = 32; o >= 1; o >>= 1) v += shflx(v, o, lane);
  return v;
}
DI int ltid(int wv) { unsigned m1 = ~0u; asm volatile("" : "+s"(m1)); int t = (wv << 6) | (int)__builtin_amdgcn_mbcnt_hi(m1, __builtin_amdgcn_mbcnt_lo(m1, 0u)); asm volatile("" : "+v"(t)); return t; }
DI int crow(int i, int h) { return (i & 3) + 8 * (i >> 2) + 4 * h; }
DI int rowmap(int t) { if (t < TP) return t; int u = t - TP; return TP + (u >> 4) * SPAD + 1024 + (u & 15); }
DI int tokpos(int t) { return t < TP ? (t & 8191) : 1024 + ((t - TP) & 15); }

DI void transpose_tile(const float* __restrict__ src, int src_ld, int ncols, bf16_t* __restrict__ dst, int dst_ld,
                       int n0, int k0, int mode, float* sm, int tid, bool active) {
  const int nl = tid & 63, kq = tid >> 6;
  const int n = n0 + nl;
  int c;
  if (mode == 0) c = n < ncols ? n : -1;
  else { int tt = n >> 5, r = n & 31; int f = tt * 16 + (r & 15); c = (r < 16) ? f : DFF + f; }
  if (active) {
#pragma unroll 4
    for (int i = 0; i < 16; ++i) {
      int kk = kq + 4 * i;
      float v = (c >= 0) ? src[(size_t)(k0 + kk) * src_ld + c] : 0.f;
      sm[kk * 65 + nl] = v;
    }
  }
  __syncthreads();
  if (active) {
    const int kp = (tid & 31) * 2, nr = tid >> 5;
#pragma unroll 4
    for (int i = 0; i < 8; ++i) {
      int nn = nr + 8 * i;
      float a = sm[kp * 65 + nn], b = sm[(kp + 1) * 65 + nn];
      *(unsigned*)(dst + (size_t)(n0 + nn) * dst_ld + k0 + kp) = pack2(a, b);
    }
  }
  __syncthreads();
}

enum { E_F32 = 0, E_RESID, E_SWIGLU, E_GELU, E_MLAQ, E_MLAKV, E_DSA };
struct EArgs {
  float* f0; float* f1; float* f2; float* f3; float* f4; float* f5; float* f6;
  bf16_t* b0; bf16_t* b1; bf16_t* b2; bf16_t* b3;
  const float* rope;
};
using f32x4v = __attribute__((ext_vector_type(4))) float;
#define LAS __attribute__((address_space(3)))
constexpr int G_HT = 128 * 64;
DI int lds_byte(int r, int c) {
  int st = (r >> 4) * 2 + (c >> 5), rr = r & 15, cc = c & 31, ob = rr * 64 + cc * 2;
  return st * 1024 + (ob ^ (((ob >> 9) & 1) << 5));
}
DI void stage_rc(int b, int& R, int& C) {
  int st = b >> 10, sb = b & 1023, swz = sb ^ (((sb >> 9) & 1) << 5);
  R = (st >> 1) * 16 + (swz >> 6); C = (st & 1) * 32 + ((swz & 63) >> 1);
}

template <int EPI>
DI void epi16(const EArgs& ea, int row0, int gb, int fr, const f32x4v& v0, const f32x4v& v1) {
  if constexpr (EPI == E_F32) {
#pragma unroll
    for (int j = 0; j < 4; ++j) { float* o = ea.f0 + (size_t)(row0 + j) * 1024 + gb + fr; o[0] = v0[j]; o[16] = v1[j]; }
  } else if constexpr (EPI == E_RESID) {
#pragma unroll
    for (int j = 0; j < 4; ++j) { float* o = ea.f0 + (size_t)(row0 + j) * 1024 + gb + fr; o[0] += v0[j]; o[16] += v1[j]; }
  } else if constexpr (EPI == E_SWIGLU) {
    const int f = (gb >> 1) + fr;
#pragma unroll
    for (int j = 0; j < 4; ++j) { float g = v0[j], u = v1[j]; ea.b0[(size_t)(row0 + j) * DFF + f] = tobf(g / (1.f + __expf(-g)) * u); }
  } else if constexpr (EPI == E_GELU) {
    bf16_t* dstp = (gb < 2048) ? (ea.b0 + gb + fr) : (ea.b1 + (gb - 2048) + fr);
#pragma unroll
    for (int j = 0; j < 4; ++j) {
      float x = v0[j], y = v1[j];
      dstp[(size_t)(row0 + j) * 2048] = tobf(0.5f * x * (1.f + erff(x * 0.70710678118654752f)));
      dstp[(size_t)(row0 + j) * 2048 + 16] = tobf(0.5f * y * (1.f + erff(y * 0.70710678118654752f)));
    }
  } else if constexpr (EPI == E_MLAQ) {
    const float qs = 0.10206207261596577f * LOG2E;
    const bool is_rope = (gb % 96) == 64;
#pragma unroll
    for (int j = 0; j < 4; ++j) {
      const int row = row0 + j;
      float o0 = v0[j], o1 = v1[j];
      if (is_rope) {
        float2 cs = *(const float2*)(ea.rope + ((size_t)tokpos(row) * 16 + fr) * 2);
        o0 = v0[j] * cs.x - v1[j] * cs.y; o1 = v0[j] * cs.y + v1[j] * cs.x;
      }
      bf16_t* o = ea.b0 + (size_t)row * 1536 + gb + fr;
      o[0] = tobf(o0 * qs); o[16] = tobf(o1 * qs);
    }
  } else if constexpr (EPI == E_MLAKV) {
    const int head = gb >> 7, c0 = gb & 127;
    if (c0 < 64) {
#pragma unroll
      for (int j = 0; j < 4; ++j) { bf16_t* o = ea.b0 + (size_t)(row0 + j) * 1024 + head * 64 + c0 + fr; o[0] = tobf(v0[j]); o[16] = tobf(v1[j]); }
    } else {
      const int d = c0 - 64 + fr;
      size_t off;
      if (row0 < TP) { int b = row0 >> 13, s = row0 & 8191; off = ((size_t)((b * 16 + head) * 64 + d)) * 8192 + s;
        uint2 pk; pk.x = pack2(v0[0], v0[1]); pk.y = pack2(v0[2], v0[3]); *(uint2*)(ea.b1 + off) = pk;
        pk.x = pack2(v1[0], v1[1]); pk.y = pack2(v1[2], v1[3]); *(uint2*)(ea.b1 + off + (size_t)16 * 8192) = pk;
      } else { int u = row0 - TP; int b = u / SPAD, s = u - b * SPAD; off = (size_t)TP * 1024 + ((size_t)((b * 16 + head) * 64 + d)) * SPAD + s;
        uint2 pk; pk.x = pack2(v0[0], v0[1]); pk.y = pack2(v0[2], v0[3]); *(uint2*)(ea.b1 + off) = pk;
        pk.x = pack2(v1[0], v1[1]); pk.y = pack2(v1[2], v1[3]); *(uint2*)(ea.b1 + off + (size_t)16 * SPAD) = pk;
      }
    }
  } else if constexpr (EPI == E_DSA) {
    if (gb < 1024) {
      const float qs = 0.125f * LOG2E;
#pragma unroll
      for (int j = 0; j < 4; ++j) { bf16_t* o = ea.b0 + (size_t)(row0 + j) * 1024 + gb + fr; o[0] = tobf(v0[j] * qs); o[16] = tobf(v1[j] * qs); }
    } else if (gb < 2048) {
      const int c = gb - 1024 + fr;
#pragma unroll
      for (int j = 0; j < 4; ++j) {
        const int row = row0 + j;
        float* o = (row < TP) ? ea.f0 + (size_t)row * 1024 + c : ea.f1 + (size_t)(row - TP) * 1024 + c;
        o[0] = v0[j]; o[16] = v1[j];
        bf16_t* ob = ea.b1 + (size_t)rowmap(row) * 1024 + c;
        ob[0] = tobf(v0[j]); ob[16] = tobf(v1[j]);
      }
    } else if (gb < 3072) {
      const int c = gb - 2048 + fr, head = c >> 6, d = c & 63;
#pragma unroll
      for (int j = 0; j < 4; ++j) {
        const int row = row0 + j;
        float* o = (row < TP) ? ea.f2 + (size_t)row * 1024 + c : ea.f3 + (size_t)(row - TP) * 1024 + c;
        o[0] = v0[j]; o[16] = v1[j];
      }
      size_t off, dstr;
      if (row0 < TP) { int b = row0 >> 13, s = row0 & 8191; off = ((size_t)((b * 16 + head) * 64 + d)) * 8192 + s; dstr = 8192; }
      else { int u = row0 - TP; int b = u >> 4, s = 1024 + (u & 15); off = (size_t)TP * 1024 + ((size_t)((b * 16 + head) * 64 + d)) * SPAD + s; dstr = SPAD; }
      uint2 pk; pk.x = pack2(v0[0], v0[1]); pk.y = pack2(v0[2], v0[3]); *(uint2*)(ea.b2 + off) = pk;
      pk.x = pack2(v1[0], v1[1]); pk.y = pack2(v1[2], v1[3]); *(uint2*)(ea.b2 + off + 16 * dstr) = pk;
    } else if (gb < 3584) {
      const int c = gb - 3072 + fr;
#pragma unroll
      for (int j = 0; j < 4; ++j) { bf16_t* o = ea.b3 + (size_t)(row0 + j) * 512 + c; o[0] = tobf(v0[j] * 0.125f); o[16] = tobf(v1[j] * 0.125f); }
    } else if (gb < 3648) {
      const int c = gb - 3584 + fr;
#pragma unroll
      for (int j = 0; j < 4; ++j) { float* o = ea.f4 + (size_t)(row0 + j) * 64 + c; o[0] = v0[j]; o[16] = v1[j]; }
    } else if (gb == 3648) {
      if (fr < 8) {
#pragma unroll
        for (int j = 0; j < 4; ++j) ea.f5[(size_t)(row0 + j) * 8 + fr] = v0[j] * 0.35355339059327379f;
      }
    }
  }
}

template <int EPI>
DI void gemm256_tile(const bf16_t* __restrict__ A, const bf16_t* __restrict__ Bt, const int K, const int brow, const int bcol,
                     const EArgs& ea, unsigned char* smem, int wv) {
  bf16_t* shm = (bf16_t*)smem;
  const int tid = ltid(wv);
#define SA(b, h) (shm + ((b) * 2 + (h)) * G_HT)
#define SB(b, h) (shm + (4 + (b) * 2 + (h)) * G_HT)
#define STAGE(P, BASE, br, kt) do { const char* _gb = (const char*)((BASE) + (long)(br) * K + (long)(kt) * 64); \
    __builtin_amdgcn_global_load_lds((const unsigned*)(_gb + voff0), (LAS unsigned*)((char*)(P) + tid * 16), 16, 0, 0); \
    __builtin_amdgcn_global_load_lds((const unsigned*)(_gb + voff1), (LAS unsigned*)((char*)(P) + tid * 16 + 8192), 16, 0, 0); } while (0)
#define LDA(dst, b, h) _Pragma("unroll") for (int m = 0; m < 4; ++m) _Pragma("unroll") for (int k = 0; k < 2; ++k) \
    dst[m][k] = *reinterpret_cast<const bf16x8*>((char*)SA(b, h) + lds_byte(wr * 64 + m * 16 + fr, k * 32 + fq * 8))
#define LDB(dst, b, h) _Pragma("unroll") for (int n = 0; n < 2; ++n) _Pragma("unroll") for (int k = 0; k < 2; ++k) \
    dst[n][k] = *reinterpret_cast<const bf16x8*>((char*)SB(b, h) + lds_byte(wc * 32 + n * 16 + fr, k * 32 + fq * 8))
#define MMA(ai, bj, At_, Bt_) do { __builtin_amdgcn_s_setprio(1); \
    _Pragma("unroll") for (int m = 0; m < 4; ++m) _Pragma("unroll") for (int n = 0; n < 2; ++n) _Pragma("unroll") for (int k = 0; k < 2; ++k) \
      acc[ai][bj][m][n] = __builtin_amdgcn_mfma_f32_16x16x32_bf16(At_[m][k], Bt_[n][k], acc[ai][bj][m][n], 0, 0, 0); \
    __builtin_amdgcn_s_setprio(0); } while (0)
#define WAIT_V(n) asm volatile("s_waitcnt vmcnt(" #n ")" ::: "memory")
#define WAIT_L(n) asm volatile("s_waitcnt lgkmcnt(" #n ")" ::: "memory")
#define BAR __builtin_amdgcn_s_barrier()
#define SCHED __builtin_amdgcn_sched_barrier(0)
  const int wid = tid >> 6, lane = tid & 63, wr = wid >> 2, wc = wid & 3, fr = lane & 15, fq = lane >> 4;
  unsigned voff0, voff1;
  { int r_, c_; stage_rc(tid * 16, r_, c_); voff0 = (unsigned)(r_ * K + c_) * 2u; stage_rc(tid * 16 + 8192, r_, c_); voff1 = (unsigned)(r_ * K + c_) * 2u; }
  f32x4v acc[2][2][4][2];
#pragma unroll
  for (int a = 0; a < 2; ++a)
#pragma unroll
    for (int b = 0; b < 2; ++b)
#pragma unroll
      for (int m = 0; m < 4; ++m)
#pragma unroll
        for (int n = 0; n < 2; ++n) acc[a][b][m][n] = (f32x4v){0.f, 0.f, 0.f, 0.f};
  bf16x8 At[4][2], B0[2][2], B1[2][2];
  const int nt = K >> 6;
  const int HALF = 128;
  WAIT_V(0); WAIT_L(0); BAR;
  STAGE(SB(0, 0), Bt, bcol, 0); STAGE(SA(0, 0), A, brow, 0);
  STAGE(SB(0, 1), Bt, bcol + HALF, 0); STAGE(SA(0, 1), A, brow + HALF, 0);
  if (wr == 1) BAR;
  WAIT_V(4); BAR;
  STAGE(SB(1, 0), Bt, bcol, 1); STAGE(SA(1, 0), A, brow, 1); STAGE(SB(1, 1), Bt, bcol + HALF, 1);
  WAIT_V(6); BAR;
  for (int t = 0; t < nt - 2; t += 2) {
    LDB(B0, 0, 0); SCHED; LDA(At, 0, 0); STAGE(SA(1, 1), A, brow + HALF, t + 1);
    WAIT_L(8); BAR; WAIT_L(0); MMA(0, 0, At, B0); BAR; SCHED;
    LDB(B1, 0, 1); STAGE(SB(0, 0), Bt, bcol, t + 2);
    BAR; WAIT_L(0); MMA(0, 1, At, B1); BAR;
    LDA(At, 0, 1); STAGE(SA(0, 0), A, brow, t + 2);
    BAR; WAIT_L(0); MMA(1, 0, At, B0); BAR; SCHED;
    STAGE(SB(0, 1), Bt, bcol + HALF, t + 2);
    WAIT_V(6); BAR; MMA(1, 1, At, B1); BAR;
    LDB(B0, 1, 0); SCHED; LDA(At, 1, 0); STAGE(SA(0, 1), A, brow + HALF, t + 2);
    WAIT_L(8); BAR; WAIT_L(0); MMA(0, 0, At, B0); BAR; SCHED;
    LDB(B1, 1, 1); STAGE(SB(1, 0), Bt, bcol, t + 3);
    BAR; WAIT_L(0); MMA(0, 1, At, B1); BAR;
    LDA(At, 1, 1); STAGE(SA(1, 0), A, brow, t + 3);
    BAR; WAIT_L(0); MMA(1, 0, At, B0); BAR; SCHED;
    STAGE(SB(1, 1), Bt, bcol + HALF, t + 3);
    WAIT_V(6); BAR; MMA(1, 1, At, B1); BAR;
  }
  { LDB(B0, 0, 0); LDA(At, 0, 0); STAGE(SA(1, 1), A, brow + HALF, nt - 1);
    BAR; WAIT_L(0); MMA(0, 0, At, B0); BAR;
    LDB(B1, 0, 1); BAR; WAIT_L(0); MMA(0, 1, At, B1); BAR;
    LDA(At, 0, 1); WAIT_V(4); BAR; WAIT_L(0); MMA(1, 0, At, B0); MMA(1, 1, At, B1); BAR; }
  { LDB(B0, 1, 0); LDA(At, 1, 0); WAIT_V(2); BAR; WAIT_L(0); MMA(0, 0, At, B0); BAR;
    LDB(B1, 1, 1); WAIT_V(0); BAR; WAIT_L(0); MMA(0, 1, At, B1); BAR;
    LDA(At, 1, 1); BAR; WAIT_L(0); MMA(1, 0, At, B0); MMA(1, 1, At, B1); BAR; }
  if (wr == 0) BAR;
#pragma unroll
  for (int ai = 0; ai < 2; ++ai)
#pragma unroll
    for (int bj = 0; bj < 2; ++bj)
#pragma unroll
      for (int m = 0; m < 4; ++m)
      { epi16<EPI>(ea, brow + ai * 128 + wr * 64 + m * 16 + fq * 4, bcol + bj * 128 + wc * 32, fr, acc[ai][bj][m][0], acc[ai][bj][m][1]); __builtin_amdgcn_sched_barrier(0); }
#undef SA
#undef SB
#undef STAGE
#undef LDA
#undef LDB
#undef MMA
#undef WAIT_V
#undef WAIT_L
#undef BAR
#undef SCHED
}

template <int EPI>
DI void gemm_phase(const bf16_t* A, const bf16_t* Bt, int M, int N, int K, const EArgs& ea,
                   unsigned char* smem, int tstart, int bid, int nblk, int wv) {
  const int nM = M >> 8, nN = N >> 8, nwg = nM * nN;
  int t0 = bid - (tstart % nblk); if (t0 < 0) t0 += nblk;
  for (int t = t0; t < nwg; t += nblk) {
    int wgid = t;
    { int q = nwg >> 3, r = nwg & 7, xcd = wgid & 7, off = wgid >> 3; wgid = (xcd < r ? xcd * (q + 1) : r * (q + 1) + (xcd - r) * q) + off; }
    const int nig = 8 * nN, gid = wgid / nig, fm = gid * 8, gsz = min(nM - fm, 8);
    const int pm = fm + ((wgid % nig) % gsz), pn = (wgid % nig) / gsz;
    gemm256_tile<EPI>(A, Bt, K, pm * 256, pn * 256, ea, smem, wv);
  }
}

DI void rmsnorm_rows(const float* __restrict__ X, const float* __restrict__ g, bf16_t* __restrict__ H, float* outp, float* outs,
                     int bid, int nblk, int wv) {
  const int lane = ltid(wv) & 63, w = ltid(wv) >> 6;
  for (int row = bid * 8 + w; row < T; row += nblk * 8) {
    const float* xr = X + (size_t)row * 1024;
    float4 v[4];
    float ss = 0.f;
#pragma unroll
    for (int c = 0; c < 4; ++c) { v[c] = *(const float4*)(xr + c * 256 + lane * 4); ss += v[c].x * v[c].x + v[c].y * v[c].y + v[c].z * v[c].z + v[c].w * v[c].w; }
    ss = wave_sum(ss, lane);
    float r = rsqrtf(ss * (1.f / 1024.f) + EPS);
#pragma unroll
    for (int c = 0; c < 4; ++c) {
      int col = c * 256 + lane * 4;
      float4 gg = *(const float4*)(g + col);
      float a = v[c].x * r * gg.x, b = v[c].y * r * gg.y, cc = v[c].z * r * gg.z, d = v[c].w * r * gg.w;
      if (H) { uint2 pk; pk.x = pack2(a, b); pk.y = pack2(cc, d); *(uint2*)(H + (size_t)row * 1024 + col) = pk; }
      else {
        float* o = (row < TP) ? outp + (size_t)row * 1024 + col : outs + (size_t)(row - TP) * 1024 + col;
        *(float4*)o = make_float4(a, b, cc, d);
      }
    }
  }
}

DI void mla_rowops(PREF p, int j, int bid, int nblk, int wv) {
  const int lane = ltid(wv) & 63, w = ltid(wv) >> 6;
  unsigned char* R = p.ws + OFF_R;
  const float* RAW = (const float*)(R + R_RAW);
  bf16_t* CQ = (bf16_t*)(R + R_CQ); bf16_t* CKV = (bf16_t*)(R + R_CKV); bf16_t* KR = (bf16_t*)(R + R_KR);
  const float* gq = p.in[11] + j * 512; const float* gkv = p.in[14] + j * 256;
  const float* rope = (const float*)(p.ws + OFF_ROPE);
  for (int row = bid * 8 + w; row < T; row += nblk * 8) {
    const float* rr = RAW + (size_t)row * 1024;
    float4 a0 = *(const float4*)(rr + lane * 4), a1 = *(const float4*)(rr + 256 + lane * 4);
    float4 c0 = *(const float4*)(rr + 512 + lane * 4);
    float ss = a0.x * a0.x + a0.y * a0.y + a0.z * a0.z + a0.w * a0.w + a1.x * a1.x + a1.y * a1.y + a1.z * a1.z + a1.w * a1.w;
    float s2 = c0.x * c0.x + c0.y * c0.y + c0.z * c0.z + c0.w * c0.w;
    ss = wave_sum(ss, lane); s2 = wave_sum(s2, lane);
    float r1 = rsqrtf(ss * (1.f / 512.f) + EPS), r2 = rsqrtf(s2 * (1.f / 256.f) + EPS);
    {
      float4 g0 = *(const float4*)(gq + lane * 4), g1 = *(const float4*)(gq + 256 + lane * 4);
      uint2 pk; pk.x = pack2(a0.x * r1 * g0.x, a0.y * r1 * g0.y); pk.y = pack2(a0.z * r1 * g0.z, a0.w * r1 * g0.w);
      *(uint2*)(CQ + (size_t)row * 512 + lane * 4) = pk;
      pk.x = pack2(a1.x * r1 * g1.x, a1.y * r1 * g1.y); pk.y = pack2(a1.z * r1 * g1.z, a1.w * r1 * g1.w);
      *(uint2*)(CQ + (size_t)row * 512 + 256 + lane * 4) = pk;
    }
    const int rm = rowmap(row);
    {
      float4 g = *(const float4*)(gkv + lane * 4);
      float4 o = make_float4(c0.x * r2 * g.x, c0.y * r2 * g.y, c0.z * r2 * g.z, c0.w * r2 * g.w);
      float* op = (row < TP) ? p.out + O_CKVP + ((size_t)j * TP + row) * 256 : p.out + O_CKVS + ((size_t)j * TS + (row - TP)) * 256;
      *(float4*)(op + lane * 4) = o;
      uint2 pk; pk.x = pack2(o.x, o.y); pk.y = pack2(o.z, o.w);
      *(uint2*)(CKV + (size_t)rm * 256 + lane * 4) = pk;
    }
    if (lane < 16) {
      float x1 = rr[768 + lane], x2 = rr[784 + lane];
      int pos = tokpos(row);
      float2 cs = *(const float2*)(rope + ((size_t)pos * 16 + lane) * 2);
      float o1 = x1 * cs.x - x2 * cs.y, o2 = x1 * cs.y + x2 * cs.x;
      float* op = (row < TP) ? p.out + O_KRP + ((size_t)j * TP + row) * 32 : p.out + O_KRS + ((size_t)j * TS + (row - TP)) * 32;
      op[lane] = o1; op[16 + lane] = o2;
      KR[(size_t)rm * 32 + lane] = tobf(o1); KR[(size_t)rm * 32 + 16 + lane] = tobf(o2);
    }
  }
}

DI void dsa_rowops(PREF p, int bid, int nblk, int wv) {
  const int lane = ltid(wv) & 63, w = ltid(wv) >> 6;
  unsigned char* R = p.ws + OFF_R;
  const float* KIR = (const float*)(R + D_KIR);
  bf16_t* KI = (bf16_t*)(R + D_KI);
  const float* g = p.in[27];
  for (int row = bid * 8 + w; row < T; row += nblk * 8) {
    float v = KIR[(size_t)row * 64 + lane];
    float ss = wave_sum(v * v, lane);
    float r = rsqrtf(ss * (1.f / 64.f) + EPS);
    float o = v * r * g[lane];
    if (row < TP) p.out[O_DIP + (size_t)row * 64 + lane] = o; else p.out[O_DIS + (size_t)(row - TP) * 64 + lane] = o;
    KI[(size_t)rowmap(row) * 64 + lane] = tobf(o);
  }
}

DI void cmlp_ln_rows(PREF p, int bid, int nblk, int wv) {
  const int lane = ltid(wv) & 63, w = ltid(wv) >> 6;
  unsigned char* R = p.ws + OFF_R;
  const bf16_t* VR = (const bf16_t*)(R + C_VR);
  bf16_t* VLN = (bf16_t*)(R + C_VLN);
  const float* g = p.in[18]; const float* bb = p.in[19];
  for (int row = bid * 8 + w; row < T; row += nblk * 8) {
    float x[32];
    float sum = 0.f;
#pragma unroll
    for (int c = 0; c < 4; ++c) {
      uint4 u = *(const uint4*)(VR + (size_t)row * 2048 + c * 512 + lane * 8);
      x[c * 8 + 0] = bflo(u.x); x[c * 8 + 1] = bfhi(u.x); x[c * 8 + 2] = bflo(u.y); x[c * 8 + 3] = bfhi(u.y);
      x[c * 8 + 4] = bflo(u.z); x[c * 8 + 5] = bfhi(u.z); x[c * 8 + 6] = bflo(u.w); x[c * 8 + 7] = bfhi(u.w);
    }
#pragma unroll
    for (int i = 0; i < 32; ++i) sum += x[i];
    sum = wave_sum(sum, lane);
    float mu = sum * (1.f / 2048.f);
    float vs = 0.f;
#pragma unroll
    for (int i = 0; i < 32; ++i) { x[i] -= mu; vs += x[i] * x[i]; }
    vs = wave_sum(vs, lane);
    float r = rsqrtf(vs * (1.f / 2048.f) + EPS);
#pragma unroll
    for (int c = 0; c < 4; ++c) {
      int col = c * 512 + lane * 8;
      float y[8];
#pragma unroll
      for (int q = 0; q < 2; ++q) {
        float4 gg = *(const float4*)(g + col + q * 4), b4 = *(const float4*)(bb + col + q * 4);
        y[q * 4 + 0] = x[c * 8 + q * 4 + 0] * r * gg.x + b4.x; y[q * 4 + 1] = x[c * 8 + q * 4 + 1] * r * gg.y + b4.y;
        y[q * 4 + 2] = x[c * 8 + q * 4 + 2] * r * gg.z + b4.z; y[q * 4 + 3] = x[c * 8 + q * 4 + 3] * r * gg.w + b4.w;
      }
      uint4 pk; pk.x = pack2(y[0], y[1]); pk.y = pack2(y[2], y[3]); pk.z = pack2(y[4], y[5]); pk.w = pack2(y[6], y[7]);
      *(uint4*)(VLN + (size_t)row * 2048 + col) = pk;
      if (row >= TP) {
        float* o = p.out + O_CVS + (size_t)(row - TP) * 2048 + col;
        *(float4*)o = make_float4(y[0], y[1], y[2], y[3]); *(float4*)(o + 4) = make_float4(y[4], y[5], y[6], y[7]);
      }
    }
  }
}

DI void cmlp_mix_phase(PREF p, unsigned char* smem, int bid, int nblk, int wv) {
  const int tid = ltid(wv), lane = tid & 63, w = tid >> 6, wm = w >> 2, wn = w & 3, lr = lane & 31, lh = lane >> 5;
  unsigned char* R = p.ws + OFF_R;
  const bf16_t* U = (const bf16_t*)(R + C_U);
  const bf16_t* VLN = (const bf16_t*)(R + C_VLN);
  bf16_t* G = (bf16_t*)(R + C_G);
  const bf16_t* WT = (const bf16_t*)(p.ws + OFF_W) + W_TRIL;
  const float* bs = p.in[21];
  bf16_t* As = (bf16_t*)smem;
  bf16_t* Bs = As + 128 * 136;
  for (int u = bid; u < 1024; u += nblk) {
    const int g = u & 7, ch = u >> 3;
    const int col0 = g * 256;
#pragma unroll 2
    for (int i = 0; i < 4; ++i) {
      int v = tid + i * NT; int r = v >> 4, c = (v & 15) * 8;
      *(uint4*)(As + r * 136 + c) = *(const uint4*)(WT + ((size_t)g * 128 + r) * 128 + c);
    }
#pragma unroll 2
    for (int i = 0; i < 8; ++i) {
      int v = tid + i * NT; int s = v >> 5, c = (v & 31) * 8;
      uint4 x = *(const uint4*)(VLN + ((size_t)ch * 128 + s) * 2048 + col0 + c);
      Bs[(c + 0) * 136 + s] = (bf16_t)(x.x & 0xffff); Bs[(c + 1) * 136 + s] = (bf16_t)(x.x >> 16);
      Bs[(c + 2) * 136 + s] = (bf16_t)(x.y & 0xffff); Bs[(c + 3) * 136 + s] = (bf16_t)(x.y >> 16);
      Bs[(c + 4) * 136 + s] = (bf16_t)(x.z & 0xffff); Bs[(c + 5) * 136 + s] = (bf16_t)(x.z >> 16);
      Bs[(c + 6) * 136 + s] = (bf16_t)(x.w & 0xffff); Bs[(c + 7) * 136 + s] = (bf16_t)(x.w >> 16);
    }
    __syncthreads();
    f32x16 acc[2][2];
#pragma unroll
    for (int a = 0; a < 2; ++a)
#pragma unroll
      for (int b = 0; b < 2; ++b)
#pragma unroll
        for (int i = 0; i < 16; ++i) acc[a][b][i] = 0.f;
    const bf16_t* Asb = As + (wm * 64 + lr) * 136 + lh * 8;
    const bf16_t* Bsb = Bs + (wn * 64 + lr) * 136 + lh * 8;
    const int ns = (wm + 1) * 4;
    for (int s = 0; s < ns; ++s) {
      bf16x8 a0 = *(const bf16x8*)(Asb + s * 16);
      bf16x8 a1 = *(const bf16x8*)(Asb + 32 * 136 + s * 16);
      bf16x8 b0 = *(const bf16x8*)(Bsb + s * 16);
      bf16x8 b1 = *(const bf16x8*)(Bsb + 32 * 136 + s * 16);
      acc[0][0] = MFMA32(a0, b0, acc[0][0]);
      acc[0][1] = MFMA32(a0, b1, acc[0][1]);
      acc[1][0] = MFMA32(a1, b0, acc[1][0]);
      acc[1][1] = MFMA32(a1, b1, acc[1][1]);
    }
#pragma unroll
    for (int mi = 0; mi < 2; ++mi)
#pragma unroll
      for (int ni = 0; ni < 2; ++ni)
#pragma unroll
        for (int i = 0; i < 16; ++i) {
          int t = wm * 64 + mi * 32 + crow(i, lh);
          int col = col0 + wn * 64 + ni * 32 + lr;
          size_t off = ((size_t)ch * 128 + t) * 2048 + col;
          float mixed = acc[mi][ni][i] + bs[g * 128 + t];
          G[off] = tobf(frombf(U[off]) * mixed);
        }
    __syncthreads();
  }
  const float* wsf = p.in[20];
  for (int e = bid * NT + tid; e < TS * 2048; e += nblk * NT) {
    int row = e >> 11, col = e & 2047, b = row >> 4, t = row & 15, g = col >> 8;
    float a = bs[g * 128 + t];
    for (int s = 0; s <= t; ++s) a += wsf[((size_t)g * 128 + t) * 128 + s] * frombf(VLN[((size_t)TP + b * 16 + s) * 2048 + col]);
    size_t off = ((size_t)TP + row) * 2048 + col;
    G[off] = tobf(frombf(U[off]) * a);
  }
}

template <int DQK, bool IS_MLA>
DI void attn_unit(const bf16_t* __restrict__ Qp, int ldq, int nq,
                  const bf16_t* __restrict__ Kp, int ldk, const bf16_t* __restrict__ KRp,
                  const bf16_t* __restrict__ Vtp, int ldv,
                  int nkt, int nkt_w, int nkeys, const unsigned* __restrict__ BMp,
                  bf16_t* __restrict__ AOp, unsigned char* smem_half, int wv) {
  constexpr int KS = DQK + 8;
  constexpr int VS = 68;
  constexpr int NQS = DQK / 16;
  const int tid = ltid(wv) & 255, lane = tid & 63, w = tid >> 6, lr = lane & 31, lh = lane >> 5;
  bf16_t* Ks = (bf16_t*)smem_half;
  bf16_t* Vs = Ks + 2 * 64 * KS;
  const bool q_ok = (w * 32 + lr) < nq;
  const int qrow = q_ok ? (w * 32 + lr) : 0;
  bf16x8 qf[NQS];
#pragma unroll
  for (int s = 0; s < NQS; ++s) qf[s] = *(const bf16x8*)(Qp + (size_t)qrow * ldq + s * 16 + lh * 8);
  f32x16 oacc[2];
#pragma unroll
  for (int d = 0; d < 2; ++d)
#pragma unroll
    for (int i = 0; i < 16; ++i) oacc[d][i] = 0.f;
  float m_run = -INFINITY, l_run = 0.f;
  const int kkey = tid >> 3, kc = (tid & 7) * 8;
  const int rkey = tid >> 2, rc = (tid & 3) * 8;
  const int vd = tid >> 3, vk = (tid & 7) * 8;
  uint4 rk[2], rr, rv[2];
  rr = make_uint4(0, 0, 0, 0);
  auto gload = [&](int kt) {
    const int key0 = kt * 64;
#pragma unroll
    for (int i = 0; i < 2; ++i) rk[i] = *(const uint4*)(Kp + (size_t)(key0 + kkey + 32 * i) * ldk + kc);
    if constexpr (IS_MLA) rr = *(const uint4*)(KRp + (size_t)(key0 + rkey) * 32 + rc);
#pragma unroll
    for (int i = 0; i < 2; ++i) rv[i] = *(const uint4*)(Vtp + (size_t)(vd + 32 * i) * ldv + key0 + vk);
  };
  auto sstore = [&](int buf) {
    bf16_t* Kb = Ks + buf * 64 * KS; bf16_t* Vb = Vs + buf * 64 * VS;
#pragma unroll
    for (int i = 0; i < 2; ++i) *(uint4*)(Kb + (kkey + 32 * i) * KS + kc) = rk[i];
    if constexpr (IS_MLA) *(uint4*)(Kb + rkey * KS + 64 + rc) = rr;
#pragma unroll
    for (int i = 0; i < 2; ++i) {
      uint2 lo = make_uint2(rv[i].x, rv[i].y), hi = make_uint2(rv[i].z, rv[i].w);
      *(uint2*)(Vb + (vd + 32 * i) * VS + vk) = lo;
      *(uint2*)(Vb + (vd + 32 * i) * VS + vk + 4) = hi;
    }
  };
  __syncthreads();
  gload(0); sstore(0);
  __syncthreads();
  for (int kt = 0; kt < nkt; ++kt) {
    const int buf = kt & 1;
    if (kt + 1 < nkt) gload(kt + 1);
    if (kt < nkt_w) {
      const bf16_t* Kb = Ks + buf * 64 * KS; const bf16_t* Vb = Vs + buf * 64 * VS;
      uint2 bmw = make_uint2(0xffffffffu, 0xffffffffu);
      if (BMp) bmw = *(const uint2*)(BMp + (size_t)qrow * 256 + kt * 2);
      f32x16 sacc[2];
#pragma unroll
      for (int mt = 0; mt < 2; ++mt) {
#pragma unroll
        for (int i = 0; i < 16; ++i) sacc[mt][i] = 0.f;
#pragma unroll
        for (int s = 0; s < NQS; ++s) {
          bf16x8 kf = *(const bf16x8*)(Kb + (mt * 32 + lr) * KS + s * 16 + lh * 8);
          sacc[mt] = MFMA32(kf, qf[s], sacc[mt]);
        }
      }
      float mx = -INFINITY;
#pragma unroll
      for (int mt = 0; mt < 2; ++mt) {
        const unsigned wbits = mt ? bmw.y : bmw.x;
#pragma unroll
        for (int i = 0; i < 16; ++i) {
          const int kin = crow(i, lh);
          const int key = kt * 64 + mt * 32 + kin;
          bool ok = (key < nkeys) && ((wbits >> kin) & 1u);
          float sv = ok ? sacc[mt][i] : -INFINITY;
          sacc[mt][i] = sv;
          mx = fmaxf(mx, sv);
        }
      }
      mx = fmaxf(mx, shflx(mx, 32, lane));
      const float m_new = fmaxf(m_run, mx);
      const float m_safe = (m_new == -INFINITY) ? 0.f : m_new;
      const float alpha = exp2f(m_run - m_safe);
      m_run = m_new;
      float ls = 0.f;
#pragma unroll
      for (int mt = 0; mt < 2; ++mt)
#pragma unroll
        for (int i = 0; i < 16; ++i) { float pv = exp2f(sacc[mt][i] - m_safe); sacc[mt][i] = pv; ls += pv; }
      l_run = l_run * alpha + ls;
#pragma unroll
      for (int d = 0; d < 2; ++d)
#pragma unroll
        for (int i = 0; i < 16; ++i) oacc[d][i] *= alpha;
#pragma unroll
      for (int mt = 0; mt < 2; ++mt)
#pragma unroll
        for (int s = 0; s < 2; ++s) {
          uint4 pp;
          pp.x = pack2(sacc[mt][8 * s + 0], sacc[mt][8 * s + 1]);
          pp.y = pack2(sacc[mt][8 * s + 2], sacc[mt][8 * s + 3]);
          pp.z = pack2(sacc[mt][8 * s + 4], sacc[mt][8 * s + 5]);
          pp.w = pack2(sacc[mt][8 * s + 6], sacc[mt][8 * s + 7]);
          bf16x8 pf = __builtin_bit_cast(bf16x8, pp);
#pragma unroll
          for (int dt = 0; dt < 2; ++dt) {
            const bf16_t* vrow = Vb + (dt * 32 + lr) * VS + mt * 32 + 16 * s + 4 * lh;
            uint2 lo = *(const uint2*)(vrow), hi = *(const uint2*)(vrow + 8);
            uint4 vv = make_uint4(lo.x, lo.y, hi.x, hi.y);
            bf16x8 vf = __builtin_bit_cast(bf16x8, vv);
            oacc[dt] = MFMA32(vf, pf, oacc[dt]);
          }
        }
    }
    if (kt + 1 < nkt) sstore(buf ^ 1);
    __syncthreads();
  }
  if (nkt_w > 0) {
    float lt = l_run + shflx(l_run, 32, lane);
    float inv = lt > 0.f ? 1.f / lt : 0.f;
    if (q_ok) {
      bf16_t* orow = AOp + (size_t)(w * 32 + lr) * 1024;
#pragma unroll
      for (int dt = 0; dt < 2; ++dt)
#pragma unroll
        for (int g = 0; g < 4; ++g) {
          uint2 pk;
          pk.x = pack2(oacc[dt][4 * g] * inv, oacc[dt][4 * g + 1] * inv);
          pk.y = pack2(oacc[dt][4 * g + 2] * inv, oacc[dt][4 * g + 3] * inv);
          *(uint2*)(orow + dt * 32 + 8 * g + 4 * lh) = pk;
        }
    }
  }
}


DI int snake_idx(int i, int bid, int nblk) { return i * nblk + ((i & 1) ? (nblk - 1 - bid) : bid); }

template <bool IS_MLA>
DI void attn_phase(PREF p, unsigned char* smem, int bid, int nblk, int wv) {
  unsigned char* R = p.ws + OFF_R;
  const int tl = ltid(wv);
  const int hf = tl >> 8, w = (tl >> 6) & 3;
  unsigned char* smh = smem + hf * 45056;
  const int total = 1024 + 256;
  for (int i = 0; i * nblk < total; ++i) {
    int pu = snake_idx(i, bid, nblk);
    if (pu >= total) continue;
    if constexpr (IS_MLA) {
      const bf16_t* Q = (const bf16_t*)(R + R_Q); const bf16_t* KN = (const bf16_t*)(R + R_KN);
      const bf16_t* KR = (const bf16_t*)(R + R_KR); const bf16_t* VT = (const bf16_t*)(R + R_VT);
      bf16_t* AO = (bf16_t*)(R + R_RAW);
      if (pu < 1024) {
        int qt = 63 - (pu >> 4), bh = (pu & 15) * 2 + hf, b = bh >> 4, h = bh & 15;
        int q0 = b * 8192 + qt * 128;
        attn_unit<96, true>(Q + (size_t)q0 * 1536 + h * 96, 1536, 128,
                            KN + (size_t)(b * 8192) * 1024 + h * 64, 1024, KR + (size_t)(b * 8192) * 32,
                            VT + (size_t)((b * 16 + h) * 64) * 8192, 8192,
                            2 * qt + 2, 2 * qt + 1 + (w >> 1), 1 << 30, nullptr,
                            AO + (size_t)q0 * 1024 + h * 64, smh, wv);
      } else {
        int u = (pu - 1024) * 2 + hf, b = u >> 4, h = u & 15;
        int q0 = TP + b * 16;
        attn_unit<96, true>(Q + (size_t)q0 * 1536 + h * 96, 1536, 16,
                            KN + (size_t)(TP + b * SPAD) * 1024 + h * 64, 1024, KR + (size_t)(TP + b * SPAD) * 32,
                            VT + (size_t)TP * 1024 + (size_t)((b * 16 + h) * 64) * SPAD, SPAD,
                            17, (w == 0) ? 17 : 0, NKS, nullptr,
                            AO + (size_t)q0 * 1024 + h * 64, smh, wv);
      }
    } else {
      const bf16_t* Q = (const bf16_t*)(R + D_Q); const bf16_t* KK = (const bf16_t*)(R + D_K);
      const bf16_t* VT = (const bf16_t*)(R + D_VT); const unsigned* BM = (const unsigned*)(R + D_BM);
      bf16_t* AO = (bf16_t*)(R + D_AO);
      if (pu < 1024) {
        int qt = 63 - (pu >> 4), bh = (pu & 15) * 2 + hf, b = bh >> 4, h = bh & 15;
        int q0 = b * 8192 + qt * 128;
        attn_unit<64, false>(Q + (size_t)q0 * 1024 + h * 64, 1024, 128,
                             KK + (size_t)(b * 8192) * 1024 + h * 64, 1024, nullptr,
                             VT + (size_t)((b * 16 + h) * 64) * 8192, 8192,
                             2 * qt + 2, 2 * qt + 1 + (w >> 1), 1 << 30, BM + (size_t)q0 * 256,
                             AO + (size_t)q0 * 1024 + h * 64, smh, wv);
      } else {
        int u = (pu - 1024) * 2 + hf, b = u >> 4, h = u & 15;
        int q0 = TP + b * 16;
        attn_unit<64, false>(Q + (size_t)q0 * 1024 + h * 64, 1024, 16,
                             KK + (size_t)(TP + b * SPAD) * 1024 + h * 64, 1024, nullptr,
                             VT + (size_t)TP * 1024 + (size_t)((b * 16 + h) * 64) * SPAD, SPAD,
                             17, (w == 0) ? 17 : 0, NKS, BM + (size_t)q0 * 256,
                             AO + (size_t)q0 * 1024 + h * 64, smh, wv);
      }
    }
  }
}

constexpr int CAP = 128;
DI int score_bin(float s) {
  unsigned u = __float_as_uint(s);
  int e = (int)((u & 0x7fffffffu) >> 19);
  int m = min(max(e, 1840), 2095) - 1840;
  return (u >> 31) ? (255 - m) : (256 + m);
}

DI void idx_unit(const bf16_t* __restrict__ QI, const float* __restrict__ WI, int q_row0, int nq,
                 const bf16_t* __restrict__ KI, int L, unsigned* __restrict__ BM, unsigned char* smem, int wv) {
  const int tid = ltid(wv), lane = tid & 63, w = tid >> 6, lr = lane & 31, lh = lane >> 5;
  bf16_t* Qs = (bf16_t*)smem;
  float* Ws = (float*)(smem + 36864);
  unsigned* hist = (unsigned*)(smem + 36864 + 1024);
  float* cand_s = (float*)hist;
  int* cand_i = (int*)(smem + 36864 + 1024 + 16384);
  int* bstar = (int*)(smem + 36864 + 1024 + 32768);
  int* need = bstar + 32;
  int* ncand = need + 32;
  __syncthreads();
#pragma unroll
  for (int i = 0; i < 4; ++i) {
    int v = tid + i * NT;
    int hd = v >> 8, q = (v >> 3) & 31, c = (v & 7) * 8;
    int qq = q < nq ? q : 0;
    *(uint4*)(Qs + (hd * 32 + q) * 72 + c) = *(const uint4*)(QI + (size_t)(q_row0 + qq) * 512 + hd * 64 + c);
  }
  if (tid < 256) { int hd = tid >> 5, q = tid & 31; int qq = q < nq ? q : 0; Ws[hd * 32 + q] = WI[(size_t)(q_row0 + qq) * 8 + hd]; }
  for (int i = tid; i < 32 * 256; i += NT) hist[i] = 0u;
  if (tid < 32) { bstar[tid] = -1; need[tid] = 0; ncand[tid] = 0; }
  __syncthreads();
  const int ntile = (L + 255) >> 8;
  const bool do_select = L > 256;
  for (int pass = do_select ? 0 : 1; pass < 2; ++pass) {
    for (int kt = 0; kt < ntile; ++kt) {
      const int key0 = kt * 256 + w * 32;
      if (key0 < L) {
        const int key = key0 + lr;
        bf16x8 kf[4];
#pragma unroll
        for (int s = 0; s < 4; ++s) kf[s] = *(const bf16x8*)(KI + (size_t)key * 64 + s * 16 + lh * 8);
        float sc[16];
#pragma unroll
        for (int i = 0; i < 16; ++i) sc[i] = 0.f;
#pragma unroll 1
        for (int hd = 0; hd < 8; ++hd) {
          f32x16 acc;
#pragma unroll
          for (int i = 0; i < 16; ++i) acc[i] = 0.f;
#pragma unroll
          for (int s = 0; s < 4; ++s) {
            bf16x8 qf = *(const bf16x8*)(Qs + (hd * 32 + lr) * 72 + s * 16 + lh * 8);
            acc = MFMA32(qf, kf[s], acc);
          }
#pragma unroll
          for (int g = 0; g < 4; ++g) {
            float4 wv = *(const float4*)(Ws + hd * 32 + 8 * g + 4 * lh);
            sc[4 * g + 0] += wv.x * fmaxf(acc[4 * g + 0], 0.f);
            sc[4 * g + 1] += wv.y * fmaxf(acc[4 * g + 1], 0.f);
            sc[4 * g + 2] += wv.z * fmaxf(acc[4 * g + 2], 0.f);
            sc[4 * g + 3] += wv.w * fmaxf(acc[4 * g + 3], 0.f);
          }
        }
        const bool kvalid = key < L;
        if (pass == 0) {
#pragma unroll
          for (int i = 0; i < 16; ++i) {
            int q = crow(i, lh);
            if (kvalid) { int b = score_bin(sc[i]); atomicAdd(&hist[q * 256 + (b >> 1)], (b & 1) ? 65536u : 1u); }
          }
        } else {
#pragma unroll
          for (int i = 0; i < 16; ++i) {
            int q = crow(i, lh);
            int b = score_bin(sc[i]);
            int bs = bstar[q];
            bool sel = kvalid && (b > bs);
            bool cnd = kvalid && (b == bs);
            unsigned long long bal = __ballot(sel);
            if (lr == 0 && q < nq) BM[(size_t)(q_row0 + q) * 256 + (key0 >> 5)] = (unsigned)(bal >> (32 * lh));
            if (cnd) {
              int pos = atomicAdd(&ncand[q], 1);
              if (pos < CAP) { cand_s[q * CAP + pos] = sc[i]; cand_i[q * CAP + pos] = key; }
            }
          }
        }
      }
    }
    __syncthreads();
    if (pass == 0) {
      for (int qi = 0; qi < 4; ++qi) {
        const int q = w * 4 + qi;
        unsigned hw[4];
#pragma unroll
        for (int k = 0; k < 4; ++k) hw[k] = hist[q * 256 + 255 - 4 * lane - k];
        int cnt = 0;
#pragma unroll
        for (int k = 0; k < 4; ++k) cnt += (int)(hw[k] >> 16) + (int)(hw[k] & 0xffffu);
        int pre = cnt;
#pragma unroll
        for (int o = 1; o < 64; o <<= 1) { int t = __builtin_amdgcn_ds_bpermute(((lane - o) & 63) << 2, pre); if (lane >= o) pre += t; }
        unsigned long long bal = __ballot(pre >= 256);
        if (bal != 0ull) {
          int fl = __ffsll((long long)bal) - 1;
          if (lane == fl) {
            int running = pre - cnt;
            int bsel = -1, above = 0;
#pragma unroll
            for (int k = 0; k < 4; ++k) {
              int chi = (int)(hw[k] >> 16), clo = (int)(hw[k] & 0xffffu);
              if (bsel < 0) { if (running + chi >= 256) { bsel = 511 - 8 * lane - 2 * k; above = running; } else running += chi; }
              if (bsel < 0) { if (running + clo >= 256) { bsel = 510 - 8 * lane - 2 * k; above = running; } else running += clo; }
            }
            bstar[q] = bsel; need[q] = 256 - above;
          }
        }
      }
      __syncthreads();
    }
  }
  __threadfence();
  __syncthreads();
  if (do_select) {
    for (int pi = tid; pi < 32 * CAP; pi += NT) {
      int q = pi / CAP, c = pi - q * CAP;
      int n = min(ncand[q], CAP);
      if (c < n && q < nq) {
        float sv = cand_s[q * CAP + c]; int iv = cand_i[q * CAP + c];
        int rank = 0;
        for (int j = 0; j < n; ++j) {
          float sj = cand_s[q * CAP + j]; int ij = cand_i[q * CAP + j];
          rank += (sj > sv || (sj == sv && ij < iv)) ? 1 : 0;
        }
        if (rank < need[q]) atomicOr(&BM[(size_t)(q_row0 + q) * 256 + (iv >> 5)], 1u << (iv & 31));
      }
    }
  }
  __syncthreads();
}

DI void idx_phase(PREF p, unsigned char* smem, int bid, int nblk, int wv) {
  unsigned char* R = p.ws + OFF_R;
  const bf16_t* QI = (const bf16_t*)(R + D_QI); const float* WI = (const float*)(R + D_WI);
  const bf16_t* KI = (const bf16_t*)(R + D_KI); unsigned* BM = (unsigned*)(R + D_BM);
  const int total = 512 + 32;
  for (int i = 0; i * nblk < total; ++i) {
    int idx = snake_idx(i, bid, nblk);
    if (idx >= total) continue;
    if (idx < 512) {
      int qt = 255 - (idx >> 1), b = idx & 1;
      int L = (((qt * 32) >> 6) + 1) * 64;
      idx_unit(QI, WI, b * 8192 + qt * 32, 32, KI + (size_t)(b * 8192) * 64, L, BM, smem, wv);
    } else {
      int b = idx - 512;
      idx_unit(QI, WI, TP + b * 16, 16, KI + (size_t)(TP + b * SPAD) * 64, NKS, BM, smem, wv);
    }
  }
}

DI void cvt8(const float* s, bf16_t* d) {
  float4 a = *(const float4*)s, b = *(const float4*)(s + 4);
  uint4 pk; pk.x = pack2(a.x, a.y); pk.y = pack2(a.z, a.w); pk.z = pack2(b.x, b.y); pk.w = pack2(b.z, b.w);
  *(uint4*)d = pk;
}
DI void cache_rows(const float* __restrict__ src, bf16_t* __restrict__ dst, int Wd, int bid, int nblk, int wv) {
  const int vpr = Wd >> 3;
  const size_t total = (size_t)32 * SPAD * vpr;
  for (size_t e = (size_t)bid * NT + ltid(wv); e < total; e += (size_t)nblk * NT) {
    int c = (int)(e % vpr) * 8; size_t rw = e / vpr; int b = (int)(rw / SPAD), s = (int)(rw % SPAD);
    bf16_t* d = dst + ((size_t)TP + (size_t)b * SPAD + s) * Wd + c;
    if (s < 1024) cvt8(src + ((size_t)b * 1024 + s) * Wd + c, d);
    else if (s >= NKS) { unsigned z = 0; asm volatile("" : "+v"(z)); *(uint4*)d = make_uint4(z, z, z, z); }
  }
}


#define XB_TMO      128
#define XB_XCNT(j)  (256  + 64 * (j))
#define XB_XSUB(j)  (1280 + 64 * (j))
#define XB_XGEN(j)  (2304 + 64 * (j))
#define XB_TOP      3328
#define XB_TOPGEN   3392
#define XCD_BAR_WORDS 3456
#define XB_SPIN_CAP (1u << 18)
DI unsigned xb_ld(unsigned* p)              { return __hip_atomic_load(p, __ATOMIC_RELAXED, __HIP_MEMORY_SCOPE_AGENT); }
DI unsigned xb_add(unsigned* p, unsigned v) { return __hip_atomic_fetch_add(p, v, __ATOMIC_RELAXED, __HIP_MEMORY_SCOPE_AGENT); }
DI unsigned xb_xcc_id() { return (unsigned)__builtin_amdgcn_s_getreg((3 << 11) | 20) & 0xFu; }
#define XB_SPIN(cond, bar) do { unsigned _sp = 0; while (cond) { __builtin_amdgcn_s_sleep(1); \
    if ((++_sp & 255u) == 0u) { if (xb_ld(&(bar)[XB_TMO])) break; if (_sp > XB_SPIN_CAP) { atomicAdd(&(bar)[XB_TMO], 1u); break; } } } } while (0)
struct XcdBarrier { unsigned* bar; unsigned x; volatile __attribute__((address_space(3))) unsigned* st; };
DI void xcd_barrier_complete(unsigned* bar, unsigned x, unsigned G, unsigned& nloc, unsigned& nx) {
  unsigned sum, cnt, mine, sp = 0u;
  for (;;) {
    sum = 0u; cnt = 0u; mine = 0u;
#pragma unroll
    for (unsigned j = 0; j < 16; ++j) { const unsigned c = xb_ld(&bar[XB_XCNT(j)]); sum += c; cnt += (c > 0u) ? 1u : 0u; mine = (j == x) ? c : mine; }
    if (sum == G) break;
    __builtin_amdgcn_s_sleep(1);
    if ((++sp & 255u) == 0u) { if (xb_ld(&bar[XB_TMO])) break; if (sp > XB_SPIN_CAP) { atomicAdd(&bar[XB_TMO], 1u); break; } }
  }
  nloc = mine > 0u ? mine : 1u; nx = cnt > 0u ? cnt : 1u;
}
DI void xcd_barrier(const XcdBarrier& b, int tid, unsigned G) {
  asm volatile("s_waitcnt vmcnt(0)" ::: "memory");
  __syncthreads();
  if (tid == 0) {
    unsigned* bar = b.bar;
    __builtin_amdgcn_s_waitcnt(0);
    unsigned nloc = b.st[0], nx = b.st[1];
    if (nloc == 0u) { xcd_barrier_complete(bar, b.x, G, nloc, nx); b.st[0] = nloc; b.st[1] = nx; }
    const unsigned old = xb_add(&bar[XB_XSUB(b.x)], 1u);
    const unsigned gen = old / nloc;
    if (old + 1u == (gen + 1u) * nloc) {
      __builtin_amdgcn_fence(__ATOMIC_RELEASE, "agent");
      asm volatile("s_waitcnt vmcnt(0)" ::: "memory");
      const unsigned og = xb_add(&bar[XB_TOP], 1u);
      const unsigned tg = og / nx;
      if (og + 1u == (tg + 1u) * nx) xb_add(&bar[XB_TOPGEN], 1u);
      else XB_SPIN(xb_ld(&bar[XB_TOPGEN]) == tg, bar);
      __builtin_amdgcn_fence(__ATOMIC_ACQUIRE, "agent");
      xb_add(&bar[XB_XGEN(b.x)], 1u);
      asm volatile("s_waitcnt vmcnt(0)" ::: "memory");
    } else {
      XB_SPIN(xb_ld(&bar[XB_XGEN(b.x)]) == gen, bar);
      __builtin_amdgcn_fence(__ATOMIC_ACQUIRE, "agent");
      asm volatile("s_waitcnt vmcnt(0)" ::: "memory");
    }
  }
  __syncthreads();
}

extern "C" __global__ void __launch_bounds__(512, 2) mega(Params p_unused) {
  extern __shared__ __attribute__((aligned(16))) unsigned char smem[];
  cg::grid_group grid = cg::this_grid();
  const int bid = blockIdx.x, nblk = gridDim.x;
  const int wv = __builtin_amdgcn_readfirstlane((int)(threadIdx.x >> 6));
  CParams* pk = (CParams*)__builtin_amdgcn_kernarg_segment_ptr();
  const int ph_lo = pk->ph_lo, ph_hi = pk->ph_hi;
  int ph = 0;
  XcdBarrier xb;
  {
    volatile __attribute__((address_space(3))) unsigned* st = (volatile __attribute__((address_space(3))) unsigned*)(smem + 131072);
    const int t0 = ltid(wv);
    if (t0 == 0) { st[0] = 0u; st[1] = 0u; }
    __syncthreads();
    xb.bar = (unsigned*)(pk->ws + OFF_BAR); xb.x = xb_xcc_id(); xb.st = st;
    if (t0 == 0) (void)xb_add(&xb.bar[XB_XCNT(xb.x)], 1u);
  }
#ifndef REPMASK
#define REPMASK 0u
#endif
#ifndef PMASK
#define PMASK 0xffffffffu
#endif
#define PHASE_BEGIN(k) if (ph >= ph_lo && ph < ph_hi) { if constexpr ((PMASK >> (k)) & 1u) for (int rep_ = 0; rep_ < 1 + (int)((REPMASK >> (k)) & 1u); ++rep_) { \
    CParams* pp_ = pk; asm volatile("" : "+s"(pp_)); PREF p = *pp_; const int tid = ltid(wv); \
    unsigned char* ws = p.ws; float* X = (float*)(ws + OFF_X); bf16_t* H = (bf16_t*)(ws + OFF_H); bf16_t* Wb = (bf16_t*)(ws + OFF_W); \
    float* ROPE = (float*)(ws + OFF_ROPE); unsigned char* R = ws + OFF_R; (void)tid; (void)X; (void)H; (void)Wb; (void)ROPE; (void)R;
#define PHASE_END   } if (ph + 1 < ph_hi) { if (ph == 0) grid.sync(); else xcd_barrier(xb, ltid(wv), (unsigned)nblk); } } ++ph;

  PHASE_BEGIN(0)
    {
      const int hf = tid >> 8, tl = tid & 255;
      float* smh = (float*)smem + hf * 4224;
      for (int t0 = bid * 2; t0 < p.total_tiles; t0 += nblk * 2) {
        const int t = t0 + hf;
        const bool active = t < p.total_tiles;
        const int tt = active ? t : 0;
        int ji = 0;
#pragma unroll 1
        for (int q = 1; q < NJOBS; ++q) if (tt >= p.jobs[q].tile0) ji = q;
        const CAS Job& jb = p.jobs[ji];
        int lt = tt - jb.tile0; int nkt = jb.k >> 6; int nt_ = lt / nkt, kt_ = lt - nt_ * nkt;
        transpose_tile(jb.src, jb.nsrc, jb.nsrc, jb.dst, jb.k, nt_ * 64, kt_ * 64, jb.mode, smh, tl, active);
      }
    }
    {
      const size_t n4p = (size_t)TP * 256, n4 = (size_t)T * 256;
      const float4* xp = (const float4*)p.in[0]; const float4* xs = (const float4*)p.in[1];
      for (size_t e = (size_t)bid * NT + tid; e < n4; e += (size_t)nblk * NT) ((float4*)X)[e] = (e < n4p) ? xp[e] : xs[e - n4p];
      for (int e = bid * NT + tid; e < 8192 * 16; e += nblk * NT) {
        int pos = e >> 4, i = e & 15;
        double rev = (double)pos * p.inv_freq[i] * 0.15915494309189535;
        rev -= floor(rev);
        float fr = (float)rev;
        ROPE[2 * e] = __builtin_amdgcn_cosf(fr); ROPE[2 * e + 1] = __builtin_amdgcn_sinf(fr);
      }
      const float* wsrc = p.in[20];
      for (int e = bid * NT + tid; e < 8 * 128 * 128; e += nblk * NT) {
        int s = e & 127, t = (e >> 7) & 127;
        Wb[W_TRIL + e] = tobf(s <= t ? wsrc[e] : 0.f);
      }
    }
  PHASE_END

#pragma unroll 1
  for (int L = 0; L < 4; ++L) {
    const int kind = L % 3, j = L / 3;
    if (kind == 0) {
      PHASE_BEGIN(1)
        rmsnorm_rows(X, p.in[7] + L * 1024, H, nullptr, nullptr, bid, nblk, wv);
        cache_rows(p.in[2] + (size_t)j * 32 * 1024 * 256, (bf16_t*)(R + R_CKV), 256, bid, nblk, wv);
        cache_rows(p.in[3] + (size_t)j * 32 * 1024 * 32, (bf16_t*)(R + R_KR), 32, bid, nblk, wv);
      PHASE_END
      PHASE_BEGIN(2)
        EArgs ea{}; ea.f0 = (float*)(R + R_RAW);
        gemm_phase<E_F32>(H, Wb + W_MLA + (size_t)j * WM_SZ + WM_D, T, 1024, 1024, ea, smem, 0, bid, nblk, wv);
      PHASE_END
      PHASE_BEGIN(3)
        mla_rowops(p, j, bid, nblk, wv);
      PHASE_END
      PHASE_BEGIN(4)
        EArgs ea{}; ea.b0 = (bf16_t*)(R + R_Q); ea.rope = ROPE;
        gemm_phase<E_MLAQ>((const bf16_t*)(R + R_CQ), Wb + W_MLA + (size_t)j * WM_SZ + WM_UQ, T, 1536, 512, ea, smem, 0, bid, nblk, wv);
        EArgs eb{}; eb.b0 = (bf16_t*)(R + R_KN); eb.b1 = (bf16_t*)(R + R_VT);
        gemm_phase<E_MLAKV>((const bf16_t*)(R + R_CKV), Wb + W_MLA + (size_t)j * WM_SZ + WM_UKV, KROWS, 2048, 256, eb, smem, (T / 256) * 6, bid, nblk, wv);
      PHASE_END
      PHASE_BEGIN(5)
        attn_phase<true>(p, smem, bid, nblk, wv);
      PHASE_END
      PHASE_BEGIN(6)
        EArgs ea{}; ea.f0 = X;
        gemm_phase<E_RESID>((const bf16_t*)(R + R_RAW), Wb + W_MLA + (size_t)j * WM_SZ + WM_O, T, 1024, 1024, ea, smem, 0, bid, nblk, wv);
      PHASE_END
    } else if (kind == 1) {
      PHASE_BEGIN(1)
        rmsnorm_rows(X, p.in[7] + L * 1024, H, nullptr, nullptr, bid, nblk, wv);
      PHASE_END
      PHASE_BEGIN(7)
        EArgs ea{}; ea.b0 = (bf16_t*)(R + C_U); ea.b1 = (bf16_t*)(R + C_VR);
        gemm_phase<E_GELU>(H, Wb + W_CM + WC_IN, T, 4096, 1024, ea, smem, 0, bid, nblk, wv);
      PHASE_END
      PHASE_BEGIN(8)
        cmlp_ln_rows(p, bid, nblk, wv);
      PHASE_END
      PHASE_BEGIN(9)
        cmlp_mix_phase(p, smem, bid, nblk, wv);
      PHASE_END
      PHASE_BEGIN(6)
        EArgs ea{}; ea.f0 = X;
        gemm_phase<E_RESID>((const bf16_t*)(R + C_G), Wb + W_CM + WC_OUT, T, 1024, 2048, ea, smem, 0, bid, nblk, wv);
      PHASE_END
    } else {
      PHASE_BEGIN(10)
        rmsnorm_rows(X, p.in[7] + L * 1024, H, nullptr, nullptr, bid, nblk, wv);
        cache_rows(p.in[4], (bf16_t*)(R + D_K), 1024, bid, nblk, wv);
        cache_rows(p.in[6], (bf16_t*)(R + D_KI), 64, bid, nblk, wv);
        {
          bf16_t* VTs = (bf16_t*)(R + D_VT) + (size_t)TP * 1024;
          {
            const int hf = tid >> 8, tl = tid & 255;
            float* smh = (float*)smem + hf * 4224;
            for (int u0 = bid * 2; u0 < 512 * 16; u0 += nblk * 2) {
              const int u = u0 + hf;
              int st = u & 15, bh = u >> 4, b = bh >> 4, h = bh & 15;
              transpose_tile(p.in[5] + (size_t)b * 1024 * 1024 + h * 64, 1024, 64, VTs + (size_t)(bh * 64) * SPAD, SPAD, 0, st * 64, 0, smh, tl, true);
            }
          }
          for (int e = bid * NT + tid; e < 512 * 64 * 12; e += nblk * NT) {
            int c = e % 12, rw = e / 12;
            { unsigned z = 0; asm volatile("" : "+v"(z)); *(uint2*)(VTs + (size_t)rw * SPAD + NKS + c * 4) = make_uint2(z, z); }
          }
        }
      PHASE_END
      PHASE_BEGIN(11)
        EArgs ea{};
        ea.f0 = p.out + O_DKP; ea.f1 = p.out + O_DKS; ea.f2 = p.out + O_DVP; ea.f3 = p.out + O_DVS;
        ea.f4 = (float*)(R + D_KIR); ea.f5 = (float*)(R + D_WI);
        ea.b0 = (bf16_t*)(R + D_Q); ea.b1 = (bf16_t*)(R + D_K); ea.b2 = (bf16_t*)(R + D_VT); ea.b3 = (bf16_t*)(R + D_QI);
        gemm_phase<E_DSA>(H, Wb + W_DS + WD_P, T, 3840, 1024, ea, smem, 0, bid, nblk, wv);
      PHASE_END
      PHASE_BEGIN(12)
        dsa_rowops(p, bid, nblk, wv);
      PHASE_END
      PHASE_BEGIN(13)
        idx_phase(p, smem, bid, nblk, wv);
      PHASE_END
      PHASE_BEGIN(14)
        attn_phase<false>(p, smem, bid, nblk, wv);
      PHASE_END
      PHASE_BEGIN(6)
        EArgs ea{}; ea.f0 = X;
        gemm_phase<E_RESID>((const bf16_t*)(R + D_AO), Wb + W_DS + WD_O, T, 1024, 1024, ea, smem, 0, bid, nblk, wv);
      PHASE_END
    }
    PHASE_BEGIN(1)
      rmsnorm_rows(X, p.in[8] + L * 1024, H, nullptr, nullptr, bid, nblk, wv);
    PHASE_END
    PHASE_BEGIN(15)
      EArgs ea{}; ea.b0 = (bf16_t*)(R + 0);
      gemm_phase<E_SWIGLU>(H, Wb + W_FF + (size_t)L * WF_SZ + WF_IN, T, 2 * DFF, 1024, ea, smem, 0, bid, nblk, wv);
    PHASE_END
    PHASE_BEGIN(6)
      EArgs ea{}; ea.f0 = X;
      gemm_phase<E_RESID>((const bf16_t*)(R + 0), Wb + W_FF + (size_t)L * WF_SZ + WF_OUT, T, 1024, DFF, ea, smem, 0, bid, nblk, wv);
    PHASE_END
  }
  PHASE_BEGIN(1)
    rmsnorm_rows(X, p.in[9], nullptr, p.out + O_YP, p.out + O_YS, bid, nblk, wv);
  PHASE_END
}

extern "C" void kernel_launch(void* const* d_in, const int* in_sizes, int n_in,
                              void* d_out, int out_size, void* d_ws, size_t ws_size,
                              hipStream_t stream) {
  constexpr int kLds = 128 * 1024 + 64;
  static int grid_blocks = 0;
  if (!grid_blocks) {
    int dev = 0, cus = 0, per_cu = 0;
    (void)hipGetDevice(&dev);
    (void)hipDeviceGetAttribute(&cus, hipDeviceAttributeMultiprocessorCount, dev);
    (void)hipFuncSetAttribute((const void*)mega, hipFuncAttributeMaxDynamicSharedMemorySize, kLds);
    (void)hipOccupancyMaxActiveBlocksPerMultiprocessor(&per_cu, (const void*)mega, NT, kLds);
    if (per_cu < 1) per_cu = 1;
    if (per_cu > 1) per_cu = 1;
    grid_blocks = cus * per_cu;
    fprintf(stderr, "grid %d (cus %d per_cu %d) ws %zu need %zu out %d need %zu\n", grid_blocks, cus, per_cu, ws_size, (size_t)WS_NEED, out_size, (size_t)O_END);
  }
  if (ws_size < WS_NEED || n_in != 31 || (size_t)out_size != O_END) { fprintf(stderr, "kernel_launch: bad sizes\n"); return; }
  Params p;
  memset(&p, 0, sizeof(p));
  for (int i = 0; i < 31; ++i) p.in[i] = (const float*)d_in[i];
  p.out = (float*)d_out; p.ws = (unsigned char*)d_ws;
  bf16_t* Wb = (bf16_t*)((unsigned char*)d_ws + OFF_W);
  int nj = 0, tiles = 0;
  auto add = [&](const float* src, int nsrc, int k, bf16_t* dst, int ndst, int mode) {
    Job& jb = p.jobs[nj++]; jb.src = src; jb.dst = dst; jb.nsrc = nsrc; jb.k = k; jb.ndst = ndst; jb.mode = mode; jb.tile0 = tiles; jb.pad = 0;
    tiles += (ndst / 64) * (k / 64);
  };
  for (int j = 0; j < 2; ++j) {
    bf16_t* Wm = Wb + W_MLA + (size_t)j * WM_SZ;
    add(p.in[10] + (size_t)j * 1024 * 512, 512, 1024, Wm + WM_D, 512, 0);
    add(p.in[13] + (size_t)j * 1024 * 288, 288, 1024, Wb + W_MLA + (size_t)j * WM_SZ + WM_D + (size_t)512 * 1024, 512, 0);
    add(p.in[12] + (size_t)j * 512 * 1536, 1536, 512, Wb + W_MLA + (size_t)j * WM_SZ + WM_UQ, 1536, 0);
    add(p.in[15] + (size_t)j * 256 * 2048, 2048, 256, Wb + W_MLA + (size_t)j * WM_SZ + WM_UKV, 2048, 0);
    add(p.in[16] + (size_t)j * 1024 * 1024, 1024, 1024, Wb + W_MLA + (size_t)j * WM_SZ + WM_O, 1024, 0);
  }
  add(p.in[17], 4096, 1024, Wb + W_CM + WC_IN, 4096, 0);
  add(p.in[22], 1024, 2048, Wb + W_CM + WC_OUT, 1024, 0);
  add(p.in[23], 3072, 1024, Wb + W_DS + WD_P, 3072, 0);
  add(p.in[25], 512, 1024, Wb + W_DS + WD_P + (size_t)3072 * 1024, 512, 0);
  add(p.in[26], 64, 1024, Wb + W_DS + WD_P + (size_t)3584 * 1024, 64, 0);
  add(p.in[28], 8, 1024, Wb + W_DS + WD_P + (size_t)3648 * 1024, 192, 0);
  add(p.in[24], 1024, 1024, Wb + W_DS + WD_O, 1024, 0);
  for (int i = 0; i < 4; ++i) {
    add(p.in[29] + (size_t)i * 1024 * 5632, 5632, 1024, Wb + W_FF + (size_t)i * WF_SZ + WF_IN, 5632, 1);
    add(p.in[30] + (size_t)i * 2816 * 1024, 1024, 2816, Wb + W_FF + (size_t)i * WF_SZ + WF_OUT, 1024, 0);
  }
  p.total_tiles = tiles;
  for (int i = 0; i < 16; ++i) p.inv_freq[i] = pow(10000.0, -(double)i / 16.0);
  p.ph_lo = 0; p.ph_hi = 1000;
  (void)hipMemsetAsync((unsigned char*)d_ws + OFF_BAR, 0, 16384, stream);
  void* args[] = {&p};
  hipError_t e = hipLaunchCooperativeKernel((const void*)mega, dim3(grid_blocks), dim3(NT), args, kLds, stream);
  if (e != hipSuccess) fprintf(stderr, "coop launch failed: %s\n", hipGetErrorString(e));
}
```

```cpp
#include <hip/hip_runtime.h>
#include <hip/hip_cooperative_groups.h>
#include <cstdio>
#include <cstring>
#include <cmath>
namespace cg = cooperative_groups;

typedef unsigned short bf16_t;
using bf16x8 = __attribute__((ext_vector_type(8))) short;
using f32x16 = __attribute__((ext_vector_type(16))) float;
using f32x2v = __attribute__((ext_vector_type(2))) float;
using bf2v = __attribute__((ext_vector_type(2))) __bf16;
#define DI __device__ __forceinline__
#define MFMA32(a, b, c) __builtin_amdgcn_mfma_f32_32x32x16_bf16((a), (b), (c), 0, 0, 0)

constexpr int TP = 16384, TS = 512, T = TP + TS;
constexpr int NT = 512;
constexpr int SPAD = 1088, NKS = 1040;
constexpr int KROWS = TP + 32 * SPAD;
constexpr int DFF = 2816;
constexpr float LOG2E = 1.4426950408889634f;
constexpr float EPS = 1e-6f;

constexpr size_t OFF_X = 0;
constexpr size_t OFF_H = OFF_X + (size_t)T * 1024 * 4;
constexpr size_t OFF_W = OFF_H + (size_t)T * 1024 * 2;
constexpr size_t W_ELEMS = 52822016;
constexpr size_t OFF_ROPE = OFF_W + W_ELEMS * 2;
constexpr size_t OFF_R = OFF_ROPE + (size_t)8192 * 16 * 2 * 4;
constexpr size_t R_RAW = 0;
constexpr size_t R_CQ = R_RAW + (size_t)T * 1024 * 4;
constexpr size_t R_CKV = R_CQ + (size_t)T * 512 * 2;
constexpr size_t R_KR = R_CKV + (size_t)KROWS * 256 * 2;
constexpr size_t R_Q = R_KR + (size_t)KROWS * 32 * 2;
constexpr size_t R_KN = R_Q + (size_t)T * 1536 * 2;
constexpr size_t R_VT = R_KN + (size_t)KROWS * 1024 * 2;
constexpr size_t R_END = R_VT + (size_t)KROWS * 1024 * 2;
constexpr size_t D_Q = 0;
constexpr size_t D_K = D_Q + (size_t)T * 1024 * 2;
constexpr size_t D_VT = D_K + (size_t)KROWS * 1024 * 2;
constexpr size_t D_QI = D_VT + (size_t)KROWS * 1024 * 2;
constexpr size_t D_KIR = D_QI + (size_t)T * 512 * 2;
constexpr size_t D_KI = D_KIR + (size_t)T * 64 * 4;
constexpr size_t D_WI = D_KI + (size_t)KROWS * 64 * 2;
constexpr size_t D_BM = D_WI + (size_t)T * 8 * 4;
constexpr size_t D_AO = D_BM + (size_t)T * 256 * 4;
constexpr size_t D_END = D_AO + (size_t)T * 1024 * 2;
constexpr size_t C_U = 0;
constexpr size_t C_VR = C_U + (size_t)T * 2048 * 2;
constexpr size_t C_VLN = C_VR + (size_t)T * 2048 * 2;
constexpr size_t C_G = C_VLN + (size_t)T * 2048 * 2;
constexpr size_t C_END = C_G + (size_t)T * 2048 * 2;
constexpr size_t OFF_BAR = OFF_R + R_END;
constexpr size_t WS_NEED = OFF_BAR + 16384;
static_assert(D_END <= R_END && C_END <= R_END && (size_t)T * DFF * 2 <= R_END, "region");

constexpr size_t W_MLA = 0;
constexpr size_t WM_D = 0, WM_UQ = 1048576, WM_UKV = WM_UQ + 786432, WM_O = WM_UKV + 524288, WM_SZ = 3407872;
constexpr size_t W_CM = 2 * WM_SZ;
constexpr size_t WC_IN = 0, WC_OUT = 4194304, WC_SZ = 6291456;
constexpr size_t W_DS = W_CM + WC_SZ;
constexpr size_t WD_P = 0, WD_O = 3932160, WD_SZ = 4980736;
constexpr size_t W_FF = W_DS + WD_SZ;
constexpr size_t WF_IN = 0, WF_OUT = 5767168, WF_SZ = 8650752;
constexpr size_t W_TRIL = W_FF + 4 * WF_SZ;
static_assert(W_TRIL + 131072 == W_ELEMS, "w");

constexpr size_t O_YP = 0;
constexpr size_t O_YS = O_YP + (size_t)TP * 1024;
constexpr size_t O_CKVP = O_YS + (size_t)TS * 1024;
constexpr size_t O_KRP = O_CKVP + (size_t)2 * TP * 256;
constexpr size_t O_CKVS = O_KRP + (size_t)2 * TP * 32;
constexpr size_t O_KRS = O_CKVS + (size_t)2 * TS * 256;
constexpr size_t O_CVS = O_KRS + (size_t)2 * TS * 32;
constexpr size_t O_DKP = O_CVS + (size_t)TS * 2048;
constexpr size_t O_DVP = O_DKP + (size_t)TP * 1024;
constexpr size_t O_DIP = O_DVP + (size_t)TP * 1024;
constexpr size_t O_DKS = O_DIP + (size_t)TP * 64;
constexpr size_t O_DVS = O_DKS + (size_t)TS * 1024;
constexpr size_t O_DIS = O_DVS + (size_t)TS * 1024;
constexpr size_t O_END = O_DIS + (size_t)TS * 64;

constexpr int NJOBS = 25;
struct Job { const float* src; bf16_t* dst; int nsrc, k, ndst, mode, tile0, pad; };
struct Params {
  const float* in[31];
  float* out;
  unsigned char* ws;
  Job jobs[NJOBS];
  int total_tiles, ph_lo, ph_hi, pad;
  double inv_freq[16];
};

#define CAS __attribute__((address_space(4)))
typedef const CAS Params CParams;
#define PREF const CAS Params&
DI unsigned pack2(float a, float b) { f32x2v v = {a, b}; bf2v r = __builtin_convertvector(v, bf2v); return __builtin_bit_cast(unsigned, r); }
DI bf16_t tobf(float a) { return (bf16_t)(pack2(a, 0.f) & 0xffffu); }
DI float frombf(bf16_t v) { return __uint_as_float(((unsigned)v) << 16); }
DI float bflo(unsigned u) { return __uint_as_float(u << 16); }
DI float bfhi(unsigned u) { return __uint_as_float(u & 0xffff0000u); }
DI float shflx(float v, int m, int lane) { return __int_as_float(__builtin_amdgcn_ds_bpermute((lane ^ m) << 2, __float_as_int(v))); }
DI float wave_sum(float v, int lane) {
#pragma unroll
  for (int o = 32; o >= 1; o >>= 1) v += shflx(v, o, lane);
  return v;
}
DI int ltid(int wv) { unsigned m1 = ~0u; asm volatile("" : "+s"(m1)); int t = (wv << 6) | (int)__builtin_amdgcn_mbcnt_hi(m1, __builtin_amdgcn_mbcnt_lo(m1, 0u)); asm volatile("" : "+v"(t)); return t; }
DI int crow(int i, int h) { return (i & 3) + 8 * (i >> 2) + 4 * h; }
DI int rowmap(int t) { if (t < TP) return t; int u = t - TP; return TP + (u >> 4) * SPAD + 1024 + (u & 15); }
DI int tokpos(int t) { return t < TP ? (t & 8191) : 1024 + ((t - TP) & 15); }

DI void transpose_tile(const float* __restrict__ src, int src_ld, int ncols, bf16_t* __restrict__ dst, int dst_ld,
                       int n0, int k0, int mode, float* sm, int tid, bool active) {
  const int nl = tid & 63, kq = tid >> 6;
  const int n = n0 + nl;
  int c;
  if (mode == 0) c = n < ncols ? n : -1;
  else { int tt = n >> 5, r = n & 31; int f = tt * 16 + (r & 15); c = (r < 16) ? f : DFF + f; }
  if (active) {
#pragma unroll 4
    for (int i = 0; i < 16; ++i) {
      int kk = kq + 4 * i;
      float v = (c >= 0) ? src[(size_t)(k0 + kk) * src_ld + c] : 0.f;
      sm[kk * 65 + nl] = v;
    }
  }
  __syncthreads();
  if (active) {
    const int kp = (tid & 31) * 2, nr = tid >> 5;
#pragma unroll 4
    for (int i = 0; i < 8; ++i) {
      int nn = nr + 8 * i;
      float a = sm[kp * 65 + nn], b = sm[(kp + 1) * 65 + nn];
      *(unsigned*)(dst + (size_t)(n0 + nn) * dst_ld + k0 + kp) = pack2(a, b);
    }
  }
  __syncthreads();
}

enum { E_F32 = 0, E_RESID, E_SWIGLU, E_GELU, E_MLAQ, E_MLAKV, E_DSA };
struct EArgs {
  float* f0; float* f1; float* f2; float* f3; float* f4; float* f5; float* f6;
  bf16_t* b0; bf16_t* b1; bf16_t* b2; bf16_t* b3;
  const float* rope;
};
using f32x4v = __attribute__((ext_vector_type(4))) float;
#define LAS __attribute__((address_space(3)))
constexpr int G_HT = 128 * 64;
DI int lds_byte(int r, int c) {
  int st = (r >> 4) * 2 + (c >> 5), rr = r & 15, cc = c & 31, ob = rr * 64 + cc * 2;
  return st * 1024 + (ob ^ (((ob >> 9) & 1) << 5));
}
DI void stage_rc(int b, int& R, int& C) {
  int st = b >> 10, sb = b & 1023, swz = sb ^ (((sb >> 9) & 1) << 5);
  R = (st >> 1) * 16 + (swz >> 6); C = (st & 1) * 32 + ((swz & 63) >> 1);
}

template <int EPI, bool ATOM>
DI void epi16(const EArgs& ea, int row0, int gb, int fr, const f32x4v& v0, const f32x4v& v1) {
  if constexpr (EPI == E_F32) {
#pragma unroll
    for (int j = 0; j < 4; ++j) { float* o = ea.f0 + (size_t)(row0 + j) * 1024 + gb + fr; o[0] = v0[j]; o[16] = v1[j]; }
  } else if constexpr (EPI == E_RESID) {
#pragma unroll
    for (int j = 0; j < 4; ++j) { float* o = ea.f0 + (size_t)(row0 + j) * 1024 + gb + fr;
      if constexpr (ATOM) { unsafeAtomicAdd(o, v0[j]); unsafeAtomicAdd(o + 16, v1[j]); } else { o[0] += v0[j]; o[16] += v1[j]; } }
  } else if constexpr (EPI == E_SWIGLU) {
    const int f = (gb >> 1) + fr;
#pragma unroll
    for (int j = 0; j < 4; ++j) { float g = v0[j], u = v1[j]; ea.b0[(size_t)(row0 + j) * DFF + f] = tobf(g / (1.f + __expf(-g)) * u); }
  } else if constexpr (EPI == E_GELU) {
    bf16_t* dstp = (gb < 2048) ? (ea.b0 + gb + fr) : (ea.b1 + (gb - 2048) + fr);
#pragma unroll
    for (int j = 0; j < 4; ++j) {
      float x = v0[j], y = v1[j];
      dstp[(size_t)(row0 + j) * 2048] = tobf(0.5f * x * (1.f + erff(x * 0.70710678118654752f)));
      dstp[(size_t)(row0 + j) * 2048 + 16] = tobf(0.5f * y * (1.f + erff(y * 0.70710678118654752f)));
    }
  } else if constexpr (EPI == E_MLAQ) {
    const float qs = 0.10206207261596577f * LOG2E;
    const bool is_rope = (gb % 96) == 64;
#pragma unroll
    for (int j = 0; j < 4; ++j) {
      const int row = row0 + j;
      float o0 = v0[j], o1 = v1[j];
      if (is_rope) {
        float2 cs = *(const float2*)(ea.rope + ((size_t)tokpos(row) * 16 + fr) * 2);
        o0 = v0[j] * cs.x - v1[j] * cs.y; o1 = v0[j] * cs.y + v1[j] * cs.x;
      }
      bf16_t* o = ea.b0 + (size_t)row * 1536 + gb + fr;
      o[0] = tobf(o0 * qs); o[16] = tobf(o1 * qs);
    }
  } else if constexpr (EPI == E_MLAKV) {
    const int head = gb >> 7, c0 = gb & 127;
    if (c0 < 64) {
#pragma unroll
      for (int j = 0; j < 4; ++j) { bf16_t* o = ea.b0 + (size_t)(row0 + j) * 1024 + head * 64 + c0 + fr; o[0] = tobf(v0[j]); o[16] = tobf(v1[j]); }
    } else {
      const int d = c0 - 64 + fr;
      size_t off;
      if (row0 < TP) { int b = row0 >> 13, s = row0 & 8191; off = ((size_t)((b * 16 + head) * 64 + d)) * 8192 + s;
        uint2 pk; pk.x = pack2(v0[0], v0[1]); pk.y = pack2(v0[2], v0[3]); *(uint2*)(ea.b1 + off) = pk;
        pk.x = pack2(v1[0], v1[1]); pk.y = pack2(v1[2], v1[3]); *(uint2*)(ea.b1 + off + (size_t)16 * 8192) = pk;
      } else { int u = row0 - TP; int b = u / SPAD, s = u - b * SPAD; off = (size_t)TP * 1024 + ((size_t)((b * 16 + head) * 64 + d)) * SPAD + s;
        uint2 pk; pk.x = pack2(v0[0], v0[1]); pk.y = pack2(v0[2], v0[3]); *(uint2*)(ea.b1 + off) = pk;
        pk.x = pack2(v1[0], v1[1]); pk.y = pack2(v1[2], v1[3]); *(uint2*)(ea.b1 + off + (size_t)16 * SPAD) = pk;
      }
    }
  } else if constexpr (EPI == E_DSA) {
    if (gb < 1024) {
      const float qs = 0.125f * LOG2E;
#pragma unroll
      for (int j = 0; j < 4; ++j) { bf16_t* o = ea.b0 + (size_t)(row0 + j) * 1024 + gb + fr; o[0] = tobf(v0[j] * qs); o[16] = tobf(v1[j] * qs); }
    } else if (gb < 2048) {
      const int c = gb - 1024 + fr;
#pragma unroll
      for (int j = 0; j < 4; ++j) {
        const int row = row0 + j;
        float* o = (row < TP) ? ea.f0 + (size_t)row * 1024 + c : ea.f1 + (size_t)(row - TP) * 1024 + c;
        o[0] = v0[j]; o[16] = v1[j];
        bf16_t* ob = ea.b1 + (size_t)rowmap(row) * 1024 + c;
        ob[0] = tobf(v0[j]); ob[16] = tobf(v1[j]);
      }
    } else if (gb < 3072) {
      const int c = gb - 2048 + fr, head = c >> 6, d = c & 63;
#pragma unroll
      for (int j = 0; j < 4; ++j) {
        const int row = row0 + j;
        float* o = (row < TP) ? ea.f2 + (size_t)row * 1024 + c : ea.f3 + (size_t)(row - TP) * 1024 + c;
        o[0] = v0[j]; o[16] = v1[j];
      }
      size_t off, dstr;
      if (row0 < TP) { int b = row0 >> 13, s = row0 & 8191; off = ((size_t)((b * 16 + head) * 64 + d)) * 8192 + s; dstr = 8192; }
      else { int u = row0 - TP; int b = u >> 4, s = 1024 + (u & 15); off = (size_t)TP * 1024 + ((size_t)((b * 16 + head) * 64 + d)) * SPAD + s; dstr = SPAD; }
      uint2 pk; pk.x = pack2(v0[0], v0[1]); pk.y = pack2(v0[2], v0[3]); *(uint2*)(ea.b2 + off) = pk;
      pk.x = pack2(v1[0], v1[1]); pk.y = pack2(v1[2], v1[3]); *(uint2*)(ea.b2 + off + 16 * dstr) = pk;
    } else if (gb < 3584) {
      const int c = gb - 3072 + fr;
#pragma unroll
      for (int j = 0; j < 4; ++j) { bf16_t* o = ea.b3 + (size_t)(row0 + j) * 512 + c; o[0] = tobf(v0[j] * 0.125f); o[16] = tobf(v1[j] * 0.125f); }
    } else if (gb < 3648) {
      const int c = gb - 3584 + fr;
#pragma unroll
      for (int j = 0; j < 4; ++j) { float* o = ea.f4 + (size_t)(row0 + j) * 64 + c; o[0] = v0[j]; o[16] = v1[j]; }
    } else if (gb == 3648) {
      if (fr < 8) {
#pragma unroll
        for (int j = 0; j < 4; ++j) ea.f5[(size_t)(row0 + j) * 8 + fr] = v0[j] * 0.35355339059327379f;
      }
    }
  }
}

template <int EPI, bool ATOM>
DI void gemm256_tile(const bf16_t* __restrict__ A, const bf16_t* __restrict__ Bt, const int K, const int kt0, const int nt, const int brow, const int bcol,
                     const EArgs& ea, unsigned char* smem, int wv) {
  bf16_t* shm = (bf16_t*)smem;
  const int tid = ltid(wv);
#define SA(b, h) (shm + ((b) * 2 + (h)) * G_HT)
#define SB(b, h) (shm + (4 + (b) * 2 + (h)) * G_HT)
#define STAGE(P, BASE, br, kt) do { const char* _gb = (const char*)((BASE) + (long)(br) * K + (long)((kt) + kt0) * 64); \
    __builtin_amdgcn_global_load_lds((const unsigned*)(_gb + voff0), (LAS unsigned*)((char*)(P) + tid * 16), 16, 0, 0); \
    __builtin_amdgcn_global_load_lds((const unsigned*)(_gb + voff1), (LAS unsigned*)((char*)(P) + tid * 16 + 8192), 16, 0, 0); } while (0)
#define LDA(dst, b, h) _Pragma("unroll") for (int m = 0; m < 4; ++m) _Pragma("unroll") for (int k = 0; k < 2; ++k) \
    dst[m][k] = *reinterpret_cast<const bf16x8*>((char*)SA(b, h) + lds_byte(wr * 64 + m * 16 + fr, k * 32 + fq * 8))
#define LDB(dst, b, h) _Pragma("unroll") for (int n = 0; n < 2; ++n) _Pragma("unroll") for (int k = 0; k < 2; ++k) \
    dst[n][k] = *reinterpret_cast<const bf16x8*>((char*)SB(b, h) + lds_byte(wc * 32 + n * 16 + fr, k * 32 + fq * 8))
#define MMA(ai, bj, At_, Bt_) do { __builtin_amdgcn_s_setprio(1); \
    _Pragma("unroll") for (int m = 0; m < 4; ++m) _Pragma("unroll") for (int n = 0; n < 2; ++n) _Pragma("unroll") for (int k = 0; k < 2; ++k) \
      acc[ai][bj][m][n] = __builtin_amdgcn_mfma_f32_16x16x32_bf16(At_[m][k], Bt_[n][k], acc[ai][bj][m][n], 0, 0, 0); \
    __builtin_amdgcn_s_setprio(0); } while (0)
#define WAIT_V(n) asm volatile("s_waitcnt vmcnt(" #n ")" ::: "memory")
#define WAIT_L(n) asm volatile("s_waitcnt lgkmcnt(" #n ")" ::: "memory")
#define BAR __builtin_amdgcn_s_barrier()
#define SCHED __builtin_amdgcn_sched_barrier(0)
  const int wid = tid >> 6, lane = tid & 63, wr = wid >> 2, wc = wid & 3, fr = lane & 15, fq = lane >> 4;
  unsigned voff0, voff1;
  { int r_, c_; stage_rc(tid * 16, r_, c_); voff0 = (unsigned)(r_ * K + c_) * 2u; stage_rc(tid * 16 + 8192, r_, c_); voff1 = (unsigned)(r_ * K + c_) * 2u; }
  f32x4v acc[2][2][4][2];
#pragma unroll
  for (int a = 0; a < 2; ++a)
#pragma unroll
    for (int b = 0; b < 2; ++b)
#pragma unroll
      for (int m = 0; m < 4; ++m)
#pragma unroll
        for (int n = 0; n < 2; ++n) acc[a][b][m][n] = (f32x4v){0.f, 0.f, 0.f, 0.f};
  bf16x8 At[4][2], B0[2][2], B1[2][2];
  const int HALF = 128;
  WAIT_V(0); WAIT_L(0); BAR;
  STAGE(SB(0, 0), Bt, bcol, 0); STAGE(SA(0, 0), A, brow, 0);
  STAGE(SB(0, 1), Bt, bcol + HALF, 0); STAGE(SA(0, 1), A, brow + HALF, 0);
  if (wr == 1) BAR;
  WAIT_V(4); BAR;
  STAGE(SB(1, 0), Bt, bcol, 1); STAGE(SA(1, 0), A, brow, 1); STAGE(SB(1, 1), Bt, bcol + HALF, 1);
  WAIT_V(6); BAR;
  for (int t = 0; t < nt - 2; t += 2) {
    LDB(B0, 0, 0); SCHED; LDA(At, 0, 0); STAGE(SA(1, 1), A, brow + HALF, t + 1);
    WAIT_L(8); BAR; WAIT_L(0); MMA(0, 0, At, B0); BAR; SCHED;
    LDB(B1, 0, 1); STAGE(SB(0, 0), Bt, bcol, t + 2);
    BAR; WAIT_L(0); MMA(0, 1, At, B1); BAR;
    LDA(At, 0, 1); STAGE(SA(0, 0), A, brow, t + 2);
    BAR; WAIT_L(0); MMA(1, 0, At, B0); BAR; SCHED;
    STAGE(SB(0, 1), Bt, bcol + HALF, t + 2);
    WAIT_V(6); BAR; MMA(1, 1, At, B1); BAR;
    LDB(B0, 1, 0); SCHED; LDA(At, 1, 0); STAGE(SA(0, 1), A, brow + HALF, t + 2);
    WAIT_L(8); BAR; WAIT_L(0); MMA(0, 0, At, B0); BAR; SCHED;
    LDB(B1, 1, 1); STAGE(SB(1, 0), Bt, bcol, t + 3);
    BAR; WAIT_L(0); MMA(0, 1, At, B1); BAR;
    LDA(At, 1, 1); STAGE(SA(1, 0), A, brow, t + 3);
    BAR; WAIT_L(0); MMA(1, 0, At, B0); BAR; SCHED;
    STAGE(SB(1, 1), Bt, bcol + HALF, t + 3);
    WAIT_V(6); BAR; MMA(1, 1, At, B1); BAR;
  }
  { LDB(B0, 0, 0); LDA(At, 0, 0); STAGE(SA(1, 1), A, brow + HALF, nt - 1);
    BAR; WAIT_L(0); MMA(0, 0, At, B0); BAR;
    LDB(B1, 0, 1); BAR; WAIT_L(0); MMA(0, 1, At, B1); BAR;
    LDA(At, 0, 1); WAIT_V(4); BAR; WAIT_L(0); MMA(1, 0, At, B0); MMA(1, 1, At, B1); BAR; }
  { LDB(B0, 1, 0); LDA(At, 1, 0); WAIT_V(2); BAR; WAIT_L(0); MMA(0, 0, At, B0); BAR;
    LDB(B1, 1, 1); WAIT_V(0); BAR; WAIT_L(0); MMA(0, 1, At, B1); BAR;
    LDA(At, 1, 1); BAR; WAIT_L(0); MMA(1, 0, At, B0); MMA(1, 1, At, B1); BAR; }
  if (wr == 0) BAR;
#pragma unroll
  for (int ai = 0; ai < 2; ++ai)
#pragma unroll
    for (int bj = 0; bj < 2; ++bj)
#pragma unroll
      for (int m = 0; m < 4; ++m)
      { epi16<EPI, ATOM>(ea, brow + ai * 128 + wr * 64 + m * 16 + fq * 4, bcol + bj * 128 + wc * 32, fr, acc[ai][bj][m][0], acc[ai][bj][m][1]); __builtin_amdgcn_sched_barrier(0); }
#undef SA
#undef SB
#undef STAGE
#undef LDA
#undef LDB
#undef MMA
#undef WAIT_V
#undef WAIT_L
#undef BAR
#undef SCHED
}

DI void tile_map(int t, int nM, int nN, int nwg, int& pm, int& pn) {
  int wgid = t;
  { int q = nwg >> 3, r = nwg & 7, xcd = wgid & 7, off = wgid >> 3; wgid = (xcd < r ? xcd * (q + 1) : r * (q + 1) + (xcd - r) * q) + off; }
  const int nig = 8 * nN, gid = wgid / nig, fm = gid * 8, gsz = min(nM - fm, 8);
  pm = fm + ((wgid % nig) % gsz); pn = (wgid % nig) / gsz;
}
template <int EPI>
DI void gemm_phase(const bf16_t* A, const bf16_t* Bt, int M, int N, int K, const EArgs& ea,
                   unsigned char* smem, int tstart, int bid, int nblk, int wv) {
  const int nM = M >> 8, nN = N >> 8, nwg = nM * nN, nt = K >> 6;
  if constexpr (EPI == E_RESID) {
    const int nfull = (nwg / nblk) * nblk, rem = nwg - nfull;
    for (int t = bid; t < nfull; t += nblk) {
      int pm, pn; tile_map(t, nM, nN, nwg, pm, pn);
      gemm256_tile<EPI, false>(A, Bt, K, 0, nt, pm * 256, pn * 256, ea, smem, wv);
    }
    if (rem > 0) {
      int ns = nblk / rem; if (ns > (nt >> 2)) ns = nt >> 2; if (ns < 1) ns = 1;
      const int per = ((nt / ns) >> 1) << 1;
      for (int u = bid; u < rem * ns; u += nblk) {
        const int t = nfull + u / ns, ks = u % ns;
        const int k0 = ks * per, kn = (ks == ns - 1) ? (nt - k0) : per;
        int pm, pn; tile_map(t, nM, nN, nwg, pm, pn);
        gemm256_tile<EPI, true>(A, Bt, K, k0, kn, pm * 256, pn * 256, ea, smem, wv);
      }
    }
  } else {
    int t0 = bid - (tstart % nblk); if (t0 < 0) t0 += nblk;
    for (int t = t0; t < nwg; t += nblk) {
      int pm, pn; tile_map(t, nM, nN, nwg, pm, pn);
      gemm256_tile<EPI, false>(A, Bt, K, 0, nt, pm * 256, pn * 256, ea, smem, wv);
    }
  }
}

DI void rmsnorm_rows(const float* __restrict__ X, const float* __restrict__ g, bf16_t* __restrict__ H, float* outp, float* outs,
                     int bid, int nblk, int wv) {
  const int lane = ltid(wv) & 63, w = ltid(wv) >> 6;
  for (int row = bid * 8 + w; row < T; row += nblk * 8) {
    const float* xr = X + (size_t)row * 1024;
    float4 v[4];
    float ss = 0.f;
#pragma unroll
    for (int c = 0; c < 4; ++c) { v[c] = *(const float4*)(xr + c * 256 + lane * 4); ss += v[c].x * v[c].x + v[c].y * v[c].y + v[c].z * v[c].z + v[c].w * v[c].w; }
    ss = wave_sum(ss, lane);
    float r = rsqrtf(ss * (1.f / 1024.f) + EPS);
#pragma unroll
    for (int c = 0; c < 4; ++c) {
      int col = c * 256 + lane * 4;
      float4 gg = *(const float4*)(g + col);
      float a = v[c].x * r * gg.x, b = v[c].y * r * gg.y, cc = v[c].z * r * gg.z, d = v[c].w * r * gg.w;
      if (H) { uint2 pk; pk.x = pack2(a, b); pk.y = pack2(cc, d); *(uint2*)(H + (size_t)row * 1024 + col) = pk; }
      else {
        float* o = (row < TP) ? outp + (size_t)row * 1024 + col : outs + (size_t)(row - TP) * 1024 + col;
        *(float4*)o = make_float4(a, b, cc, d);
      }
    }
  }
}

DI void mla_rowops(PREF p, int j, int bid, int nblk, int wv) {
  const int lane = ltid(wv) & 63, w = ltid(wv) >> 6;
  unsigned char* R = p.ws + OFF_R;
  const float* RAW = (const float*)(R + R_RAW);
  bf16_t* CQ = (bf16_t*)(R + R_CQ); bf16_t* CKV = (bf16_t*)(R + R_CKV); bf16_t* KR = (bf16_t*)(R + R_KR);
  const float* gq = p.in[11] + j * 512; const float* gkv = p.in[14] + j * 256;
  const float* rope = (const float*)(p.ws + OFF_ROPE);
  for (int row = bid * 8 + w; row < T; row += nblk * 8) {
    const float* rr = RAW + (size_t)row * 1024;
    float4 a0 = *(const float4*)(rr + lane * 4), a1 = *(const float4*)(rr + 256 + lane * 4);
    float4 c0 = *(const float4*)(rr + 512 + lane * 4);
    float ss = a0.x * a0.x + a0.y * a0.y + a0.z * a0.z + a0.w * a0.w + a1.x * a1.x + a1.y * a1.y + a1.z * a1.z + a1.w * a1.w;
    float s2 = c0.x * c0.x + c0.y * c0.y + c0.z * c0.z + c0.w * c0.w;
    ss = wave_sum(ss, lane); s2 = wave_sum(s2, lane);
    float r1 = rsqrtf(ss * (1.f / 512.f) + EPS), r2 = rsqrtf(s2 * (1.f / 256.f) + EPS);
    {
      float4 g0 = *(const float4*)(gq + lane * 4), g1 = *(const float4*)(gq + 256 + lane * 4);
      uint2 pk; pk.x = pack2(a0.x * r1 * g0.x, a0.y * r1 * g0.y); pk.y = pack2(a0.z * r1 * g0.z, a0.w * r1 * g0.w);
      *(uint2*)(CQ + (size_t)row * 512 + lane * 4) = pk;
      pk.x = pack2(a1.x * r1 * g1.x, a1.y * r1 * g1.y); pk.y = pack2(a1.z * r1 * g1.z, a1.w * r1 * g1.w);
      *(uint2*)(CQ + (size_t)row * 512 + 256 + lane * 4) = pk;
    }
    const int rm = rowmap(row);
    {
      float4 g = *(const float4*)(gkv + lane * 4);
      float4 o = make_float4(c0.x * r2 * g.x, c0.y * r2 * g.y, c0.z * r2 * g.z, c0.w * r2 * g.w);
      float* op = (row < TP) ? p.out + O_CKVP + ((size_t)j * TP + row) * 256 : p.out + O_CKVS + ((size_t)j * TS + (row - TP)) * 256;
      *(float4*)(op + lane * 4) = o;
      uint2 pk; pk.x = pack2(o.x, o.y); pk.y = pack2(o.z, o.w);
      *(uint2*)(CKV + (size_t)rm * 256 + lane * 4) = pk;
    }
    if (lane < 16) {
      float x1 = rr[768 + lane], x2 = rr[784 + lane];
      int pos = tokpos(row);
      float2 cs = *(const float2*)(rope + ((size_t)pos * 16 + lane) * 2);
      float o1 = x1 * cs.x - x2 * cs.y, o2 = x1 * cs.y + x2 * cs.x;
      float* op = (row < TP) ? p.out + O_KRP + ((size_t)j * TP + row) * 32 : p.out + O_KRS + ((size_t)j * TS + (row - TP)) * 32;
      op[lane] = o1; op[16 + lane] = o2;
      KR[(size_t)rm * 32 + lane] = tobf(o1); KR[(size_t)rm * 32 + 16 + lane] = tobf(o2);
    }
  }
}

DI void dsa_rowops(PREF p, int bid, int nblk, int wv) {
  const int lane = ltid(wv) & 63, w = ltid(wv) >> 6;
  unsigned char* R = p.ws + OFF_R;
  const float* KIR = (const float*)(R + D_KIR);
  bf16_t* KI = (bf16_t*)(R + D_KI);
  const float* g = p.in[27];
  for (int row = bid * 8 + w; row < T; row += nblk * 8) {
    float v = KIR[(size_t)row * 64 + lane];
    float ss = wave_sum(v * v, lane);
    float r = rsqrtf(ss * (1.f / 64.f) + EPS);
    float o = v * r * g[lane];
    if (row < TP) p.out[O_DIP + (size_t)row * 64 + lane] = o; else p.out[O_DIS + (size_t)(row - TP) * 64 + lane] = o;
    KI[(size_t)rowmap(row) * 64 + lane] = tobf(o);
  }
}

DI void cmlp_ln_rows(PREF p, int bid, int nblk, int wv) {
  const int lane = ltid(wv) & 63, w = ltid(wv) >> 6;
  unsigned char* R = p.ws + OFF_R;
  const bf16_t* VR = (const bf16_t*)(R + C_VR);
  bf16_t* VLN = (bf16_t*)(R + C_VLN);
  const float* g = p.in[18]; const float* bb = p.in[19];
  for (int row = bid * 8 + w; row < T; row += nblk * 8) {
    float x[32];
    float sum = 0.f;
#pragma unroll
    for (int c = 0; c < 4; ++c) {
      uint4 u = *(const uint4*)(VR + (size_t)row * 2048 + c * 512 + lane * 8);
      x[c * 8 + 0] = bflo(u.x); x[c * 8 + 1] = bfhi(u.x); x[c * 8 + 2] = bflo(u.y); x[c * 8 + 3] = bfhi(u.y);
      x[c * 8 + 4] = bflo(u.z); x[c * 8 + 5] = bfhi(u.z); x[c * 8 + 6] = bflo(u.w); x[c * 8 + 7] = bfhi(u.w);
    }
#pragma unroll
    for (int i = 0; i < 32; ++i) sum += x[i];
    sum = wave_sum(sum, lane);
    float mu = sum * (1.f / 2048.f);
    float vs = 0.f;
#pragma unroll
    for (int i = 0; i < 32; ++i) { x[i] -= mu; vs += x[i] * x[i]; }
    vs = wave_sum(vs, lane);
    float r = rsqrtf(vs * (1.f / 2048.f) + EPS);
#pragma unroll
    for (int c = 0; c < 4; ++c) {
      int col = c * 512 + lane * 8;
      float y[8];
#pragma unroll
      for (int q = 0; q < 2; ++q) {
        float4 gg = *(const float4*)(g + col + q * 4), b4 = *(const float4*)(bb + col + q * 4);
        y[q * 4 + 0] = x[c * 8 + q * 4 + 0] * r * gg.x + b4.x; y[q * 4 + 1] = x[c * 8 + q * 4 + 1] * r * gg.y + b4.y;
        y[q * 4 + 2] = x[c * 8 + q * 4 + 2] * r * gg.z + b4.z; y[q * 4 + 3] = x[c * 8 + q * 4 + 3] * r * gg.w + b4.w;
      }
      uint4 pk; pk.x = pack2(y[0], y[1]); pk.y = pack2(y[2], y[3]); pk.z = pack2(y[4], y[5]); pk.w = pack2(y[6], y[7]);
      *(uint4*)(VLN + (size_t)row * 2048 + col) = pk;
      if (row >= TP) {
        float* o = p.out + O_CVS + (size_t)(row - TP) * 2048 + col;
        *(float4*)o = make_float4(y[0], y[1], y[2], y[3]); *(float4*)(o + 4) = make_float4(y[4], y[5], y[6], y[7]);
      }
    }
  }
}

DI void cmlp_mix_phase(PREF p, unsigned char* smem, int bid, int nblk, int wv) {
  const int tid = ltid(wv), lane = tid & 63, w = tid >> 6, wm = w >> 2, wn = w & 3, lr = lane & 31, lh = lane >> 5;
  unsigned char* R = p.ws + OFF_R;
  const bf16_t* U = (const bf16_t*)(R + C_U);
  const bf16_t* VLN = (const bf16_t*)(R + C_VLN);
  bf16_t* G = (bf16_t*)(R + C_G);
  const bf16_t* WT = (const bf16_t*)(p.ws + OFF_W) + W_TRIL;
  const float* bs = p.in[21];
  bf16_t* As = (bf16_t*)smem;
  bf16_t* Bs = As + 128 * 136;
  for (int u = bid; u < 1024; u += nblk) {
    const int g = u & 7, ch = u >> 3;
    const int col0 = g * 256;
#pragma unroll 2
    for (int i = 0; i < 4; ++i) {
      int v = tid + i * NT; int r = v >> 4, c = (v & 15) * 8;
      *(uint4*)(As + r * 136 + c) = *(const uint4*)(WT + ((size_t)g * 128 + r) * 128 + c);
    }
#pragma unroll 2
    for (int i = 0; i < 8; ++i) {
      int v = tid + i * NT; int s = v >> 5, c = (v & 31) * 8;
      uint4 x = *(const uint4*)(VLN + ((size_t)ch * 128 + s) * 2048 + col0 + c);
      Bs[(c + 0) * 136 + s] = (bf16_t)(x.x & 0xffff); Bs[(c + 1) * 136 + s] = (bf16_t)(x.x >> 16);
      Bs[(c + 2) * 136 + s] = (bf16_t)(x.y & 0xffff); Bs[(c + 3) * 136 + s] = (bf16_t)(x.y >> 16);
      Bs[(c + 4) * 136 + s] = (bf16_t)(x.z & 0xffff); Bs[(c + 5) * 136 + s] = (bf16_t)(x.z >> 16);
      Bs[(c + 6) * 136 + s] = (bf16_t)(x.w & 0xffff); Bs[(c + 7) * 136 + s] = (bf16_t)(x.w >> 16);
    }
    __syncthreads();
    f32x16 acc[2][2];
#pragma unroll
    for (int a = 0; a < 2; ++a)
#pragma unroll
      for (int b = 0; b < 2; ++b)
#pragma unroll
        for (int i = 0; i < 16; ++i) acc[a][b][i] = 0.f;
    const bf16_t* Asb = As + (wm * 64 + lr) * 136 + lh * 8;
    const bf16_t* Bsb = Bs + (wn * 64 + lr) * 136 + lh * 8;
    const int ns = (wm + 1) * 4;
    for (int s = 0; s < ns; ++s) {
      bf16x8 a0 = *(const bf16x8*)(Asb + s * 16);
      bf16x8 a1 = *(const bf16x8*)(Asb + 32 * 136 + s * 16);
      bf16x8 b0 = *(const bf16x8*)(Bsb + s * 16);
      bf16x8 b1 = *(const bf16x8*)(Bsb + 32 * 136 + s * 16);
      acc[0][0] = MFMA32(a0, b0, acc[0][0]);
      acc[0][1] = MFMA32(a0, b1, acc[0][1]);
      acc[1][0] = MFMA32(a1, b0, acc[1][0]);
      acc[1][1] = MFMA32(a1, b1, acc[1][1]);
    }
#pragma unroll
    for (int mi = 0; mi < 2; ++mi)
#pragma unroll
      for (int ni = 0; ni < 2; ++ni)
#pragma unroll
        for (int i = 0; i < 16; ++i) {
          int t = wm * 64 + mi * 32 + crow(i, lh);
          int col = col0 + wn * 64 + ni * 32 + lr;
          size_t off = ((size_t)ch * 128 + t) * 2048 + col;
          float mixed = acc[mi][ni][i] + bs[g * 128 + t];
          G[off] = tobf(frombf(U[off]) * mixed);
        }
    __syncthreads();
  }
  const float* wsf = p.in[20];
  for (int e = bid * NT + tid; e < TS * 2048; e += nblk * NT) {
    int row = e >> 11, col = e & 2047, b = row >> 4, t = row & 15, g = col >> 8;
    float a = bs[g * 128 + t];
    for (int s = 0; s <= t; ++s) a += wsf[((size_t)g * 128 + t) * 128 + s] * frombf(VLN[((size_t)TP + b * 16 + s) * 2048 + col]);
    size_t off = ((size_t)TP + row) * 2048 + col;
    G[off] = tobf(frombf(U[off]) * a);
  }
}

template <int DQK, bool IS_MLA, bool MASKED>
DI void attn_unit(const bf16_t* __restrict__ Qp, int ldq, int nq,
                  const bf16_t* __restrict__ Kp, int ldk, const bf16_t* __restrict__ KRp,
                  const bf16_t* __restrict__ Vtp, int ldv,
                  int nkt, int nkt_w, int nkeys, const unsigned* __restrict__ BMp,
                  bf16_t* __restrict__ AOp, unsigned char* smem_half, int wv) {
  constexpr int KS = DQK + 8;
  constexpr int VS = 68;
  constexpr int NQS = DQK / 16;
  const int tid = ltid(wv) & 255, lane = tid & 63, w = tid >> 6, lr = lane & 31, lh = lane >> 5;
  bf16_t* Ks = (bf16_t*)smem_half;
  bf16_t* Vs = Ks + 2 * 64 * KS;
  const bool q_ok = (w * 32 + lr) < nq;
  const int qrow = q_ok ? (w * 32 + lr) : 0;
  bf16x8 qf[NQS];
#pragma unroll
  for (int s = 0; s < NQS; ++s) qf[s] = *(const bf16x8*)(Qp + (size_t)qrow * ldq + s * 16 + lh * 8);
  f32x16 oacc[2];
#pragma unroll
  for (int d = 0; d < 2; ++d)
#pragma unroll
    for (int i = 0; i < 16; ++i) oacc[d][i] = 0.f;
  float m_run = -INFINITY, l_run = 0.f;
  const int kkey = tid >> 3, kc = (tid & 7) * 8;
  const int rkey = tid >> 2, rc = (tid & 3) * 8;
  const int vd = tid >> 3, vk = (tid & 7) * 8;
  uint4 rk[2], rr, rv[2];
  rr = make_uint4(0, 0, 0, 0);
  auto gload = [&](int kt) {
    const int key0 = kt * 64;
#pragma unroll
    for (int i = 0; i < 2; ++i) rk[i] = *(const uint4*)(Kp + (size_t)(key0 + kkey + 32 * i) * ldk + kc);
    if constexpr (IS_MLA) rr = *(const uint4*)(KRp + (size_t)(key0 + rkey) * 32 + rc);
#pragma unroll
    for (int i = 0; i < 2; ++i) rv[i] = *(const uint4*)(Vtp + (size_t)(vd + 32 * i) * ldv + key0 + vk);
  };
  auto sstore = [&](int buf) {
    bf16_t* Kb = Ks + buf * 64 * KS; bf16_t* Vb = Vs + buf * 64 * VS;
#pragma unroll
    for (int i = 0; i < 2; ++i) *(uint4*)(Kb + (kkey + 32 * i) * KS + kc) = rk[i];
    if constexpr (IS_MLA) *(uint4*)(Kb + rkey * KS + 64 + rc) = rr;
#pragma unroll
    for (int i = 0; i < 2; ++i) {
      uint2 lo = make_uint2(rv[i].x, rv[i].y), hi = make_uint2(rv[i].z, rv[i].w);
      *(uint2*)(Vb + (vd + 32 * i) * VS + vk) = lo;
      *(uint2*)(Vb + (vd + 32 * i) * VS + vk + 4) = hi;
    }
  };
  __syncthreads();
  gload(0); sstore(0);
  __syncthreads();
  for (int kt = 0; kt < nkt; ++kt) {
    const int buf = kt & 1;
    if (kt + 1 < nkt) gload(kt + 1);
    if (kt < nkt_w) {
      const bf16_t* Kb = Ks + buf * 64 * KS; const bf16_t* Vb = Vs + buf * 64 * VS;
      uint2 bmw = make_uint2(0xffffffffu, 0xffffffffu);
      if constexpr (MASKED) { if (BMp) bmw = *(const uint2*)(BMp + (size_t)qrow * 256 + kt * 2); }
      f32x16 sacc[2];
#pragma unroll
      for (int mt = 0; mt < 2; ++mt) {
#pragma unroll
        for (int i = 0; i < 16; ++i) sacc[mt][i] = 0.f;
#pragma unroll
        for (int s = 0; s < NQS; ++s) {
          bf16x8 kf = *(const bf16x8*)(Kb + (mt * 32 + lr) * KS + s * 16 + lh * 8);
          sacc[mt] = MFMA32(kf, qf[s], sacc[mt]);
        }
      }
      float mx = -INFINITY;
#pragma unroll
      for (int mt = 0; mt < 2; ++mt) {
        const unsigned wbits = mt ? bmw.y : bmw.x;
#pragma unroll
        for (int i = 0; i < 16; ++i) {
          if constexpr (MASKED) {
            const int kin = crow(i, lh);
            const int key = kt * 64 + mt * 32 + kin;
            bool ok = (key < nkeys) && ((wbits >> kin) & 1u);
            sacc[mt][i] = ok ? sacc[mt][i] : -INFINITY;
          }
          mx = fmaxf(mx, sacc[mt][i]);
        }
      }
      mx = fmaxf(mx, shflx(mx, 32, lane));
      const float m_new = fmaxf(m_run, mx);
      const float m_safe = (m_new == -INFINITY) ? 0.f : m_new;
      const float alpha = __builtin_amdgcn_exp2f(m_run - m_safe);
      const bool changed = m_new > m_run;
      m_run = m_new;
      float ls = 0.f;
#pragma unroll
      for (int mt = 0; mt < 2; ++mt)
#pragma unroll
        for (int i = 0; i < 16; ++i) { float pv = __builtin_amdgcn_exp2f(sacc[mt][i] - m_safe); sacc[mt][i] = pv; ls += pv; }
      l_run = l_run * alpha + ls;
      if (__builtin_amdgcn_ballot_w64(changed) != 0ull) {
#pragma unroll
        for (int d = 0; d < 2; ++d)
#pragma unroll
          for (int i = 0; i < 16; ++i) oacc[d][i] *= alpha;
      }
#pragma unroll
      for (int mt = 0; mt < 2; ++mt)
#pragma unroll
        for (int s = 0; s < 2; ++s) {
          uint4 pp;
          pp.x = pack2(sacc[mt][8 * s + 0], sacc[mt][8 * s + 1]);
          pp.y = pack2(sacc[mt][8 * s + 2], sacc[mt][8 * s + 3]);
          pp.z = pack2(sacc[mt][8 * s + 4], sacc[mt][8 * s + 5]);
          pp.w = pack2(sacc[mt][8 * s + 6], sacc[mt][8 * s + 7]);
          bf16x8 pf = __builtin_bit_cast(bf16x8, pp);
#pragma unroll
          for (int dt = 0; dt < 2; ++dt) {
            const bf16_t* vrow = Vb + (dt * 32 + lr) * VS + mt * 32 + 16 * s + 4 * lh;
            uint2 lo = *(const uint2*)(vrow), hi = *(const uint2*)(vrow + 8);
            uint4 vv = make_uint4(lo.x, lo.y, hi.x, hi.y);
            bf16x8 vf = __builtin_bit_cast(bf16x8, vv);
            oacc[dt] = MFMA32(vf, pf, oacc[dt]);
          }
        }
    }
    if (kt + 1 < nkt) sstore(buf ^ 1);
    __syncthreads();
  }
  if (nkt_w > 0) {
    float lt = l_run + shflx(l_run, 32, lane);
    float inv = lt > 0.f ? 1.f / lt : 0.f;
    if (q_ok) {
      bf16_t* orow = AOp + (size_t)(w * 32 + lr) * 1024;
#pragma unroll
      for (int dt = 0; dt < 2; ++dt)
#pragma unroll
        for (int g = 0; g < 4; ++g) {
          uint2 pk;
          pk.x = pack2(oacc[dt][4 * g] * inv, oacc[dt][4 * g + 1] * inv);
          pk.y = pack2(oacc[dt][4 * g + 2] * inv, oacc[dt][4 * g + 3] * inv);
          *(uint2*)(orow + dt * 32 + 8 * g + 4 * lh) = pk;
        }
    }
  }
}


DI int snake_idx(int i, int bid, int nblk) { return i * nblk + ((i & 1) ? (nblk - 1 - bid) : bid); }

template <bool IS_MLA>
DI void attn_phase(PREF p, unsigned char* smem, int bid, int nblk, int wv) {
  unsigned char* R = p.ws + OFF_R;
  const int tl = ltid(wv);
  const int hf = tl >> 8, w = (tl >> 6) & 3;
  unsigned char* smh = smem + hf * 45056;
  const int total = 1024 + 256;
  for (int i = 0; i * nblk < total; ++i) {
    int pu = snake_idx(i, bid, nblk);
    if (pu >= total) continue;
    if constexpr (IS_MLA) {
      const bf16_t* Q = (const bf16_t*)(R + R_Q); const bf16_t* KN = (const bf16_t*)(R + R_KN);
      const bf16_t* KR = (const bf16_t*)(R + R_KR); const bf16_t* VT = (const bf16_t*)(R + R_VT);
      bf16_t* AO = (bf16_t*)(R + R_RAW);
      if (pu < 1024) {
        int qt = 63 - (pu >> 4), bh = (pu & 15) * 2 + hf, b = bh >> 4, h = bh & 15;
        int q0 = b * 8192 + qt * 128;
        attn_unit<96, true, false>(Q + (size_t)q0 * 1536 + h * 96, 1536, 128,
                            KN + (size_t)(b * 8192) * 1024 + h * 64, 1024, KR + (size_t)(b * 8192) * 32,
                            VT + (size_t)((b * 16 + h) * 64) * 8192, 8192,
                            2 * qt + 2, 2 * qt + 1 + (w >> 1), 1 << 30, nullptr,
                            AO + (size_t)q0 * 1024 + h * 64, smh, wv);
      } else {
        int u = (pu - 1024) * 2 + hf, b = u >> 4, h = u & 15;
        int q0 = TP + b * 16;
        attn_unit<96, true, true>(Q + (size_t)q0 * 1536 + h * 96, 1536, 16,
                            KN + (size_t)(TP + b * SPAD) * 1024 + h * 64, 1024, KR + (size_t)(TP + b * SPAD) * 32,
                            VT + (size_t)TP * 1024 + (size_t)((b * 16 + h) * 64) * SPAD, SPAD,
                            17, (w == 0) ? 17 : 0, NKS, nullptr,
                            AO + (size_t)q0 * 1024 + h * 64, smh, wv);
      }
    } else {
      const bf16_t* Q = (const bf16_t*)(R + D_Q); const bf16_t* KK = (const bf16_t*)(R + D_K);
      const bf16_t* VT = (const bf16_t*)(R + D_VT); const unsigned* BM = (const unsigned*)(R + D_BM);
      bf16_t* AO = (bf16_t*)(R + D_AO);
      if (pu < 1024) {
        int qt = 63 - (pu >> 4), bh = (pu & 15) * 2 + hf, b = bh >> 4, h = bh & 15;
        int q0 = b * 8192 + qt * 128;
        attn_unit<64, false, true>(Q + (size_t)q0 * 1024 + h * 64, 1024, 128,
                             KK + (size_t)(b * 8192) * 1024 + h * 64, 1024, nullptr,
                             VT + (size_t)((b * 16 + h) * 64) * 8192, 8192,
                             2 * qt + 2, 2 * qt + 1 + (w >> 1), 1 << 30, BM + (size_t)q0 * 256,
                             AO + (size_t)q0 * 1024 + h * 64, smh, wv);
      } else {
        int u = (pu - 1024) * 2 + hf, b = u >> 4, h = u & 15;
        int q0 = TP + b * 16;
        attn_unit<64, false, true>(Q + (size_t)q0 * 1024 + h * 64, 1024, 16,
                             KK + (size_t)(TP + b * SPAD) * 1024 + h * 64, 1024, nullptr,
                             VT + (size_t)TP * 1024 + (size_t)((b * 16 + h) * 64) * SPAD, SPAD,
                             17, (w == 0) ? 17 : 0, NKS, BM + (size_t)q0 * 256,
                             AO + (size_t)q0 * 1024 + h * 64, smh, wv);
      }
    }
  }
}

constexpr int CAP = 128;
DI int score_bin(float s) {
  unsigned u = __float_as_uint(s);
  int e = (int)((u & 0x7fffffffu) >> 19);
  int m = min(max(e, 1840), 2095) - 1840;
  return (u >> 31) ? (255 - m) : (256 + m);
}

DI void idx_unit(const bf16_t* __restrict__ QI, const float* __restrict__ WI, int q_row0, int nq,
                 const bf16_t* __restrict__ KI, int L, unsigned* __restrict__ BM, unsigned char* smem, int wv) {
  const int tid = ltid(wv), lane = tid & 63, w = tid >> 6, lr = lane & 31, lh = lane >> 5;
  bf16_t* Qs = (bf16_t*)smem;
  float* Ws = (float*)(smem + 36864);
  unsigned* hist = (unsigned*)(smem + 36864 + 1024);
  float* cand_s = (float*)hist;
  int* cand_i = (int*)(smem + 36864 + 1024 + 16384);
  int* bstar = (int*)(smem + 36864 + 1024 + 32768);
  int* need = bstar + 32;
  int* ncand = need + 32;
  __syncthreads();
#pragma unroll
  for (int i = 0; i < 4; ++i) {
    int v = tid + i * NT;
    int hd = v >> 8, q = (v >> 3) & 31, c = (v & 7) * 8;
    int qq = q < nq ? q : 0;
    *(uint4*)(Qs + (hd * 32 + q) * 72 + c) = *(const uint4*)(QI + (size_t)(q_row0 + qq) * 512 + hd * 64 + c);
  }
  if (tid < 256) { int hd = tid >> 5, q = tid & 31; int qq = q < nq ? q : 0; Ws[hd * 32 + q] = WI[(size_t)(q_row0 + qq) * 8 + hd]; }
  for (int i = tid; i < 32 * 256; i += NT) hist[i] = 0u;
  if (tid < 32) { bstar[tid] = -1; need[tid] = 0; ncand[tid] = 0; }
  __syncthreads();
  const int ntile = (L + 255) >> 8;
  const bool do_select = L > 256;
  for (int pass = do_select ? 0 : 1; pass < 2; ++pass) {
    for (int kt = 0; kt < ntile; ++kt) {
      const int key0 = kt * 256 + w * 32;
      if (key0 < L) {
        const int key = key0 + lr;
        bf16x8 kf[4];
#pragma unroll
        for (int s = 0; s < 4; ++s) kf[s] = *(const bf16x8*)(KI + (size_t)key * 64 + s * 16 + lh * 8);
        float sc[16];
#pragma unroll
        for (int i = 0; i < 16; ++i) sc[i] = 0.f;
#pragma unroll 1
        for (int hd = 0; hd < 8; ++hd) {
          f32x16 acc;
#pragma unroll
          for (int i = 0; i < 16; ++i) acc[i] = 0.f;
#pragma unroll
          for (int s = 0; s < 4; ++s) {
            bf16x8 qf = *(const bf16x8*)(Qs + (hd * 32 + lr) * 72 + s * 16 + lh * 8);
            acc = MFMA32(qf, kf[s], acc);
          }
#pragma unroll
          for (int g = 0; g < 4; ++g) {
            float4 wv = *(const float4*)(Ws + hd * 32 + 8 * g + 4 * lh);
            sc[4 * g + 0] += wv.x * fmaxf(acc[4 * g + 0], 0.f);
            sc[4 * g + 1] += wv.y * fmaxf(acc[4 * g + 1], 0.f);
            sc[4 * g + 2] += wv.z * fmaxf(acc[4 * g + 2], 0.f);
            sc[4 * g + 3] += wv.w * fmaxf(acc[4 * g + 3], 0.f);
          }
        }
        const bool kvalid = key < L;
        if (pass == 0) {
#pragma unroll
          for (int i = 0; i < 16; ++i) {
            int q = crow(i, lh);
            if (kvalid) { int b = score_bin(sc[i]); atomicAdd(&hist[q * 256 + (b >> 1)], (b & 1) ? 65536u : 1u); }
          }
        } else {
#pragma unroll
          for (int i = 0; i < 16; ++i) {
            int q = crow(i, lh);
            int b = score_bin(sc[i]);
            int bs = bstar[q];
            bool sel = kvalid && (b > bs);
            bool cnd = kvalid && (b == bs);
            unsigned long long bal = __ballot(sel);
            if (lr == 0 && q < nq) BM[(size_t)(q_row0 + q) * 256 + (key0 >> 5)] = (unsigned)(bal >> (32 * lh));
            if (cnd) {
              int pos = atomicAdd(&ncand[q], 1);
              if (pos < CAP) { cand_s[q * CAP + pos] = sc[i]; cand_i[q * CAP + pos] = key; }
            }
          }
        }
      }
    }
    __syncthreads();
    if (pass == 0) {
      for (int qi = 0; qi < 4; ++qi) {
        const int q = w * 4 + qi;
        unsigned hw[4];
#pragma unroll
        for (int k = 0; k < 4; ++k) hw[k] = hist[q * 256 + 255 - 4 * lane - k];
        int cnt = 0;
#pragma unroll
        for (int k = 0; k < 4; ++k) cnt += (int)(hw[k] >> 16) + (int)(hw[k] & 0xffffu);
        int pre = cnt;
#pragma unroll
        for (int o = 1; o < 64; o <<= 1) { int t = __builtin_amdgcn_ds_bpermute(((lane - o) & 63) << 2, pre); if (lane >= o) pre += t; }
        unsigned long long bal = __ballot(pre >= 256);
        if (bal != 0ull) {
          int fl = __ffsll((long long)bal) - 1;
          if (lane == fl) {
            int running = pre - cnt;
            int bsel = -1, above = 0;
#pragma unroll
            for (int k = 0; k < 4; ++k) {
              int chi = (int)(hw[k] >> 16), clo = (int)(hw[k] & 0xffffu);
              if (bsel < 0) { if (running + chi >= 256) { bsel = 511 - 8 * lane - 2 * k; above = running; } else running += chi; }
              if (bsel < 0) { if (running + clo >= 256) { bsel = 510 - 8 * lane - 2 * k; above = running; } else running += clo; }
            }
            bstar[q] = bsel; need[q] = 256 - above;
          }
        }
      }
      __syncthreads();
    }
  }
  __threadfence();
  __syncthreads();
  if (do_select) {
    for (int pi = tid; pi < 32 * CAP; pi += NT) {
      int q = pi / CAP, c = pi - q * CAP;
      int n = min(ncand[q], CAP);
      if (c < n && q < nq) {
        float sv = cand_s[q * CAP + c]; int iv = cand_i[q * CAP + c];
        int rank = 0;
        for (int j = 0; j < n; ++j) {
          float sj = cand_s[q * CAP + j]; int ij = cand_i[q * CAP + j];
          rank += (sj > sv || (sj == sv && ij < iv)) ? 1 : 0;
        }
        if (rank < need[q]) atomicOr(&BM[(size_t)(q_row0 + q) * 256 + (iv >> 5)], 1u << (iv & 31));
      }
    }
  }
  __syncthreads();
}

DI void idx_phase(PREF p, unsigned char* smem, int bid, int nblk, int wv) {
  unsigned char* R = p.ws + OFF_R;
  const bf16_t* QI = (const bf16_t*)(R + D_QI); const float* WI = (const float*)(R + D_WI);
  const bf16_t* KI = (const bf16_t*)(R + D_KI); unsigned* BM = (unsigned*)(R + D_BM);
  const int total = 512 + 32;
  for (int i = 0; i * nblk < total; ++i) {
    int idx = snake_idx(i, bid, nblk);
    if (idx >= total) continue;
    if (idx < 512) {
      int qt = 255 - (idx >> 1), b = idx & 1;
      int L = (((qt * 32) >> 6) + 1) * 64;
      idx_unit(QI, WI, b * 8192 + qt * 32, 32, KI + (size_t)(b * 8192) * 64, L, BM, smem, wv);
    } else {
      int b = idx - 512;
      idx_unit(QI, WI, TP + b * 16, 16, KI + (size_t)(TP + b * SPAD) * 64, NKS, BM, smem, wv);
    }
  }
}

DI void cvt8(const float* s, bf16_t* d) {
  float4 a = *(const float4*)s, b = *(const float4*)(s + 4);
  uint4 pk; pk.x = pack2(a.x, a.y); pk.y = pack2(a.z, a.w); pk.z = pack2(b.x, b.y); pk.w = pack2(b.z, b.w);
  *(uint4*)d = pk;
}
DI void cache_rows(const float* __restrict__ src, bf16_t* __restrict__ dst, int Wd, int bid, int nblk, int wv) {
  const int vpr = Wd >> 3;
  const size_t total = (size_t)32 * SPAD * vpr;
  for (size_t e = (size_t)bid * NT + ltid(wv); e < total; e += (size_t)nblk * NT) {
    int c = (int)(e % vpr) * 8; size_t rw = e / vpr; int b = (int)(rw / SPAD), s = (int)(rw % SPAD);
    bf16_t* d = dst + ((size_t)TP + (size_t)b * SPAD + s) * Wd + c;
    if (s < 1024) cvt8(src + ((size_t)b * 1024 + s) * Wd + c, d);
    else if (s >= NKS) { unsigned z = 0; asm volatile("" : "+v"(z)); *(uint4*)d = make_uint4(z, z, z, z); }
  }
}


#define XB_TMO      128
#define XB_XCNT(j)  (256  + 64 * (j))
#define XB_XSUB(j)  (1280 + 64 * (j))
#define XB_XGEN(j)  (2304 + 64 * (j))
#define XB_TOP      3328
#define XB_TOPGEN   3392
#define XCD_BAR_WORDS 3456
#define XB_SPIN_CAP (1u << 18)
DI unsigned xb_ld(unsigned* p)              { return __hip_atomic_load(p, __ATOMIC_RELAXED, __HIP_MEMORY_SCOPE_AGENT); }
DI unsigned xb_add(unsigned* p, unsigned v) { return __hip_atomic_fetch_add(p, v, __ATOMIC_RELAXED, __HIP_MEMORY_SCOPE_AGENT); }
DI unsigned xb_xcc_id() { return (unsigned)__builtin_amdgcn_s_getreg((3 << 11) | 20) & 0xFu; }
#define XB_SPIN(cond, bar) do { unsigned _sp = 0; while (cond) { __builtin_amdgcn_s_sleep(1); \
    if ((++_sp & 255u) == 0u) { if (xb_ld(&(bar)[XB_TMO])) break; if (_sp > XB_SPIN_CAP) { atomicAdd(&(bar)[XB_TMO], 1u); break; } } } } while (0)
struct XcdBarrier { unsigned* bar; unsigned x; volatile __attribute__((address_space(3))) unsigned* st; };
DI void xcd_barrier_complete(unsigned* bar, unsigned x, unsigned G, unsigned& nloc, unsigned& nx) {
  unsigned sum, cnt, mine, sp = 0u;
  for (;;) {
    sum = 0u; cnt = 0u; mine = 0u;
#pragma unroll
    for (unsigned j = 0; j < 16; ++j) { const unsigned c = xb_ld(&bar[XB_XCNT(j)]); sum += c; cnt += (c > 0u) ? 1u : 0u; mine = (j == x) ? c : mine; }
    if (sum == G) break;
    __builtin_amdgcn_s_sleep(1);
    if ((++sp & 255u) == 0u) { if (xb_ld(&bar[XB_TMO])) break; if (sp > XB_SPIN_CAP) { atomicAdd(&bar[XB_TMO], 1u); break; } }
  }
  nloc = mine > 0u ? mine : 1u; nx = cnt > 0u ? cnt : 1u;
}
DI void xcd_barrier(const XcdBarrier& b, int tid, unsigned G) {
  asm volatile("s_waitcnt vmcnt(0)" ::: "memory");
  __syncthreads();
  if (tid == 0) {
    unsigned* bar = b.bar;
    __builtin_amdgcn_s_waitcnt(0);
    unsigned nloc = b.st[0], nx = b.st[1];
    if (nloc == 0u) { xcd_barrier_complete(bar, b.x, G, nloc, nx); b.st[0] = nloc; b.st[1] = nx; }
    const unsigned old = xb_add(&bar[XB_XSUB(b.x)], 1u);
    const unsigned gen = old / nloc;
    if (old + 1u == (gen + 1u) * nloc) {
      __builtin_amdgcn_fence(__ATOMIC_RELEASE, "agent");
      asm volatile("s_waitcnt vmcnt(0)" ::: "memory");
      const unsigned og = xb_add(&bar[XB_TOP], 1u);
      const unsigned tg = og / nx;
      if (og + 1u == (tg + 1u) * nx) xb_add(&bar[XB_TOPGEN], 1u);
      else XB_SPIN(xb_ld(&bar[XB_TOPGEN]) == tg, bar);
      __builtin_amdgcn_fence(__ATOMIC_ACQUIRE, "agent");
      xb_add(&bar[XB_XGEN(b.x)], 1u);
      asm volatile("s_waitcnt vmcnt(0)" ::: "memory");
    } else {
      XB_SPIN(xb_ld(&bar[XB_XGEN(b.x)]) == gen, bar);
      __builtin_amdgcn_fence(__ATOMIC_ACQUIRE, "agent");
      asm volatile("s_waitcnt vmcnt(0)" ::: "memory");
    }
  }
  __syncthreads();
}

extern "C" __global__ void __launch_bounds__(512, 2) mega(Params p_unused) {
  extern __shared__ __attribute__((aligned(16))) unsigned char smem[];
  cg::grid_group grid = cg::this_grid();
  const int bid = blockIdx.x, nblk = gridDim.x;
  const int wv = __builtin_amdgcn_readfirstlane((int)(threadIdx.x >> 6));
  CParams* pk = (CParams*)__builtin_amdgcn_kernarg_segment_ptr();
  const int ph_lo = pk->ph_lo, ph_hi = pk->ph_hi;
  int ph = 0;
  XcdBarrier xb;
  {
    volatile __attribute__((address_space(3))) unsigned* st = (volatile __attribute__((address_space(3))) unsigned*)(smem + 131072);
    const int t0 = ltid(wv);
    if (t0 == 0) { st[0] = 0u; st[1] = 0u; }
    __syncthreads();
    xb.bar = (unsigned*)(pk->ws + OFF_BAR); xb.x = xb_xcc_id(); xb.st = st;
    if (t0 == 0) (void)xb_add(&xb.bar[XB_XCNT(xb.x)], 1u);
  }
#ifndef REPMASK
#define REPMASK 0u
#endif
#ifndef PMASK
#define PMASK 0xffffffffu
#endif
#define PHASE_BEGIN(k) if (ph >= ph_lo && ph < ph_hi) { if constexpr ((PMASK >> (k)) & 1u) for (int rep_ = 0; rep_ < 1 + (int)((REPMASK >> (k)) & 1u); ++rep_) { \
    CParams* pp_ = pk; asm volatile("" : "+s"(pp_)); PREF p = *pp_; const int tid = ltid(wv); \
    unsigned char* ws = p.ws; float* X = (float*)(ws + OFF_X); bf16_t* H = (bf16_t*)(ws + OFF_H); bf16_t* Wb = (bf16_t*)(ws + OFF_W); \
    float* ROPE = (float*)(ws + OFF_ROPE); unsigned char* R = ws + OFF_R; (void)tid; (void)X; (void)H; (void)Wb; (void)ROPE; (void)R;
#define PHASE_END   } if (ph + 1 < ph_hi) { if (ph == 0) grid.sync(); else xcd_barrier(xb, ltid(wv), (unsigned)nblk); } } ++ph;

  PHASE_BEGIN(0)
    {
      const int hf = tid >> 8, tl = tid & 255;
      float* smh = (float*)smem + hf * 4224;
      for (int t0 = bid * 2; t0 < p.total_tiles; t0 += nblk * 2) {
        const int t = t0 + hf;
        const bool active = t < p.total_tiles;
        const int tt = active ? t : 0;
        int ji = 0;
#pragma unroll 1
        for (int q = 1; q < NJOBS; ++q) if (tt >= p.jobs[q].tile0) ji = q;
        const CAS Job& jb = p.jobs[ji];
        int lt = tt - jb.tile0; int nkt = jb.k >> 6; int nt_ = lt / nkt, kt_ = lt - nt_ * nkt;
        transpose_tile(jb.src, jb.nsrc, jb.nsrc, jb.dst, jb.k, nt_ * 64, kt_ * 64, jb.mode, smh, tl, active);
      }
    }
    {
      const size_t n4p = (size_t)TP * 256, n4 = (size_t)T * 256;
      const float4* xp = (const float4*)p.in[0]; const float4* xs = (const float4*)p.in[1];
      for (size_t e = (size_t)bid * NT + tid; e < n4; e += (size_t)nblk * NT) ((float4*)X)[e] = (e < n4p) ? xp[e] : xs[e - n4p];
      for (int e = bid * NT + tid; e < 8192 * 16; e += nblk * NT) {
        int pos = e >> 4, i = e & 15;
        double rev = (double)pos * p.inv_freq[i] * 0.15915494309189535;
        rev -= floor(rev);
        float fr = (float)rev;
        ROPE[2 * e] = __builtin_amdgcn_cosf(fr); ROPE[2 * e + 1] = __builtin_amdgcn_sinf(fr);
      }
      const float* wsrc = p.in[20];
      for (int e = bid * NT + tid; e < 8 * 128 * 128; e += nblk * NT) {
        int s = e & 127, t = (e >> 7) & 127;
        Wb[W_TRIL + e] = tobf(s <= t ? wsrc[e] : 0.f);
      }
    }
  PHASE_END

#pragma unroll 1
  for (int L = 0; L < 4; ++L) {
    const int kind = L % 3, j = L / 3;
    if (kind == 0) {
      PHASE_BEGIN(1)
        rmsnorm_rows(X, p.in[7] + L * 1024, H, nullptr, nullptr, bid, nblk, wv);
        cache_rows(p.in[2] + (size_t)j * 32 * 1024 * 256, (bf16_t*)(R + R_CKV), 256, bid, nblk, wv);
        cache_rows(p.in[3] + (size_t)j * 32 * 1024 * 32, (bf16_t*)(R + R_KR), 32, bid, nblk, wv);
      PHASE_END
      PHASE_BEGIN(2)
        EArgs ea{}; ea.f0 = (float*)(R + R_RAW);
        gemm_phase<E_F32>(H, Wb + W_MLA + (size_t)j * WM_SZ + WM_D, T, 1024, 1024, ea, smem, 0, bid, nblk, wv);
      PHASE_END
      PHASE_BEGIN(3)
        mla_rowops(p, j, bid, nblk, wv);
      PHASE_END
      PHASE_BEGIN(4)
        EArgs ea{}; ea.b0 = (bf16_t*)(R + R_Q); ea.rope = ROPE;
        gemm_phase<E_MLAQ>((const bf16_t*)(R + R_CQ), Wb + W_MLA + (size_t)j * WM_SZ + WM_UQ, T, 1536, 512, ea, smem, 0, bid, nblk, wv);
        EArgs eb{}; eb.b0 = (bf16_t*)(R + R_KN); eb.b1 = (bf16_t*)(R + R_VT);
        gemm_phase<E_MLAKV>((const bf16_t*)(R + R_CKV), Wb + W_MLA + (size_t)j * WM_SZ + WM_UKV, KROWS, 2048, 256, eb, smem, (T / 256) * 6, bid, nblk, wv);
      PHASE_END
      PHASE_BEGIN(5)
        attn_phase<true>(p, smem, bid, nblk, wv);
      PHASE_END
      PHASE_BEGIN(6)
        EArgs ea{}; ea.f0 = X;
        gemm_phase<E_RESID>((const bf16_t*)(R + R_RAW), Wb + W_MLA + (size_t)j * WM_SZ + WM_O, T, 1024, 1024, ea, smem, 0, bid, nblk, wv);
      PHASE_END
    } else if (kind == 1) {
      PHASE_BEGIN(1)
        rmsnorm_rows(X, p.in[7] + L * 1024, H, nullptr, nullptr, bid, nblk, wv);
      PHASE_END
      PHASE_BEGIN(7)
        EArgs ea{}; ea.b0 = (bf16_t*)(R + C_U); ea.b1 = (bf16_t*)(R + C_VR);
        gemm_phase<E_GELU>(H, Wb + W_CM + WC_IN, T, 4096, 1024, ea, smem, 0, bid, nblk, wv);
      PHASE_END
      PHASE_BEGIN(8)
        cmlp_ln_rows(p, bid, nblk, wv);
      PHASE_END
      PHASE_BEGIN(9)
        cmlp_mix_phase(p, smem, bid, nblk, wv);
      PHASE_END
      PHASE_BEGIN(6)
        EArgs ea{}; ea.f0 = X;
        gemm_phase<E_RESID>((const bf16_t*)(R + C_G), Wb + W_CM + WC_OUT, T, 1024, 2048, ea, smem, 0, bid, nblk, wv);
      PHASE_END
    } else {
      PHASE_BEGIN(10)
        rmsnorm_rows(X, p.in[7] + L * 1024, H, nullptr, nullptr, bid, nblk, wv);
        cache_rows(p.in[4], (bf16_t*)(R + D_K), 1024, bid, nblk, wv);
        cache_rows(p.in[6], (bf16_t*)(R + D_KI), 64, bid, nblk, wv);
        {
          bf16_t* VTs = (bf16_t*)(R + D_VT) + (size_t)TP * 1024;
          {
            const int hf = tid >> 8, tl = tid & 255;
            float* smh = (float*)smem + hf * 4224;
            for (int u0 = bid * 2; u0 < 512 * 16; u0 += nblk * 2) {
              const int u = u0 + hf;
              int st = u & 15, bh = u >> 4, b = bh >> 4, h = bh & 15;
              transpose_tile(p.in[5] + (size_t)b * 1024 * 1024 + h * 64, 1024, 64, VTs + (size_t)(bh * 64) * SPAD, SPAD, 0, st * 64, 0, smh, tl, true);
            }
          }
          for (int e = bid * NT + tid; e < 512 * 64 * 12; e += nblk * NT) {
            int c = e % 12, rw = e / 12;
            { unsigned z = 0; asm volatile("" : "+v"(z)); *(uint2*)(VTs + (size_t)rw * SPAD + NKS + c * 4) = make_uint2(z, z); }
          }
        }
      PHASE_END
      PHASE_BEGIN(11)
        EArgs ea{};
        ea.f0 = p.out + O_DKP; ea.f1 = p.out + O_DKS; ea.f2 = p.out + O_DVP; ea.f3 = p.out + O_DVS;
        ea.f4 = (float*)(R + D_KIR); ea.f5 = (float*)(R + D_WI);
        ea.b0 = (bf16_t*)(R + D_Q); ea.b1 = (bf16_t*)(R + D_K); ea.b2 = (bf16_t*)(R + D_VT); ea.b3 = (bf16_t*)(R + D_QI);
        gemm_phase<E_DSA>(H, Wb + W_DS + WD_P, T, 3840, 1024, ea, smem, 0, bid, nblk, wv);
      PHASE_END
      PHASE_BEGIN(12)
        dsa_rowops(p, bid, nblk, wv);
      PHASE_END
      PHASE_BEGIN(13)
        idx_phase(p, smem, bid, nblk, wv);
      PHASE_END
      PHASE_BEGIN(14)
        attn_phase<false>(p, smem, bid, nblk, wv);
      PHASE_END
      PHASE_BEGIN(6)
        EArgs ea{}; ea.f0 = X;
        gemm_phase<E_RESID>((const bf16_t*)(R + D_AO), Wb + W_DS + WD_O, T, 1024, 1024, ea, smem, 0, bid, nblk, wv);
      PHASE_END
    }
    PHASE_BEGIN(1)
      rmsnorm_rows(X, p.in[8] + L * 1024, H, nullptr, nullptr, bid, nblk, wv);
    PHASE_END
    PHASE_BEGIN(15)
      EArgs ea{}; ea.b0 = (bf16_t*)(R + 0);
      gemm_phase<E_SWIGLU>(H, Wb + W_FF + (size_t)L * WF_SZ + WF_IN, T, 2 * DFF, 1024, ea, smem, 0, bid, nblk, wv);
    PHASE_END
    PHASE_BEGIN(6)
      EArgs ea{}; ea.f0 = X;
      gemm_phase<E_RESID>((const bf16_t*)(R + 0), Wb + W_FF + (size_t)L * WF_SZ + WF_OUT, T, 1024, DFF, ea, smem, 0, bid, nblk, wv);
    PHASE_END
  }
  PHASE_BEGIN(1)
    rmsnorm_rows(X, p.in[9], nullptr, p.out + O_YP, p.out + O_YS, bid, nblk, wv);
  PHASE_END
}

extern "C" void kernel_launch(void* const* d_in, const int* in_sizes, int n_in,
                              void* d_out, int out_size, void* d_ws, size_t ws_size,
                              hipStream_t stream) {
  constexpr int kLds = 128 * 1024 + 64;
  static int grid_blocks = 0;
  if (!grid_blocks) {
    int dev = 0, cus = 0, per_cu = 0;
    (void)hipGetDevice(&dev);
    (void)hipDeviceGetAttribute(&cus, hipDeviceAttributeMultiprocessorCount, dev);
    (void)hipFuncSetAttribute((const void*)mega, hipFuncAttributeMaxDynamicSharedMemorySize, kLds);
    (void)hipOccupancyMaxActiveBlocksPerMultiprocessor(&per_cu, (const void*)mega, NT, kLds);
    if (per_cu < 1) per_cu = 1;
    if (per_cu > 1) per_cu = 1;
    grid_blocks = cus * per_cu;
    fprintf(stderr, "grid %d (cus %d per_cu %d) ws %zu need %zu out %d need %zu\n", grid_blocks, cus, per_cu, ws_size, (size_t)WS_NEED, out_size, (size_t)O_END);
  }
  if (ws_size < WS_NEED || n_in != 31 || (size_t)out_size != O_END) { fprintf(stderr, "kernel_launch: bad sizes\n"); return; }
  Params p;
  memset(&p, 0, sizeof(p));
  for (int i = 0; i < 31; ++i) p.in[i] = (const float*)d_in[i];
  p.out = (float*)d_out; p.ws = (unsigned char*)d_ws;
  bf16_t* Wb = (bf16_t*)((unsigned char*)d_ws + OFF_W);
  int nj = 0, tiles = 0;
  auto add = [&](const float* src, int nsrc, int k, bf16_t* dst, int ndst, int mode) {
    Job& jb = p.jobs[nj++]; jb.src = src; jb.dst = dst; jb.nsrc = nsrc; jb.k = k; jb.ndst = ndst; jb.mode = mode; jb.tile0 = tiles; jb.pad = 0;
    tiles += (ndst / 64) * (k / 64);
  };
  for (int j = 0; j < 2; ++j) {
    bf16_t* Wm = Wb + W_MLA + (size_t)j * WM_SZ;
    add(p.in[10] + (size_t)j * 1024 * 512, 512, 1024, Wm + WM_D, 512, 0);
    add(p.in[13] + (size_t)j * 1024 * 288, 288, 1024, Wb + W_MLA + (size_t)j * WM_SZ + WM_D + (size_t)512 * 1024, 512, 0);
    add(p.in[12] + (size_t)j * 512 * 1536, 1536, 512, Wb + W_MLA + (size_t)j * WM_SZ + WM_UQ, 1536, 0);
    add(p.in[15] + (size_t)j * 256 * 2048, 2048, 256, Wb + W_MLA + (size_t)j * WM_SZ + WM_UKV, 2048, 0);
    add(p.in[16] + (size_t)j * 1024 * 1024, 1024, 1024, Wb + W_MLA + (size_t)j * WM_SZ + WM_O, 1024, 0);
  }
  add(p.in[17], 4096, 1024, Wb + W_CM + WC_IN, 4096, 0);
  add(p.in[22], 1024, 2048, Wb + W_CM + WC_OUT, 1024, 0);
  add(p.in[23], 3072, 1024, Wb + W_DS + WD_P, 3072, 0);
  add(p.in[25], 512, 1024, Wb + W_DS + WD_P + (size_t)3072 * 1024, 512, 0);
  add(p.in[26], 64, 1024, Wb + W_DS + WD_P + (size_t)3584 * 1024, 64, 0);
  add(p.in[28], 8, 1024, Wb + W_DS + WD_P + (size_t)3648 * 1024, 192, 0);
  add(p.in[24], 1024, 1024, Wb + W_DS + WD_O, 1024, 0);
  for (int i = 0; i < 4; ++i) {
    add(p.in[29] + (size_t)i * 1024 * 5632, 5632, 1024, Wb + W_FF + (size_t)i * WF_SZ + WF_IN, 5632, 1);
    add(p.in[30] + (size_t)i * 2816 * 1024, 1024, 2816, Wb + W_FF + (size_t)i * WF_SZ + WF_OUT, 1024, 0);
  }
  p.total_tiles = tiles;
  for (int i = 0; i < 16; ++i) p.inv_freq[i] = pow(10000.0, -(double)i / 16.0);
  p.ph_lo = 0; p.ph_hi = 1000;
  (void)hipMemsetAsync((unsigned char*)d_ws + OFF_BAR, 0, 16384, stream);
  void* args[] = {&p};
  hipError_t e = hipLaunchCooperativeKernel((const void*)mega, dim3(grid_blocks), dim3(NT), args, kLds, stream);
  if (e != hipSuccess) fprintf(stderr, "coop launch failed: %s\n", hipGetErrorString(e));
}
```

```cpp
#include <hip/hip_runtime.h>
#include <hip/hip_cooperative_groups.h>
#include <cstdio>
#include <cstring>
#include <cmath>
namespace cg = cooperative_groups;

typedef unsigned short bf16_t;
using bf16x8 = __attribute__((ext_vector_type(8))) short;
using f32x16 = __attribute__((ext_vector_type(16))) float;
using f32x2v = __attribute__((ext_vector_type(2))) float;
using bf2v = __attribute__((ext_vector_type(2))) __bf16;
#define DI __device__ __forceinline__
#define MFMA32(a, b, c) __builtin_amdgcn_mfma_f32_32x32x16_bf16((a), (b), (c), 0, 0, 0)

constexpr int TP = 16384, TS = 512, T = TP + TS;
constexpr int NT = 512;
constexpr int SPAD = 1088, NKS = 1040;
constexpr int KROWS = TP + 32 * SPAD;
constexpr int DFF = 2816;
constexpr float LOG2E = 1.4426950408889634f;
constexpr float EPS = 1e-6f;

constexpr size_t OFF_X = 0;
constexpr size_t OFF_H = OFF_X + (size_t)T * 1024 * 4;
constexpr size_t OFF_W = OFF_H + (size_t)T * 1024 * 2;
constexpr size_t W_ELEMS = 52822016;
constexpr size_t OFF_ROPE = OFF_W + W_ELEMS * 2;
constexpr size_t OFF_R = OFF_ROPE + (size_t)8192 * 16 * 2 * 4;
constexpr size_t R_RAW = 0;
constexpr size_t R_CQ = R_RAW + (size_t)T * 1024 * 4;
constexpr size_t R_CKV = R_CQ + (size_t)T * 512 * 2;
constexpr size_t R_KR = R_CKV + (size_t)KROWS * 256 * 2;
constexpr size_t R_Q = R_KR + (size_t)KROWS * 32 * 2;
constexpr size_t R_KN = R_Q + (size_t)T * 1536 * 2;
constexpr size_t R_VT = R_KN + (size_t)KROWS * 1024 * 2;
constexpr size_t R_END = R_VT + (size_t)KROWS * 1024 * 2;
constexpr size_t D_Q = 0;
constexpr size_t D_K = D_Q + (size_t)T * 1024 * 2;
constexpr size_t D_VT = D_K + (size_t)KROWS * 1024 * 2;
constexpr size_t D_QI = D_VT + (size_t)KROWS * 1024 * 2;
constexpr size_t D_KIR = D_QI + (size_t)T * 512 * 2;
constexpr size_t D_KI = D_KIR + (size_t)T * 64 * 4;
constexpr size_t D_WI = D_KI + (size_t)KROWS * 64 * 2;
constexpr size_t D_BM = D_WI + (size_t)T * 8 * 4;
constexpr size_t D_AO = D_BM + (size_t)T * 256 * 4;
constexpr size_t D_END = D_AO + (size_t)T * 1024 * 2;
constexpr size_t C_U = 0;
constexpr size_t C_VR = C_U + (size_t)T * 2048 * 2;
constexpr size_t C_VLN = C_VR + (size_t)T * 2048 * 2;
constexpr size_t C_G = C_VLN + (size_t)T * 2048 * 2;
constexpr size_t C_END = C_G + (size_t)T * 2048 * 2;
constexpr size_t OFF_BAR = OFF_R + R_END;
constexpr size_t WS_NEED = OFF_BAR + 16384;
static_assert(D_END <= R_END && C_END <= R_END && (size_t)T * DFF * 2 <= R_END, "region");

constexpr size_t W_MLA = 0;
constexpr size_t WM_D = 0, WM_UQ = 1048576, WM_UKV = WM_UQ + 786432, WM_O = WM_UKV + 524288, WM_SZ = 3407872;
constexpr size_t W_CM = 2 * WM_SZ;
constexpr size_t WC_IN = 0, WC_OUT = 4194304, WC_SZ = 6291456;
constexpr size_t W_DS = W_CM + WC_SZ;
constexpr size_t WD_P = 0, WD_O = 3932160, WD_SZ = 4980736;
constexpr size_t W_FF = W_DS + WD_SZ;
constexpr size_t WF_IN = 0, WF_OUT = 5767168, WF_SZ = 8650752;
constexpr size_t W_TRIL = W_FF + 4 * WF_SZ;
static_assert(W_TRIL + 131072 == W_ELEMS, "w");

constexpr size_t O_YP = 0;
constexpr size_t O_YS = O_YP + (size_t)TP * 1024;
constexpr size_t O_CKVP = O_YS + (size_t)TS * 1024;
constexpr size_t O_KRP = O_CKVP + (size_t)2 * TP * 256;
constexpr size_t O_CKVS = O_KRP + (size_t)2 * TP * 32;
constexpr size_t O_KRS = O_CKVS + (size_t)2 * TS * 256;
constexpr size_t O_CVS = O_KRS + (size_t)2 * TS * 32;
constexpr size_t O_DKP = O_CVS + (size_t)TS * 2048;
constexpr size_t O_DVP = O_DKP + (size_t)TP * 1024;
constexpr size_t O_DIP = O_DVP + (size_t)TP * 1024;
constexpr size_t O_DKS = O_DIP + (size_t)TP * 64;
constexpr size_t O_DVS = O_DKS + (size_t)TS * 1024;
constexpr size_t O_DIS = O_DVS + (size_t)TS * 1024;
constexpr size_t O_END = O_DIS + (size_t)TS * 64;

constexpr int NJOBS = 25;
struct Job { const float* src; bf16_t* dst; int nsrc, k, ndst, mode, tile0, pad; };
struct Params {
  const float* in[31];
  float* out;
  unsigned char* ws;
  Job jobs[NJOBS];
  int total_tiles, ph_lo, ph_hi, pad;
  double inv_freq[16];
};

#define CAS __attribute__((address_space(4)))
typedef const CAS Params CParams;
#define PREF const CAS Params&
DI unsigned pack2(float a, float b) { f32x2v v = {a, b}; bf2v r = __builtin_convertvector(v, bf2v); return __builtin_bit_cast(unsigned, r); }
DI bf16_t tobf(float a) { return (bf16_t)(pack2(a, 0.f) & 0xffffu); }
DI float frombf(bf16_t v) { return __uint_as_float(((unsigned)v) << 16); }
DI float bflo(unsigned u) { return __uint_as_float(u << 16); }
DI float bfhi(unsigned u) { return __uint_as_float(u & 0xffff0000u); }
DI float shflx(float v, int m, int lane) { return __int_as_float(__builtin_amdgcn_ds_bpermute((lane ^ m) << 2, __float_as_int(v))); }
DI float wave_sum(float v, int lane) {
#pragma unroll
  for (int o = 32; o >= 1; o >>= 1) v += shflx(v, o, lane);
  return v;
}
DI int ltid(int wv) { unsigned m1 = ~0u; asm volatile("" : "+s"(m1)); int t = (wv << 6) | (int)__builtin_amdgcn_mbcnt_hi(m1, __builtin_amdgcn_mbcnt_lo(m1, 0u)); asm volatile("" : "+v"(t)); return t; }
DI int crow(int i, int h) { return (i & 3) + 8 * (i >> 2) + 4 * h; }
DI int rowmap(int t) { if (t < TP) return t; int u = t - TP; return TP + (u >> 4) * SPAD + 1024 + (u & 15); }
DI int tokpos(int t) { return t < TP ? (t & 8191) : 1024 + ((t - TP) & 15); }

DI void transpose_tile(const float* __restrict__ src, int src_ld, int ncols, bf16_t* __restrict__ dst, int dst_ld,
                       int n0, int k0, int mode, float* sm, int tid, bool active) {
  const int nl = (tid & 15) * 4, kq = tid >> 4;
  const int n = n0 + nl;
  int c;
  if (mode == 0) c = n < ncols ? n : -1;
  else { int tt = n >> 5, r = n & 31; int f = tt * 16 + (r & 15); c = (r < 16) ? f : DFF + f; }
  if (active) {
    float4 v[4];
#pragma unroll
    for (int i = 0; i < 4; ++i) {
      int kk = kq + 16 * i;
      v[i] = (c >= 0) ? *(const float4*)(src + (size_t)(k0 + kk) * src_ld + c) : make_float4(0.f, 0.f, 0.f, 0.f);
    }
#pragma unroll
    for (int i = 0; i < 4; ++i) {
      int kk = kq + 16 * i;
      float* d = sm + kk * 65 + nl;
      d[0] = v[i].x; d[1] = v[i].y; d[2] = v[i].z; d[3] = v[i].w;
    }
  }
  __syncthreads();
  if (active) {
    const int kp = (tid & 31) * 2, nr = tid >> 5;
#pragma unroll 4
    for (int i = 0; i < 8; ++i) {
      int nn = nr + 8 * i;
      float a = sm[kp * 65 + nn], b = sm[(kp + 1) * 65 + nn];
      *(unsigned*)(dst + (size_t)(n0 + nn) * dst_ld + k0 + kp) = pack2(a, b);
    }
  }
  __syncthreads();
}

enum { E_F32 = 0, E_RESID, E_SWIGLU, E_GELU, E_MLAQ, E_MLAKV, E_DSA };
struct EArgs {
  float* f0; float* f1; float* f2; float* f3; float* f4; float* f5; float* f6;
  bf16_t* b0; bf16_t* b1; bf16_t* b2; bf16_t* b3;
  const float* rope;
};
using f32x4v = __attribute__((ext_vector_type(4))) float;
#define LAS __attribute__((address_space(3)))
constexpr int G_HT = 128 * 64;
DI int lds_byte(int r, int c) {
  int st = (r >> 4) * 2 + (c >> 5), rr = r & 15, cc = c & 31, ob = rr * 64 + cc * 2;
  return st * 1024 + (ob ^ (((ob >> 9) & 1) << 5));
}
DI void stage_rc(int b, int& R, int& C) {
  int st = b >> 10, sb = b & 1023, swz = sb ^ (((sb >> 9) & 1) << 5);
  R = (st >> 1) * 16 + (swz >> 6); C = (st & 1) * 32 + ((swz & 63) >> 1);
}

template <int EPI, bool ATOM>
DI void epi16(const EArgs& ea, int row0, int gb, int fr, const f32x4v& v0, const f32x4v& v1) {
  if constexpr (EPI == E_F32) {
#pragma unroll
    for (int j = 0; j < 4; ++j) { float* o = ea.f0 + (size_t)(row0 + j) * 1024 + gb + fr; o[0] = v0[j]; o[16] = v1[j]; }
  } else if constexpr (EPI == E_RESID) {
#pragma unroll
    for (int j = 0; j < 4; ++j) { float* o = ea.f0 + (size_t)(row0 + j) * 1024 + gb + fr;
      if constexpr (ATOM) { unsafeAtomicAdd(o, v0[j]); unsafeAtomicAdd(o + 16, v1[j]); } else { o[0] += v0[j]; o[16] += v1[j]; } }
  } else if constexpr (EPI == E_SWIGLU) {
    const int f = (gb >> 1) + fr;
#pragma unroll
    for (int j = 0; j < 4; ++j) { float g = v0[j], u = v1[j]; ea.b0[(size_t)(row0 + j) * DFF + f] = tobf(g / (1.f + __expf(-g)) * u); }
  } else if constexpr (EPI == E_GELU) {
    bf16_t* dstp = (gb < 2048) ? (ea.b0 + gb + fr) : (ea.b1 + (gb - 2048) + fr);
#pragma unroll
    for (int j = 0; j < 4; ++j) {
      float x = v0[j], y = v1[j];
      dstp[(size_t)(row0 + j) * 2048] = tobf(0.5f * x * (1.f + erff(x * 0.70710678118654752f)));
      dstp[(size_t)(row0 + j) * 2048 + 16] = tobf(0.5f * y * (1.f + erff(y * 0.70710678118654752f)));
    }
  } else if constexpr (EPI == E_MLAQ) {
    const float qs = 0.10206207261596577f * LOG2E;
    const bool is_rope = (gb % 96) == 64;
#pragma unroll
    for (int j = 0; j < 4; ++j) {
      const int row = row0 + j;
      float o0 = v0[j], o1 = v1[j];
      if (is_rope) {
        float2 cs = *(const float2*)(ea.rope + ((size_t)tokpos(row) * 16 + fr) * 2);
        o0 = v0[j] * cs.x - v1[j] * cs.y; o1 = v0[j] * cs.y + v1[j] * cs.x;
      }
      bf16_t* o = ea.b0 + (size_t)row * 1536 + gb + fr;
      o[0] = tobf(o0 * qs); o[16] = tobf(o1 * qs);
    }
  } else if constexpr (EPI == E_MLAKV) {
    const int head = gb >> 7, c0 = gb & 127;
    if (c0 < 64) {
#pragma unroll
      for (int j = 0; j < 4; ++j) { bf16_t* o = ea.b0 + (size_t)(row0 + j) * 1024 + head * 64 + c0 + fr; o[0] = tobf(v0[j]); o[16] = tobf(v1[j]); }
    } else {
      const int d = c0 - 64 + fr;
      size_t off;
      if (row0 < TP) { int b = row0 >> 13, s = row0 & 8191; off = ((size_t)((b * 16 + head) * 64 + d)) * 8192 + s;
        uint2 pk; pk.x = pack2(v0[0], v0[1]); pk.y = pack2(v0[2], v0[3]); *(uint2*)(ea.b1 + off) = pk;
        pk.x = pack2(v1[0], v1[1]); pk.y = pack2(v1[2], v1[3]); *(uint2*)(ea.b1 + off + (size_t)16 * 8192) = pk;
      } else { int u = row0 - TP; int b = u / SPAD, s = u - b * SPAD; off = (size_t)TP * 1024 + ((size_t)((b * 16 + head) * 64 + d)) * SPAD + s;
        uint2 pk; pk.x = pack2(v0[0], v0[1]); pk.y = pack2(v0[2], v0[3]); *(uint2*)(ea.b1 + off) = pk;
        pk.x = pack2(v1[0], v1[1]); pk.y = pack2(v1[2], v1[3]); *(uint2*)(ea.b1 + off + (size_t)16 * SPAD) = pk;
      }
    }
  } else if constexpr (EPI == E_DSA) {
    if (gb < 1024) {
      const float qs = 0.125f * LOG2E;
#pragma unroll
      for (int j = 0; j < 4; ++j) { bf16_t* o = ea.b0 + (size_t)(row0 + j) * 1024 + gb + fr; o[0] = tobf(v0[j] * qs); o[16] = tobf(v1[j] * qs); }
    } else if (gb < 2048) {
      const int c = gb - 1024 + fr;
#pragma unroll
      for (int j = 0; j < 4; ++j) {
        const int row = row0 + j;
        float* o = (row < TP) ? ea.f0 + (size_t)row * 1024 + c : ea.f1 + (size_t)(row - TP) * 1024 + c;
        o[0] = v0[j]; o[16] = v1[j];
        bf16_t* ob = ea.b1 + (size_t)rowmap(row) * 1024 + c;
        ob[0] = tobf(v0[j]); ob[16] = tobf(v1[j]);
      }
    } else if (gb < 3072) {
      const int c = gb - 2048 + fr, head = c >> 6, d = c & 63;
#pragma unroll
      for (int j = 0; j < 4; ++j) {
        const int row = row0 + j;
        float* o = (row < TP) ? ea.f2 + (size_t)row * 1024 + c : ea.f3 + (size_t)(row - TP) * 1024 + c;
        o[0] = v0[j]; o[16] = v1[j];
      }
      size_t off, dstr;
      if (row0 < TP) { int b = row0 >> 13, s = row0 & 8191; off = ((size_t)((b * 16 + head) * 64 + d)) * 8192 + s; dstr = 8192; }
      else { int u = row0 - TP; int b = u >> 4, s = 1024 + (u & 15); off = (size_t)TP * 1024 + ((size_t)((b * 16 + head) * 64 + d)) * SPAD + s; dstr = SPAD; }
      uint2 pk; pk.x = pack2(v0[0], v0[1]); pk.y = pack2(v0[2], v0[3]); *(uint2*)(ea.b2 + off) = pk;
      pk.x = pack2(v1[0], v1[1]); pk.y = pack2(v1[2], v1[3]); *(uint2*)(ea.b2 + off + 16 * dstr) = pk;
    } else if (gb < 3584) {
      const int c = gb - 3072 + fr;
#pragma unroll
      for (int j = 0; j < 4; ++j) { bf16_t* o = ea.b3 + (size_t)(row0 + j) * 512 + c; o[0] = tobf(v0[j] * 0.125f); o[16] = tobf(v1[j] * 0.125f); }
    } else if (gb < 3648) {
      const int c = gb - 3584 + fr;
#pragma unroll
      for (int j = 0; j < 4; ++j) { float* o = ea.f4 + (size_t)(row0 + j) * 64 + c; o[0] = v0[j]; o[16] = v1[j]; }
    } else if (gb == 3648) {
      if (fr < 8) {
#pragma unroll
        for (int j = 0; j < 4; ++j) ea.f5[(size_t)(row0 + j) * 8 + fr] = v0[j] * 0.35355339059327379f;
      }
    }
  }
}

template <int EPI, bool ATOM>
DI void gemm256_tile(const bf16_t* __restrict__ A, const bf16_t* __restrict__ Bt, const int K, const int kt0, const int nt, const int brow, const int bcol,
                     const EArgs& ea, unsigned char* smem, int wv) {
  bf16_t* shm = (bf16_t*)smem;
  const int tid = ltid(wv);
#define SA(b, h) (shm + ((b) * 2 + (h)) * G_HT)
#define SB(b, h) (shm + (4 + (b) * 2 + (h)) * G_HT)
#define STAGE(P, BASE, br, kt) do { const char* _gb = (const char*)((BASE) + (long)(br) * K + (long)((kt) + kt0) * 64); \
    __builtin_amdgcn_global_load_lds((const unsigned*)(_gb + voff0), (LAS unsigned*)((char*)(P) + tid * 16), 16, 0, 0); \
    __builtin_amdgcn_global_load_lds((const unsigned*)(_gb + voff1), (LAS unsigned*)((char*)(P) + tid * 16 + 8192), 16, 0, 0); } while (0)
#define LDA(dst, b, h) _Pragma("unroll") for (int m = 0; m < 4; ++m) _Pragma("unroll") for (int k = 0; k < 2; ++k) \
    dst[m][k] = *reinterpret_cast<const bf16x8*>((char*)SA(b, h) + lds_byte(wr * 64 + m * 16 + fr, k * 32 + fq * 8))
#define LDB(dst, b, h) _Pragma("unroll") for (int n = 0; n < 2; ++n) _Pragma("unroll") for (int k = 0; k < 2; ++k) \
    dst[n][k] = *reinterpret_cast<const bf16x8*>((char*)SB(b, h) + lds_byte(wc * 32 + n * 16 + fr, k * 32 + fq * 8))
#define MMA(ai, bj, At_, Bt_) do { __builtin_amdgcn_s_setprio(1); \
    _Pragma("unroll") for (int m = 0; m < 4; ++m) _Pragma("unroll") for (int n = 0; n < 2; ++n) _Pragma("unroll") for (int k = 0; k < 2; ++k) \
      acc[ai][bj][m][n] = __builtin_amdgcn_mfma_f32_16x16x32_bf16(At_[m][k], Bt_[n][k], acc[ai][bj][m][n], 0, 0, 0); \
    __builtin_amdgcn_s_setprio(0); } while (0)
#define WAIT_V(n) asm volatile("s_waitcnt vmcnt(" #n ")" ::: "memory")
#define WAIT_L(n) asm volatile("s_waitcnt lgkmcnt(" #n ")" ::: "memory")
#define BAR __builtin_amdgcn_s_barrier()
#define SCHED __builtin_amdgcn_sched_barrier(0)
  const int wid = tid >> 6, lane = tid & 63, wr = wid >> 2, wc = wid & 3, fr = lane & 15, fq = lane >> 4;
  unsigned voff0, voff1;
  { int r_, c_; stage_rc(tid * 16, r_, c_); voff0 = (unsigned)(r_ * K + c_) * 2u; stage_rc(tid * 16 + 8192, r_, c_); voff1 = (unsigned)(r_ * K + c_) * 2u; }
  f32x4v acc[2][2][4][2];
#pragma unroll
  for (int a = 0; a < 2; ++a)
#pragma unroll
    for (int b = 0; b < 2; ++b)
#pragma unroll
      for (int m = 0; m < 4; ++m)
#pragma unroll
        for (int n = 0; n < 2; ++n) acc[a][b][m][n] = (f32x4v){0.f, 0.f, 0.f, 0.f};
  bf16x8 At[4][2], B0[2][2], B1[2][2];
  const int HALF = 128;
  WAIT_V(0); WAIT_L(0); BAR;
  STAGE(SB(0, 0), Bt, bcol, 0); STAGE(SA(0, 0), A, brow, 0);
  STAGE(SB(0, 1), Bt, bcol + HALF, 0); STAGE(SA(0, 1), A, brow + HALF, 0);
  if (wr == 1) BAR;
  WAIT_V(4); BAR;
  STAGE(SB(1, 0), Bt, bcol, 1); STAGE(SA(1, 0), A, brow, 1); STAGE(SB(1, 1), Bt, bcol + HALF, 1);
  WAIT_V(6); BAR;
  for (int t = 0; t < nt - 2; t += 2) {
    LDB(B0, 0, 0); SCHED; LDA(At, 0, 0); STAGE(SA(1, 1), A, brow + HALF, t + 1);
    WAIT_L(8); BAR; WAIT_L(0); MMA(0, 0, At, B0); BAR; SCHED;
    LDB(B1, 0, 1); STAGE(SB(0, 0), Bt, bcol, t + 2);
    BAR; WAIT_L(0); MMA(0, 1, At, B1); BAR;
    LDA(At, 0, 1); STAGE(SA(0, 0), A, brow, t + 2);
    BAR; WAIT_L(0); MMA(1, 0, At, B0); BAR; SCHED;
    STAGE(SB(0, 1), Bt, bcol + HALF, t + 2);
    WAIT_V(6); BAR; MMA(1, 1, At, B1); BAR;
    LDB(B0, 1, 0); SCHED; LDA(At, 1, 0); STAGE(SA(0, 1), A, brow + HALF, t + 2);
    WAIT_L(8); BAR; WAIT_L(0); MMA(0, 0, At, B0); BAR; SCHED;
    LDB(B1, 1, 1); STAGE(SB(1, 0), Bt, bcol, t + 3);
    BAR; WAIT_L(0); MMA(0, 1, At, B1); BAR;
    LDA(At, 1, 1); STAGE(SA(1, 0), A, brow, t + 3);
    BAR; WAIT_L(0); MMA(1, 0, At, B0); BAR; SCHED;
    STAGE(SB(1, 1), Bt, bcol + HALF, t + 3);
    WAIT_V(6); BAR; MMA(1, 1, At, B1); BAR;
  }
  { LDB(B0, 0, 0); LDA(At, 0, 0); STAGE(SA(1, 1), A, brow + HALF, nt - 1);
    BAR; WAIT_L(0); MMA(0, 0, At, B0); BAR;
    LDB(B1, 0, 1); BAR; WAIT_L(0); MMA(0, 1, At, B1); BAR;
    LDA(At, 0, 1); WAIT_V(4); BAR; WAIT_L(0); MMA(1, 0, At, B0); MMA(1, 1, At, B1); BAR; }
  { LDB(B0, 1, 0); LDA(At, 1, 0); WAIT_V(2); BAR; WAIT_L(0); MMA(0, 0, At, B0); BAR;
    LDB(B1, 1, 1); WAIT_V(0); BAR; WAIT_L(0); MMA(0, 1, At, B1); BAR;
    LDA(At, 1, 1); BAR; WAIT_L(0); MMA(1, 0, At, B0); MMA(1, 1, At, B1); BAR; }
  if (wr == 0) BAR;
#pragma unroll
  for (int ai = 0; ai < 2; ++ai)
#pragma unroll
    for (int bj = 0; bj < 2; ++bj)
#pragma unroll
      for (int m = 0; m < 4; ++m)
      { epi16<EPI, ATOM>(ea, brow + ai * 128 + wr * 64 + m * 16 + fq * 4, bcol + bj * 128 + wc * 32, fr, acc[ai][bj][m][0], acc[ai][bj][m][1]); __builtin_amdgcn_sched_barrier(0); }
#undef SA
#undef SB
#undef STAGE
#undef LDA
#undef LDB
#undef MMA
#undef WAIT_V
#undef WAIT_L
#undef BAR
#undef SCHED
}

DI void tile_map(int t, int nM, int nN, int nwg, int& pm, int& pn) {
  int wgid = t;
  { int q = nwg >> 3, r = nwg & 7, xcd = wgid & 7, off = wgid >> 3; wgid = (xcd < r ? xcd * (q + 1) : r * (q + 1) + (xcd - r) * q) + off; }
  const int nig = 8 * nN, gid = wgid / nig, fm = gid * 8, gsz = min(nM - fm, 8);
  pm = fm + ((wgid % nig) % gsz); pn = (wgid % nig) / gsz;
}
template <int EPI>
DI void gemm_phase(const bf16_t* A, const bf16_t* Bt, int M, int N, int K, const EArgs& ea,
                   unsigned char* smem, int tstart, int bid, int nblk, int wv) {
  const int nM = M >> 8, nN = N >> 8, nwg = nM * nN, nt = K >> 6;
  if constexpr (EPI == E_RESID) {
    const int nfull = (nwg / nblk) * nblk, rem = nwg - nfull;
    for (int t = bid; t < nfull; t += nblk) {
      int pm, pn; tile_map(t, nM, nN, nwg, pm, pn);
      gemm256_tile<EPI, false>(A, Bt, K, 0, nt, pm * 256, pn * 256, ea, smem, wv);
    }
    if (rem > 0) {
      int ns = nblk / rem; if (ns > (nt >> 2)) ns = nt >> 2; if (ns < 1) ns = 1;
      const int per = ((nt / ns) >> 1) << 1;
      for (int u = bid; u < rem * ns; u += nblk) {
        const int t = nfull + u / ns, ks = u % ns;
        const int k0 = ks * per, kn = (ks == ns - 1) ? (nt - k0) : per;
        int pm, pn; tile_map(t, nM, nN, nwg, pm, pn);
        gemm256_tile<EPI, true>(A, Bt, K, k0, kn, pm * 256, pn * 256, ea, smem, wv);
      }
    }
  } else {
    int t0 = bid - (tstart % nblk); if (t0 < 0) t0 += nblk;
    for (int t = t0; t < nwg; t += nblk) {
      int pm, pn; tile_map(t, nM, nN, nwg, pm, pn);
      gemm256_tile<EPI, false>(A, Bt, K, 0, nt, pm * 256, pn * 256, ea, smem, wv);
    }
  }
}

DI void rmsnorm_rows(const float* __restrict__ X, const float* __restrict__ g, bf16_t* __restrict__ H, float* outp, float* outs,
                     int bid, int nblk, int wv) {
  const int lane = ltid(wv) & 63, w = ltid(wv) >> 6;
  for (int row = bid * 8 + w; row < T; row += nblk * 8) {
    const float* xr = X + (size_t)row * 1024;
    float4 v[4];
    float ss = 0.f;
#pragma unroll
    for (int c = 0; c < 4; ++c) { v[c] = *(const float4*)(xr + c * 256 + lane * 4); ss += v[c].x * v[c].x + v[c].y * v[c].y + v[c].z * v[c].z + v[c].w * v[c].w; }
    ss = wave_sum(ss, lane);
    float r = rsqrtf(ss * (1.f / 1024.f) + EPS);
#pragma unroll
    for (int c = 0; c < 4; ++c) {
      int col = c * 256 + lane * 4;
      float4 gg = *(const float4*)(g + col);
      float a = v[c].x * r * gg.x, b = v[c].y * r * gg.y, cc = v[c].z * r * gg.z, d = v[c].w * r * gg.w;
      if (H) { uint2 pk; pk.x = pack2(a, b); pk.y = pack2(cc, d); *(uint2*)(H + (size_t)row * 1024 + col) = pk; }
      else {
        float* o = (row < TP) ? outp + (size_t)row * 1024 + col : outs + (size_t)(row - TP) * 1024 + col;
        *(float4*)o = make_float4(a, b, cc, d);
      }
    }
  }
}

DI void mla_rowops(PREF p, int j, int bid, int nblk, int wv) {
  const int lane = ltid(wv) & 63, w = ltid(wv) >> 6;
  unsigned char* R = p.ws + OFF_R;
  const float* RAW = (const float*)(R + R_RAW);
  bf16_t* CQ = (bf16_t*)(R + R_CQ); bf16_t* CKV = (bf16_t*)(R + R_CKV); bf16_t* KR = (bf16_t*)(R + R_KR);
  const float* gq = p.in[11] + j * 512; const float* gkv = p.in[14] + j * 256;
  const float* rope = (const float*)(p.ws + OFF_ROPE);
  for (int row = bid * 8 + w; row < T; row += nblk * 8) {
    const float* rr = RAW + (size_t)row * 1024;
    float4 a0 = *(const float4*)(rr + lane * 4), a1 = *(const float4*)(rr + 256 + lane * 4);
    float4 c0 = *(const float4*)(rr + 512 + lane * 4);
    float ss = a0.x * a0.x + a0.y * a0.y + a0.z * a0.z + a0.w * a0.w + a1.x * a1.x + a1.y * a1.y + a1.z * a1.z + a1.w * a1.w;
    float s2 = c0.x * c0.x + c0.y * c0.y + c0.z * c0.z + c0.w * c0.w;
    ss = wave_sum(ss, lane); s2 = wave_sum(s2, lane);
    float r1 = rsqrtf(ss * (1.f / 512.f) + EPS), r2 = rsqrtf(s2 * (1.f / 256.f) + EPS);
    {
      float4 g0 = *(const float4*)(gq + lane * 4), g1 = *(const float4*)(gq + 256 + lane * 4);
      uint2 pk; pk.x = pack2(a0.x * r1 * g0.x, a0.y * r1 * g0.y); pk.y = pack2(a0.z * r1 * g0.z, a0.w * r1 * g0.w);
      *(uint2*)(CQ + (size_t)row * 512 + lane * 4) = pk;
      pk.x = pack2(a1.x * r1 * g1.x, a1.y * r1 * g1.y); pk.y = pack2(a1.z * r1 * g1.z, a1.w * r1 * g1.w);
      *(uint2*)(CQ + (size_t)row * 512 + 256 + lane * 4) = pk;
    }
    const int rm = rowmap(row);
    {
      float4 g = *(const float4*)(gkv + lane * 4);
      float4 o = make_float4(c0.x * r2 * g.x, c0.y * r2 * g.y, c0.z * r2 * g.z, c0.w * r2 * g.w);
      float* op = (row < TP) ? p.out + O_CKVP + ((size_t)j * TP + row) * 256 : p.out + O_CKVS + ((size_t)j * TS + (row - TP)) * 256;
      *(float4*)(op + lane * 4) = o;
      uint2 pk; pk.x = pack2(o.x, o.y); pk.y = pack2(o.z, o.w);
      *(uint2*)(CKV + (size_t)rm * 256 + lane * 4) = pk;
    }
    if (lane < 16) {
      float x1 = rr[768 + lane], x2 = rr[784 + lane];
      int pos = tokpos(row);
      float2 cs = *(const float2*)(rope + ((size_t)pos * 16 + lane) * 2);
      float o1 = x1 * cs.x - x2 * cs.y, o2 = x1 * cs.y + x2 * cs.x;
      float* op = (row < TP) ? p.out + O_KRP + ((size_t)j * TP + row) * 32 : p.out + O_KRS + ((size_t)j * TS + (row - TP)) * 32;
      op[lane] = o1; op[16 + lane] = o2;
      KR[(size_t)rm * 32 + lane] = tobf(o1); KR[(size_t)rm * 32 + 16 + lane] = tobf(o2);
    }
  }
}

DI void dsa_rowops(PREF p, int bid, int nblk, int wv) {
  const int lane = ltid(wv) & 63, w = ltid(wv) >> 6;
  unsigned char* R = p.ws + OFF_R;
  const float* KIR = (const float*)(R + D_KIR);
  bf16_t* KI = (bf16_t*)(R + D_KI);
  const float* g = p.in[27];
  for (int row = bid * 8 + w; row < T; row += nblk * 8) {
    float v = KIR[(size_t)row * 64 + lane];
    float ss = wave_sum(v * v, lane);
    float r = rsqrtf(ss * (1.f / 64.f) + EPS);
    float o = v * r * g[lane];
    if (row < TP) p.out[O_DIP + (size_t)row * 64 + lane] = o; else p.out[O_DIS + (size_t)(row - TP) * 64 + lane] = o;
    KI[(size_t)rowmap(row) * 64 + lane] = tobf(o);
  }
}

DI void cmlp_ln_rows(PREF p, int bid, int nblk, int wv) {
  const int lane = ltid(wv) & 63, w = ltid(wv) >> 6;
  unsigned char* R = p.ws + OFF_R;
  const bf16_t* VR = (const bf16_t*)(R + C_VR);
  bf16_t* VLN = (bf16_t*)(R + C_VLN);
  const float* g = p.in[18]; const float* bb = p.in[19];
  for (int row = bid * 8 + w; row < T; row += nblk * 8) {
    float x[32];
    float sum = 0.f;
#pragma unroll
    for (int c = 0; c < 4; ++c) {
      uint4 u = *(const uint4*)(VR + (size_t)row * 2048 + c * 512 + lane * 8);
      x[c * 8 + 0] = bflo(u.x); x[c * 8 + 1] = bfhi(u.x); x[c * 8 + 2] = bflo(u.y); x[c * 8 + 3] = bfhi(u.y);
      x[c * 8 + 4] = bflo(u.z); x[c * 8 + 5] = bfhi(u.z); x[c * 8 + 6] = bflo(u.w); x[c * 8 + 7] = bfhi(u.w);
    }
#pragma unroll
    for (int i = 0; i < 32; ++i) sum += x[i];
    sum = wave_sum(sum, lane);
    float mu = sum * (1.f / 2048.f);
    float vs = 0.f;
#pragma unroll
    for (int i = 0; i < 32; ++i) { x[i] -= mu; vs += x[i] * x[i]; }
    vs = wave_sum(vs, lane);
    float r = rsqrtf(vs * (1.f / 2048.f) + EPS);
#pragma unroll
    for (int c = 0; c < 4; ++c) {
      int col = c * 512 + lane * 8;
      float y[8];
#pragma unroll
      for (int q = 0; q < 2; ++q) {
        float4 gg = *(const float4*)(g + col + q * 4), b4 = *(const float4*)(bb + col + q * 4);
        y[q * 4 + 0] = x[c * 8 + q * 4 + 0] * r * gg.x + b4.x; y[q * 4 + 1] = x[c * 8 + q * 4 + 1] * r * gg.y + b4.y;
        y[q * 4 + 2] = x[c * 8 + q * 4 + 2] * r * gg.z + b4.z; y[q * 4 + 3] = x[c * 8 + q * 4 + 3] * r * gg.w + b4.w;
      }
      uint4 pk; pk.x = pack2(y[0], y[1]); pk.y = pack2(y[2], y[3]); pk.z = pack2(y[4], y[5]); pk.w = pack2(y[6], y[7]);
      *(uint4*)(VLN + (size_t)row * 2048 + col) = pk;
      if (row >= TP) {
        float* o = p.out + O_CVS + (size_t)(row - TP) * 2048 + col;
        *(float4*)o = make_float4(y[0], y[1], y[2], y[3]); *(float4*)(o + 4) = make_float4(y[4], y[5], y[6], y[7]);
      }
    }
  }
}

DI void cmlp_mix_phase(PREF p, unsigned char* smem, int bid, int nblk, int wv) {
  const int tid = ltid(wv), lane = tid & 63, w = tid >> 6, wm = w >> 2, wn = w & 3, lr = lane & 31, lh = lane >> 5;
  unsigned char* R = p.ws + OFF_R;
  const bf16_t* U = (const bf16_t*)(R + C_U);
  const bf16_t* VLN = (const bf16_t*)(R + C_VLN);
  bf16_t* G = (bf16_t*)(R + C_G);
  const bf16_t* WT = (const bf16_t*)(p.ws + OFF_W) + W_TRIL;
  const float* bs = p.in[21];
  bf16_t* As = (bf16_t*)smem;
  bf16_t* Bs = As + 128 * 136;
  for (int u = bid; u < 1024; u += nblk) {
    const int g = u & 7, ch = u >> 3;
    const int col0 = g * 256;
#pragma unroll 2
    for (int i = 0; i < 4; ++i) {
      int v = tid + i * NT; int r = v >> 4, c = (v & 15) * 8;
      *(uint4*)(As + r * 136 + c) = *(const uint4*)(WT + ((size_t)g * 128 + r) * 128 + c);
    }
#pragma unroll 2
    for (int i = 0; i < 8; ++i) {
      int v = tid + i * NT; int s = v >> 5, c = (v & 31) * 8;
      uint4 x = *(const uint4*)(VLN + ((size_t)ch * 128 + s) * 2048 + col0 + c);
      Bs[(c + 0) * 136 + s] = (bf16_t)(x.x & 0xffff); Bs[(c + 1) * 136 + s] = (bf16_t)(x.x >> 16);
      Bs[(c + 2) * 136 + s] = (bf16_t)(x.y & 0xffff); Bs[(c + 3) * 136 + s] = (bf16_t)(x.y >> 16);
      Bs[(c + 4) * 136 + s] = (bf16_t)(x.z & 0xffff); Bs[(c + 5) * 136 + s] = (bf16_t)(x.z >> 16);
      Bs[(c + 6) * 136 + s] = (bf16_t)(x.w & 0xffff); Bs[(c + 7) * 136 + s] = (bf16_t)(x.w >> 16);
    }
    __syncthreads();
    f32x16 acc[2][2];
#pragma unroll
    for (int a = 0; a < 2; ++a)
#pragma unroll
      for (int b = 0; b < 2; ++b)
#pragma unroll
        for (int i = 0; i < 16; ++i) acc[a][b][i] = 0.f;
    const bf16_t* Asb = As + (wm * 64 + lr) * 136 + lh * 8;
    const bf16_t* Bsb = Bs + (wn * 64 + lr) * 136 + lh * 8;
    const int ns = (wm + 1) * 4;
    for (int s = 0; s < ns; ++s) {
      bf16x8 a0 = *(const bf16x8*)(Asb + s * 16);
      bf16x8 a1 = *(const bf16x8*)(Asb + 32 * 136 + s * 16);
      bf16x8 b0 = *(const bf16x8*)(Bsb + s * 16);
      bf16x8 b1 = *(const bf16x8*)(Bsb + 32 * 136 + s * 16);
      acc[0][0] = MFMA32(a0, b0, acc[0][0]);
      acc[0][1] = MFMA32(a0, b1, acc[0][1]);
      acc[1][0] = MFMA32(a1, b0, acc[1][0]);
      acc[1][1] = MFMA32(a1, b1, acc[1][1]);
    }
#pragma unroll
    for (int mi = 0; mi < 2; ++mi)
#pragma unroll
      for (int ni = 0; ni < 2; ++ni)
#pragma unroll
        for (int i = 0; i < 16; ++i) {
          int t = wm * 64 + mi * 32 + crow(i, lh);
          int col = col0 + wn * 64 + ni * 32 + lr;
          size_t off = ((size_t)ch * 128 + t) * 2048 + col;
          float mixed = acc[mi][ni][i] + bs[g * 128 + t];
          G[off] = tobf(frombf(U[off]) * mixed);
        }
    __syncthreads();
  }
  const float* wsf = p.in[20];
  for (int e = bid * NT + tid; e < TS * 2048; e += nblk * NT) {
    int row = e >> 11, col = e & 2047, b = row >> 4, t = row & 15, g = col >> 8;
    float a = bs[g * 128 + t];
    for (int s = 0; s <= t; ++s) a += wsf[((size_t)g * 128 + t) * 128 + s] * frombf(VLN[((size_t)TP + b * 16 + s) * 2048 + col]);
    size_t off = ((size_t)TP + row) * 2048 + col;
    G[off] = tobf(frombf(U[off]) * a);
  }
}

template <int DQK, bool IS_MLA, bool MASKED>
DI void attn_unit(const bf16_t* __restrict__ Qp, int ldq, int nq,
                  const bf16_t* __restrict__ Kp, int ldk, const bf16_t* __restrict__ KRp,
                  const bf16_t* __restrict__ Vtp, int ldv,
                  int nkt, int nkt_w, int nkeys, const unsigned* __restrict__ BMp,
                  bf16_t* __restrict__ AOp, unsigned char* smem_half, int wv) {
  constexpr int KS = DQK + 8;
  constexpr int VS = 68;
  constexpr int NQS = DQK / 16;
  const int tid = ltid(wv) & 255, lane = tid & 63, w = tid >> 6, lr = lane & 31, lh = lane >> 5;
  bf16_t* Ks = (bf16_t*)smem_half;
  bf16_t* Vs = Ks + 2 * 64 * KS;
  const bool q_ok = (w * 32 + lr) < nq;
  const int qrow = q_ok ? (w * 32 + lr) : 0;
  bf16x8 qf[NQS];
#pragma unroll
  for (int s = 0; s < NQS; ++s) qf[s] = *(const bf16x8*)(Qp + (size_t)qrow * ldq + s * 16 + lh * 8);
  f32x16 oacc[2];
#pragma unroll
  for (int d = 0; d < 2; ++d)
#pragma unroll
    for (int i = 0; i < 16; ++i) oacc[d][i] = 0.f;
  float m_run = -INFINITY, l_run = 0.f;
  const int kkey = tid >> 3, kc = (tid & 7) * 8;
  const int rkey = tid >> 2, rc = (tid & 3) * 8;
  const int vd = tid >> 3, vk = (tid & 7) * 8;
  uint4 rk[2], rr, rv[2];
  rr = make_uint4(0, 0, 0, 0);
  uint2 bm_next = make_uint2(0xffffffffu, 0xffffffffu), bm_cur = bm_next;
  auto gload = [&](int kt) {
    const int key0 = kt * 64;
#pragma unroll
    for (int i = 0; i < 2; ++i) rk[i] = *(const uint4*)(Kp + (size_t)(key0 + kkey + 32 * i) * ldk + kc);
    if constexpr (IS_MLA) rr = *(const uint4*)(KRp + (size_t)(key0 + rkey) * 32 + rc);
#pragma unroll
    for (int i = 0; i < 2; ++i) rv[i] = *(const uint4*)(Vtp + (size_t)(vd + 32 * i) * ldv + key0 + vk);
    if constexpr (MASKED) { if (BMp) bm_next = *(const uint2*)(BMp + (size_t)qrow * 256 + kt * 2); }
  };
  auto sstore = [&](int buf) {
    bf16_t* Kb = Ks + buf * 64 * KS; bf16_t* Vb = Vs + buf * 64 * VS;
#pragma unroll
    for (int i = 0; i < 2; ++i) *(uint4*)(Kb + (kkey + 32 * i) * KS + kc) = rk[i];
    if constexpr (IS_MLA) *(uint4*)(Kb + rkey * KS + 64 + rc) = rr;
#pragma unroll
    for (int i = 0; i < 2; ++i) {
      uint2 lo = make_uint2(rv[i].x, rv[i].y), hi = make_uint2(rv[i].z, rv[i].w);
      *(uint2*)(Vb + (vd + 32 * i) * VS + vk) = lo;
      *(uint2*)(Vb + (vd + 32 * i) * VS + vk + 4) = hi;
    }
  };
  __syncthreads();
  gload(0); sstore(0); bm_cur = bm_next;
  __syncthreads();
  for (int kt = 0; kt < nkt; ++kt) {
    const int buf = kt & 1;
    if (kt + 1 < nkt) gload(kt + 1);
    if (kt < nkt_w) {
      const bf16_t* Kb = Ks + buf * 64 * KS; const bf16_t* Vb = Vs + buf * 64 * VS;
      const uint2 bmw = bm_cur;
      f32x16 sacc[2];
#pragma unroll
      for (int mt = 0; mt < 2; ++mt) {
#pragma unroll
        for (int i = 0; i < 16; ++i) sacc[mt][i] = 0.f;
#pragma unroll
        for (int s = 0; s < NQS; ++s) {
          bf16x8 kf = *(const bf16x8*)(Kb + (mt * 32 + lr) * KS + s * 16 + lh * 8);
          sacc[mt] = MFMA32(kf, qf[s], sacc[mt]);
        }
      }
      float mx = -INFINITY;
#pragma unroll
      for (int mt = 0; mt < 2; ++mt) {
        const unsigned wbits = mt ? bmw.y : bmw.x;
#pragma unroll
        for (int i = 0; i < 16; ++i) {
          if constexpr (MASKED) {
            const int kin = crow(i, lh);
            const int key = kt * 64 + mt * 32 + kin;
            bool ok = (key < nkeys) && ((wbits >> kin) & 1u);
            sacc[mt][i] = ok ? sacc[mt][i] : -INFINITY;
          }
          mx = fmaxf(mx, sacc[mt][i]);
        }
      }
      mx = fmaxf(mx, shflx(mx, 32, lane));
      const float m_new = fmaxf(m_run, mx);
      const float m_safe = (m_new == -INFINITY) ? 0.f : m_new;
      const float alpha = __builtin_amdgcn_exp2f(m_run - m_safe);
      const bool changed = m_new > m_run;
      m_run = m_new;
      float ls = 0.f;
#pragma unroll
      for (int mt = 0; mt < 2; ++mt)
#pragma unroll
        for (int i = 0; i < 16; ++i) { float pv = __builtin_amdgcn_exp2f(sacc[mt][i] - m_safe); sacc[mt][i] = pv; ls += pv; }
      l_run = l_run * alpha + ls;
      if (__builtin_amdgcn_ballot_w64(changed) != 0ull) {
#pragma unroll
        for (int d = 0; d < 2; ++d)
#pragma unroll
          for (int i = 0; i < 16; ++i) oacc[d][i] *= alpha;
      }
#pragma unroll
      for (int mt = 0; mt < 2; ++mt)
#pragma unroll
        for (int s = 0; s < 2; ++s) {
          uint4 pp;
          pp.x = pack2(sacc[mt][8 * s + 0], sacc[mt][8 * s + 1]);
          pp.y = pack2(sacc[mt][8 * s + 2], sacc[mt][8 * s + 3]);
          pp.z = pack2(sacc[mt][8 * s + 4], sacc[mt][8 * s + 5]);
          pp.w = pack2(sacc[mt][8 * s + 6], sacc[mt][8 * s + 7]);
          bf16x8 pf = __builtin_bit_cast(bf16x8, pp);
#pragma unroll
          for (int dt = 0; dt < 2; ++dt) {
            const bf16_t* vrow = Vb + (dt * 32 + lr) * VS + mt * 32 + 16 * s + 4 * lh;
            uint2 lo = *(const uint2*)(vrow), hi = *(const uint2*)(vrow + 8);
            uint4 vv = make_uint4(lo.x, lo.y, hi.x, hi.y);
            bf16x8 vf = __builtin_bit_cast(bf16x8, vv);
            oacc[dt] = MFMA32(vf, pf, oacc[dt]);
          }
        }
    }
    if (kt + 1 < nkt) { sstore(buf ^ 1); bm_cur = bm_next; }
    __syncthreads();
  }
  if (nkt_w > 0) {
    float lt = l_run + shflx(l_run, 32, lane);
    float inv = lt > 0.f ? 1.f / lt : 0.f;
    if (q_ok) {
      bf16_t* orow = AOp + (size_t)(w * 32 + lr) * 1024;
#pragma unroll
      for (int dt = 0; dt < 2; ++dt)
#pragma unroll
        for (int g = 0; g < 4; ++g) {
          uint2 pk;
          pk.x = pack2(oacc[dt][4 * g] * inv, oacc[dt][4 * g + 1] * inv);
          pk.y = pack2(oacc[dt][4 * g + 2] * inv, oacc[dt][4 * g + 3] * inv);
          *(uint2*)(orow + dt * 32 + 8 * g + 4 * lh) = pk;
        }
    }
  }
}


DI int snake_idx(int i, int bid, int nblk) { return i * nblk + ((i & 1) ? (nblk - 1 - bid) : bid); }

template <bool IS_MLA>
DI void attn_phase(PREF p, unsigned char* smem, int bid, int nblk, int wv) {
  unsigned char* R = p.ws + OFF_R;
  const int tl = ltid(wv);
  const int hf = tl >> 8, w = (tl >> 6) & 3;
  unsigned char* smh = smem + hf * 45056;
  const int total = 1024 + 256;
  for (int i = 0; i * nblk < total; ++i) {
    int pu = snake_idx(i, bid, nblk);
    if (pu >= total) continue;
    if constexpr (IS_MLA) {
      const bf16_t* Q = (const bf16_t*)(R + R_Q); const bf16_t* KN = (const bf16_t*)(R + R_KN);
      const bf16_t* KR = (const bf16_t*)(R + R_KR); const bf16_t* VT = (const bf16_t*)(R + R_VT);
      bf16_t* AO = (bf16_t*)(R + R_RAW);
      if (pu < 1024) {
        int qt = 63 - (pu >> 4), bh = (pu & 15) * 2 + hf, b = bh >> 4, h = bh & 15;
        int q0 = b * 8192 + qt * 128;
        attn_unit<96, true, false>(Q + (size_t)q0 * 1536 + h * 96, 1536, 128,
                            KN + (size_t)(b * 8192) * 1024 + h * 64, 1024, KR + (size_t)(b * 8192) * 32,
                            VT + (size_t)((b * 16 + h) * 64) * 8192, 8192,
                            2 * qt + 2, 2 * qt + 1 + (w >> 1), 1 << 30, nullptr,
                            AO + (size_t)q0 * 1024 + h * 64, smh, wv);
      } else {
        int u = (pu - 1024) * 2 + hf, b = u >> 4, h = u & 15;
        int q0 = TP + b * 16;
        attn_unit<96, true, true>(Q + (size_t)q0 * 1536 + h * 96, 1536, 16,
                            KN + (size_t)(TP + b * SPAD) * 1024 + h * 64, 1024, KR + (size_t)(TP + b * SPAD) * 32,
                            VT + (size_t)TP * 1024 + (size_t)((b * 16 + h) * 64) * SPAD, SPAD,
                            17, (w == 0) ? 17 : 0, NKS, nullptr,
                            AO + (size_t)q0 * 1024 + h * 64, smh, wv);
      }
    } else {
      const bf16_t* Q = (const bf16_t*)(R + D_Q); const bf16_t* KK = (const bf16_t*)(R + D_K);
      const bf16_t* VT = (const bf16_t*)(R + D_VT); const unsigned* BM = (const unsigned*)(R + D_BM);
      bf16_t* AO = (bf16_t*)(R + D_AO);
      if (pu < 1024) {
        int qt = 63 - (pu >> 4), bh = (pu & 15) * 2 + hf, b = bh >> 4, h = bh & 15;
        int q0 = b * 8192 + qt * 128;
        attn_unit<64, false, true>(Q + (size_t)q0 * 1024 + h * 64, 1024, 128,
                             KK + (size_t)(b * 8192) * 1024 + h * 64, 1024, nullptr,
                             VT + (size_t)((b * 16 + h) * 64) * 8192, 8192,
                             2 * qt + 2, 2 * qt + 1 + (w >> 1), 1 << 30, BM + (size_t)q0 * 256,
                             AO + (size_t)q0 * 1024 + h * 64, smh, wv);
      } else {
        int u = (pu - 1024) * 2 + hf, b = u >> 4, h = u & 15;
        int q0 = TP + b * 16;
        attn_unit<64, false, true>(Q + (size_t)q0 * 1024 + h * 64, 1024, 16,
                             KK + (size_t)(TP + b * SPAD) * 1024 + h * 64, 1024, nullptr,
                             VT + (size_t)TP * 1024 + (size_t)((b * 16 + h) * 64) * SPAD, SPAD,
                             17, (w == 0) ? 17 : 0, NKS, BM + (size_t)q0 * 256,
                             AO + (size_t)q0 * 1024 + h * 64, smh, wv);
      }
    }
  }
}

constexpr int CAP = 128;
DI int score_bin(float s) {
  unsigned u = __float_as_uint(s);
  int e = (int)((u & 0x7fffffffu) >> 19);
  int m = min(max(e, 1840), 2095) - 1840;
  return (u >> 31) ? (255 - m) : (256 + m);
}

DI void idx_unit(const bf16_t* __restrict__ QI, const float* __restrict__ WI, int q_row0, int nq,
                 const bf16_t* __restrict__ KI, int L, unsigned* __restrict__ BM, unsigned char* smem, int wv) {
  const int tid = ltid(wv), lane = tid & 63, w = tid >> 6, lr = lane & 31, lh = lane >> 5;
  bf16_t* Qs = (bf16_t*)smem;
  float* Ws = (float*)(smem + 36864);
  unsigned* hist = (unsigned*)(smem + 36864 + 1024);
  float* cand_s = (float*)hist;
  int* cand_i = (int*)(smem + 36864 + 1024 + 16384);
  int* bstar = (int*)(smem + 36864 + 1024 + 32768);
  int* need = bstar + 32;
  int* ncand = need + 32;
  __syncthreads();
#pragma unroll
  for (int i = 0; i < 4; ++i) {
    int v = tid + i * NT;
    int hd = v >> 8, q = (v >> 3) & 31, c = (v & 7) * 8;
    int qq = q < nq ? q : 0;
    *(uint4*)(Qs + (hd * 32 + q) * 72 + c) = *(const uint4*)(QI + (size_t)(q_row0 + qq) * 512 + hd * 64 + c);
  }
  if (tid < 256) { int hd = tid >> 5, q = tid & 31; int qq = q < nq ? q : 0; Ws[hd * 32 + q] = WI[(size_t)(q_row0 + qq) * 8 + hd]; }
  for (int i = tid; i < 32 * 256; i += NT) hist[i] = 0u;
  if (tid < 32) { bstar[tid] = -1; need[tid] = 0; ncand[tid] = 0; }
  __syncthreads();
  const int ntile = (L + 255) >> 8;
  const bool do_select = L > 256;
  for (int pass = do_select ? 0 : 1; pass < 2; ++pass) {
    for (int kt = 0; kt < ntile; ++kt) {
      const int key0 = kt * 256 + w * 32;
      if (key0 < L) {
        const int key = key0 + lr;
        bf16x8 kf[4];
#pragma unroll
        for (int s = 0; s < 4; ++s) kf[s] = *(const bf16x8*)(KI + (size_t)key * 64 + s * 16 + lh * 8);
        float sc[16];
#pragma unroll
        for (int i = 0; i < 16; ++i) sc[i] = 0.f;
#pragma unroll 1
        for (int hd = 0; hd < 8; ++hd) {
          f32x16 acc;
#pragma unroll
          for (int i = 0; i < 16; ++i) acc[i] = 0.f;
#pragma unroll
          for (int s = 0; s < 4; ++s) {
            bf16x8 qf = *(const bf16x8*)(Qs + (hd * 32 + lr) * 72 + s * 16 + lh * 8);
            acc = MFMA32(qf, kf[s], acc);
          }
#pragma unroll
          for (int g = 0; g < 4; ++g) {
            float4 wv = *(const float4*)(Ws + hd * 32 + 8 * g + 4 * lh);
            sc[4 * g + 0] += wv.x * fmaxf(acc[4 * g + 0], 0.f);
            sc[4 * g + 1] += wv.y * fmaxf(acc[4 * g + 1], 0.f);
            sc[4 * g + 2] += wv.z * fmaxf(acc[4 * g + 2], 0.f);
            sc[4 * g + 3] += wv.w * fmaxf(acc[4 * g + 3], 0.f);
          }
        }
        const bool kvalid = key < L;
        if (pass == 0) {
#pragma unroll
          for (int i = 0; i < 16; ++i) {
            int q = crow(i, lh);
            if (kvalid) { int b = score_bin(sc[i]); atomicAdd(&hist[q * 256 + (b >> 1)], (b & 1) ? 65536u : 1u); }
          }
        } else {
#pragma unroll
          for (int i = 0; i < 16; ++i) {
            int q = crow(i, lh);
            int b = score_bin(sc[i]);
            int bs = bstar[q];
            bool sel = kvalid && (b > bs);
            bool cnd = kvalid && (b == bs);
            unsigned long long bal = __ballot(sel);
            if (lr == 0 && q < nq) BM[(size_t)(q_row0 + q) * 256 + (key0 >> 5)] = (unsigned)(bal >> (32 * lh));
            if (cnd) {
              int pos = atomicAdd(&ncand[q], 1);
              if (pos < CAP) { cand_s[q * CAP + pos] = sc[i]; cand_i[q * CAP + pos] = key; }
            }
          }
        }
      }
    }
    __syncthreads();
    if (pass == 0) {
      for (int qi = 0; qi < 4; ++qi) {
        const int q = w * 4 + qi;
        unsigned hw[4];
#pragma unroll
        for (int k = 0; k < 4; ++k) hw[k] = hist[q * 256 + 255 - 4 * lane - k];
        int cnt = 0;
#pragma unroll
        for (int k = 0; k < 4; ++k) cnt += (int)(hw[k] >> 16) + (int)(hw[k] & 0xffffu);
        int pre = cnt;
#pragma unroll
        for (int o = 1; o < 64; o <<= 1) { int t = __builtin_amdgcn_ds_bpermute(((lane - o) & 63) << 2, pre); if (lane >= o) pre += t; }
        unsigned long long bal = __ballot(pre >= 256);
        if (bal != 0ull) {
          int fl = __ffsll((long long)bal) - 1;
          if (lane == fl) {
            int running = pre - cnt;
            int bsel = -1, above = 0;
#pragma unroll
            for (int k = 0; k < 4; ++k) {
              int chi = (int)(hw[k] >> 16), clo = (int)(hw[k] & 0xffffu);
              if (bsel < 0) { if (running + chi >= 256) { bsel = 511 - 8 * lane - 2 * k; above = running; } else running += chi; }
              if (bsel < 0) { if (running + clo >= 256) { bsel = 510 - 8 * lane - 2 * k; above = running; } else running += clo; }
            }
            bstar[q] = bsel; need[q] = 256 - above;
          }
        }
      }
      __syncthreads();
    }
  }
  __threadfence();
  __syncthreads();
  if (do_select) {
    for (int pi = tid; pi < 32 * CAP; pi += NT) {
      int q = pi / CAP, c = pi - q * CAP;
      int n = min(ncand[q], CAP);
      if (c < n && q < nq) {
        float sv = cand_s[q * CAP + c]; int iv = cand_i[q * CAP + c];
        int rank = 0;
        for (int j = 0; j < n; ++j) {
          float sj = cand_s[q * CAP + j]; int ij = cand_i[q * CAP + j];
          rank += (sj > sv || (sj == sv && ij < iv)) ? 1 : 0;
        }
        if (rank < need[q]) atomicOr(&BM[(size_t)(q_row0 + q) * 256 + (iv >> 5)], 1u << (iv & 31));
      }
    }
  }
  __syncthreads();
}

DI void idx_phase(PREF p, unsigned char* smem, int bid, int nblk, int wv) {
  unsigned char* R = p.ws + OFF_R;
  const bf16_t* QI = (const bf16_t*)(R + D_QI); const float* WI = (const float*)(R + D_WI);
  const bf16_t* KI = (const bf16_t*)(R + D_KI); unsigned* BM = (unsigned*)(R + D_BM);
  const int total = 512 + 32;
  for (int i = 0; i * nblk < total; ++i) {
    int idx = snake_idx(i, bid, nblk);
    if (idx >= total) continue;
    if (idx < 512) {
      int qt = 255 - (idx >> 1), b = idx & 1;
      int L = (((qt * 32) >> 6) + 1) * 64;
      idx_unit(QI, WI, b * 8192 + qt * 32, 32, KI + (size_t)(b * 8192) * 64, L, BM, smem, wv);
    } else {
      int b = idx - 512;
      idx_unit(QI, WI, TP + b * 16, 16, KI + (size_t)(TP + b * SPAD) * 64, NKS, BM, smem, wv);
    }
  }
}

DI void cvt8(const float* s, bf16_t* d) {
  float4 a = *(const float4*)s, b = *(const float4*)(s + 4);
  uint4 pk; pk.x = pack2(a.x, a.y); pk.y = pack2(a.z, a.w); pk.z = pack2(b.x, b.y); pk.w = pack2(b.z, b.w);
  *(uint4*)d = pk;
}
DI void cache_rows(const float* __restrict__ src, bf16_t* __restrict__ dst, int Wd, int bid, int nblk, int wv) {
  const int vpr = Wd >> 3;
  const size_t total = (size_t)32 * SPAD * vpr;
  for (size_t e = (size_t)bid * NT + ltid(wv); e < total; e += (size_t)nblk * NT) {
    int c = (int)(e % vpr) * 8; size_t rw = e / vpr; int b = (int)(rw / SPAD), s = (int)(rw % SPAD);
    bf16_t* d = dst + ((size_t)TP + (size_t)b * SPAD + s) * Wd + c;
    if (s < 1024) cvt8(src + ((size_t)b * 1024 + s) * Wd + c, d);
    else if (s >= NKS) { unsigned z = 0; asm volatile("" : "+v"(z)); *(uint4*)d = make_uint4(z, z, z, z); }
  }
}


#define XB_TMO      128
#define XB_XCNT(j)  (256  + 64 * (j))
#define XB_XSUB(j)  (1280 + 64 * (j))
#define XB_XGEN(j)  (2304 + 64 * (j))
#define XB_TOP      3328
#define XB_TOPGEN   3392
#define XCD_BAR_WORDS 3456
#define XB_SPIN_CAP (1u << 18)
DI unsigned xb_ld(unsigned* p)              { return __hip_atomic_load(p, __ATOMIC_RELAXED, __HIP_MEMORY_SCOPE_AGENT); }
DI unsigned xb_add(unsigned* p, unsigned v) { return __hip_atomic_fetch_add(p, v, __ATOMIC_RELAXED, __HIP_MEMORY_SCOPE_AGENT); }
DI unsigned xb_xcc_id() { return (unsigned)__builtin_amdgcn_s_getreg((3 << 11) | 20) & 0xFu; }
#define XB_SPIN(cond, bar) do { unsigned _sp = 0; while (cond) { __builtin_amdgcn_s_sleep(1); \
    if ((++_sp & 255u) == 0u) { if (xb_ld(&(bar)[XB_TMO])) break; if (_sp > XB_SPIN_CAP) { atomicAdd(&(bar)[XB_TMO], 1u); break; } } } } while (0)
struct XcdBarrier { unsigned* bar; unsigned x; volatile __attribute__((address_space(3))) unsigned* st; };
DI void xcd_barrier_complete(unsigned* bar, unsigned x, unsigned G, unsigned& nloc, unsigned& nx) {
  unsigned sum, cnt, mine, sp = 0u;
  for (;;) {
    sum = 0u; cnt = 0u; mine = 0u;
#pragma unroll
    for (unsigned j = 0; j < 16; ++j) { const unsigned c = xb_ld(&bar[XB_XCNT(j)]); sum += c; cnt += (c > 0u) ? 1u : 0u; mine = (j == x) ? c : mine; }
    if (sum == G) break;
    __builtin_amdgcn_s_sleep(1);
    if ((++sp & 255u) == 0u) { if (xb_ld(&bar[XB_TMO])) break; if (sp > XB_SPIN_CAP) { atomicAdd(&bar[XB_TMO], 1u); break; } }
  }
  nloc = mine > 0u ? mine : 1u; nx = cnt > 0u ? cnt : 1u;
}
DI void xcd_barrier(const XcdBarrier& b, int tid, unsigned G) {
  asm volatile("s_waitcnt vmcnt(0)" ::: "memory");
  __syncthreads();
  if (tid == 0) {
    unsigned* bar = b.bar;
    __builtin_amdgcn_s_waitcnt(0);
    unsigned nloc = b.st[0], nx = b.st[1];
    if (nloc == 0u) { xcd_barrier_complete(bar, b.x, G, nloc, nx); b.st[0] = nloc; b.st[1] = nx; }
    const unsigned old = xb_add(&bar[XB_XSUB(b.x)], 1u);
    const unsigned gen = old / nloc;
    if (old + 1u == (gen + 1u) * nloc) {
      __builtin_amdgcn_fence(__ATOMIC_RELEASE, "agent");
      asm volatile("s_waitcnt vmcnt(0)" ::: "memory");
      const unsigned og = xb_add(&bar[XB_TOP], 1u);
      const unsigned tg = og / nx;
      if (og + 1u == (tg + 1u) * nx) xb_add(&bar[XB_TOPGEN], 1u);
      else XB_SPIN(xb_ld(&bar[XB_TOPGEN]) == tg, bar);
      __builtin_amdgcn_fence(__ATOMIC_ACQUIRE, "agent");
      xb_add(&bar[XB_XGEN(b.x)], 1u);
      asm volatile("s_waitcnt vmcnt(0)" ::: "memory");
    } else {
      XB_SPIN(xb_ld(&bar[XB_XGEN(b.x)]) == gen, bar);
      __builtin_amdgcn_fence(__ATOMIC_ACQUIRE, "agent");
      asm volatile("s_waitcnt vmcnt(0)" ::: "memory");
    }
  }
  __syncthreads();
}

extern "C" __global__ void __launch_bounds__(512, 2) mega(Params p_unused) {
  extern __shared__ __attribute__((aligned(16))) unsigned char smem[];
  cg::grid_group grid = cg::this_grid();
  const int bid = blockIdx.x, nblk = gridDim.x;
  const int wv = __builtin_amdgcn_readfirstlane((int)(threadIdx.x >> 6));
  CParams* pk = (CParams*)__builtin_amdgcn_kernarg_segment_ptr();
  const int ph_lo = pk->ph_lo, ph_hi = pk->ph_hi;
  int ph = 0;
  XcdBarrier xb;
  {
    volatile __attribute__((address_space(3))) unsigned* st = (volatile __attribute__((address_space(3))) unsigned*)(smem + 131072);
    const int t0 = ltid(wv);
    if (t0 == 0) { st[0] = 0u; st[1] = 0u; }
    __syncthreads();
    xb.bar = (unsigned*)(pk->ws + OFF_BAR); xb.x = xb_xcc_id(); xb.st = st;
    if (t0 == 0) (void)xb_add(&xb.bar[XB_XCNT(xb.x)], 1u);
  }
#ifndef REPMASK
#define REPMASK 0u
#endif
#ifndef PMASK
#define PMASK 0xffffffffu
#endif
#define PHASE_BEGIN(k) if (ph >= ph_lo && ph < ph_hi) { if constexpr ((PMASK >> (k)) & 1u) for (int rep_ = 0; rep_ < 1 + (int)((REPMASK >> (k)) & 1u); ++rep_) { \
    CParams* pp_ = pk; asm volatile("" : "+s"(pp_)); PREF p = *pp_; const int tid = ltid(wv); \
    unsigned char* ws = p.ws; float* X = (float*)(ws + OFF_X); bf16_t* H = (bf16_t*)(ws + OFF_H); bf16_t* Wb = (bf16_t*)(ws + OFF_W); \
    float* ROPE = (float*)(ws + OFF_ROPE); unsigned char* R = ws + OFF_R; (void)tid; (void)X; (void)H; (void)Wb; (void)ROPE; (void)R;
#define PHASE_END   } if (ph + 1 < ph_hi) { if (ph == 0) grid.sync(); else xcd_barrier(xb, ltid(wv), (unsigned)nblk); } } ++ph;

  PHASE_BEGIN(0)
    {
      const int hf = tid >> 8, tl = tid & 255;
      float* smh = (float*)smem + hf * 4224;
      for (int t0 = bid * 2; t0 < p.total_tiles; t0 += nblk * 2) {
        const int t = t0 + hf;
        const bool active = t < p.total_tiles;
        const int tt = active ? t : 0;
        int ji = 0;
#pragma unroll 1
        for (int q = 1; q < NJOBS; ++q) if (tt >= p.jobs[q].tile0) ji = q;
        const CAS Job& jb = p.jobs[ji];
        int lt = tt - jb.tile0; int nkt = jb.k >> 6; int nt_ = lt / nkt, kt_ = lt - nt_ * nkt;
        transpose_tile(jb.src, jb.nsrc, jb.nsrc, jb.dst, jb.k, nt_ * 64, kt_ * 64, jb.mode, smh, tl, active);
      }
    }
    {
      const size_t n4p = (size_t)TP * 256, n4 = (size_t)T * 256;
      const float4* xp = (const float4*)p.in[0]; const float4* xs = (const float4*)p.in[1];
      for (size_t e = (size_t)bid * NT + tid; e < n4; e += (size_t)nblk * NT) ((float4*)X)[e] = (e < n4p) ? xp[e] : xs[e - n4p];
      for (int e = bid * NT + tid; e < 8192 * 16; e += nblk * NT) {
        int pos = e >> 4, i = e & 15;
        double rev = (double)pos * p.inv_freq[i] * 0.15915494309189535;
        rev -= floor(rev);
        float fr = (float)rev;
        ROPE[2 * e] = __builtin_amdgcn_cosf(fr); ROPE[2 * e + 1] = __builtin_amdgcn_sinf(fr);
      }
      const float* wsrc = p.in[20];
      for (int e = bid * NT + tid; e < 8 * 128 * 128; e += nblk * NT) {
        int s = e & 127, t = (e >> 7) & 127;
        Wb[W_TRIL + e] = tobf(s <= t ? wsrc[e] : 0.f);
      }
    }
  PHASE_END

#pragma unroll 1
  for (int L = 0; L < 4; ++L) {
    const int kind = L % 3, j = L / 3;
    if (kind == 0) {
      PHASE_BEGIN(1)
        rmsnorm_rows(X, p.in[7] + L * 1024, H, nullptr, nullptr, bid, nblk, wv);
        cache_rows(p.in[2] + (size_t)j * 32 * 1024 * 256, (bf16_t*)(R + R_CKV), 256, bid, nblk, wv);
        cache_rows(p.in[3] + (size_t)j * 32 * 1024 * 32, (bf16_t*)(R + R_KR), 32, bid, nblk, wv);
      PHASE_END
      PHASE_BEGIN(2)
        EArgs ea{}; ea.f0 = (float*)(R + R_RAW);
        gemm_phase<E_F32>(H, Wb + W_MLA + (size_t)j * WM_SZ + WM_D, T, 1024, 1024, ea, smem, 0, bid, nblk, wv);
      PHASE_END
      PHASE_BEGIN(3)
        mla_rowops(p, j, bid, nblk, wv);
      PHASE_END
      PHASE_BEGIN(4)
        EArgs ea{}; ea.b0 = (bf16_t*)(R + R_Q); ea.rope = ROPE;
        gemm_phase<E_MLAQ>((const bf16_t*)(R + R_CQ), Wb + W_MLA + (size_t)j * WM_SZ + WM_UQ, T, 1536, 512, ea, smem, 0, bid, nblk, wv);
        EArgs eb{}; eb.b0 = (bf16_t*)(R + R_KN); eb.b1 = (bf16_t*)(R + R_VT);
        gemm_phase<E_MLAKV>((const bf16_t*)(R + R_CKV), Wb + W_MLA + (size_t)j * WM_SZ + WM_UKV, KROWS, 2048, 256, eb, smem, (T / 256) * 6, bid, nblk, wv);
      PHASE_END
      PHASE_BEGIN(5)
        attn_phase<true>(p, smem, bid, nblk, wv);
      PHASE_END
      PHASE_BEGIN(6)
        EArgs ea{}; ea.f0 = X;
        gemm_phase<E_RESID>((const bf16_t*)(R + R_RAW), Wb + W_MLA + (size_t)j * WM_SZ + WM_O, T, 1024, 1024, ea, smem, 0, bid, nblk, wv);
      PHASE_END
    } else if (kind == 1) {
      PHASE_BEGIN(1)
        rmsnorm_rows(X, p.in[7] + L * 1024, H, nullptr, nullptr, bid, nblk, wv);
      PHASE_END
      PHASE_BEGIN(7)
        EArgs ea{}; ea.b0 = (bf16_t*)(R + C_U); ea.b1 = (bf16_t*)(R + C_VR);
        gemm_phase<E_GELU>(H, Wb + W_CM + WC_IN, T, 4096, 1024, ea, smem, 0, bid, nblk, wv);
      PHASE_END
      PHASE_BEGIN(8)
        cmlp_ln_rows(p, bid, nblk, wv);
      PHASE_END
      PHASE_BEGIN(9)
        cmlp_mix_phase(p, smem, bid, nblk, wv);
      PHASE_END
      PHASE_BEGIN(6)
        EArgs ea{}; ea.f0 = X;
        gemm_phase<E_RESID>((const bf16_t*)(R + C_G), Wb + W_CM + WC_OUT, T, 1024, 2048, ea, smem, 0, bid, nblk, wv);
      PHASE_END
    } else {
      PHASE_BEGIN(10)
        rmsnorm_rows(X, p.in[7] + L * 1024, H, nullptr, nullptr, bid, nblk, wv);
        cache_rows(p.in[4], (bf16_t*)(R + D_K), 1024, bid, nblk, wv);
        cache_rows(p.in[6], (bf16_t*)(R + D_KI), 64, bid, nblk, wv);
        {
          bf16_t* VTs = (bf16_t*)(R + D_VT) + (size_t)TP * 1024;
          {
            const int hf = tid >> 8, tl = tid & 255;
            float* smh = (float*)smem + hf * 4224;
            for (int u0 = bid * 2; u0 < 512 * 16; u0 += nblk * 2) {
              const int u = u0 + hf;
              int st = u & 15, bh = u >> 4, b = bh >> 4, h = bh & 15;
              transpose_tile(p.in[5] + (size_t)b * 1024 * 1024 + h * 64, 1024, 64, VTs + (size_t)(bh * 64) * SPAD, SPAD, 0, st * 64, 0, smh, tl, true);
            }
          }
          for (int e = bid * NT + tid; e < 512 * 64 * 12; e += nblk * NT) {
            int c = e % 12, rw = e / 12;
            { unsigned z = 0; asm volatile("" : "+v"(z)); *(uint2*)(VTs + (size_t)rw * SPAD + NKS + c * 4) = make_uint2(z, z); }
          }
        }
      PHASE_END
      PHASE_BEGIN(11)
        EArgs ea{};
        ea.f0 = p.out + O_DKP; ea.f1 = p.out + O_DKS; ea.f2 = p.out + O_DVP; ea.f3 = p.out + O_DVS;
        ea.f4 = (float*)(R + D_KIR); ea.f5 = (float*)(R + D_WI);
        ea.b0 = (bf16_t*)(R + D_Q); ea.b1 = (bf16_t*)(R + D_K); ea.b2 = (bf16_t*)(R + D_VT); ea.b3 = (bf16_t*)(R + D_QI);
        gemm_phase<E_DSA>(H, Wb + W_DS + WD_P, T, 3840, 1024, ea, smem, 0, bid, nblk, wv);
      PHASE_END
      PHASE_BEGIN(12)
        dsa_rowops(p, bid, nblk, wv);
      PHASE_END
      PHASE_BEGIN(13)
        idx_phase(p, smem, bid, nblk, wv);
      PHASE_END
      PHASE_BEGIN(14)
        attn_phase<false>(p, smem, bid, nblk, wv);
      PHASE_END
      PHASE_BEGIN(6)
        EArgs ea{}; ea.f0 = X;
        gemm_phase<E_RESID>((const bf16_t*)(R + D_AO), Wb + W_DS + WD_O, T, 1024, 1024, ea, smem, 0, bid, nblk, wv);
      PHASE_END
    }
    PHASE_BEGIN(1)
      rmsnorm_rows(X, p.in[8] + L * 1024, H, nullptr, nullptr, bid, nblk, wv);
    PHASE_END
    PHASE_BEGIN(15)
      EArgs ea{}; ea.b0 = (bf16_t*)(R + 0);
      gemm_phase<E_SWIGLU>(H, Wb + W_FF + (size_t)L * WF_SZ + WF_IN, T, 2 * DFF, 1024, ea, smem, 0, bid, nblk, wv);
    PHASE_END
    PHASE_BEGIN(6)
      EArgs ea{}; ea.f0 = X;
      gemm_phase<E_RESID>((const bf16_t*)(R + 0), Wb + W_FF + (size_t)L * WF_SZ + WF_OUT, T, 1024, DFF, ea, smem, 0, bid, nblk, wv);
    PHASE_END
  }
  PHASE_BEGIN(1)
    rmsnorm_rows(X, p.in[9], nullptr, p.out + O_YP, p.out + O_YS, bid, nblk, wv);
  PHASE_END
}

extern "C" void kernel_launch(void* const* d_in, const int* in_sizes, int n_in,
                              void* d_out, int out_size, void* d_ws, size_t ws_size,
                              hipStream_t stream) {
  constexpr int kLds = 128 * 1024 + 64;
  static int grid_blocks = 0;
  if (!grid_blocks) {
    int dev = 0, cus = 0, per_cu = 0;
    (void)hipGetDevice(&dev);
    (void)hipDeviceGetAttribute(&cus, hipDeviceAttributeMultiprocessorCount, dev);
    (void)hipFuncSetAttribute((const void*)mega, hipFuncAttributeMaxDynamicSharedMemorySize, kLds);
    (void)hipOccupancyMaxActiveBlocksPerMultiprocessor(&per_cu, (const void*)mega, NT, kLds);
    if (per_cu < 1) per_cu = 1;
    if (per_cu > 1) per_cu = 1;
    grid_blocks = cus * per_cu;
    fprintf(stderr, "grid %d (cus %d per_cu %d) ws %zu need %zu out %d need %zu\n", grid_blocks, cus, per_cu, ws_size, (size_t)WS_NEED, out_size, (size_t)O_END);
  }
  if (ws_size < WS_NEED || n_in != 31 || (size_t)out_size != O_END) { fprintf(stderr, "kernel_launch: bad sizes\n"); return; }
  Params p;
  memset(&p, 0, sizeof(p));
  for (int i = 0; i < 31; ++i) p.in[i] = (const float*)d_in[i];
  p.out = (float*)d_out; p.ws = (unsigned char*)d_ws;
  bf16_t* Wb = (bf16_t*)((unsigned char*)d_ws + OFF_W);
  int nj = 0, tiles = 0;
  auto add = [&](const float* src, int nsrc, int k, bf16_t* dst, int ndst, int mode) {
    Job& jb = p.jobs[nj++]; jb.src = src; jb.dst = dst; jb.nsrc = nsrc; jb.k = k; jb.ndst = ndst; jb.mode = mode; jb.tile0 = tiles; jb.pad = 0;
    tiles += (ndst / 64) * (k / 64);
  };
  for (int j = 0; j < 2; ++j) {
    bf16_t* Wm = Wb + W_MLA + (size_t)j * WM_SZ;
    add(p.in[10] + (size_t)j * 1024 * 512, 512, 1024, Wm + WM_D, 512, 0);
    add(p.in[13] + (size_t)j * 1024 * 288, 288, 1024, Wb + W_MLA + (size_t)j * WM_SZ + WM_D + (size_t)512 * 1024, 512, 0);
    add(p.in[12] + (size_t)j * 512 * 1536, 1536, 512, Wb + W_MLA + (size_t)j * WM_SZ + WM_UQ, 1536, 0);
    add(p.in[15] + (size_t)j * 256 * 2048, 2048, 256, Wb + W_MLA + (size_t)j * WM_SZ + WM_UKV, 2048, 0);
    add(p.in[16] + (size_t)j * 1024 * 1024, 1024, 1024, Wb + W_MLA + (size_t)j * WM_SZ + WM_O, 1024, 0);
  }
  add(p.in[17], 4096, 1024, Wb + W_CM + WC_IN, 4096, 0);
  add(p.in[22], 1024, 2048, Wb + W_CM + WC_OUT, 1024, 0);
  add(p.in[23], 3072, 1024, Wb + W_DS + WD_P, 3072, 0);
  add(p.in[25], 512, 1024, Wb + W_DS + WD_P + (size_t)3072 * 1024, 512, 0);
  add(p.in[26], 64, 1024, Wb + W_DS + WD_P + (size_t)3584 * 1024, 64, 0);
  add(p.in[28], 8, 1024, Wb + W_DS + WD_P + (size_t)3648 * 1024, 192, 0);
  add(p.in[24], 1024, 1024, Wb + W_DS + WD_O, 1024, 0);
  for (int i = 0; i < 4; ++i) {
    add(p.in[29] + (size_t)i * 1024 * 5632, 5632, 1024, Wb + W_FF + (size_t)i * WF_SZ + WF_IN, 5632, 1);
    add(p.in[30] + (size_t)i * 2816 * 1024, 1024, 2816, Wb + W_FF + (size_t)i * WF_SZ + WF_OUT, 1024, 0);
  }
  p.total_tiles = tiles;
  for (int i = 0; i < 16; ++i) p.inv_freq[i] = pow(10000.0, -(double)i / 16.0);
  p.ph_lo = 0; p.ph_hi = 1000;
  (void)hipMemsetAsync((unsigned char*)d_ws + OFF_BAR, 0, 16384, stream);
  void* args[] = {&p};
  hipError_t e = hipLaunchCooperativeKernel((const void*)mega, dim3(grid_blocks), dim3(NT), args, kLds, stream);
  if (e != hipSuccess) fprintf(stderr, "coop launch failed: %s\n", hipGetErrorString(e));
}
```

```cpp
#include <hip/hip_runtime.h>
#include <hip/hip_cooperative_groups.h>
#include <cstdio>
#include <cstring>
#include <cmath>
namespace cg = cooperative_groups;

typedef unsigned short bf16_t;
using bf16x8 = __attribute__((ext_vector_type(8))) short;
using f32x16 = __attribute__((ext_vector_type(16))) float;
using f32x2v = __attribute__((ext_vector_type(2))) float;
using bf2v = __attribute__((ext_vector_type(2))) __bf16;
#define DI __device__ __forceinline__
#define MFMA32(a, b, c) __builtin_amdgcn_mfma_f32_32x32x16_bf16((a), (b), (c), 0, 0, 0)

constexpr int TP = 16384, TS = 512, T = TP + TS;
constexpr int NT = 512;
constexpr int SPAD = 1088, NKS = 1040;
constexpr int KROWS = TP + 32 * SPAD;
constexpr int DFF = 2816;
constexpr float LOG2E = 1.4426950408889634f;
constexpr float EPS = 1e-6f;

constexpr size_t OFF_X = 0;
constexpr size_t OFF_H = OFF_X + (size_t)T * 1024 * 4;
constexpr size_t OFF_W = OFF_H + (size_t)T * 1024 * 2;
constexpr size_t W_ELEMS = 52822016;
constexpr size_t OFF_ROPE = OFF_W + W_ELEMS * 2;
constexpr size_t OFF_R = OFF_ROPE + (size_t)8192 * 16 * 2 * 4;
constexpr size_t R_RAW = 0;
constexpr size_t R_CQ = R_RAW + (size_t)T * 1024 * 4;
constexpr size_t R_CKV = R_CQ + (size_t)T * 512 * 2;
constexpr size_t R_KR = R_CKV + (size_t)KROWS * 256 * 2;
constexpr size_t R_Q = R_KR + (size_t)KROWS * 32 * 2;
constexpr size_t R_KN = R_Q + (size_t)T * 1536 * 2;
constexpr size_t R_VT = R_KN + (size_t)KROWS * 1024 * 2;
constexpr size_t R_END = R_VT + (size_t)KROWS * 1024 * 2;
constexpr size_t D_Q = 0;
constexpr size_t D_K = D_Q + (size_t)T * 1024 * 2;
constexpr size_t D_VT = D_K + (size_t)KROWS * 1024 * 2;
constexpr size_t D_QI = D_VT + (size_t)KROWS * 1024 * 2;
constexpr size_t D_KIR = D_QI + (size_t)T * 512 * 2;
constexpr size_t D_KI = D_KIR + (size_t)T * 64 * 4;
constexpr size_t D_WI = D_KI + (size_t)KROWS * 64 * 2;
constexpr size_t D_BM = D_WI + (size_t)T * 8 * 4;
constexpr size_t D_AO = D_BM + (size_t)T * 256 * 4;
constexpr size_t D_END = D_AO + (size_t)T * 1024 * 2;
constexpr size_t C_U = 0;
constexpr size_t C_VR = C_U + (size_t)T * 2048 * 2;
constexpr size_t C_VLN = C_VR + (size_t)T * 2048 * 2;
constexpr size_t C_G = C_VLN + (size_t)T * 2048 * 2;
constexpr size_t C_END = C_G + (size_t)T * 2048 * 2;
constexpr size_t OFF_BAR = OFF_R + R_END;
constexpr size_t WS_NEED = OFF_BAR + 16384;
static_assert(D_END <= R_END && C_END <= R_END && (size_t)T * DFF * 2 <= R_END, "region");

constexpr size_t W_MLA = 0;
constexpr size_t WM_D = 0, WM_UQ = 1048576, WM_UKV = WM_UQ + 786432, WM_O = WM_UKV + 524288, WM_SZ = 3407872;
constexpr size_t W_CM = 2 * WM_SZ;
constexpr size_t WC_IN = 0, WC_OUT = 4194304, WC_SZ = 6291456;
constexpr size_t W_DS = W_CM + WC_SZ;
constexpr size_t WD_P = 0, WD_O = 3932160, WD_SZ = 4980736;
constexpr size_t W_FF = W_DS + WD_SZ;
constexpr size_t WF_IN = 0, WF_OUT = 5767168, WF_SZ = 8650752;
constexpr size_t W_TRIL = W_FF + 4 * WF_SZ;
static_assert(W_TRIL + 131072 == W_ELEMS, "w");

constexpr size_t O_YP = 0;
constexpr size_t O_YS = O_YP + (size_t)TP * 1024;
constexpr size_t O_CKVP = O_YS + (size_t)TS * 1024;
constexpr size_t O_KRP = O_CKVP + (size_t)2 * TP * 256;
constexpr size_t O_CKVS = O_KRP + (size_t)2 * TP * 32;
constexpr size_t O_KRS = O_CKVS + (size_t)2 * TS * 256;
constexpr size_t O_CVS = O_KRS + (size_t)2 * TS * 32;
constexpr size_t O_DKP = O_CVS + (size_t)TS * 2048;
constexpr size_t O_DVP = O_DKP + (size_t)TP * 1024;
constexpr size_t O_DIP = O_DVP + (size_t)TP * 1024;
constexpr size_t O_DKS = O_DIP + (size_t)TP * 64;
constexpr size_t O_DVS = O_DKS + (size_t)TS * 1024;
constexpr size_t O_DIS = O_DVS + (size_t)TS * 1024;
constexpr size_t O_END = O_DIS + (size_t)TS * 64;

constexpr int NJOBS = 25;
struct Job { const float* src; bf16_t* dst; int nsrc, k, ndst, mode, tile0, pad; };
struct Params {
  const float* in[31];
  float* out;
  unsigned char* ws;
  Job jobs[NJOBS];
  int total_tiles, ph_lo, ph_hi, pad;
  double inv_freq[16];
};

#define CAS __attribute__((address_space(4)))
typedef const CAS Params CParams;
#define PREF const CAS Params&
DI unsigned pack2(float a, float b) { f32x2v v = {a, b}; bf2v r = __builtin_convertvector(v, bf2v); return __builtin_bit_cast(unsigned, r); }
DI bf16_t tobf(float a) { return (bf16_t)(pack2(a, 0.f) & 0xffffu); }
DI float frombf(bf16_t v) { return __uint_as_float(((unsigned)v) << 16); }
DI float bflo(unsigned u) { return __uint_as_float(u << 16); }
DI float bfhi(unsigned u) { return __uint_as_float(u & 0xffff0000u); }
DI float shflx(float v, int m, int lane) { return __int_as_float(__builtin_amdgcn_ds_bpermute((lane ^ m) << 2, __float_as_int(v))); }
DI float wave_sum(float v, int lane) {
#pragma unroll
  for (int o = 32; o >= 1; o >>= 1) v += shflx(v, o, lane);
  return v;
}
DI int ltid(int wv) { unsigned m1 = ~0u; asm volatile("" : "+s"(m1)); int t = (wv << 6) | (int)__builtin_amdgcn_mbcnt_hi(m1, __builtin_amdgcn_mbcnt_lo(m1, 0u)); asm volatile("" : "+v"(t)); return t; }
DI int crow(int i, int h) { return (i & 3) + 8 * (i >> 2) + 4 * h; }
DI int rowmap(int t) { if (t < TP) return t; int u = t - TP; return TP + (u >> 4) * SPAD + 1024 + (u & 15); }
DI int tokpos(int t) { return t < TP ? (t & 8191) : 1024 + ((t - TP) & 15); }

DI void transpose_tile(const float* __restrict__ src, int src_ld, int ncols, bf16_t* __restrict__ dst, int dst_ld,
                       int n0, int k0, int mode, float* sm, int tid, bool active) {
  const int nl = (tid & 15) * 4, kq = tid >> 4;
  const int n = n0 + nl;
  int c;
  if (mode == 0) c = n < ncols ? n : -1;
  else { int tt = n >> 5, r = n & 31; int f = tt * 16 + (r & 15); c = (r < 16) ? f : DFF + f; }
  if (active) {
    float4 v[4];
#pragma unroll
    for (int i = 0; i < 4; ++i) {
      int kk = kq + 16 * i;
      v[i] = (c >= 0) ? *(const float4*)(src + (size_t)(k0 + kk) * src_ld + c) : make_float4(0.f, 0.f, 0.f, 0.f);
    }
#pragma unroll
    for (int i = 0; i < 4; ++i) {
      int kk = kq + 16 * i;
      float* d = sm + kk * 65 + nl;
      d[0] = v[i].x; d[1] = v[i].y; d[2] = v[i].z; d[3] = v[i].w;
    }
  }
  __syncthreads();
  if (active) {
    const int kp = (tid & 31) * 2, nr = tid >> 5;
#pragma unroll 4
    for (int i = 0; i < 8; ++i) {
      int nn = nr + 8 * i;
      float a = sm[kp * 65 + nn], b = sm[(kp + 1) * 65 + nn];
      *(unsigned*)(dst + (size_t)(n0 + nn) * dst_ld + k0 + kp) = pack2(a, b);
    }
  }
  __syncthreads();
}

enum { E_F32 = 0, E_RESID, E_SWIGLU, E_GELU, E_MLAQ, E_MLAKV, E_DSA };
struct EArgs {
  float* f0; float* f1; float* f2; float* f3; float* f4; float* f5; float* f6;
  bf16_t* b0; bf16_t* b1; bf16_t* b2; bf16_t* b3;
  const float* rope;
};
using f32x4v = __attribute__((ext_vector_type(4))) float;
#define LAS __attribute__((address_space(3)))
constexpr int G_HT = 128 * 64;
DI int lds_byte(int r, int c) {
  int st = (r >> 4) * 2 + (c >> 5), rr = r & 15, cc = c & 31, ob = rr * 64 + cc * 2;
  return st * 1024 + (ob ^ (((ob >> 9) & 1) << 5));
}
DI void stage_rc(int b, int& R, int& C) {
  int st = b >> 10, sb = b & 1023, swz = sb ^ (((sb >> 9) & 1) << 5);
  R = (st >> 1) * 16 + (swz >> 6); C = (st & 1) * 32 + ((swz & 63) >> 1);
}

template <int EPI, bool ATOM>
DI void epi16(const EArgs& ea, int row0, int gb, int fr, const f32x4v& v0, const f32x4v& v1) {
  if constexpr (EPI == E_F32) {
#pragma unroll
    for (int j = 0; j < 4; ++j) { float* o = ea.f0 + (size_t)(row0 + j) * 1024 + gb + fr; o[0] = v0[j]; o[16] = v1[j]; }
  } else if constexpr (EPI == E_RESID) {
#pragma unroll
    for (int j = 0; j < 4; ++j) { float* o = ea.f0 + (size_t)(row0 + j) * 1024 + gb + fr;
      if constexpr (ATOM) { unsafeAtomicAdd(o, v0[j]); unsafeAtomicAdd(o + 16, v1[j]); } else { o[0] += v0[j]; o[16] += v1[j]; } }
  } else if constexpr (EPI == E_SWIGLU) {
    const int f = (gb >> 1) + fr;
#pragma unroll
    for (int j = 0; j < 4; ++j) { float g = v0[j], u = v1[j]; ea.b0[(size_t)(row0 + j) * DFF + f] = tobf(g / (1.f + __expf(-g)) * u); }
  } else if constexpr (EPI == E_GELU) {
    bf16_t* dstp = (gb < 2048) ? (ea.b0 + gb + fr) : (ea.b1 + (gb - 2048) + fr);
#pragma unroll
    for (int j = 0; j < 4; ++j) {
      float x = v0[j], y = v1[j];
      dstp[(size_t)(row0 + j) * 2048] = tobf(0.5f * x * (1.f + erff(x * 0.70710678118654752f)));
      dstp[(size_t)(row0 + j) * 2048 + 16] = tobf(0.5f * y * (1.f + erff(y * 0.70710678118654752f)));
    }
  } else if constexpr (EPI == E_MLAQ) {
    const float qs = 0.10206207261596577f * LOG2E;
    const bool is_rope = (gb % 96) == 64;
#pragma unroll
    for (int j = 0; j < 4; ++j) {
      const int row = row0 + j;
      float o0 = v0[j], o1 = v1[j];
      if (is_rope) {
        float2 cs = *(const float2*)(ea.rope + ((size_t)tokpos(row) * 16 + fr) * 2);
        o0 = v0[j] * cs.x - v1[j] * cs.y; o1 = v0[j] * cs.y + v1[j] * cs.x;
      }
      bf16_t* o = ea.b0 + (size_t)row * 1536 + gb + fr;
      o[0] = tobf(o0 * qs); o[16] = tobf(o1 * qs);
    }
  } else if constexpr (EPI == E_MLAKV) {
    const int head = gb >> 7, c0 = gb & 127;
    if (c0 < 64) {
#pragma unroll
      for (int j = 0; j < 4; ++j) { bf16_t* o = ea.b0 + (size_t)(row0 + j) * 1024 + head * 64 + c0 + fr; o[0] = tobf(v0[j]); o[16] = tobf(v1[j]); }
    } else {
      const int d = c0 - 64 + fr;
      size_t off;
      if (row0 < TP) { int b = row0 >> 13, s = row0 & 8191; off = ((size_t)((b * 16 + head) * 64 + d)) * 8192 + s;
        uint2 pk; pk.x = pack2(v0[0], v0[1]); pk.y = pack2(v0[2], v0[3]); *(uint2*)(ea.b1 + off) = pk;
        pk.x = pack2(v1[0], v1[1]); pk.y = pack2(v1[2], v1[3]); *(uint2*)(ea.b1 + off + (size_t)16 * 8192) = pk;
      } else { int u = row0 - TP; int b = u / SPAD, s = u - b * SPAD; off = (size_t)TP * 1024 + ((size_t)((b * 16 + head) * 64 + d)) * SPAD + s;
        uint2 pk; pk.x = pack2(v0[0], v0[1]); pk.y = pack2(v0[2], v0[3]); *(uint2*)(ea.b1 + off) = pk;
        pk.x = pack2(v1[0], v1[1]); pk.y = pack2(v1[2], v1[3]); *(uint2*)(ea.b1 + off + (size_t)16 * SPAD) = pk;
      }
    }
  } else if constexpr (EPI == E_DSA) {
    if (gb < 1024) {
      const float qs = 0.125f * LOG2E;
#pragma unroll
      for (int j = 0; j < 4; ++j) { bf16_t* o = ea.b0 + (size_t)(row0 + j) * 1024 + gb + fr; o[0] = tobf(v0[j] * qs); o[16] = tobf(v1[j] * qs); }
    } else if (gb < 2048) {
      const int c = gb - 1024 + fr;
#pragma unroll
      for (int j = 0; j < 4; ++j) {
        const int row = row0 + j;
        float* o = (row < TP) ? ea.f0 + (size_t)row * 1024 + c : ea.f1 + (size_t)(row - TP) * 1024 + c;
        o[0] = v0[j]; o[16] = v1[j];
        bf16_t* ob = ea.b1 + (size_t)rowmap(row) * 1024 + c;
        ob[0] = tobf(v0[j]); ob[16] = tobf(v1[j]);
      }
    } else if (gb < 3072) {
      const int c = gb - 2048 + fr, head = c >> 6, d = c & 63;
#pragma unroll
      for (int j = 0; j < 4; ++j) {
        const int row = row0 + j;
        float* o = (row < TP) ? ea.f2 + (size_t)row * 1024 + c : ea.f3 + (size_t)(row - TP) * 1024 + c;
        o[0] = v0[j]; o[16] = v1[j];
      }
      size_t off, dstr;
      if (row0 < TP) { int b = row0 >> 13, s = row0 & 8191; off = ((size_t)((b * 16 + head) * 64 + d)) * 8192 + s; dstr = 8192; }
      else { int u = row0 - TP; int b = u >> 4, s = 1024 + (u & 15); off = (size_t)TP * 1024 + ((size_t)((b * 16 + head) * 64 + d)) * SPAD + s; dstr = SPAD; }
      uint2 pk; pk.x = pack2(v0[0], v0[1]); pk.y = pack2(v0[2], v0[3]); *(uint2*)(ea.b2 + off) = pk;
      pk.x = pack2(v1[0], v1[1]); pk.y = pack2(v1[2], v1[3]); *(uint2*)(ea.b2 + off + 16 * dstr) = pk;
    } else if (gb < 3584) {
      const int c = gb - 3072 + fr;
#pragma unroll
      for (int j = 0; j < 4; ++j) { bf16_t* o = ea.b3 + (size_t)(row0 + j) * 512 + c; o[0] = tobf(v0[j] * 0.125f); o[16] = tobf(v1[j] * 0.125f); }
    } else if (gb < 3648) {
      const int c = gb - 3584 + fr;
#pragma unroll
      for (int j = 0; j < 4; ++j) { float* o = ea.f4 + (size_t)(row0 + j) * 64 + c; o[0] = v0[j]; o[16] = v1[j]; }
    } else if (gb == 3648) {
      if (fr < 8) {
#pragma unroll
        for (int j = 0; j < 4; ++j) ea.f5[(size_t)(row0 + j) * 8 + fr] = v0[j] * 0.35355339059327379f;
      }
    }
  }
}

template <int EPI, bool ATOM>
DI void gemm256_tile(const bf16_t* __restrict__ A, const bf16_t* __restrict__ Bt, const int K, const int kt0, const int nt, const int brow, const int bcol,
                     const EArgs& ea, unsigned char* smem, int wv) {
  bf16_t* shm = (bf16_t*)smem;
  const int tid = ltid(wv);
#define SA(b, h) (shm + ((b) * 2 + (h)) * G_HT)
#define SB(b, h) (shm + (4 + (b) * 2 + (h)) * G_HT)
#define STAGE(P, BASE, br, kt) do { const char* _gb = (const char*)((BASE) + (long)(br) * K + (long)((kt) + kt0) * 64); \
    __builtin_amdgcn_global_load_lds((const unsigned*)(_gb + voff0), (LAS unsigned*)((char*)(P) + tid * 16), 16, 0, 0); \
    __builtin_amdgcn_global_load_lds((const unsigned*)(_gb + voff1), (LAS unsigned*)((char*)(P) + tid * 16 + 8192), 16, 0, 0); } while (0)
#define LDA(dst, b, h) _Pragma("unroll") for (int m = 0; m < 4; ++m) _Pragma("unroll") for (int k = 0; k < 2; ++k) \
    dst[m][k] = *reinterpret_cast<const bf16x8*>((char*)SA(b, h) + lds_byte(wr * 64 + m * 16 + fr, k * 32 + fq * 8))
#define LDB(dst, b, h) _Pragma("unroll") for (int n = 0; n < 2; ++n) _Pragma("unroll") for (int k = 0; k < 2; ++k) \
    dst[n][k] = *reinterpret_cast<const bf16x8*>((char*)SB(b, h) + lds_byte(wc * 32 + n * 16 + fr, k * 32 + fq * 8))
#define MMA(ai, bj, At_, Bt_) do { __builtin_amdgcn_s_setprio(1); \
    _Pragma("unroll") for (int m = 0; m < 4; ++m) _Pragma("unroll") for (int n = 0; n < 2; ++n) _Pragma("unroll") for (int k = 0; k < 2; ++k) \
      acc[ai][bj][m][n] = __builtin_amdgcn_mfma_f32_16x16x32_bf16(At_[m][k], Bt_[n][k], acc[ai][bj][m][n], 0, 0, 0); \
    __builtin_amdgcn_s_setprio(0); } while (0)
#define WAIT_V(n) asm volatile("s_waitcnt vmcnt(" #n ")" ::: "memory")
#define WAIT_L(n) asm volatile("s_waitcnt lgkmcnt(" #n ")" ::: "memory")
#define BAR __builtin_amdgcn_s_barrier()
#define SCHED __builtin_amdgcn_sched_barrier(0)
  const int wid = tid >> 6, lane = tid & 63, wr = wid >> 2, wc = wid & 3, fr = lane & 15, fq = lane >> 4;
  unsigned voff0, voff1;
  { int r_, c_; stage_rc(tid * 16, r_, c_); voff0 = (unsigned)(r_ * K + c_) * 2u; stage_rc(tid * 16 + 8192, r_, c_); voff1 = (unsigned)(r_ * K + c_) * 2u; }
  f32x4v acc[2][2][4][2];
#pragma unroll
  for (int a = 0; a < 2; ++a)
#pragma unroll
    for (int b = 0; b < 2; ++b)
#pragma unroll
      for (int m = 0; m < 4; ++m)
#pragma unroll
        for (int n = 0; n < 2; ++n) acc[a][b][m][n] = (f32x4v){0.f, 0.f, 0.f, 0.f};
  bf16x8 At[4][2], B0[2][2], B1[2][2];
  const int HALF = 128;
  WAIT_V(0); WAIT_L(0); BAR;
  STAGE(SB(0, 0), Bt, bcol, 0); STAGE(SA(0, 0), A, brow, 0);
  STAGE(SB(0, 1), Bt, bcol + HALF, 0); STAGE(SA(0, 1), A, brow + HALF, 0);
  if (wr == 1) BAR;
  WAIT_V(4); BAR;
  STAGE(SB(1, 0), Bt, bcol, 1); STAGE(SA(1, 0), A, brow, 1); STAGE(SB(1, 1), Bt, bcol + HALF, 1);
  WAIT_V(6); BAR;
  for (int t = 0; t < nt - 2; t += 2) {
    LDB(B0, 0, 0); SCHED; LDA(At, 0, 0); STAGE(SA(1, 1), A, brow + HALF, t + 1);
    WAIT_L(8); BAR; WAIT_L(0); MMA(0, 0, At, B0); BAR; SCHED;
    LDB(B1, 0, 1); STAGE(SB(0, 0), Bt, bcol, t + 2);
    BAR; WAIT_L(0); MMA(0, 1, At, B1); BAR;
    LDA(At, 0, 1); STAGE(SA(0, 0), A, brow, t + 2);
    BAR; WAIT_L(0); MMA(1, 0, At, B0); BAR; SCHED;
    STAGE(SB(0, 1), Bt, bcol + HALF, t + 2);
    WAIT_V(6); BAR; MMA(1, 1, At, B1); BAR;
    LDB(B0, 1, 0); SCHED; LDA(At, 1, 0); STAGE(SA(0, 1), A, brow + HALF, t + 2);
    WAIT_L(8); BAR; WAIT_L(0); MMA(0, 0, At, B0); BAR; SCHED;
    LDB(B1, 1, 1); STAGE(SB(1, 0), Bt, bcol, t + 3);
    BAR; WAIT_L(0); MMA(0, 1, At, B1); BAR;
    LDA(At, 1, 1); STAGE(SA(1, 0), A, brow, t + 3);
    BAR; WAIT_L(0); MMA(1, 0, At, B0); BAR; SCHED;
    STAGE(SB(1, 1), Bt, bcol + HALF, t + 3);
    WAIT_V(6); BAR; MMA(1, 1, At, B1); BAR;
  }
  { LDB(B0, 0, 0); LDA(At, 0, 0); STAGE(SA(1, 1), A, brow + HALF, nt - 1);
    BAR; WAIT_L(0); MMA(0, 0, At, B0); BAR;
    LDB(B1, 0, 1); BAR; WAIT_L(0); MMA(0, 1, At, B1); BAR;
    LDA(At, 0, 1); WAIT_V(4); BAR; WAIT_L(0); MMA(1, 0, At, B0); MMA(1, 1, At, B1); BAR; }
  { LDB(B0, 1, 0); LDA(At, 1, 0); WAIT_V(2); BAR; WAIT_L(0); MMA(0, 0, At, B0); BAR;
    LDB(B1, 1, 1); WAIT_V(0); BAR; WAIT_L(0); MMA(0, 1, At, B1); BAR;
    LDA(At, 1, 1); BAR; WAIT_L(0); MMA(1, 0, At, B0); MMA(1, 1, At, B1); BAR; }
  if (wr == 0) BAR;
#pragma unroll
  for (int ai = 0; ai < 2; ++ai)
#pragma unroll
    for (int bj = 0; bj < 2; ++bj)
#pragma unroll
      for (int m = 0; m < 4; ++m)
      { epi16<EPI, ATOM>(ea, brow + ai * 128 + wr * 64 + m * 16 + fq * 4, bcol + bj * 128 + wc * 32, fr, acc[ai][bj][m][0], acc[ai][bj][m][1]); __builtin_amdgcn_sched_barrier(0); }
#undef SA
#undef SB
#undef STAGE
#undef LDA
#undef LDB
#undef MMA
#undef WAIT_V
#undef WAIT_L
#undef BAR
#undef SCHED
}

DI void tile_map(int t, int nM, int nN, int nwg, int& pm, int& pn) {
  int wgid = t;
  { int q = nwg >> 3, r = nwg & 7, xcd = wgid & 7, off = wgid >> 3; wgid = (xcd < r ? xcd * (q + 1) : r * (q + 1) + (xcd - r) * q) + off; }
  const int nig = 8 * nN, gid = wgid / nig, fm = gid * 8, gsz = min(nM - fm, 8);
  pm = fm + ((wgid % nig) % gsz); pn = (wgid % nig) / gsz;
}
template <int EPI>
DI void gemm_phase(const bf16_t* A, const bf16_t* Bt, int M, int N, int K, const EArgs& ea,
                   unsigned char* smem, int tstart, int bid, int nblk, int wv) {
  const int nM = M >> 8, nN = N >> 8, nwg = nM * nN, nt = K >> 6;
  if constexpr (EPI == E_RESID) {
    const int nfull = (nwg / nblk) * nblk, rem = nwg - nfull;
    for (int t = bid; t < nfull; t += nblk) {
      int pm, pn; tile_map(t, nM, nN, nwg, pm, pn);
      gemm256_tile<EPI, false>(A, Bt, K, 0, nt, pm * 256, pn * 256, ea, smem, wv);
    }
    if (rem > 0) {
      int ns = nblk / rem; if (ns > (nt >> 2)) ns = nt >> 2; if (ns < 1) ns = 1;
      const int per = ((nt / ns) >> 1) << 1;
      for (int u = bid; u < rem * ns; u += nblk) {
        const int t = nfull + u / ns, ks = u % ns;
        const int k0 = ks * per, kn = (ks == ns - 1) ? (nt - k0) : per;
        int pm, pn; tile_map(t, nM, nN, nwg, pm, pn);
        gemm256_tile<EPI, true>(A, Bt, K, k0, kn, pm * 256, pn * 256, ea, smem, wv);
      }
    }
  } else {
    int t0 = bid - (tstart % nblk); if (t0 < 0) t0 += nblk;
    for (int t = t0; t < nwg; t += nblk) {
      int pm, pn; tile_map(t, nM, nN, nwg, pm, pn);
      gemm256_tile<EPI, false>(A, Bt, K, 0, nt, pm * 256, pn * 256, ea, smem, wv);
    }
  }
}

DI void rmsnorm_rows(const float* __restrict__ X, const float* __restrict__ g, bf16_t* __restrict__ H, float* outp, float* outs,
                     int bid, int nblk, int wv) {
  const int lane = ltid(wv) & 63, w = ltid(wv) >> 6;
  for (int row = bid * 8 + w; row < T; row += nblk * 8) {
    const float* xr = X + (size_t)row * 1024;
    float4 v[4];
    float ss = 0.f;
#pragma unroll
    for (int c = 0; c < 4; ++c) { v[c] = *(const float4*)(xr + c * 256 + lane * 4); ss += v[c].x * v[c].x + v[c].y * v[c].y + v[c].z * v[c].z + v[c].w * v[c].w; }
    ss = wave_sum(ss, lane);
    float r = rsqrtf(ss * (1.f / 1024.f) + EPS);
#pragma unroll
    for (int c = 0; c < 4; ++c) {
      int col = c * 256 + lane * 4;
      float4 gg = *(const float4*)(g + col);
      float a = v[c].x * r * gg.x, b = v[c].y * r * gg.y, cc = v[c].z * r * gg.z, d = v[c].w * r * gg.w;
      if (H) { uint2 pk; pk.x = pack2(a, b); pk.y = pack2(cc, d); *(uint2*)(H + (size_t)row * 1024 + col) = pk; }
      else {
        float* o = (row < TP) ? outp + (size_t)row * 1024 + col : outs + (size_t)(row - TP) * 1024 + col;
        *(float4*)o = make_float4(a, b, cc, d);
      }
    }
  }
}

DI void mla_rowops(PREF p, int j, int bid, int nblk, int wv) {
  const int lane = ltid(wv) & 63, w = ltid(wv) >> 6;
  unsigned char* R = p.ws + OFF_R;
  const float* RAW = (const float*)(R + R_RAW);
  bf16_t* CQ = (bf16_t*)(R + R_CQ); bf16_t* CKV = (bf16_t*)(R + R_CKV); bf16_t* KR = (bf16_t*)(R + R_KR);
  const float* gq = p.in[11] + j * 512; const float* gkv = p.in[14] + j * 256;
  const float* rope = (const float*)(p.ws + OFF_ROPE);
  for (int row = bid * 8 + w; row < T; row += nblk * 8) {
    const float* rr = RAW + (size_t)row * 1024;
    float4 a0 = *(const float4*)(rr + lane * 4), a1 = *(const float4*)(rr + 256 + lane * 4);
    float4 c0 = *(const float4*)(rr + 512 + lane * 4);
    float ss = a0.x * a0.x + a0.y * a0.y + a0.z * a0.z + a0.w * a0.w + a1.x * a1.x + a1.y * a1.y + a1.z * a1.z + a1.w * a1.w;
    float s2 = c0.x * c0.x + c0.y * c0.y + c0.z * c0.z + c0.w * c0.w;
    ss = wave_sum(ss, lane); s2 = wave_sum(s2, lane);
    float r1 = rsqrtf(ss * (1.f / 512.f) + EPS), r2 = rsqrtf(s2 * (1.f / 256.f) + EPS);
    {
      float4 g0 = *(const float4*)(gq + lane * 4), g1 = *(const float4*)(gq + 256 + lane * 4);
      uint2 pk; pk.x = pack2(a0.x * r1 * g0.x, a0.y * r1 * g0.y); pk.y = pack2(a0.z * r1 * g0.z, a0.w * r1 * g0.w);
      *(uint2*)(CQ + (size_t)row * 512 + lane * 4) = pk;
      pk.x = pack2(a1.x * r1 * g1.x, a1.y * r1 * g1.y); pk.y = pack2(a1.z * r1 * g1.z, a1.w * r1 * g1.w);
      *(uint2*)(CQ + (size_t)row * 512 + 256 + lane * 4) = pk;
    }
    const int rm = rowmap(row);
    {
      float4 g = *(const float4*)(gkv + lane * 4);
      float4 o = make_float4(c0.x * r2 * g.x, c0.y * r2 * g.y, c0.z * r2 * g.z, c0.w * r2 * g.w);
      float* op = (row < TP) ? p.out + O_CKVP + ((size_t)j * TP + row) * 256 : p.out + O_CKVS + ((size_t)j * TS + (row - TP)) * 256;
      *(float4*)(op + lane * 4) = o;
      uint2 pk; pk.x = pack2(o.x, o.y); pk.y = pack2(o.z, o.w);
      *(uint2*)(CKV + (size_t)rm * 256 + lane * 4) = pk;
    }
    if (lane < 16) {
      float x1 = rr[768 + lane], x2 = rr[784 + lane];
      int pos = tokpos(row);
      float2 cs = *(const float2*)(rope + ((size_t)pos * 16 + lane) * 2);
      float o1 = x1 * cs.x - x2 * cs.y, o2 = x1 * cs.y + x2 * cs.x;
      float* op = (row < TP) ? p.out + O_KRP + ((size_t)j * TP + row) * 32 : p.out + O_KRS + ((size_t)j * TS + (row - TP)) * 32;
      op[lane] = o1; op[16 + lane] = o2;
      KR[(size_t)rm * 32 + lane] = tobf(o1); KR[(size_t)rm * 32 + 16 + lane] = tobf(o2);
    }
  }
}

DI void dsa_rowops(PREF p, int bid, int nblk, int wv) {
  const int lane = ltid(wv) & 63, w = ltid(wv) >> 6;
  unsigned char* R = p.ws + OFF_R;
  const float* KIR = (const float*)(R + D_KIR);
  bf16_t* KI = (bf16_t*)(R + D_KI);
  const float* g = p.in[27];
  for (int row = bid * 8 + w; row < T; row += nblk * 8) {
    float v = KIR[(size_t)row * 64 + lane];
    float ss = wave_sum(v * v, lane);
    float r = rsqrtf(ss * (1.f / 64.f) + EPS);
    float o = v * r * g[lane];
    if (row < TP) p.out[O_DIP + (size_t)row * 64 + lane] = o; else p.out[O_DIS + (size_t)(row - TP) * 64 + lane] = o;
    KI[(size_t)rowmap(row) * 64 + lane] = tobf(o);
  }
}

DI void cmlp_ln_rows(PREF p, int bid, int nblk, int wv) {
  const int lane = ltid(wv) & 63, w = ltid(wv) >> 6;
  unsigned char* R = p.ws + OFF_R;
  const bf16_t* VR = (const bf16_t*)(R + C_VR);
  bf16_t* VLN = (bf16_t*)(R + C_VLN);
  const float* g = p.in[18]; const float* bb = p.in[19];
  for (int row = bid * 8 + w; row < T; row += nblk * 8) {
    float x[32];
    float sum = 0.f;
#pragma unroll
    for (int c = 0; c < 4; ++c) {
      uint4 u = *(const uint4*)(VR + (size_t)row * 2048 + c * 512 + lane * 8);
      x[c * 8 + 0] = bflo(u.x); x[c * 8 + 1] = bfhi(u.x); x[c * 8 + 2] = bflo(u.y); x[c * 8 + 3] = bfhi(u.y);
      x[c * 8 + 4] = bflo(u.z); x[c * 8 + 5] = bfhi(u.z); x[c * 8 + 6] = bflo(u.w); x[c * 8 + 7] = bfhi(u.w);
    }
#pragma unroll
    for (int i = 0; i < 32; ++i) sum += x[i];
    sum = wave_sum(sum, lane);
    float mu = sum * (1.f / 2048.f);
    float vs = 0.f;
#pragma unroll
    for (int i = 0; i < 32; ++i) { x[i] -= mu; vs += x[i] * x[i]; }
    vs = wave_sum(vs, lane);
    float r = rsqrtf(vs * (1.f / 2048.f) + EPS);
#pragma unroll
    for (int c = 0; c < 4; ++c) {
      int col = c * 512 + lane * 8;
      float y[8];
#pragma unroll
      for (int q = 0; q < 2; ++q) {
        float4 gg = *(const float4*)(g + col + q * 4), b4 = *(const float4*)(bb + col + q * 4);
        y[q * 4 + 0] = x[c * 8 + q * 4 + 0] * r * gg.x + b4.x; y[q * 4 + 1] = x[c * 8 + q * 4 + 1] * r * gg.y + b4.y;
        y[q * 4 + 2] = x[c * 8 + q * 4 + 2] * r * gg.z + b4.z; y[q * 4 + 3] = x[c * 8 + q * 4 + 3] * r * gg.w + b4.w;
      }
      uint4 pk; pk.x = pack2(y[0], y[1]); pk.y = pack2(y[2], y[3]); pk.z = pack2(y[4], y[5]); pk.w = pack2(y[6], y[7]);
      *(uint4*)(VLN + (size_t)row * 2048 + col) = pk;
      if (row >= TP) {
        float* o = p.out + O_CVS + (size_t)(row - TP) * 2048 + col;
        *(float4*)o = make_float4(y[0], y[1], y[2], y[3]); *(float4*)(o + 4) = make_float4(y[4], y[5], y[6], y[7]);
      }
    }
  }
}

DI void cmlp_mix_phase(PREF p, unsigned char* smem, int bid, int nblk, int wv) {
  const int tid = ltid(wv), lane = tid & 63, w = tid >> 6, wm = w >> 2, wn = w & 3, lr = lane & 31, lh = lane >> 5;
  unsigned char* R = p.ws + OFF_R;
  const bf16_t* U = (const bf16_t*)(R + C_U);
  const bf16_t* VLN = (const bf16_t*)(R + C_VLN);
  bf16_t* G = (bf16_t*)(R + C_G);
  const bf16_t* WT = (const bf16_t*)(p.ws + OFF_W) + W_TRIL;
  const float* bs = p.in[21];
  bf16_t* As = (bf16_t*)smem;
  bf16_t* Bs = As + 128 * 136;
  for (int u = bid; u < 1024; u += nblk) {
    const int g = u & 7, ch = u >> 3;
    const int col0 = g * 256;
#pragma unroll 2
    for (int i = 0; i < 4; ++i) {
      int v = tid + i * NT; int r = v >> 4, c = (v & 15) * 8;
      *(uint4*)(As + r * 136 + c) = *(const uint4*)(WT + ((size_t)g * 128 + r) * 128 + c);
    }
#pragma unroll 2
    for (int i = 0; i < 8; ++i) {
      int v = tid + i * NT; int s = v >> 5, c = (v & 31) * 8;
      uint4 x = *(const uint4*)(VLN + ((size_t)ch * 128 + s) * 2048 + col0 + c);
      Bs[(c + 0) * 136 + s] = (bf16_t)(x.x & 0xffff); Bs[(c + 1) * 136 + s] = (bf16_t)(x.x >> 16);
      Bs[(c + 2) * 136 + s] = (bf16_t)(x.y & 0xffff); Bs[(c + 3) * 136 + s] = (bf16_t)(x.y >> 16);
      Bs[(c + 4) * 136 + s] = (bf16_t)(x.z & 0xffff); Bs[(c + 5) * 136 + s] = (bf16_t)(x.z >> 16);
      Bs[(c + 6) * 136 + s] = (bf16_t)(x.w & 0xffff); Bs[(c + 7) * 136 + s] = (bf16_t)(x.w >> 16);
    }
    __syncthreads();
    f32x16 acc[2][2];
#pragma unroll
    for (int a = 0; a < 2; ++a)
#pragma unroll
      for (int b = 0; b < 2; ++b)
#pragma unroll
        for (int i = 0; i < 16; ++i) acc[a][b][i] = 0.f;
    const bf16_t* Asb = As + (wm * 64 + lr) * 136 + lh * 8;
    const bf16_t* Bsb = Bs + (wn * 64 + lr) * 136 + lh * 8;
    const int ns = (wm + 1) * 4;
    for (int s = 0; s < ns; ++s) {
      bf16x8 a0 = *(const bf16x8*)(Asb + s * 16);
      bf16x8 a1 = *(const bf16x8*)(Asb + 32 * 136 + s * 16);
      bf16x8 b0 = *(const bf16x8*)(Bsb + s * 16);
      bf16x8 b1 = *(const bf16x8*)(Bsb + 32 * 136 + s * 16);
      acc[0][0] = MFMA32(a0, b0, acc[0][0]);
      acc[0][1] = MFMA32(a0, b1, acc[0][1]);
      acc[1][0] = MFMA32(a1, b0, acc[1][0]);
      acc[1][1] = MFMA32(a1, b1, acc[1][1]);
    }
#pragma unroll
    for (int mi = 0; mi < 2; ++mi)
#pragma unroll
      for (int ni = 0; ni < 2; ++ni)
#pragma unroll
        for (int i = 0; i < 16; ++i) {
          int t = wm * 64 + mi * 32 + crow(i, lh);
          int col = col0 + wn * 64 + ni * 32 + lr;
          size_t off = ((size_t)ch * 128 + t) * 2048 + col;
          float mixed = acc[mi][ni][i] + bs[g * 128 + t];
          G[off] = tobf(frombf(U[off]) * mixed);
        }
    __syncthreads();
  }
  const float* wsf = p.in[20];
  for (int e = bid * NT + tid; e < TS * 2048; e += nblk * NT) {
    int row = e >> 11, col = e & 2047, b = row >> 4, t = row & 15, g = col >> 8;
    float a = bs[g * 128 + t];
    for (int s = 0; s <= t; ++s) a += wsf[((size_t)g * 128 + t) * 128 + s] * frombf(VLN[((size_t)TP + b * 16 + s) * 2048 + col]);
    size_t off = ((size_t)TP + row) * 2048 + col;
    G[off] = tobf(frombf(U[off]) * a);
  }
}

template <int DQK, bool IS_MLA, bool MASKED>
DI void attn8_unit(const bf16_t* __restrict__ Qp, int ldq, int nq,
                   const bf16_t* __restrict__ Kp, int ldk, const bf16_t* __restrict__ KRp,
                   const bf16_t* __restrict__ Vtp, int ldv, int kmax,
                   int nit, int nk64_w, int nkeys, const unsigned* __restrict__ BMp,
                   bf16_t* __restrict__ AOp, unsigned char* smem, int wv) {
  constexpr int KS = DQK + 8;
  constexpr int VS = 132;
  constexpr int NQS = DQK / 16;
  const int tid = ltid(wv), lane = tid & 63, w = tid >> 6, lr = lane & 31, lh = lane >> 5;
  bf16_t* Ks = (bf16_t*)smem;
  bf16_t* Vs = Ks + 2 * 128 * KS;
  const bool q_ok = (w * 32 + lr) < nq;
  const int qrow = q_ok ? (w * 32 + lr) : 0;
  bf16x8 qf[NQS];
#pragma unroll
  for (int s = 0; s < NQS; ++s) qf[s] = *(const bf16x8*)(Qp + (size_t)qrow * ldq + s * 16 + lh * 8);
  f32x16 oacc[2];
#pragma unroll
  for (int d = 0; d < 2; ++d)
#pragma unroll
    for (int i = 0; i < 16; ++i) oacc[d][i] = 0.f;
  float m_run = -INFINITY, l_run = 0.f;
  const int kkey = tid >> 3, kc = (tid & 7) * 8;
  const int rkey = tid >> 2, rc = (tid & 3) * 8;
  const int vd = tid >> 4, vk = (tid & 15) * 8;
  uint4 rk0, rk1, rr, rv0, rv1;
  rr = make_uint4(0, 0, 0, 0);
  uint4 bm_next = make_uint4(0xffffffffu, 0xffffffffu, 0xffffffffu, 0xffffffffu), bm_cur = bm_next;
#define GLOAD(it_) do { const int key0_ = (it_) * 128; \
    { int kr_ = min(key0_ + kkey, kmax - 1); rk0 = *(const uint4*)(Kp + (size_t)kr_ * ldk + kc); } \
    { int kr_ = min(key0_ + kkey + 64, kmax - 1); rk1 = *(const uint4*)(Kp + (size_t)kr_ * ldk + kc); } \
    if constexpr (IS_MLA) { int kr_ = min(key0_ + rkey, kmax - 1); rr = *(const uint4*)(KRp + (size_t)kr_ * 32 + rc); } \
    { int kv_ = min(key0_ + vk, kmax - 8); rv0 = *(const uint4*)(Vtp + (size_t)vd * ldv + kv_); rv1 = *(const uint4*)(Vtp + (size_t)(vd + 32) * ldv + kv_); } \
    if constexpr (MASKED) { if (BMp) bm_next = *(const uint4*)(BMp + (size_t)qrow * 256 + (it_) * 4); } } while (0)
#define SSTORE(buf_) do { bf16_t* Kb_ = Ks + (buf_) * 128 * KS; bf16_t* Vb_ = Vs + (buf_) * 64 * VS; \
    *(uint4*)(Kb_ + kkey * KS + kc) = rk0; *(uint4*)(Kb_ + (kkey + 64) * KS + kc) = rk1; \
    if constexpr (IS_MLA) *(uint4*)(Kb_ + rkey * KS + 64 + rc) = rr; \
    *(uint2*)(Vb_ + vd * VS + vk) = make_uint2(rv0.x, rv0.y); *(uint2*)(Vb_ + vd * VS + vk + 4) = make_uint2(rv0.z, rv0.w); \
    *(uint2*)(Vb_ + (vd + 32) * VS + vk) = make_uint2(rv1.x, rv1.y); *(uint2*)(Vb_ + (vd + 32) * VS + vk + 4) = make_uint2(rv1.z, rv1.w); } while (0)
  const int nit_w = (nk64_w + 1) >> 1;
  __syncthreads();
  GLOAD(0); SSTORE(0); bm_cur = bm_next;
  __syncthreads();
  for (int it = 0; it < nit; ++it) {
    const int buf = it & 1;
    if (it + 1 < nit) GLOAD(it + 1);
    if (it < nit_w) {
      const bf16_t* Kb = Ks + buf * 128 * KS; const bf16_t* Vb = Vs + buf * 64 * VS;
      f32x16 sacc[4];
#pragma unroll
      for (int t4 = 0; t4 < 4; ++t4) {
#pragma unroll
        for (int i = 0; i < 16; ++i) sacc[t4][i] = 0.f;
#pragma unroll
        for (int s = 0; s < NQS; ++s) {
          bf16x8 kf = *(const bf16x8*)(Kb + (t4 * 32 + lr) * KS + s * 16 + lh * 8);
          sacc[t4] = MFMA32(kf, qf[s], sacc[t4]);
        }
      }
      if ((2 * it + 1) >= nk64_w) {
#pragma unroll
        for (int t4 = 2; t4 < 4; ++t4)
#pragma unroll
          for (int i = 0; i < 16; ++i) sacc[t4][i] = -INFINITY;
      }
      float mx = -INFINITY;
#pragma unroll
      for (int t4 = 0; t4 < 4; ++t4) {
        const unsigned wbits = (t4 == 0) ? bm_cur.x : (t4 == 1) ? bm_cur.y : (t4 == 2) ? bm_cur.z : bm_cur.w;
#pragma unroll
        for (int i = 0; i < 16; ++i) {
          if constexpr (MASKED) {
            const int kin = crow(i, lh);
            const int key = it * 128 + t4 * 32 + kin;
            bool ok = (key < nkeys) && ((wbits >> kin) & 1u);
            sacc[t4][i] = ok ? sacc[t4][i] : -INFINITY;
          }
          mx = fmaxf(mx, sacc[t4][i]);
        }
      }
      mx = fmaxf(mx, shflx(mx, 32, lane));
      const float m_new = fmaxf(m_run, mx);
      const float m_safe = (m_new == -INFINITY) ? 0.f : m_new;
      const float alpha = __builtin_amdgcn_exp2f(m_run - m_safe);
      m_run = m_new;
      float ls = 0.f;
#pragma unroll
      for (int t4 = 0; t4 < 4; ++t4)
#pragma unroll
        for (int i = 0; i < 16; ++i) { float pv = __builtin_amdgcn_exp2f(sacc[t4][i] - m_safe); sacc[t4][i] = pv; ls += pv; }
      l_run = l_run * alpha + ls;
#pragma unroll
      for (int d = 0; d < 2; ++d)
#pragma unroll
        for (int i = 0; i < 16; ++i) oacc[d][i] *= alpha;
#pragma unroll
      for (int t4 = 0; t4 < 4; ++t4)
#pragma unroll
        for (int s = 0; s < 2; ++s) {
          uint4 pp;
          pp.x = pack2(sacc[t4][8 * s + 0], sacc[t4][8 * s + 1]);
          pp.y = pack2(sacc[t4][8 * s + 2], sacc[t4][8 * s + 3]);
          pp.z = pack2(sacc[t4][8 * s + 4], sacc[t4][8 * s + 5]);
          pp.w = pack2(sacc[t4][8 * s + 6], sacc[t4][8 * s + 7]);
          bf16x8 pf = __builtin_bit_cast(bf16x8, pp);
#pragma unroll
          for (int dt = 0; dt < 2; ++dt) {
            const bf16_t* vrow = Vb + (dt * 32 + lr) * VS + t4 * 32 + 16 * s + 4 * lh;
            uint2 lo = *(const uint2*)(vrow), hi = *(const uint2*)(vrow + 8);
            uint4 vv = make_uint4(lo.x, lo.y, hi.x, hi.y);
            bf16x8 vf = __builtin_bit_cast(bf16x8, vv);
            oacc[dt] = MFMA32(vf, pf, oacc[dt]);
          }
        }
    }
    if (it + 1 < nit) { SSTORE(buf ^ 1); bm_cur = bm_next; }
    __syncthreads();
  }
  if (nit_w > 0) {
    float lt = l_run + shflx(l_run, 32, lane);
    float inv = lt > 0.f ? 1.f / lt : 0.f;
    if (q_ok) {
      bf16_t* orow = AOp + (size_t)(w * 32 + lr) * 1024;
#pragma unroll
      for (int dt = 0; dt < 2; ++dt)
#pragma unroll
        for (int g = 0; g < 4; ++g) {
          uint2 pk;
          pk.x = pack2(oacc[dt][4 * g] * inv, oacc[dt][4 * g + 1] * inv);
          pk.y = pack2(oacc[dt][4 * g + 2] * inv, oacc[dt][4 * g + 3] * inv);
          *(uint2*)(orow + dt * 32 + 8 * g + 4 * lh) = pk;
        }
    }
  }
}
#undef GLOAD
#undef SSTORE

DI int snake_idx(int i, int bid, int nblk) { return i * nblk + ((i & 1) ? (nblk - 1 - bid) : bid); }

template <bool IS_MLA>
DI void attn_phase(PREF p, unsigned char* smem, int bid, int nblk, int wv) {
  unsigned char* R = p.ws + OFF_R;
  const int w = ltid(wv) >> 6;
  const int total = 1024 + 512;
  for (int i = 0; i * nblk < total; ++i) {
    int u = snake_idx(i, bid, nblk);
    if (u >= total) continue;
    if constexpr (IS_MLA) {
      const bf16_t* Q = (const bf16_t*)(R + R_Q); const bf16_t* KN = (const bf16_t*)(R + R_KN);
      const bf16_t* KR = (const bf16_t*)(R + R_KR); const bf16_t* VT = (const bf16_t*)(R + R_VT);
      bf16_t* AO = (bf16_t*)(R + R_RAW);
      if (u < 1024) {
        int qt = 31 - (u >> 5), bh = u & 31, b = bh >> 4, h = bh & 15;
        int q0 = b * 8192 + qt * 256;
        attn8_unit<96, true, false>(Q + (size_t)q0 * 1536 + h * 96, 1536, 256,
                                    KN + (size_t)(b * 8192) * 1024 + h * 64, 1024, KR + (size_t)(b * 8192) * 32,
                                    VT + (size_t)((b * 16 + h) * 64) * 8192, 8192, 8192,
                                    2 * qt + 2, 4 * qt + 1 + (w >> 1), 1 << 30, nullptr,
                                    AO + (size_t)q0 * 1024 + h * 64, smem, wv);
      } else {
        int v = u - 1024, b = v >> 4, h = v & 15;
        int q0 = TP + b * 16;
        attn8_unit<96, true, true>(Q + (size_t)q0 * 1536 + h * 96, 1536, 16,
                                   KN + (size_t)(TP + b * SPAD) * 1024 + h * 64, 1024, KR + (size_t)(TP + b * SPAD) * 32,
                                   VT + (size_t)TP * 1024 + (size_t)((b * 16 + h) * 64) * SPAD, SPAD, SPAD,
                                   9, (w == 0) ? 17 : 0, NKS, nullptr,
                                   AO + (size_t)q0 * 1024 + h * 64, smem, wv);
      }
    } else {
      const bf16_t* Q = (const bf16_t*)(R + D_Q); const bf16_t* KK = (const bf16_t*)(R + D_K);
      const bf16_t* VT = (const bf16_t*)(R + D_VT); const unsigned* BM = (const unsigned*)(R + D_BM);
      bf16_t* AO = (bf16_t*)(R + D_AO);
      if (u < 1024) {
        int qt = 31 - (u >> 5), bh = u & 31, b = bh >> 4, h = bh & 15;
        int q0 = b * 8192 + qt * 256;
        attn8_unit<64, false, true>(Q + (size_t)q0 * 1024 + h * 64, 1024, 256,
                                    KK + (size_t)(b * 8192) * 1024 + h * 64, 1024, nullptr,
                                    VT + (size_t)((b * 16 + h) * 64) * 8192, 8192, 8192,
                                    2 * qt + 2, 4 * qt + 1 + (w >> 1), 1 << 30, BM + (size_t)q0 * 256,
                                    AO + (size_t)q0 * 1024 + h * 64, smem, wv);
      } else {
        int v = u - 1024, b = v >> 4, h = v & 15;
        int q0 = TP + b * 16;
        attn8_unit<64, false, true>(Q + (size_t)q0 * 1024 + h * 64, 1024, 16,
                                    KK + (size_t)(TP + b * SPAD) * 1024 + h * 64, 1024, nullptr,
                                    VT + (size_t)TP * 1024 + (size_t)((b * 16 + h) * 64) * SPAD, SPAD, SPAD,
                                    9, (w == 0) ? 17 : 0, NKS, BM + (size_t)q0 * 256,
                                    AO + (size_t)q0 * 1024 + h * 64, smem, wv);
      }
    }
  }
}

constexpr int CAP = 128;
DI int score_bin(float s) {
  unsigned u = __float_as_uint(s);
  int e = (int)((u & 0x7fffffffu) >> 19);
  int m = min(max(e, 1840), 2095) - 1840;
  return (u >> 31) ? (255 - m) : (256 + m);
}

DI void idx_unit(const bf16_t* __restrict__ QI, const float* __restrict__ WI, int q_row0, int nq,
                 const bf16_t* __restrict__ KI, int L, unsigned* __restrict__ BM, unsigned char* smem, int wv) {
  const int tid = ltid(wv), lane = tid & 63, w = tid >> 6, lr = lane & 31, lh = lane >> 5;
  bf16_t* Qs = (bf16_t*)smem;
  float* Ws = (float*)(smem + 36864);
  unsigned* hist = (unsigned*)(smem + 36864 + 1024);
  float* cand_s = (float*)hist;
  int* cand_i = (int*)(smem + 36864 + 1024 + 16384);
  int* bstar = (int*)(smem + 36864 + 1024 + 32768);
  int* need = bstar + 32;
  int* ncand = need + 32;
  __syncthreads();
#pragma unroll
  for (int i = 0; i < 4; ++i) {
    int v = tid + i * NT;
    int hd = v >> 8, q = (v >> 3) & 31, c = (v & 7) * 8;
    int qq = q < nq ? q : 0;
    *(uint4*)(Qs + (hd * 32 + q) * 72 + c) = *(const uint4*)(QI + (size_t)(q_row0 + qq) * 512 + hd * 64 + c);
  }
  if (tid < 256) { int hd = tid >> 5, q = tid & 31; int qq = q < nq ? q : 0; Ws[hd * 32 + q] = WI[(size_t)(q_row0 + qq) * 8 + hd]; }
  for (int i = tid; i < 32 * 256; i += NT) hist[i] = 0u;
  if (tid < 32) { bstar[tid] = -1; need[tid] = 0; ncand[tid] = 0; }
  __syncthreads();
  const int ntile = (L + 255) >> 8;
  const bool do_select = L > 256;
  for (int pass = do_select ? 0 : 1; pass < 2; ++pass) {
    for (int kt = 0; kt < ntile; ++kt) {
      const int key0 = kt * 256 + w * 32;
      if (key0 < L) {
        const int key = key0 + lr;
        bf16x8 kf[4];
#pragma unroll
        for (int s = 0; s < 4; ++s) kf[s] = *(const bf16x8*)(KI + (size_t)key * 64 + s * 16 + lh * 8);
        float sc[16];
#pragma unroll
        for (int i = 0; i < 16; ++i) sc[i] = 0.f;
#pragma unroll 1
        for (int hd = 0; hd < 8; ++hd) {
          f32x16 acc;
#pragma unroll
          for (int i = 0; i < 16; ++i) acc[i] = 0.f;
#pragma unroll
          for (int s = 0; s < 4; ++s) {
            bf16x8 qf = *(const bf16x8*)(Qs + (hd * 32 + lr) * 72 + s * 16 + lh * 8);
            acc = MFMA32(qf, kf[s], acc);
          }
#pragma unroll
          for (int g = 0; g < 4; ++g) {
            float4 wv = *(const float4*)(Ws + hd * 32 + 8 * g + 4 * lh);
            sc[4 * g + 0] += wv.x * fmaxf(acc[4 * g + 0], 0.f);
            sc[4 * g + 1] += wv.y * fmaxf(acc[4 * g + 1], 0.f);
            sc[4 * g + 2] += wv.z * fmaxf(acc[4 * g + 2], 0.f);
            sc[4 * g + 3] += wv.w * fmaxf(acc[4 * g + 3], 0.f);
          }
        }
        const bool kvalid = key < L;
        if (pass == 0) {
#pragma unroll
          for (int i = 0; i < 16; ++i) {
            int q = crow(i, lh);
            if (kvalid) { int b = score_bin(sc[i]); atomicAdd(&hist[q * 256 + (b >> 1)], (b & 1) ? 65536u : 1u); }
          }
        } else {
#pragma unroll
          for (int i = 0; i < 16; ++i) {
            int q = crow(i, lh);
            int b = score_bin(sc[i]);
            int bs = bstar[q];
            bool sel = kvalid && (b > bs);
            bool cnd = kvalid && (b == bs);
            unsigned long long bal = __ballot(sel);
            if (lr == 0 && q < nq) BM[(size_t)(q_row0 + q) * 256 + (key0 >> 5)] = (unsigned)(bal >> (32 * lh));
            if (cnd) {
              int pos = atomicAdd(&ncand[q], 1);
              if (pos < CAP) { cand_s[q * CAP + pos] = sc[i]; cand_i[q * CAP + pos] = key; }
            }
          }
        }
      }
    }
    __syncthreads();
    if (pass == 0) {
      for (int qi = 0; qi < 4; ++qi) {
        const int q = w * 4 + qi;
        unsigned hw[4];
#pragma unroll
        for (int k = 0; k < 4; ++k) hw[k] = hist[q * 256 + 255 - 4 * lane - k];
        int cnt = 0;
#pragma unroll
        for (int k = 0; k < 4; ++k) cnt += (int)(hw[k] >> 16) + (int)(hw[k] & 0xffffu);
        int pre = cnt;
#pragma unroll
        for (int o = 1; o < 64; o <<= 1) { int t = __builtin_amdgcn_ds_bpermute(((lane - o) & 63) << 2, pre); if (lane >= o) pre += t; }
        unsigned long long bal = __ballot(pre >= 256);
        if (bal != 0ull) {
          int fl = __ffsll((long long)bal) - 1;
          if (lane == fl) {
            int running = pre - cnt;
            int bsel = -1, above = 0;
#pragma unroll
            for (int k = 0; k < 4; ++k) {
              int chi = (int)(hw[k] >> 16), clo = (int)(hw[k] & 0xffffu);
              if (bsel < 0) { if (running + chi >= 256) { bsel = 511 - 8 * lane - 2 * k; above = running; } else running += chi; }
              if (bsel < 0) { if (running + clo >= 256) { bsel = 510 - 8 * lane - 2 * k; above = running; } else running += clo; }
            }
            bstar[q] = bsel; need[q] = 256 - above;
          }
        }
      }
      __syncthreads();
    }
  }
  __threadfence();
  __syncthreads();
  if (do_select) {
    for (int pi = tid; pi < 32 * CAP; pi += NT) {
      int q = pi / CAP, c = pi - q * CAP;
      int n = min(ncand[q], CAP);
      if (c < n && q < nq) {
        float sv = cand_s[q * CAP + c]; int iv = cand_i[q * CAP + c];
        int rank = 0;
        for (int j = 0; j < n; ++j) {
          float sj = cand_s[q * CAP + j]; int ij = cand_i[q * CAP + j];
          rank += (sj > sv || (sj == sv && ij < iv)) ? 1 : 0;
        }
        if (rank < need[q]) atomicOr(&BM[(size_t)(q_row0 + q) * 256 + (iv >> 5)], 1u << (iv & 31));
      }
    }
  }
  __syncthreads();
}

DI void idx_phase(PREF p, unsigned char* smem, int bid, int nblk, int wv) {
  unsigned char* R = p.ws + OFF_R;
  const bf16_t* QI = (const bf16_t*)(R + D_QI); const float* WI = (const float*)(R + D_WI);
  const bf16_t* KI = (const bf16_t*)(R + D_KI); unsigned* BM = (unsigned*)(R + D_BM);
  const int total = 512 + 32;
  for (int i = 0; i * nblk < total; ++i) {
    int idx = snake_idx(i, bid, nblk);
    if (idx >= total) continue;
    if (idx < 512) {
      int qt = 255 - (idx >> 1), b = idx & 1;
      int L = (((qt * 32) >> 6) + 1) * 64;
      idx_unit(QI, WI, b * 8192 + qt * 32, 32, KI + (size_t)(b * 8192) * 64, L, BM, smem, wv);
    } else {
      int b = idx - 512;
      idx_unit(QI, WI, TP + b * 16, 16, KI + (size_t)(TP + b * SPAD) * 64, NKS, BM, smem, wv);
    }
  }
}

DI void cvt8(const float* s, bf16_t* d) {
  float4 a = *(const float4*)s, b = *(const float4*)(s + 4);
  uint4 pk; pk.x = pack2(a.x, a.y); pk.y = pack2(a.z, a.w); pk.z = pack2(b.x, b.y); pk.w = pack2(b.z, b.w);
  *(uint4*)d = pk;
}
DI void cache_rows(const float* __restrict__ src, bf16_t* __restrict__ dst, int Wd, int bid, int nblk, int wv) {
  const int vpr = Wd >> 3;
  const size_t total = (size_t)32 * SPAD * vpr;
  for (size_t e = (size_t)bid * NT + ltid(wv); e < total; e += (size_t)nblk * NT) {
    int c = (int)(e % vpr) * 8; size_t rw = e / vpr; int b = (int)(rw / SPAD), s = (int)(rw % SPAD);
    bf16_t* d = dst + ((size_t)TP + (size_t)b * SPAD + s) * Wd + c;
    if (s < 1024) cvt8(src + ((size_t)b * 1024 + s) * Wd + c, d);
    else if (s >= NKS) { unsigned z = 0; asm volatile("" : "+v"(z)); *(uint4*)d = make_uint4(z, z, z, z); }
  }
}


#define XB_TMO      128
#define XB_XCNT(j)  (256  + 64 * (j))
#define XB_XSUB(j)  (1280 + 64 * (j))
#define XB_XGEN(j)  (2304 + 64 * (j))
#define XB_TOP      3328
#define XB_TOPGEN   3392
#define XCD_BAR_WORDS 3456
#define XB_SPIN_CAP (1u << 18)
DI unsigned xb_ld(unsigned* p)              { return __hip_atomic_load(p, __ATOMIC_RELAXED, __HIP_MEMORY_SCOPE_AGENT); }
DI unsigned xb_add(unsigned* p, unsigned v) { return __hip_atomic_fetch_add(p, v, __ATOMIC_RELAXED, __HIP_MEMORY_SCOPE_AGENT); }
DI unsigned xb_xcc_id() { return (unsigned)__builtin_amdgcn_s_getreg((3 << 11) | 20) & 0xFu; }
#define XB_SPIN(cond, bar) do { unsigned _sp = 0; while (cond) { __builtin_amdgcn_s_sleep(1); \
    if ((++_sp & 255u) == 0u) { if (xb_ld(&(bar)[XB_TMO])) break; if (_sp > XB_SPIN_CAP) { atomicAdd(&(bar)[XB_TMO], 1u); break; } } } } while (0)
struct XcdBarrier { unsigned* bar; unsigned x; volatile __attribute__((address_space(3))) unsigned* st; };
DI void xcd_barrier_complete(unsigned* bar, unsigned x, unsigned G, unsigned& nloc, unsigned& nx) {
  unsigned sum, cnt, mine, sp = 0u;
  for (;;) {
    sum = 0u; cnt = 0u; mine = 0u;
#pragma unroll
    for (unsigned j = 0; j < 16; ++j) { const unsigned c = xb_ld(&bar[XB_XCNT(j)]); sum += c; cnt += (c > 0u) ? 1u : 0u; mine = (j == x) ? c : mine; }
    if (sum == G) break;
    __builtin_amdgcn_s_sleep(1);
    if ((++sp & 255u) == 0u) { if (xb_ld(&bar[XB_TMO])) break; if (sp > XB_SPIN_CAP) { atomicAdd(&bar[XB_TMO], 1u); break; } }
  }
  nloc = mine > 0u ? mine : 1u; nx = cnt > 0u ? cnt : 1u;
}
DI void xcd_barrier(const XcdBarrier& b, int tid, unsigned G) {
  asm volatile("s_waitcnt vmcnt(0)" ::: "memory");
  __syncthreads();
  if (tid == 0) {
    unsigned* bar = b.bar;
    __builtin_amdgcn_s_waitcnt(0);
    unsigned nloc = b.st[0], nx = b.st[1];
    if (nloc == 0u) { xcd_barrier_complete(bar, b.x, G, nloc, nx); b.st[0] = nloc; b.st[1] = nx; }
    const unsigned old = xb_add(&bar[XB_XSUB(b.x)], 1u);
    const unsigned gen = old / nloc;
    if (old + 1u == (gen + 1u) * nloc) {
      __builtin_amdgcn_fence(__ATOMIC_RELEASE, "agent");
      asm volatile("s_waitcnt vmcnt(0)" ::: "memory");
      const unsigned og = xb_add(&bar[XB_TOP], 1u);
      const unsigned tg = og / nx;
      if (og + 1u == (tg + 1u) * nx) xb_add(&bar[XB_TOPGEN], 1u);
      else XB_SPIN(xb_ld(&bar[XB_TOPGEN]) == tg, bar);
      __builtin_amdgcn_fence(__ATOMIC_ACQUIRE, "agent");
      xb_add(&bar[XB_XGEN(b.x)], 1u);
      asm volatile("s_waitcnt vmcnt(0)" ::: "memory");
    } else {
      XB_SPIN(xb_ld(&bar[XB_XGEN(b.x)]) == gen, bar);
      __builtin_amdgcn_fence(__ATOMIC_ACQUIRE, "agent");
      asm volatile("s_waitcnt vmcnt(0)" ::: "memory");
    }
  }
  __syncthreads();
}

extern "C" __global__ void __launch_bounds__(512, 2) mega(Params p_unused) {
  extern __shared__ __attribute__((aligned(16))) unsigned char smem[];
  cg::grid_group grid = cg::this_grid();
  const int bid = blockIdx.x, nblk = gridDim.x;
  const int wv = __builtin_amdgcn_readfirstlane((int)(threadIdx.x >> 6));
  CParams* pk = (CParams*)__builtin_amdgcn_kernarg_segment_ptr();
  const int ph_lo = pk->ph_lo, ph_hi = pk->ph_hi;
  int ph = 0;
  XcdBarrier xb;
  {
    volatile __attribute__((address_space(3))) unsigned* st = (volatile __attribute__((address_space(3))) unsigned*)(smem + 131072);
    const int t0 = ltid(wv);
    if (t0 == 0) { st[0] = 0u; st[1] = 0u; }
    __syncthreads();
    xb.bar = (unsigned*)(pk->ws + OFF_BAR); xb.x = xb_xcc_id(); xb.st = st;
    if (t0 == 0) (void)xb_add(&xb.bar[XB_XCNT(xb.x)], 1u);
  }
#ifndef REPMASK
#define REPMASK 0u
#endif
#ifndef PMASK
#define PMASK 0xffffffffu
#endif
#define PHASE_BEGIN(k) if (ph >= ph_lo && ph < ph_hi) { if constexpr ((PMASK >> (k)) & 1u) for (int rep_ = 0; rep_ < 1 + (int)((REPMASK >> (k)) & 1u); ++rep_) { \
    CParams* pp_ = pk; asm volatile("" : "+s"(pp_)); PREF p = *pp_; const int tid = ltid(wv); \
    unsigned char* ws = p.ws; float* X = (float*)(ws + OFF_X); bf16_t* H = (bf16_t*)(ws + OFF_H); bf16_t* Wb = (bf16_t*)(ws + OFF_W); \
    float* ROPE = (float*)(ws + OFF_ROPE); unsigned char* R = ws + OFF_R; (void)tid; (void)X; (void)H; (void)Wb; (void)ROPE; (void)R;
#define PHASE_END   } if (ph + 1 < ph_hi) { if (ph == 0) grid.sync(); else xcd_barrier(xb, ltid(wv), (unsigned)nblk); } } ++ph;

  PHASE_BEGIN(0)
    {
      const int hf = tid >> 8, tl = tid & 255;
      float* smh = (float*)smem + hf * 4224;
      for (int t0 = bid * 2; t0 < p.total_tiles; t0 += nblk * 2) {
        const int t = t0 + hf;
        const bool active = t < p.total_tiles;
        const int tt = active ? t : 0;
        int ji = 0;
#pragma unroll 1
        for (int q = 1; q < NJOBS; ++q) if (tt >= p.jobs[q].tile0) ji = q;
        const CAS Job& jb = p.jobs[ji];
        int lt = tt - jb.tile0; int nkt = jb.k >> 6; int nt_ = lt / nkt, kt_ = lt - nt_ * nkt;
        transpose_tile(jb.src, jb.nsrc, jb.nsrc, jb.dst, jb.k, nt_ * 64, kt_ * 64, jb.mode, smh, tl, active);
      }
    }
    {
      const size_t n4p = (size_t)TP * 256, n4 = (size_t)T * 256;
      const float4* xp = (const float4*)p.in[0]; const float4* xs = (const float4*)p.in[1];
      for (size_t e = (size_t)bid * NT + tid; e < n4; e += (size_t)nblk * NT) ((float4*)X)[e] = (e < n4p) ? xp[e] : xs[e - n4p];
      for (int e = bid * NT + tid; e < 8192 * 16; e += nblk * NT) {
        int pos = e >> 4, i = e & 15;
        double rev = (double)pos * p.inv_freq[i] * 0.15915494309189535;
        rev -= floor(rev);
        float fr = (float)rev;
        ROPE[2 * e] = __builtin_amdgcn_cosf(fr); ROPE[2 * e + 1] = __builtin_amdgcn_sinf(fr);
      }
      const float* wsrc = p.in[20];
      for (int e = bid * NT + tid; e < 8 * 128 * 128; e += nblk * NT) {
        int s = e & 127, t = (e >> 7) & 127;
        Wb[W_TRIL + e] = tobf(s <= t ? wsrc[e] : 0.f);
      }
    }
  PHASE_END

#pragma unroll 1
  for (int L = 0; L < 4; ++L) {
    const int kind = L % 3, j = L / 3;
    if (kind == 0) {
      PHASE_BEGIN(1)
        rmsnorm_rows(X, p.in[7] + L * 1024, H, nullptr, nullptr, bid, nblk, wv);
        cache_rows(p.in[2] + (size_t)j * 32 * 1024 * 256, (bf16_t*)(R + R_CKV), 256, bid, nblk, wv);
        cache_rows(p.in[3] + (size_t)j * 32 * 1024 * 32, (bf16_t*)(R + R_KR), 32, bid, nblk, wv);
      PHASE_END
      PHASE_BEGIN(2)
        EArgs ea{}; ea.f0 = (float*)(R + R_RAW);
        gemm_phase<E_F32>(H, Wb + W_MLA + (size_t)j * WM_SZ + WM_D, T, 1024, 1024, ea, smem, 0, bid, nblk, wv);
      PHASE_END
      PHASE_BEGIN(3)
        mla_rowops(p, j, bid, nblk, wv);
      PHASE_END
      PHASE_BEGIN(4)
        EArgs ea{}; ea.b0 = (bf16_t*)(R + R_Q); ea.rope = ROPE;
        gemm_phase<E_MLAQ>((const bf16_t*)(R + R_CQ), Wb + W_MLA + (size_t)j * WM_SZ + WM_UQ, T, 1536, 512, ea, smem, 0, bid, nblk, wv);
        EArgs eb{}; eb.b0 = (bf16_t*)(R + R_KN); eb.b1 = (bf16_t*)(R + R_VT);
        gemm_phase<E_MLAKV>((const bf16_t*)(R + R_CKV), Wb + W_MLA + (size_t)j * WM_SZ + WM_UKV, KROWS, 2048, 256, eb, smem, (T / 256) * 6, bid, nblk, wv);
      PHASE_END
      PHASE_BEGIN(5)
        attn_phase<true>(p, smem, bid, nblk, wv);
      PHASE_END
      PHASE_BEGIN(6)
        EArgs ea{}; ea.f0 = X;
        gemm_phase<E_RESID>((const bf16_t*)(R + R_RAW), Wb + W_MLA + (size_t)j * WM_SZ + WM_O, T, 1024, 1024, ea, smem, 0, bid, nblk, wv);
      PHASE_END
    } else if (kind == 1) {
      PHASE_BEGIN(1)
        rmsnorm_rows(X, p.in[7] + L * 1024, H, nullptr, nullptr, bid, nblk, wv);
      PHASE_END
      PHASE_BEGIN(7)
        EArgs ea{}; ea.b0 = (bf16_t*)(R + C_U); ea.b1 = (bf16_t*)(R + C_VR);
        gemm_phase<E_GELU>(H, Wb + W_CM + WC_IN, T, 4096, 1024, ea, smem, 0, bid, nblk, wv);
      PHASE_END
      PHASE_BEGIN(8)
        cmlp_ln_rows(p, bid, nblk, wv);
      PHASE_END
      PHASE_BEGIN(9)
        cmlp_mix_phase(p, smem, bid, nblk, wv);
      PHASE_END
      PHASE_BEGIN(6)
        EArgs ea{}; ea.f0 = X;
        gemm_phase<E_RESID>((const bf16_t*)(R + C_G), Wb + W_CM + WC_OUT, T, 1024, 2048, ea, smem, 0, bid, nblk, wv);
      PHASE_END
    } else {
      PHASE_BEGIN(10)
        rmsnorm_rows(X, p.in[7] + L * 1024, H, nullptr, nullptr, bid, nblk, wv);
        cache_rows(p.in[4], (bf16_t*)(R + D_K), 1024, bid, nblk, wv);
        cache_rows(p.in[6], (bf16_t*)(R + D_KI), 64, bid, nblk, wv);
        {
          bf16_t* VTs = (bf16_t*)(R + D_VT) + (size_t)TP * 1024;
          {
            const int hf = tid >> 8, tl = tid & 255;
            float* smh = (float*)smem + hf * 4224;
            for (int u0 = bid * 2; u0 < 512 * 16; u0 += nblk * 2) {
              const int u = u0 + hf;
              int st = u & 15, bh = u >> 4, b = bh >> 4, h = bh & 15;
              transpose_tile(p.in[5] + (size_t)b * 1024 * 1024 + h * 64, 1024, 64, VTs + (size_t)(bh * 64) * SPAD, SPAD, 0, st * 64, 0, smh, tl, true);
            }
          }
          for (int e = bid * NT + tid; e < 512 * 64 * 12; e += nblk * NT) {
            int c = e % 12, rw = e / 12;
            { unsigned z = 0; asm volatile("" : "+v"(z)); *(uint2*)(VTs + (size_t)rw * SPAD + NKS + c * 4) = make_uint2(z, z); }
          }
        }
      PHASE_END
      PHASE_BEGIN(11)
        EArgs ea{};
        ea.f0 = p.out + O_DKP; ea.f1 = p.out + O_DKS; ea.f2 = p.out + O_DVP; ea.f3 = p.out + O_DVS;
        ea.f4 = (float*)(R + D_KIR); ea.f5 = (float*)(R + D_WI);
        ea.b0 = (bf16_t*)(R + D_Q); ea.b1 = (bf16_t*)(R + D_K); ea.b2 = (bf16_t*)(R + D_VT); ea.b3 = (bf16_t*)(R + D_QI);
        gemm_phase<E_DSA>(H, Wb + W_DS + WD_P, T, 3840, 1024, ea, smem, 0, bid, nblk, wv);
      PHASE_END
      PHASE_BEGIN(12)
        dsa_rowops(p, bid, nblk, wv);
      PHASE_END
      PHASE_BEGIN(13)
        idx_phase(p, smem, bid, nblk, wv);
      PHASE_END
      PHASE_BEGIN(14)
        attn_phase<false>(p, smem, bid, nblk, wv);
      PHASE_END
      PHASE_BEGIN(6)
        EArgs ea{}; ea.f0 = X;
        gemm_phase<E_RESID>((const bf16_t*)(R + D_AO), Wb + W_DS + WD_O, T, 1024, 1024, ea, smem, 0, bid, nblk, wv);
      PHASE_END
    }
    PHASE_BEGIN(1)
      rmsnorm_rows(X, p.in[8] + L * 1024, H, nullptr, nullptr, bid, nblk, wv);
    PHASE_END
    PHASE_BEGIN(15)
      EArgs ea{}; ea.b0 = (bf16_t*)(R + 0);
      gemm_phase<E_SWIGLU>(H, Wb + W_FF + (size_t)L * WF_SZ + WF_IN, T, 2 * DFF, 1024, ea, smem, 0, bid, nblk, wv);
    PHASE_END
    PHASE_BEGIN(6)
      EArgs ea{}; ea.f0 = X;
      gemm_phase<E_RESID>((const bf16_t*)(R + 0), Wb + W_FF + (size_t)L * WF_SZ + WF_OUT, T, 1024, DFF, ea, smem, 0, bid, nblk, wv);
    PHASE_END
  }
  PHASE_BEGIN(1)
    rmsnorm_rows(X, p.in[9], nullptr, p.out + O_YP, p.out + O_YS, bid, nblk, wv);
  PHASE_END
}

extern "C" void kernel_launch(void* const* d_in, const int* in_sizes, int n_in,
                              void* d_out, int out_size, void* d_ws, size_t ws_size,
                              hipStream_t stream) {
  constexpr int kLds = 128 * 1024 + 64;
  static int grid_blocks = 0;
  if (!grid_blocks) {
    int dev = 0, cus = 0, per_cu = 0;
    (void)hipGetDevice(&dev);
    (void)hipDeviceGetAttribute(&cus, hipDeviceAttributeMultiprocessorCount, dev);
    (void)hipFuncSetAttribute((const void*)mega, hipFuncAttributeMaxDynamicSharedMemorySize, kLds);
    (void)hipOccupancyMaxActiveBlocksPerMultiprocessor(&per_cu, (const void*)mega, NT, kLds);
    if (per_cu < 1) per_cu = 1;
    if (per_cu > 1) per_cu = 1;
    grid_blocks = cus * per_cu;
    fprintf(stderr, "grid %d (cus %d per_cu %d) ws %zu need %zu out %d need %zu\n", grid_blocks, cus, per_cu, ws_size, (size_t)WS_NEED, out_size, (size_t)O_END);
  }
  if (ws_size < WS_NEED || n_in != 31 || (size_t)out_size != O_END) { fprintf(stderr, "kernel_launch: bad sizes\n"); return; }
  Params p;
  memset(&p, 0, sizeof(p));
  for (int i = 0; i < 31; ++i) p.in[i] = (const float*)d_in[i];
  p.out = (float*)d_out; p.ws = (unsigned char*)d_ws;
  bf16_t* Wb = (bf16_t*)((unsigned char*)d_ws + OFF_W);
  int nj = 0, tiles = 0;
  auto add = [&](const float* src, int nsrc, int k, bf16_t* dst, int ndst, int mode) {
    Job& jb = p.jobs[nj++]; jb.src = src; jb.dst = dst; jb.nsrc = nsrc; jb.k = k; jb.ndst = ndst; jb.mode = mode; jb.tile0 = tiles; jb.pad = 0;
    tiles += (ndst / 64) * (k / 64);
  };
  for (int j = 0; j < 2; ++j) {
    bf16_t* Wm = Wb + W_MLA + (size_t)j * WM_SZ;
    add(p.in[10] + (size_t)j * 1024 * 512, 512, 1024, Wm + WM_D, 512, 0);
    add(p.in[13] + (size_t)j * 1024 * 288, 288, 1024, Wb + W_MLA + (size_t)j * WM_SZ + WM_D + (size_t)512 * 1024, 512, 0);
    add(p.in[12] + (size_t)j * 512 * 1536, 1536, 512, Wb + W_MLA + (size_t)j * WM_SZ + WM_UQ, 1536, 0);
    add(p.in[15] + (size_t)j * 256 * 2048, 2048, 256, Wb + W_MLA + (size_t)j * WM_SZ + WM_UKV, 2048, 0);
    add(p.in[16] + (size_t)j * 1024 * 1024, 1024, 1024, Wb + W_MLA + (size_t)j * WM_SZ + WM_O, 1024, 0);
  }
  add(p.in[17], 4096, 1024, Wb + W_CM + WC_IN, 4096, 0);
  add(p.in[22], 1024, 2048, Wb + W_CM + WC_OUT, 1024, 0);
  add(p.in[23], 3072, 1024, Wb + W_DS + WD_P, 3072, 0);
  add(p.in[25], 512, 1024, Wb + W_DS + WD_P + (size_t)3072 * 1024, 512, 0);
  add(p.in[26], 64, 1024, Wb + W_DS + WD_P + (size_t)3584 * 1024, 64, 0);
  add(p.in[28], 8, 1024, Wb + W_DS + WD_P + (size_t)3648 * 1024, 192, 0);
  add(p.in[24], 1024, 1024, Wb + W_DS + WD_O, 1024, 0);
  for (int i = 0; i < 4; ++i) {
    add(p.in[29] + (size_t)i * 1024 * 5632, 5632, 1024, Wb + W_FF + (size_t)i * WF_SZ + WF_IN, 5632, 1);
    add(p.in[30] + (size_t)i * 2816 * 1024, 1024, 2816, Wb + W_FF + (size_t)i * WF_SZ + WF_OUT, 1024, 0);
  }
  p.total_tiles = tiles;
  for (int i = 0; i < 16; ++i) p.inv_freq[i] = pow(10000.0, -(double)i / 16.0);
  p.ph_lo = 0; p.ph_hi = 1000;
  (void)hipMemsetAsync((unsigned char*)d_ws + OFF_BAR, 0, 16384, stream);
  void* args[] = {&p};
  hipError_t e = hipLaunchCooperativeKernel((const void*)mega, dim3(grid_blocks), dim3(NT), args, kLds, stream);
  if (e != hipSuccess) fprintf(stderr, "coop launch failed: %s\n", hipGetErrorString(e));
}
```

```cpp
#include <hip/hip_runtime.h>
#include <hip/hip_cooperative_groups.h>
#include <cstdio>
#include <cstring>
#include <cmath>
namespace cg = cooperative_groups;

typedef unsigned short bf16_t;
using bf16x8 = __attribute__((ext_vector_type(8))) short;
using f32x16 = __attribute__((ext_vector_type(16))) float;
using f32x2v = __attribute__((ext_vector_type(2))) float;
using bf2v = __attribute__((ext_vector_type(2))) __bf16;
#define DI __device__ __forceinline__
#define MFMA32(a, b, c) __builtin_amdgcn_mfma_f32_32x32x16_bf16((a), (b), (c), 0, 0, 0)

constexpr int TP = 16384, TS = 512, T = TP + TS;
constexpr int NT = 512;
constexpr int SPAD = 1088, NKS = 1040;
constexpr int KROWS = TP + 32 * SPAD;
constexpr int DFF = 2816;
constexpr float LOG2E = 1.4426950408889634f;
constexpr float EPS = 1e-6f;

constexpr size_t OFF_X = 0;
constexpr size_t OFF_H = OFF_X + (size_t)T * 1024 * 4;
constexpr size_t OFF_W = OFF_H + (size_t)T * 1024 * 2;
constexpr size_t W_ELEMS = 52822016;
constexpr size_t OFF_ROPE = OFF_W + W_ELEMS * 2;
constexpr size_t OFF_R = OFF_ROPE + (size_t)8192 * 16 * 2 * 4;
constexpr size_t R_RAW = 0;
constexpr size_t R_CQ = R_RAW + (size_t)T * 1024 * 4;
constexpr size_t R_CKV = R_CQ + (size_t)T * 512 * 2;
constexpr size_t R_KR = R_CKV + (size_t)KROWS * 256 * 2;
constexpr size_t R_Q = R_KR + (size_t)KROWS * 32 * 2;
constexpr size_t R_KN = R_Q + (size_t)T * 1536 * 2;
constexpr size_t R_VT = R_KN + (size_t)KROWS * 1024 * 2;
constexpr size_t R_END = R_VT + (size_t)KROWS * 1024 * 2;
constexpr size_t D_Q = 0;
constexpr size_t D_K = D_Q + (size_t)T * 1024 * 2;
constexpr size_t D_VT = D_K + (size_t)KROWS * 1024 * 2;
constexpr size_t D_QI = D_VT + (size_t)KROWS * 1024 * 2;
constexpr size_t D_KIR = D_QI + (size_t)T * 512 * 2;
constexpr size_t D_KI = D_KIR + (size_t)T * 64 * 4;
constexpr size_t D_WI = D_KI + (size_t)KROWS * 64 * 2;
constexpr size_t D_BM = D_WI + (size_t)T * 8 * 4;
constexpr size_t D_AO = D_BM + (size_t)T * 256 * 4;
constexpr size_t D_END = D_AO + (size_t)T * 1024 * 2;
constexpr size_t C_U = 0;
constexpr size_t C_VR = C_U + (size_t)T * 2048 * 2;
constexpr size_t C_VLN = C_VR + (size_t)T * 2048 * 2;
constexpr size_t C_G = C_VLN + (size_t)T * 2048 * 2;
constexpr size_t C_END = C_G + (size_t)T * 2048 * 2;
constexpr size_t OFF_BAR = OFF_R + R_END;
constexpr size_t WS_NEED = OFF_BAR + 16384;
static_assert(D_END <= R_END && C_END <= R_END && (size_t)T * DFF * 2 <= R_END, "region");

constexpr size_t W_MLA = 0;
constexpr size_t WM_D = 0, WM_UQ = 1048576, WM_UKV = WM_UQ + 786432, WM_O = WM_UKV + 524288, WM_SZ = 3407872;
constexpr size_t W_CM = 2 * WM_SZ;
constexpr size_t WC_IN = 0, WC_OUT = 4194304, WC_SZ = 6291456;
constexpr size_t W_DS = W_CM + WC_SZ;
constexpr size_t WD_P = 0, WD_O = 3932160, WD_SZ = 4980736;
constexpr size_t W_FF = W_DS + WD_SZ;
constexpr size_t WF_IN = 0, WF_OUT = 5767168, WF_SZ = 8650752;
constexpr size_t W_TRIL = W_FF + 4 * WF_SZ;
static_assert(W_TRIL + 131072 == W_ELEMS, "w");

constexpr size_t O_YP = 0;
constexpr size_t O_YS = O_YP + (size_t)TP * 1024;
constexpr size_t O_CKVP = O_YS + (size_t)TS * 1024;
constexpr size_t O_KRP = O_CKVP + (size_t)2 * TP * 256;
constexpr size_t O_CKVS = O_KRP + (size_t)2 * TP * 32;
constexpr size_t O_KRS = O_CKVS + (size_t)2 * TS * 256;
constexpr size_t O_CVS = O_KRS + (size_t)2 * TS * 32;
constexpr size_t O_DKP = O_CVS + (size_t)TS * 2048;
constexpr size_t O_DVP = O_DKP + (size_t)TP * 1024;
constexpr size_t O_DIP = O_DVP + (size_t)TP * 1024;
constexpr size_t O_DKS = O_DIP + (size_t)TP * 64;
constexpr size_t O_DVS = O_DKS + (size_t)TS * 1024;
constexpr size_t O_DIS = O_DVS + (size_t)TS * 1024;
constexpr size_t O_END = O_DIS + (size_t)TS * 64;

constexpr int NJOBS = 25;
struct Job { const float* src; bf16_t* dst; int nsrc, k, ndst, mode, tile0, pad; };
struct Params {
  const float* in[31];
  float* out;
  unsigned char* ws;
  Job jobs[NJOBS];
  int total_tiles, ph_lo, ph_hi, pad;
  double inv_freq[16];
};

#define CAS __attribute__((address_space(4)))
typedef const CAS Params CParams;
#define PREF const CAS Params&
DI unsigned pack2(float a, float b) { f32x2v v = {a, b}; bf2v r = __builtin_convertvector(v, bf2v); return __builtin_bit_cast(unsigned, r); }
DI bf16_t tobf(float a) { return (bf16_t)(pack2(a, 0.f) & 0xffffu); }
DI float frombf(bf16_t v) { return __uint_as_float(((unsigned)v) << 16); }
DI float bflo(unsigned u) { return __uint_as_float(u << 16); }
DI float bfhi(unsigned u) { return __uint_as_float(u & 0xffff0000u); }
DI float shflx(float v, int m, int lane) { return __int_as_float(__builtin_amdgcn_ds_bpermute((lane ^ m) << 2, __float_as_int(v))); }
DI float wave_sum(float v, int lane) {
#pragma unroll
  for (int o = 32; o >= 1; o >>= 1) v += shflx(v, o, lane);
  return v;
}
DI int ltid(int wv) { unsigned m1 = ~0u; asm volatile("" : "+s"(m1)); int t = (wv << 6) | (int)__builtin_amdgcn_mbcnt_hi(m1, __builtin_amdgcn_mbcnt_lo(m1, 0u)); asm volatile("" : "+v"(t)); return t; }
DI int crow(int i, int h) { return (i & 3) + 8 * (i >> 2) + 4 * h; }
DI int rowmap(int t) { if (t < TP) return t; int u = t - TP; return TP + (u >> 4) * SPAD + 1024 + (u & 15); }
DI int tokpos(int t) { return t < TP ? (t & 8191) : 1024 + ((t - TP) & 15); }

DI void transpose_tile(const float* __restrict__ src, int src_ld, int ncols, bf16_t* __restrict__ dst, int dst_ld,
                       int n0, int k0, int mode, float* sm, int tid, bool active) {
  const int nl = (tid & 15) * 4, kq = tid >> 4;
  const int n = n0 + nl;
  int c;
  if (mode != 1) c = n < ncols ? n : -1;
  else { int tt = n >> 5, r = n & 31; int f = tt * 16 + (r & 15); c = (r < 16) ? f : DFF + f; }
  int dr[4];
#pragma unroll
  for (int e = 0; e < 4; ++e) { int col = nl + e; dr[e] = (mode == 2) ? ((col & 32) + (col & 1) * 16 + ((col & 31) >> 1)) : col; }
  if (active) {
    float4 v[4];
#pragma unroll
    for (int i = 0; i < 4; ++i) {
      int kk = kq + 16 * i;
      v[i] = (c >= 0) ? *(const float4*)(src + (size_t)(k0 + kk) * src_ld + c) : make_float4(0.f, 0.f, 0.f, 0.f);
    }
#pragma unroll
    for (int i = 0; i < 4; ++i) {
      int kk = kq + 16 * i;
      float* d = sm + kk * 65;
      d[dr[0]] = v[i].x; d[dr[1]] = v[i].y; d[dr[2]] = v[i].z; d[dr[3]] = v[i].w;
    }
  }
  __syncthreads();
  if (active) {
    const int kp = (tid & 31) * 2, nr = tid >> 5;
#pragma unroll 4
    for (int i = 0; i < 8; ++i) {
      int nn = nr + 8 * i;
      float a = sm[kp * 65 + nn], b = sm[(kp + 1) * 65 + nn];
      *(unsigned*)(dst + (size_t)(n0 + nn) * dst_ld + k0 + kp) = pack2(a, b);
    }
  }
  __syncthreads();
}

enum { E_F32 = 0, E_RESID, E_SWIGLU, E_GELU, E_MLAQ, E_MLAKV, E_DSA };
struct EArgs {
  float* f0; float* f1; float* f2; float* f3; float* f4; float* f5; float* f6;
  bf16_t* b0; bf16_t* b1; bf16_t* b2; bf16_t* b3;
  const float* rope;
};
using f32x4v = __attribute__((ext_vector_type(4))) float;
#define LAS __attribute__((address_space(3)))
constexpr int G_HT = 128 * 64;
DI int lds_byte(int r, int c) {
  int st = (r >> 4) * 2 + (c >> 5), rr = r & 15, cc = c & 31, ob = rr * 64 + cc * 2;
  return st * 1024 + (ob ^ (((ob >> 9) & 1) << 5));
}
DI void stage_rc(int b, int& R, int& C) {
  int st = b >> 10, sb = b & 1023, swz = sb ^ (((sb >> 9) & 1) << 5);
  R = (st >> 1) * 16 + (swz >> 6); C = (st & 1) * 32 + ((swz & 63) >> 1);
}

template <int EPI, bool ATOM>
DI void epi16(const EArgs& ea, int row0, int gb, int fr, const f32x4v& v0, const f32x4v& v1) {
  if constexpr (EPI == E_F32) {
#pragma unroll
    for (int j = 0; j < 4; ++j) *(float2*)(ea.f0 + (size_t)(row0 + j) * 1024 + gb + 2 * fr) = make_float2(v0[j], v1[j]);
  } else if constexpr (EPI == E_RESID) {
#pragma unroll
    for (int j = 0; j < 4; ++j) { float* o = ea.f0 + (size_t)(row0 + j) * 1024 + gb + 2 * fr;
      if constexpr (ATOM) { unsafeAtomicAdd(o, v0[j]); unsafeAtomicAdd(o + 1, v1[j]); }
      else { float2 x = *(float2*)o; x.x += v0[j]; x.y += v1[j]; *(float2*)o = x; } }
  } else if constexpr (EPI == E_SWIGLU) {
    const int f = (gb >> 1) + fr;
#pragma unroll
    for (int j = 0; j < 4; ++j) { float g = v0[j], u = v1[j]; ea.b0[(size_t)(row0 + j) * DFF + f] = tobf(g / (1.f + __expf(-g)) * u); }
  } else if constexpr (EPI == E_GELU) {
    bf16_t* dstp = (gb < 2048) ? (ea.b0 + gb + 2 * fr) : (ea.b1 + (gb - 2048) + 2 * fr);
#pragma unroll
    for (int j = 0; j < 4; ++j) {
      float x = v0[j], y = v1[j];
      *(unsigned*)(dstp + (size_t)(row0 + j) * 2048) = pack2(0.5f * x * (1.f + erff(x * 0.70710678118654752f)), 0.5f * y * (1.f + erff(y * 0.70710678118654752f)));
    }
  } else if constexpr (EPI == E_MLAQ) {
    const float qs = 0.10206207261596577f * LOG2E;
    const bool is_rope = (gb % 96) == 64;
#pragma unroll
    for (int j = 0; j < 4; ++j) {
      const int row = row0 + j;
      float o0 = v0[j], o1 = v1[j];
      if (is_rope) {
        float2 cs = *(const float2*)(ea.rope + ((size_t)tokpos(row) * 16 + fr) * 2);
        o0 = v0[j] * cs.x - v1[j] * cs.y; o1 = v0[j] * cs.y + v1[j] * cs.x;
      }
      bf16_t* o = ea.b0 + (size_t)row * 1536 + gb + fr;
      o[0] = tobf(o0 * qs); o[16] = tobf(o1 * qs);
    }
  } else if constexpr (EPI == E_MLAKV) {
    const int head = gb >> 7, c0 = gb & 127;
    if (c0 < 64) {
#pragma unroll
      for (int j = 0; j < 4; ++j) *(unsigned*)(ea.b0 + (size_t)(row0 + j) * 1024 + head * 64 + c0 + 2 * fr) = pack2(v0[j], v1[j]);
    } else {
      const int d = c0 - 64 + 2 * fr;
      size_t off, dstr;
      if (row0 < TP) { int b = row0 >> 13, s = row0 & 8191; off = ((size_t)((b * 16 + head) * 64 + d)) * 8192 + s; dstr = 8192; }
      else { int u = row0 - TP; int b = u / SPAD, s = u - b * SPAD; off = (size_t)TP * 1024 + ((size_t)((b * 16 + head) * 64 + d)) * SPAD + s; dstr = SPAD; }
      uint2 pk; pk.x = pack2(v0[0], v0[1]); pk.y = pack2(v0[2], v0[3]); *(uint2*)(ea.b1 + off) = pk;
      pk.x = pack2(v1[0], v1[1]); pk.y = pack2(v1[2], v1[3]); *(uint2*)(ea.b1 + off + dstr) = pk;
    }
  } else if constexpr (EPI == E_DSA) {
    if (gb < 1024) {
      const float qs = 0.125f * LOG2E;
#pragma unroll
      for (int j = 0; j < 4; ++j) *(unsigned*)(ea.b0 + (size_t)(row0 + j) * 1024 + gb + 2 * fr) = pack2(v0[j] * qs, v1[j] * qs);
    } else if (gb < 2048) {
      const int c = gb - 1024 + 2 * fr;
#pragma unroll
      for (int j = 0; j < 4; ++j) {
        const int row = row0 + j;
        float* o = (row < TP) ? ea.f0 + (size_t)row * 1024 + c : ea.f1 + (size_t)(row - TP) * 1024 + c;
        *(float2*)o = make_float2(v0[j], v1[j]);
        *(unsigned*)(ea.b1 + (size_t)rowmap(row) * 1024 + c) = pack2(v0[j], v1[j]);
      }
    } else if (gb < 3072) {
      const int c = gb - 2048 + 2 * fr, head = c >> 6, d = c & 63;
#pragma unroll
      for (int j = 0; j < 4; ++j) {
        const int row = row0 + j;
        float* o = (row < TP) ? ea.f2 + (size_t)row * 1024 + c : ea.f3 + (size_t)(row - TP) * 1024 + c;
        *(float2*)o = make_float2(v0[j], v1[j]);
      }
      size_t off, dstr;
      if (row0 < TP) { int b = row0 >> 13, s = row0 & 8191; off = ((size_t)((b * 16 + head) * 64 + d)) * 8192 + s; dstr = 8192; }
      else { int u = row0 - TP; int b = u >> 4, s = 1024 + (u & 15); off = (size_t)TP * 1024 + ((size_t)((b * 16 + head) * 64 + d)) * SPAD + s; dstr = SPAD; }
      uint2 pk; pk.x = pack2(v0[0], v0[1]); pk.y = pack2(v0[2], v0[3]); *(uint2*)(ea.b2 + off) = pk;
      pk.x = pack2(v1[0], v1[1]); pk.y = pack2(v1[2], v1[3]); *(uint2*)(ea.b2 + off + dstr) = pk;
    } else if (gb < 3584) {
      const int c = gb - 3072 + 2 * fr;
#pragma unroll
      for (int j = 0; j < 4; ++j) *(unsigned*)(ea.b3 + (size_t)(row0 + j) * 512 + c) = pack2(v0[j] * 0.125f, v1[j] * 0.125f);
    } else if (gb < 3648) {
      const int c = gb - 3584 + 2 * fr;
#pragma unroll
      for (int j = 0; j < 4; ++j) *(float2*)(ea.f4 + (size_t)(row0 + j) * 64 + c) = make_float2(v0[j], v1[j]);
    } else if (gb == 3648) {
      if (fr < 4) {
#pragma unroll
        for (int j = 0; j < 4; ++j) *(float2*)(ea.f5 + (size_t)(row0 + j) * 8 + 2 * fr) = make_float2(v0[j] * 0.35355339059327379f, v1[j] * 0.35355339059327379f);
      }
    }
  }
}

template <int EPI, bool ATOM>
DI void gemm256_tile(const bf16_t* __restrict__ A, const bf16_t* __restrict__ Bt, const int K, const int kt0, const int nt, const int brow, const int bcol,
                     const EArgs& ea, unsigned char* smem, int wv) {
  bf16_t* shm = (bf16_t*)smem;
  const int tid = ltid(wv);
#define SA(b, h) (shm + ((b) * 2 + (h)) * G_HT)
#define SB(b, h) (shm + (4 + (b) * 2 + (h)) * G_HT)
#define STAGE(P, BASE, br, kt) do { const char* _gb = (const char*)((BASE) + (long)(br) * K + (long)((kt) + kt0) * 64); \
    __builtin_amdgcn_global_load_lds((const unsigned*)(_gb + voff0), (LAS unsigned*)((char*)(P) + tid * 16), 16, 0, 0); \
    __builtin_amdgcn_global_load_lds((const unsigned*)(_gb + voff1), (LAS unsigned*)((char*)(P) + tid * 16 + 8192), 16, 0, 0); } while (0)
#define LDA(dst, b, h) _Pragma("unroll") for (int m = 0; m < 4; ++m) _Pragma("unroll") for (int k = 0; k < 2; ++k) \
    dst[m][k] = *reinterpret_cast<const bf16x8*>((char*)SA(b, h) + lds_byte(wr * 64 + m * 16 + fr, k * 32 + fq * 8))
#define LDB(dst, b, h) _Pragma("unroll") for (int n = 0; n < 2; ++n) _Pragma("unroll") for (int k = 0; k < 2; ++k) \
    dst[n][k] = *reinterpret_cast<const bf16x8*>((char*)SB(b, h) + lds_byte(wc * 32 + n * 16 + fr, k * 32 + fq * 8))
#define MMA(ai, bj, At_, Bt_) do { __builtin_amdgcn_s_setprio(1); \
    _Pragma("unroll") for (int m = 0; m < 4; ++m) _Pragma("unroll") for (int n = 0; n < 2; ++n) _Pragma("unroll") for (int k = 0; k < 2; ++k) \
      acc[ai][bj][m][n] = __builtin_amdgcn_mfma_f32_16x16x32_bf16(At_[m][k], Bt_[n][k], acc[ai][bj][m][n], 0, 0, 0); \
    __builtin_amdgcn_s_setprio(0); } while (0)
#define WAIT_V(n) asm volatile("s_waitcnt vmcnt(" #n ")" ::: "memory")
#define WAIT_L(n) asm volatile("s_waitcnt lgkmcnt(" #n ")" ::: "memory")
#define BAR __builtin_amdgcn_s_barrier()
#define SCHED __builtin_amdgcn_sched_barrier(0)
  const int wid = tid >> 6, lane = tid & 63, wr = wid >> 2, wc = wid & 3, fr = lane & 15, fq = lane >> 4;
  unsigned voff0, voff1;
  { int r_, c_; stage_rc(tid * 16, r_, c_); voff0 = (unsigned)(r_ * K + c_) * 2u; stage_rc(tid * 16 + 8192, r_, c_); voff1 = (unsigned)(r_ * K + c_) * 2u; }
  f32x4v acc[2][2][4][2];
#pragma unroll
  for (int a = 0; a < 2; ++a)
#pragma unroll
    for (int b = 0; b < 2; ++b)
#pragma unroll
      for (int m = 0; m < 4; ++m)
#pragma unroll
        for (int n = 0; n < 2; ++n) acc[a][b][m][n] = (f32x4v){0.f, 0.f, 0.f, 0.f};
  bf16x8 At[4][2], B0[2][2], B1[2][2];
  const int HALF = 128;
  WAIT_V(0); WAIT_L(0); BAR;
  STAGE(SB(0, 0), Bt, bcol, 0); STAGE(SA(0, 0), A, brow, 0);
  STAGE(SB(0, 1), Bt, bcol + HALF, 0); STAGE(SA(0, 1), A, brow + HALF, 0);
  if (wr == 1) BAR;
  WAIT_V(4); BAR;
  STAGE(SB(1, 0), Bt, bcol, 1); STAGE(SA(1, 0), A, brow, 1); STAGE(SB(1, 1), Bt, bcol + HALF, 1);
  WAIT_V(6); BAR;
  for (int t = 0; t < nt - 2; t += 2) {
    LDB(B0, 0, 0); SCHED; LDA(At, 0, 0); STAGE(SA(1, 1), A, brow + HALF, t + 1);
    WAIT_L(8); BAR; WAIT_L(0); MMA(0, 0, At, B0); BAR; SCHED;
    LDB(B1, 0, 1); STAGE(SB(0, 0), Bt, bcol, t + 2);
    BAR; WAIT_L(0); MMA(0, 1, At, B1); BAR;
    LDA(At, 0, 1); STAGE(SA(0, 0), A, brow, t + 2);
    BAR; WAIT_L(0); MMA(1, 0, At, B0); BAR; SCHED;
    STAGE(SB(0, 1), Bt, bcol + HALF, t + 2);
    WAIT_V(6); BAR; MMA(1, 1, At, B1); BAR;
    LDB(B0, 1, 0); SCHED; LDA(At, 1, 0); STAGE(SA(0, 1), A, brow + HALF, t + 2);
    WAIT_L(8); BAR; WAIT_L(0); MMA(0, 0, At, B0); BAR; SCHED;
    LDB(B1, 1, 1); STAGE(SB(1, 0), Bt, bcol, t + 3);
    BAR; WAIT_L(0); MMA(0, 1, At, B1); BAR;
    LDA(At, 1, 1); STAGE(SA(1, 0), A, brow, t + 3);
    BAR; WAIT_L(0); MMA(1, 0, At, B0); BAR; SCHED;
    STAGE(SB(1, 1), Bt, bcol + HALF, t + 3);
    WAIT_V(6); BAR; MMA(1, 1, At, B1); BAR;
  }
  { LDB(B0, 0, 0); LDA(At, 0, 0); STAGE(SA(1, 1), A, brow + HALF, nt - 1);
    BAR; WAIT_L(0); MMA(0, 0, At, B0); BAR;
    LDB(B1, 0, 1); BAR; WAIT_L(0); MMA(0, 1, At, B1); BAR;
    LDA(At, 0, 1); WAIT_V(4); BAR; WAIT_L(0); MMA(1, 0, At, B0); MMA(1, 1, At, B1); BAR; }
  { LDB(B0, 1, 0); LDA(At, 1, 0); WAIT_V(2); BAR; WAIT_L(0); MMA(0, 0, At, B0); BAR;
    LDB(B1, 1, 1); WAIT_V(0); BAR; WAIT_L(0); MMA(0, 1, At, B1); BAR;
    LDA(At, 1, 1); BAR; WAIT_L(0); MMA(1, 0, At, B0); MMA(1, 1, At, B1); BAR; }
  if (wr == 0) BAR;
#pragma unroll
  for (int ai = 0; ai < 2; ++ai)
#pragma unroll
    for (int bj = 0; bj < 2; ++bj)
#pragma unroll
      for (int m = 0; m < 4; ++m)
      { epi16<EPI, ATOM>(ea, brow + ai * 128 + wr * 64 + m * 16 + fq * 4, bcol + bj * 128 + wc * 32, fr, acc[ai][bj][m][0], acc[ai][bj][m][1]); __builtin_amdgcn_sched_barrier(0); }
#undef SA
#undef SB
#undef STAGE
#undef LDA
#undef LDB
#undef MMA
#undef WAIT_V
#undef WAIT_L
#undef BAR
#undef SCHED
}

DI void tile_map(int t, int nM, int nN, int nwg, int& pm, int& pn) {
  int wgid = t;
  { int q = nwg >> 3, r = nwg & 7, xcd = wgid & 7, off = wgid >> 3; wgid = (xcd < r ? xcd * (q + 1) : r * (q + 1) + (xcd - r) * q) + off; }
  const int nig = 8 * nN, gid = wgid / nig, fm = gid * 8, gsz = min(nM - fm, 8);
  pm = fm + ((wgid % nig) % gsz); pn = (wgid % nig) / gsz;
}
template <int EPI>
DI void gemm_phase(const bf16_t* A, const bf16_t* Bt, int M, int N, int K, const EArgs& ea,
                   unsigned char* smem, int tstart, int bid, int nblk, int wv) {
  const int nM = M >> 8, nN = N >> 8, nwg = nM * nN, nt = K >> 6;
  if constexpr (EPI == E_RESID) {
    const int nfull = (nwg / nblk) * nblk, rem = nwg - nfull;
    for (int t = bid; t < nfull; t += nblk) {
      int pm, pn; tile_map(t, nM, nN, nwg, pm, pn);
      gemm256_tile<EPI, false>(A, Bt, K, 0, nt, pm * 256, pn * 256, ea, smem, wv);
    }
    if (rem > 0) {
      int ns = nblk / rem; if (ns > (nt >> 2)) ns = nt >> 2; if (ns < 1) ns = 1;
      const int per = ((nt / ns) >> 1) << 1;
      for (int u = bid; u < rem * ns; u += nblk) {
        const int t = nfull + u / ns, ks = u % ns;
        const int k0 = ks * per, kn = (ks == ns - 1) ? (nt - k0) : per;
        int pm, pn; tile_map(t, nM, nN, nwg, pm, pn);
        gemm256_tile<EPI, true>(A, Bt, K, k0, kn, pm * 256, pn * 256, ea, smem, wv);
      }
    }
  } else {
    int t0 = bid - (tstart % nblk); if (t0 < 0) t0 += nblk;
    for (int t = t0; t < nwg; t += nblk) {
      int pm, pn; tile_map(t, nM, nN, nwg, pm, pn);
      gemm256_tile<EPI, false>(A, Bt, K, 0, nt, pm * 256, pn * 256, ea, smem, wv);
    }
  }
}

DI void rmsnorm_rows(const float* __restrict__ X, const float* __restrict__ g, bf16_t* __restrict__ H, float* outp, float* outs,
                     int bid, int nblk, int wv) {
  const int lane = ltid(wv) & 63, w = ltid(wv) >> 6;
  for (int row = bid * 8 + w; row < T; row += nblk * 8) {
    const float* xr = X + (size_t)row * 1024;
    float4 v[4];
    float ss = 0.f;
#pragma unroll
    for (int c = 0; c < 4; ++c) { v[c] = *(const float4*)(xr + c * 256 + lane * 4); ss += v[c].x * v[c].x + v[c].y * v[c].y + v[c].z * v[c].z + v[c].w * v[c].w; }
    ss = wave_sum(ss, lane);
    float r = rsqrtf(ss * (1.f / 1024.f) + EPS);
#pragma unroll
    for (int c = 0; c < 4; ++c) {
      int col = c * 256 + lane * 4;
      float4 gg = *(const float4*)(g + col);
      float a = v[c].x * r * gg.x, b = v[c].y * r * gg.y, cc = v[c].z * r * gg.z, d = v[c].w * r * gg.w;
      if (H) { uint2 pk; pk.x = pack2(a, b); pk.y = pack2(cc, d); *(uint2*)(H + (size_t)row * 1024 + col) = pk; }
      else {
        float* o = (row < TP) ? outp + (size_t)row * 1024 + col : outs + (size_t)(row - TP) * 1024 + col;
        *(float4*)o = make_float4(a, b, cc, d);
      }
    }
  }
}

DI void mla_rowops(PREF p, int j, int bid, int nblk, int wv) {
  const int lane = ltid(wv) & 63, w = ltid(wv) >> 6;
  unsigned char* R = p.ws + OFF_R;
  const float* RAW = (const float*)(R + R_RAW);
  bf16_t* CQ = (bf16_t*)(R + R_CQ); bf16_t* CKV = (bf16_t*)(R + R_CKV); bf16_t* KR = (bf16_t*)(R + R_KR);
  const float* gq = p.in[11] + j * 512; const float* gkv = p.in[14] + j * 256;
  const float* rope = (const float*)(p.ws + OFF_ROPE);
  for (int row = bid * 8 + w; row < T; row += nblk * 8) {
    const float* rr = RAW + (size_t)row * 1024;
    float4 a0 = *(const float4*)(rr + lane * 4), a1 = *(const float4*)(rr + 256 + lane * 4);
    float4 c0 = *(const float4*)(rr + 512 + lane * 4);
    float ss = a0.x * a0.x + a0.y * a0.y + a0.z * a0.z + a0.w * a0.w + a1.x * a1.x + a1.y * a1.y + a1.z * a1.z + a1.w * a1.w;
    float s2 = c0.x * c0.x + c0.y * c0.y + c0.z * c0.z + c0.w * c0.w;
    ss = wave_sum(ss, lane); s2 = wave_sum(s2, lane);
    float r1 = rsqrtf(ss * (1.f / 512.f) + EPS), r2 = rsqrtf(s2 * (1.f / 256.f) + EPS);
    {
      float4 g0 = *(const float4*)(gq + lane * 4), g1 = *(const float4*)(gq + 256 + lane * 4);
      uint2 pk; pk.x = pack2(a0.x * r1 * g0.x, a0.y * r1 * g0.y); pk.y = pack2(a0.z * r1 * g0.z, a0.w * r1 * g0.w);
      *(uint2*)(CQ + (size_t)row * 512 + lane * 4) = pk;
      pk.x = pack2(a1.x * r1 * g1.x, a1.y * r1 * g1.y); pk.y = pack2(a1.z * r1 * g1.z, a1.w * r1 * g1.w);
      *(uint2*)(CQ + (size_t)row * 512 + 256 + lane * 4) = pk;
    }
    const int rm = rowmap(row);
    {
      float4 g = *(const float4*)(gkv + lane * 4);
      float4 o = make_float4(c0.x * r2 * g.x, c0.y * r2 * g.y, c0.z * r2 * g.z, c0.w * r2 * g.w);
      float* op = (row < TP) ? p.out + O_CKVP + ((size_t)j * TP + row) * 256 : p.out + O_CKVS + ((size_t)j * TS + (row - TP)) * 256;
      *(float4*)(op + lane * 4) = o;
      uint2 pk; pk.x = pack2(o.x, o.y); pk.y = pack2(o.z, o.w);
      *(uint2*)(CKV + (size_t)rm * 256 + lane * 4) = pk;
    }
    if (lane < 16) {
      float x1 = rr[768 + lane], x2 = rr[784 + lane];
      int pos = tokpos(row);
      float2 cs = *(const float2*)(rope + ((size_t)pos * 16 + lane) * 2);
      float o1 = x1 * cs.x - x2 * cs.y, o2 = x1 * cs.y + x2 * cs.x;
      float* op = (row < TP) ? p.out + O_KRP + ((size_t)j * TP + row) * 32 : p.out + O_KRS + ((size_t)j * TS + (row - TP)) * 32;
      op[lane] = o1; op[16 + lane] = o2;
      KR[(size_t)rm * 32 + lane] = tobf(o1); KR[(size_t)rm * 32 + 16 + lane] = tobf(o2);
    }
  }
}

DI void dsa_rowops(PREF p, int bid, int nblk, int wv) {
  const int lane = ltid(wv) & 63, w = ltid(wv) >> 6;
  unsigned char* R = p.ws + OFF_R;
  const float* KIR = (const float*)(R + D_KIR);
  bf16_t* KI = (bf16_t*)(R + D_KI);
  const float* g = p.in[27];
  for (int row = bid * 8 + w; row < T; row += nblk * 8) {
    float v = KIR[(size_t)row * 64 + lane];
    float ss = wave_sum(v * v, lane);
    float r = rsqrtf(ss * (1.f / 64.f) + EPS);
    float o = v * r * g[lane];
    if (row < TP) p.out[O_DIP + (size_t)row * 64 + lane] = o; else p.out[O_DIS + (size_t)(row - TP) * 64 + lane] = o;
    KI[(size_t)rowmap(row) * 64 + lane] = tobf(o);
  }
}

DI void cmlp_ln_rows(PREF p, int bid, int nblk, int wv) {
  const int lane = ltid(wv) & 63, w = ltid(wv) >> 6;
  unsigned char* R = p.ws + OFF_R;
  const bf16_t* VR = (const bf16_t*)(R + C_VR);
  bf16_t* VLN = (bf16_t*)(R + C_VLN);
  const float* g = p.in[18]; const float* bb = p.in[19];
  for (int row = bid * 8 + w; row < T; row += nblk * 8) {
    float x[32];
    float sum = 0.f;
#pragma unroll
    for (int c = 0; c < 4; ++c) {
      uint4 u = *(const uint4*)(VR + (size_t)row * 2048 + c * 512 + lane * 8);
      x[c * 8 + 0] = bflo(u.x); x[c * 8 + 1] = bfhi(u.x); x[c * 8 + 2] = bflo(u.y); x[c * 8 + 3] = bfhi(u.y);
      x[c * 8 + 4] = bflo(u.z); x[c * 8 + 5] = bfhi(u.z); x[c * 8 + 6] = bflo(u.w); x[c * 8 + 7] = bfhi(u.w);
    }
#pragma unroll
    for (int i = 0; i < 32; ++i) sum += x[i];
    sum = wave_sum(sum, lane);
    float mu = sum * (1.f / 2048.f);
    float vs = 0.f;
#pragma unroll
    for (int i = 0; i < 32; ++i) { x[i] -= mu; vs += x[i] * x[i]; }
    vs = wave_sum(vs, lane);
    float r = rsqrtf(vs * (1.f / 2048.f) + EPS);
#pragma unroll
    for (int c = 0; c < 4; ++c) {
      int col = c * 512 + lane * 8;
      float y[8];
#pragma unroll
      for (int q = 0; q < 2; ++q) {
        float4 gg = *(const float4*)(g + col + q * 4), b4 = *(const float4*)(bb + col + q * 4);
        y[q * 4 + 0] = x[c * 8 + q * 4 + 0] * r * gg.x + b4.x; y[q * 4 + 1] = x[c * 8 + q * 4 + 1] * r * gg.y + b4.y;
        y[q * 4 + 2] = x[c * 8 + q * 4 + 2] * r * gg.z + b4.z; y[q * 4 + 3] = x[c * 8 + q * 4 + 3] * r * gg.w + b4.w;
      }
      uint4 pk; pk.x = pack2(y[0], y[1]); pk.y = pack2(y[2], y[3]); pk.z = pack2(y[4], y[5]); pk.w = pack2(y[6], y[7]);
      *(uint4*)(VLN + (size_t)row * 2048 + col) = pk;
      if (row >= TP) {
        float* o = p.out + O_CVS + (size_t)(row - TP) * 2048 + col;
        *(float4*)o = make_float4(y[0], y[1], y[2], y[3]); *(float4*)(o + 4) = make_float4(y[4], y[5], y[6], y[7]);
      }
    }
  }
}

DI void cmlp_mix_phase(PREF p, unsigned char* smem, int bid, int nblk, int wv) {
  const int tid = ltid(wv), lane = tid & 63, w = tid >> 6, wm = w >> 2, wn = w & 3, lr = lane & 31, lh = lane >> 5;
  unsigned char* R = p.ws + OFF_R;
  const bf16_t* U = (const bf16_t*)(R + C_U);
  const bf16_t* VLN = (const bf16_t*)(R + C_VLN);
  bf16_t* G = (bf16_t*)(R + C_G);
  const bf16_t* WT = (const bf16_t*)(p.ws + OFF_W) + W_TRIL;
  const float* bs = p.in[21];
  bf16_t* As = (bf16_t*)smem;
  bf16_t* Bs = As + 128 * 136;
  for (int u = bid; u < 1024; u += nblk) {
    const int g = u & 7, ch = u >> 3;
    const int col0 = g * 256;
#pragma unroll 2
    for (int i = 0; i < 4; ++i) {
      int v = tid + i * NT; int r = v >> 4, c = (v & 15) * 8;
      *(uint4*)(As + r * 136 + c) = *(const uint4*)(WT + ((size_t)g * 128 + r) * 128 + c);
    }
#pragma unroll 2
    for (int i = 0; i < 8; ++i) {
      int v = tid + i * NT; int s = v >> 5, c = (v & 31) * 8;
      uint4 x = *(const uint4*)(VLN + ((size_t)ch * 128 + s) * 2048 + col0 + c);
      Bs[(c + 0) * 136 + s] = (bf16_t)(x.x & 0xffff); Bs[(c + 1) * 136 + s] = (bf16_t)(x.x >> 16);
      Bs[(c + 2) * 136 + s] = (bf16_t)(x.y & 0xffff); Bs[(c + 3) * 136 + s] = (bf16_t)(x.y >> 16);
      Bs[(c + 4) * 136 + s] = (bf16_t)(x.z & 0xffff); Bs[(c + 5) * 136 + s] = (bf16_t)(x.z >> 16);
      Bs[(c + 6) * 136 + s] = (bf16_t)(x.w & 0xffff); Bs[(c + 7) * 136 + s] = (bf16_t)(x.w >> 16);
    }
    __syncthreads();
    f32x16 acc[2][2];
#pragma unroll
    for (int a = 0; a < 2; ++a)
#pragma unroll
      for (int b = 0; b < 2; ++b)
#pragma unroll
        for (int i = 0; i < 16; ++i) acc[a][b][i] = 0.f;
    const bf16_t* Asb = As + (wm * 64 + lr) * 136 + lh * 8;
    const bf16_t* Bsb = Bs + (wn * 64 + lr) * 136 + lh * 8;
    const int ns = (wm + 1) * 4;
    for (int s = 0; s < ns; ++s) {
      bf16x8 a0 = *(const bf16x8*)(Asb + s * 16);
      bf16x8 a1 = *(const bf16x8*)(Asb + 32 * 136 + s * 16);
      bf16x8 b0 = *(const bf16x8*)(Bsb + s * 16);
      bf16x8 b1 = *(const bf16x8*)(Bsb + 32 * 136 + s * 16);
      acc[0][0] = MFMA32(a0, b0, acc[0][0]);
      acc[0][1] = MFMA32(a0, b1, acc[0][1]);
      acc[1][0] = MFMA32(a1, b0, acc[1][0]);
      acc[1][1] = MFMA32(a1, b1, acc[1][1]);
    }
#pragma unroll
    for (int mi = 0; mi < 2; ++mi)
#pragma unroll
      for (int ni = 0; ni < 2; ++ni)
#pragma unroll
        for (int i = 0; i < 16; ++i) {
          int t = wm * 64 + mi * 32 + crow(i, lh);
          int col = col0 + wn * 64 + ni * 32 + lr;
          size_t off = ((size_t)ch * 128 + t) * 2048 + col;
          float mixed = acc[mi][ni][i] + bs[g * 128 + t];
          G[off] = tobf(frombf(U[off]) * mixed);
        }
    __syncthreads();
  }
  const float* wsf = p.in[20];
  for (int e = bid * NT + tid; e < TS * 2048; e += nblk * NT) {
    int row = e >> 11, col = e & 2047, b = row >> 4, t = row & 15, g = col >> 8;
    float a = bs[g * 128 + t];
    for (int s = 0; s <= t; ++s) a += wsf[((size_t)g * 128 + t) * 128 + s] * frombf(VLN[((size_t)TP + b * 16 + s) * 2048 + col]);
    size_t off = ((size_t)TP + row) * 2048 + col;
    G[off] = tobf(frombf(U[off]) * a);
  }
}

template <int DQK, bool IS_MLA, bool MASKED>
DI void attn8_unit(const bf16_t* __restrict__ Qp, int ldq, int nq,
                   const bf16_t* __restrict__ Kp, int ldk, const bf16_t* __restrict__ KRp,
                   const bf16_t* __restrict__ Vtp, int ldv, int kmax,
                   int nit, int nk64_w, int nkeys, const unsigned* __restrict__ BMp,
                   bf16_t* __restrict__ AOp, unsigned char* smem, int wv) {
  constexpr int KS = DQK + 8;
  constexpr int VS = 132;
  constexpr int NQS = DQK / 16;
  const int tid = ltid(wv), lane = tid & 63, w = tid >> 6, lr = lane & 31, lh = lane >> 5;
  bf16_t* Ks = (bf16_t*)smem;
  bf16_t* Vs = Ks + 2 * 128 * KS;
  const bool q_ok = (w * 32 + lr) < nq;
  const int qrow = q_ok ? (w * 32 + lr) : 0;
  bf16x8 qf[NQS];
#pragma unroll
  for (int s = 0; s < NQS; ++s) qf[s] = *(const bf16x8*)(Qp + (size_t)qrow * ldq + s * 16 + lh * 8);
  f32x16 oacc[2];
#pragma unroll
  for (int d = 0; d < 2; ++d)
#pragma unroll
    for (int i = 0; i < 16; ++i) oacc[d][i] = 0.f;
  float m_run = -INFINITY, l_run = 0.f;
  const int kkey = tid >> 3, kc = (tid & 7) * 8;
  const int rkey = tid >> 2, rc = (tid & 3) * 8;
  const int vd = tid >> 4, vk = (tid & 15) * 8;
  uint4 rk0, rk1, rr, rv0, rv1;
  rr = make_uint4(0, 0, 0, 0);
  uint4 bm_next = make_uint4(0xffffffffu, 0xffffffffu, 0xffffffffu, 0xffffffffu), bm_cur = bm_next;
#define GLOAD(it_) do { const int key0_ = (it_) * 128; \
    { int kr_ = min(key0_ + kkey, kmax - 1); rk0 = *(const uint4*)(Kp + (size_t)kr_ * ldk + kc); } \
    { int kr_ = min(key0_ + kkey + 64, kmax - 1); rk1 = *(const uint4*)(Kp + (size_t)kr_ * ldk + kc); } \
    if constexpr (IS_MLA) { int kr_ = min(key0_ + rkey, kmax - 1); rr = *(const uint4*)(KRp + (size_t)kr_ * 32 + rc); } \
    { int kv_ = min(key0_ + vk, kmax - 8); rv0 = *(const uint4*)(Vtp + (size_t)vd * ldv + kv_); rv1 = *(const uint4*)(Vtp + (size_t)(vd + 32) * ldv + kv_); } \
    if constexpr (MASKED) { if (BMp) bm_next = *(const uint4*)(BMp + (size_t)qrow * 256 + (it_) * 4); } } while (0)
#define SSTORE(buf_) do { bf16_t* Kb_ = Ks + (buf_) * 128 * KS; bf16_t* Vb_ = Vs + (buf_) * 64 * VS; \
    *(uint4*)(Kb_ + kkey * KS + kc) = rk0; *(uint4*)(Kb_ + (kkey + 64) * KS + kc) = rk1; \
    if constexpr (IS_MLA) *(uint4*)(Kb_ + rkey * KS + 64 + rc) = rr; \
    *(uint2*)(Vb_ + vd * VS + vk) = make_uint2(rv0.x, rv0.y); *(uint2*)(Vb_ + vd * VS + vk + 4) = make_uint2(rv0.z, rv0.w); \
    *(uint2*)(Vb_ + (vd + 32) * VS + vk) = make_uint2(rv1.x, rv1.y); *(uint2*)(Vb_ + (vd + 32) * VS + vk + 4) = make_uint2(rv1.z, rv1.w); } while (0)
  const int nit_w = (nk64_w + 1) >> 1;
  __syncthreads();
  GLOAD(0); SSTORE(0); bm_cur = bm_next;
  __syncthreads();
  for (int it = 0; it < nit; ++it) {
    const int buf = it & 1;
    if (it + 1 < nit) GLOAD(it + 1);
    if (it < nit_w) {
      const bf16_t* Kb = Ks + buf * 128 * KS; const bf16_t* Vb = Vs + buf * 64 * VS;
      f32x16 sacc[4];
#pragma unroll
      for (int t4 = 0; t4 < 4; ++t4) {
#pragma unroll
        for (int i = 0; i < 16; ++i) sacc[t4][i] = 0.f;
#pragma unroll
        for (int s = 0; s < NQS; ++s) {
          bf16x8 kf = *(const bf16x8*)(Kb + (t4 * 32 + lr) * KS + s * 16 + lh * 8);
          sacc[t4] = MFMA32(kf, qf[s], sacc[t4]);
        }
      }
      if ((2 * it + 1) >= nk64_w) {
#pragma unroll
        for (int t4 = 2; t4 < 4; ++t4)
#pragma unroll
          for (int i = 0; i < 16; ++i) sacc[t4][i] = -INFINITY;
      }
      float mx = -INFINITY;
#pragma unroll
      for (int t4 = 0; t4 < 4; ++t4) {
        const unsigned wbits = (t4 == 0) ? bm_cur.x : (t4 == 1) ? bm_cur.y : (t4 == 2) ? bm_cur.z : bm_cur.w;
#pragma unroll
        for (int i = 0; i < 16; ++i) {
          if constexpr (MASKED) {
            const int kin = crow(i, lh);
            const int key = it * 128 + t4 * 32 + kin;
            bool ok = (key < nkeys) && ((wbits >> kin) & 1u);
            sacc[t4][i] = ok ? sacc[t4][i] : -INFINITY;
          }
          mx = fmaxf(mx, sacc[t4][i]);
        }
      }
      mx = fmaxf(mx, shflx(mx, 32, lane));
      const float m_new = fmaxf(m_run, mx);
      const float m_safe = (m_new == -INFINITY) ? 0.f : m_new;
      const float alpha = __builtin_amdgcn_exp2f(m_run - m_safe);
      m_run = m_new;
      float ls = 0.f;
#pragma unroll
      for (int t4 = 0; t4 < 4; ++t4)
#pragma unroll
        for (int i = 0; i < 16; ++i) { float pv = __builtin_amdgcn_exp2f(sacc[t4][i] - m_safe); sacc[t4][i] = pv; ls += pv; }
      l_run = l_run * alpha + ls;
#pragma unroll
      for (int d = 0; d < 2; ++d)
#pragma unroll
        for (int i = 0; i < 16; ++i) oacc[d][i] *= alpha;
#pragma unroll
      for (int t4 = 0; t4 < 4; ++t4)
#pragma unroll
        for (int s = 0; s < 2; ++s) {
          uint4 pp;
          pp.x = pack2(sacc[t4][8 * s + 0], sacc[t4][8 * s + 1]);
          pp.y = pack2(sacc[t4][8 * s + 2], sacc[t4][8 * s + 3]);
          pp.z = pack2(sacc[t4][8 * s + 4], sacc[t4][8 * s + 5]);
          pp.w = pack2(sacc[t4][8 * s + 6], sacc[t4][8 * s + 7]);
          bf16x8 pf = __builtin_bit_cast(bf16x8, pp);
#pragma unroll
          for (int dt = 0; dt < 2; ++dt) {
            const bf16_t* vrow = Vb + (dt * 32 + lr) * VS + t4 * 32 + 16 * s + 4 * lh;
            uint2 lo = *(const uint2*)(vrow), hi = *(const uint2*)(vrow + 8);
            uint4 vv = make_uint4(lo.x, lo.y, hi.x, hi.y);
            bf16x8 vf = __builtin_bit_cast(bf16x8, vv);
            oacc[dt] = MFMA32(vf, pf, oacc[dt]);
          }
        }
    }
    if (it + 1 < nit) { SSTORE(buf ^ 1); bm_cur = bm_next; }
    __syncthreads();
  }
  if (nit_w > 0) {
    float lt = l_run + shflx(l_run, 32, lane);
    float inv = lt > 0.f ? 1.f / lt : 0.f;
    if (q_ok) {
      bf16_t* orow = AOp + (size_t)(w * 32 + lr) * 1024;
#pragma unroll
      for (int dt = 0; dt < 2; ++dt)
#pragma unroll
        for (int g = 0; g < 4; ++g) {
          uint2 pk;
          pk.x = pack2(oacc[dt][4 * g] * inv, oacc[dt][4 * g + 1] * inv);
          pk.y = pack2(oacc[dt][4 * g + 2] * inv, oacc[dt][4 * g + 3] * inv);
          *(uint2*)(orow + dt * 32 + 8 * g + 4 * lh) = pk;
        }
    }
  }
}
#undef GLOAD
#undef SSTORE

DI int snake_idx(int i, int bid, int nblk) { return i * nblk + ((i & 1) ? (nblk - 1 - bid) : bid); }

template <bool IS_MLA>
DI void attn_phase(PREF p, unsigned char* smem, int bid, int nblk, int wv) {
  unsigned char* R = p.ws + OFF_R;
  const int w = ltid(wv) >> 6;
  const int total = 1024 + 512;
  for (int i = 0; i * nblk < total; ++i) {
    int u = snake_idx(i, bid, nblk);
    if (u >= total) continue;
    if constexpr (IS_MLA) {
      const bf16_t* Q = (const bf16_t*)(R + R_Q); const bf16_t* KN = (const bf16_t*)(R + R_KN);
      const bf16_t* KR = (const bf16_t*)(R + R_KR); const bf16_t* VT = (const bf16_t*)(R + R_VT);
      bf16_t* AO = (bf16_t*)(R + R_RAW);
      if (u < 1024) {
        int qt = 31 - (u >> 5), bh = u & 31, b = bh >> 4, h = bh & 15;
        int q0 = b * 8192 + qt * 256;
        attn8_unit<96, true, false>(Q + (size_t)q0 * 1536 + h * 96, 1536, 256,
                                    KN + (size_t)(b * 8192) * 1024 + h * 64, 1024, KR + (size_t)(b * 8192) * 32,
                                    VT + (size_t)((b * 16 + h) * 64) * 8192, 8192, 8192,
                                    2 * qt + 2, 4 * qt + 1 + (w >> 1), 1 << 30, nullptr,
                                    AO + (size_t)q0 * 1024 + h * 64, smem, wv);
      } else {
        int v = u - 1024, b = v >> 4, h = v & 15;
        int q0 = TP + b * 16;
        attn8_unit<96, true, true>(Q + (size_t)q0 * 1536 + h * 96, 1536, 16,
                                   KN + (size_t)(TP + b * SPAD) * 1024 + h * 64, 1024, KR + (size_t)(TP + b * SPAD) * 32,
                                   VT + (size_t)TP * 1024 + (size_t)((b * 16 + h) * 64) * SPAD, SPAD, SPAD,
                                   9, (w == 0) ? 17 : 0, NKS, nullptr,
                                   AO + (size_t)q0 * 1024 + h * 64, smem, wv);
      }
    } else {
      const bf16_t* Q = (const bf16_t*)(R + D_Q); const bf16_t* KK = (const bf16_t*)(R + D_K);
      const bf16_t* VT = (const bf16_t*)(R + D_VT); const unsigned* BM = (const unsigned*)(R + D_BM);
      bf16_t* AO = (bf16_t*)(R + D_AO);
      if (u < 1024) {
        int qt = 31 - (u >> 5), bh = u & 31, b = bh >> 4, h = bh & 15;
        int q0 = b * 8192 + qt * 256;
        attn8_unit<64, false, true>(Q + (size_t)q0 * 1024 + h * 64, 1024, 256,
                                    KK + (size_t)(b * 8192) * 1024 + h * 64, 1024, nullptr,
                                    VT + (size_t)((b * 16 + h) * 64) * 8192, 8192, 8192,
                                    2 * qt + 2, 4 * qt + 1 + (w >> 1), 1 << 30, BM + (size_t)q0 * 256,
                                    AO + (size_t)q0 * 1024 + h * 64, smem, wv);
      } else {
        int v = u - 1024, b = v >> 4, h = v & 15;
        int q0 = TP + b * 16;
        attn8_unit<64, false, true>(Q + (size_t)q0 * 1024 + h * 64, 1024, 16,
                                    KK + (size_t)(TP + b * SPAD) * 1024 + h * 64, 1024, nullptr,
                                    VT + (size_t)TP * 1024 + (size_t)((b * 16 + h) * 64) * SPAD, SPAD, SPAD,
                                    9, (w == 0) ? 17 : 0, NKS, BM + (size_t)q0 * 256,
                                    AO + (size_t)q0 * 1024 + h * 64, smem, wv);
      }
    }
  }
}

constexpr int CAP = 128;
DI int score_bin(float s) {
  unsigned u = __float_as_uint(s);
  int e = (int)((u & 0x7fffffffu) >> 19);
  int m = min(max(e, 1840), 2095) - 1840;
  return (u >> 31) ? (255 - m) : (256 + m);
}

DI void idx_unit(const bf16_t* __restrict__ QI, const float* __restrict__ WI, int q_row0, int nq,
                 const bf16_t* __restrict__ KI, int L, unsigned* __restrict__ BM, unsigned char* smem, int wv) {
  const int tid = ltid(wv), lane = tid & 63, w = tid >> 6, lr = lane & 31, lh = lane >> 5;
  bf16_t* Qs = (bf16_t*)smem;
  float* Ws = (float*)(smem + 36864);
  unsigned* hist = (unsigned*)(smem + 36864 + 1024);
  float* cand_s = (float*)hist;
  int* cand_i = (int*)(smem + 36864 + 1024 + 16384);
  int* bstar = (int*)(smem + 36864 + 1024 + 32768);
  int* need = bstar + 32;
  int* ncand = need + 32;
  __syncthreads();
#pragma unroll
  for (int i = 0; i < 4; ++i) {
    int v = tid + i * NT;
    int hd = v >> 8, q = (v >> 3) & 31, c = (v & 7) * 8;
    int qq = q < nq ? q : 0;
    *(uint4*)(Qs + (hd * 32 + q) * 72 + c) = *(const uint4*)(QI + (size_t)(q_row0 + qq) * 512 + hd * 64 + c);
  }
  if (tid < 256) { int hd = tid >> 5, q = tid & 31; int qq = q < nq ? q : 0; Ws[hd * 32 + q] = WI[(size_t)(q_row0 + qq) * 8 + hd]; }
  for (int i = tid; i < 32 * 256; i += NT) hist[i] = 0u;
  if (tid < 32) { bstar[tid] = -1; need[tid] = 0; ncand[tid] = 0; }
  __syncthreads();
  const int ntile = (L + 255) >> 8;
  const bool do_select = L > 256;
  int bsr[16];
  { int m1_ = -1; asm volatile("" : "+v"(m1_));
#pragma unroll
    for (int i = 0; i < 16; ++i) bsr[i] = m1_; }
  for (int pass = do_select ? 0 : 1; pass < 2; ++pass) {
    if (pass == 1) {
#pragma unroll
      for (int i = 0; i < 16; ++i) bsr[i] = bstar[crow(i, lh)];
    }
    bf16x8 kn0, kn1, kn2, kn3;
    { const bf16_t* kp = KI + (size_t)(w * 32 + lr) * 64 + lh * 8;
      kn0 = *(const bf16x8*)(kp); kn1 = *(const bf16x8*)(kp + 16); kn2 = *(const bf16x8*)(kp + 32); kn3 = *(const bf16x8*)(kp + 48); }
    for (int kt = 0; kt < ntile; ++kt) {
      const int key0 = kt * 256 + w * 32;
      bf16x8 kf[4];
      kf[0] = kn0; kf[1] = kn1; kf[2] = kn2; kf[3] = kn3;
      if (key0 + 256 < L) {
        const bf16_t* kp = KI + (size_t)(key0 + 256 + lr) * 64 + lh * 8;
        kn0 = *(const bf16x8*)(kp); kn1 = *(const bf16x8*)(kp + 16); kn2 = *(const bf16x8*)(kp + 32); kn3 = *(const bf16x8*)(kp + 48);
      }
      if (key0 < L) {
        const int key = key0 + lr;
        float sc[16];
#pragma unroll
        for (int i = 0; i < 16; ++i) sc[i] = 0.f;
#pragma unroll 1
        for (int hd = 0; hd < 8; ++hd) {
          f32x16 acc;
#pragma unroll
          for (int i = 0; i < 16; ++i) acc[i] = 0.f;
#pragma unroll
          for (int s = 0; s < 4; ++s) {
            bf16x8 qf = *(const bf16x8*)(Qs + (hd * 32 + lr) * 72 + s * 16 + lh * 8);
            acc = MFMA32(qf, kf[s], acc);
          }
#pragma unroll
          for (int g = 0; g < 4; ++g) {
            float4 wv = *(const float4*)(Ws + hd * 32 + 8 * g + 4 * lh);
            sc[4 * g + 0] += wv.x * fmaxf(acc[4 * g + 0], 0.f);
            sc[4 * g + 1] += wv.y * fmaxf(acc[4 * g + 1], 0.f);
            sc[4 * g + 2] += wv.z * fmaxf(acc[4 * g + 2], 0.f);
            sc[4 * g + 3] += wv.w * fmaxf(acc[4 * g + 3], 0.f);
          }
        }
        const bool kvalid = key < L;
        if (pass == 0) {
#pragma unroll
          for (int i = 0; i < 16; ++i) {
            int q = crow(i, lh);
            if (kvalid) { int b = score_bin(sc[i]); atomicAdd(&hist[q * 256 + (b >> 1)], (b & 1) ? 65536u : 1u); }
          }
        } else {
          unsigned myword = 0u, cmask = 0u;
          unsigned long long any = 0ull;
#pragma unroll
          for (int i = 0; i < 16; ++i) {
            const int b = score_bin(sc[i]);
            const int bs = bsr[i];
            const bool sel = kvalid && (b > bs);
            const bool cnd = kvalid && (b == bs);
            const unsigned long long bal = __ballot(sel);
            myword = (lr == i) ? (unsigned)(bal >> (32 * lh)) : myword;
            any |= __ballot(cnd);
            cmask |= cnd ? (1u << i) : 0u;
          }
          if (lr < 16 && crow(lr, lh) < nq) BM[(size_t)(q_row0 + crow(lr, lh)) * 256 + (key0 >> 5)] = myword;
          if (any != 0ull) {
            int base[16];
#pragma unroll
            for (int i = 0; i < 16; ++i) {
              const unsigned long long cbi = __ballot((cmask >> i) & 1u);
              base[i] = 0;
              if (lr == 0) base[i] = atomicAdd(&ncand[crow(i, lh)], __popc((unsigned)(cbi >> (32 * lh))));
            }
#pragma unroll
            for (int i = 0; i < 16; ++i) {
              const unsigned long long cbi = __ballot((cmask >> i) & 1u);
              const int bb = __builtin_amdgcn_ds_bpermute((lane & 32) << 2, base[i]);
              if ((cmask >> i) & 1u) {
                const unsigned hm = (unsigned)(cbi >> (32 * lh));
                const int pos = bb + __popc(hm & ((1u << lr) - 1u));
                const int q = crow(i, lh);
                if (pos < CAP) { cand_s[q * CAP + pos] = sc[i]; cand_i[q * CAP + pos] = key; }
              }
            }
          }
        }
      }
    }
    __syncthreads();
    if (pass == 0) {
      for (int qi = 0; qi < 4; ++qi) {
        const int q = w * 4 + qi;
        unsigned hw[4];
#pragma unroll
        for (int k = 0; k < 4; ++k) hw[k] = hist[q * 256 + 255 - 4 * lane - k];
        int cnt = 0;
#pragma unroll
        for (int k = 0; k < 4; ++k) cnt += (int)(hw[k] >> 16) + (int)(hw[k] & 0xffffu);
        int pre = cnt;
#pragma unroll
        for (int o = 1; o < 64; o <<= 1) { int t = __builtin_amdgcn_ds_bpermute(((lane - o) & 63) << 2, pre); if (lane >= o) pre += t; }
        unsigned long long bal = __ballot(pre >= 256);
        if (bal != 0ull) {
          int fl = __ffsll((long long)bal) - 1;
          if (lane == fl) {
            int running = pre - cnt;
            int bsel = -1, above = 0;
#pragma unroll
            for (int k = 0; k < 4; ++k) {
              int chi = (int)(hw[k] >> 16), clo = (int)(hw[k] & 0xffffu);
              if (bsel < 0) { if (running + chi >= 256) { bsel = 511 - 8 * lane - 2 * k; above = running; } else running += chi; }
              if (bsel < 0) { if (running + clo >= 256) { bsel = 510 - 8 * lane - 2 * k; above = running; } else running += clo; }
            }
            bstar[q] = bsel; need[q] = 256 - above;
          }
        }
      }
      __syncthreads();
    }
  }
  __threadfence();
  __syncthreads();
  if (do_select) {
    for (int pi = tid; pi < 32 * CAP; pi += NT) {
      int q = pi / CAP, c = pi - q * CAP;
      int n = min(ncand[q], CAP);
      if (c < n && q < nq) {
        float sv = cand_s[q * CAP + c]; int iv = cand_i[q * CAP + c];
        int rank = 0;
        for (int j = 0; j < n; ++j) {
          float sj = cand_s[q * CAP + j]; int ij = cand_i[q * CAP + j];
          rank += (sj > sv || (sj == sv && ij < iv)) ? 1 : 0;
        }
        if (rank < need[q]) atomicOr(&BM[(size_t)(q_row0 + q) * 256 + (iv >> 5)], 1u << (iv & 31));
      }
    }
  }
  __syncthreads();
}

DI void idx_phase(PREF p, unsigned char* smem, int bid, int nblk, int wv) {
  unsigned char* R = p.ws + OFF_R;
  const bf16_t* QI = (const bf16_t*)(R + D_QI); const float* WI = (const float*)(R + D_WI);
  const bf16_t* KI = (const bf16_t*)(R + D_KI); unsigned* BM = (unsigned*)(R + D_BM);
  const int total = 512 + 32;
  for (int i = 0; i * nblk < total; ++i) {
    int idx = snake_idx(i, bid, nblk);
    if (idx >= total) continue;
    if (idx < 512) {
      int qt = 255 - (idx >> 1), b = idx & 1;
      int L = (((qt * 32) >> 6) + 1) * 64;
      idx_unit(QI, WI, b * 8192 + qt * 32, 32, KI + (size_t)(b * 8192) * 64, L, BM, smem, wv);
    } else {
      int b = idx - 512;
      idx_unit(QI, WI, TP + b * 16, 16, KI + (size_t)(TP + b * SPAD) * 64, NKS, BM, smem, wv);
    }
  }
}

DI void cvt8(const float* s, bf16_t* d) {
  float4 a = *(const float4*)s, b = *(const float4*)(s + 4);
  uint4 pk; pk.x = pack2(a.x, a.y); pk.y = pack2(a.z, a.w); pk.z = pack2(b.x, b.y); pk.w = pack2(b.z, b.w);
  *(uint4*)d = pk;
}
DI void cache_rows(const float* __restrict__ src, bf16_t* __restrict__ dst, int Wd, int bid, int nblk, int wv) {
  const int vpr = Wd >> 3;
  const size_t total = (size_t)32 * SPAD * vpr;
  for (size_t e = (size_t)bid * NT + ltid(wv); e < total; e += (size_t)nblk * NT) {
    int c = (int)(e % vpr) * 8; size_t rw = e / vpr; int b = (int)(rw / SPAD), s = (int)(rw % SPAD);
    bf16_t* d = dst + ((size_t)TP + (size_t)b * SPAD + s) * Wd + c;
    if (s < 1024) cvt8(src + ((size_t)b * 1024 + s) * Wd + c, d);
    else if (s >= NKS) { unsigned z = 0; asm volatile("" : "+v"(z)); *(uint4*)d = make_uint4(z, z, z, z); }
  }
}


#define XB_TMO      128
#define XB_XCNT(j)  (256  + 64 * (j))
#define XB_XSUB(j)  (1280 + 64 * (j))
#define XB_XGEN(j)  (2304 + 64 * (j))
#define XB_TOP      3328
#define XB_TOPGEN   3392
#define XCD_BAR_WORDS 3456
#define XB_SPIN_CAP (1u << 18)
DI unsigned xb_ld(unsigned* p)              { return __hip_atomic_load(p, __ATOMIC_RELAXED, __HIP_MEMORY_SCOPE_AGENT); }
DI unsigned xb_add(unsigned* p, unsigned v) { return __hip_atomic_fetch_add(p, v, __ATOMIC_RELAXED, __HIP_MEMORY_SCOPE_AGENT); }
DI unsigned xb_xcc_id() { return (unsigned)__builtin_amdgcn_s_getreg((3 << 11) | 20) & 0xFu; }
#define XB_SPIN(cond, bar) do { unsigned _sp = 0; while (cond) { __builtin_amdgcn_s_sleep(1); \
    if ((++_sp & 255u) == 0u) { if (xb_ld(&(bar)[XB_TMO])) break; if (_sp > XB_SPIN_CAP) { atomicAdd(&(bar)[XB_TMO], 1u); break; } } } } while (0)
struct XcdBarrier { unsigned* bar; unsigned x; volatile __attribute__((address_space(3))) unsigned* st; };
DI void xcd_barrier_complete(unsigned* bar, unsigned x, unsigned G, unsigned& nloc, unsigned& nx) {
  unsigned sum, cnt, mine, sp = 0u;
  for (;;) {
    sum = 0u; cnt = 0u; mine = 0u;
#pragma unroll
    for (unsigned j = 0; j < 16; ++j) { const unsigned c = xb_ld(&bar[XB_XCNT(j)]); sum += c; cnt += (c > 0u) ? 1u : 0u; mine = (j == x) ? c : mine; }
    if (sum == G) break;
    __builtin_amdgcn_s_sleep(1);
    if ((++sp & 255u) == 0u) { if (xb_ld(&bar[XB_TMO])) break; if (sp > XB_SPIN_CAP) { atomicAdd(&bar[XB_TMO], 1u); break; } }
  }
  nloc = mine > 0u ? mine : 1u; nx = cnt > 0u ? cnt : 1u;
}
DI void xcd_barrier(const XcdBarrier& b, int tid, unsigned G) {
  asm volatile("s_waitcnt vmcnt(0)" ::: "memory");
  __syncthreads();
  if (tid == 0) {
    unsigned* bar = b.bar;
    __builtin_amdgcn_s_waitcnt(0);
    unsigned nloc = b.st[0], nx = b.st[1];
    if (nloc == 0u) { xcd_barrier_complete(bar, b.x, G, nloc, nx); b.st[0] = nloc; b.st[1] = nx; }
    const unsigned old = xb_add(&bar[XB_XSUB(b.x)], 1u);
    const unsigned gen = old / nloc;
    if (old + 1u == (gen + 1u) * nloc) {
      __builtin_amdgcn_fence(__ATOMIC_RELEASE, "agent");
      asm volatile("s_waitcnt vmcnt(0)" ::: "memory");
      const unsigned og = xb_add(&bar[XB_TOP], 1u);
      const unsigned tg = og / nx;
      if (og + 1u == (tg + 1u) * nx) xb_add(&bar[XB_TOPGEN], 1u);
      else XB_SPIN(xb_ld(&bar[XB_TOPGEN]) == tg, bar);
      __builtin_amdgcn_fence(__ATOMIC_ACQUIRE, "agent");
      xb_add(&bar[XB_XGEN(b.x)], 1u);
      asm volatile("s_waitcnt vmcnt(0)" ::: "memory");
    } else {
      XB_SPIN(xb_ld(&bar[XB_XGEN(b.x)]) == gen, bar);
      __builtin_amdgcn_fence(__ATOMIC_ACQUIRE, "agent");
      asm volatile("s_waitcnt vmcnt(0)" ::: "memory");
    }
  }
  __syncthreads();
}

extern "C" __global__ void __launch_bounds__(512, 2) mega(Params p_unused) {
  extern __shared__ __attribute__((aligned(16))) unsigned char smem[];
  cg::grid_group grid = cg::this_grid();
  const int bid = blockIdx.x, nblk = gridDim.x;
  const int wv = __builtin_amdgcn_readfirstlane((int)(threadIdx.x >> 6));
  CParams* pk = (CParams*)__builtin_amdgcn_kernarg_segment_ptr();
  const int ph_lo = pk->ph_lo, ph_hi = pk->ph_hi;
  int ph = 0;
  XcdBarrier xb;
  {
    volatile __attribute__((address_space(3))) unsigned* st = (volatile __attribute__((address_space(3))) unsigned*)(smem + 131072);
    const int t0 = ltid(wv);
    if (t0 == 0) { st[0] = 0u; st[1] = 0u; }
    __syncthreads();
    xb.bar = (unsigned*)(pk->ws + OFF_BAR); xb.x = xb_xcc_id(); xb.st = st;
    if (t0 == 0) (void)xb_add(&xb.bar[XB_XCNT(xb.x)], 1u);
  }
#ifndef REPMASK
#define REPMASK 0u
#endif
#ifndef PMASK
#define PMASK 0xffffffffu
#endif
#define PHASE_BEGIN(k) if (ph >= ph_lo && ph < ph_hi) { if constexpr ((PMASK >> (k)) & 1u) for (int rep_ = 0; rep_ < 1 + (int)((REPMASK >> (k)) & 1u); ++rep_) { \
    CParams* pp_ = pk; asm volatile("" : "+s"(pp_)); PREF p = *pp_; const int tid = ltid(wv); \
    unsigned char* ws = p.ws; float* X = (float*)(ws + OFF_X); bf16_t* H = (bf16_t*)(ws + OFF_H); bf16_t* Wb = (bf16_t*)(ws + OFF_W); \
    float* ROPE = (float*)(ws + OFF_ROPE); unsigned char* R = ws + OFF_R; (void)tid; (void)X; (void)H; (void)Wb; (void)ROPE; (void)R;
#define PHASE_END   } if (ph + 1 < ph_hi) { if (ph == 0) grid.sync(); else xcd_barrier(xb, ltid(wv), (unsigned)nblk); } } ++ph;

  PHASE_BEGIN(0)
    {
      const int hf = tid >> 8, tl = tid & 255;
      float* smh = (float*)smem + hf * 4224;
      for (int t0 = bid * 2; t0 < p.total_tiles; t0 += nblk * 2) {
        const int t = t0 + hf;
        const bool active = t < p.total_tiles;
        const int tt = active ? t : 0;
        int ji = 0;
#pragma unroll 1
        for (int q = 1; q < NJOBS; ++q) if (tt >= p.jobs[q].tile0) ji = q;
        const CAS Job& jb = p.jobs[ji];
        int lt = tt - jb.tile0; int nkt = jb.k >> 6; int nt_ = lt / nkt, kt_ = lt - nt_ * nkt;
        transpose_tile(jb.src, jb.nsrc, jb.nsrc, jb.dst, jb.k, nt_ * 64, kt_ * 64, jb.mode, smh, tl, active);
      }
    }
    {
      const size_t n4p = (size_t)TP * 256, n4 = (size_t)T * 256;
      const float4* xp = (const float4*)p.in[0]; const float4* xs = (const float4*)p.in[1];
      for (size_t e = (size_t)bid * NT + tid; e < n4; e += (size_t)nblk * NT) ((float4*)X)[e] = (e < n4p) ? xp[e] : xs[e - n4p];
      for (int e = bid * NT + tid; e < 8192 * 16; e += nblk * NT) {
        int pos = e >> 4, i = e & 15;
        double rev = (double)pos * p.inv_freq[i] * 0.15915494309189535;
        rev -= floor(rev);
        float fr = (float)rev;
        ROPE[2 * e] = __builtin_amdgcn_cosf(fr); ROPE[2 * e + 1] = __builtin_amdgcn_sinf(fr);
      }
      const float* wsrc = p.in[20];
      for (int e = bid * NT + tid; e < 8 * 128 * 128; e += nblk * NT) {
        int s = e & 127, t = (e >> 7) & 127;
        Wb[W_TRIL + e] = tobf(s <= t ? wsrc[e] : 0.f);
      }
    }
  PHASE_END

#pragma unroll 1
  for (int L = 0; L < 4; ++L) {
    const int kind = L % 3, j = L / 3;
    if (kind == 0) {
      PHASE_BEGIN(1)
        rmsnorm_rows(X, p.in[7] + L * 1024, H, nullptr, nullptr, bid, nblk, wv);
        cache_rows(p.in[2] + (size_t)j * 32 * 1024 * 256, (bf16_t*)(R + R_CKV), 256, bid, nblk, wv);
        cache_rows(p.in[3] + (size_t)j * 32 * 1024 * 32, (bf16_t*)(R + R_KR), 32, bid, nblk, wv);
      PHASE_END
      PHASE_BEGIN(2)
        EArgs ea{}; ea.f0 = (float*)(R + R_RAW);
        gemm_phase<E_F32>(H, Wb + W_MLA + (size_t)j * WM_SZ + WM_D, T, 1024, 1024, ea, smem, 0, bid, nblk, wv);
      PHASE_END
      PHASE_BEGIN(3)
        mla_rowops(p, j, bid, nblk, wv);
      PHASE_END
      PHASE_BEGIN(4)
        EArgs ea{}; ea.b0 = (bf16_t*)(R + R_Q); ea.rope = ROPE;
        gemm_phase<E_MLAQ>((const bf16_t*)(R + R_CQ), Wb + W_MLA + (size_t)j * WM_SZ + WM_UQ, T, 1536, 512, ea, smem, 0, bid, nblk, wv);
        EArgs eb{}; eb.b0 = (bf16_t*)(R + R_KN); eb.b1 = (bf16_t*)(R + R_VT);
        gemm_phase<E_MLAKV>((const bf16_t*)(R + R_CKV), Wb + W_MLA + (size_t)j * WM_SZ + WM_UKV, KROWS, 2048, 256, eb, smem, (T / 256) * 6, bid, nblk, wv);
      PHASE_END
      PHASE_BEGIN(5)
        attn_phase<true>(p, smem, bid, nblk, wv);
      PHASE_END
      PHASE_BEGIN(6)
        EArgs ea{}; ea.f0 = X;
        gemm_phase<E_RESID>((const bf16_t*)(R + R_RAW), Wb + W_MLA + (size_t)j * WM_SZ + WM_O, T, 1024, 1024, ea, smem, 0, bid, nblk, wv);
      PHASE_END
    } else if (kind == 1) {
      PHASE_BEGIN(1)
        rmsnorm_rows(X, p.in[7] + L * 1024, H, nullptr, nullptr, bid, nblk, wv);
      PHASE_END
      PHASE_BEGIN(7)
        EArgs ea{}; ea.b0 = (bf16_t*)(R + C_U); ea.b1 = (bf16_t*)(R + C_VR);
        gemm_phase<E_GELU>(H, Wb + W_CM + WC_IN, T, 4096, 1024, ea, smem, 0, bid, nblk, wv);
      PHASE_END
      PHASE_BEGIN(8)
        cmlp_ln_rows(p, bid, nblk, wv);
      PHASE_END
      PHASE_BEGIN(9)
        cmlp_mix_phase(p, smem, bid, nblk, wv);
      PHASE_END
      PHASE_BEGIN(6)
        EArgs ea{}; ea.f0 = X;
        gemm_phase<E_RESID>((const bf16_t*)(R + C_G), Wb + W_CM + WC_OUT, T, 1024, 2048, ea, smem, 0, bid, nblk, wv);
      PHASE_END
    } else {
      PHASE_BEGIN(10)
        rmsnorm_rows(X, p.in[7] + L * 1024, H, nullptr, nullptr, bid, nblk, wv);
        cache_rows(p.in[4], (bf16_t*)(R + D_K), 1024, bid, nblk, wv);
        cache_rows(p.in[6], (bf16_t*)(R + D_KI), 64, bid, nblk, wv);
        {
          bf16_t* VTs = (bf16_t*)(R + D_VT) + (size_t)TP * 1024;
          {
            const int hf = tid >> 8, tl = tid & 255;
            float* smh = (float*)smem + hf * 4224;
            for (int u0 = bid * 2; u0 < 512 * 16; u0 += nblk * 2) {
              const int u = u0 + hf;
              int st = u & 15, bh = u >> 4, b = bh >> 4, h = bh & 15;
              transpose_tile(p.in[5] + (size_t)b * 1024 * 1024 + h * 64, 1024, 64, VTs + (size_t)(bh * 64) * SPAD, SPAD, 0, st * 64, 0, smh, tl, true);
            }
          }
          for (int e = bid * NT + tid; e < 512 * 64 * 12; e += nblk * NT) {
            int c = e % 12, rw = e / 12;
            { unsigned z = 0; asm volatile("" : "+v"(z)); *(uint2*)(VTs + (size_t)rw * SPAD + NKS + c * 4) = make_uint2(z, z); }
          }
        }
      PHASE_END
      PHASE_BEGIN(11)
        EArgs ea{};
        ea.f0 = p.out + O_DKP; ea.f1 = p.out + O_DKS; ea.f2 = p.out + O_DVP; ea.f3 = p.out + O_DVS;
        ea.f4 = (float*)(R + D_KIR); ea.f5 = (float*)(R + D_WI);
        ea.b0 = (bf16_t*)(R + D_Q); ea.b1 = (bf16_t*)(R + D_K); ea.b2 = (bf16_t*)(R + D_VT); ea.b3 = (bf16_t*)(R + D_QI);
        gemm_phase<E_DSA>(H, Wb + W_DS + WD_P, T, 3840, 1024, ea, smem, 0, bid, nblk, wv);
      PHASE_END
      PHASE_BEGIN(12)
        dsa_rowops(p, bid, nblk, wv);
      PHASE_END
      PHASE_BEGIN(13)
        idx_phase(p, smem, bid, nblk, wv);
      PHASE_END
      PHASE_BEGIN(14)
        attn_phase<false>(p, smem, bid, nblk, wv);
      PHASE_END
      PHASE_BEGIN(6)
        EArgs ea{}; ea.f0 = X;
        gemm_phase<E_RESID>((const bf16_t*)(R + D_AO), Wb + W_DS + WD_O, T, 1024, 1024, ea, smem, 0, bid, nblk, wv);
      PHASE_END
    }
    PHASE_BEGIN(1)
      rmsnorm_rows(X, p.in[8] + L * 1024, H, nullptr, nullptr, bid, nblk, wv);
    PHASE_END
    PHASE_BEGIN(15)
      EArgs ea{}; ea.b0 = (bf16_t*)(R + 0);
      gemm_phase<E_SWIGLU>(H, Wb + W_FF + (size_t)L * WF_SZ + WF_IN, T, 2 * DFF, 1024, ea, smem, 0, bid, nblk, wv);
    PHASE_END
    PHASE_BEGIN(6)
      EArgs ea{}; ea.f0 = X;
      gemm_phase<E_RESID>((const bf16_t*)(R + 0), Wb + W_FF + (size_t)L * WF_SZ + WF_OUT, T, 1024, DFF, ea, smem, 0, bid, nblk, wv);
    PHASE_END
  }
  PHASE_BEGIN(1)
    rmsnorm_rows(X, p.in[9], nullptr, p.out + O_YP, p.out + O_YS, bid, nblk, wv);
  PHASE_END
}

extern "C" void kernel_launch(void* const* d_in, const int* in_sizes, int n_in,
                              void* d_out, int out_size, void* d_ws, size_t ws_size,
                              hipStream_t stream) {
  constexpr int kLds = 128 * 1024 + 64;
  static int grid_blocks = 0;
  if (!grid_blocks) {
    int dev = 0, cus = 0, per_cu = 0;
    (void)hipGetDevice(&dev);
    (void)hipDeviceGetAttribute(&cus, hipDeviceAttributeMultiprocessorCount, dev);
    (void)hipFuncSetAttribute((const void*)mega, hipFuncAttributeMaxDynamicSharedMemorySize, kLds);
    (void)hipOccupancyMaxActiveBlocksPerMultiprocessor(&per_cu, (const void*)mega, NT, kLds);
    if (per_cu < 1) per_cu = 1;
    if (per_cu > 1) per_cu = 1;
    grid_blocks = cus * per_cu;
    fprintf(stderr, "grid %d (cus %d per_cu %d) ws %zu need %zu out %d need %zu\n", grid_blocks, cus, per_cu, ws_size, (size_t)WS_NEED, out_size, (size_t)O_END);
  }
  if (ws_size < WS_NEED || n_in != 31 || (size_t)out_size != O_END) { fprintf(stderr, "kernel_launch: bad sizes\n"); return; }
  Params p;
  memset(&p, 0, sizeof(p));
  for (int i = 0; i < 31; ++i) p.in[i] = (const float*)d_in[i];
  p.out = (float*)d_out; p.ws = (unsigned char*)d_ws;
  bf16_t* Wb = (bf16_t*)((unsigned char*)d_ws + OFF_W);
  int nj = 0, tiles = 0;
  auto add = [&](const float* src, int nsrc, int k, bf16_t* dst, int ndst, int mode) {
    Job& jb = p.jobs[nj++]; jb.src = src; jb.dst = dst; jb.nsrc = nsrc; jb.k = k; jb.ndst = ndst; jb.mode = mode; jb.tile0 = tiles; jb.pad = 0;
    tiles += (ndst / 64) * (k / 64);
  };
  for (int j = 0; j < 2; ++j) {
    bf16_t* Wm = Wb + W_MLA + (size_t)j * WM_SZ;
    add(p.in[10] + (size_t)j * 1024 * 512, 512, 1024, Wm + WM_D, 512, 2);
    add(p.in[13] + (size_t)j * 1024 * 288, 288, 1024, Wb + W_MLA + (size_t)j * WM_SZ + WM_D + (size_t)512 * 1024, 512, 2);
    add(p.in[12] + (size_t)j * 512 * 1536, 1536, 512, Wb + W_MLA + (size_t)j * WM_SZ + WM_UQ, 1536, 0);
    add(p.in[15] + (size_t)j * 256 * 2048, 2048, 256, Wb + W_MLA + (size_t)j * WM_SZ + WM_UKV, 2048, 2);
    add(p.in[16] + (size_t)j * 1024 * 1024, 1024, 1024, Wb + W_MLA + (size_t)j * WM_SZ + WM_O, 1024, 2);
  }
  add(p.in[17], 4096, 1024, Wb + W_CM + WC_IN, 4096, 2);
  add(p.in[22], 1024, 2048, Wb + W_CM + WC_OUT, 1024, 2);
  add(p.in[23], 3072, 1024, Wb + W_DS + WD_P, 3072, 2);
  add(p.in[25], 512, 1024, Wb + W_DS + WD_P + (size_t)3072 * 1024, 512, 2);
  add(p.in[26], 64, 1024, Wb + W_DS + WD_P + (size_t)3584 * 1024, 64, 2);
  add(p.in[28], 8, 1024, Wb + W_DS + WD_P + (size_t)3648 * 1024, 192, 2);
  add(p.in[24], 1024, 1024, Wb + W_DS + WD_O, 1024, 2);
  for (int i = 0; i < 4; ++i) {
    add(p.in[29] + (size_t)i * 1024 * 5632, 5632, 1024, Wb + W_FF + (size_t)i * WF_SZ + WF_IN, 5632, 1);
    add(p.in[30] + (size_t)i * 2816 * 1024, 1024, 2816, Wb + W_FF + (size_t)i * WF_SZ + WF_OUT, 1024, 2);
  }
  p.total_tiles = tiles;
  for (int i = 0; i < 16; ++i) p.inv_freq[i] = pow(10000.0, -(double)i / 16.0);
  p.ph_lo = 0; p.ph_hi = 1000;
  (void)hipMemsetAsync((unsigned char*)d_ws + OFF_BAR, 0, 16384, stream);
  void* args[] = {&p};
  hipError_t e = hipLaunchCooperativeKernel((const void*)mega, dim3(grid_blocks), dim3(NT), args, kLds, stream);
  if (e != hipSuccess) fprintf(stderr, "coop launch failed: %s\n", hipGetErrorString(e));
}
```

```cpp
#include <hip/hip_runtime.h>
#include <hip/hip_cooperative_groups.h>
#include <cstdio>
#include <cstring>
#include <cmath>
namespace cg = cooperative_groups;

typedef unsigned short bf16_t;
using bf16x8 = __attribute__((ext_vector_type(8))) short;
using f32x16 = __attribute__((ext_vector_type(16))) float;
using f32x2v = __attribute__((ext_vector_type(2))) float;
using bf2v = __attribute__((ext_vector_type(2))) __bf16;
#define DI __device__ __forceinline__
#define MFMA32(a, b, c) __builtin_amdgcn_mfma_f32_32x32x16_bf16((a), (b), (c), 0, 0, 0)

constexpr int TP = 16384, TS = 512, T = TP + TS;
constexpr int NT = 512;
constexpr int SPAD = 1088, NKS = 1040;
constexpr int KROWS = TP + 32 * SPAD;
constexpr int DFF = 2816;
constexpr float LOG2E = 1.4426950408889634f;
constexpr float EPS = 1e-6f;

constexpr size_t OFF_X = 0;
constexpr size_t OFF_H = OFF_X + (size_t)T * 1024 * 4;
constexpr size_t OFF_W = OFF_H + (size_t)T * 1024 * 2;
constexpr size_t W_ELEMS = 52822016;
constexpr size_t OFF_ROPE = OFF_W + W_ELEMS * 2;
constexpr size_t OFF_R = OFF_ROPE + (size_t)8192 * 16 * 2 * 4;
constexpr size_t R_RAW = 0;
constexpr size_t R_CQ = R_RAW + (size_t)T * 1024 * 4;
constexpr size_t R_CKV = R_CQ + (size_t)T * 512 * 2;
constexpr size_t R_KR = R_CKV + (size_t)KROWS * 256 * 2;
constexpr size_t R_Q = R_KR + (size_t)KROWS * 32 * 2;
constexpr size_t R_KN = R_Q + (size_t)T * 1536 * 2;
constexpr size_t R_VT = R_KN + (size_t)KROWS * 1024 * 2;
constexpr size_t R_END = R_VT + (size_t)KROWS * 1024 * 2;
constexpr size_t D_Q = 0;
constexpr size_t D_K = D_Q + (size_t)T * 1024 * 2;
constexpr size_t D_VT = D_K + (size_t)KROWS * 1024 * 2;
constexpr size_t D_QI = D_VT + (size_t)KROWS * 1024 * 2;
constexpr size_t D_KIR = D_QI + (size_t)T * 512 * 2;
constexpr size_t D_KI = D_KIR + (size_t)T * 64 * 4;
constexpr size_t D_WI = D_KI + (size_t)KROWS * 64 * 2;
constexpr size_t D_BM = D_WI + (size_t)T * 8 * 4;
constexpr size_t D_AO = D_BM + (size_t)T * 256 * 4;
constexpr size_t D_END = D_AO + (size_t)T * 1024 * 2;
constexpr size_t C_U = 0;
constexpr size_t C_VR = C_U + (size_t)T * 2048 * 2;
constexpr size_t C_VLN = C_VR + (size_t)T * 2048 * 2;
constexpr size_t C_G = C_VLN + (size_t)T * 2048 * 2;
constexpr size_t C_END = C_G + (size_t)T * 2048 * 2;
constexpr size_t OFF_BAR = OFF_R + R_END;
constexpr size_t WS_NEED = OFF_BAR + 16384;
static_assert(D_END <= R_END && C_END <= R_END && (size_t)T * DFF * 2 <= R_END, "region");

constexpr size_t W_MLA = 0;
constexpr size_t WM_D = 0, WM_UQ = 1048576, WM_UKV = WM_UQ + 786432, WM_O = WM_UKV + 524288, WM_SZ = 3407872;
constexpr size_t W_CM = 2 * WM_SZ;
constexpr size_t WC_IN = 0, WC_OUT = 4194304, WC_SZ = 6291456;
constexpr size_t W_DS = W_CM + WC_SZ;
constexpr size_t WD_P = 0, WD_O = 3932160, WD_SZ = 4980736;
constexpr size_t W_FF = W_DS + WD_SZ;
constexpr size_t WF_IN = 0, WF_OUT = 5767168, WF_SZ = 8650752;
constexpr size_t W_TRIL = W_FF + 4 * WF_SZ;
static_assert(W_TRIL + 131072 == W_ELEMS, "w");

constexpr size_t O_YP = 0;
constexpr size_t O_YS = O_YP + (size_t)TP * 1024;
constexpr size_t O_CKVP = O_YS + (size_t)TS * 1024;
constexpr size_t O_KRP = O_CKVP + (size_t)2 * TP * 256;
constexpr size_t O_CKVS = O_KRP + (size_t)2 * TP * 32;
constexpr size_t O_KRS = O_CKVS + (size_t)2 * TS * 256;
constexpr size_t O_CVS = O_KRS + (size_t)2 * TS * 32;
constexpr size_t O_DKP = O_CVS + (size_t)TS * 2048;
constexpr size_t O_DVP = O_DKP + (size_t)TP * 1024;
constexpr size_t O_DIP = O_DVP + (size_t)TP * 1024;
constexpr size_t O_DKS = O_DIP + (size_t)TP * 64;
constexpr size_t O_DVS = O_DKS + (size_t)TS * 1024;
constexpr size_t O_DIS = O_DVS + (size_t)TS * 1024;
constexpr size_t O_END = O_DIS + (size_t)TS * 64;

constexpr int NJOBS = 25;
struct Job { const float* src; bf16_t* dst; int nsrc, k, ndst, mode, tile0, pad; };
struct Params {
  const float* in[31];
  float* out;
  unsigned char* ws;
  Job jobs[NJOBS];
  int total_tiles, ph_lo, ph_hi, pad;
  double inv_freq[16];
};

#define CAS __attribute__((address_space(4)))
typedef const CAS Params CParams;
#define PREF const CAS Params&
DI unsigned pack2(float a, float b) { f32x2v v = {a, b}; bf2v r = __builtin_convertvector(v, bf2v); return __builtin_bit_cast(unsigned, r); }
DI bf16_t tobf(float a) { return (bf16_t)(pack2(a, 0.f) & 0xffffu); }
DI float frombf(bf16_t v) { return __uint_as_float(((unsigned)v) << 16); }
DI float bflo(unsigned u) { return __uint_as_float(u << 16); }
DI float bfhi(unsigned u) { return __uint_as_float(u & 0xffff0000u); }
DI float shflx(float v, int m, int lane) { return __int_as_float(__builtin_amdgcn_ds_bpermute((lane ^ m) << 2, __float_as_int(v))); }
DI float wave_sum(float v, int lane) {
#pragma unroll
  for (int o = 32; o >= 1; o >>= 1) v += shflx(v, o, lane);
  return v;
}
DI int ltid(int wv) { unsigned m1 = ~0u; asm volatile("" : "+s"(m1)); int t = (wv << 6) | (int)__builtin_amdgcn_mbcnt_hi(m1, __builtin_amdgcn_mbcnt_lo(m1, 0u)); asm volatile("" : "+v"(t)); return t; }
DI int crow(int i, int h) { return (i & 3) + 8 * (i >> 2) + 4 * h; }
DI int rowmap(int t) { if (t < TP) return t; int u = t - TP; return TP + (u >> 4) * SPAD + 1024 + (u & 15); }
DI int tokpos(int t) { return t < TP ? (t & 8191) : 1024 + ((t - TP) & 15); }

DI void transpose_tile(const float* __restrict__ src, int src_ld, int ncols, bf16_t* __restrict__ dst, int dst_ld,
                       int n0, int k0, int mode, float* sm, int tid, bool active) {
  const int nl = (tid & 15) * 4, kq = tid >> 4;
  const int n = n0 + nl;
  int c;
  if (mode != 1) c = n < ncols ? n : -1;
  else { int tt = n >> 5, r = n & 31; int f = tt * 16 + (r & 15); c = (r < 16) ? f : DFF + f; }
  int dr[4];
#pragma unroll
  for (int e = 0; e < 4; ++e) { int col = nl + e; dr[e] = (mode == 2) ? ((col & 32) + (col & 1) * 16 + ((col & 31) >> 1)) : col; }
  if (active) {
    float4 v[4];
#pragma unroll
    for (int i = 0; i < 4; ++i) {
      int kk = kq + 16 * i;
      v[i] = (c >= 0) ? *(const float4*)(src + (size_t)(k0 + kk) * src_ld + c) : make_float4(0.f, 0.f, 0.f, 0.f);
    }
#pragma unroll
    for (int i = 0; i < 4; ++i) {
      int kk = kq + 16 * i;
      float* d = sm + kk * 65;
      d[dr[0]] = v[i].x; d[dr[1]] = v[i].y; d[dr[2]] = v[i].z; d[dr[3]] = v[i].w;
    }
  }
  __syncthreads();
  if (active) {
    const int kp = (tid & 31) * 2, nr = tid >> 5;
#pragma unroll 4
    for (int i = 0; i < 8; ++i) {
      int nn = nr + 8 * i;
      float a = sm[kp * 65 + nn], b = sm[(kp + 1) * 65 + nn];
      *(unsigned*)(dst + (size_t)(n0 + nn) * dst_ld + k0 + kp) = pack2(a, b);
    }
  }
  __syncthreads();
}

enum { E_F32 = 0, E_RESID, E_SWIGLU, E_GELU, E_MLAQ, E_MLAKV, E_DSA };
struct EArgs {
  float* f0; float* f1; float* f2; float* f3; float* f4; float* f5; float* f6;
  bf16_t* b0; bf16_t* b1; bf16_t* b2; bf16_t* b3;
  const float* rope;
};
using f32x4v = __attribute__((ext_vector_type(4))) float;
#define LAS __attribute__((address_space(3)))
constexpr int G_HT = 128 * 64;
DI int lds_byte(int r, int c) {
  int st = (r >> 4) * 2 + (c >> 5), rr = r & 15, cc = c & 31, ob = rr * 64 + cc * 2;
  return st * 1024 + (ob ^ (((ob >> 9) & 1) << 5));
}
DI void stage_rc(int b, int& R, int& C) {
  int st = b >> 10, sb = b & 1023, swz = sb ^ (((sb >> 9) & 1) << 5);
  R = (st >> 1) * 16 + (swz >> 6); C = (st & 1) * 32 + ((swz & 63) >> 1);
}

template <int EPI, bool ATOM>
DI void epi16(const EArgs& ea, int row0, int gb, int fr, const f32x4v& v0, const f32x4v& v1) {
  if constexpr (EPI == E_F32) {
#pragma unroll
    for (int j = 0; j < 4; ++j) *(float2*)(ea.f0 + (size_t)(row0 + j) * 1024 + gb + 2 * fr) = make_float2(v0[j], v1[j]);
  } else if constexpr (EPI == E_RESID) {
#pragma unroll
    for (int j = 0; j < 4; ++j) { float* o = ea.f0 + (size_t)(row0 + j) * 1024 + gb + 2 * fr;
      if constexpr (ATOM) { unsafeAtomicAdd(o, v0[j]); unsafeAtomicAdd(o + 1, v1[j]); }
      else { float2 x = *(float2*)o; x.x += v0[j]; x.y += v1[j]; *(float2*)o = x; } }
  } else if constexpr (EPI == E_SWIGLU) {
    const int f = (gb >> 1) + fr;
#pragma unroll
    for (int j = 0; j < 4; ++j) { float g = v0[j], u = v1[j]; ea.b0[(size_t)(row0 + j) * DFF + f] = tobf(g / (1.f + __expf(-g)) * u); }
  } else if constexpr (EPI == E_GELU) {
    bf16_t* dstp = (gb < 2048) ? (ea.b0 + gb + 2 * fr) : (ea.b1 + (gb - 2048) + 2 * fr);
#pragma unroll
    for (int j = 0; j < 4; ++j) {
      float x = v0[j], y = v1[j];
      *(unsigned*)(dstp + (size_t)(row0 + j) * 2048) = pack2(0.5f * x * (1.f + erff(x * 0.70710678118654752f)), 0.5f * y * (1.f + erff(y * 0.70710678118654752f)));
    }
  } else if constexpr (EPI == E_MLAQ) {
    const float qs = 0.10206207261596577f * LOG2E;
    const bool is_rope = (gb % 96) == 64;
#pragma unroll
    for (int j = 0; j < 4; ++j) {
      const int row = row0 + j;
      float o0 = v0[j], o1 = v1[j];
      if (is_rope) {
        float2 cs = *(const float2*)(ea.rope + ((size_t)tokpos(row) * 16 + fr) * 2);
        o0 = v0[j] * cs.x - v1[j] * cs.y; o1 = v0[j] * cs.y + v1[j] * cs.x;
      }
      bf16_t* o = ea.b0 + (size_t)row * 1536 + gb + fr;
      o[0] = tobf(o0 * qs); o[16] = tobf(o1 * qs);
    }
  } else if constexpr (EPI == E_MLAKV) {
    const int head = gb >> 7, c0 = gb & 127;
    if (c0 < 64) {
#pragma unroll
      for (int j = 0; j < 4; ++j) *(unsigned*)(ea.b0 + (size_t)(row0 + j) * 1024 + head * 64 + c0 + 2 * fr) = pack2(v0[j], v1[j]);
    } else {
      const int d = c0 - 64 + 2 * fr;
      size_t off, dstr;
      if (row0 < TP) { int b = row0 >> 13, s = row0 & 8191; off = ((size_t)((b * 16 + head) * 64 + d)) * 8192 + s; dstr = 8192; }
      else { int u = row0 - TP; int b = u / SPAD, s = u - b * SPAD; off = (size_t)TP * 1024 + ((size_t)((b * 16 + head) * 64 + d)) * SPAD + s; dstr = SPAD; }
      uint2 pk; pk.x = pack2(v0[0], v0[1]); pk.y = pack2(v0[2], v0[3]); *(uint2*)(ea.b1 + off) = pk;
      pk.x = pack2(v1[0], v1[1]); pk.y = pack2(v1[2], v1[3]); *(uint2*)(ea.b1 + off + dstr) = pk;
    }
  } else if constexpr (EPI == E_DSA) {
    if (gb < 1024) {
      const float qs = 0.125f * LOG2E;
#pragma unroll
      for (int j = 0; j < 4; ++j) *(unsigned*)(ea.b0 + (size_t)(row0 + j) * 1024 + gb + 2 * fr) = pack2(v0[j] * qs, v1[j] * qs);
    } else if (gb < 2048) {
      const int c = gb - 1024 + 2 * fr;
#pragma unroll
      for (int j = 0; j < 4; ++j) {
        const int row = row0 + j;
        float* o = (row < TP) ? ea.f0 + (size_t)row * 1024 + c : ea.f1 + (size_t)(row - TP) * 1024 + c;
        *(float2*)o = make_float2(v0[j], v1[j]);
        *(unsigned*)(ea.b1 + (size_t)rowmap(row) * 1024 + c) = pack2(v0[j], v1[j]);
      }
    } else if (gb < 3072) {
      const int c = gb - 2048 + 2 * fr, head = c >> 6, d = c & 63;
#pragma unroll
      for (int j = 0; j < 4; ++j) {
        const int row = row0 + j;
        float* o = (row < TP) ? ea.f2 + (size_t)row * 1024 + c : ea.f3 + (size_t)(row - TP) * 1024 + c;
        *(float2*)o = make_float2(v0[j], v1[j]);
      }
      size_t off, dstr;
      if (row0 < TP) { int b = row0 >> 13, s = row0 & 8191; off = ((size_t)((b * 16 + head) * 64 + d)) * 8192 + s; dstr = 8192; }
      else { int u = row0 - TP; int b = u >> 4, s = 1024 + (u & 15); off = (size_t)TP * 1024 + ((size_t)((b * 16 + head) * 64 + d)) * SPAD + s; dstr = SPAD; }
      uint2 pk; pk.x = pack2(v0[0], v0[1]); pk.y = pack2(v0[2], v0[3]); *(uint2*)(ea.b2 + off) = pk;
      pk.x = pack2(v1[0], v1[1]); pk.y = pack2(v1[2], v1[3]); *(uint2*)(ea.b2 + off + dstr) = pk;
    } else if (gb < 3584) {
      const int c = gb - 3072 + 2 * fr;
#pragma unroll
      for (int j = 0; j < 4; ++j) *(unsigned*)(ea.b3 + (size_t)(row0 + j) * 512 + c) = pack2(v0[j] * 0.125f, v1[j] * 0.125f);
    } else if (gb < 3648) {
      const int c = gb - 3584 + 2 * fr;
#pragma unroll
      for (int j = 0; j < 4; ++j) *(float2*)(ea.f4 + (size_t)(row0 + j) * 64 + c) = make_float2(v0[j], v1[j]);
    } else if (gb == 3648) {
      if (fr < 4) {
#pragma unroll
        for (int j = 0; j < 4; ++j) *(float2*)(ea.f5 + (size_t)(row0 + j) * 8 + 2 * fr) = make_float2(v0[j] * 0.35355339059327379f, v1[j] * 0.35355339059327379f);
      }
    }
  }
}

template <int EPI, bool ATOM>
DI void gemm256_tile(const bf16_t* __restrict__ A, const bf16_t* __restrict__ Bt, const int K, const int kt0, const int nt, const int brow, const int bcol,
                     const EArgs& ea, unsigned char* smem, int wv) {
  bf16_t* shm = (bf16_t*)smem;
  const int tid = ltid(wv);
#define SA(b, h) (shm + ((b) * 2 + (h)) * G_HT)
#define SB(b, h) (shm + (4 + (b) * 2 + (h)) * G_HT)
#define STAGE(P, BASE, br, kt) do { const char* _gb = (const char*)((BASE) + (long)(br) * K + (long)((kt) + kt0) * 64); \
    __builtin_amdgcn_global_load_lds((const unsigned*)(_gb + voff0), (LAS unsigned*)((char*)(P) + tid * 16), 16, 0, 0); \
    __builtin_amdgcn_global_load_lds((const unsigned*)(_gb + voff1), (LAS unsigned*)((char*)(P) + tid * 16 + 8192), 16, 0, 0); } while (0)
#define LDA(dst, b, h) _Pragma("unroll") for (int m = 0; m < 4; ++m) _Pragma("unroll") for (int k = 0; k < 2; ++k) \
    dst[m][k] = *reinterpret_cast<const bf16x8*>((char*)SA(b, h) + lds_byte(wr * 64 + m * 16 + fr, k * 32 + fq * 8))
#define LDB(dst, b, h) _Pragma("unroll") for (int n = 0; n < 2; ++n) _Pragma("unroll") for (int k = 0; k < 2; ++k) \
    dst[n][k] = *reinterpret_cast<const bf16x8*>((char*)SB(b, h) + lds_byte(wc * 32 + n * 16 + fr, k * 32 + fq * 8))
#define MMA(ai, bj, At_, Bt_) do { __builtin_amdgcn_s_setprio(1); \
    _Pragma("unroll") for (int m = 0; m < 4; ++m) _Pragma("unroll") for (int n = 0; n < 2; ++n) _Pragma("unroll") for (int k = 0; k < 2; ++k) \
      acc[ai][bj][m][n] = __builtin_amdgcn_mfma_f32_16x16x32_bf16(At_[m][k], Bt_[n][k], acc[ai][bj][m][n], 0, 0, 0); \
    __builtin_amdgcn_s_setprio(0); } while (0)
#define WAIT_V(n) asm volatile("s_waitcnt vmcnt(" #n ")" ::: "memory")
#define WAIT_L(n) asm volatile("s_waitcnt lgkmcnt(" #n ")" ::: "memory")
#define BAR __builtin_amdgcn_s_barrier()
#define SCHED __builtin_amdgcn_sched_barrier(0)
  const int wid = tid >> 6, lane = tid & 63, wr = wid >> 2, wc = wid & 3, fr = lane & 15, fq = lane >> 4;
  unsigned voff0, voff1;
  { int r_, c_; stage_rc(tid * 16, r_, c_); voff0 = (unsigned)(r_ * K + c_) * 2u; stage_rc(tid * 16 + 8192, r_, c_); voff1 = (unsigned)(r_ * K + c_) * 2u; }
  f32x4v acc[2][2][4][2];
#pragma unroll
  for (int a = 0; a < 2; ++a)
#pragma unroll
    for (int b = 0; b < 2; ++b)
#pragma unroll
      for (int m = 0; m < 4; ++m)
#pragma unroll
        for (int n = 0; n < 2; ++n) acc[a][b][m][n] = (f32x4v){0.f, 0.f, 0.f, 0.f};
  bf16x8 At[4][2], B0[2][2], B1[2][2];
  const int HALF = 128;
  WAIT_V(0); WAIT_L(0); BAR;
  STAGE(SB(0, 0), Bt, bcol, 0); STAGE(SA(0, 0), A, brow, 0);
  STAGE(SB(0, 1), Bt, bcol + HALF, 0); STAGE(SA(0, 1), A, brow + HALF, 0);
  if (wr == 1) BAR;
  WAIT_V(4); BAR;
  STAGE(SB(1, 0), Bt, bcol, 1); STAGE(SA(1, 0), A, brow, 1); STAGE(SB(1, 1), Bt, bcol + HALF, 1);
  WAIT_V(6); BAR;
  for (int t = 0; t < nt - 2; t += 2) {
    LDB(B0, 0, 0); SCHED; LDA(At, 0, 0); STAGE(SA(1, 1), A, brow + HALF, t + 1);
    WAIT_L(8); BAR; WAIT_L(0); MMA(0, 0, At, B0); BAR; SCHED;
    LDB(B1, 0, 1); STAGE(SB(0, 0), Bt, bcol, t + 2);
    BAR; WAIT_L(0); MMA(0, 1, At, B1); BAR;
    LDA(At, 0, 1); STAGE(SA(0, 0), A, brow, t + 2);
    BAR; WAIT_L(0); MMA(1, 0, At, B0); BAR; SCHED;
    STAGE(SB(0, 1), Bt, bcol + HALF, t + 2);
    WAIT_V(6); BAR; MMA(1, 1, At, B1); BAR;
    LDB(B0, 1, 0); SCHED; LDA(At, 1, 0); STAGE(SA(0, 1), A, brow + HALF, t + 2);
    WAIT_L(8); BAR; WAIT_L(0); MMA(0, 0, At, B0); BAR; SCHED;
    LDB(B1, 1, 1); STAGE(SB(1, 0), Bt, bcol, t + 3);
    BAR; WAIT_L(0); MMA(0, 1, At, B1); BAR;
    LDA(At, 1, 1); STAGE(SA(1, 0), A, brow, t + 3);
    BAR; WAIT_L(0); MMA(1, 0, At, B0); BAR; SCHED;
    STAGE(SB(1, 1), Bt, bcol + HALF, t + 3);
    WAIT_V(6); BAR; MMA(1, 1, At, B1); BAR;
  }
  { LDB(B0, 0, 0); LDA(At, 0, 0); STAGE(SA(1, 1), A, brow + HALF, nt - 1);
    BAR; WAIT_L(0); MMA(0, 0, At, B0); BAR;
    LDB(B1, 0, 1); BAR; WAIT_L(0); MMA(0, 1, At, B1); BAR;
    LDA(At, 0, 1); WAIT_V(4); BAR; WAIT_L(0); MMA(1, 0, At, B0); MMA(1, 1, At, B1); BAR; }
  { LDB(B0, 1, 0); LDA(At, 1, 0); WAIT_V(2); BAR; WAIT_L(0); MMA(0, 0, At, B0); BAR;
    LDB(B1, 1, 1); WAIT_V(0); BAR; WAIT_L(0); MMA(0, 1, At, B1); BAR;
    LDA(At, 1, 1); BAR; WAIT_L(0); MMA(1, 0, At, B0); MMA(1, 1, At, B1); BAR; }
  if (wr == 0) BAR;
#pragma unroll
  for (int ai = 0; ai < 2; ++ai)
#pragma unroll
    for (int bj = 0; bj < 2; ++bj)
#pragma unroll
      for (int m = 0; m < 4; ++m)
      { epi16<EPI, ATOM>(ea, brow + ai * 128 + wr * 64 + m * 16 + fq * 4, bcol + bj * 128 + wc * 32, fr, acc[ai][bj][m][0], acc[ai][bj][m][1]); __builtin_amdgcn_sched_barrier(0); }
#undef SA
#undef SB
#undef STAGE
#undef LDA
#undef LDB
#undef MMA
#undef WAIT_V
#undef WAIT_L
#undef BAR
#undef SCHED
}

DI void tile_map(int t, int nM, int nN, int nwg, int& pm, int& pn) {
  int wgid = t;
  { int q = nwg >> 3, r = nwg & 7, xcd = wgid & 7, off = wgid >> 3; wgid = (xcd < r ? xcd * (q + 1) : r * (q + 1) + (xcd - r) * q) + off; }
  const int nig = 8 * nN, gid = wgid / nig, fm = gid * 8, gsz = min(nM - fm, 8);
  pm = fm + ((wgid % nig) % gsz); pn = (wgid % nig) / gsz;
}
template <int EPI>
DI void gemm_phase(const bf16_t* A, const bf16_t* Bt, int M, int N, int K, const EArgs& ea,
                   unsigned char* smem, int tstart, int bid, int nblk, int wv) {
  const int nM = M >> 8, nN = N >> 8, nwg = nM * nN, nt = K >> 6;
  if constexpr (EPI == E_RESID) {
    const int nfull = (nwg / nblk) * nblk, rem = nwg - nfull;
    for (int t = bid; t < nfull; t += nblk) {
      int pm, pn; tile_map(t, nM, nN, nwg, pm, pn);
      gemm256_tile<EPI, false>(A, Bt, K, 0, nt, pm * 256, pn * 256, ea, smem, wv);
    }
    if (rem > 0) {
      int ns = nblk / rem; if (ns > (nt >> 3)) ns = nt >> 3; if (ns < 1) ns = 1;
      const int per = ((nt / ns) >> 1) << 1;
      for (int u = bid; u < rem * ns; u += nblk) {
        const int t = nfull + u / ns, ks = u % ns;
        const int k0 = ks * per, kn = (ks == ns - 1) ? (nt - k0) : per;
        int pm, pn; tile_map(t, nM, nN, nwg, pm, pn);
        gemm256_tile<EPI, true>(A, Bt, K, k0, kn, pm * 256, pn * 256, ea, smem, wv);
      }
    }
  } else {
    int t0 = bid - (tstart % nblk); if (t0 < 0) t0 += nblk;
    for (int t = t0; t < nwg; t += nblk) {
      int pm, pn; tile_map(t, nM, nN, nwg, pm, pn);
      gemm256_tile<EPI, false>(A, Bt, K, 0, nt, pm * 256, pn * 256, ea, smem, wv);
    }
  }
}

DI void rmsnorm_rows(const float* __restrict__ X, const float* __restrict__ g, bf16_t* __restrict__ H, float* outp, float* outs,
                     int bid, int nblk, int wv) {
  const int lane = ltid(wv) & 63, w = ltid(wv) >> 6;
  for (int row = bid * 8 + w; row < T; row += nblk * 8) {
    const float* xr = X + (size_t)row * 1024;
    float4 v[4];
    float ss = 0.f;
#pragma unroll
    for (int c = 0; c < 4; ++c) { v[c] = *(const float4*)(xr + c * 256 + lane * 4); ss += v[c].x * v[c].x + v[c].y * v[c].y + v[c].z * v[c].z + v[c].w * v[c].w; }
    ss = wave_sum(ss, lane);
    float r = rsqrtf(ss * (1.f / 1024.f) + EPS);
#pragma unroll
    for (int c = 0; c < 4; ++c) {
      int col = c * 256 + lane * 4;
      float4 gg = *(const float4*)(g + col);
      float a = v[c].x * r * gg.x, b = v[c].y * r * gg.y, cc = v[c].z * r * gg.z, d = v[c].w * r * gg.w;
      if (H) { uint2 pk; pk.x = pack2(a, b); pk.y = pack2(cc, d); *(uint2*)(H + (size_t)row * 1024 + col) = pk; }
      else {
        float* o = (row < TP) ? outp + (size_t)row * 1024 + col : outs + (size_t)(row - TP) * 1024 + col;
        *(float4*)o = make_float4(a, b, cc, d);
      }
    }
  }
}

DI void mla_rowops(PREF p, int j, int bid, int nblk, int wv) {
  const int lane = ltid(wv) & 63, w = ltid(wv) >> 6;
  unsigned char* R = p.ws + OFF_R;
  const float* RAW = (const float*)(R + R_RAW);
  bf16_t* CQ = (bf16_t*)(R + R_CQ); bf16_t* CKV = (bf16_t*)(R + R_CKV); bf16_t* KR = (bf16_t*)(R + R_KR);
  const float* gq = p.in[11] + j * 512; const float* gkv = p.in[14] + j * 256;
  const float* rope = (const float*)(p.ws + OFF_ROPE);
  for (int row = bid * 8 + w; row < T; row += nblk * 8) {
    const float* rr = RAW + (size_t)row * 1024;
    float4 a0 = *(const float4*)(rr + lane * 4), a1 = *(const float4*)(rr + 256 + lane * 4);
    float4 c0 = *(const float4*)(rr + 512 + lane * 4);
    float ss = a0.x * a0.x + a0.y * a0.y + a0.z * a0.z + a0.w * a0.w + a1.x * a1.x + a1.y * a1.y + a1.z * a1.z + a1.w * a1.w;
    float s2 = c0.x * c0.x + c0.y * c0.y + c0.z * c0.z + c0.w * c0.w;
    ss = wave_sum(ss, lane); s2 = wave_sum(s2, lane);
    float r1 = rsqrtf(ss * (1.f / 512.f) + EPS), r2 = rsqrtf(s2 * (1.f / 256.f) + EPS);
    {
      float4 g0 = *(const float4*)(gq + lane * 4), g1 = *(const float4*)(gq + 256 + lane * 4);
      uint2 pk; pk.x = pack2(a0.x * r1 * g0.x, a0.y * r1 * g0.y); pk.y = pack2(a0.z * r1 * g0.z, a0.w * r1 * g0.w);
      *(uint2*)(CQ + (size_t)row * 512 + lane * 4) = pk;
      pk.x = pack2(a1.x * r1 * g1.x, a1.y * r1 * g1.y); pk.y = pack2(a1.z * r1 * g1.z, a1.w * r1 * g1.w);
      *(uint2*)(CQ + (size_t)row * 512 + 256 + lane * 4) = pk;
    }
    const int rm = rowmap(row);
    {
      float4 g = *(const float4*)(gkv + lane * 4);
      float4 o = make_float4(c0.x * r2 * g.x, c0.y * r2 * g.y, c0.z * r2 * g.z, c0.w * r2 * g.w);
      float* op = (row < TP) ? p.out + O_CKVP + ((size_t)j * TP + row) * 256 : p.out + O_CKVS + ((size_t)j * TS + (row - TP)) * 256;
      *(float4*)(op + lane * 4) = o;
      uint2 pk; pk.x = pack2(o.x, o.y); pk.y = pack2(o.z, o.w);
      *(uint2*)(CKV + (size_t)rm * 256 + lane * 4) = pk;
    }
    if (lane < 16) {
      float x1 = rr[768 + lane], x2 = rr[784 + lane];
      int pos = tokpos(row);
      float2 cs = *(const float2*)(rope + ((size_t)pos * 16 + lane) * 2);
      float o1 = x1 * cs.x - x2 * cs.y, o2 = x1 * cs.y + x2 * cs.x;
      float* op = (row < TP) ? p.out + O_KRP + ((size_t)j * TP + row) * 32 : p.out + O_KRS + ((size_t)j * TS + (row - TP)) * 32;
      op[lane] = o1; op[16 + lane] = o2;
      KR[(size_t)rm * 32 + lane] = tobf(o1); KR[(size_t)rm * 32 + 16 + lane] = tobf(o2);
    }
  }
}

DI void dsa_rowops(PREF p, int bid, int nblk, int wv) {
  const int lane = ltid(wv) & 63, w = ltid(wv) >> 6;
  unsigned char* R = p.ws + OFF_R;
  const float* KIR = (const float*)(R + D_KIR);
  bf16_t* KI = (bf16_t*)(R + D_KI);
  const float* g = p.in[27];
  for (int row = bid * 8 + w; row < T; row += nblk * 8) {
    float v = KIR[(size_t)row * 64 + lane];
    float ss = wave_sum(v * v, lane);
    float r = rsqrtf(ss * (1.f / 64.f) + EPS);
    float o = v * r * g[lane];
    if (row < TP) p.out[O_DIP + (size_t)row * 64 + lane] = o; else p.out[O_DIS + (size_t)(row - TP) * 64 + lane] = o;
    KI[(size_t)rowmap(row) * 64 + lane] = tobf(o);
  }
}

DI void cmlp_ln_rows(PREF p, int bid, int nblk, int wv) {
  const int lane = ltid(wv) & 63, w = ltid(wv) >> 6;
  unsigned char* R = p.ws + OFF_R;
  const bf16_t* VR = (const bf16_t*)(R + C_VR);
  bf16_t* VLN = (bf16_t*)(R + C_VLN);
  const float* g = p.in[18]; const float* bb = p.in[19];
  for (int row = bid * 8 + w; row < T; row += nblk * 8) {
    float x[32];
    float sum = 0.f;
#pragma unroll
    for (int c = 0; c < 4; ++c) {
      uint4 u = *(const uint4*)(VR + (size_t)row * 2048 + c * 512 + lane * 8);
      x[c * 8 + 0] = bflo(u.x); x[c * 8 + 1] = bfhi(u.x); x[c * 8 + 2] = bflo(u.y); x[c * 8 + 3] = bfhi(u.y);
      x[c * 8 + 4] = bflo(u.z); x[c * 8 + 5] = bfhi(u.z); x[c * 8 + 6] = bflo(u.w); x[c * 8 + 7] = bfhi(u.w);
    }
#pragma unroll
    for (int i = 0; i < 32; ++i) sum += x[i];
    sum = wave_sum(sum, lane);
    float mu = sum * (1.f / 2048.f);
    float vs = 0.f;
#pragma unroll
    for (int i = 0; i < 32; ++i) { x[i] -= mu; vs += x[i] * x[i]; }
    vs = wave_sum(vs, lane);
    float r = rsqrtf(vs * (1.f / 2048.f) + EPS);
#pragma unroll
    for (int c = 0; c < 4; ++c) {
      int col = c * 512 + lane * 8;
      float y[8];
#pragma unroll
      for (int q = 0; q < 2; ++q) {
        float4 gg = *(const float4*)(g + col + q * 4), b4 = *(const float4*)(bb + col + q * 4);
        y[q * 4 + 0] = x[c * 8 + q * 4 + 0] * r * gg.x + b4.x; y[q * 4 + 1] = x[c * 8 + q * 4 + 1] * r * gg.y + b4.y;
        y[q * 4 + 2] = x[c * 8 + q * 4 + 2] * r * gg.z + b4.z; y[q * 4 + 3] = x[c * 8 + q * 4 + 3] * r * gg.w + b4.w;
      }
      uint4 pk; pk.x = pack2(y[0], y[1]); pk.y = pack2(y[2], y[3]); pk.z = pack2(y[4], y[5]); pk.w = pack2(y[6], y[7]);
      *(uint4*)(VLN + (size_t)row * 2048 + col) = pk;
      if (row >= TP) {
        float* o = p.out + O_CVS + (size_t)(row - TP) * 2048 + col;
        *(float4*)o = make_float4(y[0], y[1], y[2], y[3]); *(float4*)(o + 4) = make_float4(y[4], y[5], y[6], y[7]);
      }
    }
  }
}

DI void cmlp_mix_phase(PREF p, unsigned char* smem, int bid, int nblk, int wv) {
  const int tid = ltid(wv), lane = tid & 63, w = tid >> 6, wm = w >> 2, wn = w & 3, lr = lane & 31, lh = lane >> 5;
  unsigned char* R = p.ws + OFF_R;
  const bf16_t* U = (const bf16_t*)(R + C_U);
  const bf16_t* VLN = (const bf16_t*)(R + C_VLN);
  bf16_t* G = (bf16_t*)(R + C_G);
  const bf16_t* WT = (const bf16_t*)(p.ws + OFF_W) + W_TRIL;
  const float* bs = p.in[21];
  bf16_t* As = (bf16_t*)smem;
  bf16_t* Bs = As + 128 * 136;
  for (int u = bid; u < 1024; u += nblk) {
    const int g = u & 7, ch = u >> 3;
    const int col0 = g * 256;
#pragma unroll 2
    for (int i = 0; i < 4; ++i) {
      int v = tid + i * NT; int r = v >> 4, c = (v & 15) * 8;
      *(uint4*)(As + r * 136 + c) = *(const uint4*)(WT + ((size_t)g * 128 + r) * 128 + c);
    }
#pragma unroll 2
    for (int i = 0; i < 8; ++i) {
      int v = tid + i * NT; int s = v >> 5, c = (v & 31) * 8;
      uint4 x = *(const uint4*)(VLN + ((size_t)ch * 128 + s) * 2048 + col0 + c);
      Bs[(c + 0) * 136 + s] = (bf16_t)(x.x & 0xffff); Bs[(c + 1) * 136 + s] = (bf16_t)(x.x >> 16);
      Bs[(c + 2) * 136 + s] = (bf16_t)(x.y & 0xffff); Bs[(c + 3) * 136 + s] = (bf16_t)(x.y >> 16);
      Bs[(c + 4) * 136 + s] = (bf16_t)(x.z & 0xffff); Bs[(c + 5) * 136 + s] = (bf16_t)(x.z >> 16);
      Bs[(c + 6) * 136 + s] = (bf16_t)(x.w & 0xffff); Bs[(c + 7) * 136 + s] = (bf16_t)(x.w >> 16);
    }
    __syncthreads();
    f32x16 acc[2][2];
#pragma unroll
    for (int a = 0; a < 2; ++a)
#pragma unroll
      for (int b = 0; b < 2; ++b)
#pragma unroll
        for (int i = 0; i < 16; ++i) acc[a][b][i] = 0.f;
    const bf16_t* Asb = As + (wm * 64 + lr) * 136 + lh * 8;
    const bf16_t* Bsb = Bs + (wn * 64 + lr) * 136 + lh * 8;
    const int ns = (wm + 1) * 4;
    for (int s = 0; s < ns; ++s) {
      bf16x8 a0 = *(const bf16x8*)(Asb + s * 16);
      bf16x8 a1 = *(const bf16x8*)(Asb + 32 * 136 + s * 16);
      bf16x8 b0 = *(const bf16x8*)(Bsb + s * 16);
      bf16x8 b1 = *(const bf16x8*)(Bsb + 32 * 136 + s * 16);
      acc[0][0] = MFMA32(a0, b0, acc[0][0]);
      acc[0][1] = MFMA32(a0, b1, acc[0][1]);
      acc[1][0] = MFMA32(a1, b0, acc[1][0]);
      acc[1][1] = MFMA32(a1, b1, acc[1][1]);
    }
#pragma unroll
    for (int mi = 0; mi < 2; ++mi)
#pragma unroll
      for (int ni = 0; ni < 2; ++ni)
#pragma unroll
        for (int i = 0; i < 16; ++i) {
          int t = wm * 64 + mi * 32 + crow(i, lh);
          int col = col0 + wn * 64 + ni * 32 + lr;
          size_t off = ((size_t)ch * 128 + t) * 2048 + col;
          float mixed = acc[mi][ni][i] + bs[g * 128 + t];
          G[off] = tobf(frombf(U[off]) * mixed);
        }
    __syncthreads();
  }
  const float* wsf = p.in[20];
  for (int e = bid * NT + tid; e < TS * 2048; e += nblk * NT) {
    int row = e >> 11, col = e & 2047, b = row >> 4, t = row & 15, g = col >> 8;
    float a = bs[g * 128 + t];
    for (int s = 0; s <= t; ++s) a += wsf[((size_t)g * 128 + t) * 128 + s] * frombf(VLN[((size_t)TP + b * 16 + s) * 2048 + col]);
    size_t off = ((size_t)TP + row) * 2048 + col;
    G[off] = tobf(frombf(U[off]) * a);
  }
}

template <int DQK, bool IS_MLA, bool MASKED>
DI void attn8_unit(const bf16_t* __restrict__ Qp, int ldq, int nq,
                   const bf16_t* __restrict__ Kp, int ldk, const bf16_t* __restrict__ KRp,
                   const bf16_t* __restrict__ Vtp, int ldv, int kmax,
                   int nit, int nk64_w, int nkeys, const unsigned* __restrict__ BMp,
                   bf16_t* __restrict__ AOp, unsigned char* smem, int wv) {
  constexpr int KS = DQK + 8;
  constexpr int VS = 132;
  constexpr int NQS = DQK / 16;
  const int tid = ltid(wv), lane = tid & 63, w = tid >> 6, lr = lane & 31, lh = lane >> 5;
  bf16_t* Ks = (bf16_t*)smem;
  bf16_t* Vs = Ks + 2 * 128 * KS;
  const bool q_ok = (w * 32 + lr) < nq;
  const int qrow = q_ok ? (w * 32 + lr) : 0;
  bf16x8 qf[NQS];
#pragma unroll
  for (int s = 0; s < NQS; ++s) qf[s] = *(const bf16x8*)(Qp + (size_t)qrow * ldq + s * 16 + lh * 8);
  f32x16 oacc[2];
#pragma unroll
  for (int d = 0; d < 2; ++d)
#pragma unroll
    for (int i = 0; i < 16; ++i) oacc[d][i] = 0.f;
  float m_run = -INFINITY, l_run = 0.f;
  const int kkey = tid >> 3, kc = (tid & 7) * 8;
  const int rkey = tid >> 2, rc = (tid & 3) * 8;
  const int vd = tid >> 4, vk = (tid & 15) * 8;
  uint4 rk0, rk1, rr, rv0, rv1;
  rr = make_uint4(0, 0, 0, 0);
  uint4 bm_next = make_uint4(0xffffffffu, 0xffffffffu, 0xffffffffu, 0xffffffffu), bm_cur = bm_next;
#define GLOAD(it_) do { const int key0_ = (it_) * 128; \
    { int kr_ = min(key0_ + kkey, kmax - 1); rk0 = *(const uint4*)(Kp + (size_t)kr_ * ldk + kc); } \
    { int kr_ = min(key0_ + kkey + 64, kmax - 1); rk1 = *(const uint4*)(Kp + (size_t)kr_ * ldk + kc); } \
    if constexpr (IS_MLA) { int kr_ = min(key0_ + rkey, kmax - 1); rr = *(const uint4*)(KRp + (size_t)kr_ * 32 + rc); } \
    { int kv_ = min(key0_ + vk, kmax - 8); rv0 = *(const uint4*)(Vtp + (size_t)vd * ldv + kv_); rv1 = *(const uint4*)(Vtp + (size_t)(vd + 32) * ldv + kv_); } \
    if constexpr (MASKED) { if (BMp) bm_next = *(const uint4*)(BMp + (size_t)qrow * 256 + (it_) * 4); } } while (0)
#define SSTORE(buf_) do { bf16_t* Kb_ = Ks + (buf_) * 128 * KS; bf16_t* Vb_ = Vs + (buf_) * 64 * VS; \
    *(uint4*)(Kb_ + kkey * KS + kc) = rk0; *(uint4*)(Kb_ + (kkey + 64) * KS + kc) = rk1; \
    if constexpr (IS_MLA) *(uint4*)(Kb_ + rkey * KS + 64 + rc) = rr; \
    *(uint2*)(Vb_ + vd * VS + vk) = make_uint2(rv0.x, rv0.y); *(uint2*)(Vb_ + vd * VS + vk + 4) = make_uint2(rv0.z, rv0.w); \
    *(uint2*)(Vb_ + (vd + 32) * VS + vk) = make_uint2(rv1.x, rv1.y); *(uint2*)(Vb_ + (vd + 32) * VS + vk + 4) = make_uint2(rv1.z, rv1.w); } while (0)
  const int nit_w = (nk64_w + 1) >> 1;
  __syncthreads();
  GLOAD(0); SSTORE(0); bm_cur = bm_next;
  __syncthreads();
  for (int it = 0; it < nit; ++it) {
    const int buf = it & 1;
    if (it + 1 < nit) GLOAD(it + 1);
    if (it < nit_w) {
      const bf16_t* Kb = Ks + buf * 128 * KS; const bf16_t* Vb = Vs + buf * 64 * VS;
      f32x16 sacc[4];
#pragma unroll
      for (int t4 = 0; t4 < 4; ++t4) {
#pragma unroll
        for (int i = 0; i < 16; ++i) sacc[t4][i] = 0.f;
#pragma unroll
        for (int s = 0; s < NQS; ++s) {
          bf16x8 kf = *(const bf16x8*)(Kb + (t4 * 32 + lr) * KS + s * 16 + lh * 8);
          sacc[t4] = MFMA32(kf, qf[s], sacc[t4]);
        }
      }
      if ((2 * it + 1) >= nk64_w) {
#pragma unroll
        for (int t4 = 2; t4 < 4; ++t4)
#pragma unroll
          for (int i = 0; i < 16; ++i) sacc[t4][i] = -INFINITY;
      }
      float mx = -INFINITY;
#pragma unroll
      for (int t4 = 0; t4 < 4; ++t4) {
        const unsigned wbits = (t4 == 0) ? bm_cur.x : (t4 == 1) ? bm_cur.y : (t4 == 2) ? bm_cur.z : bm_cur.w;
#pragma unroll
        for (int i = 0; i < 16; ++i) {
          if constexpr (MASKED) {
            const int kin = crow(i, lh);
            const int key = it * 128 + t4 * 32 + kin;
            bool ok = (key < nkeys) && ((wbits >> kin) & 1u);
            sacc[t4][i] = ok ? sacc[t4][i] : -INFINITY;
          }
          mx = fmaxf(mx, sacc[t4][i]);
        }
      }
      mx = fmaxf(mx, shflx(mx, 32, lane));
      const float m_new = fmaxf(m_run, mx);
      const float m_safe = (m_new == -INFINITY) ? 0.f : m_new;
      const float alpha = __builtin_amdgcn_exp2f(m_run - m_safe);
      m_run = m_new;
      float ls = 0.f;
#pragma unroll
      for (int t4 = 0; t4 < 4; ++t4)
#pragma unroll
        for (int i = 0; i < 16; ++i) { float pv = __builtin_amdgcn_exp2f(sacc[t4][i] - m_safe); sacc[t4][i] = pv; ls += pv; }
      l_run = l_run * alpha + ls;
#pragma unroll
      for (int d = 0; d < 2; ++d)
#pragma unroll
        for (int i = 0; i < 16; ++i) oacc[d][i] *= alpha;
#pragma unroll
      for (int t4 = 0; t4 < 4; ++t4)
#pragma unroll
        for (int s = 0; s < 2; ++s) {
          uint4 pp;
          pp.x = pack2(sacc[t4][8 * s + 0], sacc[t4][8 * s + 1]);
          pp.y = pack2(sacc[t4][8 * s + 2], sacc[t4][8 * s + 3]);
          pp.z = pack2(sacc[t4][8 * s + 4], sacc[t4][8 * s + 5]);
          pp.w = pack2(sacc[t4][8 * s + 6], sacc[t4][8 * s + 7]);
          bf16x8 pf = __builtin_bit_cast(bf16x8, pp);
#pragma unroll
          for (int dt = 0; dt < 2; ++dt) {
            const bf16_t* vrow = Vb + (dt * 32 + lr) * VS + t4 * 32 + 16 * s + 4 * lh;
            uint2 lo = *(const uint2*)(vrow), hi = *(const uint2*)(vrow + 8);
            uint4 vv = make_uint4(lo.x, lo.y, hi.x, hi.y);
            bf16x8 vf = __builtin_bit_cast(bf16x8, vv);
            oacc[dt] = MFMA32(vf, pf, oacc[dt]);
          }
        }
    }
    if (it + 1 < nit) { SSTORE(buf ^ 1); bm_cur = bm_next; }
    __syncthreads();
  }
  if (nit_w > 0) {
    float lt = l_run + shflx(l_run, 32, lane);
    float inv = lt > 0.f ? 1.f / lt : 0.f;
    if (q_ok) {
      bf16_t* orow = AOp + (size_t)(w * 32 + lr) * 1024;
#pragma unroll
      for (int dt = 0; dt < 2; ++dt)
#pragma unroll
        for (int g = 0; g < 4; ++g) {
          uint2 pk;
          pk.x = pack2(oacc[dt][4 * g] * inv, oacc[dt][4 * g + 1] * inv);
          pk.y = pack2(oacc[dt][4 * g + 2] * inv, oacc[dt][4 * g + 3] * inv);
          *(uint2*)(orow + dt * 32 + 8 * g + 4 * lh) = pk;
        }
    }
  }
}
#undef GLOAD
#undef SSTORE

DI int snake_idx(int i, int bid, int nblk) { return i * nblk + ((i & 1) ? (nblk - 1 - bid) : bid); }

template <bool IS_MLA>
DI void attn_phase(PREF p, unsigned char* smem, int bid, int nblk, int wv) {
  unsigned char* R = p.ws + OFF_R;
  const int w = ltid(wv) >> 6;
  const int total = 1024 + 512;
  for (int i = 0; i * nblk < total; ++i) {
    int u = snake_idx(i, bid, nblk);
    if (u >= total) continue;
    if constexpr (IS_MLA) {
      const bf16_t* Q = (const bf16_t*)(R + R_Q); const bf16_t* KN = (const bf16_t*)(R + R_KN);
      const bf16_t* KR = (const bf16_t*)(R + R_KR); const bf16_t* VT = (const bf16_t*)(R + R_VT);
      bf16_t* AO = (bf16_t*)(R + R_RAW);
      if (u < 1024) {
        int qt = 31 - (u >> 5), bh = u & 31, b = bh >> 4, h = bh & 15;
        int q0 = b * 8192 + qt * 256;
        attn8_unit<96, true, false>(Q + (size_t)q0 * 1536 + h * 96, 1536, 256,
                                    KN + (size_t)(b * 8192) * 1024 + h * 64, 1024, KR + (size_t)(b * 8192) * 32,
                                    VT + (size_t)((b * 16 + h) * 64) * 8192, 8192, 8192,
                                    2 * qt + 2, 4 * qt + 1 + (w >> 1), 1 << 30, nullptr,
                                    AO + (size_t)q0 * 1024 + h * 64, smem, wv);
      } else {
        int v = u - 1024, b = v >> 4, h = v & 15;
        int q0 = TP + b * 16;
        attn8_unit<96, true, true>(Q + (size_t)q0 * 1536 + h * 96, 1536, 16,
                                   KN + (size_t)(TP + b * SPAD) * 1024 + h * 64, 1024, KR + (size_t)(TP + b * SPAD) * 32,
                                   VT + (size_t)TP * 1024 + (size_t)((b * 16 + h) * 64) * SPAD, SPAD, SPAD,
                                   9, (w == 0) ? 17 : 0, NKS, nullptr,
                                   AO + (size_t)q0 * 1024 + h * 64, smem, wv);
      }
    } else {
      const bf16_t* Q = (const bf16_t*)(R + D_Q); const bf16_t* KK = (const bf16_t*)(R + D_K);
      const bf16_t* VT = (const bf16_t*)(R + D_VT); const unsigned* BM = (const unsigned*)(R + D_BM);
      bf16_t* AO = (bf16_t*)(R + D_AO);
      if (u < 1024) {
        int qt = 31 - (u >> 5), bh = u & 31, b = bh >> 4, h = bh & 15;
        int q0 = b * 8192 + qt * 256;
        attn8_unit<64, false, true>(Q + (size_t)q0 * 1024 + h * 64, 1024, 256,
                                    KK + (size_t)(b * 8192) * 1024 + h * 64, 1024, nullptr,
                                    VT + (size_t)((b * 16 + h) * 64) * 8192, 8192, 8192,
                                    2 * qt + 2, 4 * qt + 1 + (w >> 1), 1 << 30, BM + (size_t)q0 * 256,
                                    AO + (size_t)q0 * 1024 + h * 64, smem, wv);
      } else {
        int v = u - 1024, b = v >> 4, h = v & 15;
        int q0 = TP + b * 16;
        attn8_unit<64, false, true>(Q + (size_t)q0 * 1024 + h * 64, 1024, 16,
                                    KK + (size_t)(TP + b * SPAD) * 1024 + h * 64, 1024, nullptr,
                                    VT + (size_t)TP * 1024 + (size_t)((b * 16 + h) * 64) * SPAD, SPAD, SPAD,
                                    9, (w == 0) ? 17 : 0, NKS, BM + (size_t)q0 * 256,
                                    AO + (size_t)q0 * 1024 + h * 64, smem, wv);
      }
    }
  }
}

constexpr int CAP = 128;
DI int score_bin(float s) {
  unsigned u = __float_as_uint(s);
  int e = (int)((u & 0x7fffffffu) >> 19);
  int m = min(max(e, 1840), 2095) - 1840;
  return (u >> 31) ? (255 - m) : (256 + m);
}

DI void idx_unit(const bf16_t* __restrict__ QI, const float* __restrict__ WI, int q_row0, int nq,
                 const bf16_t* __restrict__ KI, int L, unsigned* __restrict__ BM, unsigned char* smem, int wv) {
  const int tid = ltid(wv), lane = tid & 63, w = tid >> 6, lr = lane & 31, lh = lane >> 5;
  bf16_t* Qs = (bf16_t*)smem;
  float* Ws = (float*)(smem + 36864);
  unsigned* hist = (unsigned*)(smem + 36864 + 1024);
  float* cand_s = (float*)hist;
  int* cand_i = (int*)(smem + 36864 + 1024 + 16384);
  int* bstar = (int*)(smem + 36864 + 1024 + 32768);
  int* need = bstar + 32;
  int* ncand = need + 32;
  __syncthreads();
#pragma unroll
  for (int i = 0; i < 4; ++i) {
    int v = tid + i * NT;
    int hd = v >> 8, q = (v >> 3) & 31, c = (v & 7) * 8;
    int qq = q < nq ? q : 0;
    *(uint4*)(Qs + (hd * 32 + q) * 72 + c) = *(const uint4*)(QI + (size_t)(q_row0 + qq) * 512 + hd * 64 + c);
  }
  if (tid < 256) { int hd = tid >> 5, q = tid & 31; int qq = q < nq ? q : 0; Ws[hd * 32 + q] = WI[(size_t)(q_row0 + qq) * 8 + hd]; }
  for (int i = tid; i < 32 * 256; i += NT) hist[i] = 0u;
  if (tid < 32) { bstar[tid] = -1; need[tid] = 0; ncand[tid] = 0; }
  __syncthreads();
  const int ntile = (L + 255) >> 8;
  const bool do_select = L > 256;
  int bsr[16];
  { int m1_ = -1; asm volatile("" : "+v"(m1_));
#pragma unroll
    for (int i = 0; i < 16; ++i) bsr[i] = m1_; }
  for (int pass = do_select ? 0 : 1; pass < 2; ++pass) {
    if (pass == 1) {
#pragma unroll
      for (int i = 0; i < 16; ++i) bsr[i] = bstar[crow(i, lh)];
    }
    bf16x8 kn0, kn1, kn2, kn3;
    { const bf16_t* kp = KI + (size_t)(w * 32 + lr) * 64 + lh * 8;
      kn0 = *(const bf16x8*)(kp); kn1 = *(const bf16x8*)(kp + 16); kn2 = *(const bf16x8*)(kp + 32); kn3 = *(const bf16x8*)(kp + 48); }
    for (int kt = 0; kt < ntile; ++kt) {
      const int key0 = kt * 256 + w * 32;
      bf16x8 kf[4];
      kf[0] = kn0; kf[1] = kn1; kf[2] = kn2; kf[3] = kn3;
      if (key0 + 256 < L) {
        const bf16_t* kp = KI + (size_t)(key0 + 256 + lr) * 64 + lh * 8;
        kn0 = *(const bf16x8*)(kp); kn1 = *(const bf16x8*)(kp + 16); kn2 = *(const bf16x8*)(kp + 32); kn3 = *(const bf16x8*)(kp + 48);
      }
      if (key0 < L) {
        const int key = key0 + lr;
        float sc[16];
#pragma unroll
        for (int i = 0; i < 16; ++i) sc[i] = 0.f;
#pragma unroll 1
        for (int hd = 0; hd < 8; ++hd) {
          f32x16 acc;
#pragma unroll
          for (int i = 0; i < 16; ++i) acc[i] = 0.f;
#pragma unroll
          for (int s = 0; s < 4; ++s) {
            bf16x8 qf = *(const bf16x8*)(Qs + (hd * 32 + lr) * 72 + s * 16 + lh * 8);
            acc = MFMA32(qf, kf[s], acc);
          }
#pragma unroll
          for (int g = 0; g < 4; ++g) {
            float4 wv = *(const float4*)(Ws + hd * 32 + 8 * g + 4 * lh);
            sc[4 * g + 0] += wv.x * fmaxf(acc[4 * g + 0], 0.f);
            sc[4 * g + 1] += wv.y * fmaxf(acc[4 * g + 1], 0.f);
            sc[4 * g + 2] += wv.z * fmaxf(acc[4 * g + 2], 0.f);
            sc[4 * g + 3] += wv.w * fmaxf(acc[4 * g + 3], 0.f);
          }
        }
        const bool kvalid = key < L;
        if (pass == 0) {
#pragma unroll
          for (int i = 0; i < 16; ++i) {
            int q = crow(i, lh);
            if (kvalid) { int b = score_bin(sc[i]); atomicAdd(&hist[q * 256 + (b >> 1)], (b & 1) ? 65536u : 1u); }
          }
        } else {
          unsigned myword = 0u, cmask = 0u;
          unsigned long long any = 0ull;
#pragma unroll
          for (int i = 0; i < 16; ++i) {
            const int b = score_bin(sc[i]);
            const int bs = bsr[i];
            const bool sel = kvalid && (b > bs);
            const bool cnd = kvalid && (b == bs);
            const unsigned long long bal = __ballot(sel);
            myword = (lr == i) ? (unsigned)(bal >> (32 * lh)) : myword;
            any |= __ballot(cnd);
            cmask |= cnd ? (1u << i) : 0u;
          }
          if (lr < 16 && crow(lr, lh) < nq) BM[(size_t)(q_row0 + crow(lr, lh)) * 256 + (key0 >> 5)] = myword;
          if (any != 0ull) {
            int base[16];
#pragma unroll
            for (int i = 0; i < 16; ++i) {
              const unsigned long long cbi = __ballot((cmask >> i) & 1u);
              base[i] = 0;
              if (lr == 0) base[i] = atomicAdd(&ncand[crow(i, lh)], __popc((unsigned)(cbi >> (32 * lh))));
            }
#pragma unroll
            for (int i = 0; i < 16; ++i) {
              const unsigned long long cbi = __ballot((cmask >> i) & 1u);
              const int bb = __builtin_amdgcn_ds_bpermute((lane & 32) << 2, base[i]);
              if ((cmask >> i) & 1u) {
                const unsigned hm = (unsigned)(cbi >> (32 * lh));
                const int pos = bb + __popc(hm & ((1u << lr) - 1u));
                const int q = crow(i, lh);
                if (pos < CAP) { cand_s[q * CAP + pos] = sc[i]; cand_i[q * CAP + pos] = key; }
              }
            }
          }
        }
      }
    }
    __syncthreads();
    if (pass == 0) {
      for (int qi = 0; qi < 4; ++qi) {
        const int q = w * 4 + qi;
        unsigned hw[4];
#pragma unroll
        for (int k = 0; k < 4; ++k) hw[k] = hist[q * 256 + 255 - 4 * lane - k];
        int cnt = 0;
#pragma unroll
        for (int k = 0; k < 4; ++k) cnt += (int)(hw[k] >> 16) + (int)(hw[k] & 0xffffu);
        int pre = cnt;
#pragma unroll
        for (int o = 1; o < 64; o <<= 1) { int t = __builtin_amdgcn_ds_bpermute(((lane - o) & 63) << 2, pre); if (lane >= o) pre += t; }
        unsigned long long bal = __ballot(pre >= 256);
        if (bal != 0ull) {
          int fl = __ffsll((long long)bal) - 1;
          if (lane == fl) {
            int running = pre - cnt;
            int bsel = -1, above = 0;
#pragma unroll
            for (int k = 0; k < 4; ++k) {
              int chi = (int)(hw[k] >> 16), clo = (int)(hw[k] & 0xffffu);
              if (bsel < 0) { if (running + chi >= 256) { bsel = 511 - 8 * lane - 2 * k; above = running; } else running += chi; }
              if (bsel < 0) { if (running + clo >= 256) { bsel = 510 - 8 * lane - 2 * k; above = running; } else running += clo; }
            }
            bstar[q] = bsel; need[q] = 256 - above;
          }
        }
      }
      __syncthreads();
    }
  }
  __threadfence();
  __syncthreads();
  if (do_select) {
    for (int pi = tid; pi < 32 * CAP; pi += NT) {
      int q = pi / CAP, c = pi - q * CAP;
      int n = min(ncand[q], CAP);
      if (c < n && q < nq) {
        float sv = cand_s[q * CAP + c]; int iv = cand_i[q * CAP + c];
        int rank = 0;
        for (int j = 0; j < n; ++j) {
          float sj = cand_s[q * CAP + j]; int ij = cand_i[q * CAP + j];
          rank += (sj > sv || (sj == sv && ij < iv)) ? 1 : 0;
        }
        if (rank < need[q]) atomicOr(&BM[(size_t)(q_row0 + q) * 256 + (iv >> 5)], 1u << (iv & 31));
      }
    }
  }
  __syncthreads();
}

DI void idx_phase(PREF p, unsigned char* smem, int bid, int nblk, int wv) {
  unsigned char* R = p.ws + OFF_R;
  const bf16_t* QI = (const bf16_t*)(R + D_QI); const float* WI = (const float*)(R + D_WI);
  const bf16_t* KI = (const bf16_t*)(R + D_KI); unsigned* BM = (unsigned*)(R + D_BM);
  const int total = 512 + 32;
  for (int i = 0; i * nblk < total; ++i) {
    int idx = snake_idx(i, bid, nblk);
    if (idx >= total) continue;
    if (idx < 512) {
      int qt = 255 - (idx >> 1), b = idx & 1;
      int L = (((qt * 32) >> 6) + 1) * 64;
      idx_unit(QI, WI, b * 8192 + qt * 32, 32, KI + (size_t)(b * 8192) * 64, L, BM, smem, wv);
    } else {
      int b = idx - 512;
      idx_unit(QI, WI, TP + b * 16, 16, KI + (size_t)(TP + b * SPAD) * 64, NKS, BM, smem, wv);
    }
  }
}

DI void cvt8(const float* s, bf16_t* d) {
  float4 a = *(const float4*)s, b = *(const float4*)(s + 4);
  uint4 pk; pk.x = pack2(a.x, a.y); pk.y = pack2(a.z, a.w); pk.z = pack2(b.x, b.y); pk.w = pack2(b.z, b.w);
  *(uint4*)d = pk;
}
DI void cache_rows(const float* __restrict__ src, bf16_t* __restrict__ dst, int Wd, int bid, int nblk, int wv) {
  const int vpr = Wd >> 3;
  const size_t total = (size_t)32 * SPAD * vpr;
  for (size_t e = (size_t)bid * NT + ltid(wv); e < total; e += (size_t)nblk * NT) {
    int c = (int)(e % vpr) * 8; size_t rw = e / vpr; int b = (int)(rw / SPAD), s = (int)(rw % SPAD);
    bf16_t* d = dst + ((size_t)TP + (size_t)b * SPAD + s) * Wd + c;
    if (s < 1024) cvt8(src + ((size_t)b * 1024 + s) * Wd + c, d);
    else if (s >= NKS) { unsigned z = 0; asm volatile("" : "+v"(z)); *(uint4*)d = make_uint4(z, z, z, z); }
  }
}


#define XB_TMO      128
#define XB_XCNT(j)  (256  + 64 * (j))
#define XB_XSUB(j)  (1280 + 64 * (j))
#define XB_XGEN(j)  (2304 + 64 * (j))
#define XB_TOP      3328
#define XB_TOPGEN   3392
#define XCD_BAR_WORDS 3456
#define XB_SPIN_CAP (1u << 18)
DI unsigned xb_ld(unsigned* p)              { return __hip_atomic_load(p, __ATOMIC_RELAXED, __HIP_MEMORY_SCOPE_AGENT); }
DI unsigned xb_add(unsigned* p, unsigned v) { return __hip_atomic_fetch_add(p, v, __ATOMIC_RELAXED, __HIP_MEMORY_SCOPE_AGENT); }
DI unsigned xb_xcc_id() { return (unsigned)__builtin_amdgcn_s_getreg((3 << 11) | 20) & 0xFu; }
#define XB_SPIN(cond, bar) do { unsigned _sp = 0; while (cond) { __builtin_amdgcn_s_sleep(1); \
    if ((++_sp & 255u) == 0u) { if (xb_ld(&(bar)[XB_TMO])) break; if (_sp > XB_SPIN_CAP) { atomicAdd(&(bar)[XB_TMO], 1u); break; } } } } while (0)
struct XcdBarrier { unsigned* bar; unsigned x; volatile __attribute__((address_space(3))) unsigned* st; };
DI void xcd_barrier_complete(unsigned* bar, unsigned x, unsigned G, unsigned& nloc, unsigned& nx) {
  unsigned sum, cnt, mine, sp = 0u;
  for (;;) {
    sum = 0u; cnt = 0u; mine = 0u;
#pragma unroll
    for (unsigned j = 0; j < 16; ++j) { const unsigned c = xb_ld(&bar[XB_XCNT(j)]); sum += c; cnt += (c > 0u) ? 1u : 0u; mine = (j == x) ? c : mine; }
    if (sum == G) break;
    __builtin_amdgcn_s_sleep(1);
    if ((++sp & 255u) == 0u) { if (xb_ld(&bar[XB_TMO])) break; if (sp > XB_SPIN_CAP) { atomicAdd(&bar[XB_TMO], 1u); break; } }
  }
  nloc = mine > 0u ? mine : 1u; nx = cnt > 0u ? cnt : 1u;
}
DI void xcd_barrier(const XcdBarrier& b, int tid, unsigned G) {
  asm volatile("s_waitcnt vmcnt(0)" ::: "memory");
  __syncthreads();
  if (tid == 0) {
    unsigned* bar = b.bar;
    __builtin_amdgcn_s_waitcnt(0);
    unsigned nloc = b.st[0], nx = b.st[1];
    if (nloc == 0u) { xcd_barrier_complete(bar, b.x, G, nloc, nx); b.st[0] = nloc; b.st[1] = nx; }
    const unsigned old = xb_add(&bar[XB_XSUB(b.x)], 1u);
    const unsigned gen = old / nloc;
    if (old + 1u == (gen + 1u) * nloc) {
      __builtin_amdgcn_fence(__ATOMIC_RELEASE, "agent");
      asm volatile("s_waitcnt vmcnt(0)" ::: "memory");
      const unsigned og = xb_add(&bar[XB_TOP], 1u);
      const unsigned tg = og / nx;
      if (og + 1u == (tg + 1u) * nx) xb_add(&bar[XB_TOPGEN], 1u);
      else XB_SPIN(xb_ld(&bar[XB_TOPGEN]) == tg, bar);
      __builtin_amdgcn_fence(__ATOMIC_ACQUIRE, "agent");
      xb_add(&bar[XB_XGEN(b.x)], 1u);
      asm volatile("s_waitcnt vmcnt(0)" ::: "memory");
    } else {
      XB_SPIN(xb_ld(&bar[XB_XGEN(b.x)]) == gen, bar);
      __builtin_amdgcn_fence(__ATOMIC_ACQUIRE, "agent");
      asm volatile("s_waitcnt vmcnt(0)" ::: "memory");
    }
  }
  __syncthreads();
}

extern "C" __global__ void __launch_bounds__(512, 2) mega(Params p_unused) {
  extern __shared__ __attribute__((aligned(16))) unsigned char smem[];
  cg::grid_group grid = cg::this_grid();
  const int bid = blockIdx.x, nblk = gridDim.x;
  const int wv = __builtin_amdgcn_readfirstlane((int)(threadIdx.x >> 6));
  CParams* pk = (CParams*)__builtin_amdgcn_kernarg_segment_ptr();
  const int ph_lo = pk->ph_lo, ph_hi = pk->ph_hi;
  int ph = 0;
  XcdBarrier xb;
  {
    volatile __attribute__((address_space(3))) unsigned* st = (volatile __attribute__((address_space(3))) unsigned*)(smem + 131072);
    const int t0 = ltid(wv);
    if (t0 == 0) { st[0] = 0u; st[1] = 0u; }
    __syncthreads();
    xb.bar = (unsigned*)(pk->ws + OFF_BAR); xb.x = xb_xcc_id(); xb.st = st;
    if (t0 == 0) (void)xb_add(&xb.bar[XB_XCNT(xb.x)], 1u);
  }
#ifndef REPMASK
#define REPMASK 0u
#endif
#ifndef PMASK
#define PMASK 0xffffffffu
#endif
#define PHASE_BEGIN(k) if (ph >= ph_lo && ph < ph_hi) { if constexpr ((PMASK >> (k)) & 1u) for (int rep_ = 0; rep_ < 1 + (int)((REPMASK >> (k)) & 1u); ++rep_) { \
    CParams* pp_ = pk; asm volatile("" : "+s"(pp_)); PREF p = *pp_; const int tid = ltid(wv); \
    unsigned char* ws = p.ws; float* X = (float*)(ws + OFF_X); bf16_t* H = (bf16_t*)(ws + OFF_H); bf16_t* Wb = (bf16_t*)(ws + OFF_W); \
    float* ROPE = (float*)(ws + OFF_ROPE); unsigned char* R = ws + OFF_R; (void)tid; (void)X; (void)H; (void)Wb; (void)ROPE; (void)R;
#define PHASE_END   } if (ph + 1 < ph_hi) { if (ph == 0) grid.sync(); else xcd_barrier(xb, ltid(wv), (unsigned)nblk); } } ++ph;

  PHASE_BEGIN(0)
    {
      const int hf = tid >> 8, tl = tid & 255;
      float* smh = (float*)smem + hf * 4224;
      for (int t0 = bid * 2; t0 < p.total_tiles; t0 += nblk * 2) {
        const int t = t0 + hf;
        const bool active = t < p.total_tiles;
        const int tt = active ? t : 0;
        int ji = 0;
#pragma unroll 1
        for (int q = 1; q < NJOBS; ++q) if (tt >= p.jobs[q].tile0) ji = q;
        const CAS Job& jb = p.jobs[ji];
        int lt = tt - jb.tile0; int nkt = jb.k >> 6; int nt_ = lt / nkt, kt_ = lt - nt_ * nkt;
        transpose_tile(jb.src, jb.nsrc, jb.nsrc, jb.dst, jb.k, nt_ * 64, kt_ * 64, jb.mode, smh, tl, active);
      }
    }
    {
      const size_t n4p = (size_t)TP * 256, n4 = (size_t)T * 256;
      const float4* xp = (const float4*)p.in[0]; const float4* xs = (const float4*)p.in[1];
      for (size_t e = (size_t)bid * NT + tid; e < n4; e += (size_t)nblk * NT) ((float4*)X)[e] = (e < n4p) ? xp[e] : xs[e - n4p];
      for (int e = bid * NT + tid; e < 8192 * 16; e += nblk * NT) {
        int pos = e >> 4, i = e & 15;
        double rev = (double)pos * p.inv_freq[i] * 0.15915494309189535;
        rev -= floor(rev);
        float fr = (float)rev;
        ROPE[2 * e] = __builtin_amdgcn_cosf(fr); ROPE[2 * e + 1] = __builtin_amdgcn_sinf(fr);
      }
      const float* wsrc = p.in[20];
      for (int e = bid * NT + tid; e < 8 * 128 * 128; e += nblk * NT) {
        int s = e & 127, t = (e >> 7) & 127;
        Wb[W_TRIL + e] = tobf(s <= t ? wsrc[e] : 0.f);
      }
    }
  PHASE_END

#pragma unroll 1
  for (int L = 0; L < 4; ++L) {
    const int kind = L % 3, j = L / 3;
    if (kind == 0) {
      PHASE_BEGIN(1)
        rmsnorm_rows(X, p.in[7] + L * 1024, H, nullptr, nullptr, bid, nblk, wv);
        cache_rows(p.in[2] + (size_t)j * 32 * 1024 * 256, (bf16_t*)(R + R_CKV), 256, bid, nblk, wv);
        cache_rows(p.in[3] + (size_t)j * 32 * 1024 * 32, (bf16_t*)(R + R_KR), 32, bid, nblk, wv);
      PHASE_END
      PHASE_BEGIN(2)
        EArgs ea{}; ea.f0 = (float*)(R + R_RAW);
        gemm_phase<E_F32>(H, Wb + W_MLA + (size_t)j * WM_SZ + WM_D, T, 1024, 1024, ea, smem, 0, bid, nblk, wv);
      PHASE_END
      PHASE_BEGIN(3)
        mla_rowops(p, j, bid, nblk, wv);
      PHASE_END
      PHASE_BEGIN(4)
        EArgs ea{}; ea.b0 = (bf16_t*)(R + R_Q); ea.rope = ROPE;
        gemm_phase<E_MLAQ>((const bf16_t*)(R + R_CQ), Wb + W_MLA + (size_t)j * WM_SZ + WM_UQ, T, 1536, 512, ea, smem, 0, bid, nblk, wv);
        EArgs eb{}; eb.b0 = (bf16_t*)(R + R_KN); eb.b1 = (bf16_t*)(R + R_VT);
        gemm_phase<E_MLAKV>((const bf16_t*)(R + R_CKV), Wb + W_MLA + (size_t)j * WM_SZ + WM_UKV, KROWS, 2048, 256, eb, smem, (T / 256) * 6, bid, nblk, wv);
      PHASE_END
      PHASE_BEGIN(5)
        attn_phase<true>(p, smem, bid, nblk, wv);
      PHASE_END
      PHASE_BEGIN(6)
        EArgs ea{}; ea.f0 = X;
        gemm_phase<E_RESID>((const bf16_t*)(R + R_RAW), Wb + W_MLA + (size_t)j * WM_SZ + WM_O, T, 1024, 1024, ea, smem, 0, bid, nblk, wv);
      PHASE_END
    } else if (kind == 1) {
      PHASE_BEGIN(1)
        rmsnorm_rows(X, p.in[7] + L * 1024, H, nullptr, nullptr, bid, nblk, wv);
      PHASE_END
      PHASE_BEGIN(7)
        EArgs ea{}; ea.b0 = (bf16_t*)(R + C_U); ea.b1 = (bf16_t*)(R + C_VR);
        gemm_phase<E_GELU>(H, Wb + W_CM + WC_IN, T, 4096, 1024, ea, smem, 0, bid, nblk, wv);
      PHASE_END
      PHASE_BEGIN(8)
        cmlp_ln_rows(p, bid, nblk, wv);
      PHASE_END
      PHASE_BEGIN(9)
        cmlp_mix_phase(p, smem, bid, nblk, wv);
      PHASE_END
      PHASE_BEGIN(6)
        EArgs ea{}; ea.f0 = X;
        gemm_phase<E_RESID>((const bf16_t*)(R + C_G), Wb + W_CM + WC_OUT, T, 1024, 2048, ea, smem, 0, bid, nblk, wv);
      PHASE_END
    } else {
      PHASE_BEGIN(10)
        rmsnorm_rows(X, p.in[7] + L * 1024, H, nullptr, nullptr, bid, nblk, wv);
        cache_rows(p.in[4], (bf16_t*)(R + D_K), 1024, bid, nblk, wv);
        cache_rows(p.in[6], (bf16_t*)(R + D_KI), 64, bid, nblk, wv);
        {
          bf16_t* VTs = (bf16_t*)(R + D_VT) + (size_t)TP * 1024;
          {
            const int hf = tid >> 8, tl = tid & 255;
            float* smh = (float*)smem + hf * 4224;
            for (int u0 = bid * 2; u0 < 512 * 16; u0 += nblk * 2) {
              const int u = u0 + hf;
              int st = u & 15, bh = u >> 4, b = bh >> 4, h = bh & 15;
              transpose_tile(p.in[5] + (size_t)b * 1024 * 1024 + h * 64, 1024, 64, VTs + (size_t)(bh * 64) * SPAD, SPAD, 0, st * 64, 0, smh, tl, true);
            }
          }
          for (int e = bid * NT + tid; e < 512 * 64 * 12; e += nblk * NT) {
            int c = e % 12, rw = e / 12;
            { unsigned z = 0; asm volatile("" : "+v"(z)); *(uint2*)(VTs + (size_t)rw * SPAD + NKS + c * 4) = make_uint2(z, z); }
          }
        }
      PHASE_END
      PHASE_BEGIN(11)
        EArgs ea{};
        ea.f0 = p.out + O_DKP; ea.f1 = p.out + O_DKS; ea.f2 = p.out + O_DVP; ea.f3 = p.out + O_DVS;
        ea.f4 = (float*)(R + D_KIR); ea.f5 = (float*)(R + D_WI);
        ea.b0 = (bf16_t*)(R + D_Q); ea.b1 = (bf16_t*)(R + D_K); ea.b2 = (bf16_t*)(R + D_VT); ea.b3 = (bf16_t*)(R + D_QI);
        gemm_phase<E_DSA>(H, Wb + W_DS + WD_P, T, 3840, 1024, ea, smem, 0, bid, nblk, wv);
      PHASE_END
      PHASE_BEGIN(12)
        dsa_rowops(p, bid, nblk, wv);
      PHASE_END
      PHASE_BEGIN(13)
        idx_phase(p, smem, bid, nblk, wv);
      PHASE_END
      PHASE_BEGIN(14)
        attn_phase<false>(p, smem, bid, nblk, wv);
      PHASE_END
      PHASE_BEGIN(6)
        EArgs ea{}; ea.f0 = X;
        gemm_phase<E_RESID>((const bf16_t*)(R + D_AO), Wb + W_DS + WD_O, T, 1024, 1024, ea, smem, 0, bid, nblk, wv);
      PHASE_END
    }
    PHASE_BEGIN(1)
      rmsnorm_rows(X, p.in[8] + L * 1024, H, nullptr, nullptr, bid, nblk, wv);
    PHASE_END
    PHASE_BEGIN(15)
      EArgs ea{}; ea.b0 = (bf16_t*)(R + 0);
      gemm_phase<E_SWIGLU>(H, Wb + W_FF + (size_t)L * WF_SZ + WF_IN, T, 2 * DFF, 1024, ea, smem, 0, bid, nblk, wv);
    PHASE_END
    PHASE_BEGIN(6)
      EArgs ea{}; ea.f0 = X;
      gemm_phase<E_RESID>((const bf16_t*)(R + 0), Wb + W_FF + (size_t)L * WF_SZ + WF_OUT, T, 1024, DFF, ea, smem, 0, bid, nblk, wv);
    PHASE_END
  }
  PHASE_BEGIN(1)
    rmsnorm_rows(X, p.in[9], nullptr, p.out + O_YP, p.out + O_YS, bid, nblk, wv);
  PHASE_END
}

extern "C" void kernel_launch(void* const* d_in, const int* in_sizes, int n_in,
                              void* d_out, int out_size, void* d_ws, size_t ws_size,
                              hipStream_t stream) {
  constexpr int kLds = 128 * 1024 + 64;
  static int grid_blocks = 0;
  if (!grid_blocks) {
    int dev = 0, cus = 0, per_cu = 0;
    (void)hipGetDevice(&dev);
    (void)hipDeviceGetAttribute(&cus, hipDeviceAttributeMultiprocessorCount, dev);
    (void)hipFuncSetAttribute((const void*)mega, hipFuncAttributeMaxDynamicSharedMemorySize, kLds);
    (void)hipOccupancyMaxActiveBlocksPerMultiprocessor(&per_cu, (const void*)mega, NT, kLds);
    if (per_cu < 1) per_cu = 1;
    if (per_cu > 1) per_cu = 1;
    grid_blocks = cus * per_cu;
    fprintf(stderr, "grid %d (cus %d per_cu %d) ws %zu need %zu out %d need %zu\n", grid_blocks, cus, per_cu, ws_size, (size_t)WS_NEED, out_size, (size_t)O_END);
  }
  if (ws_size < WS_NEED || n_in != 31 || (size_t)out_size != O_END) { fprintf(stderr, "kernel_launch: bad sizes\n"); return; }
  Params p;
  memset(&p, 0, sizeof(p));
  for (int i = 0; i < 31; ++i) p.in[i] = (const float*)d_in[i];
  p.out = (float*)d_out; p.ws = (unsigned char*)d_ws;
  bf16_t* Wb = (bf16_t*)((unsigned char*)d_ws + OFF_W);
  int nj = 0, tiles = 0;
  auto add = [&](const float* src, int nsrc, int k, bf16_t* dst, int ndst, int mode) {
    Job& jb = p.jobs[nj++]; jb.src = src; jb.dst = dst; jb.nsrc = nsrc; jb.k = k; jb.ndst = ndst; jb.mode = mode; jb.tile0 = tiles; jb.pad = 0;
    tiles += (ndst / 64) * (k / 64);
  };
  for (int j = 0; j < 2; ++j) {
    bf16_t* Wm = Wb + W_MLA + (size_t)j * WM_SZ;
    add(p.in[10] + (size_t)j * 1024 * 512, 512, 1024, Wm + WM_D, 512, 2);
    add(p.in[13] + (size_t)j * 1024 * 288, 288, 1024, Wb + W_MLA + (size_t)j * WM_SZ + WM_D + (size_t)512 * 1024, 512, 2);
    add(p.in[12] + (size_t)j * 512 * 1536, 1536, 512, Wb + W_MLA + (size_t)j * WM_SZ + WM_UQ, 1536, 0);
    add(p.in[15] + (size_t)j * 256 * 2048, 2048, 256, Wb + W_MLA + (size_t)j * WM_SZ + WM_UKV, 2048, 2);
    add(p.in[16] + (size_t)j * 1024 * 1024, 1024, 1024, Wb + W_MLA + (size_t)j * WM_SZ + WM_O, 1024, 2);
  }
  add(p.in[17], 4096, 1024, Wb + W_CM + WC_IN, 4096, 2);
  add(p.in[22], 1024, 2048, Wb + W_CM + WC_OUT, 1024, 2);
  add(p.in[23], 3072, 1024, Wb + W_DS + WD_P, 3072, 2);
  add(p.in[25], 512, 1024, Wb + W_DS + WD_P + (size_t)3072 * 1024, 512, 2);
  add(p.in[26], 64, 1024, Wb + W_DS + WD_P + (size_t)3584 * 1024, 64, 2);
  add(p.in[28], 8, 1024, Wb + W_DS + WD_P + (size_t)3648 * 1024, 192, 2);
  add(p.in[24], 1024, 1024, Wb + W_DS + WD_O, 1024, 2);
  for (int i = 0; i < 4; ++i) {
    add(p.in[29] + (size_t)i * 1024 * 5632, 5632, 1024, Wb + W_FF + (size_t)i * WF_SZ + WF_IN, 5632, 1);
    add(p.in[30] + (size_t)i * 2816 * 1024, 1024, 2816, Wb + W_FF + (size_t)i * WF_SZ + WF_OUT, 1024, 2);
  }
  p.total_tiles = tiles;
  for (int i = 0; i < 16; ++i) p.inv_freq[i] = pow(10000.0, -(double)i / 16.0);
  p.ph_lo = 0; p.ph_hi = 1000;
  (void)hipMemsetAsync((unsigned char*)d_ws + OFF_BAR, 0, 16384, stream);
  void* args[] = {&p};
  hipError_t e = hipLaunchCooperativeKernel((const void*)mega, dim3(grid_blocks), dim3(NT), args, kLds, stream);
  if (e != hipSuccess) fprintf(stderr, "coop launch failed: %s\n", hipGetErrorString(e));
}
```

```cpp
#include <hip/hip_runtime.h>
#include <hip/hip_cooperative_groups.h>
#include <cstdio>
#include <cstring>
#include <cmath>
namespace cg = cooperative_groups;

typedef unsigned short bf16_t;
using bf16x8 = __attribute__((ext_vector_type(8))) short;
using f32x16 = __attribute__((ext_vector_type(16))) float;
using f32x2v = __attribute__((ext_vector_type(2))) float;
using bf2v = __attribute__((ext_vector_type(2))) __bf16;
#define DI __device__ __forceinline__
#define MFMA32(a, b, c) __builtin_amdgcn_mfma_f32_32x32x16_bf16((a), (b), (c), 0, 0, 0)

constexpr int TP = 16384, TS = 512, T = TP + TS;
constexpr int NT = 512;
constexpr int SPAD = 1088, NKS = 1040;
constexpr int KROWS = TP + 32 * SPAD;
constexpr int DFF = 2816;
constexpr float LOG2E = 1.4426950408889634f;
constexpr float EPS = 1e-6f;

constexpr size_t OFF_X = 0;
constexpr size_t OFF_H = OFF_X + (size_t)T * 1024 * 4;
constexpr size_t OFF_W = OFF_H + (size_t)T * 1024 * 2;
constexpr size_t W_ELEMS = 52822016;
constexpr size_t OFF_ROPE = OFF_W + W_ELEMS * 2;
constexpr size_t OFF_R = OFF_ROPE + (size_t)8192 * 16 * 2 * 4;
constexpr size_t R_RAW = 0;
constexpr size_t R_CQ = R_RAW + (size_t)T * 1024 * 4;
constexpr size_t R_CKV = R_CQ + (size_t)T * 512 * 2;
constexpr size_t R_KR = R_CKV + (size_t)KROWS * 256 * 2;
constexpr size_t R_Q = R_KR + (size_t)KROWS * 32 * 2;
constexpr size_t R_KN = R_Q + (size_t)T * 1536 * 2;
constexpr size_t R_VT = R_KN + (size_t)KROWS * 1024 * 2;
constexpr size_t R_END = R_VT + (size_t)KROWS * 1024 * 2;
constexpr size_t D_Q = 0;
constexpr size_t D_K = D_Q + (size_t)T * 1024 * 2;
constexpr size_t D_VT = D_K + (size_t)KROWS * 1024 * 2;
constexpr size_t D_QI = D_VT + (size_t)KROWS * 1024 * 2;
constexpr size_t D_KIR = D_QI + (size_t)T * 512 * 2;
constexpr size_t D_KI = D_KIR + (size_t)T * 64 * 4;
constexpr size_t D_WI = D_KI + (size_t)KROWS * 64 * 2;
constexpr size_t D_BM = D_WI + (size_t)T * 8 * 4;
constexpr size_t D_AO = D_BM + (size_t)T * 256 * 4;
constexpr size_t D_END = D_AO + (size_t)T * 1024 * 2;
constexpr size_t C_U = 0;
constexpr size_t C_VR = C_U + (size_t)T * 2048 * 2;
constexpr size_t C_VLN = C_VR + (size_t)T * 2048 * 2;
constexpr size_t C_G = C_VLN + (size_t)T * 2048 * 2;
constexpr size_t C_END = C_G + (size_t)T * 2048 * 2;
constexpr size_t OFF_BAR = OFF_R + R_END;
constexpr size_t WS_NEED = OFF_BAR + 16384;
static_assert(D_END <= R_END && C_END <= R_END && (size_t)T * DFF * 2 <= R_END, "region");

constexpr size_t W_MLA = 0;
constexpr size_t WM_D = 0, WM_UQ = 1048576, WM_UKV = WM_UQ + 786432, WM_O = WM_UKV + 524288, WM_SZ = 3407872;
constexpr size_t W_CM = 2 * WM_SZ;
constexpr size_t WC_IN = 0, WC_OUT = 4194304, WC_SZ = 6291456;
constexpr size_t W_DS = W_CM + WC_SZ;
constexpr size_t WD_P = 0, WD_O = 3932160, WD_SZ = 4980736;
constexpr size_t W_FF = W_DS + WD_SZ;
constexpr size_t WF_IN = 0, WF_OUT = 5767168, WF_SZ = 8650752;
constexpr size_t W_TRIL = W_FF + 4 * WF_SZ;
static_assert(W_TRIL + 131072 == W_ELEMS, "w");

constexpr size_t O_YP = 0;
constexpr size_t O_YS = O_YP + (size_t)TP * 1024;
constexpr size_t O_CKVP = O_YS + (size_t)TS * 1024;
constexpr size_t O_KRP = O_CKVP + (size_t)2 * TP * 256;
constexpr size_t O_CKVS = O_KRP + (size_t)2 * TP * 32;
constexpr size_t O_KRS = O_CKVS + (size_t)2 * TS * 256;
constexpr size_t O_CVS = O_KRS + (size_t)2 * TS * 32;
constexpr size_t O_DKP = O_CVS + (size_t)TS * 2048;
constexpr size_t O_DVP = O_DKP + (size_t)TP * 1024;
constexpr size_t O_DIP = O_DVP + (size_t)TP * 1024;
constexpr size_t O_DKS = O_DIP + (size_t)TP * 64;
constexpr size_t O_DVS = O_DKS + (size_t)TS * 1024;
constexpr size_t O_DIS = O_DVS + (size_t)TS * 1024;
constexpr size_t O_END = O_DIS + (size_t)TS * 64;

constexpr int NJOBS = 25;
struct Job { const float* src; bf16_t* dst; int nsrc, k, ndst, mode, tile0, pad; };
struct Params {
  const float* in[31];
  float* out;
  unsigned char* ws;
  Job jobs[NJOBS];
  int total_tiles, ph_lo, ph_hi, pad;
  double inv_freq[16];
};

#define CAS __attribute__((address_space(4)))
typedef const CAS Params CParams;
#define PREF const CAS Params&
DI unsigned pack2(float a, float b) { f32x2v v = {a, b}; bf2v r = __builtin_convertvector(v, bf2v); return __builtin_bit_cast(unsigned, r); }
DI bf16_t tobf(float a) { return (bf16_t)(pack2(a, 0.f) & 0xffffu); }
DI float frombf(bf16_t v) { return __uint_as_float(((unsigned)v) << 16); }
DI float bflo(unsigned u) { return __uint_as_float(u << 16); }
DI float bfhi(unsigned u) { return __uint_as_float(u & 0xffff0000u); }
DI float shflx(float v, int m, int lane) { return __int_as_float(__builtin_amdgcn_ds_bpermute((lane ^ m) << 2, __float_as_int(v))); }
DI float wave_sum(float v, int lane) {
#pragma unroll
  for (int o = 32; o >= 1; o >>= 1) v += shflx(v, o, lane);
  return v;
}
DI int ltid(int wv) { unsigned m1 = ~0u; asm volatile("" : "+s"(m1)); int t = (wv << 6) | (int)__builtin_amdgcn_mbcnt_hi(m1, __builtin_amdgcn_mbcnt_lo(m1, 0u)); asm volatile("" : "+v"(t)); return t; }
DI int crow(int i, int h) { return (i & 3) + 8 * (i >> 2) + 4 * h; }
DI int rowmap(int t) { if (t < TP) return t; int u = t - TP; return TP + (u >> 4) * SPAD + 1024 + (u & 15); }
DI int tokpos(int t) { return t < TP ? (t & 8191) : 1024 + ((t - TP) & 15); }

DI void transpose_tile(const float* __restrict__ src, int src_ld, int ncols, bf16_t* __restrict__ dst, int dst_ld,
                       int n0, int k0, int mode, float* sm, int tid, bool active) {
  const int nl = (tid & 15) * 4, kq = tid >> 4;
  const int n = n0 + nl;
  int c;
  if (mode != 1) c = n < ncols ? n : -1;
  else { int tt = n >> 5, r = n & 31; int f = tt * 16 + (r & 15); c = (r < 16) ? f : DFF + f; }
  int dr[4];
#pragma unroll
  for (int e = 0; e < 4; ++e) { int col = nl + e; dr[e] = (mode == 2) ? ((col & 32) + (col & 1) * 16 + ((col & 31) >> 1)) : col; }
  if (active) {
    float4 v[4];
#pragma unroll
    for (int i = 0; i < 4; ++i) {
      int kk = kq + 16 * i;
      v[i] = (c >= 0) ? *(const float4*)(src + (size_t)(k0 + kk) * src_ld + c) : make_float4(0.f, 0.f, 0.f, 0.f);
    }
#pragma unroll
    for (int i = 0; i < 4; ++i) {
      int kk = kq + 16 * i;
      float* d = sm + kk * 65;
      d[dr[0]] = v[i].x; d[dr[1]] = v[i].y; d[dr[2]] = v[i].z; d[dr[3]] = v[i].w;
    }
  }
  __syncthreads();
  if (active) {
    const int kp = (tid & 31) * 2, nr = tid >> 5;
#pragma unroll 4
    for (int i = 0; i < 8; ++i) {
      int nn = nr + 8 * i;
      float a = sm[kp * 65 + nn], b = sm[(kp + 1) * 65 + nn];
      *(unsigned*)(dst + (size_t)(n0 + nn) * dst_ld + k0 + kp) = pack2(a, b);
    }
  }
  __syncthreads();
}

enum { E_F32 = 0, E_RESID, E_SWIGLU, E_GELU, E_MLAQ, E_MLAKV, E_DSA };
struct EArgs {
  float* f0; float* f1; float* f2; float* f3; float* f4; float* f5; float* f6;
  bf16_t* b0; bf16_t* b1; bf16_t* b2; bf16_t* b3;
  const float* rope;
};
using f32x4v = __attribute__((ext_vector_type(4))) float;
#define LAS __attribute__((address_space(3)))
constexpr int G_HT = 128 * 64;
DI int lds_byte(int r, int c) {
  int st = (r >> 4) * 2 + (c >> 5), rr = r & 15, cc = c & 31, ob = rr * 64 + cc * 2;
  return st * 1024 + (ob ^ (((ob >> 9) & 1) << 5));
}
DI void stage_rc(int b, int& R, int& C) {
  int st = b >> 10, sb = b & 1023, swz = sb ^ (((sb >> 9) & 1) << 5);
  R = (st >> 1) * 16 + (swz >> 6); C = (st & 1) * 32 + ((swz & 63) >> 1);
}

template <int EPI, bool ATOM>
DI void epi16(const EArgs& ea, int row0, int gb, int fr, const f32x4v& v0, const f32x4v& v1) {
  if constexpr (EPI == E_F32) {
#pragma unroll
    for (int j = 0; j < 4; ++j) *(float2*)(ea.f0 + (size_t)(row0 + j) * 1024 + gb + 2 * fr) = make_float2(v0[j], v1[j]);
  } else if constexpr (EPI == E_RESID) {
#pragma unroll
    for (int j = 0; j < 4; ++j) { float* o = ea.f0 + (size_t)(row0 + j) * 1024 + gb + 2 * fr;
      if constexpr (ATOM) { unsafeAtomicAdd(o, v0[j]); unsafeAtomicAdd(o + 1, v1[j]); }
      else { float2 x = *(float2*)o; x.x += v0[j]; x.y += v1[j]; *(float2*)o = x; } }
  } else if constexpr (EPI == E_SWIGLU) {
    const int f = (gb >> 1) + fr;
#pragma unroll
    for (int j = 0; j < 4; ++j) { float g = v0[j], u = v1[j]; ea.b0[(size_t)(row0 + j) * DFF + f] = tobf(g / (1.f + __expf(-g)) * u); }
  } else if constexpr (EPI == E_GELU) {
    bf16_t* dstp = (gb < 2048) ? (ea.b0 + gb + 2 * fr) : (ea.b1 + (gb - 2048) + 2 * fr);
#pragma unroll
    for (int j = 0; j < 4; ++j) {
      float x = v0[j], y = v1[j];
      *(unsigned*)(dstp + (size_t)(row0 + j) * 2048) = pack2(0.5f * x * (1.f + erff(x * 0.70710678118654752f)), 0.5f * y * (1.f + erff(y * 0.70710678118654752f)));
    }
  } else if constexpr (EPI == E_MLAQ) {
    const float qs = 0.10206207261596577f * LOG2E;
    const bool is_rope = (gb % 96) == 64;
#pragma unroll
    for (int j = 0; j < 4; ++j) {
      const int row = row0 + j;
      float o0 = v0[j], o1 = v1[j];
      if (is_rope) {
        float2 cs = *(const float2*)(ea.rope + ((size_t)tokpos(row) * 16 + fr) * 2);
        o0 = v0[j] * cs.x - v1[j] * cs.y; o1 = v0[j] * cs.y + v1[j] * cs.x;
      }
      bf16_t* o = ea.b0 + (size_t)row * 1536 + gb + fr;
      o[0] = tobf(o0 * qs); o[16] = tobf(o1 * qs);
    }
  } else if constexpr (EPI == E_MLAKV) {
    const int head = gb >> 7, c0 = gb & 127;
    if (c0 < 64) {
#pragma unroll
      for (int j = 0; j < 4; ++j) *(unsigned*)(ea.b0 + (size_t)(row0 + j) * 1024 + head * 64 + c0 + 2 * fr) = pack2(v0[j], v1[j]);
    } else {
      const int d = c0 - 64 + 2 * fr;
      size_t off, dstr;
      if (row0 < TP) { int b = row0 >> 13, s = row0 & 8191; off = ((size_t)((b * 16 + head) * 64 + d)) * 8192 + s; dstr = 8192; }
      else { int u = row0 - TP; int b = u / SPAD, s = u - b * SPAD; off = (size_t)TP * 1024 + ((size_t)((b * 16 + head) * 64 + d)) * SPAD + s; dstr = SPAD; }
      uint2 pk; pk.x = pack2(v0[0], v0[1]); pk.y = pack2(v0[2], v0[3]); *(uint2*)(ea.b1 + off) = pk;
      pk.x = pack2(v1[0], v1[1]); pk.y = pack2(v1[2], v1[3]); *(uint2*)(ea.b1 + off + dstr) = pk;
    }
  } else if constexpr (EPI == E_DSA) {
    if (gb < 1024) {
      const float qs = 0.125f * LOG2E;
#pragma unroll
      for (int j = 0; j < 4; ++j) *(unsigned*)(ea.b0 + (size_t)(row0 + j) * 1024 + gb + 2 * fr) = pack2(v0[j] * qs, v1[j] * qs);
    } else if (gb < 2048) {
      const int c = gb - 1024 + 2 * fr;
#pragma unroll
      for (int j = 0; j < 4; ++j) {
        const int row = row0 + j;
        float* o = (row < TP) ? ea.f0 + (size_t)row * 1024 + c : ea.f1 + (size_t)(row - TP) * 1024 + c;
        *(float2*)o = make_float2(v0[j], v1[j]);
        *(unsigned*)(ea.b1 + (size_t)rowmap(row) * 1024 + c) = pack2(v0[j], v1[j]);
      }
    } else if (gb < 3072) {
      const int c = gb - 2048 + 2 * fr, head = c >> 6, d = c & 63;
#pragma unroll
      for (int j = 0; j < 4; ++j) {
        const int row = row0 + j;
        float* o = (row < TP) ? ea.f2 + (size_t)row * 1024 + c : ea.f3 + (size_t)(row - TP) * 1024 + c;
        *(float2*)o = make_float2(v0[j], v1[j]);
      }
      size_t off, dstr;
      if (row0 < TP) { int b = row0 >> 13, s = row0 & 8191; off = ((size_t)((b * 16 + head) * 64 + d)) * 8192 + s; dstr = 8192; }
      else { int u = row0 - TP; int b = u >> 4, s = 1024 + (u & 15); off = (size_t)TP * 1024 + ((size_t)((b * 16 + head) * 64 + d)) * SPAD + s; dstr = SPAD; }
      uint2 pk; pk.x = pack2(v0[0], v0[1]); pk.y = pack2(v0[2], v0[3]); *(uint2*)(ea.b2 + off) = pk;
      pk.x = pack2(v1[0], v1[1]); pk.y = pack2(v1[2], v1[3]); *(uint2*)(ea.b2 + off + dstr) = pk;
    } else if (gb < 3584) {
      const int c = gb - 3072 + 2 * fr;
#pragma unroll
      for (int j = 0; j < 4; ++j) *(unsigned*)(ea.b3 + (size_t)(row0 + j) * 512 + c) = pack2(v0[j] * 0.125f, v1[j] * 0.125f);
    } else if (gb < 3648) {
      const int c = gb - 3584 + 2 * fr;
#pragma unroll
      for (int j = 0; j < 4; ++j) *(float2*)(ea.f4 + (size_t)(row0 + j) * 64 + c) = make_float2(v0[j], v1[j]);
    } else if (gb == 3648) {
      if (fr < 4) {
#pragma unroll
        for (int j = 0; j < 4; ++j) *(float2*)(ea.f5 + (size_t)(row0 + j) * 8 + 2 * fr) = make_float2(v0[j] * 0.35355339059327379f, v1[j] * 0.35355339059327379f);
      }
    }
  }
}

template <int EPI, bool ATOM>
DI void gemm256_tile(const bf16_t* __restrict__ A, const bf16_t* __restrict__ Bt, const int K, const int kt0, const int nt, const int brow, const int bcol,
                     const EArgs& ea, unsigned char* smem, int wv) {
  bf16_t* shm = (bf16_t*)smem;
  const int tid = ltid(wv);
#define SA(b, h) (shm + ((b) * 2 + (h)) * G_HT)
#define SB(b, h) (shm + (4 + (b) * 2 + (h)) * G_HT)
#define STAGE(P, BASE, br, kt) do { const char* _gb = (const char*)((BASE) + (long)(br) * K + (long)((kt) + kt0) * 64); \
    __builtin_amdgcn_global_load_lds((const unsigned*)(_gb + voff0), (LAS unsigned*)((char*)(P) + tid * 16), 16, 0, 0); \
    __builtin_amdgcn_global_load_lds((const unsigned*)(_gb + voff1), (LAS unsigned*)((char*)(P) + tid * 16 + 8192), 16, 0, 0); } while (0)
#define LDA(dst, b, h) _Pragma("unroll") for (int m = 0; m < 4; ++m) _Pragma("unroll") for (int k = 0; k < 2; ++k) \
    dst[m][k] = *reinterpret_cast<const bf16x8*>((char*)SA(b, h) + lds_byte(wr * 64 + m * 16 + fr, k * 32 + fq * 8))
#define LDB(dst, b, h) _Pragma("unroll") for (int n = 0; n < 2; ++n) _Pragma("unroll") for (int k = 0; k < 2; ++k) \
    dst[n][k] = *reinterpret_cast<const bf16x8*>((char*)SB(b, h) + lds_byte(wc * 32 + n * 16 + fr, k * 32 + fq * 8))
#define MMA(ai, bj, At_, Bt_) do { __builtin_amdgcn_s_setprio(1); \
    _Pragma("unroll") for (int m = 0; m < 4; ++m) _Pragma("unroll") for (int n = 0; n < 2; ++n) _Pragma("unroll") for (int k = 0; k < 2; ++k) \
      acc[ai][bj][m][n] = __builtin_amdgcn_mfma_f32_16x16x32_bf16(At_[m][k], Bt_[n][k], acc[ai][bj][m][n], 0, 0, 0); \
    __builtin_amdgcn_s_setprio(0); } while (0)
#define WAIT_V(n) asm volatile("s_waitcnt vmcnt(" #n ")" ::: "memory")
#define WAIT_L(n) asm volatile("s_waitcnt lgkmcnt(" #n ")" ::: "memory")
#define BAR __builtin_amdgcn_s_barrier()
#define SCHED __builtin_amdgcn_sched_barrier(0)
  const int wid = tid >> 6, lane = tid & 63, wr = wid >> 2, wc = wid & 3, fr = lane & 15, fq = lane >> 4;
  unsigned voff0, voff1;
  { int r_, c_; stage_rc(tid * 16, r_, c_); voff0 = (unsigned)(r_ * K + c_) * 2u; stage_rc(tid * 16 + 8192, r_, c_); voff1 = (unsigned)(r_ * K + c_) * 2u; }
  f32x4v acc[2][2][4][2];
#pragma unroll
  for (int a = 0; a < 2; ++a)
#pragma unroll
    for (int b = 0; b < 2; ++b)
#pragma unroll
      for (int m = 0; m < 4; ++m)
#pragma unroll
        for (int n = 0; n < 2; ++n) acc[a][b][m][n] = (f32x4v){0.f, 0.f, 0.f, 0.f};
  bf16x8 At[4][2], B0[2][2], B1[2][2];
  const int HALF = 128;
  WAIT_V(0); WAIT_L(0); BAR;
  STAGE(SB(0, 0), Bt, bcol, 0); STAGE(SA(0, 0), A, brow, 0);
  STAGE(SB(0, 1), Bt, bcol + HALF, 0); STAGE(SA(0, 1), A, brow + HALF, 0);
  if (wr == 1) BAR;
  WAIT_V(4); BAR;
  STAGE(SB(1, 0), Bt, bcol, 1); STAGE(SA(1, 0), A, brow, 1); STAGE(SB(1, 1), Bt, bcol + HALF, 1);
  WAIT_V(6); BAR;
  for (int t = 0; t < nt - 2; t += 2) {
    LDB(B0, 0, 0); SCHED; LDA(At, 0, 0); STAGE(SA(1, 1), A, brow + HALF, t + 1);
    WAIT_L(8); BAR; WAIT_L(0); MMA(0, 0, At, B0); BAR; SCHED;
    LDB(B1, 0, 1); STAGE(SB(0, 0), Bt, bcol, t + 2);
    BAR; WAIT_L(0); MMA(0, 1, At, B1); BAR;
    LDA(At, 0, 1); STAGE(SA(0, 0), A, brow, t + 2);
    BAR; WAIT_L(0); MMA(1, 0, At, B0); BAR; SCHED;
    STAGE(SB(0, 1), Bt, bcol + HALF, t + 2);
    WAIT_V(6); BAR; MMA(1, 1, At, B1); BAR;
    LDB(B0, 1, 0); SCHED; LDA(At, 1, 0); STAGE(SA(0, 1), A, brow + HALF, t + 2);
    WAIT_L(8); BAR; WAIT_L(0); MMA(0, 0, At, B0); BAR; SCHED;
    LDB(B1, 1, 1); STAGE(SB(1, 0), Bt, bcol, t + 3);
    BAR; WAIT_L(0); MMA(0, 1, At, B1); BAR;
    LDA(At, 1, 1); STAGE(SA(1, 0), A, brow, t + 3);
    BAR; WAIT_L(0); MMA(1, 0, At, B0); BAR; SCHED;
    STAGE(SB(1, 1), Bt, bcol + HALF, t + 3);
    WAIT_V(6); BAR; MMA(1, 1, At, B1); BAR;
  }
  { LDB(B0, 0, 0); LDA(At, 0, 0); STAGE(SA(1, 1), A, brow + HALF, nt - 1);
    BAR; WAIT_L(0); MMA(0, 0, At, B0); BAR;
    LDB(B1, 0, 1); BAR; WAIT_L(0); MMA(0, 1, At, B1); BAR;
    LDA(At, 0, 1); WAIT_V(4); BAR; WAIT_L(0); MMA(1, 0, At, B0); MMA(1, 1, At, B1); BAR; }
  { LDB(B0, 1, 0); LDA(At, 1, 0); WAIT_V(2); BAR; WAIT_L(0); MMA(0, 0, At, B0); BAR;
    LDB(B1, 1, 1); WAIT_V(0); BAR; WAIT_L(0); MMA(0, 1, At, B1); BAR;
    LDA(At, 1, 1); BAR; WAIT_L(0); MMA(1, 0, At, B0); MMA(1, 1, At, B1); BAR; }
  if (wr == 0) BAR;
#pragma unroll
  for (int ai = 0; ai < 2; ++ai)
#pragma unroll
    for (int bj = 0; bj < 2; ++bj)
#pragma unroll
      for (int m = 0; m < 4; ++m)
      { epi16<EPI, ATOM>(ea, brow + ai * 128 + wr * 64 + m * 16 + fq * 4, bcol + bj * 128 + wc * 32, fr, acc[ai][bj][m][0], acc[ai][bj][m][1]); __builtin_amdgcn_sched_barrier(0); }
#undef SA
#undef SB
#undef STAGE
#undef LDA
#undef LDB
#undef MMA
#undef WAIT_V
#undef WAIT_L
#undef BAR
#undef SCHED
}

DI void tile_map(int t, int nM, int nN, int nwg, int& pm, int& pn) {
  int wgid = t;
  { int q = nwg >> 3, r = nwg & 7, xcd = wgid & 7, off = wgid >> 3; wgid = (xcd < r ? xcd * (q + 1) : r * (q + 1) + (xcd - r) * q) + off; }
  const int nig = 8 * nN, gid = wgid / nig, fm = gid * 8, gsz = min(nM - fm, 8);
  pm = fm + ((wgid % nig) % gsz); pn = (wgid % nig) / gsz;
}
template <int EPI>
DI void gemm_phase(const bf16_t* A, const bf16_t* Bt, int M, int N, int K, const EArgs& ea,
                   unsigned char* smem, int tstart, int bid, int nblk, int wv) {
  const int nM = M >> 8, nN = N >> 8, nwg = nM * nN, nt = K >> 6;
  if constexpr (EPI == E_RESID) {
    const int nfull = (nwg / nblk) * nblk, rem = nwg - nfull;
    for (int t = bid; t < nfull; t += nblk) {
      int pm, pn; tile_map(t, nM, nN, nwg, pm, pn);
      gemm256_tile<EPI, false>(A, Bt, K, 0, nt, pm * 256, pn * 256, ea, smem, wv);
    }
    if (rem > 0) {
      int ns = nblk / rem; if (ns > (nt >> 3)) ns = nt >> 3; if (ns < 1) ns = 1;
      const int per = ((nt / ns) >> 1) << 1;
      for (int u = bid; u < rem * ns; u += nblk) {
        const int t = nfull + u / ns, ks = u % ns;
        const int k0 = ks * per, kn = (ks == ns - 1) ? (nt - k0) : per;
        int pm, pn; tile_map(t, nM, nN, nwg, pm, pn);
        gemm256_tile<EPI, true>(A, Bt, K, k0, kn, pm * 256, pn * 256, ea, smem, wv);
      }
    }
  } else {
    int t0 = bid - (tstart % nblk); if (t0 < 0) t0 += nblk;
    for (int t = t0; t < nwg; t += nblk) {
      int pm, pn; tile_map(t, nM, nN, nwg, pm, pn);
      gemm256_tile<EPI, false>(A, Bt, K, 0, nt, pm * 256, pn * 256, ea, smem, wv);
    }
  }
}

DI void rmsnorm_rows(const float* __restrict__ X, const float* __restrict__ g, bf16_t* __restrict__ H, float* outp, float* outs,
                     int bid, int nblk, int wv) {
  const int lane = ltid(wv) & 63, w = ltid(wv) >> 6;
  for (int row = bid * 8 + w; row < T; row += nblk * 8) {
    const float* xr = X + (size_t)row * 1024;
    float4 v[4];
    float ss = 0.f;
#pragma unroll
    for (int c = 0; c < 4; ++c) { v[c] = *(const float4*)(xr + c * 256 + lane * 4); ss += v[c].x * v[c].x + v[c].y * v[c].y + v[c].z * v[c].z + v[c].w * v[c].w; }
    ss = wave_sum(ss, lane);
    float r = rsqrtf(ss * (1.f / 1024.f) + EPS);
#pragma unroll
    for (int c = 0; c < 4; ++c) {
      int col = c * 256 + lane * 4;
      float4 gg = *(const float4*)(g + col);
      float a = v[c].x * r * gg.x, b = v[c].y * r * gg.y, cc = v[c].z * r * gg.z, d = v[c].w * r * gg.w;
      if (H) { uint2 pk; pk.x = pack2(a, b); pk.y = pack2(cc, d); *(uint2*)(H + (size_t)row * 1024 + col) = pk; }
      else {
        float* o = (row < TP) ? outp + (size_t)row * 1024 + col : outs + (size_t)(row - TP) * 1024 + col;
        *(float4*)o = make_float4(a, b, cc, d);
      }
    }
  }
}

DI void mla_rowops(PREF p, int j, int bid, int nblk, int wv) {
  const int lane = ltid(wv) & 63, w = ltid(wv) >> 6;
  unsigned char* R = p.ws + OFF_R;
  const float* RAW = (const float*)(R + R_RAW);
  bf16_t* CQ = (bf16_t*)(R + R_CQ); bf16_t* CKV = (bf16_t*)(R + R_CKV); bf16_t* KR = (bf16_t*)(R + R_KR);
  const float* gq = p.in[11] + j * 512; const float* gkv = p.in[14] + j * 256;
  const float* rope = (const float*)(p.ws + OFF_ROPE);
  for (int row = bid * 8 + w; row < T; row += nblk * 8) {
    const float* rr = RAW + (size_t)row * 1024;
    float4 a0 = *(const float4*)(rr + lane * 4), a1 = *(const float4*)(rr + 256 + lane * 4);
    float4 c0 = *(const float4*)(rr + 512 + lane * 4);
    float ss = a0.x * a0.x + a0.y * a0.y + a0.z * a0.z + a0.w * a0.w + a1.x * a1.x + a1.y * a1.y + a1.z * a1.z + a1.w * a1.w;
    float s2 = c0.x * c0.x + c0.y * c0.y + c0.z * c0.z + c0.w * c0.w;
    ss = wave_sum(ss, lane); s2 = wave_sum(s2, lane);
    float r1 = rsqrtf(ss * (1.f / 512.f) + EPS), r2 = rsqrtf(s2 * (1.f / 256.f) + EPS);
    {
      float4 g0 = *(const float4*)(gq + lane * 4), g1 = *(const float4*)(gq + 256 + lane * 4);
      uint2 pk; pk.x = pack2(a0.x * r1 * g0.x, a0.y * r1 * g0.y); pk.y = pack2(a0.z * r1 * g0.z, a0.w * r1 * g0.w);
      *(uint2*)(CQ + (size_t)row * 512 + lane * 4) = pk;
      pk.x = pack2(a1.x * r1 * g1.x, a1.y * r1 * g1.y); pk.y = pack2(a1.z * r1 * g1.z, a1.w * r1 * g1.w);
      *(uint2*)(CQ + (size_t)row * 512 + 256 + lane * 4) = pk;
    }
    const int rm = rowmap(row);
    {
      float4 g = *(const float4*)(gkv + lane * 4);
      float4 o = make_float4(c0.x * r2 * g.x, c0.y * r2 * g.y, c0.z * r2 * g.z, c0.w * r2 * g.w);
      float* op = (row < TP) ? p.out + O_CKVP + ((size_t)j * TP + row) * 256 : p.out + O_CKVS + ((size_t)j * TS + (row - TP)) * 256;
      *(float4*)(op + lane * 4) = o;
      uint2 pk; pk.x = pack2(o.x, o.y); pk.y = pack2(o.z, o.w);
      *(uint2*)(CKV + (size_t)rm * 256 + lane * 4) = pk;
    }
    if (lane < 16) {
      float x1 = rr[768 + lane], x2 = rr[784 + lane];
      int pos = tokpos(row);
      float2 cs = *(const float2*)(rope + ((size_t)pos * 16 + lane) * 2);
      float o1 = x1 * cs.x - x2 * cs.y, o2 = x1 * cs.y + x2 * cs.x;
      float* op = (row < TP) ? p.out + O_KRP + ((size_t)j * TP + row) * 32 : p.out + O_KRS + ((size_t)j * TS + (row - TP)) * 32;
      op[lane] = o1; op[16 + lane] = o2;
      KR[(size_t)rm * 32 + lane] = tobf(o1); KR[(size_t)rm * 32 + 16 + lane] = tobf(o2);
    }
  }
}

DI void dsa_rowops(PREF p, int bid, int nblk, int wv) {
  const int lane = ltid(wv) & 63, w = ltid(wv) >> 6;
  unsigned char* R = p.ws + OFF_R;
  const float* KIR = (const float*)(R + D_KIR);
  bf16_t* KI = (bf16_t*)(R + D_KI);
  const float* g = p.in[27];
  for (int row = bid * 8 + w; row < T; row += nblk * 8) {
    float v = KIR[(size_t)row * 64 + lane];
    float ss = wave_sum(v * v, lane);
    float r = rsqrtf(ss * (1.f / 64.f) + EPS);
    float o = v * r * g[lane];
    if (row < TP) p.out[O_DIP + (size_t)row * 64 + lane] = o; else p.out[O_DIS + (size_t)(row - TP) * 64 + lane] = o;
    KI[(size_t)rowmap(row) * 64 + lane] = tobf(o);
  }
}

DI void cmlp_ln_rows(PREF p, int bid, int nblk, int wv) {
  const int lane = ltid(wv) & 63, w = ltid(wv) >> 6;
  unsigned char* R = p.ws + OFF_R;
  const bf16_t* VR = (const bf16_t*)(R + C_VR);
  bf16_t* VLN = (bf16_t*)(R + C_VLN);
  const float* g = p.in[18]; const float* bb = p.in[19];
  for (int row = bid * 8 + w; row < T; row += nblk * 8) {
    float x[32];
    float sum = 0.f;
#pragma unroll
    for (int c = 0; c < 4; ++c) {
      uint4 u = *(const uint4*)(VR + (size_t)row * 2048 + c * 512 + lane * 8);
      x[c * 8 + 0] = bflo(u.x); x[c * 8 + 1] = bfhi(u.x); x[c * 8 + 2] = bflo(u.y); x[c * 8 + 3] = bfhi(u.y);
      x[c * 8 + 4] = bflo(u.z); x[c * 8 + 5] = bfhi(u.z); x[c * 8 + 6] = bflo(u.w); x[c * 8 + 7] = bfhi(u.w);
    }
#pragma unroll
    for (int i = 0; i < 32; ++i) sum += x[i];
    sum = wave_sum(sum, lane);
    float mu = sum * (1.f / 2048.f);
    float vs = 0.f;
#pragma unroll
    for (int i = 0; i < 32; ++i) { x[i] -= mu; vs += x[i] * x[i]; }
    vs = wave_sum(vs, lane);
    float r = rsqrtf(vs * (1.f / 2048.f) + EPS);
#pragma unroll
    for (int c = 0; c < 4; ++c) {
      int col = c * 512 + lane * 8;
      float y[8];
#pragma unroll
      for (int q = 0; q < 2; ++q) {
        float4 gg = *(const float4*)(g + col + q * 4), b4 = *(const float4*)(bb + col + q * 4);
        y[q * 4 + 0] = x[c * 8 + q * 4 + 0] * r * gg.x + b4.x; y[q * 4 + 1] = x[c * 8 + q * 4 + 1] * r * gg.y + b4.y;
        y[q * 4 + 2] = x[c * 8 + q * 4 + 2] * r * gg.z + b4.z; y[q * 4 + 3] = x[c * 8 + q * 4 + 3] * r * gg.w + b4.w;
      }
      uint4 pk; pk.x = pack2(y[0], y[1]); pk.y = pack2(y[2], y[3]); pk.z = pack2(y[4], y[5]); pk.w = pack2(y[6], y[7]);
      *(uint4*)(VLN + (size_t)row * 2048 + col) = pk;
      if (row >= TP) {
        float* o = p.out + O_CVS + (size_t)(row - TP) * 2048 + col;
        *(float4*)o = make_float4(y[0], y[1], y[2], y[3]); *(float4*)(o + 4) = make_float4(y[4], y[5], y[6], y[7]);
      }
    }
  }
}

DI void cmlp_mix_phase(PREF p, unsigned char* smem, int bid, int nblk, int wv) {
  const int tid = ltid(wv), lane = tid & 63, w = tid >> 6, wm = w >> 2, wn = w & 3, lr = lane & 31, lh = lane >> 5;
  unsigned char* R = p.ws + OFF_R;
  const bf16_t* U = (const bf16_t*)(R + C_U);
  const bf16_t* VLN = (const bf16_t*)(R + C_VLN);
  bf16_t* G = (bf16_t*)(R + C_G);
  const bf16_t* WT = (const bf16_t*)(p.ws + OFF_W) + W_TRIL;
  const float* bs = p.in[21];
  bf16_t* As = (bf16_t*)smem;
  bf16_t* Bs = As + 128 * 136;
  for (int u = bid; u < 1024; u += nblk) {
    const int g = u & 7, ch = u >> 3;
    const int col0 = g * 256;
#pragma unroll 2
    for (int i = 0; i < 4; ++i) {
      int v = tid + i * NT; int r = v >> 4, c = (v & 15) * 8;
      *(uint4*)(As + r * 136 + c) = *(const uint4*)(WT + ((size_t)g * 128 + r) * 128 + c);
    }
#pragma unroll 2
    for (int i = 0; i < 8; ++i) {
      int v = tid + i * NT; int s = v >> 5, c = (v & 31) * 8;
      uint4 x = *(const uint4*)(VLN + ((size_t)ch * 128 + s) * 2048 + col0 + c);
      Bs[(c + 0) * 136 + s] = (bf16_t)(x.x & 0xffff); Bs[(c + 1) * 136 + s] = (bf16_t)(x.x >> 16);
      Bs[(c + 2) * 136 + s] = (bf16_t)(x.y & 0xffff); Bs[(c + 3) * 136 + s] = (bf16_t)(x.y >> 16);
      Bs[(c + 4) * 136 + s] = (bf16_t)(x.z & 0xffff); Bs[(c + 5) * 136 + s] = (bf16_t)(x.z >> 16);
      Bs[(c + 6) * 136 + s] = (bf16_t)(x.w & 0xffff); Bs[(c + 7) * 136 + s] = (bf16_t)(x.w >> 16);
    }
    __syncthreads();
    f32x16 acc[2][2];
#pragma unroll
    for (int a = 0; a < 2; ++a)
#pragma unroll
      for (int b = 0; b < 2; ++b)
#pragma unroll
        for (int i = 0; i < 16; ++i) acc[a][b][i] = 0.f;
    const bf16_t* Asb = As + (wm * 64 + lr) * 136 + lh * 8;
    const bf16_t* Bsb = Bs + (wn * 64 + lr) * 136 + lh * 8;
    const int ns = (wm + 1) * 4;
    for (int s = 0; s < ns; ++s) {
      bf16x8 a0 = *(const bf16x8*)(Asb + s * 16);
      bf16x8 a1 = *(const bf16x8*)(Asb + 32 * 136 + s * 16);
      bf16x8 b0 = *(const bf16x8*)(Bsb + s * 16);
      bf16x8 b1 = *(const bf16x8*)(Bsb + 32 * 136 + s * 16);
      acc[0][0] = MFMA32(a0, b0, acc[0][0]);
      acc[0][1] = MFMA32(a0, b1, acc[0][1]);
      acc[1][0] = MFMA32(a1, b0, acc[1][0]);
      acc[1][1] = MFMA32(a1, b1, acc[1][1]);
    }
#pragma unroll
    for (int mi = 0; mi < 2; ++mi)
#pragma unroll
      for (int ni = 0; ni < 2; ++ni)
#pragma unroll
        for (int i = 0; i < 16; ++i) {
          int t = wm * 64 + mi * 32 + crow(i, lh);
          int col = col0 + wn * 64 + ni * 32 + lr;
          size_t off = ((size_t)ch * 128 + t) * 2048 + col;
          float mixed = acc[mi][ni][i] + bs[g * 128 + t];
          G[off] = tobf(frombf(U[off]) * mixed);
        }
    __syncthreads();
  }
  const float* wsf = p.in[20];
  for (int e = bid * NT + tid; e < TS * 2048; e += nblk * NT) {
    int row = e >> 11, col = e & 2047, b = row >> 4, t = row & 15, g = col >> 8;
    float a = bs[g * 128 + t];
    for (int s = 0; s <= t; ++s) a += wsf[((size_t)g * 128 + t) * 128 + s] * frombf(VLN[((size_t)TP + b * 16 + s) * 2048 + col]);
    size_t off = ((size_t)TP + row) * 2048 + col;
    G[off] = tobf(frombf(U[off]) * a);
  }
}

template <int DQK, bool IS_MLA, bool MASKED>
DI void attn8_unit(const bf16_t* __restrict__ Qp, int ldq, int nq,
                   const bf16_t* __restrict__ Kp, int ldk, const bf16_t* __restrict__ KRp,
                   const bf16_t* __restrict__ Vtp, int ldv, int kmax,
                   int nit, int nk64_w, int nkeys, const unsigned* __restrict__ BMp,
                   bf16_t* __restrict__ AOp, unsigned char* smem, int wv) {
  constexpr int KS = DQK + 8;
  constexpr int VS = 136;
  constexpr int NQS = DQK / 16;
  const int tid = ltid(wv), lane = tid & 63, w = tid >> 6, lr = lane & 31, lh = lane >> 5;
  bf16_t* Ks = (bf16_t*)smem;
  bf16_t* Vs = Ks + 2 * 128 * KS;
  const bool q_ok = (w * 32 + lr) < nq;
  const int qrow = q_ok ? (w * 32 + lr) : 0;
  bf16x8 qf[NQS];
#pragma unroll
  for (int s = 0; s < NQS; ++s) qf[s] = *(const bf16x8*)(Qp + (size_t)qrow * ldq + s * 16 + lh * 8);
  f32x16 oacc[2];
#pragma unroll
  for (int d = 0; d < 2; ++d)
#pragma unroll
    for (int i = 0; i < 16; ++i) oacc[d][i] = 0.f;
  float m_run = -INFINITY, l_run = 0.f;
  const int kkey = tid >> 3, kc = (tid & 7) * 8;
  const int rkey = tid >> 2, rc = (tid & 3) * 8;
  const int vd = tid >> 4, vk = (tid & 15) * 8;
  const int vpos = (vk & 96) + ((vk >> 4) & 1) * 16 + ((vk >> 3) & 1) * 4;
  uint4 rk0, rk1, rr, rv0, rv1;
  rr = make_uint4(0, 0, 0, 0);
  uint4 bm_next = make_uint4(0xffffffffu, 0xffffffffu, 0xffffffffu, 0xffffffffu), bm_cur = bm_next;
#define GLOAD(it_) do { const int key0_ = (it_) * 128; \
    { int kr_ = min(key0_ + kkey, kmax - 1); rk0 = *(const uint4*)(Kp + (size_t)kr_ * ldk + kc); } \
    { int kr_ = min(key0_ + kkey + 64, kmax - 1); rk1 = *(const uint4*)(Kp + (size_t)kr_ * ldk + kc); } \
    if constexpr (IS_MLA) { int kr_ = min(key0_ + rkey, kmax - 1); rr = *(const uint4*)(KRp + (size_t)kr_ * 32 + rc); } \
    { int kv_ = min(key0_ + vk, kmax - 8); rv0 = *(const uint4*)(Vtp + (size_t)vd * ldv + kv_); rv1 = *(const uint4*)(Vtp + (size_t)(vd + 32) * ldv + kv_); } \
    if constexpr (MASKED) { if (BMp) bm_next = *(const uint4*)(BMp + (size_t)qrow * 256 + (it_) * 4); } } while (0)
#define SSTORE(buf_) do { bf16_t* Kb_ = Ks + (buf_) * 128 * KS; bf16_t* Vb_ = Vs + (buf_) * 64 * VS; \
    *(uint4*)(Kb_ + kkey * KS + kc) = rk0; *(uint4*)(Kb_ + (kkey + 64) * KS + kc) = rk1; \
    if constexpr (IS_MLA) *(uint4*)(Kb_ + rkey * KS + 64 + rc) = rr; \
    *(uint2*)(Vb_ + vd * VS + vpos) = make_uint2(rv0.x, rv0.y); *(uint2*)(Vb_ + vd * VS + vpos + 8) = make_uint2(rv0.z, rv0.w); \
    *(uint2*)(Vb_ + (vd + 32) * VS + vpos) = make_uint2(rv1.x, rv1.y); *(uint2*)(Vb_ + (vd + 32) * VS + vpos + 8) = make_uint2(rv1.z, rv1.w); } while (0)
  const int nit_w = (nk64_w + 1) >> 1;
  __syncthreads();
  GLOAD(0); SSTORE(0); bm_cur = bm_next;
  __syncthreads();
  for (int it = 0; it < nit; ++it) {
    const int buf = it & 1;
    if (it + 1 < nit) GLOAD(it + 1);
    if (it < nit_w) {
      const bf16_t* Kb = Ks + buf * 128 * KS; const bf16_t* Vb = Vs + buf * 64 * VS;
      f32x16 sacc[4];
#pragma unroll
      for (int t4 = 0; t4 < 4; ++t4) {
#pragma unroll
        for (int i = 0; i < 16; ++i) sacc[t4][i] = 0.f;
#pragma unroll
        for (int s = 0; s < NQS; ++s) {
          bf16x8 kf = *(const bf16x8*)(Kb + (t4 * 32 + lr) * KS + s * 16 + lh * 8);
          sacc[t4] = MFMA32(kf, qf[s], sacc[t4]);
        }
      }
      if ((2 * it + 1) >= nk64_w) {
#pragma unroll
        for (int t4 = 2; t4 < 4; ++t4)
#pragma unroll
          for (int i = 0; i < 16; ++i) sacc[t4][i] = -INFINITY;
      }
      float mx = -INFINITY;
#pragma unroll
      for (int t4 = 0; t4 < 4; ++t4) {
        const unsigned wbits = (t4 == 0) ? bm_cur.x : (t4 == 1) ? bm_cur.y : (t4 == 2) ? bm_cur.z : bm_cur.w;
#pragma unroll
        for (int i = 0; i < 16; ++i) {
          if constexpr (MASKED) {
            const int kin = crow(i, lh);
            const int key = it * 128 + t4 * 32 + kin;
            bool ok = (key < nkeys) && ((wbits >> kin) & 1u);
            sacc[t4][i] = ok ? sacc[t4][i] : -INFINITY;
          }
          mx = fmaxf(mx, sacc[t4][i]);
        }
      }
      mx = fmaxf(mx, shflx(mx, 32, lane));
      const float m_new = fmaxf(m_run, mx);
      const float m_safe = (m_new == -INFINITY) ? 0.f : m_new;
      const float alpha = __builtin_amdgcn_exp2f(m_run - m_safe);
      m_run = m_new;
      float ls = 0.f;
#pragma unroll
      for (int t4 = 0; t4 < 4; ++t4)
#pragma unroll
        for (int i = 0; i < 16; ++i) { float pv = __builtin_amdgcn_exp2f(sacc[t4][i] - m_safe); sacc[t4][i] = pv; ls += pv; }
      l_run = l_run * alpha + ls;
#pragma unroll
      for (int d = 0; d < 2; ++d)
#pragma unroll
        for (int i = 0; i < 16; ++i) oacc[d][i] *= alpha;
#pragma unroll
      for (int t4 = 0; t4 < 4; ++t4)
#pragma unroll
        for (int s = 0; s < 2; ++s) {
          uint4 pp;
          pp.x = pack2(sacc[t4][8 * s + 0], sacc[t4][8 * s + 1]);
          pp.y = pack2(sacc[t4][8 * s + 2], sacc[t4][8 * s + 3]);
          pp.z = pack2(sacc[t4][8 * s + 4], sacc[t4][8 * s + 5]);
          pp.w = pack2(sacc[t4][8 * s + 6], sacc[t4][8 * s + 7]);
          bf16x8 pf = __builtin_bit_cast(bf16x8, pp);
#pragma unroll
          for (int dt = 0; dt < 2; ++dt) {
            bf16x8 vf = *(const bf16x8*)(Vb + (dt * 32 + lr) * VS + t4 * 32 + 16 * s + 8 * lh);
            oacc[dt] = MFMA32(vf, pf, oacc[dt]);
          }
        }
    }
    if (it + 1 < nit) { SSTORE(buf ^ 1); bm_cur = bm_next; }
    __syncthreads();
  }
  if (nit_w > 0) {
    float lt = l_run + shflx(l_run, 32, lane);
    float inv = lt > 0.f ? 1.f / lt : 0.f;
    if (q_ok) {
      bf16_t* orow = AOp + (size_t)(w * 32 + lr) * 1024;
#pragma unroll
      for (int dt = 0; dt < 2; ++dt)
#pragma unroll
        for (int g = 0; g < 4; ++g) {
          uint2 pk;
          pk.x = pack2(oacc[dt][4 * g] * inv, oacc[dt][4 * g + 1] * inv);
          pk.y = pack2(oacc[dt][4 * g + 2] * inv, oacc[dt][4 * g + 3] * inv);
          *(uint2*)(orow + dt * 32 + 8 * g + 4 * lh) = pk;
        }
    }
  }
}
#undef GLOAD
#undef SSTORE

DI int snake_idx(int i, int bid, int nblk) { return i * nblk + ((i & 1) ? (nblk - 1 - bid) : bid); }

template <bool IS_MLA>
DI void attn_phase(PREF p, unsigned char* smem, int bid, int nblk, int wv) {
  unsigned char* R = p.ws + OFF_R;
  const int w = ltid(wv) >> 6;
  const int total = 1024 + 512;
  for (int i = 0; i * nblk < total; ++i) {
    int u = snake_idx(i, bid, nblk);
    if (u >= total) continue;
    if constexpr (IS_MLA) {
      const bf16_t* Q = (const bf16_t*)(R + R_Q); const bf16_t* KN = (const bf16_t*)(R + R_KN);
      const bf16_t* KR = (const bf16_t*)(R + R_KR); const bf16_t* VT = (const bf16_t*)(R + R_VT);
      bf16_t* AO = (bf16_t*)(R + R_RAW);
      if (u < 1024) {
        int qt = 31 - (u >> 5), bh = u & 31, b = bh >> 4, h = bh & 15;
        int q0 = b * 8192 + qt * 256;
        attn8_unit<96, true, false>(Q + (size_t)q0 * 1536 + h * 96, 1536, 256,
                                    KN + (size_t)(b * 8192) * 1024 + h * 64, 1024, KR + (size_t)(b * 8192) * 32,
                                    VT + (size_t)((b * 16 + h) * 64) * 8192, 8192, 8192,
                                    2 * qt + 2, 4 * qt + 1 + (w >> 1), 1 << 30, nullptr,
                                    AO + (size_t)q0 * 1024 + h * 64, smem, wv);
      } else {
        int v = u - 1024, b = v >> 4, h = v & 15;
        int q0 = TP + b * 16;
        attn8_unit<96, true, true>(Q + (size_t)q0 * 1536 + h * 96, 1536, 16,
                                   KN + (size_t)(TP + b * SPAD) * 1024 + h * 64, 1024, KR + (size_t)(TP + b * SPAD) * 32,
                                   VT + (size_t)TP * 1024 + (size_t)((b * 16 + h) * 64) * SPAD, SPAD, SPAD,
                                   9, (w == 0) ? 17 : 0, NKS, nullptr,
                                   AO + (size_t)q0 * 1024 + h * 64, smem, wv);
      }
    } else {
      const bf16_t* Q = (const bf16_t*)(R + D_Q); const bf16_t* KK = (const bf16_t*)(R + D_K);
      const bf16_t* VT = (const bf16_t*)(R + D_VT); const unsigned* BM = (const unsigned*)(R + D_BM);
      bf16_t* AO = (bf16_t*)(R + D_AO);
      if (u < 1024) {
        int qt = 31 - (u >> 5), bh = u & 31, b = bh >> 4, h = bh & 15;
        int q0 = b * 8192 + qt * 256;
        attn8_unit<64, false, true>(Q + (size_t)q0 * 1024 + h * 64, 1024, 256,
                                    KK + (size_t)(b * 8192) * 1024 + h * 64, 1024, nullptr,
                                    VT + (size_t)((b * 16 + h) * 64) * 8192, 8192, 8192,
                                    2 * qt + 2, 4 * qt + 1 + (w >> 1), 1 << 30, BM + (size_t)q0 * 256,
                                    AO + (size_t)q0 * 1024 + h * 64, smem, wv);
      } else {
        int v = u - 1024, b = v >> 4, h = v & 15;
        int q0 = TP + b * 16;
        attn8_unit<64, false, true>(Q + (size_t)q0 * 1024 + h * 64, 1024, 16,
                                    KK + (size_t)(TP + b * SPAD) * 1024 + h * 64, 1024, nullptr,
                                    VT + (size_t)TP * 1024 + (size_t)((b * 16 + h) * 64) * SPAD, SPAD, SPAD,
                                    9, (w == 0) ? 17 : 0, NKS, BM + (size_t)q0 * 256,
                                    AO + (size_t)q0 * 1024 + h * 64, smem, wv);
      }
    }
  }
}

constexpr int CAP = 128;
DI int score_bin(float s) {
  unsigned u = __float_as_uint(s);
  int e = (int)((u & 0x7fffffffu) >> 19);
  int m = min(max(e, 1840), 2095) - 1840;
  return (u >> 31) ? (255 - m) : (256 + m);
}

DI void idx_unit(const bf16_t* __restrict__ QI, const float* __restrict__ WI, int q_row0, int nq,
                 const bf16_t* __restrict__ KI, int L, unsigned* __restrict__ BM, unsigned char* smem, int wv) {
  const int tid = ltid(wv), lane = tid & 63, w = tid >> 6, lr = lane & 31, lh = lane >> 5;
  bf16_t* Qs = (bf16_t*)smem;
  float* Ws = (float*)(smem + 36864);
  unsigned* hist = (unsigned*)(smem + 36864 + 1024);
  float* cand_s = (float*)hist;
  int* cand_i = (int*)(smem + 36864 + 1024 + 16384);
  int* bstar = (int*)(smem + 36864 + 1024 + 32768);
  int* need = bstar + 32;
  int* ncand = need + 32;
  __syncthreads();
#pragma unroll
  for (int i = 0; i < 4; ++i) {
    int v = tid + i * NT;
    int hd = v >> 8, q = (v >> 3) & 31, c = (v & 7) * 8;
    int qq = q < nq ? q : 0;
    *(uint4*)(Qs + (hd * 32 + q) * 72 + c) = *(const uint4*)(QI + (size_t)(q_row0 + qq) * 512 + hd * 64 + c);
  }
  if (tid < 256) { int hd = tid >> 5, q = tid & 31; int qq = q < nq ? q : 0; Ws[hd * 32 + q] = WI[(size_t)(q_row0 + qq) * 8 + hd]; }
  for (int i = tid; i < 32 * 256; i += NT) hist[i] = 0u;
  if (tid < 32) { bstar[tid] = -1; need[tid] = 0; ncand[tid] = 0; }
  __syncthreads();
  const int ntile = (L + 255) >> 8;
  const bool do_select = L > 256;
  int bsr[16];
  { int m1_ = -1; asm volatile("" : "+v"(m1_));
#pragma unroll
    for (int i = 0; i < 16; ++i) bsr[i] = m1_; }
  for (int pass = do_select ? 0 : 1; pass < 2; ++pass) {
    if (pass == 1) {
#pragma unroll
      for (int i = 0; i < 16; ++i) bsr[i] = bstar[crow(i, lh)];
    }
    bf16x8 kn0, kn1, kn2, kn3;
    { const bf16_t* kp = KI + (size_t)(w * 32 + lr) * 64 + lh * 8;
      kn0 = *(const bf16x8*)(kp); kn1 = *(const bf16x8*)(kp + 16); kn2 = *(const bf16x8*)(kp + 32); kn3 = *(const bf16x8*)(kp + 48); }
    for (int kt = 0; kt < ntile; ++kt) {
      const int key0 = kt * 256 + w * 32;
      bf16x8 kf[4];
      kf[0] = kn0; kf[1] = kn1; kf[2] = kn2; kf[3] = kn3;
      if (key0 + 256 < L) {
        const bf16_t* kp = KI + (size_t)(key0 + 256 + lr) * 64 + lh * 8;
        kn0 = *(const bf16x8*)(kp); kn1 = *(const bf16x8*)(kp + 16); kn2 = *(const bf16x8*)(kp + 32); kn3 = *(const bf16x8*)(kp + 48);
      }
      if (key0 < L) {
        const int key = key0 + lr;
        float sc[16];
#pragma unroll
        for (int i = 0; i < 16; ++i) sc[i] = 0.f;
#pragma unroll 1
        for (int hd = 0; hd < 8; ++hd) {
          f32x16 acc;
#pragma unroll
          for (int i = 0; i < 16; ++i) acc[i] = 0.f;
#pragma unroll
          for (int s = 0; s < 4; ++s) {
            bf16x8 qf = *(const bf16x8*)(Qs + (hd * 32 + lr) * 72 + s * 16 + lh * 8);
            acc = MFMA32(qf, kf[s], acc);
          }
#pragma unroll
          for (int g = 0; g < 4; ++g) {
            float4 wv = *(const float4*)(Ws + hd * 32 + 8 * g + 4 * lh);
            sc[4 * g + 0] += wv.x * fmaxf(acc[4 * g + 0], 0.f);
            sc[4 * g + 1] += wv.y * fmaxf(acc[4 * g + 1], 0.f);
            sc[4 * g + 2] += wv.z * fmaxf(acc[4 * g + 2], 0.f);
            sc[4 * g + 3] += wv.w * fmaxf(acc[4 * g + 3], 0.f);
          }
        }
        const bool kvalid = key < L;
        if (pass == 0) {
#pragma unroll
          for (int i = 0; i < 16; ++i) {
            int q = crow(i, lh);
            if (kvalid) { int b = score_bin(sc[i]); atomicAdd(&hist[q * 256 + (b >> 1)], (b & 1) ? 65536u : 1u); }
          }
        } else {
          unsigned myword = 0u, cmask = 0u;
          unsigned long long any = 0ull;
#pragma unroll
          for (int i = 0; i < 16; ++i) {
            const int b = score_bin(sc[i]);
            const int bs = bsr[i];
            const bool sel = kvalid && (b > bs);
            const bool cnd = kvalid && (b == bs);
            const unsigned long long bal = __ballot(sel);
            myword = (lr == i) ? (unsigned)(bal >> (32 * lh)) : myword;
            any |= __ballot(cnd);
            cmask |= cnd ? (1u << i) : 0u;
          }
          if (lr < 16 && crow(lr, lh) < nq) BM[(size_t)(q_row0 + crow(lr, lh)) * 256 + (key0 >> 5)] = myword;
          if (any != 0ull) {
            int base[16];
#pragma unroll
            for (int i = 0; i < 16; ++i) {
              const unsigned long long cbi = __ballot((cmask >> i) & 1u);
              base[i] = 0;
              if (lr == 0) base[i] = atomicAdd(&ncand[crow(i, lh)], __popc((unsigned)(cbi >> (32 * lh))));
            }
#pragma unroll
            for (int i = 0; i < 16; ++i) {
              const unsigned long long cbi = __ballot((cmask >> i) & 1u);
              const int bb = __builtin_amdgcn_ds_bpermute((lane & 32) << 2, base[i]);
              if ((cmask >> i) & 1u) {
                const unsigned hm = (unsigned)(cbi >> (32 * lh));
                const int pos = bb + __popc(hm & ((1u << lr) - 1u));
                const int q = crow(i, lh);
                if (pos < CAP) { cand_s[q * CAP + pos] = sc[i]; cand_i[q * CAP + pos] = key; }
              }
            }
          }
        }
      }
    }
    __syncthreads();
    if (pass == 0) {
      for (int qi = 0; qi < 4; ++qi) {
        const int q = w * 4 + qi;
        unsigned hw[4];
#pragma unroll
        for (int k = 0; k < 4; ++k) hw[k] = hist[q * 256 + 255 - 4 * lane - k];
        int cnt = 0;
#pragma unroll
        for (int k = 0; k < 4; ++k) cnt += (int)(hw[k] >> 16) + (int)(hw[k] & 0xffffu);
        int pre = cnt;
#pragma unroll
        for (int o = 1; o < 64; o <<= 1) { int t = __builtin_amdgcn_ds_bpermute(((lane - o) & 63) << 2, pre); if (lane >= o) pre += t; }
        unsigned long long bal = __ballot(pre >= 256);
        if (bal != 0ull) {
          int fl = __ffsll((long long)bal) - 1;
          if (lane == fl) {
            int running = pre - cnt;
            int bsel = -1, above = 0;
#pragma unroll
            for (int k = 0; k < 4; ++k) {
              int chi = (int)(hw[k] >> 16), clo = (int)(hw[k] & 0xffffu);
              if (bsel < 0) { if (running + chi >= 256) { bsel = 511 - 8 * lane - 2 * k; above = running; } else running += chi; }
              if (bsel < 0) { if (running + clo >= 256) { bsel = 510 - 8 * lane - 2 * k; above = running; } else running += clo; }
            }
            bstar[q] = bsel; need[q] = 256 - above;
          }
        }
      }
      __syncthreads();
    }
  }
  __threadfence();
  __syncthreads();
  if (do_select) {
    for (int pi = tid; pi < 32 * CAP; pi += NT) {
      int q = pi / CAP, c = pi - q * CAP;
      int n = min(ncand[q], CAP);
      if (c < n && q < nq) {
        float sv = cand_s[q * CAP + c]; int iv = cand_i[q * CAP + c];
        int rank = 0;
        for (int j = 0; j < n; ++j) {
          float sj = cand_s[q * CAP + j]; int ij = cand_i[q * CAP + j];
          rank += (sj > sv || (sj == sv && ij < iv)) ? 1 : 0;
        }
        if (rank < need[q]) atomicOr(&BM[(size_t)(q_row0 + q) * 256 + (iv >> 5)], 1u << (iv & 31));
      }
    }
  }
  __syncthreads();
}

DI void idx_phase(PREF p, unsigned char* smem, int bid, int nblk, int wv) {
  unsigned char* R = p.ws + OFF_R;
  const bf16_t* QI = (const bf16_t*)(R + D_QI); const float* WI = (const float*)(R + D_WI);
  const bf16_t* KI = (const bf16_t*)(R + D_KI); unsigned* BM = (unsigned*)(R + D_BM);
  const int total = 512 + 32;
  for (int i = 0; i * nblk < total; ++i) {
    int idx = snake_idx(i, bid, nblk);
    if (idx >= total) continue;
    if (idx < 512) {
      int qt = 255 - (idx >> 1), b = idx & 1;
      int L = (((qt * 32) >> 6) + 1) * 64;
      idx_unit(QI, WI, b * 8192 + qt * 32, 32, KI + (size_t)(b * 8192) * 64, L, BM, smem, wv);
    } else {
      int b = idx - 512;
      idx_unit(QI, WI, TP + b * 16, 16, KI + (size_t)(TP + b * SPAD) * 64, NKS, BM, smem, wv);
    }
  }
}

DI void cvt8(const float* s, bf16_t* d) {
  float4 a = *(const float4*)s, b = *(const float4*)(s + 4);
  uint4 pk; pk.x = pack2(a.x, a.y); pk.y = pack2(a.z, a.w); pk.z = pack2(b.x, b.y); pk.w = pack2(b.z, b.w);
  *(uint4*)d = pk;
}
DI void cache_rows(const float* __restrict__ src, bf16_t* __restrict__ dst, int Wd, int bid, int nblk, int wv) {
  const int vpr = Wd >> 3;
  const size_t total = (size_t)32 * SPAD * vpr;
  for (size_t e = (size_t)bid * NT + ltid(wv); e < total; e += (size_t)nblk * NT) {
    int c = (int)(e % vpr) * 8; size_t rw = e / vpr; int b = (int)(rw / SPAD), s = (int)(rw % SPAD);
    bf16_t* d = dst + ((size_t)TP + (size_t)b * SPAD + s) * Wd + c;
    if (s < 1024) cvt8(src + ((size_t)b * 1024 + s) * Wd + c, d);
    else if (s >= NKS) { unsigned z = 0; asm volatile("" : "+v"(z)); *(uint4*)d = make_uint4(z, z, z, z); }
  }
}


#define XB_TMO      128
#define XB_XCNT(j)  (256  + 64 * (j))
#define XB_XSUB(j)  (1280 + 64 * (j))
#define XB_XGEN(j)  (2304 + 64 * (j))
#define XB_TOP      3328
#define XB_TOPGEN   3392
#define XCD_BAR_WORDS 3456
#define XB_SPIN_CAP (1u << 18)
DI unsigned xb_ld(unsigned* p)              { return __hip_atomic_load(p, __ATOMIC_RELAXED, __HIP_MEMORY_SCOPE_AGENT); }
DI unsigned xb_add(unsigned* p, unsigned v) { return __hip_atomic_fetch_add(p, v, __ATOMIC_RELAXED, __HIP_MEMORY_SCOPE_AGENT); }
DI unsigned xb_xcc_id() { return (unsigned)__builtin_amdgcn_s_getreg((3 << 11) | 20) & 0xFu; }
#define XB_SPIN(cond, bar) do { unsigned _sp = 0; while (cond) { __builtin_amdgcn_s_sleep(1); \
    if ((++_sp & 255u) == 0u) { if (xb_ld(&(bar)[XB_TMO])) break; if (_sp > XB_SPIN_CAP) { atomicAdd(&(bar)[XB_TMO], 1u); break; } } } } while (0)
struct XcdBarrier { unsigned* bar; unsigned x; volatile __attribute__((address_space(3))) unsigned* st; };
DI void xcd_barrier_complete(unsigned* bar, unsigned x, unsigned G, unsigned& nloc, unsigned& nx) {
  unsigned sum, cnt, mine, sp = 0u;
  for (;;) {
    sum = 0u; cnt = 0u; mine = 0u;
#pragma unroll
    for (unsigned j = 0; j < 16; ++j) { const unsigned c = xb_ld(&bar[XB_XCNT(j)]); sum += c; cnt += (c > 0u) ? 1u : 0u; mine = (j == x) ? c : mine; }
    if (sum == G) break;
    __builtin_amdgcn_s_sleep(1);
    if ((++sp & 255u) == 0u) { if (xb_ld(&bar[XB_TMO])) break; if (sp > XB_SPIN_CAP) { atomicAdd(&bar[XB_TMO], 1u); break; } }
  }
  nloc = mine > 0u ? mine : 1u; nx = cnt > 0u ? cnt : 1u;
}
DI void xcd_barrier(const XcdBarrier& b, int tid, unsigned G) {
  asm volatile("s_waitcnt vmcnt(0)" ::: "memory");
  __syncthreads();
  if (tid == 0) {
    unsigned* bar = b.bar;
    __builtin_amdgcn_s_waitcnt(0);
    unsigned nloc = b.st[0], nx = b.st[1];
    if (nloc == 0u) { xcd_barrier_complete(bar, b.x, G, nloc, nx); b.st[0] = nloc; b.st[1] = nx; }
    const unsigned old = xb_add(&bar[XB_XSUB(b.x)], 1u);
    const unsigned gen = old / nloc;
    if (old + 1u == (gen + 1u) * nloc) {
      __builtin_amdgcn_fence(__ATOMIC_RELEASE, "agent");
      asm volatile("s_waitcnt vmcnt(0)" ::: "memory");
      const unsigned og = xb_add(&bar[XB_TOP], 1u);
      const unsigned tg = og / nx;
      if (og + 1u == (tg + 1u) * nx) xb_add(&bar[XB_TOPGEN], 1u);
      else XB_SPIN(xb_ld(&bar[XB_TOPGEN]) == tg, bar);
      __builtin_amdgcn_fence(__ATOMIC_ACQUIRE, "agent");
      xb_add(&bar[XB_XGEN(b.x)], 1u);
      asm volatile("s_waitcnt vmcnt(0)" ::: "memory");
    } else {
      XB_SPIN(xb_ld(&bar[XB_XGEN(b.x)]) == gen, bar);
      __builtin_amdgcn_fence(__ATOMIC_ACQUIRE, "agent");
      asm volatile("s_waitcnt vmcnt(0)" ::: "memory");
    }
  }
  __syncthreads();
}

extern "C" __global__ void __launch_bounds__(512, 2) mega(Params p_unused) {
  extern __shared__ __attribute__((aligned(16))) unsigned char smem[];
  cg::grid_group grid = cg::this_grid();
  const int bid = blockIdx.x, nblk = gridDim.x;
  const int wv = __builtin_amdgcn_readfirstlane((int)(threadIdx.x >> 6));
  CParams* pk = (CParams*)__builtin_amdgcn_kernarg_segment_ptr();
  const int ph_lo = pk->ph_lo, ph_hi = pk->ph_hi;
  int ph = 0;
  XcdBarrier xb;
  {
    volatile __attribute__((address_space(3))) unsigned* st = (volatile __attribute__((address_space(3))) unsigned*)(smem + 131072);
    const int t0 = ltid(wv);
    if (t0 == 0) { st[0] = 0u; st[1] = 0u; }
    __syncthreads();
    xb.bar = (unsigned*)(pk->ws + OFF_BAR); xb.x = xb_xcc_id(); xb.st = st;
    if (t0 == 0) (void)xb_add(&xb.bar[XB_XCNT(xb.x)], 1u);
  }
#ifndef REPMASK
#define REPMASK 0u
#endif
#ifndef PMASK
#define PMASK 0xffffffffu
#endif
#define PHASE_BEGIN(k) if (ph >= ph_lo && ph < ph_hi) { if constexpr ((PMASK >> (k)) & 1u) for (int rep_ = 0; rep_ < 1 + (int)((REPMASK >> (k)) & 1u); ++rep_) { \
    CParams* pp_ = pk; asm volatile("" : "+s"(pp_)); PREF p = *pp_; const int tid = ltid(wv); \
    unsigned char* ws = p.ws; float* X = (float*)(ws + OFF_X); bf16_t* H = (bf16_t*)(ws + OFF_H); bf16_t* Wb = (bf16_t*)(ws + OFF_W); \
    float* ROPE = (float*)(ws + OFF_ROPE); unsigned char* R = ws + OFF_R; (void)tid; (void)X; (void)H; (void)Wb; (void)ROPE; (void)R;
#define PHASE_END   } if (ph + 1 < ph_hi) { if (ph == 0) grid.sync(); else xcd_barrier(xb, ltid(wv), (unsigned)nblk); } } ++ph;

  PHASE_BEGIN(0)
    {
      const int hf = tid >> 8, tl = tid & 255;
      float* smh = (float*)smem + hf * 4224;
      for (int t0 = bid * 2; t0 < p.total_tiles; t0 += nblk * 2) {
        const int t = t0 + hf;
        const bool active = t < p.total_tiles;
        const int tt = active ? t : 0;
        int ji = 0;
#pragma unroll 1
        for (int q = 1; q < NJOBS; ++q) if (tt >= p.jobs[q].tile0) ji = q;
        const CAS Job& jb = p.jobs[ji];
        int lt = tt - jb.tile0; int nkt = jb.k >> 6; int nt_ = lt / nkt, kt_ = lt - nt_ * nkt;
        transpose_tile(jb.src, jb.nsrc, jb.nsrc, jb.dst, jb.k, nt_ * 64, kt_ * 64, jb.mode, smh, tl, active);
      }
    }
    {
      const size_t n4p = (size_t)TP * 256, n4 = (size_t)T * 256;
      const float4* xp = (const float4*)p.in[0]; const float4* xs = (const float4*)p.in[1];
      for (size_t e = (size_t)bid * NT + tid; e < n4; e += (size_t)nblk * NT) ((float4*)X)[e] = (e < n4p) ? xp[e] : xs[e - n4p];
      for (int e = bid * NT + tid; e < 8192 * 16; e += nblk * NT) {
        int pos = e >> 4, i = e & 15;
        double rev = (double)pos * p.inv_freq[i] * 0.15915494309189535;
        rev -= floor(rev);
        float fr = (float)rev;
        ROPE[2 * e] = __builtin_amdgcn_cosf(fr); ROPE[2 * e + 1] = __builtin_amdgcn_sinf(fr);
      }
      const float* wsrc = p.in[20];
      for (int e = bid * NT + tid; e < 8 * 128 * 128; e += nblk * NT) {
        int s = e & 127, t = (e >> 7) & 127;
        Wb[W_TRIL + e] = tobf(s <= t ? wsrc[e] : 0.f);
      }
    }
  PHASE_END

#pragma unroll 1
  for (int L = 0; L < 4; ++L) {
    const int kind = L % 3, j = L / 3;
    if (kind == 0) {
      PHASE_BEGIN(1)
        rmsnorm_rows(X, p.in[7] + L * 1024, H, nullptr, nullptr, bid, nblk, wv);
        cache_rows(p.in[2] + (size_t)j * 32 * 1024 * 256, (bf16_t*)(R + R_CKV), 256, bid, nblk, wv);
        cache_rows(p.in[3] + (size_t)j * 32 * 1024 * 32, (bf16_t*)(R + R_KR), 32, bid, nblk, wv);
      PHASE_END
      PHASE_BEGIN(2)
        EArgs ea{}; ea.f0 = (float*)(R + R_RAW);
        gemm_phase<E_F32>(H, Wb + W_MLA + (size_t)j * WM_SZ + WM_D, T, 1024, 1024, ea, smem, 0, bid, nblk, wv);
      PHASE_END
      PHASE_BEGIN(3)
        mla_rowops(p, j, bid, nblk, wv);
      PHASE_END
      PHASE_BEGIN(4)
        EArgs ea{}; ea.b0 = (bf16_t*)(R + R_Q); ea.rope = ROPE;
        gemm_phase<E_MLAQ>((const bf16_t*)(R + R_CQ), Wb + W_MLA + (size_t)j * WM_SZ + WM_UQ, T, 1536, 512, ea, smem, 0, bid, nblk, wv);
        EArgs eb{}; eb.b0 = (bf16_t*)(R + R_KN); eb.b1 = (bf16_t*)(R + R_VT);
        gemm_phase<E_MLAKV>((const bf16_t*)(R + R_CKV), Wb + W_MLA + (size_t)j * WM_SZ + WM_UKV, KROWS, 2048, 256, eb, smem, (T / 256) * 6, bid, nblk, wv);
      PHASE_END
      PHASE_BEGIN(5)
        attn_phase<true>(p, smem, bid, nblk, wv);
      PHASE_END
      PHASE_BEGIN(6)
        EArgs ea{}; ea.f0 = X;
        gemm_phase<E_RESID>((const bf16_t*)(R + R_RAW), Wb + W_MLA + (size_t)j * WM_SZ + WM_O, T, 1024, 1024, ea, smem, 0, bid, nblk, wv);
      PHASE_END
    } else if (kind == 1) {
      PHASE_BEGIN(1)
        rmsnorm_rows(X, p.in[7] + L * 1024, H, nullptr, nullptr, bid, nblk, wv);
      PHASE_END
      PHASE_BEGIN(7)
        EArgs ea{}; ea.b0 = (bf16_t*)(R + C_U); ea.b1 = (bf16_t*)(R + C_VR);
        gemm_phase<E_GELU>(H, Wb + W_CM + WC_IN, T, 4096, 1024, ea, smem, 0, bid, nblk, wv);
      PHASE_END
      PHASE_BEGIN(8)
        cmlp_ln_rows(p, bid, nblk, wv);
      PHASE_END
      PHASE_BEGIN(9)
        cmlp_mix_phase(p, smem, bid, nblk, wv);
      PHASE_END
      PHASE_BEGIN(6)
        EArgs ea{}; ea.f0 = X;
        gemm_phase<E_RESID>((const bf16_t*)(R + C_G), Wb + W_CM + WC_OUT, T, 1024, 2048, ea, smem, 0, bid, nblk, wv);
      PHASE_END
    } else {
      PHASE_BEGIN(10)
        rmsnorm_rows(X, p.in[7] + L * 1024, H, nullptr, nullptr, bid, nblk, wv);
        cache_rows(p.in[4], (bf16_t*)(R + D_K), 1024, bid, nblk, wv);
        cache_rows(p.in[6], (bf16_t*)(R + D_KI), 64, bid, nblk, wv);
        {
          bf16_t* VTs = (bf16_t*)(R + D_VT) + (size_t)TP * 1024;
          {
            const int hf = tid >> 8, tl = tid & 255;
            float* smh = (float*)smem + hf * 4224;
            for (int u0 = bid * 2; u0 < 512 * 16; u0 += nblk * 2) {
              const int u = u0 + hf;
              int st = u & 15, bh = u >> 4, b = bh >> 4, h = bh & 15;
              transpose_tile(p.in[5] + (size_t)b * 1024 * 1024 + h * 64, 1024, 64, VTs + (size_t)(bh * 64) * SPAD, SPAD, 0, st * 64, 0, smh, tl, true);
            }
          }
          for (int e = bid * NT + tid; e < 512 * 64 * 12; e += nblk * NT) {
            int c = e % 12, rw = e / 12;
            { unsigned z = 0; asm volatile("" : "+v"(z)); *(uint2*)(VTs + (size_t)rw * SPAD + NKS + c * 4) = make_uint2(z, z); }
          }
        }
      PHASE_END
      PHASE_BEGIN(11)
        EArgs ea{};
        ea.f0 = p.out + O_DKP; ea.f1 = p.out + O_DKS; ea.f2 = p.out + O_DVP; ea.f3 = p.out + O_DVS;
        ea.f4 = (float*)(R + D_KIR); ea.f5 = (float*)(R + D_WI);
        ea.b0 = (bf16_t*)(R + D_Q); ea.b1 = (bf16_t*)(R + D_K); ea.b2 = (bf16_t*)(R + D_VT); ea.b3 = (bf16_t*)(R + D_QI);
        gemm_phase<E_DSA>(H, Wb + W_DS + WD_P, T, 3840, 1024, ea, smem, 0, bid, nblk, wv);
      PHASE_END
      PHASE_BEGIN(12)
        dsa_rowops(p, bid, nblk, wv);
      PHASE_END
      PHASE_BEGIN(13)
        idx_phase(p, smem, bid, nblk, wv);
      PHASE_END
      PHASE_BEGIN(14)
        attn_phase<false>(p, smem, bid, nblk, wv);
      PHASE_END
      PHASE_BEGIN(6)
        EArgs ea{}; ea.f0 = X;
        gemm_phase<E_RESID>((const bf16_t*)(R + D_AO), Wb + W_DS + WD_O, T, 1024, 1024, ea, smem, 0, bid, nblk, wv);
      PHASE_END
    }
    PHASE_BEGIN(1)
      rmsnorm_rows(X, p.in[8] + L * 1024, H, nullptr, nullptr, bid, nblk, wv);
    PHASE_END
    PHASE_BEGIN(15)
      EArgs ea{}; ea.b0 = (bf16_t*)(R + 0);
      gemm_phase<E_SWIGLU>(H, Wb + W_FF + (size_t)L * WF_SZ + WF_IN, T, 2 * DFF, 1024, ea, smem, 0, bid, nblk, wv);
    PHASE_END
    PHASE_BEGIN(6)
      EArgs ea{}; ea.f0 = X;
      gemm_phase<E_RESID>((const bf16_t*)(R + 0), Wb + W_FF + (size_t)L * WF_SZ + WF_OUT, T, 1024, DFF, ea, smem, 0, bid, nblk, wv);
    PHASE_END
  }
  PHASE_BEGIN(1)
    rmsnorm_rows(X, p.in[9], nullptr, p.out + O_YP, p.out + O_YS, bid, nblk, wv);
  PHASE_END
}

extern "C" void kernel_launch(void* const* d_in, const int* in_sizes, int n_in,
                              void* d_out, int out_size, void* d_ws, size_t ws_size,
                              hipStream_t stream) {
  constexpr int kLds = 128 * 1024 + 64;
  static int grid_blocks = 0;
  if (!grid_blocks) {
    int dev = 0, cus = 0, per_cu = 0;
    (void)hipGetDevice(&dev);
    (void)hipDeviceGetAttribute(&cus, hipDeviceAttributeMultiprocessorCount, dev);
    (void)hipFuncSetAttribute((const void*)mega, hipFuncAttributeMaxDynamicSharedMemorySize, kLds);
    (void)hipOccupancyMaxActiveBlocksPerMultiprocessor(&per_cu, (const void*)mega, NT, kLds);
    if (per_cu < 1) per_cu = 1;
    if (per_cu > 1) per_cu = 1;
    grid_blocks = cus * per_cu;
    fprintf(stderr, "grid %d (cus %d per_cu %d) ws %zu need %zu out %d need %zu\n", grid_blocks, cus, per_cu, ws_size, (size_t)WS_NEED, out_size, (size_t)O_END);
  }
  if (ws_size < WS_NEED || n_in != 31 || (size_t)out_size != O_END) { fprintf(stderr, "kernel_launch: bad sizes\n"); return; }
  Params p;
  memset(&p, 0, sizeof(p));
  for (int i = 0; i < 31; ++i) p.in[i] = (const float*)d_in[i];
  p.out = (float*)d_out; p.ws = (unsigned char*)d_ws;
  bf16_t* Wb = (bf16_t*)((unsigned char*)d_ws + OFF_W);
  int nj = 0, tiles = 0;
  auto add = [&](const float* src, int nsrc, int k, bf16_t* dst, int ndst, int mode) {
    Job& jb = p.jobs[nj++]; jb.src = src; jb.dst = dst; jb.nsrc = nsrc; jb.k = k; jb.ndst = ndst; jb.mode = mode; jb.tile0 = tiles; jb.pad = 0;
    tiles += (ndst / 64) * (k / 64);
  };
  for (int j = 0; j < 2; ++j) {
    bf16_t* Wm = Wb + W_MLA + (size_t)j * WM_SZ;
    add(p.in[10] + (size_t)j * 1024 * 512, 512, 1024, Wm + WM_D, 512, 2);
    add(p.in[13] + (size_t)j * 1024 * 288, 288, 1024, Wb + W_MLA + (size_t)j * WM_SZ + WM_D + (size_t)512 * 1024, 512, 2);
    add(p.in[12] + (size_t)j * 512 * 1536, 1536, 512, Wb + W_MLA + (size_t)j * WM_SZ + WM_UQ, 1536, 0);
    add(p.in[15] + (size_t)j * 256 * 2048, 2048, 256, Wb + W_MLA + (size_t)j * WM_SZ + WM_UKV, 2048, 2);
    add(p.in[16] + (size_t)j * 1024 * 1024, 1024, 1024, Wb + W_MLA + (size_t)j * WM_SZ + WM_O, 1024, 2);
  }
  add(p.in[17], 4096, 1024, Wb + W_CM + WC_IN, 4096, 2);
  add(p.in[22], 1024, 2048, Wb + W_CM + WC_OUT, 1024, 2);
  add(p.in[23], 3072, 1024, Wb + W_DS + WD_P, 3072, 2);
  add(p.in[25], 512, 1024, Wb + W_DS + WD_P + (size_t)3072 * 1024, 512, 2);
  add(p.in[26], 64, 1024, Wb + W_DS + WD_P + (size_t)3584 * 1024, 64, 2);
  add(p.in[28], 8, 1024, Wb + W_DS + WD_P + (size_t)3648 * 1024, 192, 2);
  add(p.in[24], 1024, 1024, Wb + W_DS + WD_O, 1024, 2);
  for (int i = 0; i < 4; ++i) {
    add(p.in[29] + (size_t)i * 1024 * 5632, 5632, 1024, Wb + W_FF + (size_t)i * WF_SZ + WF_IN, 5632, 1);
    add(p.in[30] + (size_t)i * 2816 * 1024, 1024, 2816, Wb + W_FF + (size_t)i * WF_SZ + WF_OUT, 1024, 2);
  }
  p.total_tiles = tiles;
  for (int i = 0; i < 16; ++i) p.inv_freq[i] = pow(10000.0, -(double)i / 16.0);
  p.ph_lo = 0; p.ph_hi = 1000;
  (void)hipMemsetAsync((unsigned char*)d_ws + OFF_BAR, 0, 16384, stream);
  void* args[] = {&p};
  hipError_t e = hipLaunchCooperativeKernel((const void*)mega, dim3(grid_blocks), dim3(NT), args, kLds, stream);
  if (e != hipSuccess) fprintf(stderr, "coop launch failed: %s\n", hipGetErrorString(e));
}
```

```cpp
#include <hip/hip_runtime.h>
#include <hip/hip_cooperative_groups.h>
#include <cstdio>
#include <cstring>
#include <cmath>
namespace cg = cooperative_groups;

typedef unsigned short bf16_t;
using bf16x8 = __attribute__((ext_vector_type(8))) short;
using f32x16 = __attribute__((ext_vector_type(16))) float;
using f32x2v = __attribute__((ext_vector_type(2))) float;
using bf2v = __attribute__((ext_vector_type(2))) __bf16;
#define DI __device__ __forceinline__
#define MFMA32(a, b, c) __builtin_amdgcn_mfma_f32_32x32x16_bf16((a), (b), (c), 0, 0, 0)

constexpr int TP = 16384, TS = 512, T = TP + TS;
constexpr int NT = 512;
constexpr int SPAD = 1088, NKS = 1040;
constexpr int KROWS = TP + 32 * SPAD;
constexpr int DFF = 2816;
constexpr float LOG2E = 1.4426950408889634f;
constexpr float EPS = 1e-6f;

constexpr size_t OFF_X = 0;
constexpr size_t OFF_H = OFF_X + (size_t)T * 1024 * 4;
constexpr size_t OFF_W = OFF_H + (size_t)T * 1024 * 2;
constexpr size_t W_ELEMS = 52822016;
constexpr size_t OFF_ROPE = OFF_W + W_ELEMS * 2;
constexpr size_t OFF_R = OFF_ROPE + (size_t)8192 * 16 * 2 * 4;
constexpr size_t R_RAW = 0;
constexpr size_t R_CQ = R_RAW + (size_t)T * 1024 * 4;
constexpr size_t R_CKV = R_CQ + (size_t)T * 512 * 2;
constexpr size_t R_KR = R_CKV + (size_t)KROWS * 256 * 2;
constexpr size_t R_Q = R_KR + (size_t)KROWS * 32 * 2;
constexpr size_t R_KN = R_Q + (size_t)T * 1536 * 2;
constexpr size_t R_VT = R_KN + (size_t)KROWS * 1024 * 2;
constexpr size_t R_END = R_VT + (size_t)KROWS * 1024 * 2;
constexpr size_t D_Q = 0;
constexpr size_t D_K = D_Q + (size_t)T * 1024 * 2;
constexpr size_t D_VT = D_K + (size_t)KROWS * 1024 * 2;
constexpr size_t D_QI = D_VT + (size_t)KROWS * 1024 * 2;
constexpr size_t D_KIR = D_QI + (size_t)T * 512 * 2;
constexpr size_t D_KI = D_KIR + (size_t)T * 64 * 4;
constexpr size_t D_WI = D_KI + (size_t)KROWS * 64 * 2;
constexpr size_t D_BM = D_WI + (size_t)T * 8 * 4;
constexpr size_t D_AO = D_BM + (size_t)T * 256 * 4;
constexpr size_t D_END = D_AO + (size_t)T * 1024 * 2;
constexpr size_t C_U = 0;
constexpr size_t C_VR = C_U + (size_t)T * 2048 * 2;
constexpr size_t C_VLN = C_VR + (size_t)T * 2048 * 2;
constexpr size_t C_G = C_VLN + (size_t)T * 2048 * 2;
constexpr size_t C_END = C_G + (size_t)T * 2048 * 2;
constexpr size_t OFF_BAR = OFF_R + R_END;
constexpr size_t WS_NEED = OFF_BAR + 16384;
static_assert(D_END <= R_END && C_END <= R_END && (size_t)T * DFF * 2 <= R_END, "region");

constexpr size_t W_MLA = 0;
constexpr size_t WM_D = 0, WM_UQ = 1048576, WM_UKV = WM_UQ + 786432, WM_O = WM_UKV + 524288, WM_SZ = 3407872;
constexpr size_t W_CM = 2 * WM_SZ;
constexpr size_t WC_IN = 0, WC_OUT = 4194304, WC_SZ = 6291456;
constexpr size_t W_DS = W_CM + WC_SZ;
constexpr size_t WD_P = 0, WD_O = 3932160, WD_SZ = 4980736;
constexpr size_t W_FF = W_DS + WD_SZ;
constexpr size_t WF_IN = 0, WF_OUT = 5767168, WF_SZ = 8650752;
constexpr size_t W_TRIL = W_FF + 4 * WF_SZ;
static_assert(W_TRIL + 131072 == W_ELEMS, "w");

constexpr size_t O_YP = 0;
constexpr size_t O_YS = O_YP + (size_t)TP * 1024;
constexpr size_t O_CKVP = O_YS + (size_t)TS * 1024;
constexpr size_t O_KRP = O_CKVP + (size_t)2 * TP * 256;
constexpr size_t O_CKVS = O_KRP + (size_t)2 * TP * 32;
constexpr size_t O_KRS = O_CKVS + (size_t)2 * TS * 256;
constexpr size_t O_CVS = O_KRS + (size_t)2 * TS * 32;
constexpr size_t O_DKP = O_CVS + (size_t)TS * 2048;
constexpr size_t O_DVP = O_DKP + (size_t)TP * 1024;
constexpr size_t O_DIP = O_DVP + (size_t)TP * 1024;
constexpr size_t O_DKS = O_DIP + (size_t)TP * 64;
constexpr size_t O_DVS = O_DKS + (size_t)TS * 1024;
constexpr size_t O_DIS = O_DVS + (size_t)TS * 1024;
constexpr size_t O_END = O_DIS + (size_t)TS * 64;

constexpr int NJOBS = 25;
struct Job { const float* src; bf16_t* dst; int nsrc, k, ndst, mode, tile0, pad; };
struct Params {
  const float* in[31];
  float* out;
  unsigned char* ws;
  Job jobs[NJOBS];
  int total_tiles, ph_lo, ph_hi, pad;
  double inv_freq[16];
};

#define CAS __attribute__((address_space(4)))
typedef const CAS Params CParams;
#define PREF const CAS Params&
DI unsigned pack2(float a, float b) { f32x2v v = {a, b}; bf2v r = __builtin_convertvector(v, bf2v); return __builtin_bit_cast(unsigned, r); }
DI bf16_t tobf(float a) { return (bf16_t)(pack2(a, 0.f) & 0xffffu); }
DI float frombf(bf16_t v) { return __uint_as_float(((unsigned)v) << 16); }
DI float bflo(unsigned u) { return __uint_as_float(u << 16); }
DI float bfhi(unsigned u) { return __uint_as_float(u & 0xffff0000u); }
DI float shflx(float v, int m, int lane) { return __int_as_float(__builtin_amdgcn_ds_bpermute((lane ^ m) << 2, __float_as_int(v))); }
DI float wave_sum(float v, int lane) {
#pragma unroll
  for (int o = 32; o >= 1; o >>= 1) v += shflx(v, o, lane);
  return v;
}
DI int ltid(int wv) { unsigned m1 = ~0u; asm volatile("" : "+s"(m1)); int t = (wv << 6) | (int)__builtin_amdgcn_mbcnt_hi(m1, __builtin_amdgcn_mbcnt_lo(m1, 0u)); asm volatile("" : "+v"(t)); return t; }
DI int crow(int i, int h) { return (i & 3) + 8 * (i >> 2) + 4 * h; }
DI int rowmap(int t) { if (t < TP) return t; int u = t - TP; return TP + (u >> 4) * SPAD + 1024 + (u & 15); }
DI int tokpos(int t) { return t < TP ? (t & 8191) : 1024 + ((t - TP) & 15); }

DI void transpose_tile(const float* __restrict__ src, int src_ld, int ncols, bf16_t* __restrict__ dst, int dst_ld,
                       int n0, int k0, int mode, float* sm, int tid, bool active) {
  const int nl = (tid & 15) * 4, kq = tid >> 4;
  const int n = n0 + nl;
  int c;
  if (mode != 1) c = n < ncols ? n : -1;
  else { int tt = n >> 5, r = n & 31; int f = tt * 16 + (r & 15); c = (r < 16) ? f : DFF + f; }
  int dr[4];
#pragma unroll
  for (int e = 0; e < 4; ++e) { int col = nl + e; dr[e] = (mode == 2) ? ((col & 32) + (col & 1) * 16 + ((col & 31) >> 1)) : col; }
  if (active) {
    float4 v[4];
#pragma unroll
    for (int i = 0; i < 4; ++i) {
      int kk = kq + 16 * i;
      v[i] = (c >= 0) ? *(const float4*)(src + (size_t)(k0 + kk) * src_ld + c) : make_float4(0.f, 0.f, 0.f, 0.f);
    }
#pragma unroll
    for (int i = 0; i < 4; ++i) {
      int kk = kq + 16 * i;
      float* d = sm + kk * 65;
      d[dr[0]] = v[i].x; d[dr[1]] = v[i].y; d[dr[2]] = v[i].z; d[dr[3]] = v[i].w;
    }
  }
  __syncthreads();
  if (active) {
    const int kp = (tid & 31) * 2, nr = tid >> 5;
#pragma unroll 4
    for (int i = 0; i < 8; ++i) {
      int nn = nr + 8 * i;
      float a = sm[kp * 65 + nn], b = sm[(kp + 1) * 65 + nn];
      *(unsigned*)(dst + (size_t)(n0 + nn) * dst_ld + k0 + kp) = pack2(a, b);
    }
  }
  __syncthreads();
}

enum { E_F32 = 0, E_RESID, E_SWIGLU, E_GELU, E_MLAQ, E_MLAKV, E_DSA };
struct EArgs {
  float* f0; float* f1; float* f2; float* f3; float* f4; float* f5; float* f6;
  bf16_t* b0; bf16_t* b1; bf16_t* b2; bf16_t* b3;
  const float* rope;
};
using f32x4v = __attribute__((ext_vector_type(4))) float;
#define LAS __attribute__((address_space(3)))
constexpr int G_HT = 128 * 64;
DI int lds_byte(int r, int c) {
  int st = (r >> 4) * 2 + (c >> 5), rr = r & 15, cc = c & 31, ob = rr * 64 + cc * 2;
  return st * 1024 + (ob ^ (((ob >> 9) & 1) << 5));
}
DI void stage_rc(int b, int& R, int& C) {
  int st = b >> 10, sb = b & 1023, swz = sb ^ (((sb >> 9) & 1) << 5);
  R = (st >> 1) * 16 + (swz >> 6); C = (st & 1) * 32 + ((swz & 63) >> 1);
}

template <int EPI, bool ATOM>
DI void epi16(const EArgs& ea, int row0, int gb, int fr, const f32x4v& v0, const f32x4v& v1) {
  if constexpr (EPI == E_F32) {
#pragma unroll
    for (int j = 0; j < 4; ++j) *(float2*)(ea.f0 + (size_t)(row0 + j) * 1024 + gb + 2 * fr) = make_float2(v0[j], v1[j]);
  } else if constexpr (EPI == E_RESID) {
#pragma unroll
    for (int j = 0; j < 4; ++j) { float* o = ea.f0 + (size_t)(row0 + j) * 1024 + gb + 2 * fr;
      if constexpr (ATOM) { unsafeAtomicAdd(o, v0[j]); unsafeAtomicAdd(o + 1, v1[j]); }
      else { float2 x = *(float2*)o; x.x += v0[j]; x.y += v1[j]; *(float2*)o = x; } }
  } else if constexpr (EPI == E_SWIGLU) {
    const int f = (gb >> 1) + fr;
#pragma unroll
    for (int j = 0; j < 4; ++j) { float g = v0[j], u = v1[j]; ea.b0[(size_t)(row0 + j) * DFF + f] = tobf(g / (1.f + __expf(-g)) * u); }
  } else if constexpr (EPI == E_GELU) {
    bf16_t* dstp = (gb < 2048) ? (ea.b0 + gb + 2 * fr) : (ea.b1 + (gb - 2048) + 2 * fr);
#pragma unroll
    for (int j = 0; j < 4; ++j) {
      float x = v0[j], y = v1[j];
      *(unsigned*)(dstp + (size_t)(row0 + j) * 2048) = pack2(0.5f * x * (1.f + erff(x * 0.70710678118654752f)), 0.5f * y * (1.f + erff(y * 0.70710678118654752f)));
    }
  } else if constexpr (EPI == E_MLAQ) {
    const float qs = 0.10206207261596577f * LOG2E;
    const bool is_rope = (gb % 96) == 64;
#pragma unroll
    for (int j = 0; j < 4; ++j) {
      const int row = row0 + j;
      float o0 = v0[j], o1 = v1[j];
      if (is_rope) {
        float2 cs = *(const float2*)(ea.rope + ((size_t)tokpos(row) * 16 + fr) * 2);
        o0 = v0[j] * cs.x - v1[j] * cs.y; o1 = v0[j] * cs.y + v1[j] * cs.x;
      }
      bf16_t* o = ea.b0 + (size_t)row * 1536 + gb + fr;
      o[0] = tobf(o0 * qs); o[16] = tobf(o1 * qs);
    }
  } else if constexpr (EPI == E_MLAKV) {
    const int head = gb >> 7, c0 = gb & 127;
    if (c0 < 64) {
#pragma unroll
      for (int j = 0; j < 4; ++j) *(unsigned*)(ea.b0 + (size_t)(row0 + j) * 1024 + head * 64 + c0 + 2 * fr) = pack2(v0[j], v1[j]);
    } else {
      const int d = c0 - 64 + 2 * fr;
      size_t off, dstr;
      if (row0 < TP) { int b = row0 >> 13, s = row0 & 8191; off = ((size_t)((b * 16 + head) * 64 + d)) * 8192 + s; dstr = 8192; }
      else { int u = row0 - TP; int b = u / SPAD, s = u - b * SPAD; off = (size_t)TP * 1024 + ((size_t)((b * 16 + head) * 64 + d)) * SPAD + s; dstr = SPAD; }
      uint2 pk; pk.x = pack2(v0[0], v0[1]); pk.y = pack2(v0[2], v0[3]); *(uint2*)(ea.b1 + off) = pk;
      pk.x = pack2(v1[0], v1[1]); pk.y = pack2(v1[2], v1[3]); *(uint2*)(ea.b1 + off + dstr) = pk;
    }
  } else if constexpr (EPI == E_DSA) {
    if (gb < 1024) {
      const float qs = 0.125f * LOG2E;
#pragma unroll
      for (int j = 0; j < 4; ++j) *(unsigned*)(ea.b0 + (size_t)(row0 + j) * 1024 + gb + 2 * fr) = pack2(v0[j] * qs, v1[j] * qs);
    } else if (gb < 2048) {
      const int c = gb - 1024 + 2 * fr;
#pragma unroll
      for (int j = 0; j < 4; ++j) {
        const int row = row0 + j;
        float* o = (row < TP) ? ea.f0 + (size_t)row * 1024 + c : ea.f1 + (size_t)(row - TP) * 1024 + c;
        *(float2*)o = make_float2(v0[j], v1[j]);
        *(unsigned*)(ea.b1 + (size_t)rowmap(row) * 1024 + c) = pack2(v0[j], v1[j]);
      }
    } else if (gb < 3072) {
      const int c = gb - 2048 + 2 * fr, head = c >> 6, d = c & 63;
#pragma unroll
      for (int j = 0; j < 4; ++j) {
        const int row = row0 + j;
        float* o = (row < TP) ? ea.f2 + (size_t)row * 1024 + c : ea.f3 + (size_t)(row - TP) * 1024 + c;
        *(float2*)o = make_float2(v0[j], v1[j]);
      }
      size_t off, dstr;
      if (row0 < TP) { int b = row0 >> 13, s = row0 & 8191; off = ((size_t)((b * 16 + head) * 64 + d)) * 8192 + s; dstr = 8192; }
      else { int u = row0 - TP; int b = u >> 4, s = 1024 + (u & 15); off = (size_t)TP * 1024 + ((size_t)((b * 16 + head) * 64 + d)) * SPAD + s; dstr = SPAD; }
      uint2 pk; pk.x = pack2(v0[0], v0[1]); pk.y = pack2(v0[2], v0[3]); *(uint2*)(ea.b2 + off) = pk;
      pk.x = pack2(v1[0], v1[1]); pk.y = pack2(v1[2], v1[3]); *(uint2*)(ea.b2 + off + dstr) = pk;
    } else if (gb < 3584) {
      const int c = gb - 3072 + 2 * fr;
#pragma unroll
      for (int j = 0; j < 4; ++j) *(unsigned*)(ea.b3 + (size_t)(row0 + j) * 512 + c) = pack2(v0[j] * 0.125f, v1[j] * 0.125f);
    } else if (gb < 3648) {
      const int c = gb - 3584 + 2 * fr;
#pragma unroll
      for (int j = 0; j < 4; ++j) *(float2*)(ea.f4 + (size_t)(row0 + j) * 64 + c) = make_float2(v0[j], v1[j]);
    } else if (gb == 3648) {
      if (fr < 4) {
#pragma unroll
        for (int j = 0; j < 4; ++j) *(float2*)(ea.f5 + (size_t)(row0 + j) * 8 + 2 * fr) = make_float2(v0[j] * 0.35355339059327379f, v1[j] * 0.35355339059327379f);
      }
    }
  }
}

template <int EPI, bool ATOM>
DI void gemm256_tile(const bf16_t* __restrict__ A, const bf16_t* __restrict__ Bt, const int K, const int kt0, const int nt, const int brow, const int bcol,
                     const EArgs& ea, unsigned char* smem, int wv) {
  bf16_t* shm = (bf16_t*)smem;
  const int tid = ltid(wv);
#define SA(b, h) (shm + ((b) * 2 + (h)) * G_HT)
#define SB(b, h) (shm + (4 + (b) * 2 + (h)) * G_HT)
#define STAGE(P, BASE, br, kt) do { const char* _gb = (const char*)((BASE) + (long)(br) * K + (long)((kt) + kt0) * 64); \
    __builtin_amdgcn_global_load_lds((const unsigned*)(_gb + voff0), (LAS unsigned*)((char*)(P) + tid * 16), 16, 0, 0); \
    __builtin_amdgcn_global_load_lds((const unsigned*)(_gb + voff1), (LAS unsigned*)((char*)(P) + tid * 16 + 8192), 16, 0, 0); } while (0)
#define LDA(dst, b, h) _Pragma("unroll") for (int m = 0; m < 4; ++m) _Pragma("unroll") for (int k = 0; k < 2; ++k) \
    dst[m][k] = *reinterpret_cast<const bf16x8*>((char*)SA(b, h) + lds_byte(wr * 64 + m * 16 + fr, k * 32 + fq * 8))
#define LDB(dst, b, h) _Pragma("unroll") for (int n = 0; n < 2; ++n) _Pragma("unroll") for (int k = 0; k < 2; ++k) \
    dst[n][k] = *reinterpret_cast<const bf16x8*>((char*)SB(b, h) + lds_byte(wc * 32 + n * 16 + fr, k * 32 + fq * 8))
#define MMA(ai, bj, At_, Bt_) do { __builtin_amdgcn_s_setprio(1); \
    _Pragma("unroll") for (int m = 0; m < 4; ++m) _Pragma("unroll") for (int n = 0; n < 2; ++n) _Pragma("unroll") for (int k = 0; k < 2; ++k) \
      acc[ai][bj][m][n] = __builtin_amdgcn_mfma_f32_16x16x32_bf16(At_[m][k], Bt_[n][k], acc[ai][bj][m][n], 0, 0, 0); \
    __builtin_amdgcn_s_setprio(0); } while (0)
#define WAIT_V(n) asm volatile("s_waitcnt vmcnt(" #n ")" ::: "memory")
#define WAIT_L(n) asm volatile("s_waitcnt lgkmcnt(" #n ")" ::: "memory")
#define BAR __builtin_amdgcn_s_barrier()
#define SCHED __builtin_amdgcn_sched_barrier(0)
  const int wid = tid >> 6, lane = tid & 63, wr = wid >> 2, wc = wid & 3, fr = lane & 15, fq = lane >> 4;
  unsigned voff0, voff1;
  { int r_, c_; stage_rc(tid * 16, r_, c_); voff0 = (unsigned)(r_ * K + c_) * 2u; stage_rc(tid * 16 + 8192, r_, c_); voff1 = (unsigned)(r_ * K + c_) * 2u; }
  f32x4v acc[2][2][4][2];
#pragma unroll
  for (int a = 0; a < 2; ++a)
#pragma unroll
    for (int b = 0; b < 2; ++b)
#pragma unroll
      for (int m = 0; m < 4; ++m)
#pragma unroll
        for (int n = 0; n < 2; ++n) acc[a][b][m][n] = (f32x4v){0.f, 0.f, 0.f, 0.f};
  bf16x8 At[4][2], B0[2][2], B1[2][2];
  const int HALF = 128;
  WAIT_V(0); WAIT_L(0); BAR;
  STAGE(SB(0, 0), Bt, bcol, 0); STAGE(SA(0, 0), A, brow, 0);
  STAGE(SB(0, 1), Bt, bcol + HALF, 0); STAGE(SA(0, 1), A, brow + HALF, 0);
  if (wr == 1) BAR;
  WAIT_V(4); BAR;
  STAGE(SB(1, 0), Bt, bcol, 1); STAGE(SA(1, 0), A, brow, 1); STAGE(SB(1, 1), Bt, bcol + HALF, 1);
  WAIT_V(6); BAR;
  for (int t = 0; t < nt - 2; t += 2) {
    LDB(B0, 0, 0); SCHED; LDA(At, 0, 0); STAGE(SA(1, 1), A, brow + HALF, t + 1);
    WAIT_L(8); BAR; WAIT_L(0); MMA(0, 0, At, B0); BAR; SCHED;
    LDB(B1, 0, 1); STAGE(SB(0, 0), Bt, bcol, t + 2);
    BAR; WAIT_L(0); MMA(0, 1, At, B1); BAR;
    LDA(At, 0, 1); STAGE(SA(0, 0), A, brow, t + 2);
    BAR; WAIT_L(0); MMA(1, 0, At, B0); BAR; SCHED;
    STAGE(SB(0, 1), Bt, bcol + HALF, t + 2);
    WAIT_V(6); BAR; MMA(1, 1, At, B1); BAR;
    LDB(B0, 1, 0); SCHED; LDA(At, 1, 0); STAGE(SA(0, 1), A, brow + HALF, t + 2);
    WAIT_L(8); BAR; WAIT_L(0); MMA(0, 0, At, B0); BAR; SCHED;
    LDB(B1, 1, 1); STAGE(SB(1, 0), Bt, bcol, t + 3);
    BAR; WAIT_L(0); MMA(0, 1, At, B1); BAR;
    LDA(At, 1, 1); STAGE(SA(1, 0), A, brow, t + 3);
    BAR; WAIT_L(0); MMA(1, 0, At, B0); BAR; SCHED;
    STAGE(SB(1, 1), Bt, bcol + HALF, t + 3);
    WAIT_V(6); BAR; MMA(1, 1, At, B1); BAR;
  }
  { LDB(B0, 0, 0); LDA(At, 0, 0); STAGE(SA(1, 1), A, brow + HALF, nt - 1);
    BAR; WAIT_L(0); MMA(0, 0, At, B0); BAR;
    LDB(B1, 0, 1); BAR; WAIT_L(0); MMA(0, 1, At, B1); BAR;
    LDA(At, 0, 1); WAIT_V(4); BAR; WAIT_L(0); MMA(1, 0, At, B0); MMA(1, 1, At, B1); BAR; }
  { LDB(B0, 1, 0); LDA(At, 1, 0); WAIT_V(2); BAR; WAIT_L(0); MMA(0, 0, At, B0); BAR;
    LDB(B1, 1, 1); WAIT_V(0); BAR; WAIT_L(0); MMA(0, 1, At, B1); BAR;
    LDA(At, 1, 1); BAR; WAIT_L(0); MMA(1, 0, At, B0); MMA(1, 1, At, B1); BAR; }
  if (wr == 0) BAR;
#pragma unroll
  for (int ai = 0; ai < 2; ++ai)
#pragma unroll
    for (int bj = 0; bj < 2; ++bj)
#pragma unroll
      for (int m = 0; m < 4; ++m)
      { epi16<EPI, ATOM>(ea, brow + ai * 128 + wr * 64 + m * 16 + fq * 4, bcol + bj * 128 + wc * 32, fr, acc[ai][bj][m][0], acc[ai][bj][m][1]); __builtin_amdgcn_sched_barrier(0); }
#undef SA
#undef SB
#undef STAGE
#undef LDA
#undef LDB
#undef MMA
#undef WAIT_V
#undef WAIT_L
#undef BAR
#undef SCHED
}

DI void tile_map(int t, int nM, int nN, int nwg, int& pm, int& pn) {
  int wgid = t;
  { int q = nwg >> 3, r = nwg & 7, xcd = wgid & 7, off = wgid >> 3; wgid = (xcd < r ? xcd * (q + 1) : r * (q + 1) + (xcd - r) * q) + off; }
  const int nig = 8 * nN, gid = wgid / nig, fm = gid * 8, gsz = min(nM - fm, 8);
  pm = fm + ((wgid % nig) % gsz); pn = (wgid % nig) / gsz;
}
template <int EPI>
DI void gemm_phase(const bf16_t* A, const bf16_t* Bt, int M, int N, int K, const EArgs& ea,
                   unsigned char* smem, int tstart, int bid, int nblk, int wv) {
  const int nM = M >> 8, nN = N >> 8, nwg = nM * nN, nt = K >> 6;
  if constexpr (EPI == E_RESID) {
    const int nfull = (nwg / nblk) * nblk, rem = nwg - nfull;
    for (int t = bid; t < nfull; t += nblk) {
      int pm, pn; tile_map(t, nM, nN, nwg, pm, pn);
      gemm256_tile<EPI, false>(A, Bt, K, 0, nt, pm * 256, pn * 256, ea, smem, wv);
    }
    if (rem > 0) {
      int ns = nblk / rem; if (ns > (nt >> 3)) ns = nt >> 3; if (ns < 1) ns = 1;
      const int per = ((nt / ns) >> 1) << 1;
      for (int u = bid; u < rem * ns; u += nblk) {
        const int t = nfull + u / ns, ks = u % ns;
        const int k0 = ks * per, kn = (ks == ns - 1) ? (nt - k0) : per;
        int pm, pn; tile_map(t, nM, nN, nwg, pm, pn);
        gemm256_tile<EPI, true>(A, Bt, K, k0, kn, pm * 256, pn * 256, ea, smem, wv);
      }
    }
  } else {
    int t0 = bid - (tstart % nblk); if (t0 < 0) t0 += nblk;
    for (int t = t0; t < nwg; t += nblk) {
      int pm, pn; tile_map(t, nM, nN, nwg, pm, pn);
      gemm256_tile<EPI, false>(A, Bt, K, 0, nt, pm * 256, pn * 256, ea, smem, wv);
    }
  }
}

DI void rmsnorm_rows(const float* __restrict__ X, const float* __restrict__ g, bf16_t* __restrict__ H, float* outp, float* outs,
                     int bid, int nblk, int wv) {
  const int lane = ltid(wv) & 63, w = ltid(wv) >> 6;
  for (int row = bid * 8 + w; row < T; row += nblk * 8) {
    const float* xr = X + (size_t)row * 1024;
    float4 v[4];
    float ss = 0.f;
#pragma unroll
    for (int c = 0; c < 4; ++c) { v[c] = *(const float4*)(xr + c * 256 + lane * 4); ss += v[c].x * v[c].x + v[c].y * v[c].y + v[c].z * v[c].z + v[c].w * v[c].w; }
    ss = wave_sum(ss, lane);
    float r = rsqrtf(ss * (1.f / 1024.f) + EPS);
#pragma unroll
    for (int c = 0; c < 4; ++c) {
      int col = c * 256 + lane * 4;
      float4 gg = *(const float4*)(g + col);
      float a = v[c].x * r * gg.x, b = v[c].y * r * gg.y, cc = v[c].z * r * gg.z, d = v[c].w * r * gg.w;
      if (H) { uint2 pk; pk.x = pack2(a, b); pk.y = pack2(cc, d); *(uint2*)(H + (size_t)row * 1024 + col) = pk; }
      else {
        float* o = (row < TP) ? outp + (size_t)row * 1024 + col : outs + (size_t)(row - TP) * 1024 + col;
        *(float4*)o = make_float4(a, b, cc, d);
      }
    }
  }
}

DI void mla_rowops(PREF p, int j, int bid, int nblk, int wv) {
  const int lane = ltid(wv) & 63, w = ltid(wv) >> 6;
  unsigned char* R = p.ws + OFF_R;
  const float* RAW = (const float*)(R + R_RAW);
  bf16_t* CQ = (bf16_t*)(R + R_CQ); bf16_t* CKV = (bf16_t*)(R + R_CKV); bf16_t* KR = (bf16_t*)(R + R_KR);
  const float* gq = p.in[11] + j * 512; const float* gkv = p.in[14] + j * 256;
  const float* rope = (const float*)(p.ws + OFF_ROPE);
  for (int row = bid * 8 + w; row < T; row += nblk * 8) {
    const float* rr = RAW + (size_t)row * 1024;
    float4 a0 = *(const float4*)(rr + lane * 4), a1 = *(const float4*)(rr + 256 + lane * 4);
    float4 c0 = *(const float4*)(rr + 512 + lane * 4);
    float ss = a0.x * a0.x + a0.y * a0.y + a0.z * a0.z + a0.w * a0.w + a1.x * a1.x + a1.y * a1.y + a1.z * a1.z + a1.w * a1.w;
    float s2 = c0.x * c0.x + c0.y * c0.y + c0.z * c0.z + c0.w * c0.w;
    ss = wave_sum(ss, lane); s2 = wave_sum(s2, lane);
    float r1 = rsqrtf(ss * (1.f / 512.f) + EPS), r2 = rsqrtf(s2 * (1.f / 256.f) + EPS);
    {
      float4 g0 = *(const float4*)(gq + lane * 4), g1 = *(const float4*)(gq + 256 + lane * 4);
      uint2 pk; pk.x = pack2(a0.x * r1 * g0.x, a0.y * r1 * g0.y); pk.y = pack2(a0.z * r1 * g0.z, a0.w * r1 * g0.w);
      *(uint2*)(CQ + (size_t)row * 512 + lane * 4) = pk;
      pk.x = pack2(a1.x * r1 * g1.x, a1.y * r1 * g1.y); pk.y = pack2(a1.z * r1 * g1.z, a1.w * r1 * g1.w);
      *(uint2*)(CQ + (size_t)row * 512 + 256 + lane * 4) = pk;
    }
    const int rm = rowmap(row);
    {
      float4 g = *(const float4*)(gkv + lane * 4);
      float4 o = make_float4(c0.x * r2 * g.x, c0.y * r2 * g.y, c0.z * r2 * g.z, c0.w * r2 * g.w);
      float* op = (row < TP) ? p.out + O_CKVP + ((size_t)j * TP + row) * 256 : p.out + O_CKVS + ((size_t)j * TS + (row - TP)) * 256;
      *(float4*)(op + lane * 4) = o;
      uint2 pk; pk.x = pack2(o.x, o.y); pk.y = pack2(o.z, o.w);
      *(uint2*)(CKV + (size_t)rm * 256 + lane * 4) = pk;
    }
    if (lane < 16) {
      float x1 = rr[768 + lane], x2 = rr[784 + lane];
      int pos = tokpos(row);
      float2 cs = *(const float2*)(rope + ((size_t)pos * 16 + lane) * 2);
      float o1 = x1 * cs.x - x2 * cs.y, o2 = x1 * cs.y + x2 * cs.x;
      float* op = (row < TP) ? p.out + O_KRP + ((size_t)j * TP + row) * 32 : p.out + O_KRS + ((size_t)j * TS + (row - TP)) * 32;
      op[lane] = o1; op[16 + lane] = o2;
      KR[(size_t)rm * 32 + lane] = tobf(o1); KR[(size_t)rm * 32 + 16 + lane] = tobf(o2);
    }
  }
}

DI void dsa_rowops(PREF p, int bid, int nblk, int wv) {
  const int lane = ltid(wv) & 63, w = ltid(wv) >> 6;
  unsigned char* R = p.ws + OFF_R;
  const float* KIR = (const float*)(R + D_KIR);
  bf16_t* KI = (bf16_t*)(R + D_KI);
  const float* g = p.in[27];
  for (int row = bid * 8 + w; row < T; row += nblk * 8) {
    float v = KIR[(size_t)row * 64 + lane];
    float ss = wave_sum(v * v, lane);
    float r = rsqrtf(ss * (1.f / 64.f) + EPS);
    float o = v * r * g[lane];
    if (row < TP) p.out[O_DIP + (size_t)row * 64 + lane] = o; else p.out[O_DIS + (size_t)(row - TP) * 64 + lane] = o;
    KI[(size_t)rowmap(row) * 64 + lane] = tobf(o);
  }
}

DI void cmlp_ln_rows(PREF p, int bid, int nblk, int wv) {
  const int lane = ltid(wv) & 63, w = ltid(wv) >> 6;
  unsigned char* R = p.ws + OFF_R;
  const bf16_t* VR = (const bf16_t*)(R + C_VR);
  bf16_t* VLN = (bf16_t*)(R + C_VLN);
  const float* g = p.in[18]; const float* bb = p.in[19];
  for (int row = bid * 8 + w; row < T; row += nblk * 8) {
    float x[32];
    float sum = 0.f;
#pragma unroll
    for (int c = 0; c < 4; ++c) {
      uint4 u = *(const uint4*)(VR + (size_t)row * 2048 + c * 512 + lane * 8);
      x[c * 8 + 0] = bflo(u.x); x[c * 8 + 1] = bfhi(u.x); x[c * 8 + 2] = bflo(u.y); x[c * 8 + 3] = bfhi(u.y);
      x[c * 8 + 4] = bflo(u.z); x[c * 8 + 5] = bfhi(u.z); x[c * 8 + 6] = bflo(u.w); x[c * 8 + 7] = bfhi(u.w);
    }
#pragma unroll
    for (int i = 0; i < 32; ++i) sum += x[i];
    sum = wave_sum(sum, lane);
    float mu = sum * (1.f / 2048.f);
    float vs = 0.f;
#pragma unroll
    for (int i = 0; i < 32; ++i) { x[i] -= mu; vs += x[i] * x[i]; }
    vs = wave_sum(vs, lane);
    float r = rsqrtf(vs * (1.f / 2048.f) + EPS);
#pragma unroll
    for (int c = 0; c < 4; ++c) {
      int col = c * 512 + lane * 8;
      float y[8];
#pragma unroll
      for (int q = 0; q < 2; ++q) {
        float4 gg = *(const float4*)(g + col + q * 4), b4 = *(const float4*)(bb + col + q * 4);
        y[q * 4 + 0] = x[c * 8 + q * 4 + 0] * r * gg.x + b4.x; y[q * 4 + 1] = x[c * 8 + q * 4 + 1] * r * gg.y + b4.y;
        y[q * 4 + 2] = x[c * 8 + q * 4 + 2] * r * gg.z + b4.z; y[q * 4 + 3] = x[c * 8 + q * 4 + 3] * r * gg.w + b4.w;
      }
      uint4 pk; pk.x = pack2(y[0], y[1]); pk.y = pack2(y[2], y[3]); pk.z = pack2(y[4], y[5]); pk.w = pack2(y[6], y[7]);
      *(uint4*)(VLN + (size_t)row * 2048 + col) = pk;
      if (row >= TP) {
        float* o = p.out + O_CVS + (size_t)(row - TP) * 2048 + col;
        *(float4*)o = make_float4(y[0], y[1], y[2], y[3]); *(float4*)(o + 4) = make_float4(y[4], y[5], y[6], y[7]);
      }
    }
  }
}

DI void cmlp_mix_phase(PREF p, unsigned char* smem, int bid, int nblk, int wv) {
  const int tid = ltid(wv), lane = tid & 63, w = tid >> 6, wm = w >> 2, wn = w & 3, lr = lane & 31, lh = lane >> 5;
  unsigned char* R = p.ws + OFF_R;
  const bf16_t* U = (const bf16_t*)(R + C_U);
  const bf16_t* VLN = (const bf16_t*)(R + C_VLN);
  bf16_t* G = (bf16_t*)(R + C_G);
  const bf16_t* WT = (const bf16_t*)(p.ws + OFF_W) + W_TRIL;
  const float* bs = p.in[21];
  bf16_t* As = (bf16_t*)smem;
  bf16_t* Bs = As + 128 * 136;
  for (int u = bid; u < 1024; u += nblk) {
    const int g = u & 7, ch = u >> 3;
    const int col0 = g * 256;
#pragma unroll 2
    for (int i = 0; i < 4; ++i) {
      int v = tid + i * NT; int r = v >> 4, c = (v & 15) * 8;
      *(uint4*)(As + r * 136 + c) = *(const uint4*)(WT + ((size_t)g * 128 + r) * 128 + c);
    }
#pragma unroll 2
    for (int i = 0; i < 8; ++i) {
      int v = tid + i * NT; int s = v >> 5, c = (v & 31) * 8;
      uint4 x = *(const uint4*)(VLN + ((size_t)ch * 128 + s) * 2048 + col0 + c);
      Bs[(c + 0) * 136 + s] = (bf16_t)(x.x & 0xffff); Bs[(c + 1) * 136 + s] = (bf16_t)(x.x >> 16);
      Bs[(c + 2) * 136 + s] = (bf16_t)(x.y & 0xffff); Bs[(c + 3) * 136 + s] = (bf16_t)(x.y >> 16);
      Bs[(c + 4) * 136 + s] = (bf16_t)(x.z & 0xffff); Bs[(c + 5) * 136 + s] = (bf16_t)(x.z >> 16);
      Bs[(c + 6) * 136 + s] = (bf16_t)(x.w & 0xffff); Bs[(c + 7) * 136 + s] = (bf16_t)(x.w >> 16);
    }
    __syncthreads();
    f32x16 acc[2][2];
#pragma unroll
    for (int a = 0; a < 2; ++a)
#pragma unroll
      for (int b = 0; b < 2; ++b)
#pragma unroll
        for (int i = 0; i < 16; ++i) acc[a][b][i] = 0.f;
    const bf16_t* Asb = As + (wm * 64 + lr) * 136 + lh * 8;
    const bf16_t* Bsb = Bs + (wn * 64 + lr) * 136 + lh * 8;
    const int ns = (wm + 1) * 4;
    for (int s = 0; s < ns; ++s) {
      bf16x8 a0 = *(const bf16x8*)(Asb + s * 16);
      bf16x8 a1 = *(const bf16x8*)(Asb + 32 * 136 + s * 16);
      bf16x8 b0 = *(const bf16x8*)(Bsb + s * 16);
      bf16x8 b1 = *(const bf16x8*)(Bsb + 32 * 136 + s * 16);
      acc[0][0] = MFMA32(a0, b0, acc[0][0]);
      acc[0][1] = MFMA32(a0, b1, acc[0][1]);
      acc[1][0] = MFMA32(a1, b0, acc[1][0]);
      acc[1][1] = MFMA32(a1, b1, acc[1][1]);
    }
#pragma unroll
    for (int mi = 0; mi < 2; ++mi)
#pragma unroll
      for (int ni = 0; ni < 2; ++ni)
#pragma unroll
        for (int i = 0; i < 16; ++i) {
          int t = wm * 64 + mi * 32 + crow(i, lh);
          int col = col0 + wn * 64 + ni * 32 + lr;
          size_t off = ((size_t)ch * 128 + t) * 2048 + col;
          float mixed = acc[mi][ni][i] + bs[g * 128 + t];
          G[off] = tobf(frombf(U[off]) * mixed);
        }
    __syncthreads();
  }
  const float* wsf = p.in[20];
  for (int e = bid * NT + tid; e < TS * 2048; e += nblk * NT) {
    int row = e >> 11, col = e & 2047, b = row >> 4, t = row & 15, g = col >> 8;
    float a = bs[g * 128 + t];
    for (int s = 0; s <= t; ++s) a += wsf[((size_t)g * 128 + t) * 128 + s] * frombf(VLN[((size_t)TP + b * 16 + s) * 2048 + col]);
    size_t off = ((size_t)TP + row) * 2048 + col;
    G[off] = tobf(frombf(U[off]) * a);
  }
}

template <int DQK, bool IS_MLA, bool MASKED>
DI void attn8_unit(const bf16_t* __restrict__ Qp, int ldq, int nq,
                   const bf16_t* __restrict__ Kp, int ldk, const bf16_t* __restrict__ KRp,
                   const bf16_t* __restrict__ Vtp, int ldv, int kmax,
                   int nit, int nk64_w, int nkeys, const unsigned* __restrict__ BMp,
                   bf16_t* __restrict__ AOp, unsigned char* smem, int wv) {
  constexpr int KS = DQK + 8;
  constexpr int VS = 136;
  constexpr int NQS = DQK / 16;
  const int tid = ltid(wv), lane = tid & 63, w = tid >> 6, lr = lane & 31, lh = lane >> 5;
  bf16_t* Ks = (bf16_t*)smem;
  bf16_t* Vs = Ks + 2 * 128 * KS;
  const bool q_ok = (w * 32 + lr) < nq;
  const int qrow = q_ok ? (w * 32 + lr) : 0;
  bf16x8 qf[NQS];
#pragma unroll
  for (int s = 0; s < NQS; ++s) qf[s] = *(const bf16x8*)(Qp + (size_t)qrow * ldq + s * 16 + lh * 8);
  f32x16 oacc[2];
#pragma unroll
  for (int d = 0; d < 2; ++d)
#pragma unroll
    for (int i = 0; i < 16; ++i) oacc[d][i] = 0.f;
  float m_run = -INFINITY, l_run = 0.f;
  const int kkey = tid >> 3, kc = (tid & 7) * 8;
  const int rkey = tid >> 2, rc = (tid & 3) * 8;
  const int vd = tid >> 4, vk = (tid & 15) * 8;
  const int vpos = (vk & 96) + ((vk >> 4) & 1) * 16 + ((vk >> 3) & 1) * 4;
  uint4 rk0, rk1, rr, rv0, rv1;
  rr = make_uint4(0, 0, 0, 0);
  uint4 bm_next = make_uint4(0xffffffffu, 0xffffffffu, 0xffffffffu, 0xffffffffu), bm_cur = bm_next;
#define GLOAD(it_) do { const int key0_ = (it_) * 128; \
    { int kr_ = min(key0_ + kkey, kmax - 1); rk0 = *(const uint4*)(Kp + (size_t)kr_ * ldk + kc); } \
    { int kr_ = min(key0_ + kkey + 64, kmax - 1); rk1 = *(const uint4*)(Kp + (size_t)kr_ * ldk + kc); } \
    if constexpr (IS_MLA) { int kr_ = min(key0_ + rkey, kmax - 1); rr = *(const uint4*)(KRp + (size_t)kr_ * 32 + rc); } \
    { int kv_ = min(key0_ + vk, kmax - 8); rv0 = *(const uint4*)(Vtp + (size_t)vd * ldv + kv_); rv1 = *(const uint4*)(Vtp + (size_t)(vd + 32) * ldv + kv_); } \
    if constexpr (MASKED) { if (BMp) bm_next = *(const uint4*)(BMp + (size_t)qrow * 256 + (it_) * 4); } } while (0)
#define SSTORE(buf_) do { bf16_t* Kb_ = Ks + (buf_) * 128 * KS; bf16_t* Vb_ = Vs + (buf_) * 64 * VS; \
    *(uint4*)(Kb_ + kkey * KS + kc) = rk0; *(uint4*)(Kb_ + (kkey + 64) * KS + kc) = rk1; \
    if constexpr (IS_MLA) *(uint4*)(Kb_ + rkey * KS + 64 + rc) = rr; \
    *(uint2*)(Vb_ + vd * VS + vpos) = make_uint2(rv0.x, rv0.y); *(uint2*)(Vb_ + vd * VS + vpos + 8) = make_uint2(rv0.z, rv0.w); \
    *(uint2*)(Vb_ + (vd + 32) * VS + vpos) = make_uint2(rv1.x, rv1.y); *(uint2*)(Vb_ + (vd + 32) * VS + vpos + 8) = make_uint2(rv1.z, rv1.w); } while (0)
  const int nit_w = (nk64_w + 1) >> 1;
  __syncthreads();
  GLOAD(0); SSTORE(0); bm_cur = bm_next;
  __syncthreads();
  for (int it = 0; it < nit; ++it) {
    const int buf = it & 1;
    if (it + 1 < nit) GLOAD(it + 1);
    if (it < nit_w) {
      const bf16_t* Kb = Ks + buf * 128 * KS; const bf16_t* Vb = Vs + buf * 64 * VS;
      f32x16 sacc[4];
#pragma unroll
      for (int t4 = 0; t4 < 4; ++t4) {
#pragma unroll
        for (int i = 0; i < 16; ++i) sacc[t4][i] = 0.f;
#pragma unroll
        for (int s = 0; s < NQS; ++s) {
          bf16x8 kf = *(const bf16x8*)(Kb + (t4 * 32 + lr) * KS + s * 16 + lh * 8);
          sacc[t4] = MFMA32(kf, qf[s], sacc[t4]);
        }
      }
      if ((2 * it + 1) >= nk64_w) {
#pragma unroll
        for (int t4 = 2; t4 < 4; ++t4)
#pragma unroll
          for (int i = 0; i < 16; ++i) sacc[t4][i] = -INFINITY;
      }
      float mx = -INFINITY;
#pragma unroll
      for (int t4 = 0; t4 < 4; ++t4) {
        const unsigned wbits = (t4 == 0) ? bm_cur.x : (t4 == 1) ? bm_cur.y : (t4 == 2) ? bm_cur.z : bm_cur.w;
#pragma unroll
        for (int i = 0; i < 16; ++i) {
          if constexpr (MASKED) {
            const int kin = crow(i, lh);
            const int key = it * 128 + t4 * 32 + kin;
            bool ok = (key < nkeys) && ((wbits >> kin) & 1u);
            sacc[t4][i] = ok ? sacc[t4][i] : -INFINITY;
          }
          mx = fmaxf(mx, sacc[t4][i]);
        }
      }
      mx = fmaxf(mx, shflx(mx, 32, lane));
      const float m_new = fmaxf(m_run, mx);
      const float m_safe = (m_new == -INFINITY) ? 0.f : m_new;
      const float alpha = __builtin_amdgcn_exp2f(m_run - m_safe);
      m_run = m_new;
      float ls = 0.f;
#pragma unroll
      for (int t4 = 0; t4 < 4; ++t4)
#pragma unroll
        for (int i = 0; i < 16; ++i) { float pv = __builtin_amdgcn_exp2f(sacc[t4][i] - m_safe); sacc[t4][i] = pv; ls += pv; }
      l_run = l_run * alpha + ls;
#pragma unroll
      for (int d = 0; d < 2; ++d)
#pragma unroll
        for (int i = 0; i < 16; ++i) oacc[d][i] *= alpha;
#pragma unroll
      for (int t4 = 0; t4 < 4; ++t4)
#pragma unroll
        for (int s = 0; s < 2; ++s) {
          uint4 pp;
          pp.x = pack2(sacc[t4][8 * s + 0], sacc[t4][8 * s + 1]);
          pp.y = pack2(sacc[t4][8 * s + 2], sacc[t4][8 * s + 3]);
          pp.z = pack2(sacc[t4][8 * s + 4], sacc[t4][8 * s + 5]);
          pp.w = pack2(sacc[t4][8 * s + 6], sacc[t4][8 * s + 7]);
          bf16x8 pf = __builtin_bit_cast(bf16x8, pp);
#pragma unroll
          for (int dt = 0; dt < 2; ++dt) {
            bf16x8 vf = *(const bf16x8*)(Vb + (dt * 32 + lr) * VS + t4 * 32 + 16 * s + 8 * lh);
            oacc[dt] = MFMA32(vf, pf, oacc[dt]);
          }
        }
    }
    if (it + 1 < nit) { SSTORE(buf ^ 1); bm_cur = bm_next; }
    __syncthreads();
  }
  if (nit_w > 0) {
    float lt = l_run + shflx(l_run, 32, lane);
    float inv = lt > 0.f ? 1.f / lt : 0.f;
    if (q_ok) {
      bf16_t* orow = AOp + (size_t)(w * 32 + lr) * 1024;
#pragma unroll
      for (int dt = 0; dt < 2; ++dt)
#pragma unroll
        for (int g = 0; g < 4; ++g) {
          uint2 pk;
          pk.x = pack2(oacc[dt][4 * g] * inv, oacc[dt][4 * g + 1] * inv);
          pk.y = pack2(oacc[dt][4 * g + 2] * inv, oacc[dt][4 * g + 3] * inv);
          *(uint2*)(orow + dt * 32 + 8 * g + 4 * lh) = pk;
        }
    }
  }
}
#undef GLOAD
#undef SSTORE

DI int snake_idx(int i, int bid, int nblk) { return i * nblk + ((i & 1) ? (nblk - 1 - bid) : bid); }

template <bool IS_MLA>
DI void attn_phase(PREF p, unsigned char* smem, int bid, int nblk, int wv) {
  unsigned char* R = p.ws + OFF_R;
  const int w = ltid(wv) >> 6;
  const int total = 1024 + 512;
  for (int i = 0; i * nblk < total; ++i) {
    int u = snake_idx(i, bid, nblk);
    if (u >= total) continue;
    if constexpr (IS_MLA) {
      const bf16_t* Q = (const bf16_t*)(R + R_Q); const bf16_t* KN = (const bf16_t*)(R + R_KN);
      const bf16_t* KR = (const bf16_t*)(R + R_KR); const bf16_t* VT = (const bf16_t*)(R + R_VT);
      bf16_t* AO = (bf16_t*)(R + R_RAW);
      if (u < 1024) {
        int qt = 31 - (u >> 5), bh = u & 31, b = bh >> 4, h = bh & 15;
        int q0 = b * 8192 + qt * 256;
        attn8_unit<96, true, false>(Q + (size_t)q0 * 1536 + h * 96, 1536, 256,
                                    KN + (size_t)(b * 8192) * 1024 + h * 64, 1024, KR + (size_t)(b * 8192) * 32,
                                    VT + (size_t)((b * 16 + h) * 64) * 8192, 8192, 8192,
                                    2 * qt + 2, 4 * qt + 1 + (w >> 1), 1 << 30, nullptr,
                                    AO + (size_t)q0 * 1024 + h * 64, smem, wv);
      } else {
        int v = u - 1024, b = v >> 4, h = v & 15;
        int q0 = TP + b * 16;
        attn8_unit<96, true, true>(Q + (size_t)q0 * 1536 + h * 96, 1536, 16,
                                   KN + (size_t)(TP + b * SPAD) * 1024 + h * 64, 1024, KR + (size_t)(TP + b * SPAD) * 32,
                                   VT + (size_t)TP * 1024 + (size_t)((b * 16 + h) * 64) * SPAD, SPAD, SPAD,
                                   9, (w == 0) ? 17 : 0, NKS, nullptr,
                                   AO + (size_t)q0 * 1024 + h * 64, smem, wv);
      }
    } else {
      const bf16_t* Q = (const bf16_t*)(R + D_Q); const bf16_t* KK = (const bf16_t*)(R + D_K);
      const bf16_t* VT = (const bf16_t*)(R + D_VT); const unsigned* BM = (const unsigned*)(R + D_BM);
      bf16_t* AO = (bf16_t*)(R + D_AO);
      if (u < 1024) {
        int qt = 31 - (u >> 5), bh = u & 31, b = bh >> 4, h = bh & 15;
        int q0 = b * 8192 + qt * 256;
        attn8_unit<64, false, true>(Q + (size_t)q0 * 1024 + h * 64, 1024, 256,
                                    KK + (size_t)(b * 8192) * 1024 + h * 64, 1024, nullptr,
                                    VT + (size_t)((b * 16 + h) * 64) * 8192, 8192, 8192,
                                    2 * qt + 2, 4 * qt + 1 + (w >> 1), 1 << 30, BM + (size_t)q0 * 256,
                                    AO + (size_t)q0 * 1024 + h * 64, smem, wv);
      } else {
        int v = u - 1024, b = v >> 4, h = v & 15;
        int q0 = TP + b * 16;
        attn8_unit<64, false, true>(Q + (size_t)q0 * 1024 + h * 64, 1024, 16,
                                    KK + (size_t)(TP + b * SPAD) * 1024 + h * 64, 1024, nullptr,
                                    VT + (size_t)TP * 1024 + (size_t)((b * 16 + h) * 64) * SPAD, SPAD, SPAD,
                                    9, (w == 0) ? 17 : 0, NKS, BM + (size_t)q0 * 256,
                                    AO + (size_t)q0 * 1024 + h * 64, smem, wv);
      }
    }
  }
}

constexpr int CAP = 128;
DI int score_bin(float s) {
  unsigned u = __float_as_uint(s);
  int e = (int)((u & 0x7fffffffu) >> 19);
  int m = min(max(e, 1840), 2095) - 1840;
  return (u >> 31) ? (255 - m) : (256 + m);
}

DI void idx_unit(const bf16_t* __restrict__ QI, const float* __restrict__ WI, int q_row0, int nq,
                 const bf16_t* __restrict__ KI, int L, unsigned* __restrict__ BM, unsigned char* smem, int wv) {
  const int tid = ltid(wv), lane = tid & 63, w = tid >> 6, lr = lane & 31, lh = lane >> 5;
  bf16_t* Qs = (bf16_t*)smem;
  float* Ws = (float*)(smem + 36864);
  unsigned* hist = (unsigned*)(smem + 36864 + 1024);
  float* cand_s = (float*)hist;
  int* cand_i = (int*)(smem + 36864 + 1024 + 16384);
  int* bstar = (int*)(smem + 36864 + 1024 + 32768);
  int* need = bstar + 32;
  int* ncand = need + 32;
  __syncthreads();
#pragma unroll
  for (int i = 0; i < 4; ++i) {
    int v = tid + i * NT;
    int hd = v >> 8, q = (v >> 3) & 31, c = (v & 7) * 8;
    int qq = q < nq ? q : 0;
    *(uint4*)(Qs + (hd * 32 + q) * 72 + c) = *(const uint4*)(QI + (size_t)(q_row0 + qq) * 512 + hd * 64 + c);
  }
  if (tid < 256) { int hd = tid >> 5, q = tid & 31; int qq = q < nq ? q : 0; Ws[hd * 32 + q] = WI[(size_t)(q_row0 + qq) * 8 + hd]; }
  for (int i = tid; i < 32 * 256; i += NT) hist[i] = 0u;
  if (tid < 32) { bstar[tid] = -1; need[tid] = 0; ncand[tid] = 0; }
  __syncthreads();
  const int ntile = (L + 255) >> 8;
  const bool do_select = L > 256;
  int bsr[16];
  { int m1_ = -1; asm volatile("" : "+v"(m1_));
#pragma unroll
    for (int i = 0; i < 16; ++i) bsr[i] = m1_; }
  for (int pass = do_select ? 0 : 1; pass < 2; ++pass) {
    if (pass == 1) {
#pragma unroll
      for (int i = 0; i < 16; ++i) bsr[i] = bstar[crow(i, lh)];
    }
    bf16x8 kn0, kn1, kn2, kn3;
    { const bf16_t* kp = KI + (size_t)(w * 32 + lr) * 64 + lh * 8;
      kn0 = *(const bf16x8*)(kp); kn1 = *(const bf16x8*)(kp + 16); kn2 = *(const bf16x8*)(kp + 32); kn3 = *(const bf16x8*)(kp + 48); }
    for (int kt = 0; kt < ntile; ++kt) {
      const int key0 = kt * 256 + w * 32;
      bf16x8 kf[4];
      kf[0] = kn0; kf[1] = kn1; kf[2] = kn2; kf[3] = kn3;
      if (key0 + 256 < L) {
        const bf16_t* kp = KI + (size_t)(key0 + 256 + lr) * 64 + lh * 8;
        kn0 = *(const bf16x8*)(kp); kn1 = *(const bf16x8*)(kp + 16); kn2 = *(const bf16x8*)(kp + 32); kn3 = *(const bf16x8*)(kp + 48);
      }
      if (key0 < L) {
        const int key = key0 + lr;
        float sc[16];
#pragma unroll
        for (int i = 0; i < 16; ++i) sc[i] = 0.f;
#pragma unroll 1
        for (int hd = 0; hd < 8; ++hd) {
          f32x16 acc;
#pragma unroll
          for (int i = 0; i < 16; ++i) acc[i] = 0.f;
#pragma unroll
          for (int s = 0; s < 4; ++s) {
            bf16x8 qf = *(const bf16x8*)(Qs + (hd * 32 + lr) * 72 + s * 16 + lh * 8);
            acc = MFMA32(qf, kf[s], acc);
          }
#pragma unroll
          for (int g = 0; g < 4; ++g) {
            float4 wv = *(const float4*)(Ws + hd * 32 + 8 * g + 4 * lh);
            sc[4 * g + 0] += wv.x * fmaxf(acc[4 * g + 0], 0.f);
            sc[4 * g + 1] += wv.y * fmaxf(acc[4 * g + 1], 0.f);
            sc[4 * g + 2] += wv.z * fmaxf(acc[4 * g + 2], 0.f);
            sc[4 * g + 3] += wv.w * fmaxf(acc[4 * g + 3], 0.f);
          }
        }
        const bool kvalid = key < L;
        if (pass == 0) {
#pragma unroll
          for (int i = 0; i < 16; ++i) {
            int q = crow(i, lh);
            if (kvalid) { int b = score_bin(sc[i]); atomicAdd(&hist[q * 256 + (b >> 1)], (b & 1) ? 65536u : 1u); }
          }
        } else {
          unsigned myword = 0u, cmask = 0u;
          unsigned long long any = 0ull;
#pragma unroll
          for (int i = 0; i < 16; ++i) {
            const int b = score_bin(sc[i]);
            const int bs = bsr[i];
            const bool sel = kvalid && (b > bs);
            const bool cnd = kvalid && (b == bs);
            const unsigned long long bal = __ballot(sel);
            myword = (lr == i) ? (unsigned)(bal >> (32 * lh)) : myword;
            any |= __ballot(cnd);
            cmask |= cnd ? (1u << i) : 0u;
          }
          if (lr < 16 && crow(lr, lh) < nq) BM[(size_t)(q_row0 + crow(lr, lh)) * 256 + (key0 >> 5)] = myword;
          if (any != 0ull) {
            int base[16];
#pragma unroll
            for (int i = 0; i < 16; ++i) {
              const unsigned long long cbi = __ballot((cmask >> i) & 1u);
              base[i] = 0;
              if (lr == 0) base[i] = atomicAdd(&ncand[crow(i, lh)], __popc((unsigned)(cbi >> (32 * lh))));
            }
#pragma unroll
            for (int i = 0; i < 16; ++i) {
              const unsigned long long cbi = __ballot((cmask >> i) & 1u);
              const int bb = __builtin_amdgcn_ds_bpermute((lane & 32) << 2, base[i]);
              if ((cmask >> i) & 1u) {
                const unsigned hm = (unsigned)(cbi >> (32 * lh));
                const int pos = bb + __popc(hm & ((1u << lr) - 1u));
                const int q = crow(i, lh);
                if (pos < CAP) { cand_s[q * CAP + pos] = sc[i]; cand_i[q * CAP + pos] = key; }
              }
            }
          }
        }
      }
    }
    __syncthreads();
    if (pass == 0) {
      for (int qi = 0; qi < 4; ++qi) {
        const int q = w * 4 + qi;
        unsigned hw[4];
#pragma unroll
        for (int k = 0; k < 4; ++k) hw[k] = hist[q * 256 + 255 - 4 * lane - k];
        int cnt = 0;
#pragma unroll
        for (int k = 0; k < 4; ++k) cnt += (int)(hw[k] >> 16) + (int)(hw[k] & 0xffffu);
        int pre = cnt;
#pragma unroll
        for (int o = 1; o < 64; o <<= 1) { int t = __builtin_amdgcn_ds_bpermute(((lane - o) & 63) << 2, pre); if (lane >= o) pre += t; }
        unsigned long long bal = __ballot(pre >= 256);
        if (bal != 0ull) {
          int fl = __ffsll((long long)bal) - 1;
          if (lane == fl) {
            int running = pre - cnt;
            int bsel = -1, above = 0;
#pragma unroll
            for (int k = 0; k < 4; ++k) {
              int chi = (int)(hw[k] >> 16), clo = (int)(hw[k] & 0xffffu);
              if (bsel < 0) { if (running + chi >= 256) { bsel = 511 - 8 * lane - 2 * k; above = running; } else running += chi; }
              if (bsel < 0) { if (running + clo >= 256) { bsel = 510 - 8 * lane - 2 * k; above = running; } else running += clo; }
            }
            bstar[q] = bsel; need[q] = 256 - above;
          }
        }
      }
      __syncthreads();
    }
  }
  __threadfence();
  __syncthreads();
  if (do_select) {
    for (int pi = tid; pi < 32 * CAP; pi += NT) {
      int q = pi / CAP, c = pi - q * CAP;
      int n = min(ncand[q], CAP);
      if (c < n && q < nq) {
        float sv = cand_s[q * CAP + c]; int iv = cand_i[q * CAP + c];
        int rank = 0;
        for (int j = 0; j < n; ++j) {
          float sj = cand_s[q * CAP + j]; int ij = cand_i[q * CAP + j];
          rank += (sj > sv || (sj == sv && ij < iv)) ? 1 : 0;
        }
        if (rank < need[q]) atomicOr(&BM[(size_t)(q_row0 + q) * 256 + (iv >> 5)], 1u << (iv & 31));
      }
    }
  }
  __syncthreads();
}

DI void idx_phase(PREF p, unsigned char* smem, int bid, int nblk, int wv) {
  unsigned char* R = p.ws + OFF_R;
  const bf16_t* QI = (const bf16_t*)(R + D_QI); const float* WI = (const float*)(R + D_WI);
  const bf16_t* KI = (const bf16_t*)(R + D_KI); unsigned* BM = (unsigned*)(R + D_BM);
  const int total = 512 + 32;
  for (int i = 0; i * nblk < total; ++i) {
    int idx = snake_idx(i, bid, nblk);
    if (idx >= total) continue;
    if (idx < 512) {
      int qt = 255 - (idx >> 1), b = idx & 1;
      int L = (((qt * 32) >> 6) + 1) * 64;
      idx_unit(QI, WI, b * 8192 + qt * 32, 32, KI + (size_t)(b * 8192) * 64, L, BM, smem, wv);
    } else {
      int b = idx - 512;
      idx_unit(QI, WI, TP + b * 16, 16, KI + (size_t)(TP + b * SPAD) * 64, NKS, BM, smem, wv);
    }
  }
}

DI void cvt8(const float* s, bf16_t* d) {
  float4 a = *(const float4*)s, b = *(const float4*)(s + 4);
  uint4 pk; pk.x = pack2(a.x, a.y); pk.y = pack2(a.z, a.w); pk.z = pack2(b.x, b.y); pk.w = pack2(b.z, b.w);
  *(uint4*)d = pk;
}
DI void cache_rows(const float* __restrict__ src, bf16_t* __restrict__ dst, int Wd, int bid, int nblk, int wv) {
  const int vpr = Wd >> 3;
  const size_t total = (size_t)32 * SPAD * vpr;
  for (size_t e = (size_t)bid * NT + ltid(wv); e < total; e += (size_t)nblk * NT) {
    int c = (int)(e % vpr) * 8; size_t rw = e / vpr; int b = (int)(rw / SPAD), s = (int)(rw % SPAD);
    bf16_t* d = dst + ((size_t)TP + (size_t)b * SPAD + s) * Wd + c;
    if (s < 1024) cvt8(src + ((size_t)b * 1024 + s) * Wd + c, d);
    else if (s >= NKS) { unsigned z = 0; asm volatile("" : "+v"(z)); *(uint4*)d = make_uint4(z, z, z, z); }
  }
}


#define XB_TMO      128
#define XB_XCNT(j)  (256  + 64 * (j))
#define XB_XSUB(j)  (1280 + 64 * (j))
#define XB_XGEN(j)  (2304 + 64 * (j))
#define XB_TOP      3328
#define XB_TOPGEN   3392
#define XCD_BAR_WORDS 3456
#define XB_SPIN_CAP (1u << 18)
DI unsigned xb_ld(unsigned* p)              { return __hip_atomic_load(p, __ATOMIC_RELAXED, __HIP_MEMORY_SCOPE_AGENT); }
DI unsigned xb_add(unsigned* p, unsigned v) { return __hip_atomic_fetch_add(p, v, __ATOMIC_RELAXED, __HIP_MEMORY_SCOPE_AGENT); }
DI unsigned xb_xcc_id() { return (unsigned)__builtin_amdgcn_s_getreg((3 << 11) | 20) & 0xFu; }
#define XB_SPIN(cond, bar) do { unsigned _sp = 0; while (cond) { __builtin_amdgcn_s_sleep(1); \
    if ((++_sp & 255u) == 0u) { if (xb_ld(&(bar)[XB_TMO])) break; if (_sp > XB_SPIN_CAP) { atomicAdd(&(bar)[XB_TMO], 1u); break; } } } } while (0)
struct XcdBarrier { unsigned* bar; unsigned x; volatile __attribute__((address_space(3))) unsigned* st; };
DI void xcd_barrier_complete(unsigned* bar, unsigned x, unsigned G, unsigned& nloc, unsigned& nx) {
  unsigned sum, cnt, mine, sp = 0u;
  for (;;) {
    sum = 0u; cnt = 0u; mine = 0u;
#pragma unroll
    for (unsigned j = 0; j < 16; ++j) { const unsigned c = xb_ld(&bar[XB_XCNT(j)]); sum += c; cnt += (c > 0u) ? 1u : 0u; mine = (j == x) ? c : mine; }
    if (sum == G) break;
    __builtin_amdgcn_s_sleep(1);
    if ((++sp & 255u) == 0u) { if (xb_ld(&bar[XB_TMO])) break; if (sp > XB_SPIN_CAP) { atomicAdd(&bar[XB_TMO], 1u); break; } }
  }
  nloc = mine > 0u ? mine : 1u; nx = cnt > 0u ? cnt : 1u;
}
DI void xcd_barrier(const XcdBarrier& b, int tid, unsigned G) {
  asm volatile("s_waitcnt vmcnt(0)" ::: "memory");
  __syncthreads();
  if (tid == 0) {
    unsigned* bar = b.bar;
    __builtin_amdgcn_s_waitcnt(0);
    unsigned nloc = b.st[0], nx = b.st[1];
    if (nloc == 0u) { xcd_barrier_complete(bar, b.x, G, nloc, nx); b.st[0] = nloc; b.st[1] = nx; }
    const unsigned old = xb_add(&bar[XB_XSUB(b.x)], 1u);
    const unsigned gen = old / nloc;
    if (old + 1u == (gen + 1u) * nloc) {
      __builtin_amdgcn_fence(__ATOMIC_RELEASE, "agent");
      asm volatile("s_waitcnt vmcnt(0)" ::: "memory");
      const unsigned og = xb_add(&bar[XB_TOP], 1u);
      const unsigned tg = og / nx;
      if (og + 1u == (tg + 1u) * nx) xb_add(&bar[XB_TOPGEN], 1u);
      else XB_SPIN(xb_ld(&bar[XB_TOPGEN]) == tg, bar);
      __builtin_amdgcn_fence(__ATOMIC_ACQUIRE, "agent");
      xb_add(&bar[XB_XGEN(b.x)], 1u);
      asm volatile("s_waitcnt vmcnt(0)" ::: "memory");
    } else {
      XB_SPIN(xb_ld(&bar[XB_XGEN(b.x)]) == gen, bar);
      __builtin_amdgcn_fence(__ATOMIC_ACQUIRE, "agent");
      asm volatile("s_waitcnt vmcnt(0)" ::: "memory");
    }
  }
  __syncthreads();
}

extern "C" __global__ void __launch_bounds__(512, 2) mega(Params p_unused) {
  extern __shared__ __attribute__((aligned(16))) unsigned char smem[];
  cg::grid_group grid = cg::this_grid();
  const int bid = blockIdx.x, nblk = gridDim.x;
  const int wv = __builtin_amdgcn_readfirstlane((int)(threadIdx.x >> 6));
  CParams* pk = (CParams*)__builtin_amdgcn_kernarg_segment_ptr();
  const int ph_lo = pk->ph_lo, ph_hi = pk->ph_hi;
  int ph = 0;
  if (ph_lo > 0x40000000) grid.sync();
  XcdBarrier xb;
  {
    volatile __attribute__((address_space(3))) unsigned* st = (volatile __attribute__((address_space(3))) unsigned*)(smem + 131072);
    const int t0 = ltid(wv);
    if (t0 == 0) { st[0] = 0u; st[1] = 0u; }
    __syncthreads();
    xb.bar = (unsigned*)(pk->ws + OFF_BAR); xb.x = xb_xcc_id(); xb.st = st;
    if (t0 == 0) (void)xb_add(&xb.bar[XB_XCNT(xb.x)], 1u);
  }
#ifndef REPMASK
#define REPMASK 0u
#endif
#ifndef PMASK
#define PMASK 0xffffffffu
#endif
#define PHASE_BEGIN(k) if (ph >= ph_lo && ph < ph_hi) { if constexpr ((PMASK >> (k)) & 1u) for (int rep_ = 0; rep_ < 1 + (int)((REPMASK >> (k)) & 1u); ++rep_) { \
    CParams* pp_ = pk; asm volatile("" : "+s"(pp_)); PREF p = *pp_; const int tid = ltid(wv); \
    unsigned char* ws = p.ws; float* X = (float*)(ws + OFF_X); bf16_t* H = (bf16_t*)(ws + OFF_H); bf16_t* Wb = (bf16_t*)(ws + OFF_W); \
    float* ROPE = (float*)(ws + OFF_ROPE); unsigned char* R = ws + OFF_R; (void)tid; (void)X; (void)H; (void)Wb; (void)ROPE; (void)R;
#define PHASE_END   } if (ph + 1 < ph_hi) { xcd_barrier(xb, ltid(wv), (unsigned)nblk); } } ++ph;

  PHASE_BEGIN(0)
    {
      const int hf = tid >> 8, tl = tid & 255;
      float* smh = (float*)smem + hf * 4224;
      for (int t0 = bid * 2; t0 < p.total_tiles; t0 += nblk * 2) {
        const int t = t0 + hf;
        const bool active = t < p.total_tiles;
        const int tt = active ? t : 0;
        int ji = 0;
#pragma unroll 1
        for (int q = 1; q < NJOBS; ++q) if (tt >= p.jobs[q].tile0) ji = q;
        const CAS Job& jb = p.jobs[ji];
        int lt = tt - jb.tile0; int nkt = jb.k >> 6; int nt_ = lt / nkt, kt_ = lt - nt_ * nkt;
        transpose_tile(jb.src, jb.nsrc, jb.nsrc, jb.dst, jb.k, nt_ * 64, kt_ * 64, jb.mode, smh, tl, active);
      }
    }
    {
      const size_t n4p = (size_t)TP * 256, n4 = (size_t)T * 256;
      const float4* xp = (const float4*)p.in[0]; const float4* xs = (const float4*)p.in[1];
      for (size_t e = (size_t)bid * NT + tid; e < n4; e += (size_t)nblk * NT) ((float4*)X)[e] = (e < n4p) ? xp[e] : xs[e - n4p];
      for (int e = bid * NT + tid; e < 8192 * 16; e += nblk * NT) {
        int pos = e >> 4, i = e & 15;
        double rev = (double)pos * p.inv_freq[i] * 0.15915494309189535;
        rev -= floor(rev);
        float fr = (float)rev;
        ROPE[2 * e] = __builtin_amdgcn_cosf(fr); ROPE[2 * e + 1] = __builtin_amdgcn_sinf(fr);
      }
      const float* wsrc = p.in[20];
      for (int e = bid * NT + tid; e < 8 * 128 * 128; e += nblk * NT) {
        int s = e & 127, t = (e >> 7) & 127;
        Wb[W_TRIL + e] = tobf(s <= t ? wsrc[e] : 0.f);
      }
    }
  PHASE_END

#pragma unroll 1
  for (int L = 0; L < 4; ++L) {
    const int kind = L % 3, j = L / 3;
    if (kind == 0) {
      PHASE_BEGIN(1)
        rmsnorm_rows(X, p.in[7] + L * 1024, H, nullptr, nullptr, bid, nblk, wv);
        cache_rows(p.in[2] + (size_t)j * 32 * 1024 * 256, (bf16_t*)(R + R_CKV), 256, bid, nblk, wv);
        cache_rows(p.in[3] + (size_t)j * 32 * 1024 * 32, (bf16_t*)(R + R_KR), 32, bid, nblk, wv);
      PHASE_END
      PHASE_BEGIN(2)
        EArgs ea{}; ea.f0 = (float*)(R + R_RAW);
        gemm_phase<E_F32>(H, Wb + W_MLA + (size_t)j * WM_SZ + WM_D, T, 1024, 1024, ea, smem, 0, bid, nblk, wv);
      PHASE_END
      PHASE_BEGIN(3)
        mla_rowops(p, j, bid, nblk, wv);
      PHASE_END
      PHASE_BEGIN(4)
        EArgs ea{}; ea.b0 = (bf16_t*)(R + R_Q); ea.rope = ROPE;
        gemm_phase<E_MLAQ>((const bf16_t*)(R + R_CQ), Wb + W_MLA + (size_t)j * WM_SZ + WM_UQ, T, 1536, 512, ea, smem, 0, bid, nblk, wv);
        EArgs eb{}; eb.b0 = (bf16_t*)(R + R_KN); eb.b1 = (bf16_t*)(R + R_VT);
        gemm_phase<E_MLAKV>((const bf16_t*)(R + R_CKV), Wb + W_MLA + (size_t)j * WM_SZ + WM_UKV, KROWS, 2048, 256, eb, smem, (T / 256) * 6, bid, nblk, wv);
      PHASE_END
      PHASE_BEGIN(5)
        attn_phase<true>(p, smem, bid, nblk, wv);
      PHASE_END
      PHASE_BEGIN(6)
        EArgs ea{}; ea.f0 = X;
        gemm_phase<E_RESID>((const bf16_t*)(R + R_RAW), Wb + W_MLA + (size_t)j * WM_SZ + WM_O, T, 1024, 1024, ea, smem, 0, bid, nblk, wv);
      PHASE_END
    } else if (kind == 1) {
      PHASE_BEGIN(1)
        rmsnorm_rows(X, p.in[7] + L * 1024, H, nullptr, nullptr, bid, nblk, wv);
      PHASE_END
      PHASE_BEGIN(7)
        EArgs ea{}; ea.b0 = (bf16_t*)(R + C_U); ea.b1 = (bf16_t*)(R + C_VR);
        gemm_phase<E_GELU>(H, Wb + W_CM + WC_IN, T, 4096, 1024, ea, smem, 0, bid, nblk, wv);
      PHASE_END
      PHASE_BEGIN(8)
        cmlp_ln_rows(p, bid, nblk, wv);
      PHASE_END
      PHASE_BEGIN(9)
        cmlp_mix_phase(p, smem, bid, nblk, wv);
      PHASE_END
      PHASE_BEGIN(6)
        EArgs ea{}; ea.f0 = X;
        gemm_phase<E_RESID>((const bf16_t*)(R + C_G), Wb + W_CM + WC_OUT, T, 1024, 2048, ea, smem, 0, bid, nblk, wv);
      PHASE_END
    } else {
      PHASE_BEGIN(10)
        rmsnorm_rows(X, p.in[7] + L * 1024, H, nullptr, nullptr, bid, nblk, wv);
        cache_rows(p.in[4], (bf16_t*)(R + D_K), 1024, bid, nblk, wv);
        cache_rows(p.in[6], (bf16_t*)(R + D_KI), 64, bid, nblk, wv);
        {
          bf16_t* VTs = (bf16_t*)(R + D_VT) + (size_t)TP * 1024;
          {
            const int hf = tid >> 8, tl = tid & 255;
            float* smh = (float*)smem + hf * 4224;
            for (int u0 = bid * 2; u0 < 512 * 16; u0 += nblk * 2) {
              const int u = u0 + hf;
              int st = u & 15, bh = u >> 4, b = bh >> 4, h = bh & 15;
              transpose_tile(p.in[5] + (size_t)b * 1024 * 1024 + h * 64, 1024, 64, VTs + (size_t)(bh * 64) * SPAD, SPAD, 0, st * 64, 0, smh, tl, true);
            }
          }
          for (int e = bid * NT + tid; e < 512 * 64 * 12; e += nblk * NT) {
            int c = e % 12, rw = e / 12;
            { unsigned z = 0; asm volatile("" : "+v"(z)); *(uint2*)(VTs + (size_t)rw * SPAD + NKS + c * 4) = make_uint2(z, z); }
          }
        }
      PHASE_END
      PHASE_BEGIN(11)
        EArgs ea{};
        ea.f0 = p.out + O_DKP; ea.f1 = p.out + O_DKS; ea.f2 = p.out + O_DVP; ea.f3 = p.out + O_DVS;
        ea.f4 = (float*)(R + D_KIR); ea.f5 = (float*)(R + D_WI);
        ea.b0 = (bf16_t*)(R + D_Q); ea.b1 = (bf16_t*)(R + D_K); ea.b2 = (bf16_t*)(R + D_VT); ea.b3 = (bf16_t*)(R + D_QI);
        gemm_phase<E_DSA>(H, Wb + W_DS + WD_P, T, 3840, 1024, ea, smem, 0, bid, nblk, wv);
      PHASE_END
      PHASE_BEGIN(12)
        dsa_rowops(p, bid, nblk, wv);
      PHASE_END
      PHASE_BEGIN(13)
        idx_phase(p, smem, bid, nblk, wv);
      PHASE_END
      PHASE_BEGIN(14)
        attn_phase<false>(p, smem, bid, nblk, wv);
      PHASE_END
      PHASE_BEGIN(6)
        EArgs ea{}; ea.f0 = X;
        gemm_phase<E_RESID>((const bf16_t*)(R + D_AO), Wb + W_DS + WD_O, T, 1024, 1024, ea, smem, 0, bid, nblk, wv);
      PHASE_END
    }
    PHASE_BEGIN(1)
      rmsnorm_rows(X, p.in[8] + L * 1024, H, nullptr, nullptr, bid, nblk, wv);
    PHASE_END
    PHASE_BEGIN(15)
      EArgs ea{}; ea.b0 = (bf16_t*)(R + 0);
      gemm_phase<E_SWIGLU>(H, Wb + W_FF + (size_t)L * WF_SZ + WF_IN, T, 2 * DFF, 1024, ea, smem, 0, bid, nblk, wv);
    PHASE_END
    PHASE_BEGIN(6)
      EArgs ea{}; ea.f0 = X;
      gemm_phase<E_RESID>((const bf16_t*)(R + 0), Wb + W_FF + (size_t)L * WF_SZ + WF_OUT, T, 1024, DFF, ea, smem, 0, bid, nblk, wv);
    PHASE_END
  }
  PHASE_BEGIN(1)
    rmsnorm_rows(X, p.in[9], nullptr, p.out + O_YP, p.out + O_YS, bid, nblk, wv);
  PHASE_END
}

extern "C" void kernel_launch(void* const* d_in, const int* in_sizes, int n_in,
                              void* d_out, int out_size, void* d_ws, size_t ws_size,
                              hipStream_t stream) {
  constexpr int kLds = 128 * 1024 + 64;
  static int grid_blocks = 0;
  if (!grid_blocks) {
    int dev = 0, cus = 0, per_cu = 0;
    (void)hipGetDevice(&dev);
    (void)hipDeviceGetAttribute(&cus, hipDeviceAttributeMultiprocessorCount, dev);
    (void)hipFuncSetAttribute((const void*)mega, hipFuncAttributeMaxDynamicSharedMemorySize, kLds);
    (void)hipOccupancyMaxActiveBlocksPerMultiprocessor(&per_cu, (const void*)mega, NT, kLds);
    if (per_cu < 1) per_cu = 1;
    if (per_cu > 1) per_cu = 1;
    grid_blocks = cus * per_cu;
    fprintf(stderr, "grid %d (cus %d per_cu %d) ws %zu need %zu out %d need %zu\n", grid_blocks, cus, per_cu, ws_size, (size_t)WS_NEED, out_size, (size_t)O_END);
  }
  if (ws_size < WS_NEED || n_in != 31 || (size_t)out_size != O_END) { fprintf(stderr, "kernel_launch: bad sizes\n"); return; }
  Params p;
  memset(&p, 0, sizeof(p));
  for (int i = 0; i < 31; ++i) p.in[i] = (const float*)d_in[i];
  p.out = (float*)d_out; p.ws = (unsigned char*)d_ws;
  bf16_t* Wb = (bf16_t*)((unsigned char*)d_ws + OFF_W);
  int nj = 0, tiles = 0;
  auto add = [&](const float* src, int nsrc, int k, bf16_t* dst, int ndst, int mode) {
    Job& jb = p.jobs[nj++]; jb.src = src; jb.dst = dst; jb.nsrc = nsrc; jb.k = k; jb.ndst = ndst; jb.mode = mode; jb.tile0 = tiles; jb.pad = 0;
    tiles += (ndst / 64) * (k / 64);
  };
  for (int j = 0; j < 2; ++j) {
    bf16_t* Wm = Wb + W_MLA + (size_t)j * WM_SZ;
    add(p.in[10] + (size_t)j * 1024 * 512, 512, 1024, Wm + WM_D, 512, 2);
    add(p.in[13] + (size_t)j * 1024 * 288, 288, 1024, Wb + W_MLA + (size_t)j * WM_SZ + WM_D + (size_t)512 * 1024, 512, 2);
    add(p.in[12] + (size_t)j * 512 * 1536, 1536, 512, Wb + W_MLA + (size_t)j * WM_SZ + WM_UQ, 1536, 0);
    add(p.in[15] + (size_t)j * 256 * 2048, 2048, 256, Wb + W_MLA + (size_t)j * WM_SZ + WM_UKV, 2048, 2);
    add(p.in[16] + (size_t)j * 1024 * 1024, 1024, 1024, Wb + W_MLA + (size_t)j * WM_SZ + WM_O, 1024, 2);
  }
  add(p.in[17], 4096, 1024, Wb + W_CM + WC_IN, 4096, 2);
  add(p.in[22], 1024, 2048, Wb + W_CM + WC_OUT, 1024, 2);
  add(p.in[23], 3072, 1024, Wb + W_DS + WD_P, 3072, 2);
  add(p.in[25], 512, 1024, Wb + W_DS + WD_P + (size_t)3072 * 1024, 512, 2);
  add(p.in[26], 64, 1024, Wb + W_DS + WD_P + (size_t)3584 * 1024, 64, 2);
  add(p.in[28], 8, 1024, Wb + W_DS + WD_P + (size_t)3648 * 1024, 192, 2);
  add(p.in[24], 1024, 1024, Wb + W_DS + WD_O, 1024, 2);
  for (int i = 0; i < 4; ++i) {
    add(p.in[29] + (size_t)i * 1024 * 5632, 5632, 1024, Wb + W_FF + (size_t)i * WF_SZ + WF_IN, 5632, 1);
    add(p.in[30] + (size_t)i * 2816 * 1024, 1024, 2816, Wb + W_FF + (size_t)i * WF_SZ + WF_OUT, 1024, 2);
  }
  p.total_tiles = tiles;
  for (int i = 0; i < 16; ++i) p.inv_freq[i] = pow(10000.0, -(double)i / 16.0);
  p.ph_lo = 0; p.ph_hi = 1000;
  (void)hipMemsetAsync((unsigned char*)d_ws + OFF_BAR, 0, 16384, stream);
  void* args[] = {&p};
  hipError_t e = hipLaunchCooperativeKernel((const void*)mega, dim3(grid_blocks), dim3(NT), args, kLds, stream);
  if (e != hipSuccess) fprintf(stderr, "coop launch failed: %s\n", hipGetErrorString(e));
}
```

```cpp
#include <hip/hip_runtime.h>
#include <hip/hip_cooperative_groups.h>
#include <cstdio>
#include <cstring>
#include <cmath>
namespace cg = cooperative_groups;

typedef unsigned short bf16_t;
using bf16x8 = __attribute__((ext_vector_type(8))) short;
using f32x16 = __attribute__((ext_vector_type(16))) float;
using f32x2v = __attribute__((ext_vector_type(2))) float;
using bf2v = __attribute__((ext_vector_type(2))) __bf16;
#define DI __device__ __forceinline__
#define MFMA32(a, b, c) __builtin_amdgcn_mfma_f32_32x32x16_bf16((a), (b), (c), 0, 0, 0)

constexpr int TP = 16384, TS = 512, T = TP + TS;
constexpr int NT = 512;
constexpr int SPAD = 1088, NKS = 1040;
constexpr int KROWS = TP + 32 * SPAD;
constexpr int DFF = 2816;
constexpr float LOG2E = 1.4426950408889634f;
constexpr float EPS = 1e-6f;

constexpr size_t OFF_X = 0;
constexpr size_t OFF_H = OFF_X + (size_t)T * 1024 * 4;
constexpr size_t OFF_W = OFF_H + (size_t)T * 1024 * 2;
constexpr size_t W_ELEMS = 52822016;
constexpr size_t OFF_ROPE = OFF_W + W_ELEMS * 2;
constexpr size_t OFF_R = OFF_ROPE + (size_t)8192 * 16 * 2 * 4;
constexpr size_t R_RAW = 0;
constexpr size_t R_CQ = R_RAW + (size_t)T * 1024 * 4;
constexpr size_t R_CKV = R_CQ + (size_t)T * 512 * 2;
constexpr size_t R_KR = R_CKV + (size_t)KROWS * 256 * 2;
constexpr size_t R_Q = R_KR + (size_t)KROWS * 32 * 2;
constexpr size_t R_KN = R_Q + (size_t)T * 1536 * 2;
constexpr size_t R_VT = R_KN + (size_t)KROWS * 1024 * 2;
constexpr size_t R_END = R_VT + (size_t)KROWS * 1024 * 2;
constexpr size_t D_Q = 0;
constexpr size_t D_K = D_Q + (size_t)T * 1024 * 2;
constexpr size_t D_VT = D_K + (size_t)KROWS * 1024 * 2;
constexpr size_t D_QI = D_VT + (size_t)KROWS * 1024 * 2;
constexpr size_t D_KIR = D_QI + (size_t)T * 512 * 2;
constexpr size_t D_KI = D_KIR + (size_t)T * 64 * 4;
constexpr size_t D_WI = D_KI + (size_t)KROWS * 64 * 2;
constexpr size_t D_BM = D_WI + (size_t)T * 8 * 4;
constexpr size_t D_AO = D_BM + (size_t)T * 256 * 4;
constexpr size_t D_END = D_AO + (size_t)T * 1024 * 2;
constexpr size_t C_U = 0;
constexpr size_t C_VR = C_U + (size_t)T * 2048 * 2;
constexpr size_t C_VLN = C_VR + (size_t)T * 2048 * 2;
constexpr size_t C_G = C_VLN + (size_t)T * 2048 * 2;
constexpr size_t C_END = C_G + (size_t)T * 2048 * 2;
constexpr size_t OFF_BAR = OFF_R + R_END;
constexpr size_t WS_NEED = OFF_BAR + 16384;
static_assert(D_END <= R_END && C_END <= R_END && (size_t)T * DFF * 2 <= R_END, "region");

constexpr size_t W_MLA = 0;
constexpr size_t WM_D = 0, WM_UQ = 1048576, WM_UKV = WM_UQ + 786432, WM_O = WM_UKV + 524288, WM_SZ = 3407872;
constexpr size_t W_CM = 2 * WM_SZ;
constexpr size_t WC_IN = 0, WC_OUT = 4194304, WC_SZ = 6291456;
constexpr size_t W_DS = W_CM + WC_SZ;
constexpr size_t WD_P = 0, WD_O = 3932160, WD_SZ = 4980736;
constexpr size_t W_FF = W_DS + WD_SZ;
constexpr size_t WF_IN = 0, WF_OUT = 5767168, WF_SZ = 8650752;
constexpr size_t W_TRIL = W_FF + 4 * WF_SZ;
static_assert(W_TRIL + 131072 == W_ELEMS, "w");

constexpr size_t O_YP = 0;
constexpr size_t O_YS = O_YP + (size_t)TP * 1024;
constexpr size_t O_CKVP = O_YS + (size_t)TS * 1024;
constexpr size_t O_KRP = O_CKVP + (size_t)2 * TP * 256;
constexpr size_t O_CKVS = O_KRP + (size_t)2 * TP * 32;
constexpr size_t O_KRS = O_CKVS + (size_t)2 * TS * 256;
constexpr size_t O_CVS = O_KRS + (size_t)2 * TS * 32;
constexpr size_t O_DKP = O_CVS + (size_t)TS * 2048;
constexpr size_t O_DVP = O_DKP + (size_t)TP * 1024;
constexpr size_t O_DIP = O_DVP + (size_t)TP * 1024;
constexpr size_t O_DKS = O_DIP + (size_t)TP * 64;
constexpr size_t O_DVS = O_DKS + (size_t)TS * 1024;
constexpr size_t O_DIS = O_DVS + (size_t)TS * 1024;
constexpr size_t O_END = O_DIS + (size_t)TS * 64;

constexpr int NJOBS = 25;
struct Job { const float* src; bf16_t* dst; int nsrc, k, ndst, mode, tile0, pad; };
struct Params {
  const float* in[31];
  float* out;
  unsigned char* ws;
  Job jobs[NJOBS];
  int total_tiles, ph_lo, ph_hi, pad;
  double inv_freq[16];
};

#define CAS __attribute__((address_space(4)))
typedef const CAS Params CParams;
#define PREF const CAS Params&
DI unsigned pack2(float a, float b) { f32x2v v = {a, b}; bf2v r = __builtin_convertvector(v, bf2v); return __builtin_bit_cast(unsigned, r); }
DI bf16_t tobf(float a) { return (bf16_t)(pack2(a, 0.f) & 0xffffu); }
DI float frombf(bf16_t v) { return __uint_as_float(((unsigned)v) << 16); }
DI float bflo(unsigned u) { return __uint_as_float(u << 16); }
DI float bfhi(unsigned u) { return __uint_as_float(u & 0xffff0000u); }
DI float shflx(float v, int m, int lane) { return __int_as_float(__builtin_amdgcn_ds_bpermute((lane ^ m) << 2, __float_as_int(v))); }
DI float wave_sum(float v, int lane) {
#pragma unroll
  for (int o = 32; o >= 1; o >>= 1) v += shflx(v, o, lane);
  return v;
}
DI int ltid(int wv) { unsigned m1 = ~0u; asm volatile("" : "+s"(m1)); int t = (wv << 6) | (int)__builtin_amdgcn_mbcnt_hi(m1, __builtin_amdgcn_mbcnt_lo(m1, 0u)); asm volatile("" : "+v"(t)); return t; }
DI int crow(int i, int h) { return (i & 3) + 8 * (i >> 2) + 4 * h; }
DI int rowmap(int t) { if (t < TP) return t; int u = t - TP; return TP + (u >> 4) * SPAD + 1024 + (u & 15); }
DI int tokpos(int t) { return t < TP ? (t & 8191) : 1024 + ((t - TP) & 15); }

DI void transpose_tile(const float* __restrict__ src, int src_ld, int ncols, bf16_t* __restrict__ dst, int dst_ld,
                       int n0, int k0, int mode, float* sm, int tid, bool active) {
  const int nl = (tid & 15) * 4, kq = tid >> 4;
  const int n = n0 + nl;
  int c;
  if (mode != 1) c = n < ncols ? n : -1;
  else { int tt = n >> 5, r = n & 31; int f = tt * 16 + (r & 15); c = (r < 16) ? f : DFF + f; }
  int dr[4];
#pragma unroll
  for (int e = 0; e < 4; ++e) { int col = nl + e; dr[e] = (mode == 2) ? ((col & 32) + (col & 1) * 16 + ((col & 31) >> 1)) : col; }
  if (active) {
    float4 v[4];
#pragma unroll
    for (int i = 0; i < 4; ++i) {
      int kk = kq + 16 * i;
      v[i] = (c >= 0) ? *(const float4*)(src + (size_t)(k0 + kk) * src_ld + c) : make_float4(0.f, 0.f, 0.f, 0.f);
    }
#pragma unroll
    for (int i = 0; i < 4; ++i) {
      int kk = kq + 16 * i;
      float* d = sm + kk * 65;
      d[dr[0]] = v[i].x; d[dr[1]] = v[i].y; d[dr[2]] = v[i].z; d[dr[3]] = v[i].w;
    }
  }
  __syncthreads();
  if (active) {
    const int kp = (tid & 31) * 2, nr = tid >> 5;
#pragma unroll 4
    for (int i = 0; i < 8; ++i) {
      int nn = nr + 8 * i;
      float a = sm[kp * 65 + nn], b = sm[(kp + 1) * 65 + nn];
      *(unsigned*)(dst + (size_t)(n0 + nn) * dst_ld + k0 + kp) = pack2(a, b);
    }
  }
  __syncthreads();
}

enum { E_F32 = 0, E_RESID, E_SWIGLU, E_GELU, E_MLAQ, E_MLAKV, E_DSA };
struct EArgs {
  float* f0; float* f1; float* f2; float* f3; float* f4; float* f5; float* f6;
  bf16_t* b0; bf16_t* b1; bf16_t* b2; bf16_t* b3;
  const float* rope;
};
using f32x4v = __attribute__((ext_vector_type(4))) float;
#define LAS __attribute__((address_space(3)))
constexpr int G_HT = 128 * 64;
DI int lds_byte(int r, int c) {
  int st = (r >> 4) * 2 + (c >> 5), rr = r & 15, cc = c & 31, ob = rr * 64 + cc * 2;
  return st * 1024 + (ob ^ (((ob >> 9) & 1) << 5));
}
DI void stage_rc(int b, int& R, int& C) {
  int st = b >> 10, sb = b & 1023, swz = sb ^ (((sb >> 9) & 1) << 5);
  R = (st >> 1) * 16 + (swz >> 6); C = (st & 1) * 32 + ((swz & 63) >> 1);
}

DI float gelu_exact(float x) {
  const float z = fabsf(x) * 0.70710678118654752f;
  const float t = __builtin_amdgcn_rcpf(1.f + 0.3275911f * z);
  float pl = 1.061405429f;
  pl = pl * t - 1.453152027f; pl = pl * t + 1.421413741f; pl = pl * t - 0.284496736f; pl = pl * t + 0.254829592f;
  const float e = pl * t * __builtin_amdgcn_exp2f(-z * z * 1.4426950408889634f);
  const float erfz = 1.f - e;
  const float erfx = x < 0.f ? -erfz : erfz;
  return 0.5f * x * (1.f + erfx);
}
template <int EPI, bool ATOM>
DI void epi16(const EArgs& ea, int row0, int gb, int fr, const f32x4v& v0, const f32x4v& v1) {
  if constexpr (EPI == E_F32) {
#pragma unroll
    for (int j = 0; j < 4; ++j) *(float2*)(ea.f0 + (size_t)(row0 + j) * 1024 + gb + 2 * fr) = make_float2(v0[j], v1[j]);
  } else if constexpr (EPI == E_RESID) {
#pragma unroll
    for (int j = 0; j < 4; ++j) { float* o = ea.f0 + (size_t)(row0 + j) * 1024 + gb + 2 * fr;
      if constexpr (ATOM) { unsafeAtomicAdd(o, v0[j]); unsafeAtomicAdd(o + 1, v1[j]); }
      else { float2 x = *(float2*)o; x.x += v0[j]; x.y += v1[j]; *(float2*)o = x; } }
  } else if constexpr (EPI == E_SWIGLU) {
    const int f = (gb >> 1) + fr;
#pragma unroll
    for (int j = 0; j < 4; ++j) { float g = v0[j], u = v1[j]; ea.b0[(size_t)(row0 + j) * DFF + f] = tobf(g / (1.f + __expf(-g)) * u); }
  } else if constexpr (EPI == E_GELU) {
    bf16_t* dstp = (gb < 2048) ? (ea.b0 + gb + 2 * fr) : (ea.b1 + (gb - 2048) + 2 * fr);
#pragma unroll
    for (int j = 0; j < 4; ++j) {
      float x = v0[j], y = v1[j];
      *(unsigned*)(dstp + (size_t)(row0 + j) * 2048) = pack2(gelu_exact(x), gelu_exact(y));
    }
  } else if constexpr (EPI == E_MLAQ) {
    const float qs = 0.10206207261596577f * LOG2E;
    const bool is_rope = (gb % 96) == 64;
#pragma unroll
    for (int j = 0; j < 4; ++j) {
      const int row = row0 + j;
      float o0 = v0[j], o1 = v1[j];
      if (is_rope) {
        float2 cs = *(const float2*)(ea.rope + ((size_t)tokpos(row) * 16 + fr) * 2);
        o0 = v0[j] * cs.x - v1[j] * cs.y; o1 = v0[j] * cs.y + v1[j] * cs.x;
      }
      bf16_t* o = ea.b0 + (size_t)row * 1536 + gb + fr;
      o[0] = tobf(o0 * qs); o[16] = tobf(o1 * qs);
    }
  } else if constexpr (EPI == E_MLAKV) {
    const int head = gb >> 7, c0 = gb & 127;
    if (c0 < 64) {
#pragma unroll
      for (int j = 0; j < 4; ++j) *(unsigned*)(ea.b0 + (size_t)(row0 + j) * 1024 + head * 64 + c0 + 2 * fr) = pack2(v0[j], v1[j]);
    } else {
      const int d = c0 - 64 + 2 * fr;
      size_t off, dstr;
      if (row0 < TP) { int b = row0 >> 13, s = row0 & 8191; off = ((size_t)((b * 16 + head) * 64 + d)) * 8192 + s; dstr = 8192; }
      else { int u = row0 - TP; int b = u / SPAD, s = u - b * SPAD; off = (size_t)TP * 1024 + ((size_t)((b * 16 + head) * 64 + d)) * SPAD + s; dstr = SPAD; }
      uint2 pk; pk.x = pack2(v0[0], v0[1]); pk.y = pack2(v0[2], v0[3]); *(uint2*)(ea.b1 + off) = pk;
      pk.x = pack2(v1[0], v1[1]); pk.y = pack2(v1[2], v1[3]); *(uint2*)(ea.b1 + off + dstr) = pk;
    }
  } else if constexpr (EPI == E_DSA) {
    if (gb < 1024) {
      const float qs = 0.125f * LOG2E;
#pragma unroll
      for (int j = 0; j < 4; ++j) *(unsigned*)(ea.b0 + (size_t)(row0 + j) * 1024 + gb + 2 * fr) = pack2(v0[j] * qs, v1[j] * qs);
    } else if (gb < 2048) {
      const int c = gb - 1024 + 2 * fr;
#pragma unroll
      for (int j = 0; j < 4; ++j) {
        const int row = row0 + j;
        float* o = (row < TP) ? ea.f0 + (size_t)row * 1024 + c : ea.f1 + (size_t)(row - TP) * 1024 + c;
        *(float2*)o = make_float2(v0[j], v1[j]);
        *(unsigned*)(ea.b1 + (size_t)rowmap(row) * 1024 + c) = pack2(v0[j], v1[j]);
      }
    } else if (gb < 3072) {
      const int c = gb - 2048 + 2 * fr, head = c >> 6, d = c & 63;
#pragma unroll
      for (int j = 0; j < 4; ++j) {
        const int row = row0 + j;
        float* o = (row < TP) ? ea.f2 + (size_t)row * 1024 + c : ea.f3 + (size_t)(row - TP) * 1024 + c;
        *(float2*)o = make_float2(v0[j], v1[j]);
      }
      size_t off, dstr;
      if (row0 < TP) { int b = row0 >> 13, s = row0 & 8191; off = ((size_t)((b * 16 + head) * 64 + d)) * 8192 + s; dstr = 8192; }
      else { int u = row0 - TP; int b = u >> 4, s = 1024 + (u & 15); off = (size_t)TP * 1024 + ((size_t)((b * 16 + head) * 64 + d)) * SPAD + s; dstr = SPAD; }
      uint2 pk; pk.x = pack2(v0[0], v0[1]); pk.y = pack2(v0[2], v0[3]); *(uint2*)(ea.b2 + off) = pk;
      pk.x = pack2(v1[0], v1[1]); pk.y = pack2(v1[2], v1[3]); *(uint2*)(ea.b2 + off + dstr) = pk;
    } else if (gb < 3584) {
      const int c = gb - 3072 + 2 * fr;
#pragma unroll
      for (int j = 0; j < 4; ++j) *(unsigned*)(ea.b3 + (size_t)(row0 + j) * 512 + c) = pack2(v0[j] * 0.125f, v1[j] * 0.125f);
    } else if (gb < 3648) {
      const int c = gb - 3584 + 2 * fr;
#pragma unroll
      for (int j = 0; j < 4; ++j) *(float2*)(ea.f4 + (size_t)(row0 + j) * 64 + c) = make_float2(v0[j], v1[j]);
    } else if (gb == 3648) {
      if (fr < 4) {
#pragma unroll
        for (int j = 0; j < 4; ++j) *(float2*)(ea.f5 + (size_t)(row0 + j) * 8 + 2 * fr) = make_float2(v0[j] * 0.35355339059327379f, v1[j] * 0.35355339059327379f);
      }
    }
  }
}

template <int EPI, bool ATOM>
DI void gemm256_tile(const bf16_t* __restrict__ A, const bf16_t* __restrict__ Bt, const int K, const int kt0, const int nt, const int brow, const int bcol,
                     const EArgs& ea, unsigned char* smem, int wv) {
  bf16_t* shm = (bf16_t*)smem;
  const int tid = ltid(wv);
#define SA(b, h) (shm + ((b) * 2 + (h)) * G_HT)
#define SB(b, h) (shm + (4 + (b) * 2 + (h)) * G_HT)
#define STAGE(P, BASE, br, kt) do { const char* _gb = (const char*)((BASE) + (long)(br) * K + (long)((kt) + kt0) * 64); \
    __builtin_amdgcn_global_load_lds((const unsigned*)(_gb + voff0), (LAS unsigned*)((char*)(P) + tid * 16), 16, 0, 0); \
    __builtin_amdgcn_global_load_lds((const unsigned*)(_gb + voff1), (LAS unsigned*)((char*)(P) + tid * 16 + 8192), 16, 0, 0); } while (0)
#define LDA(dst, b, h) _Pragma("unroll") for (int m = 0; m < 4; ++m) _Pragma("unroll") for (int k = 0; k < 2; ++k) \
    dst[m][k] = *reinterpret_cast<const bf16x8*>((char*)SA(b, h) + lds_byte(wr * 64 + m * 16 + fr, k * 32 + fq * 8))
#define LDB(dst, b, h) _Pragma("unroll") for (int n = 0; n < 2; ++n) _Pragma("unroll") for (int k = 0; k < 2; ++k) \
    dst[n][k] = *reinterpret_cast<const bf16x8*>((char*)SB(b, h) + lds_byte(wc * 32 + n * 16 + fr, k * 32 + fq * 8))
#define MMA(ai, bj, At_, Bt_) do { __builtin_amdgcn_s_setprio(1); \
    _Pragma("unroll") for (int m = 0; m < 4; ++m) _Pragma("unroll") for (int n = 0; n < 2; ++n) _Pragma("unroll") for (int k = 0; k < 2; ++k) \
      acc[ai][bj][m][n] = __builtin_amdgcn_mfma_f32_16x16x32_bf16(At_[m][k], Bt_[n][k], acc[ai][bj][m][n], 0, 0, 0); \
    __builtin_amdgcn_s_setprio(0); } while (0)
#define WAIT_V(n) asm volatile("s_waitcnt vmcnt(" #n ")" ::: "memory")
#define WAIT_L(n) asm volatile("s_waitcnt lgkmcnt(" #n ")" ::: "memory")
#define BAR __builtin_amdgcn_s_barrier()
#define SCHED __builtin_amdgcn_sched_barrier(0)
  const int wid = tid >> 6, lane = tid & 63, wr = wid >> 2, wc = wid & 3, fr = lane & 15, fq = lane >> 4;
  unsigned voff0, voff1;
  { int r_, c_; stage_rc(tid * 16, r_, c_); voff0 = (unsigned)(r_ * K + c_) * 2u; stage_rc(tid * 16 + 8192, r_, c_); voff1 = (unsigned)(r_ * K + c_) * 2u; }
  f32x4v acc[2][2][4][2];
#pragma unroll
  for (int a = 0; a < 2; ++a)
#pragma unroll
    for (int b = 0; b < 2; ++b)
#pragma unroll
      for (int m = 0; m < 4; ++m)
#pragma unroll
        for (int n = 0; n < 2; ++n) acc[a][b][m][n] = (f32x4v){0.f, 0.f, 0.f, 0.f};
  bf16x8 At[4][2], B0[2][2], B1[2][2];
  const int HALF = 128;
  WAIT_V(0); WAIT_L(0); BAR;
  STAGE(SB(0, 0), Bt, bcol, 0); STAGE(SA(0, 0), A, brow, 0);
  STAGE(SB(0, 1), Bt, bcol + HALF, 0); STAGE(SA(0, 1), A, brow + HALF, 0);
  if (wr == 1) BAR;
  WAIT_V(4); BAR;
  STAGE(SB(1, 0), Bt, bcol, 1); STAGE(SA(1, 0), A, brow, 1); STAGE(SB(1, 1), Bt, bcol + HALF, 1);
  WAIT_V(6); BAR;
  for (int t = 0; t < nt - 2; t += 2) {
    LDB(B0, 0, 0); SCHED; LDA(At, 0, 0); STAGE(SA(1, 1), A, brow + HALF, t + 1);
    WAIT_L(8); BAR; WAIT_L(0); MMA(0, 0, At, B0); BAR; SCHED;
    LDB(B1, 0, 1); STAGE(SB(0, 0), Bt, bcol, t + 2);
    BAR; WAIT_L(0); MMA(0, 1, At, B1); BAR;
    LDA(At, 0, 1); STAGE(SA(0, 0), A, brow, t + 2);
    BAR; WAIT_L(0); MMA(1, 0, At, B0); BAR; SCHED;
    STAGE(SB(0, 1), Bt, bcol + HALF, t + 2);
    WAIT_V(6); BAR; MMA(1, 1, At, B1); BAR;
    LDB(B0, 1, 0); SCHED; LDA(At, 1, 0); STAGE(SA(0, 1), A, brow + HALF, t + 2);
    WAIT_L(8); BAR; WAIT_L(0); MMA(0, 0, At, B0); BAR; SCHED;
    LDB(B1, 1, 1); STAGE(SB(1, 0), Bt, bcol, t + 3);
    BAR; WAIT_L(0); MMA(0, 1, At, B1); BAR;
    LDA(At, 1, 1); STAGE(SA(1, 0), A, brow, t + 3);
    BAR; WAIT_L(0); MMA(1, 0, At, B0); BAR; SCHED;
    STAGE(SB(1, 1), Bt, bcol + HALF, t + 3);
    WAIT_V(6); BAR; MMA(1, 1, At, B1); BAR;
  }
  { LDB(B0, 0, 0); LDA(At, 0, 0); STAGE(SA(1, 1), A, brow + HALF, nt - 1);
    BAR; WAIT_L(0); MMA(0, 0, At, B0); BAR;
    LDB(B1, 0, 1); BAR; WAIT_L(0); MMA(0, 1, At, B1); BAR;
    LDA(At, 0, 1); WAIT_V(4); BAR; WAIT_L(0); MMA(1, 0, At, B0); MMA(1, 1, At, B1); BAR; }
  { LDB(B0, 1, 0); LDA(At, 1, 0); WAIT_V(2); BAR; WAIT_L(0); MMA(0, 0, At, B0); BAR;
    LDB(B1, 1, 1); WAIT_V(0); BAR; WAIT_L(0); MMA(0, 1, At, B1); BAR;
    LDA(At, 1, 1); BAR; WAIT_L(0); MMA(1, 0, At, B0); MMA(1, 1, At, B1); BAR; }
  if (wr == 0) BAR;
#pragma unroll
  for (int ai = 0; ai < 2; ++ai)
#pragma unroll
    for (int bj = 0; bj < 2; ++bj)
#pragma unroll
      for (int m = 0; m < 4; ++m)
      { epi16<EPI, ATOM>(ea, brow + ai * 128 + wr * 64 + m * 16 + fq * 4, bcol + bj * 128 + wc * 32, fr, acc[ai][bj][m][0], acc[ai][bj][m][1]); if constexpr (EPI != E_RESID) __builtin_amdgcn_sched_barrier(0); }
#undef SA
#undef SB
#undef STAGE
#undef LDA
#undef LDB
#undef MMA
#undef WAIT_V
#undef WAIT_L
#undef BAR
#undef SCHED
}

DI void tile_map(int t, int nM, int nN, int nwg, int& pm, int& pn) {
  int wgid = t;
  { int q = nwg >> 3, r = nwg & 7, xcd = wgid & 7, off = wgid >> 3; wgid = (xcd < r ? xcd * (q + 1) : r * (q + 1) + (xcd - r) * q) + off; }
  const int nig = 8 * nN, gid = wgid / nig, fm = gid * 8, gsz = min(nM - fm, 8);
  pm = fm + ((wgid % nig) % gsz); pn = (wgid % nig) / gsz;
}
template <int EPI>
DI void gemm_phase(const bf16_t* A, const bf16_t* Bt, int M, int N, int K, const EArgs& ea,
                   unsigned char* smem, int tstart, int bid, int nblk, int wv) {
  const int nM = M >> 8, nN = N >> 8, nwg = nM * nN, nt = K >> 6;
  if constexpr (EPI == E_RESID) {
    const int nfull = (nwg / nblk) * nblk, rem = nwg - nfull;
    for (int t = bid; t < nfull; t += nblk) {
      int pm, pn; tile_map(t, nM, nN, nwg, pm, pn);
      gemm256_tile<EPI, false>(A, Bt, K, 0, nt, pm * 256, pn * 256, ea, smem, wv);
    }
    if (rem > 0) {
      int ns = nblk / rem; if (ns > (nt >> 3)) ns = nt >> 3; if (ns < 1) ns = 1;
      const int per = ((nt / ns) >> 1) << 1;
      for (int u = bid; u < rem * ns; u += nblk) {
        const int t = nfull + u / ns, ks = u % ns;
        const int k0 = ks * per, kn = (ks == ns - 1) ? (nt - k0) : per;
        int pm, pn; tile_map(t, nM, nN, nwg, pm, pn);
        gemm256_tile<EPI, true>(A, Bt, K, k0, kn, pm * 256, pn * 256, ea, smem, wv);
      }
    }
  } else {
    int t0 = bid - (tstart % nblk); if (t0 < 0) t0 += nblk;
    for (int t = t0; t < nwg; t += nblk) {
      int pm, pn; tile_map(t, nM, nN, nwg, pm, pn);
      gemm256_tile<EPI, false>(A, Bt, K, 0, nt, pm * 256, pn * 256, ea, smem, wv);
    }
  }
}

DI void rmsnorm_rows(const float* __restrict__ X, const float* __restrict__ g, bf16_t* __restrict__ H, float* outp, float* outs,
                     int bid, int nblk, int wv) {
  const int lane = ltid(wv) & 63, w = ltid(wv) >> 6;
  for (int row = bid * 8 + w; row < T; row += nblk * 8) {
    const float* xr = X + (size_t)row * 1024;
    float4 v[4];
    float ss = 0.f;
#pragma unroll
    for (int c = 0; c < 4; ++c) { v[c] = *(const float4*)(xr + c * 256 + lane * 4); ss += v[c].x * v[c].x + v[c].y * v[c].y + v[c].z * v[c].z + v[c].w * v[c].w; }
    ss = wave_sum(ss, lane);
    float r = rsqrtf(ss * (1.f / 1024.f) + EPS);
#pragma unroll
    for (int c = 0; c < 4; ++c) {
      int col = c * 256 + lane * 4;
      float4 gg = *(const float4*)(g + col);
      float a = v[c].x * r * gg.x, b = v[c].y * r * gg.y, cc = v[c].z * r * gg.z, d = v[c].w * r * gg.w;
      if (H) { uint2 pk; pk.x = pack2(a, b); pk.y = pack2(cc, d); *(uint2*)(H + (size_t)row * 1024 + col) = pk; }
      else {
        float* o = (row < TP) ? outp + (size_t)row * 1024 + col : outs + (size_t)(row - TP) * 1024 + col;
        *(float4*)o = make_float4(a, b, cc, d);
      }
    }
  }
}

DI void mla_rowops(PREF p, int j, int bid, int nblk, int wv) {
  const int lane = ltid(wv) & 63, w = ltid(wv) >> 6;
  unsigned char* R = p.ws + OFF_R;
  const float* RAW = (const float*)(R + R_RAW);
  bf16_t* CQ = (bf16_t*)(R + R_CQ); bf16_t* CKV = (bf16_t*)(R + R_CKV); bf16_t* KR = (bf16_t*)(R + R_KR);
  const float* gq = p.in[11] + j * 512; const float* gkv = p.in[14] + j * 256;
  const float* rope = (const float*)(p.ws + OFF_ROPE);
  for (int row = bid * 8 + w; row < T; row += nblk * 8) {
    const float* rr = RAW + (size_t)row * 1024;
    float4 a0 = *(const float4*)(rr + lane * 4), a1 = *(const float4*)(rr + 256 + lane * 4);
    float4 c0 = *(const float4*)(rr + 512 + lane * 4);
    float ss = a0.x * a0.x + a0.y * a0.y + a0.z * a0.z + a0.w * a0.w + a1.x * a1.x + a1.y * a1.y + a1.z * a1.z + a1.w * a1.w;
    float s2 = c0.x * c0.x + c0.y * c0.y + c0.z * c0.z + c0.w * c0.w;
    ss = wave_sum(ss, lane); s2 = wave_sum(s2, lane);
    float r1 = rsqrtf(ss * (1.f / 512.f) + EPS), r2 = rsqrtf(s2 * (1.f / 256.f) + EPS);
    {
      float4 g0 = *(const float4*)(gq + lane * 4), g1 = *(const float4*)(gq + 256 + lane * 4);
      uint2 pk; pk.x = pack2(a0.x * r1 * g0.x, a0.y * r1 * g0.y); pk.y = pack2(a0.z * r1 * g0.z, a0.w * r1 * g0.w);
      *(uint2*)(CQ + (size_t)row * 512 + lane * 4) = pk;
      pk.x = pack2(a1.x * r1 * g1.x, a1.y * r1 * g1.y); pk.y = pack2(a1.z * r1 * g1.z, a1.w * r1 * g1.w);
      *(uint2*)(CQ + (size_t)row * 512 + 256 + lane * 4) = pk;
    }
    const int rm = rowmap(row);
    {
      float4 g = *(const float4*)(gkv + lane * 4);
      float4 o = make_float4(c0.x * r2 * g.x, c0.y * r2 * g.y, c0.z * r2 * g.z, c0.w * r2 * g.w);
      float* op = (row < TP) ? p.out + O_CKVP + ((size_t)j * TP + row) * 256 : p.out + O_CKVS + ((size_t)j * TS + (row - TP)) * 256;
      *(float4*)(op + lane * 4) = o;
      uint2 pk; pk.x = pack2(o.x, o.y); pk.y = pack2(o.z, o.w);
      *(uint2*)(CKV + (size_t)rm * 256 + lane * 4) = pk;
    }
    if (lane < 16) {
      float x1 = rr[768 + lane], x2 = rr[784 + lane];
      int pos = tokpos(row);
      float2 cs = *(const float2*)(rope + ((size_t)pos * 16 + lane) * 2);
      float o1 = x1 * cs.x - x2 * cs.y, o2 = x1 * cs.y + x2 * cs.x;
      float* op = (row < TP) ? p.out + O_KRP + ((size_t)j * TP + row) * 32 : p.out + O_KRS + ((size_t)j * TS + (row - TP)) * 32;
      op[lane] = o1; op[16 + lane] = o2;
      KR[(size_t)rm * 32 + lane] = tobf(o1); KR[(size_t)rm * 32 + 16 + lane] = tobf(o2);
    }
  }
}

DI void dsa_rowops(PREF p, int bid, int nblk, int wv) {
  const int lane = ltid(wv) & 63, w = ltid(wv) >> 6;
  unsigned char* R = p.ws + OFF_R;
  const float* KIR = (const float*)(R + D_KIR);
  bf16_t* KI = (bf16_t*)(R + D_KI);
  const float* g = p.in[27];
  for (int row = bid * 8 + w; row < T; row += nblk * 8) {
    float v = KIR[(size_t)row * 64 + lane];
    float ss = wave_sum(v * v, lane);
    float r = rsqrtf(ss * (1.f / 64.f) + EPS);
    float o = v * r * g[lane];
    if (row < TP) p.out[O_DIP + (size_t)row * 64 + lane] = o; else p.out[O_DIS + (size_t)(row - TP) * 64 + lane] = o;
    KI[(size_t)rowmap(row) * 64 + lane] = tobf(o);
  }
}

DI void cmlp_ln_rows(PREF p, int bid, int nblk, int wv) {
  const int lane = ltid(wv) & 63, w = ltid(wv) >> 6;
  unsigned char* R = p.ws + OFF_R;
  const bf16_t* VR = (const bf16_t*)(R + C_VR);
  bf16_t* VLN = (bf16_t*)(R + C_VLN);
  const float* g = p.in[18]; const float* bb = p.in[19];
  for (int row = bid * 8 + w; row < T; row += nblk * 8) {
    float x[32];
    float sum = 0.f;
#pragma unroll
    for (int c = 0; c < 4; ++c) {
      uint4 u = *(const uint4*)(VR + (size_t)row * 2048 + c * 512 + lane * 8);
      x[c * 8 + 0] = bflo(u.x); x[c * 8 + 1] = bfhi(u.x); x[c * 8 + 2] = bflo(u.y); x[c * 8 + 3] = bfhi(u.y);
      x[c * 8 + 4] = bflo(u.z); x[c * 8 + 5] = bfhi(u.z); x[c * 8 + 6] = bflo(u.w); x[c * 8 + 7] = bfhi(u.w);
    }
#pragma unroll
    for (int i = 0; i < 32; ++i) sum += x[i];
    sum = wave_sum(sum, lane);
    float mu = sum * (1.f / 2048.f);
    float vs = 0.f;
#pragma unroll
    for (int i = 0; i < 32; ++i) { x[i] -= mu; vs += x[i] * x[i]; }
    vs = wave_sum(vs, lane);
    float r = rsqrtf(vs * (1.f / 2048.f) + EPS);
#pragma unroll
    for (int c = 0; c < 4; ++c) {
      int col = c * 512 + lane * 8;
      float y[8];
#pragma unroll
      for (int q = 0; q < 2; ++q) {
        float4 gg = *(const float4*)(g + col + q * 4), b4 = *(const float4*)(bb + col + q * 4);
        y[q * 4 + 0] = x[c * 8 + q * 4 + 0] * r * gg.x + b4.x; y[q * 4 + 1] = x[c * 8 + q * 4 + 1] * r * gg.y + b4.y;
        y[q * 4 + 2] = x[c * 8 + q * 4 + 2] * r * gg.z + b4.z; y[q * 4 + 3] = x[c * 8 + q * 4 + 3] * r * gg.w + b4.w;
      }
      uint4 pk; pk.x = pack2(y[0], y[1]); pk.y = pack2(y[2], y[3]); pk.z = pack2(y[4], y[5]); pk.w = pack2(y[6], y[7]);
      *(uint4*)(VLN + (size_t)row * 2048 + col) = pk;
      if (row >= TP) {
        float* o = p.out + O_CVS + (size_t)(row - TP) * 2048 + col;
        *(float4*)o = make_float4(y[0], y[1], y[2], y[3]); *(float4*)(o + 4) = make_float4(y[4], y[5], y[6], y[7]);
      }
    }
  }
}

DI void cmlp_mix_phase(PREF p, unsigned char* smem, int bid, int nblk, int wv) {
  const int tid = ltid(wv), lane = tid & 63, w = tid >> 6, wm = w >> 2, wn = w & 3, lr = lane & 31, lh = lane >> 5;
  unsigned char* R = p.ws + OFF_R;
  const bf16_t* U = (const bf16_t*)(R + C_U);
  const bf16_t* VLN = (const bf16_t*)(R + C_VLN);
  bf16_t* G = (bf16_t*)(R + C_G);
  const bf16_t* WT = (const bf16_t*)(p.ws + OFF_W) + W_TRIL;
  const float* bs = p.in[21];
  bf16_t* As = (bf16_t*)smem;
  bf16_t* Bs = As + 128 * 136;
  for (int u = bid; u < 1024; u += nblk) {
    const int g = u & 7, ch = u >> 3;
    const int col0 = g * 256;
#pragma unroll 2
    for (int i = 0; i < 4; ++i) {
      int v = tid + i * NT; int r = v >> 4, c = (v & 15) * 8;
      *(uint4*)(As + r * 136 + c) = *(const uint4*)(WT + ((size_t)g * 128 + r) * 128 + c);
    }
#pragma unroll 2
    for (int i = 0; i < 8; ++i) {
      int v = tid + i * NT; int s = v >> 5, c = (v & 31) * 8;
      uint4 x = *(const uint4*)(VLN + ((size_t)ch * 128 + s) * 2048 + col0 + c);
      Bs[(c + 0) * 136 + s] = (bf16_t)(x.x & 0xffff); Bs[(c + 1) * 136 + s] = (bf16_t)(x.x >> 16);
      Bs[(c + 2) * 136 + s] = (bf16_t)(x.y & 0xffff); Bs[(c + 3) * 136 + s] = (bf16_t)(x.y >> 16);
      Bs[(c + 4) * 136 + s] = (bf16_t)(x.z & 0xffff); Bs[(c + 5) * 136 + s] = (bf16_t)(x.z >> 16);
      Bs[(c + 6) * 136 + s] = (bf16_t)(x.w & 0xffff); Bs[(c + 7) * 136 + s] = (bf16_t)(x.w >> 16);
    }
    __syncthreads();
    f32x16 acc[2][2];
#pragma unroll
    for (int a = 0; a < 2; ++a)
#pragma unroll
      for (int b = 0; b < 2; ++b)
#pragma unroll
        for (int i = 0; i < 16; ++i) acc[a][b][i] = 0.f;
    const bf16_t* Asb = As + (wm * 64 + lr) * 136 + lh * 8;
    const bf16_t* Bsb = Bs + (wn * 64 + lr) * 136 + lh * 8;
    const int ns = (wm + 1) * 4;
    for (int s = 0; s < ns; ++s) {
      bf16x8 a0 = *(const bf16x8*)(Asb + s * 16);
      bf16x8 a1 = *(const bf16x8*)(Asb + 32 * 136 + s * 16);
      bf16x8 b0 = *(const bf16x8*)(Bsb + s * 16);
      bf16x8 b1 = *(const bf16x8*)(Bsb + 32 * 136 + s * 16);
      acc[0][0] = MFMA32(a0, b0, acc[0][0]);
      acc[0][1] = MFMA32(a0, b1, acc[0][1]);
      acc[1][0] = MFMA32(a1, b0, acc[1][0]);
      acc[1][1] = MFMA32(a1, b1, acc[1][1]);
    }
#pragma unroll
    for (int mi = 0; mi < 2; ++mi)
#pragma unroll
      for (int ni = 0; ni < 2; ++ni)
#pragma unroll
        for (int i = 0; i < 16; ++i) {
          int t = wm * 64 + mi * 32 + crow(i, lh);
          int col = col0 + wn * 64 + ni * 32 + lr;
          size_t off = ((size_t)ch * 128 + t) * 2048 + col;
          float mixed = acc[mi][ni][i] + bs[g * 128 + t];
          G[off] = tobf(frombf(U[off]) * mixed);
        }
    __syncthreads();
  }
  const float* wsf = p.in[20];
  for (int e = bid * NT + tid; e < TS * 2048; e += nblk * NT) {
    int row = e >> 11, col = e & 2047, b = row >> 4, t = row & 15, g = col >> 8;
    float a = bs[g * 128 + t];
    for (int s = 0; s <= t; ++s) a += wsf[((size_t)g * 128 + t) * 128 + s] * frombf(VLN[((size_t)TP + b * 16 + s) * 2048 + col]);
    size_t off = ((size_t)TP + row) * 2048 + col;
    G[off] = tobf(frombf(U[off]) * a);
  }
}

template <int DQK, bool IS_MLA, bool MASKED>
DI void attn8_unit(const bf16_t* __restrict__ Qp, int ldq, int nq,
                   const bf16_t* __restrict__ Kp, int ldk, const bf16_t* __restrict__ KRp,
                   const bf16_t* __restrict__ Vtp, int ldv, int kmax,
                   int nit, int nk64_w, int nkeys, const unsigned* __restrict__ BMp,
                   bf16_t* __restrict__ AOp, unsigned char* smem, int wv) {
  constexpr int KS = DQK + 8;
  constexpr int VS = 136;
  constexpr int NQS = DQK / 16;
  const int tid = ltid(wv), lane = tid & 63, w = tid >> 6, lr = lane & 31, lh = lane >> 5;
  bf16_t* Ks = (bf16_t*)smem;
  bf16_t* Vs = Ks + 2 * 128 * KS;
  const bool q_ok = (w * 32 + lr) < nq;
  const int qrow = q_ok ? (w * 32 + lr) : 0;
  bf16x8 qf[NQS];
#pragma unroll
  for (int s = 0; s < NQS; ++s) qf[s] = *(const bf16x8*)(Qp + (size_t)qrow * ldq + s * 16 + lh * 8);
  f32x16 oacc[2];
#pragma unroll
  for (int d = 0; d < 2; ++d)
#pragma unroll
    for (int i = 0; i < 16; ++i) oacc[d][i] = 0.f;
  float m_run = -INFINITY, l_run = 0.f;
  const int kkey = tid >> 3, kc = (tid & 7) * 8;
  const int rkey = tid >> 2, rc = (tid & 3) * 8;
  const int vd = tid >> 4, vk = (tid & 15) * 8;
  const int vpos = (vk & 96) + ((vk >> 4) & 1) * 16 + ((vk >> 3) & 1) * 4;
  uint4 rk0, rk1, rr, rv0, rv1;
  rr = make_uint4(0, 0, 0, 0);
  uint4 bm_next = make_uint4(0xffffffffu, 0xffffffffu, 0xffffffffu, 0xffffffffu), bm_cur = bm_next;
#define GLOAD(it_) do { const int key0_ = (it_) * 128; \
    { int kr_ = min(key0_ + kkey, kmax - 1); rk0 = *(const uint4*)(Kp + (size_t)kr_ * ldk + kc); } \
    { int kr_ = min(key0_ + kkey + 64, kmax - 1); rk1 = *(const uint4*)(Kp + (size_t)kr_ * ldk + kc); } \
    if constexpr (IS_MLA) { int kr_ = min(key0_ + rkey, kmax - 1); rr = *(const uint4*)(KRp + (size_t)kr_ * 32 + rc); } \
    { int kv_ = min(key0_ + vk, kmax - 8); rv0 = *(const uint4*)(Vtp + (size_t)vd * ldv + kv_); rv1 = *(const uint4*)(Vtp + (size_t)(vd + 32) * ldv + kv_); } \
    if constexpr (MASKED) { if (BMp) bm_next = *(const uint4*)(BMp + (size_t)qrow * 256 + (it_) * 4); } } while (0)
#define SSTORE(buf_) do { bf16_t* Kb_ = Ks + (buf_) * 128 * KS; bf16_t* Vb_ = Vs + (buf_) * 64 * VS; \
    *(uint4*)(Kb_ + kkey * KS + kc) = rk0; *(uint4*)(Kb_ + (kkey + 64) * KS + kc) = rk1; \
    if constexpr (IS_MLA) *(uint4*)(Kb_ + rkey * KS + 64 + rc) = rr; \
    *(uint2*)(Vb_ + vd * VS + vpos) = make_uint2(rv0.x, rv0.y); *(uint2*)(Vb_ + vd * VS + vpos + 8) = make_uint2(rv0.z, rv0.w); \
    *(uint2*)(Vb_ + (vd + 32) * VS + vpos) = make_uint2(rv1.x, rv1.y); *(uint2*)(Vb_ + (vd + 32) * VS + vpos + 8) = make_uint2(rv1.z, rv1.w); } while (0)
  const int nit_w = (nk64_w + 1) >> 1;
  __syncthreads();
  GLOAD(0); SSTORE(0); bm_cur = bm_next;
  __syncthreads();
  for (int it = 0; it < nit; ++it) {
    const int buf = it & 1;
    if (it + 1 < nit) GLOAD(it + 1);
    if (it < nit_w) {
      const bf16_t* Kb = Ks + buf * 128 * KS; const bf16_t* Vb = Vs + buf * 64 * VS;
      f32x16 sacc[4];
#pragma unroll
      for (int t4 = 0; t4 < 4; ++t4) {
#pragma unroll
        for (int i = 0; i < 16; ++i) sacc[t4][i] = 0.f;
#pragma unroll
        for (int s = 0; s < NQS; ++s) {
          bf16x8 kf = *(const bf16x8*)(Kb + (t4 * 32 + lr) * KS + s * 16 + lh * 8);
          sacc[t4] = MFMA32(kf, qf[s], sacc[t4]);
        }
      }
      if ((2 * it + 1) >= nk64_w) {
#pragma unroll
        for (int t4 = 2; t4 < 4; ++t4)
#pragma unroll
          for (int i = 0; i < 16; ++i) sacc[t4][i] = -INFINITY;
      }
      float mx = -INFINITY;
#pragma unroll
      for (int t4 = 0; t4 < 4; ++t4) {
        const unsigned wbits = (t4 == 0) ? bm_cur.x : (t4 == 1) ? bm_cur.y : (t4 == 2) ? bm_cur.z : bm_cur.w;
#pragma unroll
        for (int i = 0; i < 16; ++i) {
          if constexpr (MASKED) {
            const int kin = crow(i, lh);
            const int key = it * 128 + t4 * 32 + kin;
            bool ok = (key < nkeys) && ((wbits >> kin) & 1u);
            sacc[t4][i] = ok ? sacc[t4][i] : -INFINITY;
          }
          mx = fmaxf(mx, sacc[t4][i]);
        }
      }
      mx = fmaxf(mx, shflx(mx, 32, lane));
      const float m_new = fmaxf(m_run, mx);
      const float m_safe = (m_new == -INFINITY) ? 0.f : m_new;
      const float alpha = __builtin_amdgcn_exp2f(m_run - m_safe);
      m_run = m_new;
      float ls = 0.f;
#pragma unroll
      for (int t4 = 0; t4 < 4; ++t4)
#pragma unroll
        for (int i = 0; i < 16; ++i) { float pv = __builtin_amdgcn_exp2f(sacc[t4][i] - m_safe); sacc[t4][i] = pv; ls += pv; }
      l_run = l_run * alpha + ls;
#pragma unroll
      for (int d = 0; d < 2; ++d)
#pragma unroll
        for (int i = 0; i < 16; ++i) oacc[d][i] *= alpha;
#pragma unroll
      for (int t4 = 0; t4 < 4; ++t4)
#pragma unroll
        for (int s = 0; s < 2; ++s) {
          uint4 pp;
          pp.x = pack2(sacc[t4][8 * s + 0], sacc[t4][8 * s + 1]);
          pp.y = pack2(sacc[t4][8 * s + 2], sacc[t4][8 * s + 3]);
          pp.z = pack2(sacc[t4][8 * s + 4], sacc[t4][8 * s + 5]);
          pp.w = pack2(sacc[t4][8 * s + 6], sacc[t4][8 * s + 7]);
          bf16x8 pf = __builtin_bit_cast(bf16x8, pp);
#pragma unroll
          for (int dt = 0; dt < 2; ++dt) {
            bf16x8 vf = *(const bf16x8*)(Vb + (dt * 32 + lr) * VS + t4 * 32 + 16 * s + 8 * lh);
            oacc[dt] = MFMA32(vf, pf, oacc[dt]);
          }
        }
    }
    if (it + 1 < nit) { SSTORE(buf ^ 1); bm_cur = bm_next; }
    __syncthreads();
  }
  if (nit_w > 0) {
    float lt = l_run + shflx(l_run, 32, lane);
    float inv = lt > 0.f ? 1.f / lt : 0.f;
    if (q_ok) {
      bf16_t* orow = AOp + (size_t)(w * 32 + lr) * 1024;
#pragma unroll
      for (int dt = 0; dt < 2; ++dt)
#pragma unroll
        for (int g = 0; g < 4; ++g) {
          uint2 pk;
          pk.x = pack2(oacc[dt][4 * g] * inv, oacc[dt][4 * g + 1] * inv);
          pk.y = pack2(oacc[dt][4 * g + 2] * inv, oacc[dt][4 * g + 3] * inv);
          *(uint2*)(orow + dt * 32 + 8 * g + 4 * lh) = pk;
        }
    }
  }
}
#undef GLOAD
#undef SSTORE

DI int snake_idx(int i, int bid, int nblk) { return i * nblk + ((i & 1) ? (nblk - 1 - bid) : bid); }

template <bool IS_MLA>
DI void attn_phase(PREF p, unsigned char* smem, int bid, int nblk, int wv) {
  unsigned char* R = p.ws + OFF_R;
  const int w = ltid(wv) >> 6;
  const int total = 1024 + 512;
  for (int i = 0; i * nblk < total; ++i) {
    int u = snake_idx(i, bid, nblk);
    if (u >= total) continue;
    if constexpr (IS_MLA) {
      const bf16_t* Q = (const bf16_t*)(R + R_Q); const bf16_t* KN = (const bf16_t*)(R + R_KN);
      const bf16_t* KR = (const bf16_t*)(R + R_KR); const bf16_t* VT = (const bf16_t*)(R + R_VT);
      bf16_t* AO = (bf16_t*)(R + R_RAW);
      if (u < 1024) {
        int qt = 31 - (u >> 5), bh = u & 31, b = bh >> 4, h = bh & 15;
        int q0 = b * 8192 + qt * 256;
        attn8_unit<96, true, false>(Q + (size_t)q0 * 1536 + h * 96, 1536, 256,
                                    KN + (size_t)(b * 8192) * 1024 + h * 64, 1024, KR + (size_t)(b * 8192) * 32,
                                    VT + (size_t)((b * 16 + h) * 64) * 8192, 8192, 8192,
                                    2 * qt + 2, 4 * qt + 1 + (w >> 1), 1 << 30, nullptr,
                                    AO + (size_t)q0 * 1024 + h * 64, smem, wv);
      } else {
        int v = u - 1024, b = v >> 4, h = v & 15;
        int q0 = TP + b * 16;
        attn8_unit<96, true, true>(Q + (size_t)q0 * 1536 + h * 96, 1536, 16,
                                   KN + (size_t)(TP + b * SPAD) * 1024 + h * 64, 1024, KR + (size_t)(TP + b * SPAD) * 32,
                                   VT + (size_t)TP * 1024 + (size_t)((b * 16 + h) * 64) * SPAD, SPAD, SPAD,
                                   9, (w == 0) ? 17 : 0, NKS, nullptr,
                                   AO + (size_t)q0 * 1024 + h * 64, smem, wv);
      }
    } else {
      const bf16_t* Q = (const bf16_t*)(R + D_Q); const bf16_t* KK = (const bf16_t*)(R + D_K);
      const bf16_t* VT = (const bf16_t*)(R + D_VT); const unsigned* BM = (const unsigned*)(R + D_BM);
      bf16_t* AO = (bf16_t*)(R + D_AO);
      if (u < 1024) {
        int qt = 31 - (u >> 5), bh = u & 31, b = bh >> 4, h = bh & 15;
        int q0 = b * 8192 + qt * 256;
        attn8_unit<64, false, true>(Q + (size_t)q0 * 1024 + h * 64, 1024, 256,
                                    KK + (size_t)(b * 8192) * 1024 + h * 64, 1024, nullptr,
                                    VT + (size_t)((b * 16 + h) * 64) * 8192, 8192, 8192,
                                    2 * qt + 2, 4 * qt + 1 + (w >> 1), 1 << 30, BM + (size_t)q0 * 256,
                                    AO + (size_t)q0 * 1024 + h * 64, smem, wv);
      } else {
        int v = u - 1024, b = v >> 4, h = v & 15;
        int q0 = TP + b * 16;
        attn8_unit<64, false, true>(Q + (size_t)q0 * 1024 + h * 64, 1024, 16,
                                    KK + (size_t)(TP + b * SPAD) * 1024 + h * 64, 1024, nullptr,
                                    VT + (size_t)TP * 1024 + (size_t)((b * 16 + h) * 64) * SPAD, SPAD, SPAD,
                                    9, (w == 0) ? 17 : 0, NKS, BM + (size_t)q0 * 256,
                                    AO + (size_t)q0 * 1024 + h * 64, smem, wv);
      }
    }
  }
}

constexpr int CAP = 128;
DI int score_bin(float s) {
  unsigned u = __float_as_uint(s);
  int e = (int)((u & 0x7fffffffu) >> 19);
  int m = min(max(e, 1840), 2095) - 1840;
  return (u >> 31) ? (255 - m) : (256 + m);
}

DI void idx_unit(const bf16_t* __restrict__ QI, const float* __restrict__ WI, int q_row0, int nq,
                 const bf16_t* __restrict__ KI, int L, unsigned* __restrict__ BM, unsigned char* smem, int wv) {
  const int tid = ltid(wv), lane = tid & 63, w = tid >> 6, lr = lane & 31, lh = lane >> 5;
  bf16_t* Qs = (bf16_t*)smem;
  float* Ws = (float*)(smem + 36864);
  unsigned* hist = (unsigned*)(smem + 36864 + 1024);
  float* cand_s = (float*)hist;
  int* cand_i = (int*)(smem + 36864 + 1024 + 16384);
  int* bstar = (int*)(smem + 36864 + 1024 + 32768);
  int* need = bstar + 32;
  int* ncand = need + 32;
  __syncthreads();
#pragma unroll
  for (int i = 0; i < 4; ++i) {
    int v = tid + i * NT;
    int hd = v >> 8, q = (v >> 3) & 31, c = (v & 7) * 8;
    int qq = q < nq ? q : 0;
    *(uint4*)(Qs + (hd * 32 + q) * 72 + c) = *(const uint4*)(QI + (size_t)(q_row0 + qq) * 512 + hd * 64 + c);
  }
  if (tid < 256) { int hd = tid >> 5, q = tid & 31; int qq = q < nq ? q : 0; Ws[hd * 32 + q] = WI[(size_t)(q_row0 + qq) * 8 + hd]; }
  for (int i = tid; i < 32 * 256; i += NT) hist[i] = 0u;
  if (tid < 32) { bstar[tid] = -1; need[tid] = 0; ncand[tid] = 0; }
  __syncthreads();
  const int ntile = (L + 255) >> 8;
  const bool do_select = L > 256;
  int bsr[16];
  { int m1_ = -1; asm volatile("" : "+v"(m1_));
#pragma unroll
    for (int i = 0; i < 16; ++i) bsr[i] = m1_; }
  for (int pass = do_select ? 0 : 1; pass < 2; ++pass) {
    if (pass == 1) {
#pragma unroll
      for (int i = 0; i < 16; ++i) bsr[i] = bstar[crow(i, lh)];
    }
    bf16x8 kn0, kn1, kn2, kn3;
    { const bf16_t* kp = KI + (size_t)(w * 32 + lr) * 64 + lh * 8;
      kn0 = *(const bf16x8*)(kp); kn1 = *(const bf16x8*)(kp + 16); kn2 = *(const bf16x8*)(kp + 32); kn3 = *(const bf16x8*)(kp + 48); }
    for (int kt = 0; kt < ntile; ++kt) {
      const int key0 = kt * 256 + w * 32;
      bf16x8 kf[4];
      kf[0] = kn0; kf[1] = kn1; kf[2] = kn2; kf[3] = kn3;
      if (key0 + 256 < L) {
        const bf16_t* kp = KI + (size_t)(key0 + 256 + lr) * 64 + lh * 8;
        kn0 = *(const bf16x8*)(kp); kn1 = *(const bf16x8*)(kp + 16); kn2 = *(const bf16x8*)(kp + 32); kn3 = *(const bf16x8*)(kp + 48);
      }
      if (key0 < L) {
        const int key = key0 + lr;
        float sc[16];
#pragma unroll
        for (int i = 0; i < 16; ++i) sc[i] = 0.f;
#pragma unroll 1
        for (int hd = 0; hd < 8; ++hd) {
          f32x16 acc;
#pragma unroll
          for (int i = 0; i < 16; ++i) acc[i] = 0.f;
#pragma unroll
          for (int s = 0; s < 4; ++s) {
            bf16x8 qf = *(const bf16x8*)(Qs + (hd * 32 + lr) * 72 + s * 16 + lh * 8);
            acc = MFMA32(qf, kf[s], acc);
          }
#pragma unroll
          for (int g = 0; g < 4; ++g) {
            float4 wv = *(const float4*)(Ws + hd * 32 + 8 * g + 4 * lh);
            sc[4 * g + 0] += wv.x * fmaxf(acc[4 * g + 0], 0.f);
            sc[4 * g + 1] += wv.y * fmaxf(acc[4 * g + 1], 0.f);
            sc[4 * g + 2] += wv.z * fmaxf(acc[4 * g + 2], 0.f);
            sc[4 * g + 3] += wv.w * fmaxf(acc[4 * g + 3], 0.f);
          }
        }
        const bool kvalid = key < L;
        if (pass == 0) {
#pragma unroll
          for (int i = 0; i < 16; ++i) {
            int q = crow(i, lh);
            if (kvalid) { int b = score_bin(sc[i]); atomicAdd(&hist[q * 256 + (b >> 1)], (b & 1) ? 65536u : 1u); }
          }
        } else {
          unsigned myword = 0u, cmask = 0u;
          unsigned long long any = 0ull;
#pragma unroll
          for (int i = 0; i < 16; ++i) {
            const int b = score_bin(sc[i]);
            const int bs = bsr[i];
            const bool sel = kvalid && (b > bs);
            const bool cnd = kvalid && (b == bs);
            const unsigned long long bal = __ballot(sel);
            myword = (lr == i) ? (unsigned)(bal >> (32 * lh)) : myword;
            any |= __ballot(cnd);
            cmask |= cnd ? (1u << i) : 0u;
          }
          if (lr < 16 && crow(lr, lh) < nq) BM[(size_t)(q_row0 + crow(lr, lh)) * 256 + (key0 >> 5)] = myword;
          if (any != 0ull) {
            int base[16];
#pragma unroll
            for (int i = 0; i < 16; ++i) {
              const unsigned long long cbi = __ballot((cmask >> i) & 1u);
              base[i] = 0;
              if (lr == 0) base[i] = atomicAdd(&ncand[crow(i, lh)], __popc((unsigned)(cbi >> (32 * lh))));
            }
#pragma unroll
            for (int i = 0; i < 16; ++i) {
              const unsigned long long cbi = __ballot((cmask >> i) & 1u);
              const int bb = __builtin_amdgcn_ds_bpermute((lane & 32) << 2, base[i]);
              if ((cmask >> i) & 1u) {
                const unsigned hm = (unsigned)(cbi >> (32 * lh));
                const int pos = bb + __popc(hm & ((1u << lr) - 1u));
                const int q = crow(i, lh);
                if (pos < CAP) { cand_s[q * CAP + pos] = sc[i]; cand_i[q * CAP + pos] = key; }
              }
            }
          }
        }
      }
    }
    __syncthreads();
    if (pass == 0) {
      for (int qi = 0; qi < 4; ++qi) {
        const int q = w * 4 + qi;
        unsigned hw[4];
#pragma unroll
        for (int k = 0; k < 4; ++k) hw[k] = hist[q * 256 + 255 - 4 * lane - k];
        int cnt = 0;
#pragma unroll
        for (int k = 0; k < 4; ++k) cnt += (int)(hw[k] >> 16) + (int)(hw[k] & 0xffffu);
        int pre = cnt;
#pragma unroll
        for (int o = 1; o < 64; o <<= 1) { int t = __builtin_amdgcn_ds_bpermute(((lane - o) & 63) << 2, pre); if (lane >= o) pre += t; }
        unsigned long long bal = __ballot(pre >= 256);
        if (bal != 0ull) {
          int fl = __ffsll((long long)bal) - 1;
          if (lane == fl) {
            int running = pre - cnt;
            int bsel = -1, above = 0;
#pragma unroll
            for (int k = 0; k < 4; ++k) {
              int chi = (int)(hw[k] >> 16), clo = (int)(hw[k] & 0xffffu);
              if (bsel < 0) { if (running + chi >= 256) { bsel = 511 - 8 * lane - 2 * k; above = running; } else running += chi; }
              if (bsel < 0) { if (running + clo >= 256) { bsel = 510 - 8 * lane - 2 * k; above = running; } else running += clo; }
            }
            bstar[q] = bsel; need[q] = 256 - above;
          }
        }
      }
      __syncthreads();
    }
  }
  __threadfence();
  __syncthreads();
  if (do_select) {
    for (int pi = tid; pi < 32 * CAP; pi += NT) {
      int q = pi / CAP, c = pi - q * CAP;
      int n = min(ncand[q], CAP);
      if (c < n && q < nq) {
        float sv = cand_s[q * CAP + c]; int iv = cand_i[q * CAP + c];
        int rank = 0;
        for (int j = 0; j < n; ++j) {
          float sj = cand_s[q * CAP + j]; int ij = cand_i[q * CAP + j];
          rank += (sj > sv || (sj == sv && ij < iv)) ? 1 : 0;
        }
        if (rank < need[q]) atomicOr(&BM[(size_t)(q_row0 + q) * 256 + (iv >> 5)], 1u << (iv & 31));
      }
    }
  }
  __syncthreads();
}

DI void idx_phase(PREF p, unsigned char* smem, int bid, int nblk, int wv) {
  unsigned char* R = p.ws + OFF_R;
  const bf16_t* QI = (const bf16_t*)(R + D_QI); const float* WI = (const float*)(R + D_WI);
  const bf16_t* KI = (const bf16_t*)(R + D_KI); unsigned* BM = (unsigned*)(R + D_BM);
  const int total = 512 + 32;
  for (int i = 0; i * nblk < total; ++i) {
    int idx = snake_idx(i, bid, nblk);
    if (idx >= total) continue;
    if (idx < 512) {
      int qt = 255 - (idx >> 1), b = idx & 1;
      int L = (((qt * 32) >> 6) + 1) * 64;
      idx_unit(QI, WI, b * 8192 + qt * 32, 32, KI + (size_t)(b * 8192) * 64, L, BM, smem, wv);
    } else {
      int b = idx - 512;
      idx_unit(QI, WI, TP + b * 16, 16, KI + (size_t)(TP + b * SPAD) * 64, NKS, BM, smem, wv);
    }
  }
}

DI void cvt8(const float* s, bf16_t* d) {
  float4 a = *(const float4*)s, b = *(const float4*)(s + 4);
  uint4 pk; pk.x = pack2(a.x, a.y); pk.y = pack2(a.z, a.w); pk.z = pack2(b.x, b.y); pk.w = pack2(b.z, b.w);
  *(uint4*)d = pk;
}
DI void cache_rows(const float* __restrict__ src, bf16_t* __restrict__ dst, int Wd, int bid, int nblk, int wv) {
  const int vpr = Wd >> 3;
  const size_t total = (size_t)32 * SPAD * vpr;
  for (size_t e = (size_t)bid * NT + ltid(wv); e < total; e += (size_t)nblk * NT) {
    int c = (int)(e % vpr) * 8; size_t rw = e / vpr; int b = (int)(rw / SPAD), s = (int)(rw % SPAD);
    bf16_t* d = dst + ((size_t)TP + (size_t)b * SPAD + s) * Wd + c;
    if (s < 1024) cvt8(src + ((size_t)b * 1024 + s) * Wd + c, d);
    else if (s >= NKS) { unsigned z = 0; asm volatile("" : "+v"(z)); *(uint4*)d = make_uint4(z, z, z, z); }
  }
}


#define XB_TMO      128
#define XB_XCNT(j)  (256  + 64 * (j))
#define XB_XSUB(j)  (1280 + 64 * (j))
#define XB_XGEN(j)  (2304 + 64 * (j))
#define XB_TOP      3328
#define XB_TOPGEN   3392
#define XCD_BAR_WORDS 3456
#define XB_SPIN_CAP (1u << 18)
DI unsigned xb_ld(unsigned* p)              { return __hip_atomic_load(p, __ATOMIC_RELAXED, __HIP_MEMORY_SCOPE_AGENT); }
DI unsigned xb_add(unsigned* p, unsigned v) { return __hip_atomic_fetch_add(p, v, __ATOMIC_RELAXED, __HIP_MEMORY_SCOPE_AGENT); }
DI unsigned xb_xcc_id() { return (unsigned)__builtin_amdgcn_s_getreg((3 << 11) | 20) & 0xFu; }
#define XB_SPIN(cond, bar) do { unsigned _sp = 0; while (cond) { __builtin_amdgcn_s_sleep(1); \
    if ((++_sp & 255u) == 0u) { if (xb_ld(&(bar)[XB_TMO])) break; if (_sp > XB_SPIN_CAP) { atomicAdd(&(bar)[XB_TMO], 1u); break; } } } } while (0)
struct XcdBarrier { unsigned* bar; unsigned x; volatile __attribute__((address_space(3))) unsigned* st; };
DI void xcd_barrier_complete(unsigned* bar, unsigned x, unsigned G, unsigned& nloc, unsigned& nx) {
  unsigned sum, cnt, mine, sp = 0u;
  for (;;) {
    sum = 0u; cnt = 0u; mine = 0u;
#pragma unroll
    for (unsigned j = 0; j < 16; ++j) { const unsigned c = xb_ld(&bar[XB_XCNT(j)]); sum += c; cnt += (c > 0u) ? 1u : 0u; mine = (j == x) ? c : mine; }
    if (sum == G) break;
    __builtin_amdgcn_s_sleep(1);
    if ((++sp & 255u) == 0u) { if (xb_ld(&bar[XB_TMO])) break; if (sp > XB_SPIN_CAP) { atomicAdd(&bar[XB_TMO], 1u); break; } }
  }
  nloc = mine > 0u ? mine : 1u; nx = cnt > 0u ? cnt : 1u;
}
DI void xcd_barrier(const XcdBarrier& b, int tid, unsigned G) {
  asm volatile("s_waitcnt vmcnt(0)" ::: "memory");
  __syncthreads();
  if (tid == 0) {
    unsigned* bar = b.bar;
    __builtin_amdgcn_s_waitcnt(0);
    unsigned nloc = b.st[0], nx = b.st[1];
    if (nloc == 0u) { xcd_barrier_complete(bar, b.x, G, nloc, nx); b.st[0] = nloc; b.st[1] = nx; }
    const unsigned old = xb_add(&bar[XB_XSUB(b.x)], 1u);
    const unsigned gen = old / nloc;
    if (old + 1u == (gen + 1u) * nloc) {
      __builtin_amdgcn_fence(__ATOMIC_RELEASE, "agent");
      asm volatile("s_waitcnt vmcnt(0)" ::: "memory");
      const unsigned og = xb_add(&bar[XB_TOP], 1u);
      const unsigned tg = og / nx;
      if (og + 1u == (tg + 1u) * nx) xb_add(&bar[XB_TOPGEN], 1u);
      else XB_SPIN(xb_ld(&bar[XB_TOPGEN]) == tg, bar);
      __builtin_amdgcn_fence(__ATOMIC_ACQUIRE, "agent");
      xb_add(&bar[XB_XGEN(b.x)], 1u);
      asm volatile("s_waitcnt vmcnt(0)" ::: "memory");
    } else {
      XB_SPIN(xb_ld(&bar[XB_XGEN(b.x)]) == gen, bar);
      __builtin_amdgcn_fence(__ATOMIC_ACQUIRE, "agent");
      asm volatile("s_waitcnt vmcnt(0)" ::: "memory");
    }
  }
  __syncthreads();
}

extern "C" __global__ void __launch_bounds__(512, 2) mega(Params p_unused) {
  extern __shared__ __attribute__((aligned(16))) unsigned char smem[];
  cg::grid_group grid = cg::this_grid();
  const int bid = blockIdx.x, nblk = gridDim.x;
  const int wv = __builtin_amdgcn_readfirstlane((int)(threadIdx.x >> 6));
  CParams* pk = (CParams*)__builtin_amdgcn_kernarg_segment_ptr();
  const int ph_lo = pk->ph_lo, ph_hi = pk->ph_hi;
  int ph = 0;
  if (ph_lo > 0x40000000) grid.sync();
  XcdBarrier xb;
  {
    volatile __attribute__((address_space(3))) unsigned* st = (volatile __attribute__((address_space(3))) unsigned*)(smem + 131072);
    const int t0 = ltid(wv);
    if (t0 == 0) { st[0] = 0u; st[1] = 0u; }
    __syncthreads();
    xb.bar = (unsigned*)(pk->ws + OFF_BAR); xb.x = xb_xcc_id(); xb.st = st;
    if (t0 == 0) (void)xb_add(&xb.bar[XB_XCNT(xb.x)], 1u);
  }
#ifndef REPMASK
#define REPMASK 0u
#endif
#ifndef PMASK
#define PMASK 0xffffffffu
#endif
#define PHASE_BEGIN(k) if (ph >= ph_lo && ph < ph_hi) { if constexpr ((PMASK >> (k)) & 1u) for (int rep_ = 0; rep_ < 1 + (int)((REPMASK >> (k)) & 1u); ++rep_) { \
    CParams* pp_ = pk; asm volatile("" : "+s"(pp_)); PREF p = *pp_; const int tid = ltid(wv); \
    unsigned char* ws = p.ws; float* X = (float*)(ws + OFF_X); bf16_t* H = (bf16_t*)(ws + OFF_H); bf16_t* Wb = (bf16_t*)(ws + OFF_W); \
    float* ROPE = (float*)(ws + OFF_ROPE); unsigned char* R = ws + OFF_R; (void)tid; (void)X; (void)H; (void)Wb; (void)ROPE; (void)R;
#define PHASE_END   } if (ph + 1 < ph_hi) { xcd_barrier(xb, ltid(wv), (unsigned)nblk); } } ++ph;

  PHASE_BEGIN(0)
    {
      const int hf = tid >> 8, tl = tid & 255;
      float* smh = (float*)smem + hf * 4224;
      for (int t0 = bid * 2; t0 < p.total_tiles; t0 += nblk * 2) {
        const int t = t0 + hf;
        const bool active = t < p.total_tiles;
        const int tt = active ? t : 0;
        int ji = 0;
#pragma unroll 1
        for (int q = 1; q < NJOBS; ++q) if (tt >= p.jobs[q].tile0) ji = q;
        const CAS Job& jb = p.jobs[ji];
        int lt = tt - jb.tile0; int nkt = jb.k >> 6; int nt_ = lt / nkt, kt_ = lt - nt_ * nkt;
        transpose_tile(jb.src, jb.nsrc, jb.nsrc, jb.dst, jb.k, nt_ * 64, kt_ * 64, jb.mode, smh, tl, active);
      }
    }
    {
      const size_t n4p = (size_t)TP * 256, n4 = (size_t)T * 256;
      const float4* xp = (const float4*)p.in[0]; const float4* xs = (const float4*)p.in[1];
      for (size_t e = (size_t)bid * NT + tid; e < n4; e += (size_t)nblk * NT) ((float4*)X)[e] = (e < n4p) ? xp[e] : xs[e - n4p];
      for (int e = bid * NT + tid; e < 8192 * 16; e += nblk * NT) {
        int pos = e >> 4, i = e & 15;
        double rev = (double)pos * p.inv_freq[i] * 0.15915494309189535;
        rev -= floor(rev);
        float fr = (float)rev;
        ROPE[2 * e] = __builtin_amdgcn_cosf(fr); ROPE[2 * e + 1] = __builtin_amdgcn_sinf(fr);
      }
      const float* wsrc = p.in[20];
      for (int e = bid * NT + tid; e < 8 * 128 * 128; e += nblk * NT) {
        int s = e & 127, t = (e >> 7) & 127;
        Wb[W_TRIL + e] = tobf(s <= t ? wsrc[e] : 0.f);
      }
    }
  PHASE_END

#pragma unroll 1
  for (int L = 0; L < 4; ++L) {
    const int kind = L % 3, j = L / 3;
    if (kind == 0) {
      PHASE_BEGIN(1)
        rmsnorm_rows(X, p.in[7] + L * 1024, H, nullptr, nullptr, bid, nblk, wv);
        cache_rows(p.in[2] + (size_t)j * 32 * 1024 * 256, (bf16_t*)(R + R_CKV), 256, bid, nblk, wv);
        cache_rows(p.in[3] + (size_t)j * 32 * 1024 * 32, (bf16_t*)(R + R_KR), 32, bid, nblk, wv);
      PHASE_END
      PHASE_BEGIN(2)
        EArgs ea{}; ea.f0 = (float*)(R + R_RAW);
        gemm_phase<E_F32>(H, Wb + W_MLA + (size_t)j * WM_SZ + WM_D, T, 1024, 1024, ea, smem, 0, bid, nblk, wv);
      PHASE_END
      PHASE_BEGIN(3)
        mla_rowops(p, j, bid, nblk, wv);
      PHASE_END
      PHASE_BEGIN(4)
        EArgs ea{}; ea.b0 = (bf16_t*)(R + R_Q); ea.rope = ROPE;
        gemm_phase<E_MLAQ>((const bf16_t*)(R + R_CQ), Wb + W_MLA + (size_t)j * WM_SZ + WM_UQ, T, 1536, 512, ea, smem, 0, bid, nblk, wv);
        EArgs eb{}; eb.b0 = (bf16_t*)(R + R_KN); eb.b1 = (bf16_t*)(R + R_VT);
        gemm_phase<E_MLAKV>((const bf16_t*)(R + R_CKV), Wb + W_MLA + (size_t)j * WM_SZ + WM_UKV, KROWS, 2048, 256, eb, smem, (T / 256) * 6, bid, nblk, wv);
      PHASE_END
      PHASE_BEGIN(5)
        attn_phase<true>(p, smem, bid, nblk, wv);
      PHASE_END
      PHASE_BEGIN(6)
        EArgs ea{}; ea.f0 = X;
        gemm_phase<E_RESID>((const bf16_t*)(R + R_RAW), Wb + W_MLA + (size_t)j * WM_SZ + WM_O, T, 1024, 1024, ea, smem, 0, bid, nblk, wv);
      PHASE_END
    } else if (kind == 1) {
      PHASE_BEGIN(1)
        rmsnorm_rows(X, p.in[7] + L * 1024, H, nullptr, nullptr, bid, nblk, wv);
      PHASE_END
      PHASE_BEGIN(7)
        EArgs ea{}; ea.b0 = (bf16_t*)(R + C_U); ea.b1 = (bf16_t*)(R + C_VR);
        gemm_phase<E_GELU>(H, Wb + W_CM + WC_IN, T, 4096, 1024, ea, smem, 0, bid, nblk, wv);
      PHASE_END
      PHASE_BEGIN(8)
        cmlp_ln_rows(p, bid, nblk, wv);
      PHASE_END
      PHASE_BEGIN(9)
        cmlp_mix_phase(p, smem, bid, nblk, wv);
      PHASE_END
      PHASE_BEGIN(6)
        EArgs ea{}; ea.f0 = X;
        gemm_phase<E_RESID>((const bf16_t*)(R + C_G), Wb + W_CM + WC_OUT, T, 1024, 2048, ea, smem, 0, bid, nblk, wv);
      PHASE_END
    } else {
      PHASE_BEGIN(10)
        rmsnorm_rows(X, p.in[7] + L * 1024, H, nullptr, nullptr, bid, nblk, wv);
        cache_rows(p.in[4], (bf16_t*)(R + D_K), 1024, bid, nblk, wv);
        cache_rows(p.in[6], (bf16_t*)(R + D_KI), 64, bid, nblk, wv);
        {
          bf16_t* VTs = (bf16_t*)(R + D_VT) + (size_t)TP * 1024;
          {
            const int hf = tid >> 8, tl = tid & 255;
            float* smh = (float*)smem + hf * 4224;
            for (int u0 = bid * 2; u0 < 512 * 16; u0 += nblk * 2) {
              const int u = u0 + hf;
              int st = u & 15, bh = u >> 4, b = bh >> 4, h = bh & 15;
              transpose_tile(p.in[5] + (size_t)b * 1024 * 1024 + h * 64, 1024, 64, VTs + (size_t)(bh * 64) * SPAD, SPAD, 0, st * 64, 0, smh, tl, true);
            }
          }
          for (int e = bid * NT + tid; e < 512 * 64 * 12; e += nblk * NT) {
            int c = e % 12, rw = e / 12;
            { unsigned z = 0; asm volatile("" : "+v"(z)); *(uint2*)(VTs + (size_t)rw * SPAD + NKS + c * 4) = make_uint2(z, z); }
          }
        }
      PHASE_END
      PHASE_BEGIN(11)
        EArgs ea{};
        ea.f0 = p.out + O_DKP; ea.f1 = p.out + O_DKS; ea.f2 = p.out + O_DVP; ea.f3 = p.out + O_DVS;
        ea.f4 = (float*)(R + D_KIR); ea.f5 = (float*)(R + D_WI);
        ea.b0 = (bf16_t*)(R + D_Q); ea.b1 = (bf16_t*)(R + D_K); ea.b2 = (bf16_t*)(R + D_VT); ea.b3 = (bf16_t*)(R + D_QI);
        gemm_phase<E_DSA>(H, Wb + W_DS + WD_P, T, 3840, 1024, ea, smem, 0, bid, nblk, wv);
      PHASE_END
      PHASE_BEGIN(12)
        dsa_rowops(p, bid, nblk, wv);
      PHASE_END
      PHASE_BEGIN(13)
        idx_phase(p, smem, bid, nblk, wv);
      PHASE_END
      PHASE_BEGIN(14)
        attn_phase<false>(p, smem, bid, nblk, wv);
      PHASE_END
      PHASE_BEGIN(6)
        EArgs ea{}; ea.f0 = X;
        gemm_phase<E_RESID>((const bf16_t*)(R + D_AO), Wb + W_DS + WD_O, T, 1024, 1024, ea, smem, 0, bid, nblk, wv);
      PHASE_END
    }
    PHASE_BEGIN(1)
      rmsnorm_rows(X, p.in[8] + L * 1024, H, nullptr, nullptr, bid, nblk, wv);
    PHASE_END
    PHASE_BEGIN(15)
      EArgs ea{}; ea.b0 = (bf16_t*)(R + 0);
      gemm_phase<E_SWIGLU>(H, Wb + W_FF + (size_t)L * WF_SZ + WF_IN, T, 2 * DFF, 1024, ea, smem, 0, bid, nblk, wv);
    PHASE_END
    PHASE_BEGIN(6)
      EArgs ea{}; ea.f0 = X;
      gemm_phase<E_RESID>((const bf16_t*)(R + 0), Wb + W_FF + (size_t)L * WF_SZ + WF_OUT, T, 1024, DFF, ea, smem, 0, bid, nblk, wv);
    PHASE_END
  }
  PHASE_BEGIN(1)
    rmsnorm_rows(X, p.in[9], nullptr, p.out + O_YP, p.out + O_YS, bid, nblk, wv);
  PHASE_END
}

extern "C" void kernel_launch(void* const* d_in, const int* in_sizes, int n_in,
                              void* d_out, int out_size, void* d_ws, size_t ws_size,
                              hipStream_t stream) {
  constexpr int kLds = 128 * 1024 + 64;
  static int grid_blocks = 0;
  if (!grid_blocks) {
    int dev = 0, cus = 0, per_cu = 0;
    (void)hipGetDevice(&dev);
    (void)hipDeviceGetAttribute(&cus, hipDeviceAttributeMultiprocessorCount, dev);
    (void)hipFuncSetAttribute((const void*)mega, hipFuncAttributeMaxDynamicSharedMemorySize, kLds);
    (void)hipOccupancyMaxActiveBlocksPerMultiprocessor(&per_cu, (const void*)mega, NT, kLds);
    if (per_cu < 1) per_cu = 1;
    if (per_cu > 1) per_cu = 1;
    grid_blocks = cus * per_cu;
    fprintf(stderr, "grid %d (cus %d per_cu %d) ws %zu need %zu out %d need %zu\n", grid_blocks, cus, per_cu, ws_size, (size_t)WS_NEED, out_size, (size_t)O_END);
  }
  if (ws_size < WS_NEED || n_in != 31 || (size_t)out_size != O_END) { fprintf(stderr, "kernel_launch: bad sizes\n"); return; }
  Params p;
  memset(&p, 0, sizeof(p));
  for (int i = 0; i < 31; ++i) p.in[i] = (const float*)d_in[i];
  p.out = (float*)d_out; p.ws = (unsigned char*)d_ws;
  bf16_t* Wb = (bf16_t*)((unsigned char*)d_ws + OFF_W);
  int nj = 0, tiles = 0;
  auto add = [&](const float* src, int nsrc, int k, bf16_t* dst, int ndst, int mode) {
    Job& jb = p.jobs[nj++]; jb.src = src; jb.dst = dst; jb.nsrc = nsrc; jb.k = k; jb.ndst = ndst; jb.mode = mode; jb.tile0 = tiles; jb.pad = 0;
    tiles += (ndst / 64) * (k / 64);
  };
  for (int j = 0; j < 2; ++j) {
    bf16_t* Wm = Wb + W_MLA + (size_t)j * WM_SZ;
    add(p.in[10] + (size_t)j * 1024 * 512, 512, 1024, Wm + WM_D, 512, 2);
    add(p.in[13] + (size_t)j * 1024 * 288, 288, 1024, Wb + W_MLA + (size_t)j * WM_SZ + WM_D + (size_t)512 * 1024, 512, 2);
    add(p.in[12] + (size_t)j * 512 * 1536, 1536, 512, Wb + W_MLA + (size_t)j * WM_SZ + WM_UQ, 1536, 0);
    add(p.in[15] + (size_t)j * 256 * 2048, 2048, 256, Wb + W_MLA + (size_t)j * WM_SZ + WM_UKV, 2048, 2);
    add(p.in[16] + (size_t)j * 1024 * 1024, 1024, 1024, Wb + W_MLA + (size_t)j * WM_SZ + WM_O, 1024, 2);
  }
  add(p.in[17], 4096, 1024, Wb + W_CM + WC_IN, 4096, 2);
  add(p.in[22], 1024, 2048, Wb + W_CM + WC_OUT, 1024, 2);
  add(p.in[23], 3072, 1024, Wb + W_DS + WD_P, 3072, 2);
  add(p.in[25], 512, 1024, Wb + W_DS + WD_P + (size_t)3072 * 1024, 512, 2);
  add(p.in[26], 64, 1024, Wb + W_DS + WD_P + (size_t)3584 * 1024, 64, 2);
  add(p.in[28], 8, 1024, Wb + W_DS + WD_P + (size_t)3648 * 1024, 192, 2);
  add(p.in[24], 1024, 1024, Wb + W_DS + WD_O, 1024, 2);
  for (int i = 0; i < 4; ++i) {
    add(p.in[29] + (size_t)i * 1024 * 5632, 5632, 1024, Wb + W_FF + (size_t)i * WF_SZ + WF_IN, 5632, 1);
    add(p.in[30] + (size_t)i * 2816 * 1024, 1024, 2816, Wb + W_FF + (size_t)i * WF_SZ + WF_OUT, 1024, 2);
  }
  p.total_tiles = tiles;
  for (int i = 0; i < 16; ++i) p.inv_freq[i] = pow(10000.0, -(double)i / 16.0);
  p.ph_lo = 0; p.ph_hi = 1000;
  (void)hipMemsetAsync((unsigned char*)d_ws + OFF_BAR, 0, 16384, stream);
  void* args[] = {&p};
  hipError_t e = hipLaunchCooperativeKernel((const void*)mega, dim3(grid_blocks), dim3(NT), args, kLds, stream);
  if (e != hipSuccess) fprintf(stderr, "coop launch failed: %s\n", hipGetErrorString(e));
}
```

```cpp
#include <hip/hip_runtime.h>
#include <hip/hip_cooperative_groups.h>
#include <cstdio>
#include <cstring>
#include <cmath>
namespace cg = cooperative_groups;

typedef unsigned short bf16_t;
using bf16x8 = __attribute__((ext_vector_type(8))) short;
using f32x16 = __attribute__((ext_vector_type(16))) float;
using f32x2v = __attribute__((ext_vector_type(2))) float;
using bf2v = __attribute__((ext_vector_type(2))) __bf16;
#define DI __device__ __forceinline__
#define MFMA32(a, b, c) __builtin_amdgcn_mfma_f32_32x32x16_bf16((a), (b), (c), 0, 0, 0)

constexpr int TP = 16384, TS = 512, T = TP + TS;
constexpr int NT = 512;
constexpr int SPAD = 1088, NKS = 1040;
constexpr int KROWS = TP + 32 * SPAD;
constexpr int DFF = 2816;
constexpr float LOG2E = 1.4426950408889634f;
constexpr float EPS = 1e-6f;

constexpr size_t OFF_X = 0;
constexpr size_t OFF_H = OFF_X + (size_t)T * 1024 * 4;
constexpr size_t OFF_W = OFF_H + (size_t)T * 1024 * 2;
constexpr size_t W_ELEMS = 52822016;
constexpr size_t OFF_ROPE = OFF_W + W_ELEMS * 2;
constexpr size_t OFF_R = OFF_ROPE + (size_t)8192 * 16 * 2 * 4;
constexpr size_t R_RAW = 0;
constexpr size_t R_CQ = R_RAW + (size_t)T * 1024 * 4;
constexpr size_t R_CKV = R_CQ + (size_t)T * 512 * 2;
constexpr size_t R_KR = R_CKV + (size_t)KROWS * 256 * 2;
constexpr size_t R_Q = R_KR + (size_t)KROWS * 32 * 2;
constexpr size_t R_KN = R_Q + (size_t)T * 1536 * 2;
constexpr size_t R_VT = R_KN + (size_t)KROWS * 1024 * 2;
constexpr size_t R_END = R_VT + (size_t)KROWS * 1024 * 2;
constexpr size_t D_Q = 0;
constexpr size_t D_K = D_Q + (size_t)T * 1024 * 2;
constexpr size_t D_VT = D_K + (size_t)KROWS * 1024 * 2;
constexpr size_t D_QI = D_VT + (size_t)KROWS * 1024 * 2;
constexpr size_t D_KIR = D_QI + (size_t)T * 512 * 2;
constexpr size_t D_KI = D_KIR + (size_t)T * 64 * 4;
constexpr size_t D_WI = D_KI + (size_t)KROWS * 64 * 2;
constexpr size_t D_BM = D_WI + (size_t)T * 8 * 4;
constexpr size_t D_AO = D_BM + (size_t)T * 256 * 4;
constexpr size_t D_END = D_AO + (size_t)T * 1024 * 2;
constexpr size_t C_U = 0;
constexpr size_t C_VR = C_U + (size_t)T * 2048 * 2;
constexpr size_t C_VLN = C_VR + (size_t)T * 2048 * 2;
constexpr size_t C_G = C_VLN + (size_t)T * 2048 * 2;
constexpr size_t C_END = C_G + (size_t)T * 2048 * 2;
constexpr size_t OFF_BAR = OFF_R + R_END;
constexpr size_t WS_NEED = OFF_BAR + 16384;
static_assert(D_END <= R_END && C_END <= R_END && (size_t)T * DFF * 2 <= R_END, "region");

constexpr size_t W_MLA = 0;
constexpr size_t WM_D = 0, WM_UQ = 1048576, WM_UKV = WM_UQ + 786432, WM_O = WM_UKV + 524288, WM_SZ = 3407872;
constexpr size_t W_CM = 2 * WM_SZ;
constexpr size_t WC_IN = 0, WC_OUT = 4194304, WC_SZ = 6291456;
constexpr size_t W_DS = W_CM + WC_SZ;
constexpr size_t WD_P = 0, WD_O = 3932160, WD_SZ = 4980736;
constexpr size_t W_FF = W_DS + WD_SZ;
constexpr size_t WF_IN = 0, WF_OUT = 5767168, WF_SZ = 8650752;
constexpr size_t W_TRIL = W_FF + 4 * WF_SZ;
static_assert(W_TRIL + 131072 == W_ELEMS, "w");

constexpr size_t O_YP = 0;
constexpr size_t O_YS = O_YP + (size_t)TP * 1024;
constexpr size_t O_CKVP = O_YS + (size_t)TS * 1024;
constexpr size_t O_KRP = O_CKVP + (size_t)2 * TP * 256;
constexpr size_t O_CKVS = O_KRP + (size_t)2 * TP * 32;
constexpr size_t O_KRS = O_CKVS + (size_t)2 * TS * 256;
constexpr size_t O_CVS = O_KRS + (size_t)2 * TS * 32;
constexpr size_t O_DKP = O_CVS + (size_t)TS * 2048;
constexpr size_t O_DVP = O_DKP + (size_t)TP * 1024;
constexpr size_t O_DIP = O_DVP + (size_t)TP * 1024;
constexpr size_t O_DKS = O_DIP + (size_t)TP * 64;
constexpr size_t O_DVS = O_DKS + (size_t)TS * 1024;
constexpr size_t O_DIS = O_DVS + (size_t)TS * 1024;
constexpr size_t O_END = O_DIS + (size_t)TS * 64;

constexpr int NJOBS = 25;
struct Job { const float* src; bf16_t* dst; int nsrc, k, ndst, mode, tile0, pad; };
struct Params {
  const float* in[31];
  float* out;
  unsigned char* ws;
  Job jobs[NJOBS];
  int total_tiles, ph_lo, ph_hi, pad;
  double inv_freq[16];
};

#define CAS __attribute__((address_space(4)))
typedef const CAS Params CParams;
#define PREF const CAS Params&
DI unsigned pack2(float a, float b) { f32x2v v = {a, b}; bf2v r = __builtin_convertvector(v, bf2v); return __builtin_bit_cast(unsigned, r); }
DI bf16_t tobf(float a) { return (bf16_t)(pack2(a, 0.f) & 0xffffu); }
DI float frombf(bf16_t v) { return __uint_as_float(((unsigned)v) << 16); }
DI float bflo(unsigned u) { return __uint_as_float(u << 16); }
DI float bfhi(unsigned u) { return __uint_as_float(u & 0xffff0000u); }
DI float shflx(float v, int m, int lane) { return __int_as_float(__builtin_amdgcn_ds_bpermute((lane ^ m) << 2, __float_as_int(v))); }
DI float wave_sum(float v, int lane) {
#pragma unroll
  for (int o = 32; o >= 1; o >>= 1) v += shflx(v, o, lane);
  return v;
}
DI int ltid(int wv) { unsigned m1 = ~0u; asm volatile("" : "+s"(m1)); int t = (wv << 6) | (int)__builtin_amdgcn_mbcnt_hi(m1, __builtin_amdgcn_mbcnt_lo(m1, 0u)); asm volatile("" : "+v"(t)); return t; }
DI int crow(int i, int h) { return (i & 3) + 8 * (i >> 2) + 4 * h; }
DI int rowmap(int t) { if (t < TP) return t; int u = t - TP; return TP + (u >> 4) * SPAD + 1024 + (u & 15); }
DI int tokpos(int t) { return t < TP ? (t & 8191) : 1024 + ((t - TP) & 15); }

DI void transpose_tile(const float* __restrict__ src, int src_ld, int ncols, bf16_t* __restrict__ dst, int dst_ld,
                       int n0, int k0, int mode, float* sm, int tid, bool active) {
  const int nl = (tid & 15) * 4, kq = tid >> 4;
  const int n = n0 + nl;
  int c;
  if (mode != 1) c = n < ncols ? n : -1;
  else { int tt = n >> 5, r = n & 31; int f = tt * 16 + (r & 15); c = (r < 16) ? f : DFF + f; }
  int dr[4];
#pragma unroll
  for (int e = 0; e < 4; ++e) { int col = nl + e; dr[e] = (mode == 2) ? ((col & 32) + (col & 1) * 16 + ((col & 31) >> 1)) : col; }
  if (active) {
    float4 v[4];
#pragma unroll
    for (int i = 0; i < 4; ++i) {
      int kk = kq + 16 * i;
      v[i] = (c >= 0) ? *(const float4*)(src + (size_t)(k0 + kk) * src_ld + c) : make_float4(0.f, 0.f, 0.f, 0.f);
    }
#pragma unroll
    for (int i = 0; i < 4; ++i) {
      int kk = kq + 16 * i;
      float* d = sm + kk * 65;
      d[dr[0]] = v[i].x; d[dr[1]] = v[i].y; d[dr[2]] = v[i].z; d[dr[3]] = v[i].w;
    }
  }
  __syncthreads();
  if (active) {
    const int kp = (tid & 31) * 2, nr = tid >> 5;
#pragma unroll 4
    for (int i = 0; i < 8; ++i) {
      int nn = nr + 8 * i;
      float a = sm[kp * 65 + nn], b = sm[(kp + 1) * 65 + nn];
      *(unsigned*)(dst + (size_t)(n0 + nn) * dst_ld + k0 + kp) = pack2(a, b);
    }
  }
  __syncthreads();
}

enum { E_F32 = 0, E_RESID, E_SWIGLU, E_GELU, E_MLAQ, E_MLAKV, E_DSA };
struct EArgs {
  float* f0; float* f1; float* f2; float* f3; float* f4; float* f5; float* f6;
  bf16_t* b0; bf16_t* b1; bf16_t* b2; bf16_t* b3;
  const float* rope;
};
using f32x4v = __attribute__((ext_vector_type(4))) float;
#define LAS __attribute__((address_space(3)))
constexpr int G_HT = 128 * 64;
DI int lds_byte(int r, int c) {
  int st = (r >> 4) * 2 + (c >> 5), rr = r & 15, cc = c & 31, ob = rr * 64 + cc * 2;
  return st * 1024 + (ob ^ (((ob >> 9) & 1) << 5));
}
DI void stage_rc(int b, int& R, int& C) {
  int st = b >> 10, sb = b & 1023, swz = sb ^ (((sb >> 9) & 1) << 5);
  R = (st >> 1) * 16 + (swz >> 6); C = (st & 1) * 32 + ((swz & 63) >> 1);
}

DI float gelu_exact(float x) {
  const float z = fabsf(x) * 0.70710678118654752f;
  const float t = __builtin_amdgcn_rcpf(1.f + 0.3275911f * z);
  float pl = 1.061405429f;
  pl = pl * t - 1.453152027f; pl = pl * t + 1.421413741f; pl = pl * t - 0.284496736f; pl = pl * t + 0.254829592f;
  const float e = pl * t * __builtin_amdgcn_exp2f(-z * z * 1.4426950408889634f);
  const float erfz = 1.f - e;
  const float erfx = x < 0.f ? -erfz : erfz;
  return 0.5f * x * (1.f + erfx);
}
template <int EPI, bool ATOM>
DI void epi16(const EArgs& ea, int row0, int gb, int fr, const f32x4v& v0, const f32x4v& v1) {
  if constexpr (EPI == E_F32) {
#pragma unroll
    for (int j = 0; j < 4; ++j) *(float2*)(ea.f0 + (size_t)(row0 + j) * 1024 + gb + 2 * fr) = make_float2(v0[j], v1[j]);
  } else if constexpr (EPI == E_RESID) {
#pragma unroll
    for (int j = 0; j < 4; ++j) { float* o = ea.f0 + (size_t)(row0 + j) * 1024 + gb + 2 * fr;
      if constexpr (ATOM) { unsafeAtomicAdd(o, v0[j]); unsafeAtomicAdd(o + 1, v1[j]); }
      else { float2 x = *(float2*)o; x.x += v0[j]; x.y += v1[j]; *(float2*)o = x; } }
  } else if constexpr (EPI == E_SWIGLU) {
    const int f = (gb >> 1) + fr;
#pragma unroll
    for (int j = 0; j < 4; ++j) { float g = v0[j], u = v1[j]; ea.b0[(size_t)(row0 + j) * DFF + f] = tobf(g * __builtin_amdgcn_rcpf(1.f + __builtin_amdgcn_exp2f(-g * LOG2E)) * u); }
  } else if constexpr (EPI == E_GELU) {
    bf16_t* dstp = (gb < 2048) ? (ea.b0 + gb + 2 * fr) : (ea.b1 + (gb - 2048) + 2 * fr);
#pragma unroll
    for (int j = 0; j < 4; ++j) {
      float x = v0[j], y = v1[j];
      *(unsigned*)(dstp + (size_t)(row0 + j) * 2048) = pack2(gelu_exact(x), gelu_exact(y));
    }
  } else if constexpr (EPI == E_MLAQ) {
    const float qs = 0.10206207261596577f * LOG2E;
    const bool is_rope = (gb % 96) == 64;
#pragma unroll
    for (int j = 0; j < 4; ++j) {
      const int row = row0 + j;
      float o0 = v0[j], o1 = v1[j];
      if (is_rope) {
        float2 cs = *(const float2*)(ea.rope + ((size_t)tokpos(row) * 16 + fr) * 2);
        o0 = v0[j] * cs.x - v1[j] * cs.y; o1 = v0[j] * cs.y + v1[j] * cs.x;
      }
      bf16_t* o = ea.b0 + (size_t)row * 1536 + gb + fr;
      o[0] = tobf(o0 * qs); o[16] = tobf(o1 * qs);
    }
  } else if constexpr (EPI == E_MLAKV) {
    const int head = gb >> 7, c0 = gb & 127;
    if (c0 < 64) {
#pragma unroll
      for (int j = 0; j < 4; ++j) *(unsigned*)(ea.b0 + (size_t)(row0 + j) * 1024 + head * 64 + c0 + 2 * fr) = pack2(v0[j], v1[j]);
    } else {
      const int d = c0 - 64 + 2 * fr;
      size_t off, dstr;
      if (row0 < TP) { int b = row0 >> 13, s = row0 & 8191; off = ((size_t)((b * 16 + head) * 64 + d)) * 8192 + s; dstr = 8192; }
      else { int u = row0 - TP; int b = u / SPAD, s = u - b * SPAD; off = (size_t)TP * 1024 + ((size_t)((b * 16 + head) * 64 + d)) * SPAD + s; dstr = SPAD; }
      uint2 pk; pk.x = pack2(v0[0], v0[1]); pk.y = pack2(v0[2], v0[3]); *(uint2*)(ea.b1 + off) = pk;
      pk.x = pack2(v1[0], v1[1]); pk.y = pack2(v1[2], v1[3]); *(uint2*)(ea.b1 + off + dstr) = pk;
    }
  } else if constexpr (EPI == E_DSA) {
    if (gb < 1024) {
      const float qs = 0.125f * LOG2E;
#pragma unroll
      for (int j = 0; j < 4; ++j) *(unsigned*)(ea.b0 + (size_t)(row0 + j) * 1024 + gb + 2 * fr) = pack2(v0[j] * qs, v1[j] * qs);
    } else if (gb < 2048) {
      const int c = gb - 1024 + 2 * fr;
#pragma unroll
      for (int j = 0; j < 4; ++j) {
        const int row = row0 + j;
        float* o = (row < TP) ? ea.f0 + (size_t)row * 1024 + c : ea.f1 + (size_t)(row - TP) * 1024 + c;
        *(float2*)o = make_float2(v0[j], v1[j]);
        *(unsigned*)(ea.b1 + (size_t)rowmap(row) * 1024 + c) = pack2(v0[j], v1[j]);
      }
    } else if (gb < 3072) {
      const int c = gb - 2048 + 2 * fr, head = c >> 6, d = c & 63;
#pragma unroll
      for (int j = 0; j < 4; ++j) {
        const int row = row0 + j;
        float* o = (row < TP) ? ea.f2 + (size_t)row * 1024 + c : ea.f3 + (size_t)(row - TP) * 1024 + c;
        *(float2*)o = make_float2(v0[j], v1[j]);
      }
      size_t off, dstr;
      if (row0 < TP) { int b = row0 >> 13, s = row0 & 8191; off = ((size_t)((b * 16 + head) * 64 + d)) * 8192 + s; dstr = 8192; }
      else { int u = row0 - TP; int b = u >> 4, s = 1024 + (u & 15); off = (size_t)TP * 1024 + ((size_t)((b * 16 + head) * 64 + d)) * SPAD + s; dstr = SPAD; }
      uint2 pk; pk.x = pack2(v0[0], v0[1]); pk.y = pack2(v0[2], v0[3]); *(uint2*)(ea.b2 + off) = pk;
      pk.x = pack2(v1[0], v1[1]); pk.y = pack2(v1[2], v1[3]); *(uint2*)(ea.b2 + off + dstr) = pk;
    } else if (gb < 3584) {
      const int c = gb - 3072 + 2 * fr;
#pragma unroll
      for (int j = 0; j < 4; ++j) *(unsigned*)(ea.b3 + (size_t)(row0 + j) * 512 + c) = pack2(v0[j] * 0.125f, v1[j] * 0.125f);
    } else if (gb < 3648) {
      const int c = gb - 3584 + 2 * fr;
#pragma unroll
      for (int j = 0; j < 4; ++j) *(float2*)(ea.f4 + (size_t)(row0 + j) * 64 + c) = make_float2(v0[j], v1[j]);
    } else if (gb == 3648) {
      if (fr < 4) {
#pragma unroll
        for (int j = 0; j < 4; ++j) *(float2*)(ea.f5 + (size_t)(row0 + j) * 8 + 2 * fr) = make_float2(v0[j] * 0.35355339059327379f, v1[j] * 0.35355339059327379f);
      }
    }
  }
}

template <int EPI, bool ATOM>
DI void gemm256_tile(const bf16_t* __restrict__ A, const bf16_t* __restrict__ Bt, const int K, const int kt0, const int nt, const int brow, const int bcol,
                     const EArgs& ea, unsigned char* smem, int wv) {
  bf16_t* shm = (bf16_t*)smem;
  const int tid = ltid(wv);
#define SA(b, h) (shm + ((b) * 2 + (h)) * G_HT)
#define SB(b, h) (shm + (4 + (b) * 2 + (h)) * G_HT)
#define STAGE(P, BASE, br, kt) do { const char* _gb = (const char*)((BASE) + (long)(br) * K + (long)((kt) + kt0) * 64); \
    __builtin_amdgcn_global_load_lds((const unsigned*)(_gb + voff0), (LAS unsigned*)((char*)(P) + tid * 16), 16, 0, 0); \
    __builtin_amdgcn_global_load_lds((const unsigned*)(_gb + voff1), (LAS unsigned*)((char*)(P) + tid * 16 + 8192), 16, 0, 0); } while (0)
#define LDA(dst, b, h) _Pragma("unroll") for (int m = 0; m < 4; ++m) _Pragma("unroll") for (int k = 0; k < 2; ++k) \
    dst[m][k] = *reinterpret_cast<const bf16x8*>((char*)SA(b, h) + lds_byte(wr * 64 + m * 16 + fr, k * 32 + fq * 8))
#define LDB(dst, b, h) _Pragma("unroll") for (int n = 0; n < 2; ++n) _Pragma("unroll") for (int k = 0; k < 2; ++k) \
    dst[n][k] = *reinterpret_cast<const bf16x8*>((char*)SB(b, h) + lds_byte(wc * 32 + n * 16 + fr, k * 32 + fq * 8))
#define MMA(ai, bj, At_, Bt_) do { __builtin_amdgcn_s_setprio(1); \
    _Pragma("unroll") for (int m = 0; m < 4; ++m) _Pragma("unroll") for (int n = 0; n < 2; ++n) _Pragma("unroll") for (int k = 0; k < 2; ++k) \
      acc[ai][bj][m][n] = __builtin_amdgcn_mfma_f32_16x16x32_bf16(At_[m][k], Bt_[n][k], acc[ai][bj][m][n], 0, 0, 0); \
    __builtin_amdgcn_s_setprio(0); } while (0)
#define WAIT_V(n) asm volatile("s_waitcnt vmcnt(" #n ")" ::: "memory")
#define WAIT_L(n) asm volatile("s_waitcnt lgkmcnt(" #n ")" ::: "memory")
#define BAR __builtin_amdgcn_s_barrier()
#define SCHED __builtin_amdgcn_sched_barrier(0)
  const int wid = tid >> 6, lane = tid & 63, wr = wid >> 2, wc = wid & 3, fr = lane & 15, fq = lane >> 4;
  unsigned voff0, voff1;
  { int r_, c_; stage_rc(tid * 16, r_, c_); voff0 = (unsigned)(r_ * K + c_) * 2u; stage_rc(tid * 16 + 8192, r_, c_); voff1 = (unsigned)(r_ * K + c_) * 2u; }
  f32x4v acc[2][2][4][2];
#pragma unroll
  for (int a = 0; a < 2; ++a)
#pragma unroll
    for (int b = 0; b < 2; ++b)
#pragma unroll
      for (int m = 0; m < 4; ++m)
#pragma unroll
        for (int n = 0; n < 2; ++n) acc[a][b][m][n] = (f32x4v){0.f, 0.f, 0.f, 0.f};
  bf16x8 At[4][2], B0[2][2], B1[2][2];
  const int HALF = 128;
  WAIT_V(0); WAIT_L(0); BAR;
  STAGE(SB(0, 0), Bt, bcol, 0); STAGE(SA(0, 0), A, brow, 0);
  STAGE(SB(0, 1), Bt, bcol + HALF, 0); STAGE(SA(0, 1), A, brow + HALF, 0);
  if (wr == 1) BAR;
  WAIT_V(4); BAR;
  STAGE(SB(1, 0), Bt, bcol, 1); STAGE(SA(1, 0), A, brow, 1); STAGE(SB(1, 1), Bt, bcol + HALF, 1);
  WAIT_V(6); BAR;
  for (int t = 0; t < nt - 2; t += 2) {
    LDB(B0, 0, 0); SCHED; LDA(At, 0, 0); STAGE(SA(1, 1), A, brow + HALF, t + 1);
    WAIT_L(8); BAR; WAIT_L(0); MMA(0, 0, At, B0); BAR; SCHED;
    LDB(B1, 0, 1); STAGE(SB(0, 0), Bt, bcol, t + 2);
    BAR; WAIT_L(0); MMA(0, 1, At, B1); BAR;
    LDA(At, 0, 1); STAGE(SA(0, 0), A, brow, t + 2);
    BAR; WAIT_L(0); MMA(1, 0, At, B0); BAR; SCHED;
    STAGE(SB(0, 1), Bt, bcol + HALF, t + 2);
    WAIT_V(6); BAR; MMA(1, 1, At, B1); BAR;
    LDB(B0, 1, 0); SCHED; LDA(At, 1, 0); STAGE(SA(0, 1), A, brow + HALF, t + 2);
    WAIT_L(8); BAR; WAIT_L(0); MMA(0, 0, At, B0); BAR; SCHED;
    LDB(B1, 1, 1); STAGE(SB(1, 0), Bt, bcol, t + 3);
    BAR; WAIT_L(0); MMA(0, 1, At, B1); BAR;
    LDA(At, 1, 1); STAGE(SA(1, 0), A, brow, t + 3);
    BAR; WAIT_L(0); MMA(1, 0, At, B0); BAR; SCHED;
    STAGE(SB(1, 1), Bt, bcol + HALF, t + 3);
    WAIT_V(6); BAR; MMA(1, 1, At, B1); BAR;
  }
  { LDB(B0, 0, 0); LDA(At, 0, 0); STAGE(SA(1, 1), A, brow + HALF, nt - 1);
    BAR; WAIT_L(0); MMA(0, 0, At, B0); BAR;
    LDB(B1, 0, 1); BAR; WAIT_L(0); MMA(0, 1, At, B1); BAR;
    LDA(At, 0, 1); WAIT_V(4); BAR; WAIT_L(0); MMA(1, 0, At, B0); MMA(1, 1, At, B1); BAR; }
  { LDB(B0, 1, 0); LDA(At, 1, 0); WAIT_V(2); BAR; WAIT_L(0); MMA(0, 0, At, B0); BAR;
    LDB(B1, 1, 1); WAIT_V(0); BAR; WAIT_L(0); MMA(0, 1, At, B1); BAR;
    LDA(At, 1, 1); BAR; WAIT_L(0); MMA(1, 0, At, B0); MMA(1, 1, At, B1); BAR; }
  if (wr == 0) BAR;
#pragma unroll
  for (int ai = 0; ai < 2; ++ai)
#pragma unroll
    for (int bj = 0; bj < 2; ++bj)
#pragma unroll
      for (int m = 0; m < 4; ++m)
      { epi16<EPI, ATOM>(ea, brow + ai * 128 + wr * 64 + m * 16 + fq * 4, bcol + bj * 128 + wc * 32, fr, acc[ai][bj][m][0], acc[ai][bj][m][1]); if constexpr (EPI != E_RESID) __builtin_amdgcn_sched_barrier(0); }
#undef SA
#undef SB
#undef STAGE
#undef LDA
#undef LDB
#undef MMA
#undef WAIT_V
#undef WAIT_L
#undef BAR
#undef SCHED
}

DI void tile_map(int t, int nM, int nN, int nwg, int& pm, int& pn) {
  int wgid = t;
  { int q = nwg >> 3, r = nwg & 7, xcd = wgid & 7, off = wgid >> 3; wgid = (xcd < r ? xcd * (q + 1) : r * (q + 1) + (xcd - r) * q) + off; }
  const int nig = 8 * nN, gid = wgid / nig, fm = gid * 8, gsz = min(nM - fm, 8);
  pm = fm + ((wgid % nig) % gsz); pn = (wgid % nig) / gsz;
}
template <int EPI>
DI void gemm_phase(const bf16_t* A, const bf16_t* Bt, int M, int N, int K, const EArgs& ea,
                   unsigned char* smem, int tstart, int bid, int nblk, int wv) {
  const int nM = M >> 8, nN = N >> 8, nwg = nM * nN, nt = K >> 6;
  if constexpr (EPI == E_RESID) {
    const int nfull = (nwg / nblk) * nblk, rem = nwg - nfull;
    for (int t = bid; t < nfull; t += nblk) {
      int pm, pn; tile_map(t, nM, nN, nwg, pm, pn);
      gemm256_tile<EPI, false>(A, Bt, K, 0, nt, pm * 256, pn * 256, ea, smem, wv);
    }
    if (rem > 0) {
      int ns = nblk / rem; if (ns > (nt >> 3)) ns = nt >> 3; if (ns < 1) ns = 1;
      const int per = ((nt / ns) >> 1) << 1;
      for (int u = bid; u < rem * ns; u += nblk) {
        const int t = nfull + u / ns, ks = u % ns;
        const int k0 = ks * per, kn = (ks == ns - 1) ? (nt - k0) : per;
        int pm, pn; tile_map(t, nM, nN, nwg, pm, pn);
        gemm256_tile<EPI, true>(A, Bt, K, k0, kn, pm * 256, pn * 256, ea, smem, wv);
      }
    }
  } else {
    int t0 = bid - (tstart % nblk); if (t0 < 0) t0 += nblk;
    for (int t = t0; t < nwg; t += nblk) {
      int pm, pn; tile_map(t, nM, nN, nwg, pm, pn);
      gemm256_tile<EPI, false>(A, Bt, K, 0, nt, pm * 256, pn * 256, ea, smem, wv);
    }
  }
}

DI void rmsnorm_rows(const float* __restrict__ X, const float* __restrict__ g, bf16_t* __restrict__ H, float* outp, float* outs,
                     int bid, int nblk, int wv) {
  const int lane = ltid(wv) & 63, w = ltid(wv) >> 6;
  for (int row = bid * 8 + w; row < T; row += nblk * 8) {
    const float* xr = X + (size_t)row * 1024;
    float4 v[4];
    float ss = 0.f;
#pragma unroll
    for (int c = 0; c < 4; ++c) { v[c] = *(const float4*)(xr + c * 256 + lane * 4); ss += v[c].x * v[c].x + v[c].y * v[c].y + v[c].z * v[c].z + v[c].w * v[c].w; }
    ss = wave_sum(ss, lane);
    float r = rsqrtf(ss * (1.f / 1024.f) + EPS);
#pragma unroll
    for (int c = 0; c < 4; ++c) {
      int col = c * 256 + lane * 4;
      float4 gg = *(const float4*)(g + col);
      float a = v[c].x * r * gg.x, b = v[c].y * r * gg.y, cc = v[c].z * r * gg.z, d = v[c].w * r * gg.w;
      if (H) { uint2 pk; pk.x = pack2(a, b); pk.y = pack2(cc, d); *(uint2*)(H + (size_t)row * 1024 + col) = pk; }
      else {
        float* o = (row < TP) ? outp + (size_t)row * 1024 + col : outs + (size_t)(row - TP) * 1024 + col;
        *(float4*)o = make_float4(a, b, cc, d);
      }
    }
  }
}

DI void mla_rowops(PREF p, int j, int bid, int nblk, int wv) {
  const int lane = ltid(wv) & 63, w = ltid(wv) >> 6;
  unsigned char* R = p.ws + OFF_R;
  const float* RAW = (const float*)(R + R_RAW);
  bf16_t* CQ = (bf16_t*)(R + R_CQ); bf16_t* CKV = (bf16_t*)(R + R_CKV); bf16_t* KR = (bf16_t*)(R + R_KR);
  const float* gq = p.in[11] + j * 512; const float* gkv = p.in[14] + j * 256;
  const float* rope = (const float*)(p.ws + OFF_ROPE);
  for (int row = bid * 8 + w; row < T; row += nblk * 8) {
    const float* rr = RAW + (size_t)row * 1024;
    float4 a0 = *(const float4*)(rr + lane * 4), a1 = *(const float4*)(rr + 256 + lane * 4);
    float4 c0 = *(const float4*)(rr + 512 + lane * 4);
    float ss = a0.x * a0.x + a0.y * a0.y + a0.z * a0.z + a0.w * a0.w + a1.x * a1.x + a1.y * a1.y + a1.z * a1.z + a1.w * a1.w;
    float s2 = c0.x * c0.x + c0.y * c0.y + c0.z * c0.z + c0.w * c0.w;
    ss = wave_sum(ss, lane); s2 = wave_sum(s2, lane);
    float r1 = rsqrtf(ss * (1.f / 512.f) + EPS), r2 = rsqrtf(s2 * (1.f / 256.f) + EPS);
    {
      float4 g0 = *(const float4*)(gq + lane * 4), g1 = *(const float4*)(gq + 256 + lane * 4);
      uint2 pk; pk.x = pack2(a0.x * r1 * g0.x, a0.y * r1 * g0.y); pk.y = pack2(a0.z * r1 * g0.z, a0.w * r1 * g0.w);
      *(uint2*)(CQ + (size_t)row * 512 + lane * 4) = pk;
      pk.x = pack2(a1.x * r1 * g1.x, a1.y * r1 * g1.y); pk.y = pack2(a1.z * r1 * g1.z, a1.w * r1 * g1.w);
      *(uint2*)(CQ + (size_t)row * 512 + 256 + lane * 4) = pk;
    }
    const int rm = rowmap(row);
    {
      float4 g = *(const float4*)(gkv + lane * 4);
      float4 o = make_float4(c0.x * r2 * g.x, c0.y * r2 * g.y, c0.z * r2 * g.z, c0.w * r2 * g.w);
      float* op = (row < TP) ? p.out + O_CKVP + ((size_t)j * TP + row) * 256 : p.out + O_CKVS + ((size_t)j * TS + (row - TP)) * 256;
      *(float4*)(op + lane * 4) = o;
      uint2 pk; pk.x = pack2(o.x, o.y); pk.y = pack2(o.z, o.w);
      *(uint2*)(CKV + (size_t)rm * 256 + lane * 4) = pk;
    }
    if (lane < 16) {
      float x1 = rr[768 + lane], x2 = rr[784 + lane];
      int pos = tokpos(row);
      float2 cs = *(const float2*)(rope + ((size_t)pos * 16 + lane) * 2);
      float o1 = x1 * cs.x - x2 * cs.y, o2 = x1 * cs.y + x2 * cs.x;
      float* op = (row < TP) ? p.out + O_KRP + ((size_t)j * TP + row) * 32 : p.out + O_KRS + ((size_t)j * TS + (row - TP)) * 32;
      op[lane] = o1; op[16 + lane] = o2;
      KR[(size_t)rm * 32 + lane] = tobf(o1); KR[(size_t)rm * 32 + 16 + lane] = tobf(o2);
    }
  }
}

DI void dsa_rowops(PREF p, int bid, int nblk, int wv) {
  const int lane = ltid(wv) & 63, w = ltid(wv) >> 6;
  unsigned char* R = p.ws + OFF_R;
  const float* KIR = (const float*)(R + D_KIR);
  bf16_t* KI = (bf16_t*)(R + D_KI);
  const float* g = p.in[27];
  for (int row = bid * 8 + w; row < T; row += nblk * 8) {
    float v = KIR[(size_t)row * 64 + lane];
    float ss = wave_sum(v * v, lane);
    float r = rsqrtf(ss * (1.f / 64.f) + EPS);
    float o = v * r * g[lane];
    if (row < TP) p.out[O_DIP + (size_t)row * 64 + lane] = o; else p.out[O_DIS + (size_t)(row - TP) * 64 + lane] = o;
    KI[(size_t)rowmap(row) * 64 + lane] = tobf(o);
  }
}

DI void cmlp_ln_rows(PREF p, int bid, int nblk, int wv) {
  const int lane = ltid(wv) & 63, w = ltid(wv) >> 6;
  unsigned char* R = p.ws + OFF_R;
  const bf16_t* VR = (const bf16_t*)(R + C_VR);
  bf16_t* VLN = (bf16_t*)(R + C_VLN);
  const float* g = p.in[18]; const float* bb = p.in[19];
  for (int row = bid * 8 + w; row < T; row += nblk * 8) {
    float x[32];
    float sum = 0.f;
#pragma unroll
    for (int c = 0; c < 4; ++c) {
      uint4 u = *(const uint4*)(VR + (size_t)row * 2048 + c * 512 + lane * 8);
      x[c * 8 + 0] = bflo(u.x); x[c * 8 + 1] = bfhi(u.x); x[c * 8 + 2] = bflo(u.y); x[c * 8 + 3] = bfhi(u.y);
      x[c * 8 + 4] = bflo(u.z); x[c * 8 + 5] = bfhi(u.z); x[c * 8 + 6] = bflo(u.w); x[c * 8 + 7] = bfhi(u.w);
    }
#pragma unroll
    for (int i = 0; i < 32; ++i) sum += x[i];
    sum = wave_sum(sum, lane);
    float mu = sum * (1.f / 2048.f);
    float vs = 0.f;
#pragma unroll
    for (int i = 0; i < 32; ++i) { x[i] -= mu; vs += x[i] * x[i]; }
    vs = wave_sum(vs, lane);
    float r = rsqrtf(vs * (1.f / 2048.f) + EPS);
#pragma unroll
    for (int c = 0; c < 4; ++c) {
      int col = c * 512 + lane * 8;
      float y[8];
#pragma unroll
      for (int q = 0; q < 2; ++q) {
        float4 gg = *(const float4*)(g + col + q * 4), b4 = *(const float4*)(bb + col + q * 4);
        y[q * 4 + 0] = x[c * 8 + q * 4 + 0] * r * gg.x + b4.x; y[q * 4 + 1] = x[c * 8 + q * 4 + 1] * r * gg.y + b4.y;
        y[q * 4 + 2] = x[c * 8 + q * 4 + 2] * r * gg.z + b4.z; y[q * 4 + 3] = x[c * 8 + q * 4 + 3] * r * gg.w + b4.w;
      }
      uint4 pk; pk.x = pack2(y[0], y[1]); pk.y = pack2(y[2], y[3]); pk.z = pack2(y[4], y[5]); pk.w = pack2(y[6], y[7]);
      *(uint4*)(VLN + (size_t)row * 2048 + col) = pk;
      if (row >= TP) {
        float* o = p.out + O_CVS + (size_t)(row - TP) * 2048 + col;
        *(float4*)o = make_float4(y[0], y[1], y[2], y[3]); *(float4*)(o + 4) = make_float4(y[4], y[5], y[6], y[7]);
      }
    }
  }
}

DI void cmlp_mix_phase(PREF p, unsigned char* smem, int bid, int nblk, int wv) {
  const int tid = ltid(wv), lane = tid & 63, w = tid >> 6, wm = w >> 2, wn = w & 3, lr = lane & 31, lh = lane >> 5;
  unsigned char* R = p.ws + OFF_R;
  const bf16_t* U = (const bf16_t*)(R + C_U);
  const bf16_t* VLN = (const bf16_t*)(R + C_VLN);
  bf16_t* G = (bf16_t*)(R + C_G);
  const bf16_t* WT = (const bf16_t*)(p.ws + OFF_W) + W_TRIL;
  const float* bs = p.in[21];
  bf16_t* As = (bf16_t*)smem;
  bf16_t* Bs = As + 128 * 136;
  for (int u = bid; u < 1024; u += nblk) {
    const int g = u & 7, ch = u >> 3;
    const int col0 = g * 256;
#pragma unroll 2
    for (int i = 0; i < 4; ++i) {
      int v = tid + i * NT; int r = v >> 4, c = (v & 15) * 8;
      *(uint4*)(As + r * 136 + c) = *(const uint4*)(WT + ((size_t)g * 128 + r) * 128 + c);
    }
#pragma unroll 2
    for (int i = 0; i < 8; ++i) {
      int v = tid + i * NT; int s = v >> 5, c = (v & 31) * 8;
      uint4 x = *(const uint4*)(VLN + ((size_t)ch * 128 + s) * 2048 + col0 + c);
      Bs[(c + 0) * 136 + s] = (bf16_t)(x.x & 0xffff); Bs[(c + 1) * 136 + s] = (bf16_t)(x.x >> 16);
      Bs[(c + 2) * 136 + s] = (bf16_t)(x.y & 0xffff); Bs[(c + 3) * 136 + s] = (bf16_t)(x.y >> 16);
      Bs[(c + 4) * 136 + s] = (bf16_t)(x.z & 0xffff); Bs[(c + 5) * 136 + s] = (bf16_t)(x.z >> 16);
      Bs[(c + 6) * 136 + s] = (bf16_t)(x.w & 0xffff); Bs[(c + 7) * 136 + s] = (bf16_t)(x.w >> 16);
    }
    __syncthreads();
    f32x16 acc[2][2];
#pragma unroll
    for (int a = 0; a < 2; ++a)
#pragma unroll
      for (int b = 0; b < 2; ++b)
#pragma unroll
        for (int i = 0; i < 16; ++i) acc[a][b][i] = 0.f;
    const bf16_t* Asb = As + (wm * 64 + lr) * 136 + lh * 8;
    const bf16_t* Bsb = Bs + (wn * 64 + lr) * 136 + lh * 8;
    const int ns = (wm + 1) * 4;
    for (int s = 0; s < ns; ++s) {
      bf16x8 a0 = *(const bf16x8*)(Asb + s * 16);
      bf16x8 a1 = *(const bf16x8*)(Asb + 32 * 136 + s * 16);
      bf16x8 b0 = *(const bf16x8*)(Bsb + s * 16);
      bf16x8 b1 = *(const bf16x8*)(Bsb + 32 * 136 + s * 16);
      acc[0][0] = MFMA32(a0, b0, acc[0][0]);
      acc[0][1] = MFMA32(a0, b1, acc[0][1]);
      acc[1][0] = MFMA32(a1, b0, acc[1][0]);
      acc[1][1] = MFMA32(a1, b1, acc[1][1]);
    }
#pragma unroll
    for (int mi = 0; mi < 2; ++mi)
#pragma unroll
      for (int ni = 0; ni < 2; ++ni)
#pragma unroll
        for (int i = 0; i < 16; ++i) {
          int t = wm * 64 + mi * 32 + crow(i, lh);
          int col = col0 + wn * 64 + ni * 32 + lr;
          size_t off = ((size_t)ch * 128 + t) * 2048 + col;
          float mixed = acc[mi][ni][i] + bs[g * 128 + t];
          G[off] = tobf(frombf(U[off]) * mixed);
        }
    __syncthreads();
  }
  const float* wsf = p.in[20];
  for (int e = bid * NT + tid; e < TS * 2048; e += nblk * NT) {
    int row = e >> 11, col = e & 2047, b = row >> 4, t = row & 15, g = col >> 8;
    float a = bs[g * 128 + t];
    for (int s = 0; s <= t; ++s) a += wsf[((size_t)g * 128 + t) * 128 + s] * frombf(VLN[((size_t)TP + b * 16 + s) * 2048 + col]);
    size_t off = ((size_t)TP + row) * 2048 + col;
    G[off] = tobf(frombf(U[off]) * a);
  }
}

template <int DQK, bool IS_MLA, bool MASKED>
DI void attn8_unit(const bf16_t* __restrict__ Qp, int ldq, int nq,
                   const bf16_t* __restrict__ Kp, int ldk, const bf16_t* __restrict__ KRp,
                   const bf16_t* __restrict__ Vtp, int ldv, int kmax,
                   int nit, int nk64_w, int nkeys, const unsigned* __restrict__ BMp,
                   bf16_t* __restrict__ AOp, unsigned char* smem, int wv) {
  constexpr int KS = DQK + 8;
  constexpr int VS = 136;
  constexpr int NQS = DQK / 16;
  const int tid = ltid(wv), lane = tid & 63, w = tid >> 6, lr = lane & 31, lh = lane >> 5;
  bf16_t* Ks = (bf16_t*)smem;
  bf16_t* Vs = Ks + 2 * 128 * KS;
  const bool q_ok = (w * 32 + lr) < nq;
  const int qrow = q_ok ? (w * 32 + lr) : 0;
  bf16x8 qf[NQS];
#pragma unroll
  for (int s = 0; s < NQS; ++s) qf[s] = *(const bf16x8*)(Qp + (size_t)qrow * ldq + s * 16 + lh * 8);
  f32x16 oacc[2];
#pragma unroll
  for (int d = 0; d < 2; ++d)
#pragma unroll
    for (int i = 0; i < 16; ++i) oacc[d][i] = 0.f;
  float m_run = -INFINITY, l_run = 0.f;
  const int kkey = tid >> 3, kc = (tid & 7) * 8;
  const int rkey = tid >> 2, rc = (tid & 3) * 8;
  const int vd = tid >> 4, vk = (tid & 15) * 8;
  const int vpos = (vk & 96) + ((vk >> 4) & 1) * 16 + ((vk >> 3) & 1) * 4;
  uint4 rk0, rk1, rr, rv0, rv1;
  rr = make_uint4(0, 0, 0, 0);
  uint4 bm_next = make_uint4(0xffffffffu, 0xffffffffu, 0xffffffffu, 0xffffffffu), bm_cur = bm_next;
#define GLOAD(it_) do { const int key0_ = (it_) * 128; \
    { int kr_ = min(key0_ + kkey, kmax - 1); rk0 = *(const uint4*)(Kp + (size_t)kr_ * ldk + kc); } \
    { int kr_ = min(key0_ + kkey + 64, kmax - 1); rk1 = *(const uint4*)(Kp + (size_t)kr_ * ldk + kc); } \
    if constexpr (IS_MLA) { int kr_ = min(key0_ + rkey, kmax - 1); rr = *(const uint4*)(KRp + (size_t)kr_ * 32 + rc); } \
    { int kv_ = min(key0_ + vk, kmax - 8); rv0 = *(const uint4*)(Vtp + (size_t)vd * ldv + kv_); rv1 = *(const uint4*)(Vtp + (size_t)(vd + 32) * ldv + kv_); } \
    if constexpr (MASKED) { if (BMp) bm_next = *(const uint4*)(BMp + (size_t)qrow * 256 + (it_) * 4); } } while (0)
#define SSTORE(buf_) do { bf16_t* Kb_ = Ks + (buf_) * 128 * KS; bf16_t* Vb_ = Vs + (buf_) * 64 * VS; \
    *(uint4*)(Kb_ + kkey * KS + kc) = rk0; *(uint4*)(Kb_ + (kkey + 64) * KS + kc) = rk1; \
    if constexpr (IS_MLA) *(uint4*)(Kb_ + rkey * KS + 64 + rc) = rr; \
    *(uint2*)(Vb_ + vd * VS + vpos) = make_uint2(rv0.x, rv0.y); *(uint2*)(Vb_ + vd * VS + vpos + 8) = make_uint2(rv0.z, rv0.w); \
    *(uint2*)(Vb_ + (vd + 32) * VS + vpos) = make_uint2(rv1.x, rv1.y); *(uint2*)(Vb_ + (vd + 32) * VS + vpos + 8) = make_uint2(rv1.z, rv1.w); } while (0)
  const int nit_w = (nk64_w + 1) >> 1;
  __syncthreads();
  GLOAD(0); SSTORE(0); bm_cur = bm_next;
  __syncthreads();
  for (int it = 0; it < nit; ++it) {
    const int buf = it & 1;
    if (it + 1 < nit) GLOAD(it + 1);
    if (it < nit_w) {
      const bf16_t* Kb = Ks + buf * 128 * KS; const bf16_t* Vb = Vs + buf * 64 * VS;
      f32x16 sacc[4];
#pragma unroll
      for (int t4 = 0; t4 < 4; ++t4) {
#pragma unroll
        for (int i = 0; i < 16; ++i) sacc[t4][i] = 0.f;
#pragma unroll
        for (int s = 0; s < NQS; ++s) {
          bf16x8 kf = *(const bf16x8*)(Kb + (t4 * 32 + lr) * KS + s * 16 + lh * 8);
          sacc[t4] = MFMA32(kf, qf[s], sacc[t4]);
        }
      }
      if ((2 * it + 1) >= nk64_w) {
#pragma unroll
        for (int t4 = 2; t4 < 4; ++t4)
#pragma unroll
          for (int i = 0; i < 16; ++i) sacc[t4][i] = -INFINITY;
      }
      float mx = -INFINITY;
#pragma unroll
      for (int t4 = 0; t4 < 4; ++t4) {
        const unsigned wbits = (t4 == 0) ? bm_cur.x : (t4 == 1) ? bm_cur.y : (t4 == 2) ? bm_cur.z : bm_cur.w;
#pragma unroll
        for (int i = 0; i < 16; ++i) {
          if constexpr (MASKED) {
            const int kin = crow(i, lh);
            const int key = it * 128 + t4 * 32 + kin;
            bool ok = (key < nkeys) && ((wbits >> kin) & 1u);
            sacc[t4][i] = ok ? sacc[t4][i] : -INFINITY;
          }
          mx = fmaxf(mx, sacc[t4][i]);
        }
      }
      mx = fmaxf(mx, shflx(mx, 32, lane));
      const float m_new = fmaxf(m_run, mx);
      const float m_safe = (m_new == -INFINITY) ? 0.f : m_new;
      const float alpha = __builtin_amdgcn_exp2f(m_run - m_safe);
      m_run = m_new;
      float ls = 0.f;
#pragma unroll
      for (int t4 = 0; t4 < 4; ++t4)
#pragma unroll
        for (int i = 0; i < 16; ++i) { float pv = __builtin_amdgcn_exp2f(sacc[t4][i] - m_safe); sacc[t4][i] = pv; ls += pv; }
      l_run = l_run * alpha + ls;
#pragma unroll
      for (int d = 0; d < 2; ++d)
#pragma unroll
        for (int i = 0; i < 16; ++i) oacc[d][i] *= alpha;
#pragma unroll
      for (int t4 = 0; t4 < 4; ++t4)
#pragma unroll
        for (int s = 0; s < 2; ++s) {
          uint4 pp;
          pp.x = pack2(sacc[t4][8 * s + 0], sacc[t4][8 * s + 1]);
          pp.y = pack2(sacc[t4][8 * s + 2], sacc[t4][8 * s + 3]);
          pp.z = pack2(sacc[t4][8 * s + 4], sacc[t4][8 * s + 5]);
          pp.w = pack2(sacc[t4][8 * s + 6], sacc[t4][8 * s + 7]);
          bf16x8 pf = __builtin_bit_cast(bf16x8, pp);
#pragma unroll
          for (int dt = 0; dt < 2; ++dt) {
            bf16x8 vf = *(const bf16x8*)(Vb + (dt * 32 + lr) * VS + t4 * 32 + 16 * s + 8 * lh);
            oacc[dt] = MFMA32(vf, pf, oacc[dt]);
          }
        }
    }
    if (it + 1 < nit) { SSTORE(buf ^ 1); bm_cur = bm_next; }
    __syncthreads();
  }
  if (nit_w > 0) {
    float lt = l_run + shflx(l_run, 32, lane);
    float inv = lt > 0.f ? 1.f / lt : 0.f;
    if (q_ok) {
      bf16_t* orow = AOp + (size_t)(w * 32 + lr) * 1024;
#pragma unroll
      for (int dt = 0; dt < 2; ++dt)
#pragma unroll
        for (int g = 0; g < 4; ++g) {
          uint2 pk;
          pk.x = pack2(oacc[dt][4 * g] * inv, oacc[dt][4 * g + 1] * inv);
          pk.y = pack2(oacc[dt][4 * g + 2] * inv, oacc[dt][4 * g + 3] * inv);
          *(uint2*)(orow + dt * 32 + 8 * g + 4 * lh) = pk;
        }
    }
  }
}
#undef GLOAD
#undef SSTORE

DI int snake_idx(int i, int bid, int nblk) { return i * nblk + ((i & 1) ? (nblk - 1 - bid) : bid); }

template <bool IS_MLA>
DI void attn_phase(PREF p, unsigned char* smem, int bid, int nblk, int wv) {
  unsigned char* R = p.ws + OFF_R;
  const int w = ltid(wv) >> 6;
  const int total = 1024 + 512;
  for (int i = 0; i * nblk < total; ++i) {
    int u = snake_idx(i, bid, nblk);
    if (u >= total) continue;
    if constexpr (IS_MLA) {
      const bf16_t* Q = (const bf16_t*)(R + R_Q); const bf16_t* KN = (const bf16_t*)(R + R_KN);
      const bf16_t* KR = (const bf16_t*)(R + R_KR); const bf16_t* VT = (const bf16_t*)(R + R_VT);
      bf16_t* AO = (bf16_t*)(R + R_RAW);
      if (u < 1024) {
        int qt = 31 - (u >> 5), bh = u & 31, b = bh >> 4, h = bh & 15;
        int q0 = b * 8192 + qt * 256;
        attn8_unit<96, true, false>(Q + (size_t)q0 * 1536 + h * 96, 1536, 256,
                                    KN + (size_t)(b * 8192) * 1024 + h * 64, 1024, KR + (size_t)(b * 8192) * 32,
                                    VT + (size_t)((b * 16 + h) * 64) * 8192, 8192, 8192,
                                    2 * qt + 2, 4 * qt + 1 + (w >> 1), 1 << 30, nullptr,
                                    AO + (size_t)q0 * 1024 + h * 64, smem, wv);
      } else {
        int v = u - 1024, b = v >> 4, h = v & 15;
        int q0 = TP + b * 16;
        attn8_unit<96, true, true>(Q + (size_t)q0 * 1536 + h * 96, 1536, 16,
                                   KN + (size_t)(TP + b * SPAD) * 1024 + h * 64, 1024, KR + (size_t)(TP + b * SPAD) * 32,
                                   VT + (size_t)TP * 1024 + (size_t)((b * 16 + h) * 64) * SPAD, SPAD, SPAD,
                                   9, (w == 0) ? 17 : 0, NKS, nullptr,
                                   AO + (size_t)q0 * 1024 + h * 64, smem, wv);
      }
    } else {
      const bf16_t* Q = (const bf16_t*)(R + D_Q); const bf16_t* KK = (const bf16_t*)(R + D_K);
      const bf16_t* VT = (const bf16_t*)(R + D_VT); const unsigned* BM = (const unsigned*)(R + D_BM);
      bf16_t* AO = (bf16_t*)(R + D_AO);
      if (u < 1024) {
        int qt = 31 - (u >> 5), bh = u & 31, b = bh >> 4, h = bh & 15;
        int q0 = b * 8192 + qt * 256;
        attn8_unit<64, false, true>(Q + (size_t)q0 * 1024 + h * 64, 1024, 256,
                                    KK + (size_t)(b * 8192) * 1024 + h * 64, 1024, nullptr,
                                    VT + (size_t)((b * 16 + h) * 64) * 8192, 8192, 8192,
                                    2 * qt + 2, 4 * qt + 1 + (w >> 1), 1 << 30, BM + (size_t)q0 * 256,
                                    AO + (size_t)q0 * 1024 + h * 64, smem, wv);
      } else {
        int v = u - 1024, b = v >> 4, h = v & 15;
        int q0 = TP + b * 16;
        attn8_unit<64, false, true>(Q + (size_t)q0 * 1024 + h * 64, 1024, 16,
                                    KK + (size_t)(TP + b * SPAD) * 1024 + h * 64, 1024, nullptr,
                                    VT + (size_t)TP * 1024 + (size_t)((b * 16 + h) * 64) * SPAD, SPAD, SPAD,
                                    9, (w == 0) ? 17 : 0, NKS, BM + (size_t)q0 * 256,
                                    AO + (size_t)q0 * 1024 + h * 64, smem, wv);
      }
    }
  }
}

constexpr int CAP = 128;
DI int score_bin(float s) {
  unsigned u = __float_as_uint(s);
  int e = (int)((u & 0x7fffffffu) >> 19);
  int m = min(max(e, 1840), 2095) - 1840;
  return (u >> 31) ? (255 - m) : (256 + m);
}

DI void idx_unit(const bf16_t* __restrict__ QI, const float* __restrict__ WI, int q_row0, int nq,
                 const bf16_t* __restrict__ KI, int L, unsigned* __restrict__ BM, unsigned char* smem, int wv) {
  const int tid = ltid(wv), lane = tid & 63, w = tid >> 6, lr = lane & 31, lh = lane >> 5;
  bf16_t* Qs = (bf16_t*)smem;
  float* Ws = (float*)(smem + 36864);
  unsigned* hist = (unsigned*)(smem + 36864 + 1024);
  float* cand_s = (float*)hist;
  int* cand_i = (int*)(smem + 36864 + 1024 + 16384);
  int* bstar = (int*)(smem + 36864 + 1024 + 32768);
  int* need = bstar + 32;
  int* ncand = need + 32;
  __syncthreads();
#pragma unroll
  for (int i = 0; i < 4; ++i) {
    int v = tid + i * NT;
    int hd = v >> 8, q = (v >> 3) & 31, c = (v & 7) * 8;
    int qq = q < nq ? q : 0;
    *(uint4*)(Qs + (hd * 32 + q) * 72 + c) = *(const uint4*)(QI + (size_t)(q_row0 + qq) * 512 + hd * 64 + c);
  }
  if (tid < 256) { int hd = tid >> 5, q = tid & 31; int qq = q < nq ? q : 0; Ws[hd * 32 + q] = WI[(size_t)(q_row0 + qq) * 8 + hd]; }
  for (int i = tid; i < 32 * 256; i += NT) hist[i] = 0u;
  if (tid < 32) { bstar[tid] = -1; need[tid] = 0; ncand[tid] = 0; }
  __syncthreads();
  const int ntile = (L + 255) >> 8;
  const bool do_select = L > 256;
  int bsr[16];
  { int m1_ = -1; asm volatile("" : "+v"(m1_));
#pragma unroll
    for (int i = 0; i < 16; ++i) bsr[i] = m1_; }
  for (int pass = do_select ? 0 : 1; pass < 2; ++pass) {
    if (pass == 1) {
#pragma unroll
      for (int i = 0; i < 16; ++i) bsr[i] = bstar[crow(i, lh)];
    }
    bf16x8 kn0, kn1, kn2, kn3;
    { const bf16_t* kp = KI + (size_t)(w * 32 + lr) * 64 + lh * 8;
      kn0 = *(const bf16x8*)(kp); kn1 = *(const bf16x8*)(kp + 16); kn2 = *(const bf16x8*)(kp + 32); kn3 = *(const bf16x8*)(kp + 48); }
    for (int kt = 0; kt < ntile; ++kt) {
      const int key0 = kt * 256 + w * 32;
      bf16x8 kf[4];
      kf[0] = kn0; kf[1] = kn1; kf[2] = kn2; kf[3] = kn3;
      if (key0 + 256 < L) {
        const bf16_t* kp = KI + (size_t)(key0 + 256 + lr) * 64 + lh * 8;
        kn0 = *(const bf16x8*)(kp); kn1 = *(const bf16x8*)(kp + 16); kn2 = *(const bf16x8*)(kp + 32); kn3 = *(const bf16x8*)(kp + 48);
      }
      if (key0 < L) {
        const int key = key0 + lr;
        float sc[16];
#pragma unroll
        for (int i = 0; i < 16; ++i) sc[i] = 0.f;
#pragma unroll 1
        for (int hd = 0; hd < 8; ++hd) {
          f32x16 acc;
#pragma unroll
          for (int i = 0; i < 16; ++i) acc[i] = 0.f;
#pragma unroll
          for (int s = 0; s < 4; ++s) {
            bf16x8 qf = *(const bf16x8*)(Qs + (hd * 32 + lr) * 72 + s * 16 + lh * 8);
            acc = MFMA32(qf, kf[s], acc);
          }
#pragma unroll
          for (int g = 0; g < 4; ++g) {
            float4 wv = *(const float4*)(Ws + hd * 32 + 8 * g + 4 * lh);
            sc[4 * g + 0] += wv.x * fmaxf(acc[4 * g + 0], 0.f);
            sc[4 * g + 1] += wv.y * fmaxf(acc[4 * g + 1], 0.f);
            sc[4 * g + 2] += wv.z * fmaxf(acc[4 * g + 2], 0.f);
            sc[4 * g + 3] += wv.w * fmaxf(acc[4 * g + 3], 0.f);
          }
        }
        const bool kvalid = key < L;
        if (pass == 0) {
#pragma unroll
          for (int i = 0; i < 16; ++i) {
            int q = crow(i, lh);
            if (kvalid) { int b = score_bin(sc[i]); atomicAdd(&hist[q * 256 + (b >> 1)], (b & 1) ? 65536u : 1u); }
          }
        } else {
          unsigned myword = 0u, cmask = 0u;
          unsigned long long any = 0ull;
#pragma unroll
          for (int i = 0; i < 16; ++i) {
            const int b = score_bin(sc[i]);
            const int bs = bsr[i];
            const bool sel = kvalid && (b > bs);
            const bool cnd = kvalid && (b == bs);
            const unsigned long long bal = __ballot(sel);
            myword = (lr == i) ? (unsigned)(bal >> (32 * lh)) : myword;
            any |= __ballot(cnd);
            cmask |= cnd ? (1u << i) : 0u;
          }
          if (lr < 16 && crow(lr, lh) < nq) BM[(size_t)(q_row0 + crow(lr, lh)) * 256 + (key0 >> 5)] = myword;
          if (any != 0ull) {
            int base[16];
#pragma unroll
            for (int i = 0; i < 16; ++i) {
              const unsigned long long cbi = __ballot((cmask >> i) & 1u);
              base[i] = 0;
              if (lr == 0) base[i] = atomicAdd(&ncand[crow(i, lh)], __popc((unsigned)(cbi >> (32 * lh))));
            }
#pragma unroll
            for (int i = 0; i < 16; ++i) {
              const unsigned long long cbi = __ballot((cmask >> i) & 1u);
              const int bb = __builtin_amdgcn_ds_bpermute((lane & 32) << 2, base[i]);
              if ((cmask >> i) & 1u) {
                const unsigned hm = (unsigned)(cbi >> (32 * lh));
                const int pos = bb + __popc(hm & ((1u << lr) - 1u));
                const int q = crow(i, lh);
                if (pos < CAP) { cand_s[q * CAP + pos] = sc[i]; cand_i[q * CAP + pos] = key; }
              }
            }
          }
        }
      }
    }
    __syncthreads();
    if (pass == 0) {
      for (int qi = 0; qi < 4; ++qi) {
        const int q = w * 4 + qi;
        unsigned hw[4];
#pragma unroll
        for (int k = 0; k < 4; ++k) hw[k] = hist[q * 256 + 255 - 4 * lane - k];
        int cnt = 0;
#pragma unroll
        for (int k = 0; k < 4; ++k) cnt += (int)(hw[k] >> 16) + (int)(hw[k] & 0xffffu);
        int pre = cnt;
#pragma unroll
        for (int o = 1; o < 64; o <<= 1) { int t = __builtin_amdgcn_ds_bpermute(((lane - o) & 63) << 2, pre); if (lane >= o) pre += t; }
        unsigned long long bal = __ballot(pre >= 256);
        if (bal != 0ull) {
          int fl = __ffsll((long long)bal) - 1;
          if (lane == fl) {
            int running = pre - cnt;
            int bsel = -1, above = 0;
#pragma unroll
            for (int k = 0; k < 4; ++k) {
              int chi = (int)(hw[k] >> 16), clo = (int)(hw[k] & 0xffffu);
              if (bsel < 0) { if (running + chi >= 256) { bsel = 511 - 8 * lane - 2 * k; above = running; } else running += chi; }
              if (bsel < 0) { if (running + clo >= 256) { bsel = 510 - 8 * lane - 2 * k; above = running; } else running += clo; }
            }
            bstar[q] = bsel; need[q] = 256 - above;
          }
        }
      }
      __syncthreads();
    }
  }
  __threadfence();
  __syncthreads();
  if (do_select) {
    for (int pi = tid; pi < 32 * CAP; pi += NT) {
      int q = pi / CAP, c = pi - q * CAP;
      int n = min(ncand[q], CAP);
      if (c < n && q < nq) {
        float sv = cand_s[q * CAP + c]; int iv = cand_i[q * CAP + c];
        int rank = 0;
        for (int j = 0; j < n; ++j) {
          float sj = cand_s[q * CAP + j]; int ij = cand_i[q * CAP + j];
          rank += (sj > sv || (sj == sv && ij < iv)) ? 1 : 0;
        }
        if (rank < need[q]) atomicOr(&BM[(size_t)(q_row0 + q) * 256 + (iv >> 5)], 1u << (iv & 31));
      }
    }
  }
  __syncthreads();
}

DI void idx_phase(PREF p, unsigned char* smem, int bid, int nblk, int wv) {
  unsigned char* R = p.ws + OFF_R;
  const bf16_t* QI = (const bf16_t*)(R + D_QI); const float* WI = (const float*)(R + D_WI);
  const bf16_t* KI = (const bf16_t*)(R + D_KI); unsigned* BM = (unsigned*)(R + D_BM);
  const int total = 512 + 32;
  for (int i = 0; i * nblk < total; ++i) {
    int idx = snake_idx(i, bid, nblk);
    if (idx >= total) continue;
    if (idx < 512) {
      int qt = 255 - (idx >> 1), b = idx & 1;
      int L = (((qt * 32) >> 6) + 1) * 64;
      idx_unit(QI, WI, b * 8192 + qt * 32, 32, KI + (size_t)(b * 8192) * 64, L, BM, smem, wv);
    } else {
      int b = idx - 512;
      idx_unit(QI, WI, TP + b * 16, 16, KI + (size_t)(TP + b * SPAD) * 64, NKS, BM, smem, wv);
    }
  }
}

DI void cvt8(const float* s, bf16_t* d) {
  float4 a = *(const float4*)s, b = *(const float4*)(s + 4);
  uint4 pk; pk.x = pack2(a.x, a.y); pk.y = pack2(a.z, a.w); pk.z = pack2(b.x, b.y); pk.w = pack2(b.z, b.w);
  *(uint4*)d = pk;
}
DI void cache_rows(const float* __restrict__ src, bf16_t* __restrict__ dst, int Wd, int bid, int nblk, int wv) {
  const int vpr = Wd >> 3;
  const size_t total = (size_t)32 * SPAD * vpr;
  for (size_t e = (size_t)bid * NT + ltid(wv); e < total; e += (size_t)nblk * NT) {
    int c = (int)(e % vpr) * 8; size_t rw = e / vpr; int b = (int)(rw / SPAD), s = (int)(rw % SPAD);
    bf16_t* d = dst + ((size_t)TP + (size_t)b * SPAD + s) * Wd + c;
    if (s < 1024) cvt8(src + ((size_t)b * 1024 + s) * Wd + c, d);
    else if (s >= NKS) { unsigned z = 0; asm volatile("" : "+v"(z)); *(uint4*)d = make_uint4(z, z, z, z); }
  }
}


#define XB_TMO      128
#define XB_XCNT(j)  (256  + 64 * (j))
#define XB_XSUB(j)  (1280 + 64 * (j))
#define XB_XGEN(j)  (2304 + 64 * (j))
#define XB_TOP      3328
#define XB_TOPGEN   3392
#define XCD_BAR_WORDS 3456
#define XB_SPIN_CAP (1u << 18)
DI unsigned xb_ld(unsigned* p)              { return __hip_atomic_load(p, __ATOMIC_RELAXED, __HIP_MEMORY_SCOPE_AGENT); }
DI unsigned xb_add(unsigned* p, unsigned v) { return __hip_atomic_fetch_add(p, v, __ATOMIC_RELAXED, __HIP_MEMORY_SCOPE_AGENT); }
DI unsigned xb_xcc_id() { return (unsigned)__builtin_amdgcn_s_getreg((3 << 11) | 20) & 0xFu; }
#define XB_SPIN(cond, bar) do { unsigned _sp = 0; while (cond) { __builtin_amdgcn_s_sleep(1); \
    if ((++_sp & 255u) == 0u) { if (xb_ld(&(bar)[XB_TMO])) break; if (_sp > XB_SPIN_CAP) { atomicAdd(&(bar)[XB_TMO], 1u); break; } } } } while (0)
struct XcdBarrier { unsigned* bar; unsigned x; volatile __attribute__((address_space(3))) unsigned* st; };
DI void xcd_barrier_complete(unsigned* bar, unsigned x, unsigned G, unsigned& nloc, unsigned& nx) {
  unsigned sum, cnt, mine, sp = 0u;
  for (;;) {
    sum = 0u; cnt = 0u; mine = 0u;
#pragma unroll
    for (unsigned j = 0; j < 16; ++j) { const unsigned c = xb_ld(&bar[XB_XCNT(j)]); sum += c; cnt += (c > 0u) ? 1u : 0u; mine = (j == x) ? c : mine; }
    if (sum == G) break;
    __builtin_amdgcn_s_sleep(1);
    if ((++sp & 255u) == 0u) { if (xb_ld(&bar[XB_TMO])) break; if (sp > XB_SPIN_CAP) { atomicAdd(&bar[XB_TMO], 1u); break; } }
  }
  nloc = mine > 0u ? mine : 1u; nx = cnt > 0u ? cnt : 1u;
}
DI void xcd_barrier(const XcdBarrier& b, int tid, unsigned G) {
  asm volatile("s_waitcnt vmcnt(0)" ::: "memory");
  __syncthreads();
  if (tid == 0) {
    unsigned* bar = b.bar;
    __builtin_amdgcn_s_waitcnt(0);
    unsigned nloc = b.st[0], nx = b.st[1];
    if (nloc == 0u) { xcd_barrier_complete(bar, b.x, G, nloc, nx); b.st[0] = nloc; b.st[1] = nx; }
    const unsigned old = xb_add(&bar[XB_XSUB(b.x)], 1u);
    const unsigned gen = old / nloc;
    if (old + 1u == (gen + 1u) * nloc) {
      __builtin_amdgcn_fence(__ATOMIC_RELEASE, "agent");
      asm volatile("s_waitcnt vmcnt(0)" ::: "memory");
      const unsigned og = xb_add(&bar[XB_TOP], 1u);
      const unsigned tg = og / nx;
      if (og + 1u == (tg + 1u) * nx) xb_add(&bar[XB_TOPGEN], 1u);
      else XB_SPIN(xb_ld(&bar[XB_TOPGEN]) == tg, bar);
      __builtin_amdgcn_fence(__ATOMIC_ACQUIRE, "agent");
      xb_add(&bar[XB_XGEN(b.x)], 1u);
      asm volatile("s_waitcnt vmcnt(0)" ::: "memory");
    } else {
      XB_SPIN(xb_ld(&bar[XB_XGEN(b.x)]) == gen, bar);
      __builtin_amdgcn_fence(__ATOMIC_ACQUIRE, "agent");
      asm volatile("s_waitcnt vmcnt(0)" ::: "memory");
    }
  }
  __syncthreads();
}

extern "C" __global__ void __launch_bounds__(512, 2) mega(Params p_unused) {
  extern __shared__ __attribute__((aligned(16))) unsigned char smem[];
  cg::grid_group grid = cg::this_grid();
  const int bid = blockIdx.x, nblk = gridDim.x;
  const int wv = __builtin_amdgcn_readfirstlane((int)(threadIdx.x >> 6));
  CParams* pk = (CParams*)__builtin_amdgcn_kernarg_segment_ptr();
  const int ph_lo = pk->ph_lo, ph_hi = pk->ph_hi;
  int ph = 0;
  if (ph_lo > 0x40000000) grid.sync();
  XcdBarrier xb;
  {
    volatile __attribute__((address_space(3))) unsigned* st = (volatile __attribute__((address_space(3))) unsigned*)(smem + 131072);
    const int t0 = ltid(wv);
    if (t0 == 0) { st[0] = 0u; st[1] = 0u; }
    __syncthreads();
    xb.bar = (unsigned*)(pk->ws + OFF_BAR); xb.x = xb_xcc_id(); xb.st = st;
    if (t0 == 0) (void)xb_add(&xb.bar[XB_XCNT(xb.x)], 1u);
  }
#ifndef REPMASK
#define REPMASK 0u
#endif
#ifndef PMASK
#define PMASK 0xffffffffu
#endif
#define PHASE_BEGIN(k) if (ph >= ph_lo && ph < ph_hi) { if constexpr ((PMASK >> (k)) & 1u) for (int rep_ = 0; rep_ < 1 + (int)((REPMASK >> (k)) & 1u); ++rep_) { \
    CParams* pp_ = pk; asm volatile("" : "+s"(pp_)); PREF p = *pp_; const int tid = ltid(wv); \
    unsigned char* ws = p.ws; float* X = (float*)(ws + OFF_X); bf16_t* H = (bf16_t*)(ws + OFF_H); bf16_t* Wb = (bf16_t*)(ws + OFF_W); \
    float* ROPE = (float*)(ws + OFF_ROPE); unsigned char* R = ws + OFF_R; (void)tid; (void)X; (void)H; (void)Wb; (void)ROPE; (void)R;
#define PHASE_END   } if (ph + 1 < ph_hi) { xcd_barrier(xb, ltid(wv), (unsigned)nblk); } } ++ph;

  PHASE_BEGIN(0)
    {
      const int hf = tid >> 8, tl = tid & 255;
      float* smh = (float*)smem + hf * 4224;
      for (int t0 = bid * 2; t0 < p.total_tiles; t0 += nblk * 2) {
        const int t = t0 + hf;
        const bool active = t < p.total_tiles;
        const int tt = active ? t : 0;
        int ji = 0;
#pragma unroll 1
        for (int q = 1; q < NJOBS; ++q) if (tt >= p.jobs[q].tile0) ji = q;
        const CAS Job& jb = p.jobs[ji];
        int lt = tt - jb.tile0; int nkt = jb.k >> 6; int nt_ = lt / nkt, kt_ = lt - nt_ * nkt;
        transpose_tile(jb.src, jb.nsrc, jb.nsrc, jb.dst, jb.k, nt_ * 64, kt_ * 64, jb.mode, smh, tl, active);
      }
    }
    {
      const size_t n4p = (size_t)TP * 256, n4 = (size_t)T * 256;
      const float4* xp = (const float4*)p.in[0]; const float4* xs = (const float4*)p.in[1];
      for (size_t e = (size_t)bid * NT + tid; e < n4; e += (size_t)nblk * NT) ((float4*)X)[e] = (e < n4p) ? xp[e] : xs[e - n4p];
      for (int e = bid * NT + tid; e < 8192 * 16; e += nblk * NT) {
        int pos = e >> 4, i = e & 15;
        double rev = (double)pos * p.inv_freq[i] * 0.15915494309189535;
        rev -= floor(rev);
        float fr = (float)rev;
        ROPE[2 * e] = __builtin_amdgcn_cosf(fr); ROPE[2 * e + 1] = __builtin_amdgcn_sinf(fr);
      }
      const float* wsrc = p.in[20];
      for (int e = bid * NT + tid; e < 8 * 128 * 128; e += nblk * NT) {
        int s = e & 127, t = (e >> 7) & 127;
        Wb[W_TRIL + e] = tobf(s <= t ? wsrc[e] : 0.f);
      }
    }
  PHASE_END

#pragma unroll 1
  for (int L = 0; L < 4; ++L) {
    const int kind = L % 3, j = L / 3;
    if (kind == 0) {
      PHASE_BEGIN(1)
        rmsnorm_rows(X, p.in[7] + L * 1024, H, nullptr, nullptr, bid, nblk, wv);
        cache_rows(p.in[2] + (size_t)j * 32 * 1024 * 256, (bf16_t*)(R + R_CKV), 256, bid, nblk, wv);
        cache_rows(p.in[3] + (size_t)j * 32 * 1024 * 32, (bf16_t*)(R + R_KR), 32, bid, nblk, wv);
      PHASE_END
      PHASE_BEGIN(2)
        EArgs ea{}; ea.f0 = (float*)(R + R_RAW);
        gemm_phase<E_F32>(H, Wb + W_MLA + (size_t)j * WM_SZ + WM_D, T, 1024, 1024, ea, smem, 0, bid, nblk, wv);
      PHASE_END
      PHASE_BEGIN(3)
        mla_rowops(p, j, bid, nblk, wv);
      PHASE_END
      PHASE_BEGIN(4)
        EArgs ea{}; ea.b0 = (bf16_t*)(R + R_Q); ea.rope = ROPE;
        gemm_phase<E_MLAQ>((const bf16_t*)(R + R_CQ), Wb + W_MLA + (size_t)j * WM_SZ + WM_UQ, T, 1536, 512, ea, smem, 0, bid, nblk, wv);
        EArgs eb{}; eb.b0 = (bf16_t*)(R + R_KN); eb.b1 = (bf16_t*)(R + R_VT);
        gemm_phase<E_MLAKV>((const bf16_t*)(R + R_CKV), Wb + W_MLA + (size_t)j * WM_SZ + WM_UKV, KROWS, 2048, 256, eb, smem, (T / 256) * 6, bid, nblk, wv);
      PHASE_END
      PHASE_BEGIN(5)
        attn_phase<true>(p, smem, bid, nblk, wv);
      PHASE_END
      PHASE_BEGIN(6)
        EArgs ea{}; ea.f0 = X;
        gemm_phase<E_RESID>((const bf16_t*)(R + R_RAW), Wb + W_MLA + (size_t)j * WM_SZ + WM_O, T, 1024, 1024, ea, smem, 0, bid, nblk, wv);
      PHASE_END
    } else if (kind == 1) {
      PHASE_BEGIN(1)
        rmsnorm_rows(X, p.in[7] + L * 1024, H, nullptr, nullptr, bid, nblk, wv);
      PHASE_END
      PHASE_BEGIN(7)
        EArgs ea{}; ea.b0 = (bf16_t*)(R + C_U); ea.b1 = (bf16_t*)(R + C_VR);
        gemm_phase<E_GELU>(H, Wb + W_CM + WC_IN, T, 4096, 1024, ea, smem, 0, bid, nblk, wv);
      PHASE_END
      PHASE_BEGIN(8)
        cmlp_ln_rows(p, bid, nblk, wv);
      PHASE_END
      PHASE_BEGIN(9)
        cmlp_mix_phase(p, smem, bid, nblk, wv);
      PHASE_END
      PHASE_BEGIN(6)
        EArgs ea{}; ea.f0 = X;
        gemm_phase<E_RESID>((const bf16_t*)(R + C_G), Wb + W_CM + WC_OUT, T, 1024, 2048, ea, smem, 0, bid, nblk, wv);
      PHASE_END
    } else {
      PHASE_BEGIN(10)
        rmsnorm_rows(X, p.in[7] + L * 1024, H, nullptr, nullptr, bid, nblk, wv);
        cache_rows(p.in[4], (bf16_t*)(R + D_K), 1024, bid, nblk, wv);
        cache_rows(p.in[6], (bf16_t*)(R + D_KI), 64, bid, nblk, wv);
        {
          bf16_t* VTs = (bf16_t*)(R + D_VT) + (size_t)TP * 1024;
          {
            const int hf = tid >> 8, tl = tid & 255;
            float* smh = (float*)smem + hf * 4224;
            for (int u0 = bid * 2; u0 < 512 * 16; u0 += nblk * 2) {
              const int u = u0 + hf;
              int st = u & 15, bh = u >> 4, b = bh >> 4, h = bh & 15;
              transpose_tile(p.in[5] + (size_t)b * 1024 * 1024 + h * 64, 1024, 64, VTs + (size_t)(bh * 64) * SPAD, SPAD, 0, st * 64, 0, smh, tl, true);
            }
          }
          for (int e = bid * NT + tid; e < 512 * 64 * 12; e += nblk * NT) {
            int c = e % 12, rw = e / 12;
            { unsigned z = 0; asm volatile("" : "+v"(z)); *(uint2*)(VTs + (size_t)rw * SPAD + NKS + c * 4) = make_uint2(z, z); }
          }
        }
      PHASE_END
      PHASE_BEGIN(11)
        EArgs ea{};
        ea.f0 = p.out + O_DKP; ea.f1 = p.out + O_DKS; ea.f2 = p.out + O_DVP; ea.f3 = p.out + O_DVS;
        ea.f4 = (float*)(R + D_KIR); ea.f5 = (float*)(R + D_WI);
        ea.b0 = (bf16_t*)(R + D_Q); ea.b1 = (bf16_t*)(R + D_K); ea.b2 = (bf16_t*)(R + D_VT); ea.b3 = (bf16_t*)(R + D_QI);
        gemm_phase<E_DSA>(H, Wb + W_DS + WD_P, T, 3840, 1024, ea, smem, 0, bid, nblk, wv);
      PHASE_END
      PHASE_BEGIN(12)
        dsa_rowops(p, bid, nblk, wv);
      PHASE_END
      PHASE_BEGIN(13)
        idx_phase(p, smem, bid, nblk, wv);
      PHASE_END
      PHASE_BEGIN(14)
        attn_phase<false>(p, smem, bid, nblk, wv);
      PHASE_END
      PHASE_BEGIN(6)
        EArgs ea{}; ea.f0 = X;
        gemm_phase<E_RESID>((const bf16_t*)(R + D_AO), Wb + W_DS + WD_O, T, 1024, 1024, ea, smem, 0, bid, nblk, wv);
      PHASE_END
    }
    PHASE_BEGIN(1)
      rmsnorm_rows(X, p.in[8] + L * 1024, H, nullptr, nullptr, bid, nblk, wv);
    PHASE_END
    PHASE_BEGIN(15)
      EArgs ea{}; ea.b0 = (bf16_t*)(R + 0);
      gemm_phase<E_SWIGLU>(H, Wb + W_FF + (size_t)L * WF_SZ + WF_IN, T, 2 * DFF, 1024, ea, smem, 0, bid, nblk, wv);
    PHASE_END
    PHASE_BEGIN(6)
      EArgs ea{}; ea.f0 = X;
      gemm_phase<E_RESID>((const bf16_t*)(R + 0), Wb + W_FF + (size_t)L * WF_SZ + WF_OUT, T, 1024, DFF, ea, smem, 0, bid, nblk, wv);
    PHASE_END
  }
  PHASE_BEGIN(1)
    rmsnorm_rows(X, p.in[9], nullptr, p.out + O_YP, p.out + O_YS, bid, nblk, wv);
  PHASE_END
}

extern "C" void kernel_launch(void* const* d_in, const int* in_sizes, int n_in,
                              void* d_out, int out_size, void* d_ws, size_t ws_size,
                              hipStream_t stream) {
  constexpr int kLds = 128 * 1024 + 64;
  static int grid_blocks = 0;
  if (!grid_blocks) {
    int dev = 0, cus = 0, per_cu = 0;
    (void)hipGetDevice(&dev);
    (void)hipDeviceGetAttribute(&cus, hipDeviceAttributeMultiprocessorCount, dev);
    (void)hipFuncSetAttribute((const void*)mega, hipFuncAttributeMaxDynamicSharedMemorySize, kLds);
    (void)hipOccupancyMaxActiveBlocksPerMultiprocessor(&per_cu, (const void*)mega, NT, kLds);
    if (per_cu < 1) per_cu = 1;
    if (per_cu > 1) per_cu = 1;
    grid_blocks = cus * per_cu;
    fprintf(stderr, "grid %d (cus %d per_cu %d) ws %zu need %zu out %d need %zu\n", grid_blocks, cus, per_cu, ws_size, (size_t)WS_NEED, out_size, (size_t)O_END);
  }
  if (ws_size < WS_NEED || n_in != 31 || (size_t)out_size != O_END) { fprintf(stderr, "kernel_launch: bad sizes\n"); return; }
  Params p;
  memset(&p, 0, sizeof(p));
  for (int i = 0; i < 31; ++i) p.in[i] = (const float*)d_in[i];
  p.out = (float*)d_out; p.ws = (unsigned char*)d_ws;
  bf16_t* Wb = (bf16_t*)((unsigned char*)d_ws + OFF_W);
  int nj = 0, tiles = 0;
  auto add = [&](const float* src, int nsrc, int k, bf16_t* dst, int ndst, int mode) {
    Job& jb = p.jobs[nj++]; jb.src = src; jb.dst = dst; jb.nsrc = nsrc; jb.k = k; jb.ndst = ndst; jb.mode = mode; jb.tile0 = tiles; jb.pad = 0;
    tiles += (ndst / 64) * (k / 64);
  };
  for (int j = 0; j < 2; ++j) {
    bf16_t* Wm = Wb + W_MLA + (size_t)j * WM_SZ;
    add(p.in[10] + (size_t)j * 1024 * 512, 512, 1024, Wm + WM_D, 512, 2);
    add(p.in[13] + (size_t)j * 1024 * 288, 288, 1024, Wb + W_MLA + (size_t)j * WM_SZ + WM_D + (size_t)512 * 1024, 512, 2);
    add(p.in[12] + (size_t)j * 512 * 1536, 1536, 512, Wb + W_MLA + (size_t)j * WM_SZ + WM_UQ, 1536, 0);
    add(p.in[15] + (size_t)j * 256 * 2048, 2048, 256, Wb + W_MLA + (size_t)j * WM_SZ + WM_UKV, 2048, 2);
    add(p.in[16] + (size_t)j * 1024 * 1024, 1024, 1024, Wb + W_MLA + (size_t)j * WM_SZ + WM_O, 1024, 2);
  }
  add(p.in[17], 4096, 1024, Wb + W_CM + WC_IN, 4096, 2);
  add(p.in[22], 1024, 2048, Wb + W_CM + WC_OUT, 1024, 2);
  add(p.in[23], 3072, 1024, Wb + W_DS + WD_P, 3072, 2);
  add(p.in[25], 512, 1024, Wb + W_DS + WD_P + (size_t)3072 * 1024, 512, 2);
  add(p.in[26], 64, 1024, Wb + W_DS + WD_P + (size_t)3584 * 1024, 64, 2);
  add(p.in[28], 8, 1024, Wb + W_DS + WD_P + (size_t)3648 * 1024, 192, 2);
  add(p.in[24], 1024, 1024, Wb + W_DS + WD_O, 1024, 2);
  for (int i = 0; i < 4; ++i) {
    add(p.in[29] + (size_t)i * 1024 * 5632, 5632, 1024, Wb + W_FF + (size_t)i * WF_SZ + WF_IN, 5632, 1);
    add(p.in[30] + (size_t)i * 2816 * 1024, 1024, 2816, Wb + W_FF + (size_t)i * WF_SZ + WF_OUT, 1024, 2);
  }
  p.total_tiles = tiles;
  for (int i = 0; i < 16; ++i) p.inv_freq[i] = pow(10000.0, -(double)i / 16.0);
  p.ph_lo = 0; p.ph_hi = 1000;
  (void)hipMemsetAsync((unsigned char*)d_ws + OFF_BAR, 0, 16384, stream);
  void* args[] = {&p};
  hipError_t e = hipLaunchCooperativeKernel((const void*)mega, dim3(grid_blocks), dim3(NT), args, kLds, stream);
  if (e != hipSuccess) fprintf(stderr, "coop launch failed: %s\n", hipGetErrorString(e));
}
```

```cpp
#include <hip/hip_runtime.h>
#include <hip/hip_cooperative_groups.h>
#include <cstdio>
#include <cstring>
#include <cmath>
namespace cg = cooperative_groups;

typedef unsigned short bf16_t;
using bf16x8 = __attribute__((ext_vector_type(8))) short;
using f32x16 = __attribute__((ext_vector_type(16))) float;
using f32x2v = __attribute__((ext_vector_type(2))) float;
using bf2v = __attribute__((ext_vector_type(2))) __bf16;
#define DI __device__ __forceinline__
#define MFMA32(a, b, c) __builtin_amdgcn_mfma_f32_32x32x16_bf16((a), (b), (c), 0, 0, 0)

constexpr int TP = 16384, TS = 512, T = TP + TS;
constexpr int NT = 512;
constexpr int SPAD = 1088, NKS = 1040;
constexpr int KROWS = TP + 32 * SPAD;
constexpr int DFF = 2816;
constexpr float LOG2E = 1.4426950408889634f;
constexpr float EPS = 1e-6f;

constexpr size_t OFF_X = 0;
constexpr size_t OFF_H = OFF_X + (size_t)T * 1024 * 4;
constexpr size_t OFF_W = OFF_H + (size_t)T * 1024 * 2;
constexpr size_t W_ELEMS = 52822016;
constexpr size_t OFF_ROPE = OFF_W + W_ELEMS * 2;
constexpr size_t OFF_R = OFF_ROPE + (size_t)8192 * 16 * 2 * 4;
constexpr size_t R_RAW = 0;
constexpr size_t R_CQ = R_RAW + (size_t)T * 1024 * 4;
constexpr size_t R_CKV = R_CQ + (size_t)T * 512 * 2;
constexpr size_t R_KR = R_CKV + (size_t)KROWS * 256 * 2;
constexpr size_t R_Q = R_KR + (size_t)KROWS * 32 * 2;
constexpr size_t R_KN = R_Q + (size_t)T * 1536 * 2;
constexpr size_t R_VT = R_KN + (size_t)KROWS * 1024 * 2;
constexpr size_t R_END = R_VT + (size_t)KROWS * 1024 * 2;
constexpr size_t D_Q = 0;
constexpr size_t D_K = D_Q + (size_t)T * 1024 * 2;
constexpr size_t D_VT = D_K + (size_t)KROWS * 1024 * 2;
constexpr size_t D_QI = D_VT + (size_t)KROWS * 1024 * 2;
constexpr size_t D_KIR = D_QI + (size_t)T * 512 * 2;
constexpr size_t D_KI = D_KIR + (size_t)T * 64 * 4;
constexpr size_t D_WI = D_KI + (size_t)KROWS * 64 * 2;
constexpr size_t D_BM = D_WI + (size_t)T * 8 * 4;
constexpr size_t D_AO = D_BM + (size_t)T * 256 * 4;
constexpr size_t D_END = D_AO + (size_t)T * 1024 * 2;
constexpr size_t C_U = 0;
constexpr size_t C_VR = C_U + (size_t)T * 2048 * 2;
constexpr size_t C_VLN = C_VR + (size_t)T * 2048 * 2;
constexpr size_t C_G = C_VLN + (size_t)T * 2048 * 2;
constexpr size_t C_END = C_G + (size_t)T * 2048 * 2;
constexpr size_t OFF_BAR = OFF_R + R_END;
constexpr size_t WS_NEED = OFF_BAR + 16384;
static_assert(D_END <= R_END && C_END <= R_END && (size_t)T * DFF * 2 <= R_END, "region");

constexpr size_t W_MLA = 0;
constexpr size_t WM_D = 0, WM_UQ = 1048576, WM_UKV = WM_UQ + 786432, WM_O = WM_UKV + 524288, WM_SZ = 3407872;
constexpr size_t W_CM = 2 * WM_SZ;
constexpr size_t WC_IN = 0, WC_OUT = 4194304, WC_SZ = 6291456;
constexpr size_t W_DS = W_CM + WC_SZ;
constexpr size_t WD_P = 0, WD_O = 3932160, WD_SZ = 4980736;
constexpr size_t W_FF = W_DS + WD_SZ;
constexpr size_t WF_IN = 0, WF_OUT = 5767168, WF_SZ = 8650752;
constexpr size_t W_TRIL = W_FF + 4 * WF_SZ;
static_assert(W_TRIL + 131072 == W_ELEMS, "w");

constexpr size_t O_YP = 0;
constexpr size_t O_YS = O_YP + (size_t)TP * 1024;
constexpr size_t O_CKVP = O_YS + (size_t)TS * 1024;
constexpr size_t O_KRP = O_CKVP + (size_t)2 * TP * 256;
constexpr size_t O_CKVS = O_KRP + (size_t)2 * TP * 32;
constexpr size_t O_KRS = O_CKVS + (size_t)2 * TS * 256;
constexpr size_t O_CVS = O_KRS + (size_t)2 * TS * 32;
constexpr size_t O_DKP = O_CVS + (size_t)TS * 2048;
constexpr size_t O_DVP = O_DKP + (size_t)TP * 1024;
constexpr size_t O_DIP = O_DVP + (size_t)TP * 1024;
constexpr size_t O_DKS = O_DIP + (size_t)TP * 64;
constexpr size_t O_DVS = O_DKS + (size_t)TS * 1024;
constexpr size_t O_DIS = O_DVS + (size_t)TS * 1024;
constexpr size_t O_END = O_DIS + (size_t)TS * 64;

constexpr int NJOBS = 25;
struct Job { const float* src; bf16_t* dst; int nsrc, k, ndst, mode, tile0, pad; };
struct Params {
  const float* in[31];
  float* out;
  unsigned char* ws;
  Job jobs[NJOBS];
  int total_tiles, ph_lo, ph_hi, pad;
  double inv_freq[16];
};

#define CAS __attribute__((address_space(4)))
typedef const CAS Params CParams;
#define PREF const CAS Params&
DI unsigned pack2(float a, float b) { f32x2v v = {a, b}; bf2v r = __builtin_convertvector(v, bf2v); return __builtin_bit_cast(unsigned, r); }
DI bf16_t tobf(float a) { return (bf16_t)(pack2(a, 0.f) & 0xffffu); }
DI float frombf(bf16_t v) { return __uint_as_float(((unsigned)v) << 16); }
DI float bflo(unsigned u) { return __uint_as_float(u << 16); }
DI float bfhi(unsigned u) { return __uint_as_float(u & 0xffff0000u); }
DI float shflx(float v, int m, int lane) { return __int_as_float(__builtin_amdgcn_ds_bpermute((lane ^ m) << 2, __float_as_int(v))); }
DI float wave_sum(float v, int lane) {
#pragma unroll
  for (int o = 32; o >= 1; o >>= 1) v += shflx(v, o, lane);
  return v;
}
DI int ltid(int wv) { unsigned m1 = ~0u; asm volatile("" : "+s"(m1)); int t = (wv << 6) | (int)__builtin_amdgcn_mbcnt_hi(m1, __builtin_amdgcn_mbcnt_lo(m1, 0u)); asm volatile("" : "+v"(t)); return t; }
DI int crow(int i, int h) { return (i & 3) + 8 * (i >> 2) + 4 * h; }
DI int rowmap(int t) { if (t < TP) return t; int u = t - TP; return TP + (u >> 4) * SPAD + 1024 + (u & 15); }
DI int tokpos(int t) { return t < TP ? (t & 8191) : 1024 + ((t - TP) & 15); }

DI void transpose_tile(const float* __restrict__ src, int src_ld, int ncols, bf16_t* __restrict__ dst, int dst_ld,
                       int n0, int k0, int mode, float* sm, int tid, bool active) {
  const int nl = (tid & 15) * 4, kq = tid >> 4;
  const int n = n0 + nl;
  int c;
  if (mode != 1) c = n < ncols ? n : -1;
  else { int tt = n >> 5, r = n & 31; int f = tt * 16 + (r & 15); c = (r < 16) ? f : DFF + f; }
  int dr[4];
#pragma unroll
  for (int e = 0; e < 4; ++e) { int col = nl + e; dr[e] = (mode == 2) ? ((col & 32) + (col & 1) * 16 + ((col & 31) >> 1)) : col; }
  if (active) {
    float4 v[4];
#pragma unroll
    for (int i = 0; i < 4; ++i) {
      int kk = kq + 16 * i;
      v[i] = (c >= 0) ? *(const float4*)(src + (size_t)(k0 + kk) * src_ld + c) : make_float4(0.f, 0.f, 0.f, 0.f);
    }
#pragma unroll
    for (int i = 0; i < 4; ++i) {
      int kk = kq + 16 * i;
      float* d = sm + kk * 65;
      d[dr[0]] = v[i].x; d[dr[1]] = v[i].y; d[dr[2]] = v[i].z; d[dr[3]] = v[i].w;
    }
  }
  __syncthreads();
  if (active) {
    const int kp = (tid & 31) * 2, nr = tid >> 5;
#pragma unroll 4
    for (int i = 0; i < 8; ++i) {
      int nn = nr + 8 * i;
      float a = sm[kp * 65 + nn], b = sm[(kp + 1) * 65 + nn];
      *(unsigned*)(dst + (size_t)(n0 + nn) * dst_ld + k0 + kp) = pack2(a, b);
    }
  }
  __syncthreads();
}

enum { E_F32 = 0, E_RESID, E_SWIGLU, E_GELU, E_MLAQ, E_MLAKV, E_DSA };
struct EArgs {
  float* f0; float* f1; float* f2; float* f3; float* f4; float* f5; float* f6;
  bf16_t* b0; bf16_t* b1; bf16_t* b2; bf16_t* b3;
  const float* rope;
};
using f32x4v = __attribute__((ext_vector_type(4))) float;
#define LAS __attribute__((address_space(3)))
constexpr int G_HT = 128 * 64;
DI int lds_byte(int r, int c) {
  int st = (r >> 4) * 2 + (c >> 5), rr = r & 15, cc = c & 31, ob = rr * 64 + cc * 2;
  return st * 1024 + (ob ^ (((ob >> 9) & 1) << 5));
}
DI void stage_rc(int b, int& R, int& C) {
  int st = b >> 10, sb = b & 1023, swz = sb ^ (((sb >> 9) & 1) << 5);
  R = (st >> 1) * 16 + (swz >> 6); C = (st & 1) * 32 + ((swz & 63) >> 1);
}

DI float gelu_exact(float x) {
  const float z = fabsf(x) * 0.70710678118654752f;
  const float t = __builtin_amdgcn_rcpf(1.f + 0.3275911f * z);
  float pl = 1.061405429f;
  pl = pl * t - 1.453152027f; pl = pl * t + 1.421413741f; pl = pl * t - 0.284496736f; pl = pl * t + 0.254829592f;
  const float e = pl * t * __builtin_amdgcn_exp2f(-z * z * 1.4426950408889634f);
  const float erfz = 1.f - e;
  const float erfx = x < 0.f ? -erfz : erfz;
  return 0.5f * x * (1.f + erfx);
}
template <int EPI, bool ATOM>
DI void epi16(const EArgs& ea, int row0, int gb, int fr, const f32x4v& v0, const f32x4v& v1) {
  if constexpr (EPI == E_F32) {
#pragma unroll
    for (int j = 0; j < 4; ++j) *(float2*)(ea.f0 + (size_t)(row0 + j) * 1024 + gb + 2 * fr) = make_float2(v0[j], v1[j]);
  } else if constexpr (EPI == E_RESID) {
#pragma unroll
    for (int j = 0; j < 4; ++j) { float* o = ea.f0 + (size_t)(row0 + j) * 1024 + gb + 2 * fr;
      if constexpr (ATOM) { unsafeAtomicAdd(o, v0[j]); unsafeAtomicAdd(o + 1, v1[j]); }
      else { float2 x = *(float2*)o; x.x += v0[j]; x.y += v1[j]; *(float2*)o = x; } }
  } else if constexpr (EPI == E_SWIGLU) {
    const int f = (gb >> 1) + fr;
#pragma unroll
    for (int j = 0; j < 4; ++j) { float g = v0[j], u = v1[j]; ea.b0[(size_t)(row0 + j) * DFF + f] = tobf(g * __builtin_amdgcn_rcpf(1.f + __builtin_amdgcn_exp2f(-g * LOG2E)) * u); }
  } else if constexpr (EPI == E_GELU) {
    bf16_t* dstp = (gb < 2048) ? (ea.b0 + gb + 2 * fr) : (ea.b1 + (gb - 2048) + 2 * fr);
#pragma unroll
    for (int j = 0; j < 4; ++j) {
      float x = v0[j], y = v1[j];
      *(unsigned*)(dstp + (size_t)(row0 + j) * 2048) = pack2(gelu_exact(x), gelu_exact(y));
    }
  } else if constexpr (EPI == E_MLAQ) {
    const float qs = 0.10206207261596577f * LOG2E;
    const bool is_rope = (gb % 96) == 64;
#pragma unroll
    for (int j = 0; j < 4; ++j) {
      const int row = row0 + j;
      float o0 = v0[j], o1 = v1[j];
      if (is_rope) {
        float2 cs = *(const float2*)(ea.rope + ((size_t)tokpos(row) * 16 + fr) * 2);
        o0 = v0[j] * cs.x - v1[j] * cs.y; o1 = v0[j] * cs.y + v1[j] * cs.x;
      }
      bf16_t* o = ea.b0 + (size_t)row * 1536 + gb + fr;
      o[0] = tobf(o0 * qs); o[16] = tobf(o1 * qs);
    }
  } else if constexpr (EPI == E_MLAKV) {
    const int head = gb >> 7, c0 = gb & 127;
    if (c0 < 64) {
#pragma unroll
      for (int j = 0; j < 4; ++j) *(unsigned*)(ea.b0 + (size_t)(row0 + j) * 1024 + head * 64 + c0 + 2 * fr) = pack2(v0[j], v1[j]);
    } else {
      const int d = c0 - 64 + 2 * fr;
      size_t off, dstr;
      if (row0 < TP) { int b = row0 >> 13, s = row0 & 8191; off = ((size_t)((b * 16 + head) * 64 + d)) * 8192 + s; dstr = 8192; }
      else { int u = row0 - TP; int b = u / SPAD, s = u - b * SPAD; off = (size_t)TP * 1024 + ((size_t)((b * 16 + head) * 64 + d)) * SPAD + s; dstr = SPAD; }
      uint2 pk; pk.x = pack2(v0[0], v0[1]); pk.y = pack2(v0[2], v0[3]); *(uint2*)(ea.b1 + off) = pk;
      pk.x = pack2(v1[0], v1[1]); pk.y = pack2(v1[2], v1[3]); *(uint2*)(ea.b1 + off + dstr) = pk;
    }
  } else if constexpr (EPI == E_DSA) {
    if (gb < 1024) {
      const float qs = 0.125f * LOG2E;
#pragma unroll
      for (int j = 0; j < 4; ++j) *(unsigned*)(ea.b0 + (size_t)(row0 + j) * 1024 + gb + 2 * fr) = pack2(v0[j] * qs, v1[j] * qs);
    } else if (gb < 2048) {
      const int c = gb - 1024 + 2 * fr;
#pragma unroll
      for (int j = 0; j < 4; ++j) {
        const int row = row0 + j;
        float* o = (row < TP) ? ea.f0 + (size_t)row * 1024 + c : ea.f1 + (size_t)(row - TP) * 1024 + c;
        *(float2*)o = make_float2(v0[j], v1[j]);
        *(unsigned*)(ea.b1 + (size_t)rowmap(row) * 1024 + c) = pack2(v0[j], v1[j]);
      }
    } else if (gb < 3072) {
      const int c = gb - 2048 + 2 * fr, head = c >> 6, d = c & 63;
#pragma unroll
      for (int j = 0; j < 4; ++j) {
        const int row = row0 + j;
        float* o = (row < TP) ? ea.f2 + (size_t)row * 1024 + c : ea.f3 + (size_t)(row - TP) * 1024 + c;
        *(float2*)o = make_float2(v0[j], v1[j]);
      }
      size_t off, dstr;
      if (row0 < TP) { int b = row0 >> 13, s = row0 & 8191; off = ((size_t)((b * 16 + head) * 64 + d)) * 8192 + s; dstr = 8192; }
      else { int u = row0 - TP; int b = u >> 4, s = 1024 + (u & 15); off = (size_t)TP * 1024 + ((size_t)((b * 16 + head) * 64 + d)) * SPAD + s; dstr = SPAD; }
      uint2 pk; pk.x = pack2(v0[0], v0[1]); pk.y = pack2(v0[2], v0[3]); *(uint2*)(ea.b2 + off) = pk;
      pk.x = pack2(v1[0], v1[1]); pk.y = pack2(v1[2], v1[3]); *(uint2*)(ea.b2 + off + dstr) = pk;
    } else if (gb < 3584) {
      const int c = gb - 3072 + 2 * fr;
#pragma unroll
      for (int j = 0; j < 4; ++j) *(unsigned*)(ea.b3 + (size_t)(row0 + j) * 512 + c) = pack2(v0[j] * 0.125f, v1[j] * 0.125f);
    } else if (gb < 3648) {
      const int c = gb - 3584 + 2 * fr;
#pragma unroll
      for (int j = 0; j < 4; ++j) *(float2*)(ea.f4 + (size_t)(row0 + j) * 64 + c) = make_float2(v0[j], v1[j]);
    } else if (gb == 3648) {
      if (fr < 4) {
#pragma unroll
        for (int j = 0; j < 4; ++j) *(float2*)(ea.f5 + (size_t)(row0 + j) * 8 + 2 * fr) = make_float2(v0[j] * 0.35355339059327379f, v1[j] * 0.35355339059327379f);
      }
    }
  }
}

template <int EPI, bool ATOM>
DI void gemm256_tile(const bf16_t* __restrict__ A, const bf16_t* __restrict__ Bt, const int K, const int kt0, const int nt, const int brow, const int bcol,
                     const EArgs& ea, unsigned char* smem, int wv) {
  bf16_t* shm = (bf16_t*)smem;
  const int tid = ltid(wv);
#define SA(b, h) (shm + ((b) * 2 + (h)) * G_HT)
#define SB(b, h) (shm + (4 + (b) * 2 + (h)) * G_HT)
#define STAGE(P, BASE, br, kt) do { const char* _gb = (const char*)((BASE) + (long)(br) * K + (long)((kt) + kt0) * 64); \
    __builtin_amdgcn_global_load_lds((const unsigned*)(_gb + voff0), (LAS unsigned*)((char*)(P) + tid * 16), 16, 0, 0); \
    __builtin_amdgcn_global_load_lds((const unsigned*)(_gb + voff1), (LAS unsigned*)((char*)(P) + tid * 16 + 8192), 16, 0, 0); } while (0)
#define LDA(dst, b, h) _Pragma("unroll") for (int m = 0; m < 4; ++m) _Pragma("unroll") for (int k = 0; k < 2; ++k) \
    dst[m][k] = *reinterpret_cast<const bf16x8*>((char*)SA(b, h) + lds_byte(wr * 64 + m * 16 + fr, k * 32 + fq * 8))
#define LDB(dst, b, h) _Pragma("unroll") for (int n = 0; n < 2; ++n) _Pragma("unroll") for (int k = 0; k < 2; ++k) \
    dst[n][k] = *reinterpret_cast<const bf16x8*>((char*)SB(b, h) + lds_byte(wc * 32 + n * 16 + fr, k * 32 + fq * 8))
#define MMA(ai, bj, At_, Bt_) do { __builtin_amdgcn_s_setprio(1); \
    _Pragma("unroll") for (int m = 0; m < 4; ++m) _Pragma("unroll") for (int n = 0; n < 2; ++n) _Pragma("unroll") for (int k = 0; k < 2; ++k) \
      acc[ai][bj][m][n] = __builtin_amdgcn_mfma_f32_16x16x32_bf16(At_[m][k], Bt_[n][k], acc[ai][bj][m][n], 0, 0, 0); \
    __builtin_amdgcn_s_setprio(0); } while (0)
#define WAIT_V(n) asm volatile("s_waitcnt vmcnt(" #n ")" ::: "memory")
#define WAIT_L(n) asm volatile("s_waitcnt lgkmcnt(" #n ")" ::: "memory")
#define BAR __builtin_amdgcn_s_barrier()
#define SCHED __builtin_amdgcn_sched_barrier(0)
  const int wid = tid >> 6, lane = tid & 63, wr = wid >> 2, wc = wid & 3, fr = lane & 15, fq = lane >> 4;
  unsigned voff0, voff1;
  { int r_, c_; stage_rc(tid * 16, r_, c_); voff0 = (unsigned)(r_ * K + c_) * 2u; stage_rc(tid * 16 + 8192, r_, c_); voff1 = (unsigned)(r_ * K + c_) * 2u; }
  f32x4v acc[2][2][4][2];
#pragma unroll
  for (int a = 0; a < 2; ++a)
#pragma unroll
    for (int b = 0; b < 2; ++b)
#pragma unroll
      for (int m = 0; m < 4; ++m)
#pragma unroll
        for (int n = 0; n < 2; ++n) acc[a][b][m][n] = (f32x4v){0.f, 0.f, 0.f, 0.f};
  bf16x8 At[4][2], B0[2][2], B1[2][2];
  const int HALF = 128;
  WAIT_V(0); WAIT_L(0); BAR;
  STAGE(SB(0, 0), Bt, bcol, 0); STAGE(SA(0, 0), A, brow, 0);
  STAGE(SB(0, 1), Bt, bcol + HALF, 0); STAGE(SA(0, 1), A, brow + HALF, 0);
  if (wr == 1) BAR;
  WAIT_V(4); BAR;
  STAGE(SB(1, 0), Bt, bcol, 1); STAGE(SA(1, 0), A, brow, 1); STAGE(SB(1, 1), Bt, bcol + HALF, 1);
  WAIT_V(6); BAR;
  for (int t = 0; t < nt - 2; t += 2) {
    LDB(B0, 0, 0); SCHED; LDA(At, 0, 0); STAGE(SA(1, 1), A, brow + HALF, t + 1);
    WAIT_L(8); BAR; WAIT_L(0); MMA(0, 0, At, B0); BAR; SCHED;
    LDB(B1, 0, 1); STAGE(SB(0, 0), Bt, bcol, t + 2);
    BAR; WAIT_L(0); MMA(0, 1, At, B1); BAR;
    LDA(At, 0, 1); STAGE(SA(0, 0), A, brow, t + 2);
    BAR; WAIT_L(0); MMA(1, 0, At, B0); BAR; SCHED;
    STAGE(SB(0, 1), Bt, bcol + HALF, t + 2);
    WAIT_V(6); BAR; MMA(1, 1, At, B1); BAR;
    LDB(B0, 1, 0); SCHED; LDA(At, 1, 0); STAGE(SA(0, 1), A, brow + HALF, t + 2);
    WAIT_L(8); BAR; WAIT_L(0); MMA(0, 0, At, B0); BAR; SCHED;
    LDB(B1, 1, 1); STAGE(SB(1, 0), Bt, bcol, t + 3);
    BAR; WAIT_L(0); MMA(0, 1, At, B1); BAR;
    LDA(At, 1, 1); STAGE(SA(1, 0), A, brow, t + 3);
    BAR; WAIT_L(0); MMA(1, 0, At, B0); BAR; SCHED;
    STAGE(SB(1, 1), Bt, bcol + HALF, t + 3);
    WAIT_V(6); BAR; MMA(1, 1, At, B1); BAR;
  }
  { LDB(B0, 0, 0); LDA(At, 0, 0); STAGE(SA(1, 1), A, brow + HALF, nt - 1);
    BAR; WAIT_L(0); MMA(0, 0, At, B0); BAR;
    LDB(B1, 0, 1); BAR; WAIT_L(0); MMA(0, 1, At, B1); BAR;
    LDA(At, 0, 1); WAIT_V(4); BAR; WAIT_L(0); MMA(1, 0, At, B0); MMA(1, 1, At, B1); BAR; }
  { LDB(B0, 1, 0); LDA(At, 1, 0); WAIT_V(2); BAR; WAIT_L(0); MMA(0, 0, At, B0); BAR;
    LDB(B1, 1, 1); WAIT_V(0); BAR; WAIT_L(0); MMA(0, 1, At, B1); BAR;
    LDA(At, 1, 1); BAR; WAIT_L(0); MMA(1, 0, At, B0); MMA(1, 1, At, B1); BAR; }
  if (wr == 0) BAR;
#pragma unroll
  for (int ai = 0; ai < 2; ++ai)
#pragma unroll
    for (int bj = 0; bj < 2; ++bj)
#pragma unroll
      for (int m = 0; m < 4; ++m)
      { epi16<EPI, ATOM>(ea, brow + ai * 128 + wr * 64 + m * 16 + fq * 4, bcol + bj * 128 + wc * 32, fr, acc[ai][bj][m][0], acc[ai][bj][m][1]); if constexpr (EPI != E_RESID) __builtin_amdgcn_sched_barrier(0); }
#undef SA
#undef SB
#undef STAGE
#undef LDA
#undef LDB
#undef MMA
#undef WAIT_V
#undef WAIT_L
#undef BAR
#undef SCHED
}

DI void tile_map(int t, int nM, int nN, int nwg, int& pm, int& pn) {
  int wgid = t;
  { int q = nwg >> 3, r = nwg & 7, xcd = wgid & 7, off = wgid >> 3; wgid = (xcd < r ? xcd * (q + 1) : r * (q + 1) + (xcd - r) * q) + off; }
  const int nig = 8 * nN, gid = wgid / nig, fm = gid * 8, gsz = min(nM - fm, 8);
  pm = fm + ((wgid % nig) % gsz); pn = (wgid % nig) / gsz;
}
template <int EPI>
DI void gemm_phase(const bf16_t* A, const bf16_t* Bt, int M, int N, int K, const EArgs& ea,
                   unsigned char* smem, int tstart, int bid, int nblk, int wv) {
  const int nM = M >> 8, nN = N >> 8, nwg = nM * nN, nt = K >> 6;
  if constexpr (EPI == E_RESID) {
    const int nfull = (nwg / nblk) * nblk, rem = nwg - nfull;
    for (int t = bid; t < nfull; t += nblk) {
      int pm, pn; tile_map(t, nM, nN, nwg, pm, pn);
      gemm256_tile<EPI, false>(A, Bt, K, 0, nt, pm * 256, pn * 256, ea, smem, wv);
    }
    if (rem > 0) {
      int ns = nblk / rem; if (ns > (nt >> 3)) ns = nt >> 3; if (ns < 1) ns = 1;
      const int per = ((nt / ns) >> 1) << 1;
      for (int u = bid; u < rem * ns; u += nblk) {
        const int t = nfull + u / ns, ks = u % ns;
        const int k0 = ks * per, kn = (ks == ns - 1) ? (nt - k0) : per;
        int pm, pn; tile_map(t, nM, nN, nwg, pm, pn);
        gemm256_tile<EPI, true>(A, Bt, K, k0, kn, pm * 256, pn * 256, ea, smem, wv);
      }
    }
  } else {
    int t0 = bid - (tstart % nblk); if (t0 < 0) t0 += nblk;
    for (int t = t0; t < nwg; t += nblk) {
      int pm, pn; tile_map(t, nM, nN, nwg, pm, pn);
      gemm256_tile<EPI, false>(A, Bt, K, 0, nt, pm * 256, pn * 256, ea, smem, wv);
    }
  }
}

DI void rmsnorm_rows(const float* __restrict__ X, const float* __restrict__ g, bf16_t* __restrict__ H, float* outp, float* outs,
                     int bid, int nblk, int wv) {
  const int lane = ltid(wv) & 63, w = ltid(wv) >> 6;
  for (int row = bid * 8 + w; row < T; row += nblk * 8) {
    const float* xr = X + (size_t)row * 1024;
    float4 v[4];
    float ss = 0.f;
#pragma unroll
    for (int c = 0; c < 4; ++c) { v[c] = *(const float4*)(xr + c * 256 + lane * 4); ss += v[c].x * v[c].x + v[c].y * v[c].y + v[c].z * v[c].z + v[c].w * v[c].w; }
    ss = wave_sum(ss, lane);
    float r = rsqrtf(ss * (1.f / 1024.f) + EPS);
#pragma unroll
    for (int c = 0; c < 4; ++c) {
      int col = c * 256 + lane * 4;
      float4 gg = *(const float4*)(g + col);
      float a = v[c].x * r * gg.x, b = v[c].y * r * gg.y, cc = v[c].z * r * gg.z, d = v[c].w * r * gg.w;
      if (H) { uint2 pk; pk.x = pack2(a, b); pk.y = pack2(cc, d); *(uint2*)(H + (size_t)row * 1024 + col) = pk; }
      else {
        float* o = (row < TP) ? outp + (size_t)row * 1024 + col : outs + (size_t)(row - TP) * 1024 + col;
        *(float4*)o = make_float4(a, b, cc, d);
      }
    }
  }
}

DI void mla_rowops(PREF p, int j, int bid, int nblk, int wv) {
  const int lane = ltid(wv) & 63, w = ltid(wv) >> 6;
  unsigned char* R = p.ws + OFF_R;
  const float* RAW = (const float*)(R + R_RAW);
  bf16_t* CQ = (bf16_t*)(R + R_CQ); bf16_t* CKV = (bf16_t*)(R + R_CKV); bf16_t* KR = (bf16_t*)(R + R_KR);
  const float* gq = p.in[11] + j * 512; const float* gkv = p.in[14] + j * 256;
  const float* rope = (const float*)(p.ws + OFF_ROPE);
  for (int row = bid * 8 + w; row < T; row += nblk * 8) {
    const float* rr = RAW + (size_t)row * 1024;
    float4 a0 = *(const float4*)(rr + lane * 4), a1 = *(const float4*)(rr + 256 + lane * 4);
    float4 c0 = *(const float4*)(rr + 512 + lane * 4);
    float ss = a0.x * a0.x + a0.y * a0.y + a0.z * a0.z + a0.w * a0.w + a1.x * a1.x + a1.y * a1.y + a1.z * a1.z + a1.w * a1.w;
    float s2 = c0.x * c0.x + c0.y * c0.y + c0.z * c0.z + c0.w * c0.w;
    ss = wave_sum(ss, lane); s2 = wave_sum(s2, lane);
    float r1 = rsqrtf(ss * (1.f / 512.f) + EPS), r2 = rsqrtf(s2 * (1.f / 256.f) + EPS);
    {
      float4 g0 = *(const float4*)(gq + lane * 4), g1 = *(const float4*)(gq + 256 + lane * 4);
      uint2 pk; pk.x = pack2(a0.x * r1 * g0.x, a0.y * r1 * g0.y); pk.y = pack2(a0.z * r1 * g0.z, a0.w * r1 * g0.w);
      *(uint2*)(CQ + (size_t)row * 512 + lane * 4) = pk;
      pk.x = pack2(a1.x * r1 * g1.x, a1.y * r1 * g1.y); pk.y = pack2(a1.z * r1 * g1.z, a1.w * r1 * g1.w);
      *(uint2*)(CQ + (size_t)row * 512 + 256 + lane * 4) = pk;
    }
    const int rm = rowmap(row);
    {
      float4 g = *(const float4*)(gkv + lane * 4);
      float4 o = make_float4(c0.x * r2 * g.x, c0.y * r2 * g.y, c0.z * r2 * g.z, c0.w * r2 * g.w);
      float* op = (row < TP) ? p.out + O_CKVP + ((size_t)j * TP + row) * 256 : p.out + O_CKVS + ((size_t)j * TS + (row - TP)) * 256;
      *(float4*)(op + lane * 4) = o;
      uint2 pk; pk.x = pack2(o.x, o.y); pk.y = pack2(o.z, o.w);
      *(uint2*)(CKV + (size_t)rm * 256 + lane * 4) = pk;
    }
    if (lane < 16) {
      float x1 = rr[768 + lane], x2 = rr[784 + lane];
      int pos = tokpos(row);
      float2 cs = *(const float2*)(rope + ((size_t)pos * 16 + lane) * 2);
      float o1 = x1 * cs.x - x2 * cs.y, o2 = x1 * cs.y + x2 * cs.x;
      float* op = (row < TP) ? p.out + O_KRP + ((size_t)j * TP + row) * 32 : p.out + O_KRS + ((size_t)j * TS + (row - TP)) * 32;
      op[lane] = o1; op[16 + lane] = o2;
      KR[(size_t)rm * 32 + lane] = tobf(o1); KR[(size_t)rm * 32 + 16 + lane] = tobf(o2);
    }
  }
}

DI void dsa_rowops(PREF p, int bid, int nblk, int wv) {
  const int lane = ltid(wv) & 63, w = ltid(wv) >> 6;
  unsigned char* R = p.ws + OFF_R;
  const float* KIR = (const float*)(R + D_KIR);
  bf16_t* KI = (bf16_t*)(R + D_KI);
  const float* g = p.in[27];
  for (int row = bid * 8 + w; row < T; row += nblk * 8) {
    float v = KIR[(size_t)row * 64 + lane];
    float ss = wave_sum(v * v, lane);
    float r = rsqrtf(ss * (1.f / 64.f) + EPS);
    float o = v * r * g[lane];
    if (row < TP) p.out[O_DIP + (size_t)row * 64 + lane] = o; else p.out[O_DIS + (size_t)(row - TP) * 64 + lane] = o;
    KI[(size_t)rowmap(row) * 64 + lane] = tobf(o);
  }
}

DI void cmlp_ln_rows(PREF p, int bid, int nblk, int wv) {
  const int lane = ltid(wv) & 63, w = ltid(wv) >> 6;
  unsigned char* R = p.ws + OFF_R;
  const bf16_t* VR = (const bf16_t*)(R + C_VR);
  bf16_t* VLN = (bf16_t*)(R + C_VLN);
  const float* g = p.in[18]; const float* bb = p.in[19];
  for (int row = bid * 8 + w; row < T; row += nblk * 8) {
    float x[32];
    float sum = 0.f;
#pragma unroll
    for (int c = 0; c < 4; ++c) {
      uint4 u = *(const uint4*)(VR + (size_t)row * 2048 + c * 512 + lane * 8);
      x[c * 8 + 0] = bflo(u.x); x[c * 8 + 1] = bfhi(u.x); x[c * 8 + 2] = bflo(u.y); x[c * 8 + 3] = bfhi(u.y);
      x[c * 8 + 4] = bflo(u.z); x[c * 8 + 5] = bfhi(u.z); x[c * 8 + 6] = bflo(u.w); x[c * 8 + 7] = bfhi(u.w);
    }
#pragma unroll
    for (int i = 0; i < 32; ++i) sum += x[i];
    sum = wave_sum(sum, lane);
    float mu = sum * (1.f / 2048.f);
    float vs = 0.f;
#pragma unroll
    for (int i = 0; i < 32; ++i) { x[i] -= mu; vs += x[i] * x[i]; }
    vs = wave_sum(vs, lane);
    float r = rsqrtf(vs * (1.f / 2048.f) + EPS);
#pragma unroll
    for (int c = 0; c < 4; ++c) {
      int col = c * 512 + lane * 8;
      float y[8];
#pragma unroll
      for (int q = 0; q < 2; ++q) {
        float4 gg = *(const float4*)(g + col + q * 4), b4 = *(const float4*)(bb + col + q * 4);
        y[q * 4 + 0] = x[c * 8 + q * 4 + 0] * r * gg.x + b4.x; y[q * 4 + 1] = x[c * 8 + q * 4 + 1] * r * gg.y + b4.y;
        y[q * 4 + 2] = x[c * 8 + q * 4 + 2] * r * gg.z + b4.z; y[q * 4 + 3] = x[c * 8 + q * 4 + 3] * r * gg.w + b4.w;
      }
      uint4 pk; pk.x = pack2(y[0], y[1]); pk.y = pack2(y[2], y[3]); pk.z = pack2(y[4], y[5]); pk.w = pack2(y[6], y[7]);
      *(uint4*)(VLN + (size_t)row * 2048 + col) = pk;
      if (row >= TP) {
        float* o = p.out + O_CVS + (size_t)(row - TP) * 2048 + col;
        *(float4*)o = make_float4(y[0], y[1], y[2], y[3]); *(float4*)(o + 4) = make_float4(y[4], y[5], y[6], y[7]);
      }
    }
  }
}

DI void cmlp_mix_phase(PREF p, unsigned char* smem, int bid, int nblk, int wv) {
  const int tid = ltid(wv), lane = tid & 63, w = tid >> 6, wm = w >> 2, wn = w & 3, lr = lane & 31, lh = lane >> 5;
  unsigned char* R = p.ws + OFF_R;
  const bf16_t* U = (const bf16_t*)(R + C_U);
  const bf16_t* VLN = (const bf16_t*)(R + C_VLN);
  bf16_t* G = (bf16_t*)(R + C_G);
  const bf16_t* WT = (const bf16_t*)(p.ws + OFF_W) + W_TRIL;
  const float* bs = p.in[21];
  bf16_t* As = (bf16_t*)smem;
  bf16_t* Bs = As + 128 * 136;
  for (int u = bid; u < 1024; u += nblk) {
    const int g = u & 7, ch = u >> 3;
    const int col0 = g * 256;
#pragma unroll 2
    for (int i = 0; i < 4; ++i) {
      int v = tid + i * NT; int r = v >> 4, c = (v & 15) * 8;
      *(uint4*)(As + r * 136 + c) = *(const uint4*)(WT + ((size_t)g * 128 + r) * 128 + c);
    }
#pragma unroll 2
    for (int i = 0; i < 8; ++i) {
      int v = tid + i * NT; int s = v >> 5, c = (v & 31) * 8;
      uint4 x = *(const uint4*)(VLN + ((size_t)ch * 128 + s) * 2048 + col0 + c);
      Bs[(c + 0) * 136 + s] = (bf16_t)(x.x & 0xffff); Bs[(c + 1) * 136 + s] = (bf16_t)(x.x >> 16);
      Bs[(c + 2) * 136 + s] = (bf16_t)(x.y & 0xffff); Bs[(c + 3) * 136 + s] = (bf16_t)(x.y >> 16);
      Bs[(c + 4) * 136 + s] = (bf16_t)(x.z & 0xffff); Bs[(c + 5) * 136 + s] = (bf16_t)(x.z >> 16);
      Bs[(c + 6) * 136 + s] = (bf16_t)(x.w & 0xffff); Bs[(c + 7) * 136 + s] = (bf16_t)(x.w >> 16);
    }
    __syncthreads();
    f32x16 acc[2][2];
#pragma unroll
    for (int a = 0; a < 2; ++a)
#pragma unroll
      for (int b = 0; b < 2; ++b)
#pragma unroll
        for (int i = 0; i < 16; ++i) acc[a][b][i] = 0.f;
    const bf16_t* Asb = As + (wm * 64 + lr) * 136 + lh * 8;
    const bf16_t* Bsb = Bs + (wn * 64 + lr) * 136 + lh * 8;
    const int ns = (wm + 1) * 4;
    for (int s = 0; s < ns; ++s) {
      bf16x8 a0 = *(const bf16x8*)(Asb + s * 16);
      bf16x8 a1 = *(const bf16x8*)(Asb + 32 * 136 + s * 16);
      bf16x8 b0 = *(const bf16x8*)(Bsb + s * 16);
      bf16x8 b1 = *(const bf16x8*)(Bsb + 32 * 136 + s * 16);
      acc[0][0] = MFMA32(a0, b0, acc[0][0]);
      acc[0][1] = MFMA32(a0, b1, acc[0][1]);
      acc[1][0] = MFMA32(a1, b0, acc[1][0]);
      acc[1][1] = MFMA32(a1, b1, acc[1][1]);
    }
#pragma unroll
    for (int mi = 0; mi < 2; ++mi)
#pragma unroll
      for (int ni = 0; ni < 2; ++ni)
#pragma unroll
        for (int i = 0; i < 16; ++i) {
          int t = wm * 64 + mi * 32 + crow(i, lh);
          int col = col0 + wn * 64 + ni * 32 + lr;
          size_t off = ((size_t)ch * 128 + t) * 2048 + col;
          float mixed = acc[mi][ni][i] + bs[g * 128 + t];
          G[off] = tobf(frombf(U[off]) * mixed);
        }
    __syncthreads();
  }
  const float* wsf = p.in[20];
  for (int e = bid * NT + tid; e < TS * 2048; e += nblk * NT) {
    int row = e >> 11, col = e & 2047, b = row >> 4, t = row & 15, g = col >> 8;
    float a = bs[g * 128 + t];
    for (int s = 0; s <= t; ++s) a += wsf[((size_t)g * 128 + t) * 128 + s] * frombf(VLN[((size_t)TP + b * 16 + s) * 2048 + col]);
    size_t off = ((size_t)TP + row) * 2048 + col;
    G[off] = tobf(frombf(U[off]) * a);
  }
}

template <int DQK, bool IS_MLA, bool MASKED>
DI void attn8_unit(const bf16_t* __restrict__ Qp, int ldq, int nq,
                   const bf16_t* __restrict__ Kp, int ldk, const bf16_t* __restrict__ KRp,
                   const bf16_t* __restrict__ Vtp, int ldv, int kmax,
                   int nit, int nk64_w, int nkeys, const unsigned* __restrict__ BMp,
                   bf16_t* __restrict__ AOp, unsigned char* smem, int wv) {
  constexpr int KS = DQK + 8;
  constexpr int VS = 136;
  constexpr int NQS = DQK / 16;
  const int tid = ltid(wv), lane = tid & 63, w = tid >> 6, lr = lane & 31, lh = lane >> 5;
  bf16_t* Ks = (bf16_t*)smem;
  bf16_t* Vs = Ks + 2 * 128 * KS;
  const bool q_ok = (w * 32 + lr) < nq;
  const int qrow = q_ok ? (w * 32 + lr) : 0;
  bf16x8 qf[NQS];
#pragma unroll
  for (int s = 0; s < NQS; ++s) qf[s] = *(const bf16x8*)(Qp + (size_t)qrow * ldq + s * 16 + lh * 8);
  f32x16 oacc[2];
#pragma unroll
  for (int d = 0; d < 2; ++d)
#pragma unroll
    for (int i = 0; i < 16; ++i) oacc[d][i] = 0.f;
  float m_run = -INFINITY, l_run = 0.f;
  const int kkey = tid >> 3, kc = (tid & 7) * 8;
  const int rkey = tid >> 2, rc = (tid & 3) * 8;
  const int vd = tid >> 4, vk = (tid & 15) * 8;
  const int vpos = (vk & 96) + ((vk >> 4) & 1) * 16 + ((vk >> 3) & 1) * 4;
  uint4 rk0, rk1, rr, rv0, rv1;
  rr = make_uint4(0, 0, 0, 0);
  uint4 bm_next = make_uint4(0xffffffffu, 0xffffffffu, 0xffffffffu, 0xffffffffu), bm_cur = bm_next;
#define GLOAD(it_) do { const int key0_ = (it_) * 128; \
    { int kr_ = min(key0_ + kkey, kmax - 1); rk0 = *(const uint4*)(Kp + (size_t)kr_ * ldk + kc); } \
    { int kr_ = min(key0_ + kkey + 64, kmax - 1); rk1 = *(const uint4*)(Kp + (size_t)kr_ * ldk + kc); } \
    if constexpr (IS_MLA) { int kr_ = min(key0_ + rkey, kmax - 1); rr = *(const uint4*)(KRp + (size_t)kr_ * 32 + rc); } \
    { int kv_ = min(key0_ + vk, kmax - 8); rv0 = *(const uint4*)(Vtp + (size_t)vd * ldv + kv_); rv1 = *(const uint4*)(Vtp + (size_t)(vd + 32) * ldv + kv_); } \
    if constexpr (MASKED) { if (BMp) bm_next = *(const uint4*)(BMp + (size_t)qrow * 256 + (it_) * 4); } } while (0)
#define SSTORE(buf_) do { bf16_t* Kb_ = Ks + (buf_) * 128 * KS; bf16_t* Vb_ = Vs + (buf_) * 64 * VS; \
    *(uint4*)(Kb_ + kkey * KS + kc) = rk0; *(uint4*)(Kb_ + (kkey + 64) * KS + kc) = rk1; \
    if constexpr (IS_MLA) *(uint4*)(Kb_ + rkey * KS + 64 + rc) = rr; \
    *(uint2*)(Vb_ + vd * VS + vpos) = make_uint2(rv0.x, rv0.y); *(uint2*)(Vb_ + vd * VS + vpos + 8) = make_uint2(rv0.z, rv0.w); \
    *(uint2*)(Vb_ + (vd + 32) * VS + vpos) = make_uint2(rv1.x, rv1.y); *(uint2*)(Vb_ + (vd + 32) * VS + vpos + 8) = make_uint2(rv1.z, rv1.w); } while (0)
  const int nit_w = (nk64_w + 1) >> 1;
  __syncthreads();
  GLOAD(0); SSTORE(0); bm_cur = bm_next;
  __syncthreads();
  for (int it = 0; it < nit; ++it) {
    const int buf = it & 1;
    if (it + 1 < nit) GLOAD(it + 1);
    if (it < nit_w) {
      const bf16_t* Kb = Ks + buf * 128 * KS; const bf16_t* Vb = Vs + buf * 64 * VS;
      f32x16 sacc[4];
#pragma unroll
      for (int t4 = 0; t4 < 4; ++t4) {
#pragma unroll
        for (int i = 0; i < 16; ++i) sacc[t4][i] = 0.f;
#pragma unroll
        for (int s = 0; s < NQS; ++s) {
          bf16x8 kf = *(const bf16x8*)(Kb + (t4 * 32 + lr) * KS + s * 16 + lh * 8);
          sacc[t4] = MFMA32(kf, qf[s], sacc[t4]);
        }
      }
      if ((2 * it + 1) >= nk64_w) {
#pragma unroll
        for (int t4 = 2; t4 < 4; ++t4)
#pragma unroll
          for (int i = 0; i < 16; ++i) sacc[t4][i] = -INFINITY;
      }
      float mx = -INFINITY;
#pragma unroll
      for (int t4 = 0; t4 < 4; ++t4) {
        const int remk = nkeys - (it * 128 + t4 * 32);
        const unsigned vmask = remk >= 32 ? 0xffffffffu : (remk <= 0 ? 0u : ((1u << remk) - 1u));
        const unsigned wbits = (((t4 == 0) ? bm_cur.x : (t4 == 1) ? bm_cur.y : (t4 == 2) ? bm_cur.z : bm_cur.w) & vmask) >> (4 * lh);
#pragma unroll
        for (int i = 0; i < 16; ++i) {
          if constexpr (MASKED) {
            const bool ok = (wbits >> ((i & 3) + 8 * (i >> 2))) & 1u;
            sacc[t4][i] = ok ? sacc[t4][i] : -INFINITY;
          }
          mx = fmaxf(mx, sacc[t4][i]);
        }
      }
      mx = fmaxf(mx, shflx(mx, 32, lane));
      const float m_new = fmaxf(m_run, mx);
      const float m_safe = (m_new == -INFINITY) ? 0.f : m_new;
      const float alpha = __builtin_amdgcn_exp2f(m_run - m_safe);
      m_run = m_new;
      float ls = 0.f;
#pragma unroll
      for (int t4 = 0; t4 < 4; ++t4)
#pragma unroll
        for (int i = 0; i < 16; ++i) { float pv = __builtin_amdgcn_exp2f(sacc[t4][i] - m_safe); sacc[t4][i] = pv; ls += pv; }
      l_run = l_run * alpha + ls;
#pragma unroll
      for (int d = 0; d < 2; ++d)
#pragma unroll
        for (int i = 0; i < 16; ++i) oacc[d][i] *= alpha;
#pragma unroll
      for (int t4 = 0; t4 < 4; ++t4)
#pragma unroll
        for (int s = 0; s < 2; ++s) {
          uint4 pp;
          pp.x = pack2(sacc[t4][8 * s + 0], sacc[t4][8 * s + 1]);
          pp.y = pack2(sacc[t4][8 * s + 2], sacc[t4][8 * s + 3]);
          pp.z = pack2(sacc[t4][8 * s + 4], sacc[t4][8 * s + 5]);
          pp.w = pack2(sacc[t4][8 * s + 6], sacc[t4][8 * s + 7]);
          bf16x8 pf = __builtin_bit_cast(bf16x8, pp);
#pragma unroll
          for (int dt = 0; dt < 2; ++dt) {
            bf16x8 vf = *(const bf16x8*)(Vb + (dt * 32 + lr) * VS + t4 * 32 + 16 * s + 8 * lh);
            oacc[dt] = MFMA32(vf, pf, oacc[dt]);
          }
        }
    }
    if (it + 1 < nit) { SSTORE(buf ^ 1); bm_cur = bm_next; }
    __syncthreads();
  }
  if (nit_w > 0) {
    float lt = l_run + shflx(l_run, 32, lane);
    float inv = lt > 0.f ? 1.f / lt : 0.f;
    if (q_ok) {
      bf16_t* orow = AOp + (size_t)(w * 32 + lr) * 1024;
#pragma unroll
      for (int dt = 0; dt < 2; ++dt)
#pragma unroll
        for (int g = 0; g < 4; ++g) {
          uint2 pk;
          pk.x = pack2(oacc[dt][4 * g] * inv, oacc[dt][4 * g + 1] * inv);
          pk.y = pack2(oacc[dt][4 * g + 2] * inv, oacc[dt][4 * g + 3] * inv);
          *(uint2*)(orow + dt * 32 + 8 * g + 4 * lh) = pk;
        }
    }
  }
}
#undef GLOAD
#undef SSTORE

DI int snake_idx(int i, int bid, int nblk) { return i * nblk + ((i & 1) ? (nblk - 1 - bid) : bid); }

template <bool IS_MLA>
DI void attn_phase(PREF p, unsigned char* smem, int bid, int nblk, int wv) {
  unsigned char* R = p.ws + OFF_R;
  const int w = ltid(wv) >> 6;
  const int total = 1024 + 512;
  for (int i = 0; i * nblk < total; ++i) {
    int u = snake_idx(i, bid, nblk);
    if (u >= total) continue;
    if constexpr (IS_MLA) {
      const bf16_t* Q = (const bf16_t*)(R + R_Q); const bf16_t* KN = (const bf16_t*)(R + R_KN);
      const bf16_t* KR = (const bf16_t*)(R + R_KR); const bf16_t* VT = (const bf16_t*)(R + R_VT);
      bf16_t* AO = (bf16_t*)(R + R_RAW);
      if (u < 1024) {
        int qt = 31 - (u >> 5), bh = u & 31, b = bh >> 4, h = bh & 15;
        int q0 = b * 8192 + qt * 256;
        attn8_unit<96, true, false>(Q + (size_t)q0 * 1536 + h * 96, 1536, 256,
                                    KN + (size_t)(b * 8192) * 1024 + h * 64, 1024, KR + (size_t)(b * 8192) * 32,
                                    VT + (size_t)((b * 16 + h) * 64) * 8192, 8192, 8192,
                                    2 * qt + 2, 4 * qt + 1 + (w >> 1), 1 << 30, nullptr,
                                    AO + (size_t)q0 * 1024 + h * 64, smem, wv);
      } else {
        int v = u - 1024, b = v >> 4, h = v & 15;
        int q0 = TP + b * 16;
        attn8_unit<96, true, true>(Q + (size_t)q0 * 1536 + h * 96, 1536, 16,
                                   KN + (size_t)(TP + b * SPAD) * 1024 + h * 64, 1024, KR + (size_t)(TP + b * SPAD) * 32,
                                   VT + (size_t)TP * 1024 + (size_t)((b * 16 + h) * 64) * SPAD, SPAD, SPAD,
                                   9, (w == 0) ? 17 : 0, NKS, nullptr,
                                   AO + (size_t)q0 * 1024 + h * 64, smem, wv);
      }
    } else {
      const bf16_t* Q = (const bf16_t*)(R + D_Q); const bf16_t* KK = (const bf16_t*)(R + D_K);
      const bf16_t* VT = (const bf16_t*)(R + D_VT); const unsigned* BM = (const unsigned*)(R + D_BM);
      bf16_t* AO = (bf16_t*)(R + D_AO);
      if (u < 1024) {
        int qt = 31 - (u >> 5), bh = u & 31, b = bh >> 4, h = bh & 15;
        int q0 = b * 8192 + qt * 256;
        attn8_unit<64, false, true>(Q + (size_t)q0 * 1024 + h * 64, 1024, 256,
                                    KK + (size_t)(b * 8192) * 1024 + h * 64, 1024, nullptr,
                                    VT + (size_t)((b * 16 + h) * 64) * 8192, 8192, 8192,
                                    2 * qt + 2, 4 * qt + 1 + (w >> 1), 1 << 30, BM + (size_t)q0 * 256,
                                    AO + (size_t)q0 * 1024 + h * 64, smem, wv);
      } else {
        int v = u - 1024, b = v >> 4, h = v & 15;
        int q0 = TP + b * 16;
        attn8_unit<64, false, true>(Q + (size_t)q0 * 1024 + h * 64, 1024, 16,
                                    KK + (size_t)(TP + b * SPAD) * 1024 + h * 64, 1024, nullptr,
                                    VT + (size_t)TP * 1024 + (size_t)((b * 16 + h) * 64) * SPAD, SPAD, SPAD,
                                    9, (w == 0) ? 17 : 0, NKS, BM + (size_t)q0 * 256,
                                    AO + (size_t)q0 * 1024 + h * 64, smem, wv);
      }
    }
  }
}

constexpr int CAP = 128;
DI int score_bin(float s) {
  unsigned u = __float_as_uint(s);
  int e = (int)((u & 0x7fffffffu) >> 19);
  int m = min(max(e, 1840), 2095) - 1840;
  return (u >> 31) ? (255 - m) : (256 + m);
}

DI void idx_unit(const bf16_t* __restrict__ QI, const float* __restrict__ WI, int q_row0, int nq,
                 const bf16_t* __restrict__ KI, int L, unsigned* __restrict__ BM, unsigned char* smem, int wv) {
  const int tid = ltid(wv), lane = tid & 63, w = tid >> 6, lr = lane & 31, lh = lane >> 5;
  bf16_t* Qs = (bf16_t*)smem;
  float* Ws = (float*)(smem + 36864);
  unsigned* hist = (unsigned*)(smem + 36864 + 1024);
  float* cand_s = (float*)hist;
  int* cand_i = (int*)(smem + 36864 + 1024 + 16384);
  int* bstar = (int*)(smem + 36864 + 1024 + 32768);
  int* need = bstar + 32;
  int* ncand = need + 32;
  __syncthreads();
#pragma unroll
  for (int i = 0; i < 4; ++i) {
    int v = tid + i * NT;
    int hd = v >> 8, q = (v >> 3) & 31, c = (v & 7) * 8;
    int qq = q < nq ? q : 0;
    *(uint4*)(Qs + (hd * 32 + q) * 72 + c) = *(const uint4*)(QI + (size_t)(q_row0 + qq) * 512 + hd * 64 + c);
  }
  if (tid < 256) { int hd = tid >> 5, q = tid & 31; int qq = q < nq ? q : 0; Ws[hd * 32 + q] = WI[(size_t)(q_row0 + qq) * 8 + hd]; }
  for (int i = tid; i < 32 * 256; i += NT) hist[i] = 0u;
  if (tid < 32) { bstar[tid] = -1; need[tid] = 0; ncand[tid] = 0; }
  __syncthreads();
  const int ntile = (L + 255) >> 8;
  const bool do_select = L > 256;
  int bsr[16];
  { int m1_ = -1; asm volatile("" : "+v"(m1_));
#pragma unroll
    for (int i = 0; i < 16; ++i) bsr[i] = m1_; }
  for (int pass = do_select ? 0 : 1; pass < 2; ++pass) {
    if (pass == 1) {
#pragma unroll
      for (int i = 0; i < 16; ++i) bsr[i] = bstar[crow(i, lh)];
    }
    bf16x8 kn0, kn1, kn2, kn3;
    { const bf16_t* kp = KI + (size_t)(w * 32 + lr) * 64 + lh * 8;
      kn0 = *(const bf16x8*)(kp); kn1 = *(const bf16x8*)(kp + 16); kn2 = *(const bf16x8*)(kp + 32); kn3 = *(const bf16x8*)(kp + 48); }
    for (int kt = 0; kt < ntile; ++kt) {
      const int key0 = kt * 256 + w * 32;
      bf16x8 kf[4];
      kf[0] = kn0; kf[1] = kn1; kf[2] = kn2; kf[3] = kn3;
      if (key0 + 256 < L) {
        const bf16_t* kp = KI + (size_t)(key0 + 256 + lr) * 64 + lh * 8;
        kn0 = *(const bf16x8*)(kp); kn1 = *(const bf16x8*)(kp + 16); kn2 = *(const bf16x8*)(kp + 32); kn3 = *(const bf16x8*)(kp + 48);
      }
      if (key0 < L) {
        const int key = key0 + lr;
        float sc[16];
#pragma unroll
        for (int i = 0; i < 16; ++i) sc[i] = 0.f;
#pragma unroll 1
        for (int hd = 0; hd < 8; ++hd) {
          f32x16 acc;
#pragma unroll
          for (int i = 0; i < 16; ++i) acc[i] = 0.f;
#pragma unroll
          for (int s = 0; s < 4; ++s) {
            bf16x8 qf = *(const bf16x8*)(Qs + (hd * 32 + lr) * 72 + s * 16 + lh * 8);
            acc = MFMA32(qf, kf[s], acc);
          }
#pragma unroll
          for (int g = 0; g < 4; ++g) {
            float4 wv = *(const float4*)(Ws + hd * 32 + 8 * g + 4 * lh);
            sc[4 * g + 0] += wv.x * fmaxf(acc[4 * g + 0], 0.f);
            sc[4 * g + 1] += wv.y * fmaxf(acc[4 * g + 1], 0.f);
            sc[4 * g + 2] += wv.z * fmaxf(acc[4 * g + 2], 0.f);
            sc[4 * g + 3] += wv.w * fmaxf(acc[4 * g + 3], 0.f);
          }
        }
        const bool kvalid = key < L;
        if (pass == 0) {
#pragma unroll
          for (int i = 0; i < 16; ++i) {
            int q = crow(i, lh);
            if (kvalid) { int b = score_bin(sc[i]); atomicAdd(&hist[q * 256 + (b >> 1)], (b & 1) ? 65536u : 1u); }
          }
        } else {
          unsigned myword = 0u, cmask = 0u;
          unsigned long long any = 0ull;
#pragma unroll
          for (int i = 0; i < 16; ++i) {
            const int b = score_bin(sc[i]);
            const int bs = bsr[i];
            const bool sel = kvalid && (b > bs);
            const bool cnd = kvalid && (b == bs);
            const unsigned long long bal = __ballot(sel);
            myword = (lr == i) ? (unsigned)(bal >> (32 * lh)) : myword;
            any |= __ballot(cnd);
            cmask |= cnd ? (1u << i) : 0u;
          }
          if (lr < 16 && crow(lr, lh) < nq) BM[(size_t)(q_row0 + crow(lr, lh)) * 256 + (key0 >> 5)] = myword;
          if (any != 0ull) {
            int base[16];
#pragma unroll
            for (int i = 0; i < 16; ++i) {
              const unsigned long long cbi = __ballot((cmask >> i) & 1u);
              base[i] = 0;
              if (lr == 0) base[i] = atomicAdd(&ncand[crow(i, lh)], __popc((unsigned)(cbi >> (32 * lh))));
            }
#pragma unroll
            for (int i = 0; i < 16; ++i) {
              const unsigned long long cbi = __ballot((cmask >> i) & 1u);
              const int bb = __builtin_amdgcn_ds_bpermute((lane & 32) << 2, base[i]);
              if ((cmask >> i) & 1u) {
                const unsigned hm = (unsigned)(cbi >> (32 * lh));
                const int pos = bb + __popc(hm & ((1u << lr) - 1u));
                const int q = crow(i, lh);
                if (pos < CAP) { cand_s[q * CAP + pos] = sc[i]; cand_i[q * CAP + pos] = key; }
              }
            }
          }
        }
      }
    }
    __syncthreads();
    if (pass == 0) {
      for (int qi = 0; qi < 4; ++qi) {
        const int q = w * 4 + qi;
        unsigned hw[4];
#pragma unroll
        for (int k = 0; k < 4; ++k) hw[k] = hist[q * 256 + 255 - 4 * lane - k];
        int cnt = 0;
#pragma unroll
        for (int k = 0; k < 4; ++k) cnt += (int)(hw[k] >> 16) + (int)(hw[k] & 0xffffu);
        int pre = cnt;
#pragma unroll
        for (int o = 1; o < 64; o <<= 1) { int t = __builtin_amdgcn_ds_bpermute(((lane - o) & 63) << 2, pre); if (lane >= o) pre += t; }
        unsigned long long bal = __ballot(pre >= 256);
        if (bal != 0ull) {
          int fl = __ffsll((long long)bal) - 1;
          if (lane == fl) {
            int running = pre - cnt;
            int bsel = -1, above = 0;
#pragma unroll
            for (int k = 0; k < 4; ++k) {
              int chi = (int)(hw[k] >> 16), clo = (int)(hw[k] & 0xffffu);
              if (bsel < 0) { if (running + chi >= 256) { bsel = 511 - 8 * lane - 2 * k; above = running; } else running += chi; }
              if (bsel < 0) { if (running + clo >= 256) { bsel = 510 - 8 * lane - 2 * k; above = running; } else running += clo; }
            }
            bstar[q] = bsel; need[q] = 256 - above;
          }
        }
      }
      __syncthreads();
    }
  }
  __threadfence();
  __syncthreads();
  if (do_select) {
    for (int pi = tid; pi < 32 * CAP; pi += NT) {
      int q = pi / CAP, c = pi - q * CAP;
      int n = min(ncand[q], CAP);
      if (c < n && q < nq) {
        float sv = cand_s[q * CAP + c]; int iv = cand_i[q * CAP + c];
        int rank = 0;
        for (int j = 0; j < n; ++j) {
          float sj = cand_s[q * CAP + j]; int ij = cand_i[q * CAP + j];
          rank += (sj > sv || (sj == sv && ij < iv)) ? 1 : 0;
        }
        if (rank < need[q]) atomicOr(&BM[(size_t)(q_row0 + q) * 256 + (iv >> 5)], 1u << (iv & 31));
      }
    }
  }
  __syncthreads();
}

DI void idx_phase(PREF p, unsigned char* smem, int bid, int nblk, int wv) {
  unsigned char* R = p.ws + OFF_R;
  const bf16_t* QI = (const bf16_t*)(R + D_QI); const float* WI = (const float*)(R + D_WI);
  const bf16_t* KI = (const bf16_t*)(R + D_KI); unsigned* BM = (unsigned*)(R + D_BM);
  const int total = 512 + 32;
  for (int i = 0; i * nblk < total; ++i) {
    int idx = snake_idx(i, bid, nblk);
    if (idx >= total) continue;
    if (idx < 512) {
      int qt = 255 - (idx >> 1), b = idx & 1;
      int L = (((qt * 32) >> 6) + 1) * 64;
      idx_unit(QI, WI, b * 8192 + qt * 32, 32, KI + (size_t)(b * 8192) * 64, L, BM, smem, wv);
    } else {
      int b = idx - 512;
      idx_unit(QI, WI, TP + b * 16, 16, KI + (size_t)(TP + b * SPAD) * 64, NKS, BM, smem, wv);
    }
  }
}

DI void cvt8(const float* s, bf16_t* d) {
  float4 a = *(const float4*)s, b = *(const float4*)(s + 4);
  uint4 pk; pk.x = pack2(a.x, a.y); pk.y = pack2(a.z, a.w); pk.z = pack2(b.x, b.y); pk.w = pack2(b.z, b.w);
  *(uint4*)d = pk;
}
DI void cache_rows(const float* __restrict__ src, bf16_t* __restrict__ dst, int Wd, int bid, int nblk, int wv) {
  const int vpr = Wd >> 3;
  const size_t total = (size_t)32 * SPAD * vpr;
  for (size_t e = (size_t)bid * NT + ltid(wv); e < total; e += (size_t)nblk * NT) {
    int c = (int)(e % vpr) * 8; size_t rw = e / vpr; int b = (int)(rw / SPAD), s = (int)(rw % SPAD);
    bf16_t* d = dst + ((size_t)TP + (size_t)b * SPAD + s) * Wd + c;
    if (s < 1024) cvt8(src + ((size_t)b * 1024 + s) * Wd + c, d);
    else if (s >= NKS) { unsigned z = 0; asm volatile("" : "+v"(z)); *(uint4*)d = make_uint4(z, z, z, z); }
  }
}


#define XB_TMO      128
#define XB_XCNT(j)  (256  + 64 * (j))
#define XB_XSUB(j)  (1280 + 64 * (j))
#define XB_XGEN(j)  (2304 + 64 * (j))
#define XB_TOP      3328
#define XB_TOPGEN   3392
#define XCD_BAR_WORDS 3456
#define XB_SPIN_CAP (1u << 18)
DI unsigned xb_ld(unsigned* p)              { return __hip_atomic_load(p, __ATOMIC_RELAXED, __HIP_MEMORY_SCOPE_AGENT); }
DI unsigned xb_add(unsigned* p, unsigned v) { return __hip_atomic_fetch_add(p, v, __ATOMIC_RELAXED, __HIP_MEMORY_SCOPE_AGENT); }
DI unsigned xb_xcc_id() { return (unsigned)__builtin_amdgcn_s_getreg((3 << 11) | 20) & 0xFu; }
#define XB_SPIN(cond, bar) do { unsigned _sp = 0; while (cond) { __builtin_amdgcn_s_sleep(1); \
    if ((++_sp & 255u) == 0u) { if (xb_ld(&(bar)[XB_TMO])) break; if (_sp > XB_SPIN_CAP) { atomicAdd(&(bar)[XB_TMO], 1u); break; } } } } while (0)
struct XcdBarrier { unsigned* bar; unsigned x; volatile __attribute__((address_space(3))) unsigned* st; };
DI void xcd_barrier_complete(unsigned* bar, unsigned x, unsigned G, unsigned& nloc, unsigned& nx) {
  unsigned sum, cnt, mine, sp = 0u;
  for (;;) {
    sum = 0u; cnt = 0u; mine = 0u;
#pragma unroll
    for (unsigned j = 0; j < 16; ++j) { const unsigned c = xb_ld(&bar[XB_XCNT(j)]); sum += c; cnt += (c > 0u) ? 1u : 0u; mine = (j == x) ? c : mine; }
    if (sum == G) break;
    __builtin_amdgcn_s_sleep(1);
    if ((++sp & 255u) == 0u) { if (xb_ld(&bar[XB_TMO])) break; if (sp > XB_SPIN_CAP) { atomicAdd(&bar[XB_TMO], 1u); break; } }
  }
  nloc = mine > 0u ? mine : 1u; nx = cnt > 0u ? cnt : 1u;
}
DI void xcd_barrier(const XcdBarrier& b, int tid, unsigned G) {
  asm volatile("s_waitcnt vmcnt(0)" ::: "memory");
  __syncthreads();
  if (tid == 0) {
    unsigned* bar = b.bar;
    __builtin_amdgcn_s_waitcnt(0);
    unsigned nloc = b.st[0], nx = b.st[1];
    if (nloc == 0u) { xcd_barrier_complete(bar, b.x, G, nloc, nx); b.st[0] = nloc; b.st[1] = nx; }
    const unsigned old = xb_add(&bar[XB_XSUB(b.x)], 1u);
    const unsigned gen = old / nloc;
    if (old + 1u == (gen + 1u) * nloc) {
      __builtin_amdgcn_fence(__ATOMIC_RELEASE, "agent");
      asm volatile("s_waitcnt vmcnt(0)" ::: "memory");
      const unsigned og = xb_add(&bar[XB_TOP], 1u);
      const unsigned tg = og / nx;
      if (og + 1u == (tg + 1u) * nx) xb_add(&bar[XB_TOPGEN], 1u);
      else XB_SPIN(xb_ld(&bar[XB_TOPGEN]) == tg, bar);
      __builtin_amdgcn_fence(__ATOMIC_ACQUIRE, "agent");
      xb_add(&bar[XB_XGEN(b.x)], 1u);
      asm volatile("s_waitcnt vmcnt(0)" ::: "memory");
    } else {
      XB_SPIN(xb_ld(&bar[XB_XGEN(b.x)]) == gen, bar);
      __builtin_amdgcn_fence(__ATOMIC_ACQUIRE, "agent");
      asm volatile("s_waitcnt vmcnt(0)" ::: "memory");
    }
  }
  __syncthreads();
}

extern "C" __global__ void __launch_bounds__(512, 2) mega(Params p_unused) {
  extern __shared__ __attribute__((aligned(16))) unsigned char smem[];
  cg::grid_group grid = cg::this_grid();
  const int bid = blockIdx.x, nblk = gridDim.x;
  const int wv = __builtin_amdgcn_readfirstlane((int)(threadIdx.x >> 6));
  CParams* pk = (CParams*)__builtin_amdgcn_kernarg_segment_ptr();
  const int ph_lo = pk->ph_lo, ph_hi = pk->ph_hi;
  int ph = 0;
  if (ph_lo > 0x40000000) grid.sync();
  XcdBarrier xb;
  {
    volatile __attribute__((address_space(3))) unsigned* st = (volatile __attribute__((address_space(3))) unsigned*)(smem + 131072);
    const int t0 = ltid(wv);
    if (t0 == 0) { st[0] = 0u; st[1] = 0u; }
    __syncthreads();
    xb.bar = (unsigned*)(pk->ws + OFF_BAR); xb.x = xb_xcc_id(); xb.st = st;
    if (t0 == 0) (void)xb_add(&xb.bar[XB_XCNT(xb.x)], 1u);
  }
#ifndef REPMASK
#define REPMASK 0u
#endif
#ifndef PMASK
#define PMASK 0xffffffffu
#endif
#define PHASE_BEGIN(k) if (ph >= ph_lo && ph < ph_hi) { if constexpr ((PMASK >> (k)) & 1u) for (int rep_ = 0; rep_ < 1 + (int)((REPMASK >> (k)) & 1u); ++rep_) { \
    CParams* pp_ = pk; asm volatile("" : "+s"(pp_)); PREF p = *pp_; const int tid = ltid(wv); \
    unsigned char* ws = p.ws; float* X = (float*)(ws + OFF_X); bf16_t* H = (bf16_t*)(ws + OFF_H); bf16_t* Wb = (bf16_t*)(ws + OFF_W); \
    float* ROPE = (float*)(ws + OFF_ROPE); unsigned char* R = ws + OFF_R; (void)tid; (void)X; (void)H; (void)Wb; (void)ROPE; (void)R;
#define PHASE_END   } if (ph + 1 < ph_hi) { xcd_barrier(xb, ltid(wv), (unsigned)nblk); } } ++ph;

  PHASE_BEGIN(0)
    {
      const int hf = tid >> 8, tl = tid & 255;
      float* smh = (float*)smem + hf * 4224;
      for (int t0 = bid * 2; t0 < p.total_tiles; t0 += nblk * 2) {
        const int t = t0 + hf;
        const bool active = t < p.total_tiles;
        const int tt = active ? t : 0;
        int ji = 0;
#pragma unroll 1
        for (int q = 1; q < NJOBS; ++q) if (tt >= p.jobs[q].tile0) ji = q;
        const CAS Job& jb = p.jobs[ji];
        int lt = tt - jb.tile0; int nkt = jb.k >> 6; int nt_ = lt / nkt, kt_ = lt - nt_ * nkt;
        transpose_tile(jb.src, jb.nsrc, jb.nsrc, jb.dst, jb.k, nt_ * 64, kt_ * 64, jb.mode, smh, tl, active);
      }
    }
    {
      const size_t n4p = (size_t)TP * 256, n4 = (size_t)T * 256;
      const float4* xp = (const float4*)p.in[0]; const float4* xs = (const float4*)p.in[1];
      for (size_t e = (size_t)bid * NT + tid; e < n4; e += (size_t)nblk * NT) ((float4*)X)[e] = (e < n4p) ? xp[e] : xs[e - n4p];
      for (int e = bid * NT + tid; e < 8192 * 16; e += nblk * NT) {
        int pos = e >> 4, i = e & 15;
        double rev = (double)pos * p.inv_freq[i] * 0.15915494309189535;
        rev -= floor(rev);
        float fr = (float)rev;
        ROPE[2 * e] = __builtin_amdgcn_cosf(fr); ROPE[2 * e + 1] = __builtin_amdgcn_sinf(fr);
      }
      const float* wsrc = p.in[20];
      for (int e = bid * NT + tid; e < 8 * 128 * 128; e += nblk * NT) {
        int s = e & 127, t = (e >> 7) & 127;
        Wb[W_TRIL + e] = tobf(s <= t ? wsrc[e] : 0.f);
      }
    }
  PHASE_END

#pragma unroll 1
  for (int L = 0; L < 4; ++L) {
    const int kind = L % 3, j = L / 3;
    if (kind == 0) {
      PHASE_BEGIN(1)
        rmsnorm_rows(X, p.in[7] + L * 1024, H, nullptr, nullptr, bid, nblk, wv);
        cache_rows(p.in[2] + (size_t)j * 32 * 1024 * 256, (bf16_t*)(R + R_CKV), 256, bid, nblk, wv);
        cache_rows(p.in[3] + (size_t)j * 32 * 1024 * 32, (bf16_t*)(R + R_KR), 32, bid, nblk, wv);
      PHASE_END
      PHASE_BEGIN(2)
        EArgs ea{}; ea.f0 = (float*)(R + R_RAW);
        gemm_phase<E_F32>(H, Wb + W_MLA + (size_t)j * WM_SZ + WM_D, T, 1024, 1024, ea, smem, 0, bid, nblk, wv);
      PHASE_END
      PHASE_BEGIN(3)
        mla_rowops(p, j, bid, nblk, wv);
      PHASE_END
      PHASE_BEGIN(4)
        EArgs ea{}; ea.b0 = (bf16_t*)(R + R_Q); ea.rope = ROPE;
        gemm_phase<E_MLAQ>((const bf16_t*)(R + R_CQ), Wb + W_MLA + (size_t)j * WM_SZ + WM_UQ, T, 1536, 512, ea, smem, 0, bid, nblk, wv);
        EArgs eb{}; eb.b0 = (bf16_t*)(R + R_KN); eb.b1 = (bf16_t*)(R + R_VT);
        gemm_phase<E_MLAKV>((const bf16_t*)(R + R_CKV), Wb + W_MLA + (size_t)j * WM_SZ + WM_UKV, KROWS, 2048, 256, eb, smem, (T / 256) * 6, bid, nblk, wv);
      PHASE_END
      PHASE_BEGIN(5)
        attn_phase<true>(p, smem, bid, nblk, wv);
      PHASE_END
      PHASE_BEGIN(6)
        EArgs ea{}; ea.f0 = X;
        gemm_phase<E_RESID>((const bf16_t*)(R + R_RAW), Wb + W_MLA + (size_t)j * WM_SZ + WM_O, T, 1024, 1024, ea, smem, 0, bid, nblk, wv);
      PHASE_END
    } else if (kind == 1) {
      PHASE_BEGIN(1)
        rmsnorm_rows(X, p.in[7] + L * 1024, H, nullptr, nullptr, bid, nblk, wv);
      PHASE_END
      PHASE_BEGIN(7)
        EArgs ea{}; ea.b0 = (bf16_t*)(R + C_U); ea.b1 = (bf16_t*)(R + C_VR);
        gemm_phase<E_GELU>(H, Wb + W_CM + WC_IN, T, 4096, 1024, ea, smem, 0, bid, nblk, wv);
      PHASE_END
      PHASE_BEGIN(8)
        cmlp_ln_rows(p, bid, nblk, wv);
      PHASE_END
      PHASE_BEGIN(9)
        cmlp_mix_phase(p, smem, bid, nblk, wv);
      PHASE_END
      PHASE_BEGIN(6)
        EArgs ea{}; ea.f0 = X;
        gemm_phase<E_RESID>((const bf16_t*)(R + C_G), Wb + W_CM + WC_OUT, T, 1024, 2048, ea, smem, 0, bid, nblk, wv);
      PHASE_END
    } else {
      PHASE_BEGIN(10)
        rmsnorm_rows(X, p.in[7] + L * 1024, H, nullptr, nullptr, bid, nblk, wv);
        cache_rows(p.in[4], (bf16_t*)(R + D_K), 1024, bid, nblk, wv);
        cache_rows(p.in[6], (bf16_t*)(R + D_KI), 64, bid, nblk, wv);
        {
          bf16_t* VTs = (bf16_t*)(R + D_VT) + (size_t)TP * 1024;
          {
            const int hf = tid >> 8, tl = tid & 255;
            float* smh = (float*)smem + hf * 4224;
            for (int u0 = bid * 2; u0 < 512 * 16; u0 += nblk * 2) {
              const int u = u0 + hf;
              int st = u & 15, bh = u >> 4, b = bh >> 4, h = bh & 15;
              transpose_tile(p.in[5] + (size_t)b * 1024 * 1024 + h * 64, 1024, 64, VTs + (size_t)(bh * 64) * SPAD, SPAD, 0, st * 64, 0, smh, tl, true);
            }
          }
          for (int e = bid * NT + tid; e < 512 * 64 * 12; e += nblk * NT) {
            int c = e % 12, rw = e / 12;
            { unsigned z = 0; asm volatile("" : "+v"(z)); *(uint2*)(VTs + (size_t)rw * SPAD + NKS + c * 4) = make_uint2(z, z); }
          }
        }
      PHASE_END
      PHASE_BEGIN(11)
        EArgs ea{};
        ea.f0 = p.out + O_DKP; ea.f1 = p.out + O_DKS; ea.f2 = p.out + O_DVP; ea.f3 = p.out + O_DVS;
        ea.f4 = (float*)(R + D_KIR); ea.f5 = (float*)(R + D_WI);
        ea.b0 = (bf16_t*)(R + D_Q); ea.b1 = (bf16_t*)(R + D_K); ea.b2 = (bf16_t*)(R + D_VT); ea.b3 = (bf16_t*)(R + D_QI);
        gemm_phase<E_DSA>(H, Wb + W_DS + WD_P, T, 3840, 1024, ea, smem, 0, bid, nblk, wv);
      PHASE_END
      PHASE_BEGIN(12)
        dsa_rowops(p, bid, nblk, wv);
      PHASE_END
      PHASE_BEGIN(13)
        idx_phase(p, smem, bid, nblk, wv);
      PHASE_END
      PHASE_BEGIN(14)
        attn_phase<false>(p, smem, bid, nblk, wv);
      PHASE_END
      PHASE_BEGIN(6)
        EArgs ea{}; ea.f0 = X;
        gemm_phase<E_RESID>((const bf16_t*)(R + D_AO), Wb + W_DS + WD_O, T, 1024, 1024, ea, smem, 0, bid, nblk, wv);
      PHASE_END
    }
    PHASE_BEGIN(1)
      rmsnorm_rows(X, p.in[8] + L * 1024, H, nullptr, nullptr, bid, nblk, wv);
    PHASE_END
    PHASE_BEGIN(15)
      EArgs ea{}; ea.b0 = (bf16_t*)(R + 0);
      gemm_phase<E_SWIGLU>(H, Wb + W_FF + (size_t)L * WF_SZ + WF_IN, T, 2 * DFF, 1024, ea, smem, 0, bid, nblk, wv);
    PHASE_END
    PHASE_BEGIN(6)
      EArgs ea{}; ea.f0 = X;
      gemm_phase<E_RESID>((const bf16_t*)(R + 0), Wb + W_FF + (size_t)L * WF_SZ + WF_OUT, T, 1024, DFF, ea, smem, 0, bid, nblk, wv);
    PHASE_END
  }
  PHASE_BEGIN(1)
    rmsnorm_rows(X, p.in[9], nullptr, p.out + O_YP, p.out + O_YS, bid, nblk, wv);
  PHASE_END
}

extern "C" void kernel_launch(void* const* d_in, const int* in_sizes, int n_in,
                              void* d_out, int out_size, void* d_ws, size_t ws_size,
                              hipStream_t stream) {
  constexpr int kLds = 128 * 1024 + 64;
  static int grid_blocks = 0;
  if (!grid_blocks) {
    int dev = 0, cus = 0, per_cu = 0;
    (void)hipGetDevice(&dev);
    (void)hipDeviceGetAttribute(&cus, hipDeviceAttributeMultiprocessorCount, dev);
    (void)hipFuncSetAttribute((const void*)mega, hipFuncAttributeMaxDynamicSharedMemorySize, kLds);
    (void)hipOccupancyMaxActiveBlocksPerMultiprocessor(&per_cu, (const void*)mega, NT, kLds);
    if (per_cu < 1) per_cu = 1;
    if (per_cu > 1) per_cu = 1;
    grid_blocks = cus * per_cu;
    fprintf(stderr, "grid %d (cus %d per_cu %d) ws %zu need %zu out %d need %zu\n", grid_blocks, cus, per_cu, ws_size, (size_t)WS_NEED, out_size, (size_t)O_END);
  }
  if (ws_size < WS_NEED || n_in != 31 || (size_t)out_size != O_END) { fprintf(stderr, "kernel_launch: bad sizes\n"); return; }
  Params p;
  memset(&p, 0, sizeof(p));
  for (int i = 0; i < 31; ++i) p.in[i] = (const float*)d_in[i];
  p.out = (float*)d_out; p.ws = (unsigned char*)d_ws;
  bf16_t* Wb = (bf16_t*)((unsigned char*)d_ws + OFF_W);
  int nj = 0, tiles = 0;
  auto add = [&](const float* src, int nsrc, int k, bf16_t* dst, int ndst, int mode) {
    Job& jb = p.jobs[nj++]; jb.src = src; jb.dst = dst; jb.nsrc = nsrc; jb.k = k; jb.ndst = ndst; jb.mode = mode; jb.tile0 = tiles; jb.pad = 0;
    tiles += (ndst / 64) * (k / 64);
  };
  for (int j = 0; j < 2; ++j) {
    bf16_t* Wm = Wb + W_MLA + (size_t)j * WM_SZ;
    add(p.in[10] + (size_t)j * 1024 * 512, 512, 1024, Wm + WM_D, 512, 2);
    add(p.in[13] + (size_t)j * 1024 * 288, 288, 1024, Wb + W_MLA + (size_t)j * WM_SZ + WM_D + (size_t)512 * 1024, 512, 2);
    add(p.in[12] + (size_t)j * 512 * 1536, 1536, 512, Wb + W_MLA + (size_t)j * WM_SZ + WM_UQ, 1536, 0);
    add(p.in[15] + (size_t)j * 256 * 2048, 2048, 256, Wb + W_MLA + (size_t)j * WM_SZ + WM_UKV, 2048, 2);
    add(p.in[16] + (size_t)j * 1024 * 1024, 1024, 1024, Wb + W_MLA + (size_t)j * WM_SZ + WM_O, 1024, 2);
  }
  add(p.in[17], 4096, 1024, Wb + W_CM + WC_IN, 4096, 2);
  add(p.in[22], 1024, 2048, Wb + W_CM + WC_OUT, 1024, 2);
  add(p.in[23], 3072, 1024, Wb + W_DS + WD_P, 3072, 2);
  add(p.in[25], 512, 1024, Wb + W_DS + WD_P + (size_t)3072 * 1024, 512, 2);
  add(p.in[26], 64, 1024, Wb + W_DS + WD_P + (size_t)3584 * 1024, 64, 2);
  add(p.in[28], 8, 1024, Wb + W_DS + WD_P + (size_t)3648 * 1024, 192, 2);
  add(p.in[24], 1024, 1024, Wb + W_DS + WD_O, 1024, 2);
  for (int i = 0; i < 4; ++i) {
    add(p.in[29] + (size_t)i * 1024 * 5632, 5632, 1024, Wb + W_FF + (size_t)i * WF_SZ + WF_IN, 5632, 1);
    add(p.in[30] + (size_t)i * 2816 * 1024, 1024, 2816, Wb + W_FF + (size_t)i * WF_SZ + WF_OUT, 1024, 2);
  }
  p.total_tiles = tiles;
  for (int i = 0; i < 16; ++i) p.inv_freq[i] = pow(10000.0, -(double)i / 16.0);
  p.ph_lo = 0; p.ph_hi = 1000;
  (void)hipMemsetAsync((unsigned char*)d_ws + OFF_BAR, 0, 16384, stream);
  void* args[] = {&p};
  hipError_t e = hipLaunchCooperativeKernel((const void*)mega, dim3(grid_blocks), dim3(NT), args, kLds, stream);
  if (e != hipSuccess) fprintf(stderr, "coop launch failed: %s\n", hipGetErrorString(e));
}
```

```cpp
#include <hip/hip_runtime.h>
#include <hip/hip_cooperative_groups.h>
#include <cstdio>
#include <cstring>
#include <cmath>
namespace cg = cooperative_groups;

typedef unsigned short bf16_t;
using bf16x8 = __attribute__((ext_vector_type(8))) short;
using f32x16 = __attribute__((ext_vector_type(16))) float;
using f32x2v = __attribute__((ext_vector_type(2))) float;
using bf2v = __attribute__((ext_vector_type(2))) __bf16;
#define DI __device__ __forceinline__
#define MFMA32(a, b, c) __builtin_amdgcn_mfma_f32_32x32x16_bf16((a), (b), (c), 0, 0, 0)

constexpr int TP = 16384, TS = 512, T = TP + TS;
constexpr int NT = 512;
constexpr int SPAD = 1088, NKS = 1040;
constexpr int KROWS = TP + 32 * SPAD;
constexpr int DFF = 2816;
constexpr float LOG2E = 1.4426950408889634f;
constexpr float EPS = 1e-6f;

constexpr size_t OFF_X = 0;
constexpr size_t OFF_H = OFF_X + (size_t)T * 1024 * 4;
constexpr size_t OFF_W = OFF_H + (size_t)T * 1024 * 2;
constexpr size_t W_ELEMS = 52822016;
constexpr size_t OFF_ROPE = OFF_W + W_ELEMS * 2;
constexpr size_t OFF_R = OFF_ROPE + (size_t)8192 * 16 * 2 * 4;
constexpr size_t R_RAW = 0;
constexpr size_t R_CQ = R_RAW + (size_t)T * 1024 * 4;
constexpr size_t R_CKV = R_CQ + (size_t)T * 512 * 2;
constexpr size_t R_KR = R_CKV + (size_t)KROWS * 256 * 2;
constexpr size_t R_Q = R_KR + (size_t)KROWS * 32 * 2;
constexpr size_t R_KN = R_Q + (size_t)T * 1536 * 2;
constexpr size_t R_VT = R_KN + (size_t)KROWS * 1024 * 2;
constexpr size_t R_END = R_VT + (size_t)KROWS * 1024 * 2;
constexpr size_t D_Q = 0;
constexpr size_t D_K = D_Q + (size_t)T * 1024 * 2;
constexpr size_t D_VT = D_K + (size_t)KROWS * 1024 * 2;
constexpr size_t D_QI = D_VT + (size_t)KROWS * 1024 * 2;
constexpr size_t D_KIR = D_QI + (size_t)T * 512 * 2;
constexpr size_t D_KI = D_KIR + (size_t)T * 64 * 4;
constexpr size_t D_WI = D_KI + (size_t)KROWS * 64 * 2;
constexpr size_t D_BM = D_WI + (size_t)T * 8 * 4;
constexpr size_t D_AO = D_BM + (size_t)T * 256 * 4;
constexpr size_t D_END = D_AO + (size_t)T * 1024 * 2;
constexpr size_t C_U = 0;
constexpr size_t C_VR = C_U + (size_t)T * 2048 * 2;
constexpr size_t C_VLN = C_VR + (size_t)T * 2048 * 2;
constexpr size_t C_G = C_VLN + (size_t)T * 2048 * 2;
constexpr size_t C_END = C_G + (size_t)T * 2048 * 2;
constexpr size_t OFF_BAR = OFF_R + R_END;
constexpr size_t WS_NEED = OFF_BAR + 16384;
static_assert(D_END <= R_END && C_END <= R_END && (size_t)T * DFF * 2 <= R_END, "region");

constexpr size_t W_MLA = 0;
constexpr size_t WM_D = 0, WM_UQ = 1048576, WM_UKV = WM_UQ + 786432, WM_O = WM_UKV + 524288, WM_SZ = 3407872;
constexpr size_t W_CM = 2 * WM_SZ;
constexpr size_t WC_IN = 0, WC_OUT = 4194304, WC_SZ = 6291456;
constexpr size_t W_DS = W_CM + WC_SZ;
constexpr size_t WD_P = 0, WD_O = 3932160, WD_SZ = 4980736;
constexpr size_t W_FF = W_DS + WD_SZ;
constexpr size_t WF_IN = 0, WF_OUT = 5767168, WF_SZ = 8650752;
constexpr size_t W_TRIL = W_FF + 4 * WF_SZ;
static_assert(W_TRIL + 131072 == W_ELEMS, "w");

constexpr size_t O_YP = 0;
constexpr size_t O_YS = O_YP + (size_t)TP * 1024;
constexpr size_t O_CKVP = O_YS + (size_t)TS * 1024;
constexpr size_t O_KRP = O_CKVP + (size_t)2 * TP * 256;
constexpr size_t O_CKVS = O_KRP + (size_t)2 * TP * 32;
constexpr size_t O_KRS = O_CKVS + (size_t)2 * TS * 256;
constexpr size_t O_CVS = O_KRS + (size_t)2 * TS * 32;
constexpr size_t O_DKP = O_CVS + (size_t)TS * 2048;
constexpr size_t O_DVP = O_DKP + (size_t)TP * 1024;
constexpr size_t O_DIP = O_DVP + (size_t)TP * 1024;
constexpr size_t O_DKS = O_DIP + (size_t)TP * 64;
constexpr size_t O_DVS = O_DKS + (size_t)TS * 1024;
constexpr size_t O_DIS = O_DVS + (size_t)TS * 1024;
constexpr size_t O_END = O_DIS + (size_t)TS * 64;

constexpr int NJOBS = 25;
struct Job { const float* src; bf16_t* dst; int nsrc, k, ndst, mode, tile0, pad; };
struct Params {
  const float* in[31];
  float* out;
  unsigned char* ws;
  Job jobs[NJOBS];
  int total_tiles, ph_lo, ph_hi, pad;
  double inv_freq[16];
};

#define CAS __attribute__((address_space(4)))
typedef const CAS Params CParams;
#define PREF const CAS Params&
DI unsigned pack2(float a, float b) { f32x2v v = {a, b}; bf2v r = __builtin_convertvector(v, bf2v); return __builtin_bit_cast(unsigned, r); }
DI bf16_t tobf(float a) { return (bf16_t)(pack2(a, 0.f) & 0xffffu); }
DI float frombf(bf16_t v) { return __uint_as_float(((unsigned)v) << 16); }
DI float bflo(unsigned u) { return __uint_as_float(u << 16); }
DI float bfhi(unsigned u) { return __uint_as_float(u & 0xffff0000u); }
DI float shflx(float v, int m, int lane) { return __int_as_float(__builtin_amdgcn_ds_bpermute((lane ^ m) << 2, __float_as_int(v))); }
DI float wave_sum(float v, int lane) {
#pragma unroll
  for (int o = 32; o >= 1; o >>= 1) v += shflx(v, o, lane);
  return v;
}
DI int ltid(int wv) { unsigned m1 = ~0u; asm volatile("" : "+s"(m1)); int t = (wv << 6) | (int)__builtin_amdgcn_mbcnt_hi(m1, __builtin_amdgcn_mbcnt_lo(m1, 0u)); asm volatile("" : "+v"(t)); return t; }
DI int crow(int i, int h) { return (i & 3) + 8 * (i >> 2) + 4 * h; }
DI int rowmap(int t) { if (t < TP) return t; int u = t - TP; return TP + (u >> 4) * SPAD + 1024 + (u & 15); }
DI int tokpos(int t) { return t < TP ? (t & 8191) : 1024 + ((t - TP) & 15); }

DI void transpose_tile(const float* __restrict__ src, int src_ld, int ncols, bf16_t* __restrict__ dst, int dst_ld,
                       int n0, int k0, int mode, float* sm, int tid, bool active) {
  const int nl = (tid & 15) * 4, kq = tid >> 4;
  const int n = n0 + nl;
  int c;
  if (mode != 1) c = n < ncols ? n : -1;
  else { int tt = n >> 5, r = n & 31; int f = tt * 16 + (r & 15); c = (r < 16) ? f : DFF + f; }
  int dr[4];
#pragma unroll
  for (int e = 0; e < 4; ++e) { int col = nl + e; dr[e] = (mode == 2) ? ((col & 32) + (col & 1) * 16 + ((col & 31) >> 1)) : col; }
  if (active) {
    float4 v[4];
#pragma unroll
    for (int i = 0; i < 4; ++i) {
      int kk = kq + 16 * i;
      v[i] = (c >= 0) ? *(const float4*)(src + (size_t)(k0 + kk) * src_ld + c) : make_float4(0.f, 0.f, 0.f, 0.f);
    }
#pragma unroll
    for (int i = 0; i < 4; ++i) {
      int kk = kq + 16 * i;
      float* d = sm + kk * 65;
      d[dr[0]] = v[i].x; d[dr[1]] = v[i].y; d[dr[2]] = v[i].z; d[dr[3]] = v[i].w;
    }
  }
  __syncthreads();
  if (active) {
    const int kp = (tid & 31) * 2, nr = tid >> 5;
#pragma unroll 4
    for (int i = 0; i < 8; ++i) {
      int nn = nr + 8 * i;
      float a = sm[kp * 65 + nn], b = sm[(kp + 1) * 65 + nn];
      *(unsigned*)(dst + (size_t)(n0 + nn) * dst_ld + k0 + kp) = pack2(a, b);
    }
  }
  __syncthreads();
}

enum { E_F32 = 0, E_RESID, E_SWIGLU, E_GELU, E_MLAQ, E_MLAKV, E_DSA };
struct EArgs {
  float* f0; float* f1; float* f2; float* f3; float* f4; float* f5; float* f6;
  bf16_t* b0; bf16_t* b1; bf16_t* b2; bf16_t* b3;
  const float* rope;
};
using f32x4v = __attribute__((ext_vector_type(4))) float;
#define LAS __attribute__((address_space(3)))
constexpr int G_HT = 128 * 64;
DI int lds_byte(int r, int c) {
  int st = (r >> 4) * 2 + (c >> 5), rr = r & 15, cc = c & 31, ob = rr * 64 + cc * 2;
  return st * 1024 + (ob ^ (((ob >> 9) & 1) << 5));
}
DI void stage_rc(int b, int& R, int& C) {
  int st = b >> 10, sb = b & 1023, swz = sb ^ (((sb >> 9) & 1) << 5);
  R = (st >> 1) * 16 + (swz >> 6); C = (st & 1) * 32 + ((swz & 63) >> 1);
}

DI float gelu_exact(float x) {
  const float z = fabsf(x) * 0.70710678118654752f;
  const float t = __builtin_amdgcn_rcpf(1.f + 0.3275911f * z);
  float pl = 1.061405429f;
  pl = pl * t - 1.453152027f; pl = pl * t + 1.421413741f; pl = pl * t - 0.284496736f; pl = pl * t + 0.254829592f;
  const float e = pl * t * __builtin_amdgcn_exp2f(-z * z * 1.4426950408889634f);
  const float erfz = 1.f - e;
  const float erfx = x < 0.f ? -erfz : erfz;
  return 0.5f * x * (1.f + erfx);
}
template <int EPI, bool ATOM>
DI void epi16(const EArgs& ea, int row0, int gb, int fr, const f32x4v& v0, const f32x4v& v1) {
  if constexpr (EPI == E_F32) {
#pragma unroll
    for (int j = 0; j < 4; ++j) *(float2*)(ea.f0 + (size_t)(row0 + j) * 1024 + gb + 2 * fr) = make_float2(v0[j], v1[j]);
  } else if constexpr (EPI == E_RESID) {
#pragma unroll
    for (int j = 0; j < 4; ++j) { float* o = ea.f0 + (size_t)(row0 + j) * 1024 + gb + 2 * fr;
      if constexpr (ATOM) { unsafeAtomicAdd(o, v0[j]); unsafeAtomicAdd(o + 1, v1[j]); }
      else { float2 x = *(float2*)o; x.x += v0[j]; x.y += v1[j]; *(float2*)o = x; } }
  } else if constexpr (EPI == E_SWIGLU) {
    const int f = (gb >> 1) + fr;
#pragma unroll
    for (int j = 0; j < 4; ++j) { float g = v0[j], u = v1[j]; ea.b0[(size_t)(row0 + j) * DFF + f] = tobf(g * __builtin_amdgcn_rcpf(1.f + __builtin_amdgcn_exp2f(-g * LOG2E)) * u); }
  } else if constexpr (EPI == E_GELU) {
    bf16_t* dstp = (gb < 2048) ? (ea.b0 + gb + 2 * fr) : (ea.b1 + (gb - 2048) + 2 * fr);
#pragma unroll
    for (int j = 0; j < 4; ++j) {
      float x = v0[j], y = v1[j];
      *(unsigned*)(dstp + (size_t)(row0 + j) * 2048) = pack2(gelu_exact(x), gelu_exact(y));
    }
  } else if constexpr (EPI == E_MLAQ) {
    const float qs = 0.10206207261596577f * LOG2E;
    const bool is_rope = (gb % 96) == 64;
#pragma unroll
    for (int j = 0; j < 4; ++j) {
      const int row = row0 + j;
      float o0 = v0[j], o1 = v1[j];
      if (is_rope) {
        float2 cs = *(const float2*)(ea.rope + ((size_t)tokpos(row) * 16 + fr) * 2);
        o0 = v0[j] * cs.x - v1[j] * cs.y; o1 = v0[j] * cs.y + v1[j] * cs.x;
      }
      bf16_t* o = ea.b0 + (size_t)row * 1536 + gb + fr;
      o[0] = tobf(o0 * qs); o[16] = tobf(o1 * qs);
    }
  } else if constexpr (EPI == E_MLAKV) {
    const int head = gb >> 7, c0 = gb & 127;
    if (c0 < 64) {
#pragma unroll
      for (int j = 0; j < 4; ++j) *(unsigned*)(ea.b0 + (size_t)(row0 + j) * 1024 + head * 64 + c0 + 2 * fr) = pack2(v0[j], v1[j]);
    } else {
      const int d = c0 - 64 + 2 * fr;
      size_t off, dstr;
      if (row0 < TP) { int b = row0 >> 13, s = row0 & 8191; off = ((size_t)((b * 16 + head) * 64 + d)) * 8192 + s; dstr = 8192; }
      else { int u = row0 - TP; int b = u / SPAD, s = u - b * SPAD; off = (size_t)TP * 1024 + ((size_t)((b * 16 + head) * 64 + d)) * SPAD + s; dstr = SPAD; }
      uint2 pk; pk.x = pack2(v0[0], v0[1]); pk.y = pack2(v0[2], v0[3]); *(uint2*)(ea.b1 + off) = pk;
      pk.x = pack2(v1[0], v1[1]); pk.y = pack2(v1[2], v1[3]); *(uint2*)(ea.b1 + off + dstr) = pk;
    }
  } else if constexpr (EPI == E_DSA) {
    if (gb < 1024) {
      const float qs = 0.125f * LOG2E;
#pragma unroll
      for (int j = 0; j < 4; ++j) *(unsigned*)(ea.b0 + (size_t)(row0 + j) * 1024 + gb + 2 * fr) = pack2(v0[j] * qs, v1[j] * qs);
    } else if (gb < 2048) {
      const int c = gb - 1024 + 2 * fr;
#pragma unroll
      for (int j = 0; j < 4; ++j) {
        const int row = row0 + j;
        float* o = (row < TP) ? ea.f0 + (size_t)row * 1024 + c : ea.f1 + (size_t)(row - TP) * 1024 + c;
        *(float2*)o = make_float2(v0[j], v1[j]);
        *(unsigned*)(ea.b1 + (size_t)rowmap(row) * 1024 + c) = pack2(v0[j], v1[j]);
      }
    } else if (gb < 3072) {
      const int c = gb - 2048 + 2 * fr, head = c >> 6, d = c & 63;
#pragma unroll
      for (int j = 0; j < 4; ++j) {
        const int row = row0 + j;
        float* o = (row < TP) ? ea.f2 + (size_t)row * 1024 + c : ea.f3 + (size_t)(row - TP) * 1024 + c;
        *(float2*)o = make_float2(v0[j], v1[j]);
      }
      size_t off, dstr;
      if (row0 < TP) { int b = row0 >> 13, s = row0 & 8191; off = ((size_t)((b * 16 + head) * 64 + d)) * 8192 + s; dstr = 8192; }
      else { int u = row0 - TP; int b = u >> 4, s = 1024 + (u & 15); off = (size_t)TP * 1024 + ((size_t)((b * 16 + head) * 64 + d)) * SPAD + s; dstr = SPAD; }
      uint2 pk; pk.x = pack2(v0[0], v0[1]); pk.y = pack2(v0[2], v0[3]); *(uint2*)(ea.b2 + off) = pk;
      pk.x = pack2(v1[0], v1[1]); pk.y = pack2(v1[2], v1[3]); *(uint2*)(ea.b2 + off + dstr) = pk;
    } else if (gb < 3584) {
      const int c = gb - 3072 + 2 * fr;
#pragma unroll
      for (int j = 0; j < 4; ++j) *(unsigned*)(ea.b3 + (size_t)(row0 + j) * 512 + c) = pack2(v0[j] * 0.125f, v1[j] * 0.125f);
    } else if (gb < 3648) {
      const int c = gb - 3584 + 2 * fr;
#pragma unroll
      for (int j = 0; j < 4; ++j) *(float2*)(ea.f4 + (size_t)(row0 + j) * 64 + c) = make_float2(v0[j], v1[j]);
    } else if (gb == 3648) {
      if (fr < 4) {
#pragma unroll
        for (int j = 0; j < 4; ++j) *(float2*)(ea.f5 + (size_t)(row0 + j) * 8 + 2 * fr) = make_float2(v0[j] * 0.35355339059327379f, v1[j] * 0.35355339059327379f);
      }
    }
  }
}

template <int EPI, bool ATOM>
DI void gemm256_tile(const bf16_t* __restrict__ A, const bf16_t* __restrict__ Bt, const int K, const int kt0, const int nt, const int brow, const int bcol,
                     const EArgs& ea, unsigned char* smem, int wv) {
  bf16_t* shm = (bf16_t*)smem;
  const int tid = ltid(wv);
#define SA(b, h) (shm + ((b) * 2 + (h)) * G_HT)
#define SB(b, h) (shm + (4 + (b) * 2 + (h)) * G_HT)
#define STAGE(P, BASE, br, kt) do { const char* _gb = (const char*)((BASE) + (long)(br) * K + (long)((kt) + kt0) * 64); \
    __builtin_amdgcn_global_load_lds((const unsigned*)(_gb + voff0), (LAS unsigned*)((char*)(P) + tid * 16), 16, 0, 0); \
    __builtin_amdgcn_global_load_lds((const unsigned*)(_gb + voff1), (LAS unsigned*)((char*)(P) + tid * 16 + 8192), 16, 0, 0); } while (0)
#define LDA(dst, b, h) _Pragma("unroll") for (int m = 0; m < 4; ++m) _Pragma("unroll") for (int k = 0; k < 2; ++k) \
    dst[m][k] = *reinterpret_cast<const bf16x8*>((char*)SA(b, h) + lds_byte(wr * 64 + m * 16 + fr, k * 32 + fq * 8))
#define LDB(dst, b, h) _Pragma("unroll") for (int n = 0; n < 2; ++n) _Pragma("unroll") for (int k = 0; k < 2; ++k) \
    dst[n][k] = *reinterpret_cast<const bf16x8*>((char*)SB(b, h) + lds_byte(wc * 32 + n * 16 + fr, k * 32 + fq * 8))
#define MMA(ai, bj, At_, Bt_) do { __builtin_amdgcn_s_setprio(1); \
    _Pragma("unroll") for (int m = 0; m < 4; ++m) _Pragma("unroll") for (int n = 0; n < 2; ++n) _Pragma("unroll") for (int k = 0; k < 2; ++k) \
      acc[ai][bj][m][n] = __builtin_amdgcn_mfma_f32_16x16x32_bf16(At_[m][k], Bt_[n][k], acc[ai][bj][m][n], 0, 0, 0); \
    __builtin_amdgcn_s_setprio(0); } while (0)
#define WAIT_V(n) asm volatile("s_waitcnt vmcnt(" #n ")" ::: "memory")
#define WAIT_L(n) asm volatile("s_waitcnt lgkmcnt(" #n ")" ::: "memory")
#define BAR __builtin_amdgcn_s_barrier()
#define SCHED __builtin_amdgcn_sched_barrier(0)
  const int wid = tid >> 6, lane = tid & 63, wr = wid >> 2, wc = wid & 3, fr = lane & 15, fq = lane >> 4;
  unsigned voff0, voff1;
  { int r_, c_; stage_rc(tid * 16, r_, c_); voff0 = (unsigned)(r_ * K + c_) * 2u; stage_rc(tid * 16 + 8192, r_, c_); voff1 = (unsigned)(r_ * K + c_) * 2u; }
  f32x4v acc[2][2][4][2];
#pragma unroll
  for (int a = 0; a < 2; ++a)
#pragma unroll
    for (int b = 0; b < 2; ++b)
#pragma unroll
      for (int m = 0; m < 4; ++m)
#pragma unroll
        for (int n = 0; n < 2; ++n) acc[a][b][m][n] = (f32x4v){0.f, 0.f, 0.f, 0.f};
  bf16x8 At[4][2], B0[2][2], B1[2][2];
  const int HALF = 128;
  WAIT_V(0); WAIT_L(0); BAR;
  STAGE(SB(0, 0), Bt, bcol, 0); STAGE(SA(0, 0), A, brow, 0);
  STAGE(SB(0, 1), Bt, bcol + HALF, 0); STAGE(SA(0, 1), A, brow + HALF, 0);
  if (wr == 1) BAR;
  WAIT_V(4); BAR;
  STAGE(SB(1, 0), Bt, bcol, 1); STAGE(SA(1, 0), A, brow, 1); STAGE(SB(1, 1), Bt, bcol + HALF, 1);
  WAIT_V(6); BAR;
  for (int t = 0; t < nt - 2; t += 2) {
    LDB(B0, 0, 0); SCHED; LDA(At, 0, 0); STAGE(SA(1, 1), A, brow + HALF, t + 1);
    WAIT_L(8); BAR; WAIT_L(0); MMA(0, 0, At, B0); BAR; SCHED;
    LDB(B1, 0, 1); STAGE(SB(0, 0), Bt, bcol, t + 2);
    BAR; WAIT_L(0); MMA(0, 1, At, B1); BAR;
    LDA(At, 0, 1); STAGE(SA(0, 0), A, brow, t + 2);
    BAR; WAIT_L(0); MMA(1, 0, At, B0); BAR; SCHED;
    STAGE(SB(0, 1), Bt, bcol + HALF, t + 2);
    WAIT_V(6); BAR; MMA(1, 1, At, B1); BAR;
    LDB(B0, 1, 0); SCHED; LDA(At, 1, 0); STAGE(SA(0, 1), A, brow + HALF, t + 2);
    WAIT_L(8); BAR; WAIT_L(0); MMA(0, 0, At, B0); BAR; SCHED;
    LDB(B1, 1, 1); STAGE(SB(1, 0), Bt, bcol, t + 3);
    BAR; WAIT_L(0); MMA(0, 1, At, B1); BAR;
    LDA(At, 1, 1); STAGE(SA(1, 0), A, brow, t + 3);
    BAR; WAIT_L(0); MMA(1, 0, At, B0); BAR; SCHED;
    STAGE(SB(1, 1), Bt, bcol + HALF, t + 3);
    WAIT_V(6); BAR; MMA(1, 1, At, B1); BAR;
  }
  { LDB(B0, 0, 0); LDA(At, 0, 0); STAGE(SA(1, 1), A, brow + HALF, nt - 1);
    BAR; WAIT_L(0); MMA(0, 0, At, B0); BAR;
    LDB(B1, 0, 1); BAR; WAIT_L(0); MMA(0, 1, At, B1); BAR;
    LDA(At, 0, 1); WAIT_V(4); BAR; WAIT_L(0); MMA(1, 0, At, B0); MMA(1, 1, At, B1); BAR; }
  { LDB(B0, 1, 0); LDA(At, 1, 0); WAIT_V(2); BAR; WAIT_L(0); MMA(0, 0, At, B0); BAR;
    LDB(B1, 1, 1); WAIT_V(0); BAR; WAIT_L(0); MMA(0, 1, At, B1); BAR;
    LDA(At, 1, 1); BAR; WAIT_L(0); MMA(1, 0, At, B0); MMA(1, 1, At, B1); BAR; }
  if (wr == 0) BAR;
#pragma unroll
  for (int ai = 0; ai < 2; ++ai)
#pragma unroll
    for (int bj = 0; bj < 2; ++bj)
#pragma unroll
      for (int m = 0; m < 4; ++m)
      { epi16<EPI, ATOM>(ea, brow + ai * 128 + wr * 64 + m * 16 + fq * 4, bcol + bj * 128 + wc * 32, fr, acc[ai][bj][m][0], acc[ai][bj][m][1]); if constexpr (EPI != E_RESID) __builtin_amdgcn_sched_barrier(0); }
#undef SA
#undef SB
#undef STAGE
#undef LDA
#undef LDB
#undef MMA
#undef WAIT_V
#undef WAIT_L
#undef BAR
#undef SCHED
}

DI void tile_map(int t, int nM, int nN, int nwg, int& pm, int& pn) {
  int wgid = t;
  { int q = nwg >> 3, r = nwg & 7, xcd = wgid & 7, off = wgid >> 3; wgid = (xcd < r ? xcd * (q + 1) : r * (q + 1) + (xcd - r) * q) + off; }
  const int nig = 8 * nN, gid = wgid / nig, fm = gid * 8, gsz = min(nM - fm, 8);
  pm = fm + ((wgid % nig) % gsz); pn = (wgid % nig) / gsz;
}
template <int EPI>
DI void gemm_phase(const bf16_t* A, const bf16_t* Bt, int M, int N, int K, const EArgs& ea,
                   unsigned char* smem, int tstart, int bid, int nblk, int wv) {
  const int nM = M >> 8, nN = N >> 8, nwg = nM * nN, nt = K >> 6;
  if constexpr (EPI == E_RESID) {
    const int nfull = (nwg / nblk) * nblk, rem = nwg - nfull;
    for (int t = bid; t < nfull; t += nblk) {
      int pm, pn; tile_map(t, nM, nN, nwg, pm, pn);
      gemm256_tile<EPI, false>(A, Bt, K, 0, nt, pm * 256, pn * 256, ea, smem, wv);
    }
    if (rem > 0) {
      int ns = nblk / rem; if (ns > (nt >> 3)) ns = nt >> 3; if (ns < 1) ns = 1;
      const int per = ((nt / ns) >> 1) << 1;
      for (int u = bid; u < rem * ns; u += nblk) {
        const int t = nfull + u / ns, ks = u % ns;
        const int k0 = ks * per, kn = (ks == ns - 1) ? (nt - k0) : per;
        int pm, pn; tile_map(t, nM, nN, nwg, pm, pn);
        gemm256_tile<EPI, true>(A, Bt, K, k0, kn, pm * 256, pn * 256, ea, smem, wv);
      }
    }
  } else {
    int t0 = bid - (tstart % nblk); if (t0 < 0) t0 += nblk;
    for (int t = t0; t < nwg; t += nblk) {
      int pm, pn; tile_map(t, nM, nN, nwg, pm, pn);
      gemm256_tile<EPI, false>(A, Bt, K, 0, nt, pm * 256, pn * 256, ea, smem, wv);
    }
  }
}

DI void rmsnorm_rows(const float* __restrict__ X, const float* __restrict__ g, bf16_t* __restrict__ H, float* outp, float* outs,
                     int bid, int nblk, int wv) {
  const int lane = ltid(wv) & 63, w = ltid(wv) >> 6;
  for (int row = bid * 8 + w; row < T; row += nblk * 8) {
    const float* xr = X + (size_t)row * 1024;
    float4 v[4];
    float ss = 0.f;
#pragma unroll
    for (int c = 0; c < 4; ++c) { v[c] = *(const float4*)(xr + c * 256 + lane * 4); ss += v[c].x * v[c].x + v[c].y * v[c].y + v[c].z * v[c].z + v[c].w * v[c].w; }
    ss = wave_sum(ss, lane);
    float r = rsqrtf(ss * (1.f / 1024.f) + EPS);
#pragma unroll
    for (int c = 0; c < 4; ++c) {
      int col = c * 256 + lane * 4;
      float4 gg = *(const float4*)(g + col);
      float a = v[c].x * r * gg.x, b = v[c].y * r * gg.y, cc = v[c].z * r * gg.z, d = v[c].w * r * gg.w;
      if (H) { uint2 pk; pk.x = pack2(a, b); pk.y = pack2(cc, d); *(uint2*)(H + (size_t)row * 1024 + col) = pk; }
      else {
        float* o = (row < TP) ? outp + (size_t)row * 1024 + col : outs + (size_t)(row - TP) * 1024 + col;
        *(float4*)o = make_float4(a, b, cc, d);
      }
    }
  }
}

DI void mla_rowops(PREF p, int j, int bid, int nblk, int wv) {
  const int lane = ltid(wv) & 63, w = ltid(wv) >> 6;
  unsigned char* R = p.ws + OFF_R;
  const float* RAW = (const float*)(R + R_RAW);
  bf16_t* CQ = (bf16_t*)(R + R_CQ); bf16_t* CKV = (bf16_t*)(R + R_CKV); bf16_t* KR = (bf16_t*)(R + R_KR);
  const float* gq = p.in[11] + j * 512; const float* gkv = p.in[14] + j * 256;
  const float* rope = (const float*)(p.ws + OFF_ROPE);
  for (int row = bid * 8 + w; row < T; row += nblk * 8) {
    const float* rr = RAW + (size_t)row * 1024;
    float4 a0 = *(const float4*)(rr + lane * 4), a1 = *(const float4*)(rr + 256 + lane * 4);
    float4 c0 = *(const float4*)(rr + 512 + lane * 4);
    float ss = a0.x * a0.x + a0.y * a0.y + a0.z * a0.z + a0.w * a0.w + a1.x * a1.x + a1.y * a1.y + a1.z * a1.z + a1.w * a1.w;
    float s2 = c0.x * c0.x + c0.y * c0.y + c0.z * c0.z + c0.w * c0.w;
    ss = wave_sum(ss, lane); s2 = wave_sum(s2, lane);
    float r1 = rsqrtf(ss * (1.f / 512.f) + EPS), r2 = rsqrtf(s2 * (1.f / 256.f) + EPS);
    {
      float4 g0 = *(const float4*)(gq + lane * 4), g1 = *(const float4*)(gq + 256 + lane * 4);
      uint2 pk; pk.x = pack2(a0.x * r1 * g0.x, a0.y * r1 * g0.y); pk.y = pack2(a0.z * r1 * g0.z, a0.w * r1 * g0.w);
      *(uint2*)(CQ + (size_t)row * 512 + lane * 4) = pk;
      pk.x = pack2(a1.x * r1 * g1.x, a1.y * r1 * g1.y); pk.y = pack2(a1.z * r1 * g1.z, a1.w * r1 * g1.w);
      *(uint2*)(CQ + (size_t)row * 512 + 256 + lane * 4) = pk;
    }
    const int rm = rowmap(row);
    {
      float4 g = *(const float4*)(gkv + lane * 4);
      float4 o = make_float4(c0.x * r2 * g.x, c0.y * r2 * g.y, c0.z * r2 * g.z, c0.w * r2 * g.w);
      float* op = (row < TP) ? p.out + O_CKVP + ((size_t)j * TP + row) * 256 : p.out + O_CKVS + ((size_t)j * TS + (row - TP)) * 256;
      *(float4*)(op + lane * 4) = o;
      uint2 pk; pk.x = pack2(o.x, o.y); pk.y = pack2(o.z, o.w);
      *(uint2*)(CKV + (size_t)rm * 256 + lane * 4) = pk;
    }
    if (lane < 16) {
      float x1 = rr[768 + lane], x2 = rr[784 + lane];
      int pos = tokpos(row);
      float2 cs = *(const float2*)(rope + ((size_t)pos * 16 + lane) * 2);
      float o1 = x1 * cs.x - x2 * cs.y, o2 = x1 * cs.y + x2 * cs.x;
      float* op = (row < TP) ? p.out + O_KRP + ((size_t)j * TP + row) * 32 : p.out + O_KRS + ((size_t)j * TS + (row - TP)) * 32;
      op[lane] = o1; op[16 + lane] = o2;
      KR[(size_t)rm * 32 + lane] = tobf(o1); KR[(size_t)rm * 32 + 16 + lane] = tobf(o2);
    }
  }
}

DI void dsa_rowops(PREF p, int bid, int nblk, int wv) {
  const int lane = ltid(wv) & 63, w = ltid(wv) >> 6;
  unsigned char* R = p.ws + OFF_R;
  const float* KIR = (const float*)(R + D_KIR);
  bf16_t* KI = (bf16_t*)(R + D_KI);
  const float* g = p.in[27];
  for (int row = bid * 8 + w; row < T; row += nblk * 8) {
    float v = KIR[(size_t)row * 64 + lane];
    float ss = wave_sum(v * v, lane);
    float r = rsqrtf(ss * (1.f / 64.f) + EPS);
    float o = v * r * g[lane];
    if (row < TP) p.out[O_DIP + (size_t)row * 64 + lane] = o; else p.out[O_DIS + (size_t)(row - TP) * 64 + lane] = o;
    KI[(size_t)rowmap(row) * 64 + lane] = tobf(o);
  }
}

DI void cmlp_ln_rows(PREF p, int bid, int nblk, int wv) {
  const int lane = ltid(wv) & 63, w = ltid(wv) >> 6;
  unsigned char* R = p.ws + OFF_R;
  const bf16_t* VR = (const bf16_t*)(R + C_VR);
  bf16_t* VLN = (bf16_t*)(R + C_VLN);
  const float* g = p.in[18]; const float* bb = p.in[19];
  for (int row = bid * 8 + w; row < T; row += nblk * 8) {
    float x[32];
    float sum = 0.f;
#pragma unroll
    for (int c = 0; c < 4; ++c) {
      uint4 u = *(const uint4*)(VR + (size_t)row * 2048 + c * 512 + lane * 8);
      x[c * 8 + 0] = bflo(u.x); x[c * 8 + 1] = bfhi(u.x); x[c * 8 + 2] = bflo(u.y); x[c * 8 + 3] = bfhi(u.y);
      x[c * 8 + 4] = bflo(u.z); x[c * 8 + 5] = bfhi(u.z); x[c * 8 + 6] = bflo(u.w); x[c * 8 + 7] = bfhi(u.w);
    }
#pragma unroll
    for (int i = 0; i < 32; ++i) sum += x[i];
    sum = wave_sum(sum, lane);
    float mu = sum * (1.f / 2048.f);
    float vs = 0.f;
#pragma unroll
    for (int i = 0; i < 32; ++i) { x[i] -= mu; vs += x[i] * x[i]; }
    vs = wave_sum(vs, lane);
    float r = rsqrtf(vs * (1.f / 2048.f) + EPS);
#pragma unroll
    for (int c = 0; c < 4; ++c) {
      int col = c * 512 + lane * 8;
      float y[8];
#pragma unroll
      for (int q = 0; q < 2; ++q) {
        float4 gg = *(const float4*)(g + col + q * 4), b4 = *(const float4*)(bb + col + q * 4);
        y[q * 4 + 0] = x[c * 8 + q * 4 + 0] * r * gg.x + b4.x; y[q * 4 + 1] = x[c * 8 + q * 4 + 1] * r * gg.y + b4.y;
        y[q * 4 + 2] = x[c * 8 + q * 4 + 2] * r * gg.z + b4.z; y[q * 4 + 3] = x[c * 8 + q * 4 + 3] * r * gg.w + b4.w;
      }
      uint4 pk; pk.x = pack2(y[0], y[1]); pk.y = pack2(y[2], y[3]); pk.z = pack2(y[4], y[5]); pk.w = pack2(y[6], y[7]);
      *(uint4*)(VLN + (size_t)row * 2048 + col) = pk;
      if (row >= TP) {
        float* o = p.out + O_CVS + (size_t)(row - TP) * 2048 + col;
        *(float4*)o = make_float4(y[0], y[1], y[2], y[3]); *(float4*)(o + 4) = make_float4(y[4], y[5], y[6], y[7]);
      }
    }
  }
}

DI void cmlp_mix_phase(PREF p, unsigned char* smem, int bid, int nblk, int wv) {
  const int tid = ltid(wv), lane = tid & 63, w = tid >> 6, wm = w >> 2, wn = w & 3, lr = lane & 31, lh = lane >> 5;
  unsigned char* R = p.ws + OFF_R;
  const bf16_t* U = (const bf16_t*)(R + C_U);
  const bf16_t* VLN = (const bf16_t*)(R + C_VLN);
  bf16_t* G = (bf16_t*)(R + C_G);
  const bf16_t* WT = (const bf16_t*)(p.ws + OFF_W) + W_TRIL;
  const float* bs = p.in[21];
  bf16_t* As = (bf16_t*)smem;
  bf16_t* Bs = As + 128 * 136;
  for (int u = bid; u < 1024; u += nblk) {
    const int g = u & 7, ch = u >> 3;
    const int col0 = g * 256;
#pragma unroll 2
    for (int i = 0; i < 4; ++i) {
      int v = tid + i * NT; int r = v >> 4, c = (v & 15) * 8;
      *(uint4*)(As + r * 136 + c) = *(const uint4*)(WT + ((size_t)g * 128 + r) * 128 + c);
    }
#pragma unroll 2
    for (int i = 0; i < 8; ++i) {
      int v = tid + i * NT; int s = v >> 5, c = (v & 31) * 8;
      uint4 x = *(const uint4*)(VLN + ((size_t)ch * 128 + s) * 2048 + col0 + c);
      Bs[(c + 0) * 136 + s] = (bf16_t)(x.x & 0xffff); Bs[(c + 1) * 136 + s] = (bf16_t)(x.x >> 16);
      Bs[(c + 2) * 136 + s] = (bf16_t)(x.y & 0xffff); Bs[(c + 3) * 136 + s] = (bf16_t)(x.y >> 16);
      Bs[(c + 4) * 136 + s] = (bf16_t)(x.z & 0xffff); Bs[(c + 5) * 136 + s] = (bf16_t)(x.z >> 16);
      Bs[(c + 6) * 136 + s] = (bf16_t)(x.w & 0xffff); Bs[(c + 7) * 136 + s] = (bf16_t)(x.w >> 16);
    }
    __syncthreads();
    f32x16 acc[2][2];
#pragma unroll
    for (int a = 0; a < 2; ++a)
#pragma unroll
      for (int b = 0; b < 2; ++b)
#pragma unroll
        for (int i = 0; i < 16; ++i) acc[a][b][i] = 0.f;
    const bf16_t* Asb = As + (wm * 64 + lr) * 136 + lh * 8;
    const bf16_t* Bsb = Bs + (wn * 64 + lr) * 136 + lh * 8;
    const int ns = (wm + 1) * 4;
    for (int s = 0; s < ns; ++s) {
      bf16x8 a0 = *(const bf16x8*)(Asb + s * 16);
      bf16x8 a1 = *(const bf16x8*)(Asb + 32 * 136 + s * 16);
      bf16x8 b0 = *(const bf16x8*)(Bsb + s * 16);
      bf16x8 b1 = *(const bf16x8*)(Bsb + 32 * 136 + s * 16);
      acc[0][0] = MFMA32(a0, b0, acc[0][0]);
      acc[0][1] = MFMA32(a0, b1, acc[0][1]);
      acc[1][0] = MFMA32(a1, b0, acc[1][0]);
      acc[1][1] = MFMA32(a1, b1, acc[1][1]);
    }
#pragma unroll
    for (int mi = 0; mi < 2; ++mi)
#pragma unroll
      for (int ni = 0; ni < 2; ++ni)
#pragma unroll
        for (int i = 0; i < 16; ++i) {
          int t = wm * 64 + mi * 32 + crow(i, lh);
          int col = col0 + wn * 64 + ni * 32 + lr;
          size_t off = ((size_t)ch * 128 + t) * 2048 + col;
          float mixed = acc[mi][ni][i] + bs[g * 128 + t];
          G[off] = tobf(frombf(U[off]) * mixed);
        }
    __syncthreads();
  }
  const float* wsf = p.in[20];
  for (int e = bid * NT + tid; e < TS * 2048; e += nblk * NT) {
    int row = e >> 11, col = e & 2047, b = row >> 4, t = row & 15, g = col >> 8;
    float a = bs[g * 128 + t];
    for (int s = 0; s <= t; ++s) a += wsf[((size_t)g * 128 + t) * 128 + s] * frombf(VLN[((size_t)TP + b * 16 + s) * 2048 + col]);
    size_t off = ((size_t)TP + row) * 2048 + col;
    G[off] = tobf(frombf(U[off]) * a);
  }
}

template <int DQK, bool IS_MLA, bool MASKED>
DI void attn8_unit(const bf16_t* __restrict__ Qp, int ldq, int nq,
                   const bf16_t* __restrict__ Kp, int ldk, const bf16_t* __restrict__ KRp,
                   const bf16_t* __restrict__ Vtp, int ldv, int kmax,
                   int nit, int nk64_w, int nkeys, const unsigned* __restrict__ BMp,
                   bf16_t* __restrict__ AOp, unsigned char* smem, int wv) {
  constexpr int KS = DQK + 8;
  constexpr int VS = 136;
  constexpr int NQS = DQK / 16;
  const int tid = ltid(wv), lane = tid & 63, w = tid >> 6, lr = lane & 31, lh = lane >> 5;
  bf16_t* Ks = (bf16_t*)smem;
  bf16_t* Vs = Ks + 2 * 128 * KS;
  const bool q_ok = (w * 32 + lr) < nq;
  const int qrow = q_ok ? (w * 32 + lr) : 0;
  bf16x8 qf[NQS];
#pragma unroll
  for (int s = 0; s < NQS; ++s) qf[s] = *(const bf16x8*)(Qp + (size_t)qrow * ldq + s * 16 + lh * 8);
  f32x16 oacc[2];
#pragma unroll
  for (int d = 0; d < 2; ++d)
#pragma unroll
    for (int i = 0; i < 16; ++i) oacc[d][i] = 0.f;
  float m_run = -INFINITY, l_run = 0.f;
  const int kkey = tid >> 3, kc = (tid & 7) * 8;
  const int rkey = tid >> 2, rc = (tid & 3) * 8;
  const int vd = tid >> 4, vk = (tid & 15) * 8;
  const int vpos = (vk & 96) + ((vk >> 4) & 1) * 16 + ((vk >> 3) & 1) * 4;
  uint4 rk0, rk1, rr, rv0, rv1;
  rr = make_uint4(0, 0, 0, 0);
  uint4 bm_next = make_uint4(0xffffffffu, 0xffffffffu, 0xffffffffu, 0xffffffffu), bm_cur = bm_next;
#define GLOAD(it_) do { const int key0_ = (it_) * 128; \
    { int kr_ = min(key0_ + kkey, kmax - 1); rk0 = *(const uint4*)(Kp + (size_t)kr_ * ldk + kc); } \
    { int kr_ = min(key0_ + kkey + 64, kmax - 1); rk1 = *(const uint4*)(Kp + (size_t)kr_ * ldk + kc); } \
    if constexpr (IS_MLA) { int kr_ = min(key0_ + rkey, kmax - 1); rr = *(const uint4*)(KRp + (size_t)kr_ * 32 + rc); } \
    { int kv_ = min(key0_ + vk, kmax - 8); rv0 = *(const uint4*)(Vtp + (size_t)vd * ldv + kv_); rv1 = *(const uint4*)(Vtp + (size_t)(vd + 32) * ldv + kv_); } \
    if constexpr (MASKED) { if (BMp) bm_next = *(const uint4*)(BMp + (size_t)qrow * 256 + (it_) * 4); } } while (0)
#define SSTORE(buf_) do { bf16_t* Kb_ = Ks + (buf_) * 128 * KS; bf16_t* Vb_ = Vs + (buf_) * 64 * VS; \
    *(uint4*)(Kb_ + kkey * KS + kc) = rk0; *(uint4*)(Kb_ + (kkey + 64) * KS + kc) = rk1; \
    if constexpr (IS_MLA) *(uint4*)(Kb_ + rkey * KS + 64 + rc) = rr; \
    *(uint2*)(Vb_ + vd * VS + vpos) = make_uint2(rv0.x, rv0.y); *(uint2*)(Vb_ + vd * VS + vpos + 8) = make_uint2(rv0.z, rv0.w); \
    *(uint2*)(Vb_ + (vd + 32) * VS + vpos) = make_uint2(rv1.x, rv1.y); *(uint2*)(Vb_ + (vd + 32) * VS + vpos + 8) = make_uint2(rv1.z, rv1.w); } while (0)
  const int nit_w = (nk64_w + 1) >> 1;
  __syncthreads();
  GLOAD(0); SSTORE(0); bm_cur = bm_next;
  __syncthreads();
  for (int it = 0; it < nit; ++it) {
    const int buf = it & 1;
    if (it + 1 < nit) GLOAD(it + 1);
    if (it < nit_w) {
      const bf16_t* Kb = Ks + buf * 128 * KS; const bf16_t* Vb = Vs + buf * 64 * VS;
      f32x16 sacc[4];
#pragma unroll
      for (int t4 = 0; t4 < 4; ++t4) {
#pragma unroll
        for (int i = 0; i < 16; ++i) sacc[t4][i] = 0.f;
#pragma unroll
        for (int s = 0; s < NQS; ++s) {
          bf16x8 kf = *(const bf16x8*)(Kb + (t4 * 32 + lr) * KS + s * 16 + lh * 8);
          sacc[t4] = MFMA32(kf, qf[s], sacc[t4]);
        }
      }
      if ((2 * it + 1) >= nk64_w) {
#pragma unroll
        for (int t4 = 2; t4 < 4; ++t4)
#pragma unroll
          for (int i = 0; i < 16; ++i) sacc[t4][i] = -INFINITY;
      }
      float mx = -INFINITY;
#pragma unroll
      for (int t4 = 0; t4 < 4; ++t4) {
        const int remk = nkeys - (it * 128 + t4 * 32);
        const unsigned vmask = remk >= 32 ? 0xffffffffu : (remk <= 0 ? 0u : ((1u << remk) - 1u));
        const unsigned wbits = (((t4 == 0) ? bm_cur.x : (t4 == 1) ? bm_cur.y : (t4 == 2) ? bm_cur.z : bm_cur.w) & vmask) >> (4 * lh);
#pragma unroll
        for (int i = 0; i < 16; ++i) {
          if constexpr (MASKED) {
            const int sel = ((int)(wbits << (31 - ((i & 3) + 8 * (i >> 2))))) >> 31;
            const unsigned sb = __float_as_uint(sacc[t4][i]);
            sacc[t4][i] = __uint_as_float((sb & (unsigned)sel) | (~(unsigned)sel & 0xff800000u));
          }
          mx = fmaxf(mx, sacc[t4][i]);
        }
      }
      mx = fmaxf(mx, shflx(mx, 32, lane));
      const float m_new = fmaxf(m_run, mx);
      const float m_safe = (m_new == -INFINITY) ? 0.f : m_new;
      const float alpha = __builtin_amdgcn_exp2f(m_run - m_safe);
      m_run = m_new;
      float ls = 0.f;
#pragma unroll
      for (int t4 = 0; t4 < 4; ++t4)
#pragma unroll
        for (int i = 0; i < 16; ++i) { float pv = __builtin_amdgcn_exp2f(sacc[t4][i] - m_safe); sacc[t4][i] = pv; ls += pv; }
      l_run = l_run * alpha + ls;
#pragma unroll
      for (int d = 0; d < 2; ++d)
#pragma unroll
        for (int i = 0; i < 16; ++i) oacc[d][i] *= alpha;
#pragma unroll
      for (int t4 = 0; t4 < 4; ++t4)
#pragma unroll
        for (int s = 0; s < 2; ++s) {
          uint4 pp;
          pp.x = pack2(sacc[t4][8 * s + 0], sacc[t4][8 * s + 1]);
          pp.y = pack2(sacc[t4][8 * s + 2], sacc[t4][8 * s + 3]);
          pp.z = pack2(sacc[t4][8 * s + 4], sacc[t4][8 * s + 5]);
          pp.w = pack2(sacc[t4][8 * s + 6], sacc[t4][8 * s + 7]);
          bf16x8 pf = __builtin_bit_cast(bf16x8, pp);
#pragma unroll
          for (int dt = 0; dt < 2; ++dt) {
            bf16x8 vf = *(const bf16x8*)(Vb + (dt * 32 + lr) * VS + t4 * 32 + 16 * s + 8 * lh);
            oacc[dt] = MFMA32(vf, pf, oacc[dt]);
          }
        }
    }
    if (it + 1 < nit) { SSTORE(buf ^ 1); bm_cur = bm_next; }
    __syncthreads();
  }
  if (nit_w > 0) {
    float lt = l_run + shflx(l_run, 32, lane);
    float inv = lt > 0.f ? 1.f / lt : 0.f;
    if (q_ok) {
      bf16_t* orow = AOp + (size_t)(w * 32 + lr) * 1024;
#pragma unroll
      for (int dt = 0; dt < 2; ++dt)
#pragma unroll
        for (int g = 0; g < 4; ++g) {
          uint2 pk;
          pk.x = pack2(oacc[dt][4 * g] * inv, oacc[dt][4 * g + 1] * inv);
          pk.y = pack2(oacc[dt][4 * g + 2] * inv, oacc[dt][4 * g + 3] * inv);
          *(uint2*)(orow + dt * 32 + 8 * g + 4 * lh) = pk;
        }
    }
  }
}
#undef GLOAD
#undef SSTORE

DI int snake_idx(int i, int bid, int nblk) { return i * nblk + ((i & 1) ? (nblk - 1 - bid) : bid); }

template <bool IS_MLA>
DI void attn_phase(PREF p, unsigned char* smem, int bid, int nblk, int wv) {
  unsigned char* R = p.ws + OFF_R;
  const int w = ltid(wv) >> 6;
  const int total = 1024 + 512;
  for (int i = 0; i * nblk < total; ++i) {
    int u = snake_idx(i, bid, nblk);
    if (u >= total) continue;
    if constexpr (IS_MLA) {
      const bf16_t* Q = (const bf16_t*)(R + R_Q); const bf16_t* KN = (const bf16_t*)(R + R_KN);
      const bf16_t* KR = (const bf16_t*)(R + R_KR); const bf16_t* VT = (const bf16_t*)(R + R_VT);
      bf16_t* AO = (bf16_t*)(R + R_RAW);
      if (u < 1024) {
        int qt = 31 - (u >> 5), bh = u & 31, b = bh >> 4, h = bh & 15;
        int q0 = b * 8192 + qt * 256;
        attn8_unit<96, true, false>(Q + (size_t)q0 * 1536 + h * 96, 1536, 256,
                                    KN + (size_t)(b * 8192) * 1024 + h * 64, 1024, KR + (size_t)(b * 8192) * 32,
                                    VT + (size_t)((b * 16 + h) * 64) * 8192, 8192, 8192,
                                    2 * qt + 2, 4 * qt + 1 + (w >> 1), 1 << 30, nullptr,
                                    AO + (size_t)q0 * 1024 + h * 64, smem, wv);
      } else {
        int v = u - 1024, b = v >> 4, h = v & 15;
        int q0 = TP + b * 16;
        attn8_unit<96, true, true>(Q + (size_t)q0 * 1536 + h * 96, 1536, 16,
                                   KN + (size_t)(TP + b * SPAD) * 1024 + h * 64, 1024, KR + (size_t)(TP + b * SPAD) * 32,
                                   VT + (size_t)TP * 1024 + (size_t)((b * 16 + h) * 64) * SPAD, SPAD, SPAD,
                                   9, (w == 0) ? 17 : 0, NKS, nullptr,
                                   AO + (size_t)q0 * 1024 + h * 64, smem, wv);
      }
    } else {
      const bf16_t* Q = (const bf16_t*)(R + D_Q); const bf16_t* KK = (const bf16_t*)(R + D_K);
      const bf16_t* VT = (const bf16_t*)(R + D_VT); const unsigned* BM = (const unsigned*)(R + D_BM);
      bf16_t* AO = (bf16_t*)(R + D_AO);
      if (u < 1024) {
        int qt = 31 - (u >> 5), bh = u & 31, b = bh >> 4, h = bh & 15;
        int q0 = b * 8192 + qt * 256;
        attn8_unit<64, false, true>(Q + (size_t)q0 * 1024 + h * 64, 1024, 256,
                                    KK + (size_t)(b * 8192) * 1024 + h * 64, 1024, nullptr,
                                    VT + (size_t)((b * 16 + h) * 64) * 8192, 8192, 8192,
                                    2 * qt + 2, 4 * qt + 1 + (w >> 1), 1 << 30, BM + (size_t)q0 * 256,
                                    AO + (size_t)q0 * 1024 + h * 64, smem, wv);
      } else {
        int v = u - 1024, b = v >> 4, h = v & 15;
        int q0 = TP + b * 16;
        attn8_unit<64, false, true>(Q + (size_t)q0 * 1024 + h * 64, 1024, 16,
                                    KK + (size_t)(TP + b * SPAD) * 1024 + h * 64, 1024, nullptr,
                                    VT + (size_t)TP * 1024 + (size_t)((b * 16 + h) * 64) * SPAD, SPAD, SPAD,
                                    9, (w == 0) ? 17 : 0, NKS, BM + (size_t)q0 * 256,
                                    AO + (size_t)q0 * 1024 + h * 64, smem, wv);
      }
    }
  }
}

constexpr int CAP = 128;
DI int score_bin(float s) {
  unsigned u = __float_as_uint(s);
  int e = (int)((u & 0x7fffffffu) >> 19);
  int m = min(max(e, 1840), 2095) - 1840;
  return (u >> 31) ? (255 - m) : (256 + m);
}

DI void idx_unit(const bf16_t* __restrict__ QI, const float* __restrict__ WI, int q_row0, int nq,
                 const bf16_t* __restrict__ KI, int L, unsigned* __restrict__ BM, unsigned char* smem, int wv) {
  const int tid = ltid(wv), lane = tid & 63, w = tid >> 6, lr = lane & 31, lh = lane >> 5;
  bf16_t* Qs = (bf16_t*)smem;
  float* Ws = (float*)(smem + 36864);
  unsigned* hist = (unsigned*)(smem + 36864 + 1024);
  float* cand_s = (float*)hist;
  int* cand_i = (int*)(smem + 36864 + 1024 + 16384);
  int* bstar = (int*)(smem + 36864 + 1024 + 32768);
  int* need = bstar + 32;
  int* ncand = need + 32;
  __syncthreads();
#pragma unroll
  for (int i = 0; i < 4; ++i) {
    int v = tid + i * NT;
    int hd = v >> 8, q = (v >> 3) & 31, c = (v & 7) * 8;
    int qq = q < nq ? q : 0;
    *(uint4*)(Qs + (hd * 32 + q) * 72 + c) = *(const uint4*)(QI + (size_t)(q_row0 + qq) * 512 + hd * 64 + c);
  }
  if (tid < 256) { int hd = tid >> 5, q = tid & 31; int qq = q < nq ? q : 0; Ws[hd * 32 + q] = WI[(size_t)(q_row0 + qq) * 8 + hd]; }
  for (int i = tid; i < 32 * 256; i += NT) hist[i] = 0u;
  if (tid < 32) { bstar[tid] = -1; need[tid] = 0; ncand[tid] = 0; }
  __syncthreads();
  const int ntile = (L + 255) >> 8;
  const bool do_select = L > 256;
  int bsr[16];
  { int m1_ = -1; asm volatile("" : "+v"(m1_));
#pragma unroll
    for (int i = 0; i < 16; ++i) bsr[i] = m1_; }
  for (int pass = do_select ? 0 : 1; pass < 2; ++pass) {
    if (pass == 1) {
#pragma unroll
      for (int i = 0; i < 16; ++i) bsr[i] = bstar[crow(i, lh)];
    }
    bf16x8 kn0, kn1, kn2, kn3;
    { const bf16_t* kp = KI + (size_t)(w * 32 + lr) * 64 + lh * 8;
      kn0 = *(const bf16x8*)(kp); kn1 = *(const bf16x8*)(kp + 16); kn2 = *(const bf16x8*)(kp + 32); kn3 = *(const bf16x8*)(kp + 48); }
    for (int kt = 0; kt < ntile; ++kt) {
      const int key0 = kt * 256 + w * 32;
      bf16x8 kf[4];
      kf[0] = kn0; kf[1] = kn1; kf[2] = kn2; kf[3] = kn3;
      if (key0 + 256 < L) {
        const bf16_t* kp = KI + (size_t)(key0 + 256 + lr) * 64 + lh * 8;
        kn0 = *(const bf16x8*)(kp); kn1 = *(const bf16x8*)(kp + 16); kn2 = *(const bf16x8*)(kp + 32); kn3 = *(const bf16x8*)(kp + 48);
      }
      if (key0 < L) {
        const int key = key0 + lr;
        float sc[16];
#pragma unroll
        for (int i = 0; i < 16; ++i) sc[i] = 0.f;
#pragma unroll 1
        for (int hd = 0; hd < 8; ++hd) {
          f32x16 acc;
#pragma unroll
          for (int i = 0; i < 16; ++i) acc[i] = 0.f;
#pragma unroll
          for (int s = 0; s < 4; ++s) {
            bf16x8 qf = *(const bf16x8*)(Qs + (hd * 32 + lr) * 72 + s * 16 + lh * 8);
            acc = MFMA32(qf, kf[s], acc);
          }
#pragma unroll
          for (int g = 0; g < 4; ++g) {
            float4 wv = *(const float4*)(Ws + hd * 32 + 8 * g + 4 * lh);
            sc[4 * g + 0] += wv.x * fmaxf(acc[4 * g + 0], 0.f);
            sc[4 * g + 1] += wv.y * fmaxf(acc[4 * g + 1], 0.f);
            sc[4 * g + 2] += wv.z * fmaxf(acc[4 * g + 2], 0.f);
            sc[4 * g + 3] += wv.w * fmaxf(acc[4 * g + 3], 0.f);
          }
        }
        const bool kvalid = key < L;
        if (pass == 0) {
#pragma unroll
          for (int i = 0; i < 16; ++i) {
            int q = crow(i, lh);
            if (kvalid) { int b = score_bin(sc[i]); atomicAdd(&hist[q * 256 + (b >> 1)], (b & 1) ? 65536u : 1u); }
          }
        } else {
          unsigned myword = 0u, cmask = 0u;
          unsigned long long any = 0ull;
#pragma unroll
          for (int i = 0; i < 16; ++i) {
            const int b = score_bin(sc[i]);
            const int bs = bsr[i];
            const bool sel = kvalid && (b > bs);
            const bool cnd = kvalid && (b == bs);
            const unsigned long long bal = __ballot(sel);
            myword = (lr == i) ? (unsigned)(bal >> (32 * lh)) : myword;
            any |= __ballot(cnd);
            cmask |= cnd ? (1u << i) : 0u;
          }
          if (lr < 16 && crow(lr, lh) < nq) BM[(size_t)(q_row0 + crow(lr, lh)) * 256 + (key0 >> 5)] = myword;
          if (any != 0ull) {
            int base[16];
#pragma unroll
            for (int i = 0; i < 16; ++i) {
              const unsigned long long cbi = __ballot((cmask >> i) & 1u);
              base[i] = 0;
              if (lr == 0) base[i] = atomicAdd(&ncand[crow(i, lh)], __popc((unsigned)(cbi >> (32 * lh))));
            }
#pragma unroll
            for (int i = 0; i < 16; ++i) {
              const unsigned long long cbi = __ballot((cmask >> i) & 1u);
              const int bb = __builtin_amdgcn_ds_bpermute((lane & 32) << 2, base[i]);
              if ((cmask >> i) & 1u) {
                const unsigned hm = (unsigned)(cbi >> (32 * lh));
                const int pos = bb + __popc(hm & ((1u << lr) - 1u));
                const int q = crow(i, lh);
                if (pos < CAP) { cand_s[q * CAP + pos] = sc[i]; cand_i[q * CAP + pos] = key; }
              }
            }
          }
        }
      }
    }
    __syncthreads();
    if (pass == 0) {
      for (int qi = 0; qi < 4; ++qi) {
        const int q = w * 4 + qi;
        unsigned hw[4];
#pragma unroll
        for (int k = 0; k < 4; ++k) hw[k] = hist[q * 256 + 255 - 4 * lane - k];
        int cnt = 0;
#pragma unroll
        for (int k = 0; k < 4; ++k) cnt += (int)(hw[k] >> 16) + (int)(hw[k] & 0xffffu);
        int pre = cnt;
#pragma unroll
        for (int o = 1; o < 64; o <<= 1) { int t = __builtin_amdgcn_ds_bpermute(((lane - o) & 63) << 2, pre); if (lane >= o) pre += t; }
        unsigned long long bal = __ballot(pre >= 256);
        if (bal != 0ull) {
          int fl = __ffsll((long long)bal) - 1;
          if (lane == fl) {
            int running = pre - cnt;
            int bsel = -1, above = 0;
#pragma unroll
            for (int k = 0; k < 4; ++k) {
              int chi = (int)(hw[k] >> 16), clo = (int)(hw[k] & 0xffffu);
              if (bsel < 0) { if (running + chi >= 256) { bsel = 511 - 8 * lane - 2 * k; above = running; } else running += chi; }
              if (bsel < 0) { if (running + clo >= 256) { bsel = 510 - 8 * lane - 2 * k; above = running; } else running += clo; }
            }
            bstar[q] = bsel; need[q] = 256 - above;
          }
        }
      }
      __syncthreads();
    }
  }
  __threadfence();
  __syncthreads();
  if (do_select) {
    for (int pi = tid; pi < 32 * CAP; pi += NT) {
      int q = pi / CAP, c = pi - q * CAP;
      int n = min(ncand[q], CAP);
      if (c < n && q < nq) {
        float sv = cand_s[q * CAP + c]; int iv = cand_i[q * CAP + c];
        int rank = 0;
        for (int j = 0; j < n; ++j) {
          float sj = cand_s[q * CAP + j]; int ij = cand_i[q * CAP + j];
          rank += (sj > sv || (sj == sv && ij < iv)) ? 1 : 0;
        }
        if (rank < need[q]) atomicOr(&BM[(size_t)(q_row0 + q) * 256 + (iv >> 5)], 1u << (iv & 31));
      }
    }
  }
  __syncthreads();
}

DI void idx_phase(PREF p, unsigned char* smem, int bid, int nblk, int wv) {
  unsigned char* R = p.ws + OFF_R;
  const bf16_t* QI = (const bf16_t*)(R + D_QI); const float* WI = (const float*)(R + D_WI);
  const bf16_t* KI = (const bf16_t*)(R + D_KI); unsigned* BM = (unsigned*)(R + D_BM);
  const int total = 512 + 32;
  for (int i = 0; i * nblk < total; ++i) {
    int idx = snake_idx(i, bid, nblk);
    if (idx >= total) continue;
    if (idx < 512) {
      int qt = 255 - (idx >> 1), b = idx & 1;
      int L = (((qt * 32) >> 6) + 1) * 64;
      idx_unit(QI, WI, b * 8192 + qt * 32, 32, KI + (size_t)(b * 8192) * 64, L, BM, smem, wv);
    } else {
      int b = idx - 512;
      idx_unit(QI, WI, TP + b * 16, 16, KI + (size_t)(TP + b * SPAD) * 64, NKS, BM, smem, wv);
    }
  }
}

DI void cvt8(const float* s, bf16_t* d) {
  float4 a = *(const float4*)s, b = *(const float4*)(s + 4);
  uint4 pk; pk.x = pack2(a.x, a.y); pk.y = pack2(a.z, a.w); pk.z = pack2(b.x, b.y); pk.w = pack2(b.z, b.w);
  *(uint4*)d = pk;
}
DI void cache_rows(const float* __restrict__ src, bf16_t* __restrict__ dst, int Wd, int bid, int nblk, int wv) {
  const int vpr = Wd >> 3;
  const size_t total = (size_t)32 * SPAD * vpr;
  for (size_t e = (size_t)bid * NT + ltid(wv); e < total; e += (size_t)nblk * NT) {
    int c = (int)(e % vpr) * 8; size_t rw = e / vpr; int b = (int)(rw / SPAD), s = (int)(rw % SPAD);
    bf16_t* d = dst + ((size_t)TP + (size_t)b * SPAD + s) * Wd + c;
    if (s < 1024) cvt8(src + ((size_t)b * 1024 + s) * Wd + c, d);
    else if (s >= NKS) { unsigned z = 0; asm volatile("" : "+v"(z)); *(uint4*)d = make_uint4(z, z, z, z); }
  }
}


#define XB_TMO      128
#define XB_XCNT(j)  (256  + 64 * (j))
#define XB_XSUB(j)  (1280 + 64 * (j))
#define XB_XGEN(j)  (2304 + 64 * (j))
#define XB_TOP      3328
#define XB_TOPGEN   3392
#define XCD_BAR_WORDS 3456
#define XB_SPIN_CAP (1u << 18)
DI unsigned xb_ld(unsigned* p)              { return __hip_atomic_load(p, __ATOMIC_RELAXED, __HIP_MEMORY_SCOPE_AGENT); }
DI unsigned xb_add(unsigned* p, unsigned v) { return __hip_atomic_fetch_add(p, v, __ATOMIC_RELAXED, __HIP_MEMORY_SCOPE_AGENT); }
DI unsigned xb_xcc_id() { return (unsigned)__builtin_amdgcn_s_getreg((3 << 11) | 20) & 0xFu; }
#define XB_SPIN(cond, bar) do { unsigned _sp = 0; while (cond) { __builtin_amdgcn_s_sleep(1); \
    if ((++_sp & 255u) == 0u) { if (xb_ld(&(bar)[XB_TMO])) break; if (_sp > XB_SPIN_CAP) { atomicAdd(&(bar)[XB_TMO], 1u); break; } } } } while (0)
struct XcdBarrier { unsigned* bar; unsigned x; volatile __attribute__((address_space(3))) unsigned* st; };
DI void xcd_barrier_complete(unsigned* bar, unsigned x, unsigned G, unsigned& nloc, unsigned& nx) {
  unsigned sum, cnt, mine, sp = 0u;
  for (;;) {
    sum = 0u; cnt = 0u; mine = 0u;
#pragma unroll
    for (unsigned j = 0; j < 16; ++j) { const unsigned c = xb_ld(&bar[XB_XCNT(j)]); sum += c; cnt += (c > 0u) ? 1u : 0u; mine = (j == x) ? c : mine; }
    if (sum == G) break;
    __builtin_amdgcn_s_sleep(1);
    if ((++sp & 255u) == 0u) { if (xb_ld(&bar[XB_TMO])) break; if (sp > XB_SPIN_CAP) { atomicAdd(&bar[XB_TMO], 1u); break; } }
  }
  nloc = mine > 0u ? mine : 1u; nx = cnt > 0u ? cnt : 1u;
}
DI void xcd_barrier(const XcdBarrier& b, int tid, unsigned G) {
  asm volatile("s_waitcnt vmcnt(0)" ::: "memory");
  __syncthreads();
  if (tid == 0) {
    unsigned* bar = b.bar;
    __builtin_amdgcn_s_waitcnt(0);
    unsigned nloc = b.st[0], nx = b.st[1];
    if (nloc == 0u) { xcd_barrier_complete(bar, b.x, G, nloc, nx); b.st[0] = nloc; b.st[1] = nx; }
    const unsigned old = xb_add(&bar[XB_XSUB(b.x)], 1u);
    const unsigned gen = old / nloc;
    if (old + 1u == (gen + 1u) * nloc) {
      __builtin_amdgcn_fence(__ATOMIC_RELEASE, "agent");
      asm volatile("s_waitcnt vmcnt(0)" ::: "memory");
      const unsigned og = xb_add(&bar[XB_TOP], 1u);
      const unsigned tg = og / nx;
      if (og + 1u == (tg + 1u) * nx) xb_add(&bar[XB_TOPGEN], 1u);
      else XB_SPIN(xb_ld(&bar[XB_TOPGEN]) == tg, bar);
      __builtin_amdgcn_fence(__ATOMIC_ACQUIRE, "agent");
      xb_add(&bar[XB_XGEN(b.x)], 1u);
      asm volatile("s_waitcnt vmcnt(0)" ::: "memory");
    } else {
      XB_SPIN(xb_ld(&bar[XB_XGEN(b.x)]) == gen, bar);
      __builtin_amdgcn_fence(__ATOMIC_ACQUIRE, "agent");
      asm volatile("s_waitcnt vmcnt(0)" ::: "memory");
    }
  }
  __syncthreads();
}

extern "C" __global__ void __launch_bounds__(512, 2) mega(Params p_unused) {
  extern __shared__ __attribute__((aligned(16))) unsigned char smem[];
  cg::grid_group grid = cg::this_grid();
  const int bid = blockIdx.x, nblk = gridDim.x;
  const int wv = __builtin_amdgcn_readfirstlane((int)(threadIdx.x >> 6));
  CParams* pk = (CParams*)__builtin_amdgcn_kernarg_segment_ptr();
  const int ph_lo = pk->ph_lo, ph_hi = pk->ph_hi;
  int ph = 0;
  if (ph_lo > 0x40000000) grid.sync();
  XcdBarrier xb;
  {
    volatile __attribute__((address_space(3))) unsigned* st = (volatile __attribute__((address_space(3))) unsigned*)(smem + 131072);
    const int t0 = ltid(wv);
    if (t0 == 0) { st[0] = 0u; st[1] = 0u; }
    __syncthreads();
    xb.bar = (unsigned*)(pk->ws + OFF_BAR); xb.x = xb_xcc_id(); xb.st = st;
    if (t0 == 0) (void)xb_add(&xb.bar[XB_XCNT(xb.x)], 1u);
  }
#ifndef REPMASK
#define REPMASK 0u
#endif
#ifndef PMASK
#define PMASK 0xffffffffu
#endif
#define PHASE_BEGIN(k) if (ph >= ph_lo && ph < ph_hi) { if constexpr ((PMASK >> (k)) & 1u) for (int rep_ = 0; rep_ < 1 + (int)((REPMASK >> (k)) & 1u); ++rep_) { \
    CParams* pp_ = pk; asm volatile("" : "+s"(pp_)); PREF p = *pp_; const int tid = ltid(wv); \
    unsigned char* ws = p.ws; float* X = (float*)(ws + OFF_X); bf16_t* H = (bf16_t*)(ws + OFF_H); bf16_t* Wb = (bf16_t*)(ws + OFF_W); \
    float* ROPE = (float*)(ws + OFF_ROPE); unsigned char* R = ws + OFF_R; (void)tid; (void)X; (void)H; (void)Wb; (void)ROPE; (void)R;
#define PHASE_END   } if (ph + 1 < ph_hi) { xcd_barrier(xb, ltid(wv), (unsigned)nblk); } } ++ph;

  PHASE_BEGIN(0)
    {
      const int hf = tid >> 8, tl = tid & 255;
      float* smh = (float*)smem + hf * 4224;
      for (int t0 = bid * 2; t0 < p.total_tiles; t0 += nblk * 2) {
        const int t = t0 + hf;
        const bool active = t < p.total_tiles;
        const int tt = active ? t : 0;
        int ji = 0;
#pragma unroll 1
        for (int q = 1; q < NJOBS; ++q) if (tt >= p.jobs[q].tile0) ji = q;
        const CAS Job& jb = p.jobs[ji];
        int lt = tt - jb.tile0; int nkt = jb.k >> 6; int nt_ = lt / nkt, kt_ = lt - nt_ * nkt;
        transpose_tile(jb.src, jb.nsrc, jb.nsrc, jb.dst, jb.k, nt_ * 64, kt_ * 64, jb.mode, smh, tl, active);
      }
    }
    {
      const size_t n4p = (size_t)TP * 256, n4 = (size_t)T * 256;
      const float4* xp = (const float4*)p.in[0]; const float4* xs = (const float4*)p.in[1];
      for (size_t e = (size_t)bid * NT + tid; e < n4; e += (size_t)nblk * NT) ((float4*)X)[e] = (e < n4p) ? xp[e] : xs[e - n4p];
      for (int e = bid * NT + tid; e < 8192 * 16; e += nblk * NT) {
        int pos = e >> 4, i = e & 15;
        double rev = (double)pos * p.inv_freq[i] * 0.15915494309189535;
        rev -= floor(rev);
        float fr = (float)rev;
        ROPE[2 * e] = __builtin_amdgcn_cosf(fr); ROPE[2 * e + 1] = __builtin_amdgcn_sinf(fr);
      }
      const float* wsrc = p.in[20];
      for (int e = bid * NT + tid; e < 8 * 128 * 128; e += nblk * NT) {
        int s = e & 127, t = (e >> 7) & 127;
        Wb[W_TRIL + e] = tobf(s <= t ? wsrc[e] : 0.f);
      }
    }
  PHASE_END

#pragma unroll 1
  for (int L = 0; L < 4; ++L) {
    const int kind = L % 3, j = L / 3;
    if (kind == 0) {
      PHASE_BEGIN(1)
        rmsnorm_rows(X, p.in[7] + L * 1024, H, nullptr, nullptr, bid, nblk, wv);
        cache_rows(p.in[2] + (size_t)j * 32 * 1024 * 256, (bf16_t*)(R + R_CKV), 256, bid, nblk, wv);
        cache_rows(p.in[3] + (size_t)j * 32 * 1024 * 32, (bf16_t*)(R + R_KR), 32, bid, nblk, wv);
      PHASE_END
      PHASE_BEGIN(2)
        EArgs ea{}; ea.f0 = (float*)(R + R_RAW);
        gemm_phase<E_F32>(H, Wb + W_MLA + (size_t)j * WM_SZ + WM_D, T, 1024, 1024, ea, smem, 0, bid, nblk, wv);
      PHASE_END
      PHASE_BEGIN(3)
        mla_rowops(p, j, bid, nblk, wv);
      PHASE_END
      PHASE_BEGIN(4)
        EArgs ea{}; ea.b0 = (bf16_t*)(R + R_Q); ea.rope = ROPE;
        gemm_phase<E_MLAQ>((const bf16_t*)(R + R_CQ), Wb + W_MLA + (size_t)j * WM_SZ + WM_UQ, T, 1536, 512, ea, smem, 0, bid, nblk, wv);
        EArgs eb{}; eb.b0 = (bf16_t*)(R + R_KN); eb.b1 = (bf16_t*)(R + R_VT);
        gemm_phase<E_MLAKV>((const bf16_t*)(R + R_CKV), Wb + W_MLA + (size_t)j * WM_SZ + WM_UKV, KROWS, 2048, 256, eb, smem, (T / 256) * 6, bid, nblk, wv);
      PHASE_END
      PHASE_BEGIN(5)
        attn_phase<true>(p, smem, bid, nblk, wv);
      PHASE_END
      PHASE_BEGIN(6)
        EArgs ea{}; ea.f0 = X;
        gemm_phase<E_RESID>((const bf16_t*)(R + R_RAW), Wb + W_MLA + (size_t)j * WM_SZ + WM_O, T, 1024, 1024, ea, smem, 0, bid, nblk, wv);
      PHASE_END
    } else if (kind == 1) {
      PHASE_BEGIN(1)
        rmsnorm_rows(X, p.in[7] + L * 1024, H, nullptr, nullptr, bid, nblk, wv);
      PHASE_END
      PHASE_BEGIN(7)
        EArgs ea{}; ea.b0 = (bf16_t*)(R + C_U); ea.b1 = (bf16_t*)(R + C_VR);
        gemm_phase<E_GELU>(H, Wb + W_CM + WC_IN, T, 4096, 1024, ea, smem, 0, bid, nblk, wv);
      PHASE_END
      PHASE_BEGIN(8)
        cmlp_ln_rows(p, bid, nblk, wv);
      PHASE_END
      PHASE_BEGIN(9)
        cmlp_mix_phase(p, smem, bid, nblk, wv);
      PHASE_END
      PHASE_BEGIN(6)
        EArgs ea{}; ea.f0 = X;
        gemm_phase<E_RESID>((const bf16_t*)(R + C_G), Wb + W_CM + WC_OUT, T, 1024, 2048, ea, smem, 0, bid, nblk, wv);
      PHASE_END
    } else {
      PHASE_BEGIN(10)
        rmsnorm_rows(X, p.in[7] + L * 1024, H, nullptr, nullptr, bid, nblk, wv);
        cache_rows(p.in[4], (bf16_t*)(R + D_K), 1024, bid, nblk, wv);
        cache_rows(p.in[6], (bf16_t*)(R + D_KI), 64, bid, nblk, wv);
        {
          bf16_t* VTs = (bf16_t*)(R + D_VT) + (size_t)TP * 1024;
          {
            const int hf = tid >> 8, tl = tid & 255;
            float* smh = (float*)smem + hf * 4224;
            for (int u0 = bid * 2; u0 < 512 * 16; u0 += nblk * 2) {
              const int u = u0 + hf;
              int st = u & 15, bh = u >> 4, b = bh >> 4, h = bh & 15;
              transpose_tile(p.in[5] + (size_t)b * 1024 * 1024 + h * 64, 1024, 64, VTs + (size_t)(bh * 64) * SPAD, SPAD, 0, st * 64, 0, smh, tl, true);
            }
          }
          for (int e = bid * NT + tid; e < 512 * 64 * 12; e += nblk * NT) {
            int c = e % 12, rw = e / 12;
            { unsigned z = 0; asm volatile("" : "+v"(z)); *(uint2*)(VTs + (size_t)rw * SPAD + NKS + c * 4) = make_uint2(z, z); }
          }
        }
      PHASE_END
      PHASE_BEGIN(11)
        EArgs ea{};
        ea.f0 = p.out + O_DKP; ea.f1 = p.out + O_DKS; ea.f2 = p.out + O_DVP; ea.f3 = p.out + O_DVS;
        ea.f4 = (float*)(R + D_KIR); ea.f5 = (float*)(R + D_WI);
        ea.b0 = (bf16_t*)(R + D_Q); ea.b1 = (bf16_t*)(R + D_K); ea.b2 = (bf16_t*)(R + D_VT); ea.b3 = (bf16_t*)(R + D_QI);
        gemm_phase<E_DSA>(H, Wb + W_DS + WD_P, T, 3840, 1024, ea, smem, 0, bid, nblk, wv);
      PHASE_END
      PHASE_BEGIN(12)
        dsa_rowops(p, bid, nblk, wv);
      PHASE_END
      PHASE_BEGIN(13)
        idx_phase(p, smem, bid, nblk, wv);
      PHASE_END
      PHASE_BEGIN(14)
        attn_phase<false>(p, smem, bid, nblk, wv);
      PHASE_END
      PHASE_BEGIN(6)
        EArgs ea{}; ea.f0 = X;
        gemm_phase<E_RESID>((const bf16_t*)(R + D_AO), Wb + W_DS + WD_O, T, 1024, 1024, ea, smem, 0, bid, nblk, wv);
      PHASE_END
    }
    PHASE_BEGIN(1)
      rmsnorm_rows(X, p.in[8] + L * 1024, H, nullptr, nullptr, bid, nblk, wv);
    PHASE_END
    PHASE_BEGIN(15)
      EArgs ea{}; ea.b0 = (bf16_t*)(R + 0);
      gemm_phase<E_SWIGLU>(H, Wb + W_FF + (size_t)L * WF_SZ + WF_IN, T, 2 * DFF, 1024, ea, smem, 0, bid, nblk, wv);
    PHASE_END
    PHASE_BEGIN(6)
      EArgs ea{}; ea.f0 = X;
      gemm_phase<E_RESID>((const bf16_t*)(R + 0), Wb + W_FF + (size_t)L * WF_SZ + WF_OUT, T, 1024, DFF, ea, smem, 0, bid, nblk, wv);
    PHASE_END
  }
  PHASE_BEGIN(1)
    rmsnorm_rows(X, p.in[9], nullptr, p.out + O_YP, p.out + O_YS, bid, nblk, wv);
  PHASE_END
}

extern "C" void kernel_launch(void* const* d_in, const int* in_sizes, int n_in,
                              void* d_out, int out_size, void* d_ws, size_t ws_size,
                              hipStream_t stream) {
  constexpr int kLds = 128 * 1024 + 64;
  static int grid_blocks = 0;
  if (!grid_blocks) {
    int dev = 0, cus = 0, per_cu = 0;
    (void)hipGetDevice(&dev);
    (void)hipDeviceGetAttribute(&cus, hipDeviceAttributeMultiprocessorCount, dev);
    (void)hipFuncSetAttribute((const void*)mega, hipFuncAttributeMaxDynamicSharedMemorySize, kLds);
    (void)hipOccupancyMaxActiveBlocksPerMultiprocessor(&per_cu, (const void*)mega, NT, kLds);
    if (per_cu < 1) per_cu = 1;
    if (per_cu > 1) per_cu = 1;
    grid_blocks = cus * per_cu;
    fprintf(stderr, "grid %d (cus %d per_cu %d) ws %zu need %zu out %d need %zu\n", grid_blocks, cus, per_cu, ws_size, (size_t)WS_NEED, out_size, (size_t)O_END);
  }
  if (ws_size < WS_NEED || n_in != 31 || (size_t)out_size != O_END) { fprintf(stderr, "kernel_launch: bad sizes\n"); return; }
  Params p;
  memset(&p, 0, sizeof(p));
  for (int i = 0; i < 31; ++i) p.in[i] = (const float*)d_in[i];
  p.out = (float*)d_out; p.ws = (unsigned char*)d_ws;
  bf16_t* Wb = (bf16_t*)((unsigned char*)d_ws + OFF_W);
  int nj = 0, tiles = 0;
  auto add = [&](const float* src, int nsrc, int k, bf16_t* dst, int ndst, int mode) {
    Job& jb = p.jobs[nj++]; jb.src = src; jb.dst = dst; jb.nsrc = nsrc; jb.k = k; jb.ndst = ndst; jb.mode = mode; jb.tile0 = tiles; jb.pad = 0;
    tiles += (ndst / 64) * (k / 64);
  };
  for (int j = 0; j < 2; ++j) {
    bf16_t* Wm = Wb + W_MLA + (size_t)j * WM_SZ;
    add(p.in[10] + (size_t)j * 1024 * 512, 512, 1024, Wm + WM_D, 512, 2);
    add(p.in[13] + (size_t)j * 1024 * 288, 288, 1024, Wb + W_MLA + (size_t)j * WM_SZ + WM_D + (size_t)512 * 1024, 512, 2);
    add(p.in[12] + (size_t)j * 512 * 1536, 1536, 512, Wb + W_MLA + (size_t)j * WM_SZ + WM_UQ, 1536, 0);
    add(p.in[15] + (size_t)j * 256 * 2048, 2048, 256, Wb + W_MLA + (size_t)j * WM_SZ + WM_UKV, 2048, 2);
    add(p.in[16] + (size_t)j * 1024 * 1024, 1024, 1024, Wb + W_MLA + (size_t)j * WM_SZ + WM_O, 1024, 2);
  }
  add(p.in[17], 4096, 1024, Wb + W_CM + WC_IN, 4096, 2);
  add(p.in[22], 1024, 2048, Wb + W_CM + WC_OUT, 1024, 2);
  add(p.in[23], 3072, 1024, Wb + W_DS + WD_P, 3072, 2);
  add(p.in[25], 512, 1024, Wb + W_DS + WD_P + (size_t)3072 * 1024, 512, 2);
  add(p.in[26], 64, 1024, Wb + W_DS + WD_P + (size_t)3584 * 1024, 64, 2);
  add(p.in[28], 8, 1024, Wb + W_DS + WD_P + (size_t)3648 * 1024, 192, 2);
  add(p.in[24], 1024, 1024, Wb + W_DS + WD_O, 1024, 2);
  for (int i = 0; i < 4; ++i) {
    add(p.in[29] + (size_t)i * 1024 * 5632, 5632, 1024, Wb + W_FF + (size_t)i * WF_SZ + WF_IN, 5632, 1);
    add(p.in[30] + (size_t)i * 2816 * 1024, 1024, 2816, Wb + W_FF + (size_t)i * WF_SZ + WF_OUT, 1024, 2);
  }
  p.total_tiles = tiles;
  for (int i = 0; i < 16; ++i) p.inv_freq[i] = pow(10000.0, -(double)i / 16.0);
  p.ph_lo = 0; p.ph_hi = 1000;
  (void)hipMemsetAsync((unsigned char*)d_ws + OFF_BAR, 0, 16384, stream);
  void* args[] = {&p};
  hipError_t e = hipLaunchCooperativeKernel((const void*)mega, dim3(grid_blocks), dim3(NT), args, kLds, stream);
  if (e != hipSuccess) fprintf(stderr, "coop launch failed: %s\n", hipGetErrorString(e));
}
```

```cpp
#include <hip/hip_runtime.h>
#include <hip/hip_cooperative_groups.h>
#include <cstdio>
#include <cstring>
#include <cmath>
namespace cg = cooperative_groups;

typedef unsigned short bf16_t;
using bf16x8 = __attribute__((ext_vector_type(8))) short;
using f32x16 = __attribute__((ext_vector_type(16))) float;
using f32x2v = __attribute__((ext_vector_type(2))) float;
using bf2v = __attribute__((ext_vector_type(2))) __bf16;
#define DI __device__ __forceinline__
#define MFMA32(a, b, c) __builtin_amdgcn_mfma_f32_32x32x16_bf16((a), (b), (c), 0, 0, 0)

constexpr int TP = 16384, TS = 512, T = TP + TS;
constexpr int NT = 512;
constexpr int SPAD = 1088, NKS = 1040;
constexpr int KROWS = TP + 32 * SPAD;
constexpr int DFF = 2816;
constexpr float LOG2E = 1.4426950408889634f;
constexpr float EPS = 1e-6f;

constexpr size_t OFF_X = 0;
constexpr size_t OFF_H = OFF_X + (size_t)T * 1024 * 4;
constexpr size_t OFF_W = OFF_H + (size_t)T * 1024 * 2;
constexpr size_t W_ELEMS = 52822016;
constexpr size_t OFF_ROPE = OFF_W + W_ELEMS * 2;
constexpr size_t OFF_R = OFF_ROPE + (size_t)8192 * 16 * 2 * 4;
constexpr size_t R_RAW = 0;
constexpr size_t R_CQ = R_RAW + (size_t)T * 1024 * 4;
constexpr size_t R_CKV = R_CQ + (size_t)T * 512 * 2;
constexpr size_t R_KR = R_CKV + (size_t)KROWS * 256 * 2;
constexpr size_t R_Q = R_KR + (size_t)KROWS * 32 * 2;
constexpr size_t R_KN = R_Q + (size_t)T * 1536 * 2;
constexpr size_t R_VT = R_KN + (size_t)KROWS * 1024 * 2;
constexpr size_t R_END = R_VT + (size_t)KROWS * 1024 * 2;
constexpr size_t D_Q = 0;
constexpr size_t D_K = D_Q + (size_t)T * 1024 * 2;
constexpr size_t D_VT = D_K + (size_t)KROWS * 1024 * 2;
constexpr size_t D_QI = D_VT + (size_t)KROWS * 1024 * 2;
constexpr size_t D_KIR = D_QI + (size_t)T * 512 * 2;
constexpr size_t D_KI = D_KIR + (size_t)T * 64 * 4;
constexpr size_t D_WI = D_KI + (size_t)KROWS * 64 * 2;
constexpr size_t D_BM = D_WI + (size_t)T * 8 * 4;
constexpr size_t D_AO = D_BM + (size_t)T * 256 * 4;
constexpr size_t D_END = D_AO + (size_t)T * 1024 * 2;
constexpr size_t C_U = 0;
constexpr size_t C_VR = C_U + (size_t)T * 2048 * 2;
constexpr size_t C_VLN = C_VR + (size_t)T * 2048 * 2;
constexpr size_t C_G = C_VLN + (size_t)T * 2048 * 2;
constexpr size_t C_END = C_G + (size_t)T * 2048 * 2;
constexpr size_t OFF_BAR = OFF_R + R_END;
constexpr size_t WS_NEED = OFF_BAR + 16384;
static_assert(D_END <= R_END && C_END <= R_END && (size_t)T * DFF * 2 <= R_END, "region");

constexpr size_t W_MLA = 0;
constexpr size_t WM_D = 0, WM_UQ = 1048576, WM_UKV = WM_UQ + 786432, WM_O = WM_UKV + 524288, WM_SZ = 3407872;
constexpr size_t W_CM = 2 * WM_SZ;
constexpr size_t WC_IN = 0, WC_OUT = 4194304, WC_SZ = 6291456;
constexpr size_t W_DS = W_CM + WC_SZ;
constexpr size_t WD_P = 0, WD_O = 3932160, WD_SZ = 4980736;
constexpr size_t W_FF = W_DS + WD_SZ;
constexpr size_t WF_IN = 0, WF_OUT = 5767168, WF_SZ = 8650752;
constexpr size_t W_TRIL = W_FF + 4 * WF_SZ;
static_assert(W_TRIL + 131072 == W_ELEMS, "w");

constexpr size_t O_YP = 0;
constexpr size_t O_YS = O_YP + (size_t)TP * 1024;
constexpr size_t O_CKVP = O_YS + (size_t)TS * 1024;
constexpr size_t O_KRP = O_CKVP + (size_t)2 * TP * 256;
constexpr size_t O_CKVS = O_KRP + (size_t)2 * TP * 32;
constexpr size_t O_KRS = O_CKVS + (size_t)2 * TS * 256;
constexpr size_t O_CVS = O_KRS + (size_t)2 * TS * 32;
constexpr size_t O_DKP = O_CVS + (size_t)TS * 2048;
constexpr size_t O_DVP = O_DKP + (size_t)TP * 1024;
constexpr size_t O_DIP = O_DVP + (size_t)TP * 1024;
constexpr size_t O_DKS = O_DIP + (size_t)TP * 64;
constexpr size_t O_DVS = O_DKS + (size_t)TS * 1024;
constexpr size_t O_DIS = O_DVS + (size_t)TS * 1024;
constexpr size_t O_END = O_DIS + (size_t)TS * 64;

constexpr int NJOBS = 25;
struct Job { const float* src; bf16_t* dst; int nsrc, k, ndst, mode, tile0, pad; };
struct Params {
  const float* in[31];
  float* out;
  unsigned char* ws;
  Job jobs[NJOBS];
  int total_tiles, ph_lo, ph_hi, pad;
  double inv_freq[16];
};

#define CAS __attribute__((address_space(4)))
typedef const CAS Params CParams;
#define PREF const CAS Params&
DI unsigned pack2(float a, float b) { f32x2v v = {a, b}; bf2v r = __builtin_convertvector(v, bf2v); return __builtin_bit_cast(unsigned, r); }
DI bf16_t tobf(float a) { return (bf16_t)(pack2(a, 0.f) & 0xffffu); }
DI float frombf(bf16_t v) { return __uint_as_float(((unsigned)v) << 16); }
DI float bflo(unsigned u) { return __uint_as_float(u << 16); }
DI float bfhi(unsigned u) { return __uint_as_float(u & 0xffff0000u); }
DI float shflx(float v, int m, int lane) { return __int_as_float(__builtin_amdgcn_ds_bpermute((lane ^ m) << 2, __float_as_int(v))); }
DI float wave_sum(float v, int lane) {
#pragma unroll
  for (int o = 32; o >= 1; o >>= 1) v += shflx(v, o, lane);
  return v;
}
DI int ltid(int wv) { unsigned m1 = ~0u; asm volatile("" : "+s"(m1)); int t = (wv << 6) | (int)__builtin_amdgcn_mbcnt_hi(m1, __builtin_amdgcn_mbcnt_lo(m1, 0u)); asm volatile("" : "+v"(t)); return t; }
using f4v = __attribute__((ext_vector_type(4))) float;
DI float4 ldnt4(const float* p) { f4v v = __builtin_nontemporal_load((const f4v*)p); return make_float4(v[0], v[1], v[2], v[3]); }
DI int crow(int i, int h) { return (i & 3) + 8 * (i >> 2) + 4 * h; }
DI int rowmap(int t) { if (t < TP) return t; int u = t - TP; return TP + (u >> 4) * SPAD + 1024 + (u & 15); }
DI int tokpos(int t) { return t < TP ? (t & 8191) : 1024 + ((t - TP) & 15); }

DI void transpose_tile(const float* __restrict__ src, int src_ld, int ncols, bf16_t* __restrict__ dst, int dst_ld,
                       int n0, int k0, int mode, float* sm, int tid, bool active) {
  const int nl = (tid & 15) * 4, kq = tid >> 4;
  const int n = n0 + nl;
  int c;
  if (mode != 1) c = n < ncols ? n : -1;
  else { int tt = n >> 5, r = n & 31; int f = tt * 16 + (r & 15); c = (r < 16) ? f : DFF + f; }
  int dr[4];
#pragma unroll
  for (int e = 0; e < 4; ++e) { int col = nl + e; dr[e] = (mode == 2) ? ((col & 32) + (col & 1) * 16 + ((col & 31) >> 1)) : col; }
  if (active) {
    float4 v[4];
#pragma unroll
    for (int i = 0; i < 4; ++i) {
      int kk = kq + 16 * i;
      v[i] = (c >= 0) ? ldnt4(src + (size_t)(k0 + kk) * src_ld + c) : make_float4(0.f, 0.f, 0.f, 0.f);
    }
#pragma unroll
    for (int i = 0; i < 4; ++i) {
      int kk = kq + 16 * i;
      float* d = sm + kk * 65;
      d[dr[0]] = v[i].x; d[dr[1]] = v[i].y; d[dr[2]] = v[i].z; d[dr[3]] = v[i].w;
    }
  }
  __syncthreads();
  if (active) {
    const int kp = (tid & 31) * 2, nr = tid >> 5;
#pragma unroll 4
    for (int i = 0; i < 8; ++i) {
      int nn = nr + 8 * i;
      float a = sm[kp * 65 + nn], b = sm[(kp + 1) * 65 + nn];
      *(unsigned*)(dst + (size_t)(n0 + nn) * dst_ld + k0 + kp) = pack2(a, b);
    }
  }
  __syncthreads();
}

enum { E_F32 = 0, E_RESID, E_SWIGLU, E_GELU, E_MLAQ, E_MLAKV, E_DSA };
struct EArgs {
  float* f0; float* f1; float* f2; float* f3; float* f4; float* f5; float* f6;
  bf16_t* b0; bf16_t* b1; bf16_t* b2; bf16_t* b3;
  const float* rope;
};
using f32x4v = __attribute__((ext_vector_type(4))) float;
#define LAS __attribute__((address_space(3)))
constexpr int G_HT = 128 * 64;
DI int lds_byte(int r, int c) {
  int st = (r >> 4) * 2 + (c >> 5), rr = r & 15, cc = c & 31, ob = rr * 64 + cc * 2;
  return st * 1024 + (ob ^ (((ob >> 9) & 1) << 5));
}
DI void stage_rc(int b, int& R, int& C) {
  int st = b >> 10, sb = b & 1023, swz = sb ^ (((sb >> 9) & 1) << 5);
  R = (st >> 1) * 16 + (swz >> 6); C = (st & 1) * 32 + ((swz & 63) >> 1);
}

DI float gelu_exact(float x) {
  const float z = fabsf(x) * 0.70710678118654752f;
  const float t = __builtin_amdgcn_rcpf(1.f + 0.3275911f * z);
  float pl = 1.061405429f;
  pl = pl * t - 1.453152027f; pl = pl * t + 1.421413741f; pl = pl * t - 0.284496736f; pl = pl * t + 0.254829592f;
  const float e = pl * t * __builtin_amdgcn_exp2f(-z * z * 1.4426950408889634f);
  const float erfz = 1.f - e;
  const float erfx = x < 0.f ? -erfz : erfz;
  return 0.5f * x * (1.f + erfx);
}
template <int EPI, bool ATOM>
DI void epi16(const EArgs& ea, int row0, int gb, int fr, const f32x4v& v0, const f32x4v& v1) {
  if constexpr (EPI == E_F32) {
#pragma unroll
    for (int j = 0; j < 4; ++j) *(float2*)(ea.f0 + (size_t)(row0 + j) * 1024 + gb + 2 * fr) = make_float2(v0[j], v1[j]);
  } else if constexpr (EPI == E_RESID) {
#pragma unroll
    for (int j = 0; j < 4; ++j) { float* o = ea.f0 + (size_t)(row0 + j) * 1024 + gb + 2 * fr;
      if constexpr (ATOM) { unsafeAtomicAdd(o, v0[j]); unsafeAtomicAdd(o + 1, v1[j]); }
      else { float2 x = *(float2*)o; x.x += v0[j]; x.y += v1[j]; *(float2*)o = x; } }
  } else if constexpr (EPI == E_SWIGLU) {
    const int f = (gb >> 1) + fr;
#pragma unroll
    for (int j = 0; j < 4; ++j) { float g = v0[j], u = v1[j]; ea.b0[(size_t)(row0 + j) * DFF + f] = tobf(g * __builtin_amdgcn_rcpf(1.f + __builtin_amdgcn_exp2f(-g * LOG2E)) * u); }
  } else if constexpr (EPI == E_GELU) {
    bf16_t* dstp = (gb < 2048) ? (ea.b0 + gb + 2 * fr) : (ea.b1 + (gb - 2048) + 2 * fr);
#pragma unroll
    for (int j = 0; j < 4; ++j) {
      float x = v0[j], y = v1[j];
      *(unsigned*)(dstp + (size_t)(row0 + j) * 2048) = pack2(gelu_exact(x), gelu_exact(y));
    }
  } else if constexpr (EPI == E_MLAQ) {
    const float qs = 0.10206207261596577f * LOG2E;
    const bool is_rope = (gb % 96) == 64;
#pragma unroll
    for (int j = 0; j < 4; ++j) {
      const int row = row0 + j;
      float o0 = v0[j], o1 = v1[j];
      if (is_rope) {
        float2 cs = *(const float2*)(ea.rope + ((size_t)tokpos(row) * 16 + fr) * 2);
        o0 = v0[j] * cs.x - v1[j] * cs.y; o1 = v0[j] * cs.y + v1[j] * cs.x;
      }
      bf16_t* o = ea.b0 + (size_t)row * 1536 + gb + fr;
      o[0] = tobf(o0 * qs); o[16] = tobf(o1 * qs);
    }
  } else if constexpr (EPI == E_MLAKV) {
    const int head = gb >> 7, c0 = gb & 127;
    if (c0 < 64) {
#pragma unroll
      for (int j = 0; j < 4; ++j) *(unsigned*)(ea.b0 + (size_t)(row0 + j) * 1024 + head * 64 + c0 + 2 * fr) = pack2(v0[j], v1[j]);
    } else {
      const int d = c0 - 64 + 2 * fr;
      size_t off, dstr;
      if (row0 < TP) { int b = row0 >> 13, s = row0 & 8191; off = ((size_t)((b * 16 + head) * 64 + d)) * 8192 + s; dstr = 8192; }
      else { int u = row0 - TP; int b = u / SPAD, s = u - b * SPAD; off = (size_t)TP * 1024 + ((size_t)((b * 16 + head) * 64 + d)) * SPAD + s; dstr = SPAD; }
      uint2 pk; pk.x = pack2(v0[0], v0[1]); pk.y = pack2(v0[2], v0[3]); *(uint2*)(ea.b1 + off) = pk;
      pk.x = pack2(v1[0], v1[1]); pk.y = pack2(v1[2], v1[3]); *(uint2*)(ea.b1 + off + dstr) = pk;
    }
  } else if constexpr (EPI == E_DSA) {
    if (gb < 1024) {
      const float qs = 0.125f * LOG2E;
#pragma unroll
      for (int j = 0; j < 4; ++j) *(unsigned*)(ea.b0 + (size_t)(row0 + j) * 1024 + gb + 2 * fr) = pack2(v0[j] * qs, v1[j] * qs);
    } else if (gb < 2048) {
      const int c = gb - 1024 + 2 * fr;
#pragma unroll
      for (int j = 0; j < 4; ++j) {
        const int row = row0 + j;
        float* o = (row < TP) ? ea.f0 + (size_t)row * 1024 + c : ea.f1 + (size_t)(row - TP) * 1024 + c;
        *(float2*)o = make_float2(v0[j], v1[j]);
        *(unsigned*)(ea.b1 + (size_t)rowmap(row) * 1024 + c) = pack2(v0[j], v1[j]);
      }
    } else if (gb < 3072) {
      const int c = gb - 2048 + 2 * fr, head = c >> 6, d = c & 63;
#pragma unroll
      for (int j = 0; j < 4; ++j) {
        const int row = row0 + j;
        float* o = (row < TP) ? ea.f2 + (size_t)row * 1024 + c : ea.f3 + (size_t)(row - TP) * 1024 + c;
        *(float2*)o = make_float2(v0[j], v1[j]);
      }
      size_t off, dstr;
      if (row0 < TP) { int b = row0 >> 13, s = row0 & 8191; off = ((size_t)((b * 16 + head) * 64 + d)) * 8192 + s; dstr = 8192; }
      else { int u = row0 - TP; int b = u >> 4, s = 1024 + (u & 15); off = (size_t)TP * 1024 + ((size_t)((b * 16 + head) * 64 + d)) * SPAD + s; dstr = SPAD; }
      uint2 pk; pk.x = pack2(v0[0], v0[1]); pk.y = pack2(v0[2], v0[3]); *(uint2*)(ea.b2 + off) = pk;
      pk.x = pack2(v1[0], v1[1]); pk.y = pack2(v1[2], v1[3]); *(uint2*)(ea.b2 + off + dstr) = pk;
    } else if (gb < 3584) {
      const int c = gb - 3072 + 2 * fr;
#pragma unroll
      for (int j = 0; j < 4; ++j) *(unsigned*)(ea.b3 + (size_t)(row0 + j) * 512 + c) = pack2(v0[j] * 0.125f, v1[j] * 0.125f);
    } else if (gb < 3648) {
      const int c = gb - 3584 + 2 * fr;
#pragma unroll
      for (int j = 0; j < 4; ++j) *(float2*)(ea.f4 + (size_t)(row0 + j) * 64 + c) = make_float2(v0[j], v1[j]);
    } else if (gb == 3648) {
      if (fr < 4) {
#pragma unroll
        for (int j = 0; j < 4; ++j) *(float2*)(ea.f5 + (size_t)(row0 + j) * 8 + 2 * fr) = make_float2(v0[j] * 0.35355339059327379f, v1[j] * 0.35355339059327379f);
      }
    }
  }
}

template <int EPI, bool ATOM>
DI void gemm256_tile(const bf16_t* __restrict__ A, const bf16_t* __restrict__ Bt, const int K, const int kt0, const int nt, const int brow, const int bcol,
                     const EArgs& ea, unsigned char* smem, int wv) {
  bf16_t* shm = (bf16_t*)smem;
  const int tid = ltid(wv);
#define SA(b, h) (shm + ((b) * 2 + (h)) * G_HT)
#define SB(b, h) (shm + (4 + (b) * 2 + (h)) * G_HT)
#define STAGE(P, BASE, br, kt) do { const char* _gb = (const char*)((BASE) + (long)(br) * K + (long)((kt) + kt0) * 64); \
    __builtin_amdgcn_global_load_lds((const unsigned*)(_gb + voff0), (LAS unsigned*)((char*)(P) + tid * 16), 16, 0, 0); \
    __builtin_amdgcn_global_load_lds((const unsigned*)(_gb + voff1), (LAS unsigned*)((char*)(P) + tid * 16 + 8192), 16, 0, 0); } while (0)
#define LDA(dst, b, h) _Pragma("unroll") for (int m = 0; m < 4; ++m) _Pragma("unroll") for (int k = 0; k < 2; ++k) \
    dst[m][k] = *reinterpret_cast<const bf16x8*>((char*)SA(b, h) + lds_byte(wr * 64 + m * 16 + fr, k * 32 + fq * 8))
#define LDB(dst, b, h) _Pragma("unroll") for (int n = 0; n < 2; ++n) _Pragma("unroll") for (int k = 0; k < 2; ++k) \
    dst[n][k] = *reinterpret_cast<const bf16x8*>((char*)SB(b, h) + lds_byte(wc * 32 + n * 16 + fr, k * 32 + fq * 8))
#define MMA(ai, bj, At_, Bt_) do { __builtin_amdgcn_s_setprio(1); \
    _Pragma("unroll") for (int m = 0; m < 4; ++m) _Pragma("unroll") for (int n = 0; n < 2; ++n) _Pragma("unroll") for (int k = 0; k < 2; ++k) \
      acc[ai][bj][m][n] = __builtin_amdgcn_mfma_f32_16x16x32_bf16(At_[m][k], Bt_[n][k], acc[ai][bj][m][n], 0, 0, 0); \
    __builtin_amdgcn_s_setprio(0); } while (0)
#define WAIT_V(n) asm volatile("s_waitcnt vmcnt(" #n ")" ::: "memory")
#define WAIT_L(n) asm volatile("s_waitcnt lgkmcnt(" #n ")" ::: "memory")
#define BAR __builtin_amdgcn_s_barrier()
#define SCHED __builtin_amdgcn_sched_barrier(0)
  const int wid = tid >> 6, lane = tid & 63, wr = wid >> 2, wc = wid & 3, fr = lane & 15, fq = lane >> 4;
  unsigned voff0, voff1;
  { int r_, c_; stage_rc(tid * 16, r_, c_); voff0 = (unsigned)(r_ * K + c_) * 2u; stage_rc(tid * 16 + 8192, r_, c_); voff1 = (unsigned)(r_ * K + c_) * 2u; }
  f32x4v acc[2][2][4][2];
#pragma unroll
  for (int a = 0; a < 2; ++a)
#pragma unroll
    for (int b = 0; b < 2; ++b)
#pragma unroll
      for (int m = 0; m < 4; ++m)
#pragma unroll
        for (int n = 0; n < 2; ++n) acc[a][b][m][n] = (f32x4v){0.f, 0.f, 0.f, 0.f};
  bf16x8 At[4][2], B0[2][2], B1[2][2];
  const int HALF = 128;
  WAIT_V(0); WAIT_L(0); BAR;
  STAGE(SB(0, 0), Bt, bcol, 0); STAGE(SA(0, 0), A, brow, 0);
  STAGE(SB(0, 1), Bt, bcol + HALF, 0); STAGE(SA(0, 1), A, brow + HALF, 0);
  if (wr == 1) BAR;
  WAIT_V(4); BAR;
  STAGE(SB(1, 0), Bt, bcol, 1); STAGE(SA(1, 0), A, brow, 1); STAGE(SB(1, 1), Bt, bcol + HALF, 1);
  WAIT_V(6); BAR;
  for (int t = 0; t < nt - 2; t += 2) {
    LDB(B0, 0, 0); SCHED; LDA(At, 0, 0); STAGE(SA(1, 1), A, brow + HALF, t + 1);
    WAIT_L(8); BAR; WAIT_L(0); MMA(0, 0, At, B0); BAR; SCHED;
    LDB(B1, 0, 1); STAGE(SB(0, 0), Bt, bcol, t + 2);
    BAR; WAIT_L(0); MMA(0, 1, At, B1); BAR;
    LDA(At, 0, 1); STAGE(SA(0, 0), A, brow, t + 2);
    BAR; WAIT_L(0); MMA(1, 0, At, B0); BAR; SCHED;
    STAGE(SB(0, 1), Bt, bcol + HALF, t + 2);
    WAIT_V(6); BAR; MMA(1, 1, At, B1); BAR;
    LDB(B0, 1, 0); SCHED; LDA(At, 1, 0); STAGE(SA(0, 1), A, brow + HALF, t + 2);
    WAIT_L(8); BAR; WAIT_L(0); MMA(0, 0, At, B0); BAR; SCHED;
    LDB(B1, 1, 1); STAGE(SB(1, 0), Bt, bcol, t + 3);
    BAR; WAIT_L(0); MMA(0, 1, At, B1); BAR;
    LDA(At, 1, 1); STAGE(SA(1, 0), A, brow, t + 3);
    BAR; WAIT_L(0); MMA(1, 0, At, B0); BAR; SCHED;
    STAGE(SB(1, 1), Bt, bcol + HALF, t + 3);
    WAIT_V(6); BAR; MMA(1, 1, At, B1); BAR;
  }
  { LDB(B0, 0, 0); LDA(At, 0, 0); STAGE(SA(1, 1), A, brow + HALF, nt - 1);
    BAR; WAIT_L(0); MMA(0, 0, At, B0); BAR;
    LDB(B1, 0, 1); BAR; WAIT_L(0); MMA(0, 1, At, B1); BAR;
    LDA(At, 0, 1); WAIT_V(4); BAR; WAIT_L(0); MMA(1, 0, At, B0); MMA(1, 1, At, B1); BAR; }
  { LDB(B0, 1, 0); LDA(At, 1, 0); WAIT_V(2); BAR; WAIT_L(0); MMA(0, 0, At, B0); BAR;
    LDB(B1, 1, 1); WAIT_V(0); BAR; WAIT_L(0); MMA(0, 1, At, B1); BAR;
    LDA(At, 1, 1); BAR; WAIT_L(0); MMA(1, 0, At, B0); MMA(1, 1, At, B1); BAR; }
  if (wr == 0) BAR;
#pragma unroll
  for (int ai = 0; ai < 2; ++ai)
#pragma unroll
    for (int bj = 0; bj < 2; ++bj)
#pragma unroll
      for (int m = 0; m < 4; ++m)
      { epi16<EPI, ATOM>(ea, brow + ai * 128 + wr * 64 + m * 16 + fq * 4, bcol + bj * 128 + wc * 32, fr, acc[ai][bj][m][0], acc[ai][bj][m][1]); if constexpr (EPI != E_RESID) __builtin_amdgcn_sched_barrier(0); }
#undef SA
#undef SB
#undef STAGE
#undef LDA
#undef LDB
#undef MMA
#undef WAIT_V
#undef WAIT_L
#undef BAR
#undef SCHED
}

DI void tile_map(int t, int nM, int nN, int nwg, int& pm, int& pn) {
  int wgid = t;
  { int q = nwg >> 3, r = nwg & 7, xcd = wgid & 7, off = wgid >> 3; wgid = (xcd < r ? xcd * (q + 1) : r * (q + 1) + (xcd - r) * q) + off; }
  const int nig = 8 * nN, gid = wgid / nig, fm = gid * 8, gsz = min(nM - fm, 8);
  pm = fm + ((wgid % nig) % gsz); pn = (wgid % nig) / gsz;
}
template <int EPI>
DI void gemm_phase(const bf16_t* A, const bf16_t* Bt, int M, int N, int K, const EArgs& ea,
                   unsigned char* smem, int tstart, int bid, int nblk, int wv) {
  const int nM = M >> 8, nN = N >> 8, nwg = nM * nN, nt = K >> 6;
  if constexpr (EPI == E_RESID) {
    const int nfull = (nwg / nblk) * nblk, rem = nwg - nfull;
    for (int t = bid; t < nfull; t += nblk) {
      int pm, pn; tile_map(t, nM, nN, nwg, pm, pn);
      gemm256_tile<EPI, false>(A, Bt, K, 0, nt, pm * 256, pn * 256, ea, smem, wv);
    }
    if (rem > 0) {
      int ns = nblk / rem; if (ns > (nt >> 3)) ns = nt >> 3; if (ns < 1) ns = 1;
      const int per = ((nt / ns) >> 1) << 1;
      for (int u = bid; u < rem * ns; u += nblk) {
        const int t = nfull + u / ns, ks = u % ns;
        const int k0 = ks * per, kn = (ks == ns - 1) ? (nt - k0) : per;
        int pm, pn; tile_map(t, nM, nN, nwg, pm, pn);
        gemm256_tile<EPI, true>(A, Bt, K, k0, kn, pm * 256, pn * 256, ea, smem, wv);
      }
    }
  } else {
    int t0 = bid - (tstart % nblk); if (t0 < 0) t0 += nblk;
    for (int t = t0; t < nwg; t += nblk) {
      int pm, pn; tile_map(t, nM, nN, nwg, pm, pn);
      gemm256_tile<EPI, false>(A, Bt, K, 0, nt, pm * 256, pn * 256, ea, smem, wv);
    }
  }
}

DI void rmsnorm_rows(const float* __restrict__ X, const float* __restrict__ g, bf16_t* __restrict__ H, float* outp, float* outs,
                     int bid, int nblk, int wv) {
  const int lane = ltid(wv) & 63, w = ltid(wv) >> 6;
  for (int row = bid * 8 + w; row < T; row += nblk * 8) {
    const float* xr = X + (size_t)row * 1024;
    float4 v[4];
    float ss = 0.f;
#pragma unroll
    for (int c = 0; c < 4; ++c) { v[c] = *(const float4*)(xr + c * 256 + lane * 4); ss += v[c].x * v[c].x + v[c].y * v[c].y + v[c].z * v[c].z + v[c].w * v[c].w; }
    ss = wave_sum(ss, lane);
    float r = rsqrtf(ss * (1.f / 1024.f) + EPS);
#pragma unroll
    for (int c = 0; c < 4; ++c) {
      int col = c * 256 + lane * 4;
      float4 gg = *(const float4*)(g + col);
      float a = v[c].x * r * gg.x, b = v[c].y * r * gg.y, cc = v[c].z * r * gg.z, d = v[c].w * r * gg.w;
      if (H) { uint2 pk; pk.x = pack2(a, b); pk.y = pack2(cc, d); *(uint2*)(H + (size_t)row * 1024 + col) = pk; }
      else {
        float* o = (row < TP) ? outp + (size_t)row * 1024 + col : outs + (size_t)(row - TP) * 1024 + col;
        *(float4*)o = make_float4(a, b, cc, d);
      }
    }
  }
}

DI void mla_rowops(PREF p, int j, int bid, int nblk, int wv) {
  const int lane = ltid(wv) & 63, w = ltid(wv) >> 6;
  unsigned char* R = p.ws + OFF_R;
  const float* RAW = (const float*)(R + R_RAW);
  bf16_t* CQ = (bf16_t*)(R + R_CQ); bf16_t* CKV = (bf16_t*)(R + R_CKV); bf16_t* KR = (bf16_t*)(R + R_KR);
  const float* gq = p.in[11] + j * 512; const float* gkv = p.in[14] + j * 256;
  const float* rope = (const float*)(p.ws + OFF_ROPE);
  for (int row = bid * 8 + w; row < T; row += nblk * 8) {
    const float* rr = RAW + (size_t)row * 1024;
    float4 a0 = *(const float4*)(rr + lane * 4), a1 = *(const float4*)(rr + 256 + lane * 4);
    float4 c0 = *(const float4*)(rr + 512 + lane * 4);
    float ss = a0.x * a0.x + a0.y * a0.y + a0.z * a0.z + a0.w * a0.w + a1.x * a1.x + a1.y * a1.y + a1.z * a1.z + a1.w * a1.w;
    float s2 = c0.x * c0.x + c0.y * c0.y + c0.z * c0.z + c0.w * c0.w;
    ss = wave_sum(ss, lane); s2 = wave_sum(s2, lane);
    float r1 = rsqrtf(ss * (1.f / 512.f) + EPS), r2 = rsqrtf(s2 * (1.f / 256.f) + EPS);
    {
      float4 g0 = *(const float4*)(gq + lane * 4), g1 = *(const float4*)(gq + 256 + lane * 4);
      uint2 pk; pk.x = pack2(a0.x * r1 * g0.x, a0.y * r1 * g0.y); pk.y = pack2(a0.z * r1 * g0.z, a0.w * r1 * g0.w);
      *(uint2*)(CQ + (size_t)row * 512 + lane * 4) = pk;
      pk.x = pack2(a1.x * r1 * g1.x, a1.y * r1 * g1.y); pk.y = pack2(a1.z * r1 * g1.z, a1.w * r1 * g1.w);
      *(uint2*)(CQ + (size_t)row * 512 + 256 + lane * 4) = pk;
    }
    const int rm = rowmap(row);
    {
      float4 g = *(const float4*)(gkv + lane * 4);
      float4 o = make_float4(c0.x * r2 * g.x, c0.y * r2 * g.y, c0.z * r2 * g.z, c0.w * r2 * g.w);
      float* op = (row < TP) ? p.out + O_CKVP + ((size_t)j * TP + row) * 256 : p.out + O_CKVS + ((size_t)j * TS + (row - TP)) * 256;
      *(float4*)(op + lane * 4) = o;
      uint2 pk; pk.x = pack2(o.x, o.y); pk.y = pack2(o.z, o.w);
      *(uint2*)(CKV + (size_t)rm * 256 + lane * 4) = pk;
    }
    if (lane < 16) {
      float x1 = rr[768 + lane], x2 = rr[784 + lane];
      int pos = tokpos(row);
      float2 cs = *(const float2*)(rope + ((size_t)pos * 16 + lane) * 2);
      float o1 = x1 * cs.x - x2 * cs.y, o2 = x1 * cs.y + x2 * cs.x;
      float* op = (row < TP) ? p.out + O_KRP + ((size_t)j * TP + row) * 32 : p.out + O_KRS + ((size_t)j * TS + (row - TP)) * 32;
      op[lane] = o1; op[16 + lane] = o2;
      KR[(size_t)rm * 32 + lane] = tobf(o1); KR[(size_t)rm * 32 + 16 + lane] = tobf(o2);
    }
  }
}

DI void dsa_rowops(PREF p, int bid, int nblk, int wv) {
  const int lane = ltid(wv) & 63, w = ltid(wv) >> 6;
  unsigned char* R = p.ws + OFF_R;
  const float* KIR = (const float*)(R + D_KIR);
  bf16_t* KI = (bf16_t*)(R + D_KI);
  const float* g = p.in[27];
  for (int row = bid * 8 + w; row < T; row += nblk * 8) {
    float v = KIR[(size_t)row * 64 + lane];
    float ss = wave_sum(v * v, lane);
    float r = rsqrtf(ss * (1.f / 64.f) + EPS);
    float o = v * r * g[lane];
    if (row < TP) p.out[O_DIP + (size_t)row * 64 + lane] = o; else p.out[O_DIS + (size_t)(row - TP) * 64 + lane] = o;
    KI[(size_t)rowmap(row) * 64 + lane] = tobf(o);
  }
}

DI void cmlp_ln_rows(PREF p, int bid, int nblk, int wv) {
  const int lane = ltid(wv) & 63, w = ltid(wv) >> 6;
  unsigned char* R = p.ws + OFF_R;
  const bf16_t* VR = (const bf16_t*)(R + C_VR);
  bf16_t* VLN = (bf16_t*)(R + C_VLN);
  const float* g = p.in[18]; const float* bb = p.in[19];
  for (int row = bid * 8 + w; row < T; row += nblk * 8) {
    float x[32];
    float sum = 0.f;
#pragma unroll
    for (int c = 0; c < 4; ++c) {
      uint4 u = *(const uint4*)(VR + (size_t)row * 2048 + c * 512 + lane * 8);
      x[c * 8 + 0] = bflo(u.x); x[c * 8 + 1] = bfhi(u.x); x[c * 8 + 2] = bflo(u.y); x[c * 8 + 3] = bfhi(u.y);
      x[c * 8 + 4] = bflo(u.z); x[c * 8 + 5] = bfhi(u.z); x[c * 8 + 6] = bflo(u.w); x[c * 8 + 7] = bfhi(u.w);
    }
#pragma unroll
    for (int i = 0; i < 32; ++i) sum += x[i];
    sum = wave_sum(sum, lane);
    float mu = sum * (1.f / 2048.f);
    float vs = 0.f;
#pragma unroll
    for (int i = 0; i < 32; ++i) { x[i] -= mu; vs += x[i] * x[i]; }
    vs = wave_sum(vs, lane);
    float r = rsqrtf(vs * (1.f / 2048.f) + EPS);
#pragma unroll
    for (int c = 0; c < 4; ++c) {
      int col = c * 512 + lane * 8;
      float y[8];
#pragma unroll
      for (int q = 0; q < 2; ++q) {
        float4 gg = *(const float4*)(g + col + q * 4), b4 = *(const float4*)(bb + col + q * 4);
        y[q * 4 + 0] = x[c * 8 + q * 4 + 0] * r * gg.x + b4.x; y[q * 4 + 1] = x[c * 8 + q * 4 + 1] * r * gg.y + b4.y;
        y[q * 4 + 2] = x[c * 8 + q * 4 + 2] * r * gg.z + b4.z; y[q * 4 + 3] = x[c * 8 + q * 4 + 3] * r * gg.w + b4.w;
      }
      uint4 pk; pk.x = pack2(y[0], y[1]); pk.y = pack2(y[2], y[3]); pk.z = pack2(y[4], y[5]); pk.w = pack2(y[6], y[7]);
      *(uint4*)(VLN + (size_t)row * 2048 + col) = pk;
      if (row >= TP) {
        float* o = p.out + O_CVS + (size_t)(row - TP) * 2048 + col;
        *(float4*)o = make_float4(y[0], y[1], y[2], y[3]); *(float4*)(o + 4) = make_float4(y[4], y[5], y[6], y[7]);
      }
    }
  }
}

DI void cmlp_mix_phase(PREF p, unsigned char* smem, int bid, int nblk, int wv) {
  const int tid = ltid(wv), lane = tid & 63, w = tid >> 6, wm = w >> 2, wn = w & 3, lr = lane & 31, lh = lane >> 5;
  unsigned char* R = p.ws + OFF_R;
  const bf16_t* U = (const bf16_t*)(R + C_U);
  const bf16_t* VLN = (const bf16_t*)(R + C_VLN);
  bf16_t* G = (bf16_t*)(R + C_G);
  const bf16_t* WT = (const bf16_t*)(p.ws + OFF_W) + W_TRIL;
  const float* bs = p.in[21];
  bf16_t* As = (bf16_t*)smem;
  bf16_t* Bs = As + 128 * 136;
  for (int u = bid; u < 1024; u += nblk) {
    const int g = u & 7, ch = u >> 3;
    const int col0 = g * 256;
#pragma unroll 2
    for (int i = 0; i < 4; ++i) {
      int v = tid + i * NT; int r = v >> 4, c = (v & 15) * 8;
      *(uint4*)(As + r * 136 + c) = *(const uint4*)(WT + ((size_t)g * 128 + r) * 128 + c);
    }
#pragma unroll 2
    for (int i = 0; i < 8; ++i) {
      int v = tid + i * NT; int s = v >> 5, c = (v & 31) * 8;
      uint4 x = *(const uint4*)(VLN + ((size_t)ch * 128 + s) * 2048 + col0 + c);
      Bs[(c + 0) * 136 + s] = (bf16_t)(x.x & 0xffff); Bs[(c + 1) * 136 + s] = (bf16_t)(x.x >> 16);
      Bs[(c + 2) * 136 + s] = (bf16_t)(x.y & 0xffff); Bs[(c + 3) * 136 + s] = (bf16_t)(x.y >> 16);
      Bs[(c + 4) * 136 + s] = (bf16_t)(x.z & 0xffff); Bs[(c + 5) * 136 + s] = (bf16_t)(x.z >> 16);
      Bs[(c + 6) * 136 + s] = (bf16_t)(x.w & 0xffff); Bs[(c + 7) * 136 + s] = (bf16_t)(x.w >> 16);
    }
    __syncthreads();
    f32x16 acc[2][2];
#pragma unroll
    for (int a = 0; a < 2; ++a)
#pragma unroll
      for (int b = 0; b < 2; ++b)
#pragma unroll
        for (int i = 0; i < 16; ++i) acc[a][b][i] = 0.f;
    const bf16_t* Asb = As + (wm * 64 + lr) * 136 + lh * 8;
    const bf16_t* Bsb = Bs + (wn * 64 + lr) * 136 + lh * 8;
    const int ns = (wm + 1) * 4;
    for (int s = 0; s < ns; ++s) {
      bf16x8 a0 = *(const bf16x8*)(Asb + s * 16);
      bf16x8 a1 = *(const bf16x8*)(Asb + 32 * 136 + s * 16);
      bf16x8 b0 = *(const bf16x8*)(Bsb + s * 16);
      bf16x8 b1 = *(const bf16x8*)(Bsb + 32 * 136 + s * 16);
      acc[0][0] = MFMA32(a0, b0, acc[0][0]);
      acc[0][1] = MFMA32(a0, b1, acc[0][1]);
      acc[1][0] = MFMA32(a1, b0, acc[1][0]);
      acc[1][1] = MFMA32(a1, b1, acc[1][1]);
    }
#pragma unroll
    for (int mi = 0; mi < 2; ++mi)
#pragma unroll
      for (int ni = 0; ni < 2; ++ni)
#pragma unroll
        for (int i = 0; i < 16; ++i) {
          int t = wm * 64 + mi * 32 + crow(i, lh);
          int col = col0 + wn * 64 + ni * 32 + lr;
          size_t off = ((size_t)ch * 128 + t) * 2048 + col;
          float mixed = acc[mi][ni][i] + bs[g * 128 + t];
          G[off] = tobf(frombf(U[off]) * mixed);
        }
    __syncthreads();
  }
  const float* wsf = p.in[20];
  for (int e = bid * NT + tid; e < TS * 2048; e += nblk * NT) {
    int row = e >> 11, col = e & 2047, b = row >> 4, t = row & 15, g = col >> 8;
    float a = bs[g * 128 + t];
    for (int s = 0; s <= t; ++s) a += wsf[((size_t)g * 128 + t) * 128 + s] * frombf(VLN[((size_t)TP + b * 16 + s) * 2048 + col]);
    size_t off = ((size_t)TP + row) * 2048 + col;
    G[off] = tobf(frombf(U[off]) * a);
  }
}

template <int DQK, bool IS_MLA, bool MASKED>
DI void attn8_unit(const bf16_t* __restrict__ Qp, int ldq, int nq,
                   const bf16_t* __restrict__ Kp, int ldk, const bf16_t* __restrict__ KRp,
                   const bf16_t* __restrict__ Vtp, int ldv, int kmax,
                   int nit, int nk64_w, int nkeys, const unsigned* __restrict__ BMp,
                   bf16_t* __restrict__ AOp, unsigned char* smem, int wv) {
  constexpr int KS = DQK + 8;
  constexpr int VS = 136;
  constexpr int NQS = DQK / 16;
  const int tid = ltid(wv), lane = tid & 63, w = tid >> 6, lr = lane & 31, lh = lane >> 5;
  bf16_t* Ks = (bf16_t*)smem;
  bf16_t* Vs = Ks + 2 * 128 * KS;
  const bool q_ok = (w * 32 + lr) < nq;
  const int qrow = q_ok ? (w * 32 + lr) : 0;
  bf16x8 qf[NQS];
#pragma unroll
  for (int s = 0; s < NQS; ++s) qf[s] = *(const bf16x8*)(Qp + (size_t)qrow * ldq + s * 16 + lh * 8);
  f32x16 oacc[2];
#pragma unroll
  for (int d = 0; d < 2; ++d)
#pragma unroll
    for (int i = 0; i < 16; ++i) oacc[d][i] = 0.f;
  float m_run = -INFINITY, l_run = 0.f;
  const int kkey = tid >> 3, kc = (tid & 7) * 8;
  const int rkey = tid >> 2, rc = (tid & 3) * 8;
  const int vd = tid >> 4, vk = (tid & 15) * 8;
  const int vpos = (vk & 96) + ((vk >> 4) & 1) * 16 + ((vk >> 3) & 1) * 4;
  uint4 rk0, rk1, rr, rv0, rv1;
  rr = make_uint4(0, 0, 0, 0);
  uint4 bm_next = make_uint4(0xffffffffu, 0xffffffffu, 0xffffffffu, 0xffffffffu), bm_cur = bm_next;
#define GLOAD(it_) do { const int key0_ = (it_) * 128; \
    { int kr_ = min(key0_ + kkey, kmax - 1); rk0 = *(const uint4*)(Kp + (size_t)kr_ * ldk + kc); } \
    { int kr_ = min(key0_ + kkey + 64, kmax - 1); rk1 = *(const uint4*)(Kp + (size_t)kr_ * ldk + kc); } \
    if constexpr (IS_MLA) { int kr_ = min(key0_ + rkey, kmax - 1); rr = *(const uint4*)(KRp + (size_t)kr_ * 32 + rc); } \
    { int kv_ = min(key0_ + vk, kmax - 8); rv0 = *(const uint4*)(Vtp + (size_t)vd * ldv + kv_); rv1 = *(const uint4*)(Vtp + (size_t)(vd + 32) * ldv + kv_); } \
    if constexpr (MASKED) { if (BMp) bm_next = *(const uint4*)(BMp + (size_t)qrow * 256 + (it_) * 4); } } while (0)
#define SSTORE(buf_) do { bf16_t* Kb_ = Ks + (buf_) * 128 * KS; bf16_t* Vb_ = Vs + (buf_) * 64 * VS; \
    *(uint4*)(Kb_ + kkey * KS + kc) = rk0; *(uint4*)(Kb_ + (kkey + 64) * KS + kc) = rk1; \
    if constexpr (IS_MLA) *(uint4*)(Kb_ + rkey * KS + 64 + rc) = rr; \
    *(uint2*)(Vb_ + vd * VS + vpos) = make_uint2(rv0.x, rv0.y); *(uint2*)(Vb_ + vd * VS + vpos + 8) = make_uint2(rv0.z, rv0.w); \
    *(uint2*)(Vb_ + (vd + 32) * VS + vpos) = make_uint2(rv1.x, rv1.y); *(uint2*)(Vb_ + (vd + 32) * VS + vpos + 8) = make_uint2(rv1.z, rv1.w); } while (0)
  const int nit_w = (nk64_w + 1) >> 1;
  __syncthreads();
  GLOAD(0); SSTORE(0); bm_cur = bm_next;
  __syncthreads();
  for (int it = 0; it < nit; ++it) {
    const int buf = it & 1;
    if (it + 1 < nit) GLOAD(it + 1);
    if (it < nit_w) {
      const bf16_t* Kb = Ks + buf * 128 * KS; const bf16_t* Vb = Vs + buf * 64 * VS;
      f32x16 sacc[4];
#pragma unroll
      for (int t4 = 0; t4 < 4; ++t4) {
#pragma unroll
        for (int i = 0; i < 16; ++i) sacc[t4][i] = 0.f;
#pragma unroll
        for (int s = 0; s < NQS; ++s) {
          bf16x8 kf = *(const bf16x8*)(Kb + (t4 * 32 + lr) * KS + s * 16 + lh * 8);
          sacc[t4] = MFMA32(kf, qf[s], sacc[t4]);
        }
      }
      if ((2 * it + 1) >= nk64_w) {
#pragma unroll
        for (int t4 = 2; t4 < 4; ++t4)
#pragma unroll
          for (int i = 0; i < 16; ++i) sacc[t4][i] = -INFINITY;
      }
      float mx = -INFINITY;
#pragma unroll
      for (int t4 = 0; t4 < 4; ++t4) {
        const int remk = nkeys - (it * 128 + t4 * 32);
        const unsigned vmask = remk >= 32 ? 0xffffffffu : (remk <= 0 ? 0u : ((1u << remk) - 1u));
        const unsigned wbits = (((t4 == 0) ? bm_cur.x : (t4 == 1) ? bm_cur.y : (t4 == 2) ? bm_cur.z : bm_cur.w) & vmask) >> (4 * lh);
#pragma unroll
        for (int i = 0; i < 16; ++i) {
          if constexpr (MASKED) {
            const int sel = ((int)(wbits << (31 - ((i & 3) + 8 * (i >> 2))))) >> 31;
            const unsigned sb = __float_as_uint(sacc[t4][i]);
            sacc[t4][i] = __uint_as_float((sb & (unsigned)sel) | (~(unsigned)sel & 0xff800000u));
          }
          mx = fmaxf(mx, sacc[t4][i]);
        }
      }
      mx = fmaxf(mx, shflx(mx, 32, lane));
      const float m_new = fmaxf(m_run, mx);
      const float m_safe = (m_new == -INFINITY) ? 0.f : m_new;
      const float alpha = __builtin_amdgcn_exp2f(m_run - m_safe);
      m_run = m_new;
      float ls = 0.f;
#pragma unroll
      for (int t4 = 0; t4 < 4; ++t4)
#pragma unroll
        for (int i = 0; i < 16; ++i) { float pv = __builtin_amdgcn_exp2f(sacc[t4][i] - m_safe); sacc[t4][i] = pv; ls += pv; }
      l_run = l_run * alpha + ls;
#pragma unroll
      for (int d = 0; d < 2; ++d)
#pragma unroll
        for (int i = 0; i < 16; ++i) oacc[d][i] *= alpha;
#pragma unroll
      for (int t4 = 0; t4 < 4; ++t4)
#pragma unroll
        for (int s = 0; s < 2; ++s) {
          uint4 pp;
          pp.x = pack2(sacc[t4][8 * s + 0], sacc[t4][8 * s + 1]);
          pp.y = pack2(sacc[t4][8 * s + 2], sacc[t4][8 * s + 3]);
          pp.z = pack2(sacc[t4][8 * s + 4], sacc[t4][8 * s + 5]);
          pp.w = pack2(sacc[t4][8 * s + 6], sacc[t4][8 * s + 7]);
          bf16x8 pf = __builtin_bit_cast(bf16x8, pp);
#pragma unroll
          for (int dt = 0; dt < 2; ++dt) {
            bf16x8 vf = *(const bf16x8*)(Vb + (dt * 32 + lr) * VS + t4 * 32 + 16 * s + 8 * lh);
            oacc[dt] = MFMA32(vf, pf, oacc[dt]);
          }
        }
    }
    if (it + 1 < nit) { SSTORE(buf ^ 1); bm_cur = bm_next; }
    __syncthreads();
  }
  if (nit_w > 0) {
    float lt = l_run + shflx(l_run, 32, lane);
    float inv = lt > 0.f ? 1.f / lt : 0.f;
    if (q_ok) {
      bf16_t* orow = AOp + (size_t)(w * 32 + lr) * 1024;
#pragma unroll
      for (int dt = 0; dt < 2; ++dt)
#pragma unroll
        for (int g = 0; g < 4; ++g) {
          uint2 pk;
          pk.x = pack2(oacc[dt][4 * g] * inv, oacc[dt][4 * g + 1] * inv);
          pk.y = pack2(oacc[dt][4 * g + 2] * inv, oacc[dt][4 * g + 3] * inv);
          *(uint2*)(orow + dt * 32 + 8 * g + 4 * lh) = pk;
        }
    }
  }
}
#undef GLOAD
#undef SSTORE

DI int snake_idx(int i, int bid, int nblk) { return i * nblk + ((i & 1) ? (nblk - 1 - bid) : bid); }

template <bool IS_MLA>
DI void attn_phase(PREF p, unsigned char* smem, int bid, int nblk, int wv) {
  unsigned char* R = p.ws + OFF_R;
  const int w = ltid(wv) >> 6;
  const int total = 1024 + 512;
  for (int i = 0; i * nblk < total; ++i) {
    int u = snake_idx(i, bid, nblk);
    if (u >= total) continue;
    if constexpr (IS_MLA) {
      const bf16_t* Q = (const bf16_t*)(R + R_Q); const bf16_t* KN = (const bf16_t*)(R + R_KN);
      const bf16_t* KR = (const bf16_t*)(R + R_KR); const bf16_t* VT = (const bf16_t*)(R + R_VT);
      bf16_t* AO = (bf16_t*)(R + R_RAW);
      if (u < 1024) {
        int qt = 31 - (u >> 5), bh = u & 31, b = bh >> 4, h = bh & 15;
        int q0 = b * 8192 + qt * 256;
        attn8_unit<96, true, false>(Q + (size_t)q0 * 1536 + h * 96, 1536, 256,
                                    KN + (size_t)(b * 8192) * 1024 + h * 64, 1024, KR + (size_t)(b * 8192) * 32,
                                    VT + (size_t)((b * 16 + h) * 64) * 8192, 8192, 8192,
                                    2 * qt + 2, 4 * qt + 1 + (w >> 1), 1 << 30, nullptr,
                                    AO + (size_t)q0 * 1024 + h * 64, smem, wv);
      } else {
        int v = u - 1024, b = v >> 4, h = v & 15;
        int q0 = TP + b * 16;
        attn8_unit<96, true, true>(Q + (size_t)q0 * 1536 + h * 96, 1536, 16,
                                   KN + (size_t)(TP + b * SPAD) * 1024 + h * 64, 1024, KR + (size_t)(TP + b * SPAD) * 32,
                                   VT + (size_t)TP * 1024 + (size_t)((b * 16 + h) * 64) * SPAD, SPAD, SPAD,
                                   9, (w == 0) ? 17 : 0, NKS, nullptr,
                                   AO + (size_t)q0 * 1024 + h * 64, smem, wv);
      }
    } else {
      const bf16_t* Q = (const bf16_t*)(R + D_Q); const bf16_t* KK = (const bf16_t*)(R + D_K);
      const bf16_t* VT = (const bf16_t*)(R + D_VT); const unsigned* BM = (const unsigned*)(R + D_BM);
      bf16_t* AO = (bf16_t*)(R + D_AO);
      if (u < 1024) {
        int qt = 31 - (u >> 5), bh = u & 31, b = bh >> 4, h = bh & 15;
        int q0 = b * 8192 + qt * 256;
        attn8_unit<64, false, true>(Q + (size_t)q0 * 1024 + h * 64, 1024, 256,
                                    KK + (size_t)(b * 8192) * 1024 + h * 64, 1024, nullptr,
                                    VT + (size_t)((b * 16 + h) * 64) * 8192, 8192, 8192,
                                    2 * qt + 2, 4 * qt + 1 + (w >> 1), 1 << 30, BM + (size_t)q0 * 256,
                                    AO + (size_t)q0 * 1024 + h * 64, smem, wv);
      } else {
        int v = u - 1024, b = v >> 4, h = v & 15;
        int q0 = TP + b * 16;
        attn8_unit<64, false, true>(Q + (size_t)q0 * 1024 + h * 64, 1024, 16,
                                    KK + (size_t)(TP + b * SPAD) * 1024 + h * 64, 1024, nullptr,
                                    VT + (size_t)TP * 1024 + (size_t)((b * 16 + h) * 64) * SPAD, SPAD, SPAD,
                                    9, (w == 0) ? 17 : 0, NKS, BM + (size_t)q0 * 256,
                                    AO + (size_t)q0 * 1024 + h * 64, smem, wv);
      }
    }
  }
}

constexpr int CAP = 128;
DI int score_bin(float s) {
  unsigned u = __float_as_uint(s);
  int e = (int)((u & 0x7fffffffu) >> 19);
  int m = min(max(e, 1840), 2095) - 1840;
  return (u >> 31) ? (255 - m) : (256 + m);
}

DI void idx_unit(const bf16_t* __restrict__ QI, const float* __restrict__ WI, int q_row0, int nq,
                 const bf16_t* __restrict__ KI, int L, unsigned* __restrict__ BM, unsigned char* smem, int wv) {
  const int tid = ltid(wv), lane = tid & 63, w = tid >> 6, lr = lane & 31, lh = lane >> 5;
  bf16_t* Qs = (bf16_t*)smem;
  float* Ws = (float*)(smem + 36864);
  unsigned* hist = (unsigned*)(smem + 36864 + 1024);
  float* cand_s = (float*)hist;
  int* cand_i = (int*)(smem + 36864 + 1024 + 16384);
  int* bstar = (int*)(smem + 36864 + 1024 + 32768);
  int* need = bstar + 32;
  int* ncand = need + 32;
  __syncthreads();
#pragma unroll
  for (int i = 0; i < 4; ++i) {
    int v = tid + i * NT;
    int hd = v >> 8, q = (v >> 3) & 31, c = (v & 7) * 8;
    int qq = q < nq ? q : 0;
    *(uint4*)(Qs + (hd * 32 + q) * 72 + c) = *(const uint4*)(QI + (size_t)(q_row0 + qq) * 512 + hd * 64 + c);
  }
  if (tid < 256) { int hd = tid >> 5, q = tid & 31; int qq = q < nq ? q : 0; Ws[hd * 32 + q] = WI[(size_t)(q_row0 + qq) * 8 + hd]; }
  for (int i = tid; i < 32 * 256; i += NT) hist[i] = 0u;
  if (tid < 32) { bstar[tid] = -1; need[tid] = 0; ncand[tid] = 0; }
  __syncthreads();
  const int ntile = (L + 255) >> 8;
  const bool do_select = L > 256;
  int bsr[16];
  { int m1_ = -1; asm volatile("" : "+v"(m1_));
#pragma unroll
    for (int i = 0; i < 16; ++i) bsr[i] = m1_; }
  for (int pass = do_select ? 0 : 1; pass < 2; ++pass) {
    if (pass == 1) {
#pragma unroll
      for (int i = 0; i < 16; ++i) bsr[i] = bstar[crow(i, lh)];
    }
    bf16x8 kn0, kn1, kn2, kn3;
    { const bf16_t* kp = KI + (size_t)(w * 32 + lr) * 64 + lh * 8;
      kn0 = *(const bf16x8*)(kp); kn1 = *(const bf16x8*)(kp + 16); kn2 = *(const bf16x8*)(kp + 32); kn3 = *(const bf16x8*)(kp + 48); }
    for (int kt = 0; kt < ntile; ++kt) {
      const int key0 = kt * 256 + w * 32;
      bf16x8 kf[4];
      kf[0] = kn0; kf[1] = kn1; kf[2] = kn2; kf[3] = kn3;
      if (key0 + 256 < L) {
        const bf16_t* kp = KI + (size_t)(key0 + 256 + lr) * 64 + lh * 8;
        kn0 = *(const bf16x8*)(kp); kn1 = *(const bf16x8*)(kp + 16); kn2 = *(const bf16x8*)(kp + 32); kn3 = *(const bf16x8*)(kp + 48);
      }
      if (key0 < L) {
        const int key = key0 + lr;
        float sc[16];
#pragma unroll
        for (int i = 0; i < 16; ++i) sc[i] = 0.f;
#pragma unroll 1
        for (int hd = 0; hd < 8; ++hd) {
          f32x16 acc;
#pragma unroll
          for (int i = 0; i < 16; ++i) acc[i] = 0.f;
#pragma unroll
          for (int s = 0; s < 4; ++s) {
            bf16x8 qf = *(const bf16x8*)(Qs + (hd * 32 + lr) * 72 + s * 16 + lh * 8);
            acc = MFMA32(qf, kf[s], acc);
          }
#pragma unroll
          for (int g = 0; g < 4; ++g) {
            float4 wv = *(const float4*)(Ws + hd * 32 + 8 * g + 4 * lh);
            sc[4 * g + 0] += wv.x * fmaxf(acc[4 * g + 0], 0.f);
            sc[4 * g + 1] += wv.y * fmaxf(acc[4 * g + 1], 0.f);
            sc[4 * g + 2] += wv.z * fmaxf(acc[4 * g + 2], 0.f);
            sc[4 * g + 3] += wv.w * fmaxf(acc[4 * g + 3], 0.f);
          }
        }
        const bool kvalid = key < L;
        if (pass == 0) {
#pragma unroll
          for (int i = 0; i < 16; ++i) {
            int q = crow(i, lh);
            if (kvalid) { int b = score_bin(sc[i]); atomicAdd(&hist[q * 256 + (b >> 1)], (b & 1) ? 65536u : 1u); }
          }
        } else {
          unsigned myword = 0u, cmask = 0u;
          unsigned long long any = 0ull;
#pragma unroll
          for (int i = 0; i < 16; ++i) {
            const int b = score_bin(sc[i]);
            const int bs = bsr[i];
            const bool sel = kvalid && (b > bs);
            const bool cnd = kvalid && (b == bs);
            const unsigned long long bal = __ballot(sel);
            myword = (lr == i) ? (unsigned)(bal >> (32 * lh)) : myword;
            any |= __ballot(cnd);
            cmask |= cnd ? (1u << i) : 0u;
          }
          if (lr < 16 && crow(lr, lh) < nq) BM[(size_t)(q_row0 + crow(lr, lh)) * 256 + (key0 >> 5)] = myword;
          if (any != 0ull) {
            int base[16];
#pragma unroll
            for (int i = 0; i < 16; ++i) {
              const unsigned long long cbi = __ballot((cmask >> i) & 1u);
              base[i] = 0;
              if (lr == 0) base[i] = atomicAdd(&ncand[crow(i, lh)], __popc((unsigned)(cbi >> (32 * lh))));
            }
#pragma unroll
            for (int i = 0; i < 16; ++i) {
              const unsigned long long cbi = __ballot((cmask >> i) & 1u);
              const int bb = __builtin_amdgcn_ds_bpermute((lane & 32) << 2, base[i]);
              if ((cmask >> i) & 1u) {
                const unsigned hm = (unsigned)(cbi >> (32 * lh));
                const int pos = bb + __popc(hm & ((1u << lr) - 1u));
                const int q = crow(i, lh);
                if (pos < CAP) { cand_s[q * CAP + pos] = sc[i]; cand_i[q * CAP + pos] = key; }
              }
            }
          }
        }
      }
    }
    __syncthreads();
    if (pass == 0) {
      for (int qi = 0; qi < 4; ++qi) {
        const int q = w * 4 + qi;
        unsigned hw[4];
#pragma unroll
        for (int k = 0; k < 4; ++k) hw[k] = hist[q * 256 + 255 - 4 * lane - k];
        int cnt = 0;
#pragma unroll
        for (int k = 0; k < 4; ++k) cnt += (int)(hw[k] >> 16) + (int)(hw[k] & 0xffffu);
        int pre = cnt;
#pragma unroll
        for (int o = 1; o < 64; o <<= 1) { int t = __builtin_amdgcn_ds_bpermute(((lane - o) & 63) << 2, pre); if (lane >= o) pre += t; }
        unsigned long long bal = __ballot(pre >= 256);
        if (bal != 0ull) {
          int fl = __ffsll((long long)bal) - 1;
          if (lane == fl) {
            int running = pre - cnt;
            int bsel = -1, above = 0;
#pragma unroll
            for (int k = 0; k < 4; ++k) {
              int chi = (int)(hw[k] >> 16), clo = (int)(hw[k] & 0xffffu);
              if (bsel < 0) { if (running + chi >= 256) { bsel = 511 - 8 * lane - 2 * k; above = running; } else running += chi; }
              if (bsel < 0) { if (running + clo >= 256) { bsel = 510 - 8 * lane - 2 * k; above = running; } else running += clo; }
            }
            bstar[q] = bsel; need[q] = 256 - above;
          }
        }
      }
      __syncthreads();
    }
  }
  __threadfence();
  __syncthreads();
  if (do_select) {
    for (int pi = tid; pi < 32 * CAP; pi += NT) {
      int q = pi / CAP, c = pi - q * CAP;
      int n = min(ncand[q], CAP);
      if (c < n && q < nq) {
        float sv = cand_s[q * CAP + c]; int iv = cand_i[q * CAP + c];
        int rank = 0;
        for (int j = 0; j < n; ++j) {
          float sj = cand_s[q * CAP + j]; int ij = cand_i[q * CAP + j];
          rank += (sj > sv || (sj == sv && ij < iv)) ? 1 : 0;
        }
        if (rank < need[q]) atomicOr(&BM[(size_t)(q_row0 + q) * 256 + (iv >> 5)], 1u << (iv & 31));
      }
    }
  }
  __syncthreads();
}

DI void idx_phase(PREF p, unsigned char* smem, int bid, int nblk, int wv) {
  unsigned char* R = p.ws + OFF_R;
  const bf16_t* QI = (const bf16_t*)(R + D_QI); const float* WI = (const float*)(R + D_WI);
  const bf16_t* KI = (const bf16_t*)(R + D_KI); unsigned* BM = (unsigned*)(R + D_BM);
  const int total = 512 + 32;
  for (int i = 0; i * nblk < total; ++i) {
    int idx = snake_idx(i, bid, nblk);
    if (idx >= total) continue;
    if (idx < 512) {
      int qt = 255 - (idx >> 1), b = idx & 1;
      int L = (((qt * 32) >> 6) + 1) * 64;
      idx_unit(QI, WI, b * 8192 + qt * 32, 32, KI + (size_t)(b * 8192) * 64, L, BM, smem, wv);
    } else {
      int b = idx - 512;
      idx_unit(QI, WI, TP + b * 16, 16, KI + (size_t)(TP + b * SPAD) * 64, NKS, BM, smem, wv);
    }
  }
}

DI void cvt8(const float* s, bf16_t* d) {
  float4 a = ldnt4(s), b = ldnt4(s + 4);
  uint4 pk; pk.x = pack2(a.x, a.y); pk.y = pack2(a.z, a.w); pk.z = pack2(b.x, b.y); pk.w = pack2(b.z, b.w);
  *(uint4*)d = pk;
}
DI void cache_rows(const float* __restrict__ src, bf16_t* __restrict__ dst, int Wd, int bid, int nblk, int wv) {
  const int vpr = Wd >> 3;
  const size_t total = (size_t)32 * SPAD * vpr;
  for (size_t e = (size_t)bid * NT + ltid(wv); e < total; e += (size_t)nblk * NT) {
    int c = (int)(e % vpr) * 8; size_t rw = e / vpr; int b = (int)(rw / SPAD), s = (int)(rw % SPAD);
    bf16_t* d = dst + ((size_t)TP + (size_t)b * SPAD + s) * Wd + c;
    if (s < 1024) cvt8(src + ((size_t)b * 1024 + s) * Wd + c, d);
    else if (s >= NKS) { unsigned z = 0; asm volatile("" : "+v"(z)); *(uint4*)d = make_uint4(z, z, z, z); }
  }
}


#define XB_TMO      128
#define XB_XCNT(j)  (256  + 64 * (j))
#define XB_XSUB(j)  (1280 + 64 * (j))
#define XB_XGEN(j)  (2304 + 64 * (j))
#define XB_TOP      3328
#define XB_TOPGEN   3392
#define XCD_BAR_WORDS 3456
#define XB_SPIN_CAP (1u << 18)
DI unsigned xb_ld(unsigned* p)              { return __hip_atomic_load(p, __ATOMIC_RELAXED, __HIP_MEMORY_SCOPE_AGENT); }
DI unsigned xb_add(unsigned* p, unsigned v) { return __hip_atomic_fetch_add(p, v, __ATOMIC_RELAXED, __HIP_MEMORY_SCOPE_AGENT); }
DI unsigned xb_xcc_id() { return (unsigned)__builtin_amdgcn_s_getreg((3 << 11) | 20) & 0xFu; }
#define XB_SPIN(cond, bar) do { unsigned _sp = 0; while (cond) { __builtin_amdgcn_s_sleep(1); \
    if ((++_sp & 255u) == 0u) { if (xb_ld(&(bar)[XB_TMO])) break; if (_sp > XB_SPIN_CAP) { atomicAdd(&(bar)[XB_TMO], 1u); break; } } } } while (0)
struct XcdBarrier { unsigned* bar; unsigned x; volatile __attribute__((address_space(3))) unsigned* st; };
DI void xcd_barrier_complete(unsigned* bar, unsigned x, unsigned G, unsigned& nloc, unsigned& nx) {
  unsigned sum, cnt, mine, sp = 0u;
  for (;;) {
    sum = 0u; cnt = 0u; mine = 0u;
#pragma unroll
    for (unsigned j = 0; j < 16; ++j) { const unsigned c = xb_ld(&bar[XB_XCNT(j)]); sum += c; cnt += (c > 0u) ? 1u : 0u; mine = (j == x) ? c : mine; }
    if (sum == G) break;
    __builtin_amdgcn_s_sleep(1);
    if ((++sp & 255u) == 0u) { if (xb_ld(&bar[XB_TMO])) break; if (sp > XB_SPIN_CAP) { atomicAdd(&bar[XB_TMO], 1u); break; } }
  }
  nloc = mine > 0u ? mine : 1u; nx = cnt > 0u ? cnt : 1u;
}
DI void xcd_barrier(const XcdBarrier& b, int tid, unsigned G) {
  asm volatile("s_waitcnt vmcnt(0)" ::: "memory");
  __syncthreads();
  if (tid == 0) {
    unsigned* bar = b.bar;
    __builtin_amdgcn_s_waitcnt(0);
    unsigned nloc = b.st[0], nx = b.st[1];
    if (nloc == 0u) { xcd_barrier_complete(bar, b.x, G, nloc, nx); b.st[0] = nloc; b.st[1] = nx; }
    const unsigned old = xb_add(&bar[XB_XSUB(b.x)], 1u);
    const unsigned gen = old / nloc;
    if (old + 1u == (gen + 1u) * nloc) {
      __builtin_amdgcn_fence(__ATOMIC_RELEASE, "agent");
      asm volatile("s_waitcnt vmcnt(0)" ::: "memory");
      const unsigned og = xb_add(&bar[XB_TOP], 1u);
      const unsigned tg = og / nx;
      if (og + 1u == (tg + 1u) * nx) xb_add(&bar[XB_TOPGEN], 1u);
      else XB_SPIN(xb_ld(&bar[XB_TOPGEN]) == tg, bar);
      __builtin_amdgcn_fence(__ATOMIC_ACQUIRE, "agent");
      xb_add(&bar[XB_XGEN(b.x)], 1u);
      asm volatile("s_waitcnt vmcnt(0)" ::: "memory");
    } else {
      XB_SPIN(xb_ld(&bar[XB_XGEN(b.x)]) == gen, bar);
      __builtin_amdgcn_fence(__ATOMIC_ACQUIRE, "agent");
      asm volatile("s_waitcnt vmcnt(0)" ::: "memory");
    }
  }
  __syncthreads();
}

extern "C" __global__ void __launch_bounds__(512, 2) mega(Params p_unused) {
  extern __shared__ __attribute__((aligned(16))) unsigned char smem[];
  cg::grid_group grid = cg::this_grid();
  const int bid = blockIdx.x, nblk = gridDim.x;
  const int wv = __builtin_amdgcn_readfirstlane((int)(threadIdx.x >> 6));
  CParams* pk = (CParams*)__builtin_amdgcn_kernarg_segment_ptr();
  const int ph_lo = pk->ph_lo, ph_hi = pk->ph_hi;
  int ph = 0;
  if (ph_lo > 0x40000000) grid.sync();
  XcdBarrier xb;
  {
    volatile __attribute__((address_space(3))) unsigned* st = (volatile __attribute__((address_space(3))) unsigned*)(smem + 131072);
    const int t0 = ltid(wv);
    if (t0 == 0) { st[0] = 0u; st[1] = 0u; }
    __syncthreads();
    xb.bar = (unsigned*)(pk->ws + OFF_BAR); xb.x = xb_xcc_id(); xb.st = st;
    if (t0 == 0) (void)xb_add(&xb.bar[XB_XCNT(xb.x)], 1u);
  }
#ifndef REPMASK
#define REPMASK 0u
#endif
#ifndef PMASK
#define PMASK 0xffffffffu
#endif
#define PHASE_BEGIN(k) if (ph >= ph_lo && ph < ph_hi) { if constexpr ((PMASK >> (k)) & 1u) for (int rep_ = 0; rep_ < 1 + (int)((REPMASK >> (k)) & 1u); ++rep_) { \
    CParams* pp_ = pk; asm volatile("" : "+s"(pp_)); PREF p = *pp_; const int tid = ltid(wv); \
    unsigned char* ws = p.ws; float* X = (float*)(ws + OFF_X); bf16_t* H = (bf16_t*)(ws + OFF_H); bf16_t* Wb = (bf16_t*)(ws + OFF_W); \
    float* ROPE = (float*)(ws + OFF_ROPE); unsigned char* R = ws + OFF_R; (void)tid; (void)X; (void)H; (void)Wb; (void)ROPE; (void)R;
#define PHASE_END   } if (ph + 1 < ph_hi) { xcd_barrier(xb, ltid(wv), (unsigned)nblk); } } ++ph;

  PHASE_BEGIN(0)
    {
      const int hf = tid >> 8, tl = tid & 255;
      float* smh = (float*)smem + hf * 4224;
      for (int t0 = bid * 2; t0 < p.total_tiles; t0 += nblk * 2) {
        const int t = t0 + hf;
        const bool active = t < p.total_tiles;
        const int tt = active ? t : 0;
        int ji = 0;
#pragma unroll 1
        for (int q = 1; q < NJOBS; ++q) if (tt >= p.jobs[q].tile0) ji = q;
        const CAS Job& jb = p.jobs[ji];
        int lt = tt - jb.tile0; int nkt = jb.k >> 6; int nt_ = lt / nkt, kt_ = lt - nt_ * nkt;
        transpose_tile(jb.src, jb.nsrc, jb.nsrc, jb.dst, jb.k, nt_ * 64, kt_ * 64, jb.mode, smh, tl, active);
      }
    }
    {
      const size_t n4p = (size_t)TP * 256, n4 = (size_t)T * 256;
      const float4* xp = (const float4*)p.in[0]; const float4* xs = (const float4*)p.in[1];
      for (size_t e = (size_t)bid * NT + tid; e < n4; e += (size_t)nblk * NT) ((float4*)X)[e] = (e < n4p) ? ldnt4((const float*)(xp + e)) : ldnt4((const float*)(xs + (e - n4p)));
      for (int e = bid * NT + tid; e < 8192 * 16; e += nblk * NT) {
        int pos = e >> 4, i = e & 15;
        double rev = (double)pos * p.inv_freq[i] * 0.15915494309189535;
        rev -= floor(rev);
        float fr = (float)rev;
        ROPE[2 * e] = __builtin_amdgcn_cosf(fr); ROPE[2 * e + 1] = __builtin_amdgcn_sinf(fr);
      }
      const float* wsrc = p.in[20];
      for (int e = bid * NT + tid; e < 8 * 128 * 128; e += nblk * NT) {
        int s = e & 127, t = (e >> 7) & 127;
        Wb[W_TRIL + e] = tobf(s <= t ? wsrc[e] : 0.f);
      }
    }
  PHASE_END

#pragma unroll 1
  for (int L = 0; L < 4; ++L) {
    const int kind = L % 3, j = L / 3;
    if (kind == 0) {
      PHASE_BEGIN(1)
        rmsnorm_rows(X, p.in[7] + L * 1024, H, nullptr, nullptr, bid, nblk, wv);
        cache_rows(p.in[2] + (size_t)j * 32 * 1024 * 256, (bf16_t*)(R + R_CKV), 256, bid, nblk, wv);
        cache_rows(p.in[3] + (size_t)j * 32 * 1024 * 32, (bf16_t*)(R + R_KR), 32, bid, nblk, wv);
      PHASE_END
      PHASE_BEGIN(2)
        EArgs ea{}; ea.f0 = (float*)(R + R_RAW);
        gemm_phase<E_F32>(H, Wb + W_MLA + (size_t)j * WM_SZ + WM_D, T, 1024, 1024, ea, smem, 0, bid, nblk, wv);
      PHASE_END
      PHASE_BEGIN(3)
        mla_rowops(p, j, bid, nblk, wv);
      PHASE_END
      PHASE_BEGIN(4)
        EArgs ea{}; ea.b0 = (bf16_t*)(R + R_Q); ea.rope = ROPE;
        gemm_phase<E_MLAQ>((const bf16_t*)(R + R_CQ), Wb + W_MLA + (size_t)j * WM_SZ + WM_UQ, T, 1536, 512, ea, smem, 0, bid, nblk, wv);
        EArgs eb{}; eb.b0 = (bf16_t*)(R + R_KN); eb.b1 = (bf16_t*)(R + R_VT);
        gemm_phase<E_MLAKV>((const bf16_t*)(R + R_CKV), Wb + W_MLA + (size_t)j * WM_SZ + WM_UKV, KROWS, 2048, 256, eb, smem, (T / 256) * 6, bid, nblk, wv);
      PHASE_END
      PHASE_BEGIN(5)
        attn_phase<true>(p, smem, bid, nblk, wv);
      PHASE_END
      PHASE_BEGIN(6)
        EArgs ea{}; ea.f0 = X;
        gemm_phase<E_RESID>((const bf16_t*)(R + R_RAW), Wb + W_MLA + (size_t)j * WM_SZ + WM_O, T, 1024, 1024, ea, smem, 0, bid, nblk, wv);
      PHASE_END
    } else if (kind == 1) {
      PHASE_BEGIN(1)
        rmsnorm_rows(X, p.in[7] + L * 1024, H, nullptr, nullptr, bid, nblk, wv);
      PHASE_END
      PHASE_BEGIN(7)
        EArgs ea{}; ea.b0 = (bf16_t*)(R + C_U); ea.b1 = (bf16_t*)(R + C_VR);
        gemm_phase<E_GELU>(H, Wb + W_CM + WC_IN, T, 4096, 1024, ea, smem, 0, bid, nblk, wv);
      PHASE_END
      PHASE_BEGIN(8)
        cmlp_ln_rows(p, bid, nblk, wv);
      PHASE_END
      PHASE_BEGIN(9)
        cmlp_mix_phase(p, smem, bid, nblk, wv);
      PHASE_END
      PHASE_BEGIN(6)
        EArgs ea{}; ea.f0 = X;
        gemm_phase<E_RESID>((const bf16_t*)(R + C_G), Wb + W_CM + WC_OUT, T, 1024, 2048, ea, smem, 0, bid, nblk, wv);
      PHASE_END
    } else {
      PHASE_BEGIN(10)
        rmsnorm_rows(X, p.in[7] + L * 1024, H, nullptr, nullptr, bid, nblk, wv);
        cache_rows(p.in[4], (bf16_t*)(R + D_K), 1024, bid, nblk, wv);
        cache_rows(p.in[6], (bf16_t*)(R + D_KI), 64, bid, nblk, wv);
        {
          bf16_t* VTs = (bf16_t*)(R + D_VT) + (size_t)TP * 1024;
          {
            const int hf = tid >> 8, tl = tid & 255;
            float* smh = (float*)smem + hf * 4224;
            for (int u0 = bid * 2; u0 < 512 * 16; u0 += nblk * 2) {
              const int u = u0 + hf;
              int st = u & 15, bh = u >> 4, b = bh >> 4, h = bh & 15;
              transpose_tile(p.in[5] + (size_t)b * 1024 * 1024 + h * 64, 1024, 64, VTs + (size_t)(bh * 64) * SPAD, SPAD, 0, st * 64, 0, smh, tl, true);
            }
          }
          for (int e = bid * NT + tid; e < 512 * 64 * 12; e += nblk * NT) {
            int c = e % 12, rw = e / 12;
            { unsigned z = 0; asm volatile("" : "+v"(z)); *(uint2*)(VTs + (size_t)rw * SPAD + NKS + c * 4) = make_uint2(z, z); }
          }
        }
      PHASE_END
      PHASE_BEGIN(11)
        EArgs ea{};
        ea.f0 = p.out + O_DKP; ea.f1 = p.out + O_DKS; ea.f2 = p.out + O_DVP; ea.f3 = p.out + O_DVS;
        ea.f4 = (float*)(R + D_KIR); ea.f5 = (float*)(R + D_WI);
        ea.b0 = (bf16_t*)(R + D_Q); ea.b1 = (bf16_t*)(R + D_K); ea.b2 = (bf16_t*)(R + D_VT); ea.b3 = (bf16_t*)(R + D_QI);
        gemm_phase<E_DSA>(H, Wb + W_DS + WD_P, T, 3840, 1024, ea, smem, 0, bid, nblk, wv);
      PHASE_END
      PHASE_BEGIN(12)
        dsa_rowops(p, bid, nblk, wv);
      PHASE_END
      PHASE_BEGIN(13)
        idx_phase(p, smem, bid, nblk, wv);
      PHASE_END
      PHASE_BEGIN(14)
        attn_phase<false>(p, smem, bid, nblk, wv);
      PHASE_END
      PHASE_BEGIN(6)
        EArgs ea{}; ea.f0 = X;
        gemm_phase<E_RESID>((const bf16_t*)(R + D_AO), Wb + W_DS + WD_O, T, 1024, 1024, ea, smem, 0, bid, nblk, wv);
      PHASE_END
    }
    PHASE_BEGIN(1)
      rmsnorm_rows(X, p.in[8] + L * 1024, H, nullptr, nullptr, bid, nblk, wv);
    PHASE_END
    PHASE_BEGIN(15)
      EArgs ea{}; ea.b0 = (bf16_t*)(R + 0);
      gemm_phase<E_SWIGLU>(H, Wb + W_FF + (size_t)L * WF_SZ + WF_IN, T, 2 * DFF, 1024, ea, smem, 0, bid, nblk, wv);
    PHASE_END
    PHASE_BEGIN(6)
      EArgs ea{}; ea.f0 = X;
      gemm_phase<E_RESID>((const bf16_t*)(R + 0), Wb + W_FF + (size_t)L * WF_SZ + WF_OUT, T, 1024, DFF, ea, smem, 0, bid, nblk, wv);
    PHASE_END
  }
  PHASE_BEGIN(1)
    rmsnorm_rows(X, p.in[9], nullptr, p.out + O_YP, p.out + O_YS, bid, nblk, wv);
  PHASE_END
}

extern "C" void kernel_launch(void* const* d_in, const int* in_sizes, int n_in,
                              void* d_out, int out_size, void* d_ws, size_t ws_size,
                              hipStream_t stream) {
  constexpr int kLds = 128 * 1024 + 64;
  static int grid_blocks = 0;
  if (!grid_blocks) {
    int dev = 0, cus = 0, per_cu = 0;
    (void)hipGetDevice(&dev);
    (void)hipDeviceGetAttribute(&cus, hipDeviceAttributeMultiprocessorCount, dev);
    (void)hipFuncSetAttribute((const void*)mega, hipFuncAttributeMaxDynamicSharedMemorySize, kLds);
    (void)hipOccupancyMaxActiveBlocksPerMultiprocessor(&per_cu, (const void*)mega, NT, kLds);
    if (per_cu < 1) per_cu = 1;
    if (per_cu > 1) per_cu = 1;
    grid_blocks = cus * per_cu;
    fprintf(stderr, "grid %d (cus %d per_cu %d) ws %zu need %zu out %d need %zu\n", grid_blocks, cus, per_cu, ws_size, (size_t)WS_NEED, out_size, (size_t)O_END);
  }
  if (ws_size < WS_NEED || n_in != 31 || (size_t)out_size != O_END) { fprintf(stderr, "kernel_launch: bad sizes\n"); return; }
  Params p;
  memset(&p, 0, sizeof(p));
  for (int i = 0; i < 31; ++i) p.in[i] = (const float*)d_in[i];
  p.out = (float*)d_out; p.ws = (unsigned char*)d_ws;
  bf16_t* Wb = (bf16_t*)((unsigned char*)d_ws + OFF_W);
  int nj = 0, tiles = 0;
  auto add = [&](const float* src, int nsrc, int k, bf16_t* dst, int ndst, int mode) {
    Job& jb = p.jobs[nj++]; jb.src = src; jb.dst = dst; jb.nsrc = nsrc; jb.k = k; jb.ndst = ndst; jb.mode = mode; jb.tile0 = tiles; jb.pad = 0;
    tiles += (ndst / 64) * (k / 64);
  };
  for (int j = 0; j < 2; ++j) {
    bf16_t* Wm = Wb + W_MLA + (size_t)j * WM_SZ;
    add(p.in[10] + (size_t)j * 1024 * 512, 512, 1024, Wm + WM_D, 512, 2);
    add(p.in[13] + (size_t)j * 1024 * 288, 288, 1024, Wb + W_MLA + (size_t)j * WM_SZ + WM_D + (size_t)512 * 1024, 512, 2);
    add(p.in[12] + (size_t)j * 512 * 1536, 1536, 512, Wb + W_MLA + (size_t)j * WM_SZ + WM_UQ, 1536, 0);
    add(p.in[15] + (size_t)j * 256 * 2048, 2048, 256, Wb + W_MLA + (size_t)j * WM_SZ + WM_UKV, 2048, 2);
    add(p.in[16] + (size_t)j * 1024 * 1024, 1024, 1024, Wb + W_MLA + (size_t)j * WM_SZ + WM_O, 1024, 2);
  }
  add(p.in[17], 4096, 1024, Wb + W_CM + WC_IN, 4096, 2);
  add(p.in[22], 1024, 2048, Wb + W_CM + WC_OUT, 1024, 2);
  add(p.in[23], 3072, 1024, Wb + W_DS + WD_P, 3072, 2);
  add(p.in[25], 512, 1024, Wb + W_DS + WD_P + (size_t)3072 * 1024, 512, 2);
  add(p.in[26], 64, 1024, Wb + W_DS + WD_P + (size_t)3584 * 1024, 64, 2);
  add(p.in[28], 8, 1024, Wb + W_DS + WD_P + (size_t)3648 * 1024, 192, 2);
  add(p.in[24], 1024, 1024, Wb + W_DS + WD_O, 1024, 2);
  for (int i = 0; i < 4; ++i) {
    add(p.in[29] + (size_t)i * 1024 * 5632, 5632, 1024, Wb + W_FF + (size_t)i * WF_SZ + WF_IN, 5632, 1);
    add(p.in[30] + (size_t)i * 2816 * 1024, 1024, 2816, Wb + W_FF + (size_t)i * WF_SZ + WF_OUT, 1024, 2);
  }
  p.total_tiles = tiles;
  for (int i = 0; i < 16; ++i) p.inv_freq[i] = pow(10000.0, -(double)i / 16.0);
  p.ph_lo = 0; p.ph_hi = 1000;
  (void)hipMemsetAsync((unsigned char*)d_ws + OFF_BAR, 0, 16384, stream);
  void* args[] = {&p};
  hipError_t e = hipLaunchCooperativeKernel((const void*)mega, dim3(grid_blocks), dim3(NT), args, kLds, stream);
  if (e != hipSuccess) fprintf(stderr, "coop launch failed: %s\n", hipGetErrorString(e));
}
```
